# Optimizing an MI355X kernel written in HIP

```python
import math
import jax, jax.numpy as jnp
from jax import lax
import numpy as np

D_MODEL = 1024
BATCH = 8
SEQ = 4096
DEPTH = 1

MIX_WIDTH = D_MODEL
ATT_WIDTH = MIX_WIDTH // 2
RWKV_WIDTH = MIX_WIDTH - ATT_WIDTH
HD_ATT = 64
H_ATT = ATT_WIDTH // HD_ATT
HD_RWKV = 64
H_RWKV = RWKV_WIDTH // HD_RWKV
Q_LORA = 256
KV_LATENT = 128
IDX_HEADS = 8
IDX_DIM = 64
TOPK_MAX = 256
Q_BLOCK = 128
NUM_BUCKETS = 32
MAX_DISTANCE = 128
DECAY_LORA = 64
AAA_LORA = 64
GATE_LORA = 160
GN_EPS = 64e-5
ATT_COLS = Q_LORA + KV_LATENT + IDX_DIM + IDX_HEADS
RWKV_COLS = 3 * RWKV_WIDTH + DECAY_LORA + AAA_LORA + GATE_LORA
IN_COLS = ATT_COLS + RWKV_COLS
D_FF = -(-8 * D_MODEL // 768) * 256
NORM_EPS = 1e-6

kernel_name = "hybrid_dsa_rwkv7_sandwich_adaln"


def rms_norm(x, gain):
    xf = x.astype(jnp.float32)
    y = xf * lax.rsqrt(jnp.mean(xf * xf, axis=-1, keepdims=True) + NORM_EPS)
    return (y * gain.astype(jnp.float32)).astype(x.dtype)


def t5_bucket(rel):
    max_exact = NUM_BUCKETS // 2
    nf = jnp.maximum(rel, 1).astype(jnp.float32)
    large = max_exact + (jnp.log(nf / max_exact) / math.log(MAX_DISTANCE / max_exact)
                         * (NUM_BUCKETS - max_exact)).astype(jnp.int32)
    large = jnp.minimum(large, NUM_BUCKETS - 1)
    return jnp.where(rel < max_exact, rel, large)


def dsa_attention(c_q, c_kv, idx_k_raw, idx_w_raw, q_norm, w_uq, w_idx_q, kv_norm, idx_k_norm, w_uk, w_uv, rel_bias):
    B, T, _ = c_q.shape
    topk = min(TOPK_MAX, T // 4)
    cq = rms_norm(c_q, q_norm)
    q = jnp.einsum('btr,rhd->bthd', cq, w_uq)
    q_abs = jnp.einsum('bthd,hcd->bthc', q, w_uk) * (HD_ATT ** -0.5)
    ckv = rms_norm(c_kv, kv_norm)
    iq = jnp.einsum('btr,rhd->bthd', cq, w_idx_q).astype(jnp.float32)
    ik = rms_norm(idx_k_raw, idx_k_norm).astype(jnp.float32)
    iw = idx_w_raw.astype(jnp.float32) * (IDX_HEADS ** -0.5 * IDX_DIM ** -0.5)
    s_pos = jnp.arange(T)

    def block(i):
        t0 = i * Q_BLOCK
        qi = lax.dynamic_slice_in_dim(iq, t0, Q_BLOCK, axis=1)
        wi = lax.dynamic_slice_in_dim(iw, t0, Q_BLOCK, axis=1)
        qa = lax.dynamic_slice_in_dim(q_abs, t0, Q_BLOCK, axis=1)
        t_pos = t0 + jnp.arange(Q_BLOCK)
        score = jnp.einsum('bth,bths->bts', wi, jax.nn.relu(jnp.einsum('bthd,bsd->bths', qi, ik)))
        causal = s_pos[None, :] <= t_pos[:, None]
        score = jnp.where(causal[None], score, -jnp.inf)
        _, sel = lax.top_k(score, topk)
        kv_sel = jax.vmap(lambda m, j: m[j])(ckv, sel)
        rel = t_pos[None, :, None] - sel
        bias = rel_bias[t5_bucket(jnp.maximum(rel, 0))]
        logits = (jnp.einsum('bthc,btkc->bthk', qa, kv_sel).astype(jnp.float32)
                  + jnp.moveaxis(bias, -1, 2).astype(jnp.float32))
        logits = jnp.where((rel >= 0)[:, :, None, :], logits, -jnp.inf)
        p = jax.nn.softmax(logits, axis=-1).astype(kv_sel.dtype)
        return jnp.einsum('bthk,btkc->bthc', p, kv_sel)

    o = lax.map(block, jnp.arange(T // Q_BLOCK))
    o = jnp.moveaxis(o, 0, 1).reshape(B, T, H_ATT, KV_LATENT)
    return jnp.einsum('bthc,hcd->bthd', o, w_uv).reshape(B, T, ATT_WIDTH)


def rwkv7_scan(r, w, k, v, a_vec, b_vec):
    B, T, H, N = r.shape

    def step(S, inp):
        r_t, w_t, k_t, v_t, a_t, b_t = inp
        sa = jnp.einsum('bhij,bhj->bhi', S, a_t)
        S = S * w_t[:, :, None, :] + sa[..., None] * b_t[:, :, None, :] + v_t[..., None] * k_t[:, :, None, :]
        return S, jnp.einsum('bhij,bhj->bhi', S, r_t)

    xs = tuple(jnp.moveaxis(z, 1, 0) for z in (r, w, k, v, a_vec, b_vec))
    _, y = lax.scan(step, jnp.zeros((B, H, N, N), jnp.float32), xs)
    return jnp.moveaxis(y, 0, 1)


def rwkv7_group(p, mu_shift, w0, w_decay_up, a0, w_aaa_up, w_gate_up, k_k, k_a, r_k, ln_x_gain, ln_x_bias):
    B, T, _ = p.shape
    dt = p.dtype
    p_prev = jnp.pad(p, ((0, 0), (1, 0), (0, 0)))[:, :T]
    p = p + mu_shift * (p_prev - p)
    splits = [RWKV_WIDTH, 2 * RWKV_WIDTH, 3 * RWKV_WIDTH, 3 * RWKV_WIDTH + DECAY_LORA, 3 * RWKV_WIDTH + DECAY_LORA + AAA_LORA]
    r, k, v, wd, ad, gd = jnp.split(p, splits, axis=-1)
    w_log = -jax.nn.softplus(-(w0 + jnp.tanh(wd) @ w_decay_up)) - 0.5
    decay = jnp.exp(-jnp.exp(w_log.astype(jnp.float32)))
    a = jax.nn.sigmoid(a0 + ad @ w_aaa_up)
    g = jax.nn.sigmoid(gd) @ w_gate_up
    hs = (B, T, H_RWKV, HD_RWKV)
    kk = (k * k_k).astype(jnp.float32).reshape(hs)
    kk = kk / jnp.maximum(jnp.linalg.norm(kk, axis=-1, keepdims=True), 1e-12)
    k = k * (1 + (a - 1) * k_a)
    rf = r.astype(jnp.float32).reshape(hs)
    kf = k.astype(jnp.float32).reshape(hs)
    vf = v.astype(jnp.float32).reshape(hs)
    af = a.astype(jnp.float32).reshape(hs)
    y = rwkv7_scan(rf, decay.reshape(hs), kf, vf, -kk, kk * af)
    mean = jnp.mean(y, axis=-1, keepdims=True)
    var = jnp.mean(jnp.square(y - mean), axis=-1, keepdims=True)
    y = ((y - mean) * lax.rsqrt(var + GN_EPS)).reshape(B, T, RWKV_WIDTH)
    y = y * ln_x_gain.astype(jnp.float32) + ln_x_bias.astype(jnp.float32)
    bonus = jnp.sum(rf * kf * r_k.astype(jnp.float32), axis=-1, keepdims=True) * vf
    y = (y + bonus.reshape(B, T, RWKV_WIDTH)) * g.astype(jnp.float32)
    return y.astype(dt)


def hybrid_layer(x, c, rel_bias, ada_w, ada_b, mix_pre_norm, mix_post_norm, ffn_pre_norm, ffn_post_norm,
                 w_in, q_norm, w_uq, w_idx_q, kv_norm, idx_k_norm, w_uk, w_uv,
                 mu_shift, w0, w_decay_up, a0, w_aaa_up, w_gate_up, k_k, k_a, r_k, ln_x_gain, ln_x_bias,
                 w_out, w_ffn_gate, w_ffn_up, w_ffn_down):
    mod = jax.nn.silu(c) @ ada_w + ada_b
    sh_m, sc_m, g_m, sh_f, sc_f, g_f = [m[:, None, :] for m in jnp.split(mod, 6, axis=-1)]
    h = rms_norm(x, mix_pre_norm) * (1 + sc_m) + sh_m
    proj = h @ w_in
    att_p, rwkv_p = proj[..., :ATT_COLS], proj[..., ATT_COLS:]
    c_q, c_kv, idx_k_raw, idx_w_raw = jnp.split(att_p, [Q_LORA, Q_LORA + KV_LATENT, Q_LORA + KV_LATENT + IDX_DIM], axis=-1)
    y_att = dsa_attention(c_q, c_kv, idx_k_raw, idx_w_raw, q_norm, w_uq, w_idx_q, kv_norm, idx_k_norm, w_uk, w_uv, rel_bias)
    y_rwkv = rwkv7_group(rwkv_p, mu_shift, w0, w_decay_up, a0, w_aaa_up, w_gate_up, k_k, k_a, r_k, ln_x_gain, ln_x_bias)
    mix = jnp.concatenate([y_att, y_rwkv], axis=-1) @ w_out
    x = x + g_m * rms_norm(mix, mix_post_norm)
    hf = rms_norm(x, ffn_pre_norm) * (1 + sc_f) + sh_f
    f = (jax.nn.silu(hf @ w_ffn_gate) * (hf @ w_ffn_up)) @ w_ffn_down
    return x + g_f * rms_norm(f, ffn_post_norm)


def setup_inputs(seed: int = 0) -> dict:
    key = jax.random.key(seed)
    ks = jax.random.split(key, 40)
    f32 = jnp.float32
    L = DEPTH

    def nrm(k, shape, scale):
        return jax.random.normal(k, shape, f32) * scale

    def gain(k, n):
        return 1.0 + 0.05 * jax.random.normal(k, (L, n), f32)

    return {
        "x": jax.random.normal(ks[0], (BATCH, SEQ, D_MODEL), f32),
        "c": jax.random.normal(ks[1], (BATCH, D_MODEL), f32),
        "rel_bias": nrm(ks[2], (NUM_BUCKETS, H_ATT), 0.5),
        "ada_w": nrm(ks[3], (L, D_MODEL, 6 * D_MODEL), 0.5 * D_MODEL ** -0.5),
        "ada_b": nrm(ks[4], (L, 6 * D_MODEL), 0.02),
        "mix_pre_norm": gain(ks[5], D_MODEL),
        "mix_post_norm": gain(ks[6], D_MODEL),
        "ffn_pre_norm": gain(ks[7], D_MODEL),
        "ffn_post_norm": gain(ks[8], D_MODEL),
        "w_in": nrm(ks[9], (L, D_MODEL, IN_COLS), D_MODEL ** -0.5),
        "q_norm": gain(ks[10], Q_LORA),
        "w_uq": nrm(ks[11], (L, Q_LORA, H_ATT, HD_ATT), Q_LORA ** -0.5),
        "w_idx_q": nrm(ks[12], (L, Q_LORA, IDX_HEADS, IDX_DIM), Q_LORA ** -0.5),
        "kv_norm": gain(ks[13], KV_LATENT),
        "idx_k_norm": gain(ks[14], IDX_DIM),
        "w_uk": nrm(ks[15], (L, H_ATT, KV_LATENT, HD_ATT), KV_LATENT ** -0.5),
        "w_uv": nrm(ks[16], (L, H_ATT, KV_LATENT, HD_ATT), KV_LATENT ** -0.5),
        "mu_shift": jax.random.uniform(ks[17], (L, RWKV_COLS), f32),
        "w0": nrm(ks[18], (L, RWKV_WIDTH), 0.5),
        "w_decay_up": nrm(ks[19], (L, DECAY_LORA, RWKV_WIDTH), 0.1 * DECAY_LORA ** -0.5),
        "a0": nrm(ks[20], (L, RWKV_WIDTH), 0.1),
        "w_aaa_up": nrm(ks[21], (L, AAA_LORA, RWKV_WIDTH), 0.5 * AAA_LORA ** -0.5),
        "w_gate_up": nrm(ks[22], (L, GATE_LORA, RWKV_WIDTH), GATE_LORA ** -0.5),
        "k_k": 0.85 + 0.05 * jax.random.normal(ks[23], (L, RWKV_WIDTH), f32),
        "k_a": 1.0 + 0.05 * jax.random.normal(ks[24], (L, RWKV_WIDTH), f32),
        "r_k": nrm(ks[25], (L, H_RWKV, HD_RWKV), 0.1),
        "ln_x_gain": gain(ks[26], RWKV_WIDTH),
        "ln_x_bias": nrm(ks[27], (L, RWKV_WIDTH), 0.02),
        "w_out": nrm(ks[28], (L, MIX_WIDTH, D_MODEL), MIX_WIDTH ** -0.5),
        "w_ffn_gate": nrm(ks[29], (L, D_MODEL, D_FF), D_MODEL ** -0.5),
        "w_ffn_up": nrm(ks[30], (L, D_MODEL, D_FF), D_MODEL ** -0.5),
        "w_ffn_down": nrm(ks[31], (L, D_FF, D_MODEL), D_FF ** -0.5),
    }


def reference(x, c, rel_bias, ada_w, ada_b, mix_pre_norm, mix_post_norm, ffn_pre_norm, ffn_post_norm,
              w_in, q_norm, w_uq, w_idx_q, kv_norm, idx_k_norm, w_uk, w_uv,
              mu_shift, w0, w_decay_up, a0, w_aaa_up, w_gate_up, k_k, k_a, r_k, ln_x_gain, ln_x_bias,
              w_out, w_ffn_gate, w_ffn_up, w_ffn_down):
    layer_params = (ada_w, ada_b, mix_pre_norm, mix_post_norm, ffn_pre_norm, ffn_post_norm,
                    w_in, q_norm, w_uq, w_idx_q, kv_norm, idx_k_norm, w_uk, w_uv,
                    mu_shift, w0, w_decay_up, a0, w_aaa_up, w_gate_up, k_k, k_a, r_k, ln_x_gain, ln_x_bias,
                    w_out, w_ffn_gate, w_ffn_up, w_ffn_down)
    for l in range(DEPTH):
        x = hybrid_layer(x, c, rel_bias, *[p[l] for p in layer_params])
    return x
```

```cpp
#include <hip/hip_runtime.h>
#include <cstdio>
#include <cstdint>

#define LAS __attribute__((address_space(3)))
#define GAS __attribute__((address_space(1)))
typedef _Float16 f16;
typedef _Float16 f16x8 __attribute__((ext_vector_type(8)));
typedef _Float16 f16x4 __attribute__((ext_vector_type(4)));
typedef _Float16 f16x2 __attribute__((ext_vector_type(2)));
typedef float f32x4 __attribute__((ext_vector_type(4)));
typedef float f32x2 __attribute__((ext_vector_type(2)));
typedef unsigned u32x4 __attribute__((ext_vector_type(4)));
typedef unsigned u32x2 __attribute__((ext_vector_type(2)));

__device__ __forceinline__ unsigned pkh(float a, float b) { f16x2 v = {(f16)a, (f16)b}; return __builtin_bit_cast(unsigned, v); }
__device__ __forceinline__ float h2f(f16 h) { return (float)h; }

namespace pg8 {
constexpr int BM = 256, BK = 64, HALF = 128, HTB = HALF * BK * 2, STAGE_BYTES = 8 * HTB, NXCD = 8, WGM = 8;
__host__ __device__ __forceinline__ int lds_byte(int r, int c) { const int st = (r >> 4) * 2 + (c >> 5), rr = r & 15, cc = c & 31, ob = rr * 64 + cc * 2; return st * 1024 + (ob ^ (((ob >> 9) & 1) << 5)); }
__host__ __device__ __forceinline__ void stage_rc(int b, int& R, int& C) { const int st = b / 1024, sb = b % 1024, swz = sb ^ (((sb >> 9) & 1) << 5); R = (st >> 1) * 16 + swz / 64; C = (st & 1) * 32 + (swz % 64) / 2; }
__host__ __device__ __forceinline__ int perm32(int rho) { const int n = rho >> 4, i = rho & 15; return 8 * (i >> 2) + 4 * n + (i & 3); }

struct Unit { int pm, pn; };
struct Gemm { const f16* A; const f16* Bt; int M, N, K; };

struct StaticOrder {
    int nM, nN, nwg, G, c;
    __host__ __device__ void init(int M, int N, int G_, int c_) { nM = M / BM; nN = N / BM; nwg = nM * nN; G = G_; c = c_; }
    __host__ __device__ bool next(int i, Unit& u) const {
        const long L = (long)i * G + c; if (L >= nwg) return false;
        int wgid = (int)L; { const int q = nwg / NXCD, r = nwg % NXCD, xcd = wgid % NXCD, off = wgid / NXCD; wgid = (xcd < r ? xcd * (q + 1) : r * (q + 1) + (xcd - r) * q) + off; }
        const int nig = WGM * nN, gid = wgid / nig, fm = gid * WGM, gsz = (nM - fm) < WGM ? (nM - fm) : WGM;
        u.pm = fm + ((wgid % nig) % gsz); u.pn = (wgid % nig) / gsz; return true;
    }
    __device__ __forceinline__ void a_ready(const Unit&) const {}
    __device__ __forceinline__ void done(const Unit&) const {}
};

struct EpiF16 {
    static constexpr bool PERM = true, AFTER_DRAIN = false;
    f16* O; int ldc;
    __device__ __forceinline__ void operator()(const f32x4 (&acc)[2][2][4][2], const Unit& u, int wr, int wc, int fr, int fq) const {
        const int row0 = u.pm * BM + wr * 64 + fr; const int col0 = u.pn * BM + wc * 32 + 8 * fq;
#pragma unroll
        for (int ai = 0; ai < 2; ++ai)
#pragma unroll
            for (int m = 0; m < 4; ++m) { f16* rowp = O + (size_t)(row0 + ai * HALF + m * 16) * ldc + col0;
#pragma unroll
                for (int bj = 0; bj < 2; ++bj) { const f32x4 v0 = acc[ai][bj][m][0], v1 = acc[ai][bj][m][1];
                    u32x4 w; w.x = pkh(v0[0], v0[1]); w.y = pkh(v0[2], v0[3]); w.z = pkh(v1[0], v1[1]); w.w = pkh(v1[2], v1[3]);
                    *(u32x4*)(rowp + bj * HALF) = w; } }
    }
};
struct EpiSwiGLU {
    static constexpr bool PERM = true, AFTER_DRAIN = false;
    f16* O; int ldc;
    __device__ __forceinline__ void operator()(const f32x4 (&acc)[2][2][4][2], const Unit& u, int wr, int wc, int fr, int fq) const {
        const int row0 = u.pm * BM + wr * 64 + fr; const int col0 = u.pn * HALF + wc * 32 + 8 * fq;
#pragma unroll
        for (int ai = 0; ai < 2; ++ai)
#pragma unroll
            for (int m = 0; m < 4; ++m) { f16* rowp = O + (size_t)(row0 + ai * HALF + m * 16) * ldc + col0;
                float o[8];
#pragma unroll
                for (int n = 0; n < 2; ++n)
#pragma unroll
                    for (int j = 0; j < 4; ++j) { const float g = acc[ai][0][m][n][j], up = acc[ai][1][m][n][j]; o[n * 4 + j] = g * __builtin_amdgcn_rcpf(1.0f + __expf(-g)) * up; }
                u32x4 w; w.x = pkh(o[0], o[1]); w.y = pkh(o[2], o[3]); w.z = pkh(o[4], o[5]); w.w = pkh(o[6], o[7]);
                *(u32x4*)rowp = w; }
    }
};

template <class Epi, class Sched, bool ALIGN_EPI = false, bool SP2 = false>
__device__ __forceinline__ void gemm_phase(LAS unsigned char* lds, const Gemm g, const Sched& S, const Epi& E) {
    const int tid = threadIdx.x, wid = __builtin_amdgcn_readfirstlane(tid >> 6), lane = tid & 63, wr = wid >> 2, wc = wid & 3, fr = lane & 15, fq = lane >> 4;
    const int K = g.K, nt = K / BK;
    unsigned voffA[2], voffB[2];
#pragma unroll
    for (int i = 0; i < 2; ++i) { int R, C; stage_rc(tid * 16 + i * 8192, R, C); const int Rb = Epi::PERM ? ((R & ~31) + perm32(R & 31)) : R;
        voffA[i] = (unsigned)(R * K + C) * 2u; voffB[i] = (unsigned)(Rb * K + C) * 2u; }
    const size_t kstep = (size_t)(BK * 2);
    const size_t hstep = (size_t)HALF * K * 2;
    const size_t tstep = 2 * hstep;
    const unsigned ldsw = (unsigned)wid * 1024u;
    const int aoff = lds_byte(wr * 64 + fr, fq * 8), boff = lds_byte(wc * 32 + fr, fq * 8);
#define PG8_SA(b, h) (((b) * 2 + (h)) * HTB)
#define PG8_SB(b, h) ((4 + (b) * 2 + (h)) * HTB)
#define PG8_STAGE(bufoff, gbase, voff) do { _Pragma("unroll") for (int _i = 0; _i < 2; ++_i) \
        __builtin_amdgcn_global_load_lds((const unsigned*)((const char*)(gbase) + (voff)[_i]), (LAS unsigned*)(lds + (bufoff) + ldsw + _i * 8192), 16, 0, 0); } while (0)
#define PG8_LDA(dst, b, h) do { _Pragma("unroll") for (int m = 0; m < 4; ++m) _Pragma("unroll") for (int k = 0; k < 2; ++k) dst[m][k] = *(const LAS f16x8*)(lds + PG8_SA(b, h) + aoff + m * 2048 + k * 1024); } while (0)
#define PG8_LDB(dst, b, h) do { _Pragma("unroll") for (int n = 0; n < 2; ++n) _Pragma("unroll") for (int k = 0; k < 2; ++k) dst[n][k] = *(const LAS f16x8*)(lds + PG8_SB(b, h) + boff + n * 2048 + k * 1024); } while (0)
#define PG8_MMA(ai, bj, At, Bt) do { __builtin_amdgcn_s_setprio(1); _Pragma("unroll") for (int m = 0; m < 4; ++m) _Pragma("unroll") for (int n = 0; n < 2; ++n) _Pragma("unroll") for (int k = 0; k < 2; ++k) \
        acc[ai][bj][m][n] = __builtin_amdgcn_mfma_f32_16x16x32_f16(Bt[n][k], At[m][k], acc[ai][bj][m][n], 0, 0, 0); __builtin_amdgcn_s_setprio(0); } while (0)
#define PG8_WAIT_V(n) asm volatile("s_waitcnt vmcnt(" #n ")" ::: "memory")
#define PG8_WAIT_L(n) asm volatile("s_waitcnt lgkmcnt(" #n ")" ::: "memory")
#define PG8_BAR __builtin_amdgcn_s_barrier()
#define PG8_SCHED __builtin_amdgcn_sched_barrier(0)
    Unit cur, nxt; int ui = 0;
    if (!S.next(0, cur)) return;
    f32x4 acc[2][2][4][2];
#pragma unroll
    for (int a = 0; a < 2; ++a)
#pragma unroll
        for (int b = 0; b < 2; ++b)
#pragma unroll
            for (int m = 0; m < 4; ++m)
#pragma unroll
                for (int n = 0; n < 2; ++n) acc[a][b][m][n] = (f32x4){0.f, 0.f, 0.f, 0.f};
    f16x8 At[4][2], B0[2][2], B1[2][2];
    const char* cA = (const char*)g.A + (size_t)cur.pm * tstep; const char* cB = (const char*)g.Bt + (size_t)cur.pn * tstep;
    S.a_ready(cur);
    if constexpr (SP2) {
        PG8_STAGE(PG8_SB(0, 0), cB, voffB); PG8_STAGE(PG8_SB(0, 1), cB + hstep, voffB); PG8_STAGE(PG8_SA(0, 0), cA, voffA); PG8_STAGE(PG8_SA(0, 1), cA + hstep, voffA);
        if (wr == 1) PG8_BAR;
        PG8_WAIT_V(2); PG8_BAR;
        PG8_STAGE(PG8_SB(1, 0), cB + kstep, voffB); PG8_STAGE(PG8_SA(1, 0), cA + kstep, voffA); PG8_STAGE(PG8_SB(1, 1), cB + hstep + kstep, voffB);
        PG8_WAIT_V(6); PG8_BAR;
    } else {
        PG8_STAGE(PG8_SB(0, 0), cB, voffB); PG8_STAGE(PG8_SA(0, 0), cA, voffA); PG8_STAGE(PG8_SB(0, 1), cB + hstep, voffB); PG8_STAGE(PG8_SA(0, 1), cA + hstep, voffA);
        if (wr == 1) PG8_BAR;
        PG8_WAIT_V(4); PG8_BAR;
        PG8_STAGE(PG8_SB(1, 0), cB + kstep, voffB); PG8_STAGE(PG8_SA(1, 0), cA + kstep, voffA); PG8_STAGE(PG8_SB(1, 1), cB + hstep + kstep, voffB);
        PG8_WAIT_V(6); PG8_BAR;
    }
    for (;;) {
        const bool has_next = S.next(ui + 1, nxt);
        const char* nA = has_next ? (const char*)g.A + (size_t)nxt.pm * tstep : cA; const char* nB = has_next ? (const char*)g.Bt + (size_t)nxt.pn * tstep : cB;
        for (int t = 0; t < nt; t += 2) {
            const bool last = (t == nt - 2);
            const char* a1 = cA + (size_t)(t + 1) * kstep;
            const char* a2 = last ? nA : cA + (size_t)(t + 2) * kstep; const char* b2 = last ? nB : cB + (size_t)(t + 2) * kstep;
            const char* a3 = a2 + kstep; const char* b3 = b2 + kstep;
            if (last && has_next) S.a_ready(nxt);
            if constexpr (SP2) {
            PG8_LDB(B0, 0, 0); PG8_LDB(B1, 0, 1); PG8_SCHED; PG8_LDA(At, 0, 0); PG8_STAGE(PG8_SA(1, 1), a1 + hstep, voffA);
            PG8_WAIT_V(8); PG8_WAIT_L(0); PG8_BAR; PG8_MMA(0, 0, At, B0); PG8_MMA(0, 1, At, B1); PG8_BAR; PG8_SCHED;
            PG8_LDA(At, 0, 1); PG8_STAGE(PG8_SB(0, 0), b2, voffB); PG8_STAGE(PG8_SB(0, 1), b2 + hstep, voffB); PG8_STAGE(PG8_SA(0, 0), a2, voffA);
            PG8_WAIT_V(8); PG8_WAIT_L(0); PG8_BAR; PG8_MMA(1, 0, At, B0); PG8_MMA(1, 1, At, B1); PG8_BAR; PG8_SCHED;
            PG8_LDB(B0, 1, 0); PG8_LDB(B1, 1, 1); PG8_SCHED; PG8_LDA(At, 1, 0); PG8_STAGE(PG8_SA(0, 1), a2 + hstep, voffA);
            PG8_WAIT_V(8); PG8_WAIT_L(0); PG8_BAR; PG8_MMA(0, 0, At, B0); PG8_MMA(0, 1, At, B1); PG8_BAR; PG8_SCHED;
            PG8_LDA(At, 1, 1); PG8_STAGE(PG8_SB(1, 0), b3, voffB); PG8_STAGE(PG8_SB(1, 1), b3 + hstep, voffB); PG8_STAGE(PG8_SA(1, 0), a3, voffA);
            PG8_WAIT_V(8); PG8_WAIT_L(0); PG8_BAR; PG8_MMA(1, 0, At, B0); PG8_MMA(1, 1, At, B1); PG8_BAR; PG8_SCHED;
            } else {
            PG8_LDB(B0, 0, 0); PG8_SCHED; PG8_LDA(At, 0, 0); PG8_STAGE(PG8_SA(1, 1), a1 + hstep, voffA);
            PG8_WAIT_L(8); PG8_BAR; PG8_WAIT_L(0); PG8_MMA(0, 0, At, B0); PG8_BAR; PG8_SCHED;
            PG8_LDB(B1, 0, 1); PG8_STAGE(PG8_SB(0, 0), b2, voffB);
            PG8_BAR; PG8_WAIT_L(0); PG8_MMA(0, 1, At, B1); PG8_BAR;
            PG8_LDA(At, 0, 1); PG8_STAGE(PG8_SA(0, 0), a2, voffA);
            PG8_BAR; PG8_WAIT_L(0); PG8_MMA(1, 0, At, B0); PG8_BAR; PG8_SCHED;
            PG8_STAGE(PG8_SB(0, 1), b2 + hstep, voffB);
            PG8_WAIT_V(6); PG8_BAR; PG8_MMA(1, 1, At, B1); PG8_BAR;
            PG8_LDB(B0, 1, 0); PG8_SCHED; PG8_LDA(At, 1, 0); PG8_STAGE(PG8_SA(0, 1), a2 + hstep, voffA);
            PG8_WAIT_L(8); PG8_BAR; PG8_WAIT_L(0); PG8_MMA(0, 0, At, B0); PG8_BAR; PG8_SCHED;
            PG8_LDB(B1, 1, 1); PG8_STAGE(PG8_SB(1, 0), b3, voffB);
            PG8_BAR; PG8_WAIT_L(0); PG8_MMA(0, 1, At, B1); PG8_BAR;
            PG8_LDA(At, 1, 1); PG8_STAGE(PG8_SA(1, 0), a3, voffA);
            PG8_BAR; PG8_WAIT_L(0); PG8_MMA(1, 0, At, B0); PG8_BAR; PG8_SCHED;
            PG8_STAGE(PG8_SB(1, 1), b3 + hstep, voffB);
            PG8_WAIT_V(6); PG8_BAR; PG8_MMA(1, 1, At, B1); PG8_BAR;
            }
        }
        if constexpr (ALIGN_EPI) { if (wr == 0) PG8_BAR; }
        if constexpr (!Epi::AFTER_DRAIN) { E(acc, cur, wr, wc, fr, fq); S.done(cur); }
        if (!has_next) break;
#pragma unroll
        for (int a = 0; a < 2; ++a)
#pragma unroll
            for (int b = 0; b < 2; ++b)
#pragma unroll
                for (int m = 0; m < 4; ++m)
#pragma unroll
                    for (int n = 0; n < 2; ++n) acc[a][b][m][n] = (f32x4){0.f, 0.f, 0.f, 0.f};
        cur = nxt; cA = nA; cB = nB; ++ui;
        if constexpr (ALIGN_EPI) { if (wr == 1) PG8_BAR; }
    }
    PG8_WAIT_V(0);
    if constexpr (!ALIGN_EPI) { if (wr == 0) PG8_BAR; }
    PG8_BAR;
#undef PG8_SA
#undef PG8_SB
#undef PG8_STAGE
#undef PG8_LDA
#undef PG8_LDB
#undef PG8_MMA
#undef PG8_WAIT_V
#undef PG8_WAIT_L
#undef PG8_BAR
#undef PG8_SCHED
}
}

#define XB_TMO      128
#define XB_XCNT(j)  (256  + 64 * (j))
#define XB_XSUB(j)  (1280 + 64 * (j))
#define XB_XGEN(j)  (2304 + 64 * (j))
#define XB_TOP      3328
#define XB_TOPGEN   3392
#define XCD_BAR_WORDS 3456
#define XB_SPIN_CAP (1u << 18)
__device__ __forceinline__ unsigned xb_ld(unsigned* p)              { return __hip_atomic_load(p, __ATOMIC_RELAXED, __HIP_MEMORY_SCOPE_AGENT); }
__device__ __forceinline__ unsigned xb_add(unsigned* p, unsigned v) { return __hip_atomic_fetch_add(p, v, __ATOMIC_RELAXED, __HIP_MEMORY_SCOPE_AGENT); }
__device__ __forceinline__ unsigned xb_xcc_id() { return (unsigned)__builtin_amdgcn_s_getreg((3 << 11) | 20) & 0xFu; }
#define XB_SPIN(cond, bar) do { unsigned _sp = 0; while (cond) { __builtin_amdgcn_s_sleep(1); \
    if ((++_sp & 255u) == 0u) { if (xb_ld(&(bar)[XB_TMO])) break; if (_sp > XB_SPIN_CAP) { atomicAdd(&(bar)[XB_TMO], 1u); break; } } } } while (0)
struct XcdBarrier { unsigned* bar; unsigned x; volatile LAS unsigned* st; };
__device__ __forceinline__ XcdBarrier xcd_barrier_post(unsigned* bar, volatile LAS unsigned* st) {
    XcdBarrier b; b.bar = bar; b.x = xb_xcc_id(); b.st = st;
    if (threadIdx.x == 0) (void)xb_add(&bar[XB_XCNT(b.x)], 1u);
    return b;
}
__device__ __forceinline__ void xcd_barrier_complete(unsigned* bar, unsigned x, unsigned& nloc, unsigned& nx) {
    const unsigned G = gridDim.x * gridDim.y * gridDim.z;
    unsigned sum, cnt, mine, sp = 0u;
    for (;;) {
        sum = 0u; cnt = 0u; mine = 0u;
#pragma unroll
        for (unsigned j = 0; j < 16; ++j) { const unsigned c = xb_ld(&bar[XB_XCNT(j)]); sum += c; cnt += (c > 0u) ? 1u : 0u; mine = (j == x) ? c : mine; }
        if (sum == G) break;
        __builtin_amdgcn_s_sleep(1);
        if ((++sp & 255u) == 0u) { if (xb_ld(&bar[XB_TMO])) break; if (sp > XB_SPIN_CAP) { atomicAdd(&bar[XB_TMO], 1u); break; } }
    }
    nloc = mine > 0u ? mine : 1u; nx = cnt > 0u ? cnt : 1u;
}
__device__ __forceinline__ void xcd_barrier(const XcdBarrier& b) {
    asm volatile("s_waitcnt vmcnt(0)" ::: "memory");
    __syncthreads();
    if (threadIdx.x == 0) {
        unsigned* bar = b.bar;
        __builtin_amdgcn_s_waitcnt(0);
        unsigned nloc = b.st[0], nx = b.st[1];
        if (nloc == 0u) { xcd_barrier_complete(bar, b.x, nloc, nx); b.st[0] = nloc; b.st[1] = nx; }
        const unsigned old = xb_add(&bar[XB_XSUB(b.x)], 1u);
        const unsigned gen = old / nloc;
        if (old + 1u == (gen + 1u) * nloc) {
            __builtin_amdgcn_fence(__ATOMIC_RELEASE, "agent");
            asm volatile("s_waitcnt vmcnt(0)" ::: "memory");
            const unsigned og = xb_add(&bar[XB_TOP], 1u);
            const unsigned tg = og / nx;
            if (og + 1u == (tg + 1u) * nx) xb_add(&bar[XB_TOPGEN], 1u);
            else XB_SPIN(xb_ld(&bar[XB_TOPGEN]) == tg, bar);
            __builtin_amdgcn_fence(__ATOMIC_ACQUIRE, "agent");
            xb_add(&bar[XB_XGEN(b.x)], 1u);
            asm volatile("s_waitcnt vmcnt(0)" ::: "memory");
        } else {
            XB_SPIN(xb_ld(&bar[XB_XGEN(b.x)]) == gen, bar);
            __builtin_amdgcn_fence(__ATOMIC_ACQUIRE, "agent");
            asm volatile("s_waitcnt vmcnt(0)" ::: "memory");
        }
    }
    __syncthreads();
}

constexpr int BATCH = 8, SEQ = 4096, D = 1024, MTOK = BATCH * SEQ;
constexpr int QL = 256, KVL = 128, IDXD = 64, IDXH = 8, HATT = 8, TOPK = 256;
constexpr int RW = 512, HRW = 8, NRW = 64;
constexpr int IN_COLS = 2280, IN_PAD = 2304;
constexpr int C_CQ = 0, C_CKV = 256, C_IK = 384, C_IW = 448, C_R = 456, C_K = 968, C_V = 1480, C_WD = 1992, C_AD = 2056, C_GD = 2120;
constexpr int DFF = 2816;
constexpr int NQI = 1536;
constexpr int KOUT = 1536;
constexpr float NORM_EPS = 1e-6f, GN_EPS = 64e-5f;

constexpr size_t MiB = 1u << 20;
constexpr size_t WS_CTL = 0, CTL_ZERO_BYTES = 64 * 1024;
constexpr size_t WS_MOD = 1 * MiB;
constexpr size_t WS_WIN = 2 * MiB;
constexpr size_t WS_WCQ = 7 * MiB;
constexpr size_t WS_WOUT = 8 * MiB;
constexpr size_t WS_WGU = 11 * MiB;
constexpr size_t WS_WDN = 22 * MiB;
constexpr size_t WS_H = 32 * MiB;
constexpr size_t WS_RWW = 32 * MiB, WS_RWA = 64 * MiB;
constexpr size_t WS_PROJ = 96 * MiB;
constexpr size_t WS_CQ = 240 * MiB;
constexpr size_t WS_SEL = 240 * MiB;
constexpr size_t WS_OATT = 256 * MiB;
constexpr size_t WS_CKV = 352 * MiB;
constexpr size_t WS_IK16 = 360 * MiB;
constexpr size_t WS_IK32 = 364 * MiB;
constexpr size_t WS_IW = 372 * MiB;
constexpr size_t WS_RWG = 376 * MiB;
constexpr size_t WS_YRAW = 408 * MiB;
constexpr size_t WS_MIX = 408 * MiB;
constexpr size_t WS_ACT = 96 * MiB;
constexpr size_t WS_F = 288 * MiB;
constexpr size_t WS_END = 504 * MiB;

constexpr int CW_BAR = 1024;
constexpr int NWAVES = 8;
constexpr int RING_BYTES = 131072, AUX_OFF = RING_BYTES  , MISC_OFF = 155648, LDS_BYTES = 155904;

struct Args { const float* in[32]; float* out; unsigned char* ws; int ph_lo, ph_hi; };

__device__ __forceinline__ float wave_sum(float v) {
#pragma unroll
    for (int o = 1; o < 64; o <<= 1) v += __shfl_xor(v, o);
    return v;
}
__device__ __forceinline__ void lds_barrier() { asm volatile("s_waitcnt lgkmcnt(0)\n\ts_barrier" ::: "memory"); }
__device__ __forceinline__ float sigmoidf_(float x) { return __builtin_amdgcn_rcpf(1.0f + __expf(-x)); }

__device__ __forceinline__ void p0_transpose_item(const float* W, int K, int N, int Npad, f16* WT, int ldk, int koff, int row_off, int mode, LAS float* scr, int item, int lane) {
    const int nblk = Npad / 32, kb = item / nblk, nb = item % nblk, k0 = 64 * kb, n0 = 32 * nb;
#pragma unroll 8
    for (int i = 0; i < 32; ++i) { const int kk = 2 * i + (lane >> 5); const int n = n0 + (lane & 31); scr[kk * 33 + (lane & 31)] = (n < N && k0 + kk < K) ? W[(size_t)(k0 + kk) * N + n] : 0.f; }
    asm volatile("s_waitcnt lgkmcnt(0)" ::: "memory");
    const int c = lane & 7;
#pragma unroll
    for (int j = 0; j < 4; ++j) { const int nl = (lane >> 3) + 8 * j; const LAS float* s = scr + (8 * c) * 33 + nl;
        u32x4 o; o.x = pkh(s[0 * 33], s[1 * 33]); o.y = pkh(s[2 * 33], s[3 * 33]); o.z = pkh(s[4 * 33], s[5 * 33]); o.w = pkh(s[6 * 33], s[7 * 33]);
        const int n = n0 + nl; int row;
        if (mode == 0) row = row_off + n; else row = (n >> 7) * 256 + (mode == 2 ? 128 : 0) + (n & 127);
        *(u32x4*)(WT + (size_t)row * ldk + koff + k0 + 8 * c) = o; }
    asm volatile("s_waitcnt lgkmcnt(0)" ::: "memory");
}

__device__ __forceinline__ void p0_prologue(const Args& a, LAS unsigned char* lds, int vcu, int G, int wave, int lane) {
    unsigned char* ws = a.ws;
    LAS float* scr = (LAS float*)(lds + wave * 16384);
    const int gw = vcu * NWAVES + wave, NGW = G * NWAVES;
    f16* Win = (f16*)(ws + WS_WIN); f16* Wcq = (f16*)(ws + WS_WCQ); f16* Wout = (f16*)(ws + WS_WOUT); f16* Wgu = (f16*)(ws + WS_WGU); f16* Wdn = (f16*)(ws + WS_WDN);
    constexpr int I_IN = (D / 64) * (IN_PAD / 32), I_IDX = (QL / 64) * (512 / 32), I_OR = (512 / 64) * (D / 32), I_G = (D / 64) * (DFF / 32), I_D = (DFF / 64) * (D / 32);
    constexpr int I_FQ = 4 * 64, I_FO = 16 * 64, I_MOD = 8 * 96, I_LD = 16, I_LG = 48;
    constexpr int NITEMS = I_IN + I_IDX + I_OR + 2 * I_G + I_D + I_FQ + I_FO + 2 * I_LD + I_LG;
    for (int it = gw; it < NITEMS; it += NGW) {
        int r = it;
        if (r < I_IN) { p0_transpose_item(a.in[9], D, IN_COLS, IN_PAD, Win, D, 0, 0, 0, scr, r, lane); continue; } r -= I_IN;
        if (r < I_IDX) { p0_transpose_item(a.in[12], QL, 512, 512, Wcq, QL, 0, 1024, 0, scr, r, lane); continue; } r -= I_IDX;
        if (r < I_OR) { p0_transpose_item(a.in[28] + (size_t)512 * D, 512, D, D, Wout, KOUT, 1024, 0, 0, scr, r, lane); continue; } r -= I_OR;
        if (r < I_G) { p0_transpose_item(a.in[29], D, DFF, DFF, Wgu, D, 0, 0, 1, scr, r, lane); continue; } r -= I_G;
        if (r < I_G) { p0_transpose_item(a.in[30], D, DFF, DFF, Wgu, D, 0, 0, 2, scr, r, lane); continue; } r -= I_G;
        if (r < I_D) { p0_transpose_item(a.in[31], DFF, D, D, Wdn, DFF, 0, 0, 0, scr, r, lane); continue; } r -= I_D;
        if (r < I_FQ) {
            const int rb = r & 3, nb = r >> 2, rr = rb * 64 + lane, n0 = nb * 16, h = n0 >> 7;
            const float* uq = a.in[11] + (size_t)rr * 512 + h * 64; const float* uk = a.in[15] + (size_t)n0 * 64;
            float q[64];
#pragma unroll
            for (int d4 = 0; d4 < 16; ++d4) { const f32x4 v = *(const f32x4*)(uq + 4 * d4); q[4 * d4] = v[0]; q[4 * d4 + 1] = v[1]; q[4 * d4 + 2] = v[2]; q[4 * d4 + 3] = v[3]; }
#pragma unroll 4
            for (int i = 0; i < 16; ++i) { float s = 0.f;
#pragma unroll
                for (int d = 0; d < 64; ++d) s += q[d] * uk[i * 64 + d];
                Wcq[(size_t)(n0 + i) * QL + rr] = (f16)(0.125f * s); }
            continue; } r -= I_FQ;
        if (r < I_FO) {
            const int kb = r & 15, nb = r >> 4, k = kb * 64 + lane, h = k >> 7, n0 = nb * 16;
            const float* uv = a.in[16] + (size_t)k * 64; const float* wo = a.in[28] + (size_t)(h * 64) * D + n0;
            float acc[16];
#pragma unroll
            for (int i = 0; i < 16; ++i) acc[i] = 0.f;
#pragma unroll 8
            for (int d = 0; d < 64; ++d) { const float v = uv[d];
#pragma unroll
                for (int i4 = 0; i4 < 4; ++i4) { const f32x4 w = *(const f32x4*)(wo + (size_t)d * D + 4 * i4); acc[4 * i4] += v * w[0]; acc[4 * i4 + 1] += v * w[1]; acc[4 * i4 + 2] += v * w[2]; acc[4 * i4 + 3] += v * w[3]; } }
#pragma unroll
            for (int i = 0; i < 16; ++i) Wout[(size_t)(n0 + i) * KOUT + k] = (f16)acc[i];
            continue; } r -= I_FO;
        if (r < I_LD) { p0_transpose_item(a.in[19], 64, 512, 512, (f16*)(ws + (28u << 20)), 64, 0, 0, 0, scr, r, lane); continue; } r -= I_LD;
        if (r < I_LD) { p0_transpose_item(a.in[21], 64, 512, 512, (f16*)(ws + (28u << 20) + 65536), 64, 0, 0, 0, scr, r, lane); continue; } r -= I_LD;
        { p0_transpose_item(a.in[22], 160, 512, 512, (f16*)(ws + (28u << 20) + 131072), 192, 0, 0, 0, scr, r, lane); }
    }
    if (vcu < 96) {
        __syncthreads();
        const int tid = wave * 64 + lane;
        for (int e = tid; e < 8 * D; e += 512) { const float cc = a.in[1][e]; *(LAS float*)(lds + (e >> 10) * 16384 + 10496 + (e & 1023) * 4) = cc * sigmoidf_(cc); }
        for (int cb = vcu; cb < 96; cb += G) {
            __syncthreads();
            const int j = cb * 64 + lane; const float* aw = a.in[3] + j;
            float acc[8];
#pragma unroll
            for (int b = 0; b < 8; ++b) acc[b] = 0.f;
            const int kbeg = wave * 128;
#pragma unroll 1
            for (int k0 = 0; k0 < 128; k0 += 16) {
                float wv[16];
#pragma unroll
                for (int i = 0; i < 16; ++i) wv[i] = aw[(size_t)(kbeg + k0 + i) * 6144];
#pragma unroll
                for (int b = 0; b < 8; ++b) {
#pragma unroll
                    for (int i4 = 0; i4 < 4; ++i4) { const f32x4 sv = *(const LAS f32x4*)(lds + b * 16384 + 10496 + (kbeg + k0 + 4 * i4) * 4);
                        acc[b] += sv[0] * wv[4 * i4] + sv[1] * wv[4 * i4 + 1] + sv[2] * wv[4 * i4 + 2] + sv[3] * wv[4 * i4 + 3]; } }
            }
#pragma unroll
            for (int b = 0; b < 8; ++b) *(LAS float*)(lds + wave * 16384 + 8448 + (b * 64 + lane) * 4) = acc[b];
            __syncthreads();
            float sum = 0.f;
#pragma unroll
            for (int w = 0; w < 8; ++w) sum += *(const LAS float*)(lds + w * 16384 + 8448 + (wave * 64 + lane) * 4);
            ((float*)(ws + WS_MOD))[wave * 6144 + j] = sum + a.in[4][j];
        }
    }
}

__device__ __forceinline__ void p1_modnorm(const Args& a, int vcu, int G, int wave, int lane) {
    const int gw = vcu * NWAVES + wave, NGW = G * NWAVES;
    const float* mod = (const float*)(a.ws + WS_MOD); f16* H = (f16*)(a.ws + WS_H);
    for (int m = gw; m < MTOK; m += NGW) {
        const int b = m >> 12;
        const f32x4* xr = (const f32x4*)(a.in[0] + (size_t)m * D) + lane;
        f32x4 v[4]; float s = 0.f;
#pragma unroll
        for (int j = 0; j < 4; ++j) { v[j] = xr[64 * j]; s += (v[j][0] * v[j][0] + v[j][1] * v[j][1]) + (v[j][2] * v[j][2] + v[j][3] * v[j][3]); }
        const float r = rsqrtf(wave_sum(s) * (1.f / D) + NORM_EPS);
        u32x2* o = (u32x2*)(H + (size_t)m * D) + lane;
#pragma unroll
        for (int j = 0; j < 4; ++j) { const int c = 4 * lane + 256 * j;
            const f32x4 g = *(const f32x4*)(a.in[5] + c), sh = *(const f32x4*)(mod + b * 6144 + c), sc = *(const f32x4*)(mod + b * 6144 + 1024 + c);
            f32x4 y;
#pragma unroll
            for (int e = 0; e < 4; ++e) y[e] = v[j][e] * r * g[e] * (1.f + sc[e]) + sh[e];
            u32x2 w; w.x = pkh(y[0], y[1]); w.y = pkh(y[2], y[3]); o[64 * j] = w; }
    }
}

__device__ __forceinline__ void p3_rows(const Args& a, int vcu, int G, int wave, int lane) {
    const int gw = vcu * NWAVES + wave, NGW = G * NWAVES;
    unsigned char* ws = a.ws;
    const f16* PROJ = (const f16*)(ws + WS_PROJ);
    f16* CQ = (f16*)(ws + WS_CQ); f16* CKV = (f16*)(ws + WS_CKV); f16* IK16 = (f16*)(ws + WS_IK16); float* IW = (float*)(ws + WS_IW);
    for (int m = gw; m < MTOK; m += NGW) {
        const f16* pr = PROJ + (size_t)m * IN_PAD;
        const f16x4 q = *(const f16x4*)(pr + C_CQ + 4 * lane);
        const f16x2 kv = *(const f16x2*)(pr + C_CKV + 2 * lane);
        const float ik = (float)pr[C_IK + lane];
        float q0 = (float)q[0], q1 = (float)q[1], q2 = (float)q[2], q3 = (float)q[3], k0 = (float)kv[0], k1 = (float)kv[1];
        const float rq = rsqrtf(wave_sum(q0 * q0 + q1 * q1 + q2 * q2 + q3 * q3) * (1.f / QL) + NORM_EPS);
        const float rk = rsqrtf(wave_sum(k0 * k0 + k1 * k1) * (1.f / KVL) + NORM_EPS);
        const float ri = rsqrtf(wave_sum(ik * ik) * (1.f / IDXD) + NORM_EPS);
        const f32x4 gq = *(const f32x4*)(a.in[10] + 4 * lane); const f32x2 gk = *(const f32x2*)(a.in[13] + 2 * lane); const float gi = a.in[14][lane];
        u32x2 w; w.x = pkh(q0 * rq * gq[0], q1 * rq * gq[1]); w.y = pkh(q2 * rq * gq[2], q3 * rq * gq[3]);
        *(u32x2*)(CQ + (size_t)m * QL + 4 * lane) = w;
        *(unsigned*)(CKV + (size_t)m * KVL + 2 * lane) = pkh(k0 * rk * gk[0], k1 * rk * gk[1]);
        const float ikn = ik * ri * gi;
        IK16[(size_t)m * IDXD + lane] = (f16)ikn;
        if (lane < 8) IW[(size_t)m * 8 + lane] = (float)pr[C_IW + lane] * 0.04419417382415922f;
    }
}
__device__ __forceinline__ void p3_rwkv_prep(const Args& a, LAS unsigned char* lds, int vcu, int G, int tid) {
    unsigned char* ws = a.ws;
    const f16* PROJ = (const f16*)(ws + WS_PROJ);
    f16* RWW = (f16*)(ws + WS_RWW); f16* RWA = (f16*)(ws + WS_RWA); f16* RWG = (f16*)(ws + WS_RWG);
    LAS float* xs = (LAS float*)lds;
    const float* mu = a.in[17];
    const int ch = tid;
    const float w0 = a.in[18][ch], a0 = a.in[20][ch];
    for (int u = vcu; u < MTOK / 16; u += G) {
        const int m0 = u * 16;
        __syncthreads();
        for (int e = tid; e < 16 * 288; e += 512) {
            const int t = e / 288, col = e % 288, m = m0 + t;
            const float cur = (float)PROJ[(size_t)m * IN_PAD + C_WD + col];
            const float prev = ((m & (SEQ - 1)) != 0) ? (float)PROJ[(size_t)(m - 1) * IN_PAD + C_WD + col] : 0.f;
            float v = cur + mu[1536 + col] * (prev - cur);
            if (col < 64) v = tanhf(v); else if (col >= 128) v = sigmoidf_(v);
            xs[t * 288 + col] = v;
        }
        __syncthreads();
        float dl[16], al[16], gl[16];
#pragma unroll
        for (int t = 0; t < 16; ++t) { dl[t] = 0.f; al[t] = 0.f; gl[t] = 0.f; }
        for (int kk = 0; kk < 64; ++kk) {
            const float wd = a.in[19][kk * 512 + ch], wa = a.in[21][kk * 512 + ch];
#pragma unroll
            for (int t = 0; t < 16; ++t) { dl[t] += xs[t * 288 + kk] * wd; al[t] += xs[t * 288 + 64 + kk] * wa; }
        }
        for (int kk = 0; kk < 160; ++kk) {
            const float wg = a.in[22][kk * 512 + ch];
#pragma unroll
            for (int t = 0; t < 16; ++t) gl[t] += xs[t * 288 + 128 + kk] * wg;
        }
#pragma unroll
        for (int t = 0; t < 16; ++t) {
            const float z = -(w0 + dl[t]);
            const float sp = z > 20.f ? z : log1pf(__expf(z));
            const float wlog = -sp - 0.5f;
            const float lw = -__expf(wlog);
            const float av = sigmoidf_(a0 + al[t]);
            const size_t o = (size_t)(m0 + t) * RW + ch;
            RWW[o] = (f16)lw; RWA[o] = (f16)av; RWG[o] = (f16)gl[t];
        }
    }
}

__device__ __forceinline__ unsigned f2key(float f) { const unsigned u = __builtin_bit_cast(unsigned, f); return (u & 0x80000000u) ? ~u : (u | 0x80000000u); }
__device__ __forceinline__ void p5_indexer(const Args& a, LAS unsigned char* lds, int vcu, int G, int wave, int lane) {
    unsigned char* ws = a.ws;
    const f16* QI = (const f16*)a.out;
    const float* IK32 = (const float*)(ws + WS_IK32); const float* IW = (const float*)(ws + WS_IW);
    unsigned short* SEL = (unsigned short*)(ws + WS_SEL);
    LAS float* sc = (LAS float*)(lds + wave * 16384);
    LAS float* iq = (LAS float*)(lds + AUX_OFF + wave * 2048);
    const int gw = vcu * NWAVES + wave, NGW = G * NWAVES;
    for (int q = gw; q < MTOK; q += NGW) {
        const int b = q >> 12, t = q & (SEQ - 1);
        unsigned short* sel = SEL + (size_t)q * TOPK;
        if (t < TOPK) {
#pragma unroll
            for (int j = 0; j < 4; ++j) { const int s = lane + 64 * j; sel[s] = (s <= t) ? (unsigned short)s : (unsigned short)0xFFFF; }
            continue;
        }
        { const f16x8 v = *(const f16x8*)(QI + (size_t)q * NQI + 1024 + 8 * lane);
#pragma unroll
          for (int e = 0; e < 8; ++e) iq[8 * lane + e] = (float)v[e]; }
        float wq[8];
#pragma unroll
        for (int h = 0; h < 8; ++h) wq[h] = IW[(size_t)q * 8 + h];
        asm volatile("s_waitcnt lgkmcnt(0)" ::: "memory");
        const int nj = (t >> 6) + 1;
        for (int j = 0; j < nj; ++j) {
            const int s = j * 64 + lane;
            const float* kr = IK32 + ((size_t)(b << 12) + (s <= t ? s : t)) * IDXD;
            float kx[64];
#pragma unroll
            for (int d4 = 0; d4 < 16; ++d4) { const f32x4 v = *(const f32x4*)(kr + 4 * d4); kx[4 * d4] = v[0]; kx[4 * d4 + 1] = v[1]; kx[4 * d4 + 2] = v[2]; kx[4 * d4 + 3] = v[3]; }
            float score = 0.f;
#pragma unroll
            for (int h = 0; h < 8; ++h) { float d0 = 0.f;
#pragma unroll
                for (int d4 = 0; d4 < 16; ++d4) { const f32x4 qv = *(const LAS f32x4*)(iq + h * 64 + 4 * d4); d0 += qv[0] * kx[4 * d4]; d0 += qv[1] * kx[4 * d4 + 1]; d0 += qv[2] * kx[4 * d4 + 2]; d0 += qv[3] * kx[4 * d4 + 3]; }
                score += wq[h] * fmaxf(d0, 0.f); }
            sc[s] = (s <= t) ? score : -INFINITY;
        }
        asm volatile("s_waitcnt lgkmcnt(0)" ::: "memory");
        const int nvalid = nj * 64;
        unsigned key[64];
#pragma unroll
        for (int j = 0; j < 64; ++j) { const int s = lane * 64 + j; key[j] = (s < nvalid) ? f2key(sc[s]) : 0u; }
        unsigned prefix = 0u;
        for (int bit = 31; bit >= 0; --bit) {
            const unsigned cand = prefix | (1u << bit);
            int c = 0;
#pragma unroll
            for (int j = 0; j < 64; ++j) c += (key[j] >= cand) ? 1 : 0;
#pragma unroll
            for (int o = 1; o < 64; o <<= 1) c += __shfl_xor(c, o);
            if (c >= TOPK) prefix = cand;
        }
        int cgt = 0, ceq = 0;
#pragma unroll
        for (int j = 0; j < 64; ++j) { cgt += (key[j] > prefix) ? 1 : 0; ceq += (key[j] == prefix) ? 1 : 0; }
        int sgt = cgt, seq = ceq;
#pragma unroll
        for (int o = 1; o < 64; o <<= 1) { const int x = __shfl_up(sgt, o), y = __shfl_up(seq, o); if (lane >= o) { sgt += x; seq += y; } }
        const int tot_gt = __shfl(sgt, 63);
        int pos_gt = sgt - cgt, rank_eq = seq - ceq;
        const int need = TOPK - tot_gt;
#pragma unroll
        for (int j = 0; j < 64; ++j) {
            const int s = lane * 64 + j;
            if (key[j] > prefix) { sel[pos_gt] = (unsigned short)s; ++pos_gt; }
            else if (key[j] == prefix) { if (rank_eq < need) sel[tot_gt + rank_eq] = (unsigned short)s; ++rank_eq; }
        }
    }
}

__device__ __forceinline__ int t5_bucket(int rel) {
    if (rel < 16) return rel;
    const int l = 16 + (int)(logf((float)rel * (1.f / 16.f)) / 2.0794415416798357f * 16.f);
    return l < 31 ? l : 31;
}
__device__ __forceinline__ void p6_attention(const Args& a, LAS unsigned char* lds, int vcu, int G, int wave, int lane) {
    unsigned char* ws = a.ws;
    const f16* QI = (const f16*)a.out; const f16* CKV = (const f16*)(ws + WS_CKV);
    const unsigned short* SEL = (const unsigned short*)(ws + WS_SEL);
    f16* OATT = (f16*)(ws + WS_OATT);
    const float* rel_bias = a.in[2];
    LAS float* qa = (LAS float*)(lds + wave * 16384);
    LAS float* pp = (LAS float*)(lds + wave * 16384 + 4096);
    LAS int* sidx = (LAS int*)(lds + wave * 16384 + 12288);
    const int gw = vcu * NWAVES + wave, NGW = G * NWAVES;
    for (int q = gw; q < MTOK; q += NGW) {
        const int b = q >> 12, t = q & (SEQ - 1);
#pragma unroll
        for (int i = 0; i < 2; ++i) { const f16x8 v = *(const f16x8*)(QI + (size_t)q * NQI + 512 * i + 8 * lane);
#pragma unroll
            for (int e = 0; e < 8; ++e) qa[512 * i + 8 * lane + e] = (float)v[e]; }
        asm volatile("s_waitcnt lgkmcnt(0)" ::: "memory");
        float lg[4][8];
        int srow[4]; bool okv[4];
#pragma unroll
        for (int i = 0; i < 4; ++i) {
            const int sraw = SEL[(size_t)q * TOPK + lane + 64 * i];
            okv[i] = sraw != 0xFFFF && sraw <= t;
            srow[i] = okv[i] ? sraw : 0;
            sidx[lane + 64 * i] = okv[i] ? sraw : -1;
#pragma unroll
            for (int h = 0; h < 8; ++h) lg[i][h] = 0.f;
        }
#pragma unroll 1
        for (int c8 = 0; c8 < 16; ++c8) {
            f16x8 kv[4];
#pragma unroll
            for (int i = 0; i < 4; ++i) kv[i] = *(const f16x8*)(CKV + ((size_t)(b << 12) + srow[i]) * KVL + 8 * c8);
#pragma unroll
            for (int h = 0; h < 8; ++h) {
                const f32x4 q0 = *(const LAS f32x4*)(qa + h * 128 + 8 * c8), q1 = *(const LAS f32x4*)(qa + h * 128 + 8 * c8 + 4);
#pragma unroll
                for (int i = 0; i < 4; ++i)
                    lg[i][h] += q0[0] * (float)kv[i][0] + q0[1] * (float)kv[i][1] + q0[2] * (float)kv[i][2] + q0[3] * (float)kv[i][3] + q1[0] * (float)kv[i][4] + q1[1] * (float)kv[i][5] + q1[2] * (float)kv[i][6] + q1[3] * (float)kv[i][7];
            }
        }
#pragma unroll
        for (int i = 0; i < 4; ++i) {
            const int bk = t5_bucket(t - srow[i]);
#pragma unroll
            for (int h = 0; h < 8; ++h) lg[i][h] = okv[i] ? lg[i][h] + rel_bias[bk * 8 + h] : -INFINITY;
        }
#pragma unroll
        for (int h = 0; h < 8; ++h) {
            float mx = fmaxf(fmaxf(lg[0][h], lg[1][h]), fmaxf(lg[2][h], lg[3][h]));
#pragma unroll
            for (int o = 1; o < 64; o <<= 1) mx = fmaxf(mx, __shfl_xor(mx, o));
            float e[4], s = 0.f;
#pragma unroll
            for (int i = 0; i < 4; ++i) { e[i] = __expf(lg[i][h] - mx); s += e[i]; }
            s = wave_sum(s);
            const float inv = 1.f / s;
#pragma unroll
            for (int i = 0; i < 4; ++i) pp[h * 256 + lane + 64 * i] = e[i] * inv;
        }
        asm volatile("s_waitcnt lgkmcnt(0)" ::: "memory");
        float o0[8], o1[8];
#pragma unroll
        for (int h = 0; h < 8; ++h) { o0[h] = 0.f; o1[h] = 0.f; }
        for (int kk = 0; kk < TOPK; ++kk) {
            const int s = sidx[kk];
            if (s < 0) continue;
            const f16x2 kv = *(const f16x2*)(CKV + ((size_t)(b << 12) + s) * KVL + 2 * lane);
            const float v0 = (float)kv[0], v1 = (float)kv[1];
#pragma unroll
            for (int h = 0; h < 8; ++h) { const float p = pp[h * 256 + kk]; o0[h] += p * v0; o1[h] += p * v1; }
        }
#pragma unroll
        for (int h = 0; h < 8; ++h) *(unsigned*)(OATT + (size_t)q * KOUT + h * 128 + 2 * lane) = pkh(o0[h], o1[h]);
        asm volatile("s_waitcnt lgkmcnt(0)" ::: "memory");
    }
}

constexpr int SC_PITCH = 8224, DSA_SEL_OFF = 16 * SC_PITCH, DSA_BL_OFF = DSA_SEL_OFF + 8192, DSA_HIST_OFF = 143936;
static_assert(DSA_BL_OFF + 129 * 8 * 4 <= DSA_HIST_OFF && DSA_HIST_OFF + 8 * 1280 <= MISC_OFF, "DSA LDS map");
typedef short v4i16_t __attribute__((ext_vector_type(4)));
__device__ __forceinline__ unsigned kv_off(unsigned row, unsigned ch) { return 256u * row + 16u * (ch ^ (((row & 3u) << 2) | ((row >> 2) & 3u))); }
__device__ __forceinline__ f16x4 tr_read16(LAS unsigned char* p) { return __builtin_bit_cast(f16x4, __builtin_amdgcn_ds_read_tr16_b64_v4i16((LAS v4i16_t*)p)); }
template <int CTRL, int RMASK> __device__ __forceinline__ int dpp_i(int x) { return __builtin_amdgcn_update_dpp(0, x, CTRL, RMASK, 0xF, false); }
template <int CTRL> __device__ __forceinline__ int dpp_iz(int x) { return __builtin_amdgcn_update_dpp(0, x, CTRL, 0xF, 0xF, true); }
__device__ __forceinline__ int wave_incl_scan_i(int x) { x += dpp_iz<0x111>(x); x += dpp_iz<0x112>(x); x += dpp_iz<0x114>(x); x += dpp_iz<0x118>(x);
    x += dpp_i<0x142, 0xA>(x); x += dpp_i<0x143, 0xC>(x); return x; }
__device__ __forceinline__ void p5_dsa(const Args& a, LAS unsigned char* lds, int G, int bx, int tid, int wave, int lane) {
    unsigned char* ws = a.ws;
    const f16* QI = (const f16*)a.out; const f16* IK16 = (const f16*)(ws + WS_IK16); const float* IW = (const float*)(ws + WS_IW);
    const f16* CKV = (const f16*)(ws + WS_CKV); f16* OATT = (f16*)(ws + WS_OATT);
    LAS unsigned short* SELL = (LAS unsigned short*)(lds + DSA_SEL_OFF);
    LAS float* BL = (LAS float*)(lds + DSA_BL_OFF);
    for (int e = tid; e < 129 * 8; e += 512) { const int rel = e >> 3, h = e & 7; BL[e] = a.in[2][t5_bucket(rel) * 8 + h]; }
    const int nunits = BATCH * (SEQ / 16);
    const bool balanced = (G == 256);
    const int niter = balanced ? 8 : (nunits + G - 1) / G;
#pragma unroll 1
    for (int it = 0; it < niter; ++it) {
        int b, tile;
        if (balanced) { b = bx & 7; const int r = bx >> 3, base = 64 * (it >> 1); tile = (it & 1) ? base + 63 - r : base + r; }
        else { const int u = it * G + bx; if (u >= nunits) break; b = u >> 8; tile = u & 255; }
        int lane_o = lane; asm volatile("" : "+v"(lane_o));
        const int r16 = lane_o & 15, g = lane_o >> 4;
        const int t0 = tile * 16;
        const size_t qb = (size_t)(b << 12);
        const int jn = ((t0 + 15) >> 7) + 1;
        lds_barrier();
#ifndef DSAREP
#define DSAREP 0
#endif
#ifndef DSA_NO_A
        for (int ra_ = 0; ra_ < ((DSAREP & 1) ? 2 : 1); ++ra_)
        if (t0 + 15 >= TOPK) {
            f16x8 afr[8][2]; f32x4 wv[4][2];
#pragma unroll
            for (int mt = 0; mt < 8; ++mt) { const int tg = mt >> 1, hf = mt & 1, t = t0 + 4 * tg + (r16 >> 2), h = 4 * hf + (r16 & 3);
#pragma unroll
                for (int ks = 0; ks < 2; ++ks) afr[mt][ks] = *(const f16x8*)(QI + (qb + t) * NQI + 1024 + h * 64 + 32 * ks + 8 * g); }
#pragma unroll
            for (int tg = 0; tg < 4; ++tg)
#pragma unroll
                for (int hf = 0; hf < 2; ++hf) wv[tg][hf] = *(const f32x4*)(IW + (qb + t0 + 4 * tg + g) * 8 + 4 * hf);
            f16x8 bn0[2], bn1[2], bn2[2];
            const f16* ikp = IK16 + (qb + 16 * wave + r16) * IDXD + 8 * g;
#pragma unroll
            for (int ks = 0; ks < 2; ++ks) { bn0[ks] = *(const f16x8*)(ikp + 32 * ks); bn1[ks] = bn0[ks]; bn2[ks] = bn0[ks];
                if (jn > 1) bn1[ks] = *(const f16x8*)(ikp + 128 * IDXD + 32 * ks);
                if (jn > 2) bn2[ks] = *(const f16x8*)(ikp + 256 * IDXD + 32 * ks); }
            for (int j = 0; j < jn; ++j) {
                const int s = 128 * j + 16 * wave + r16;
                f16x8 bfr[2]; bfr[0] = bn0[0]; bfr[1] = bn0[1];
                bn0[0] = bn1[0]; bn0[1] = bn1[1]; bn1[0] = bn2[0]; bn1[1] = bn2[1];
                if (j + 3 < jn) {
#pragma unroll
                    for (int ks = 0; ks < 2; ++ks) bn2[ks] = *(const f16x8*)(ikp + (size_t)(128 * (j + 3)) * IDXD + 32 * ks); }
                f32x4 acc[8];
#pragma unroll
                for (int mt = 0; mt < 8; ++mt) { acc[mt] = __builtin_amdgcn_mfma_f32_16x16x32_f16(afr[mt][0], bfr[0], (f32x4){0.f, 0.f, 0.f, 0.f}, 0, 0, 0);
                    acc[mt] = __builtin_amdgcn_mfma_f32_16x16x32_f16(afr[mt][1], bfr[1], acc[mt], 0, 0, 0); }
#pragma unroll
                for (int tg = 0; tg < 4; ++tg) { float sc = 0.f;
#pragma unroll
                    for (int hf = 0; hf < 2; ++hf)
#pragma unroll
                        for (int e = 0; e < 4; ++e) sc += wv[tg][hf][e] * fmaxf(acc[2 * tg + hf][e], 0.f);
                    const int tl = 4 * tg + g;
                    if (s > t0 + tl) sc = -INFINITY;
                    *(LAS f16*)(lds + tl * SC_PITCH + s * 2) = (f16)sc; }
            }
        }
#endif
        __builtin_amdgcn_sched_barrier(0); lds_barrier(); __builtin_amdgcn_sched_barrier(0);
#ifndef DSA_NO_C
#pragma unroll 1
        for (int rr = 0; rr < ((DSAREP & 2) ? 4 : 2); ++rr) {
            const int rl = 2 * wave + (rr & 1), t = t0 + rl;
            LAS unsigned short* sel = SELL + rl * 256;
            if (t < TOPK) {
#pragma unroll
                for (int k = 0; k < 4; ++k) { const int jx = lane_o + 64 * k; sel[jx] = (jx <= t) ? (unsigned short)jx : (unsigned short)0xFFFF; }
                continue;
            }
            const LAS unsigned* srow = (const LAS unsigned*)(lds + rl * SC_PITCH) + lane_o;
#define DSA_KEY(jj_) ({ const unsigned x_ = srow[(jj_) * 64]; x_ ^ ((((x_ >> 15) & 0x00010001u) * 0x7FFFu) | 0x80008000u); })
            LAS unsigned* hist = (LAS unsigned*)(lds + DSA_HIST_OFF + wave * 1280);
            unsigned prefix = 0u; int kneed = TOPK;
#pragma unroll 1
            for (int pass = 0; pass < 2; ++pass) {
                *(LAS u32x4*)(hist + 4 * lane_o) = (u32x4){0u, 0u, 0u, 0u};
                asm volatile("s_waitcnt lgkmcnt(0)" ::: "memory");
                if (pass == 0) {
#pragma unroll 4
                    for (int jj = 0; jj < jn; ++jj) { const unsigned k = DSA_KEY(jj);
                        __hip_atomic_fetch_add(hist + (k >> 24), 1u, __ATOMIC_RELAXED, __HIP_MEMORY_SCOPE_WORKGROUP);
                        __hip_atomic_fetch_add(hist + ((k >> 8) & 0xFFu), 1u, __ATOMIC_RELAXED, __HIP_MEMORY_SCOPE_WORKGROUP); }
                } else {
#pragma unroll 4
                    for (int jj = 0; jj < jn; ++jj) { const unsigned k = DSA_KEY(jj);
                        const unsigned dump = 256u + (unsigned)lane_o;
                        __hip_atomic_fetch_add(hist + (((k >> 24) == prefix) ? ((k >> 16) & 0xFFu) : dump), 1u, __ATOMIC_RELAXED, __HIP_MEMORY_SCOPE_WORKGROUP);
                        __hip_atomic_fetch_add(hist + ((((k >> 8) & 0xFFu) == prefix) ? (k & 0xFFu) : dump), 1u, __ATOMIC_RELAXED, __HIP_MEMORY_SCOPE_WORKGROUP); }
                }
                asm volatile("s_waitcnt lgkmcnt(0)" ::: "memory");
                const u32x4 hv = *(const LAS u32x4*)(hist + 4 * lane_o);
                const int sl = (int)(hv.x + hv.y + hv.z + hv.w);
                const int pre = wave_incl_scan_i(sl);
                const int tot = __builtin_amdgcn_readlane(pre, 63);
                const int S = tot - pre + sl;
                const int excl = S - sl;
                const unsigned long long bm = __ballot(excl < kneed && S >= kneed);
                const int L = bm ? (int)__builtin_ctzll(bm) : 0;
                const int ex = __builtin_amdgcn_readlane(excl, L); const int h1 = __builtin_amdgcn_readlane((int)hv.y, L), h2 = __builtin_amdgcn_readlane((int)hv.z, L), h3 = __builtin_amdgcn_readlane((int)hv.w, L);
                int cabove = ex, bin;
                if (cabove + h3 >= kneed) bin = 3; else { cabove += h3;
                    if (cabove + h2 >= kneed) bin = 2; else { cabove += h2;
                        if (cabove + h1 >= kneed) bin = 1; else { cabove += h1; bin = 0; } } }
                prefix = (prefix << 8) | (unsigned)(4 * L + bin); kneed -= cabove;
            }
            const unsigned lo = prefix << 16, hi = (prefix + 1u) << 16;
            int cgt = 0, ceq = 0;
#pragma unroll 4
            for (int jj = 0; jj < jn; ++jj) { const unsigned k = DSA_KEY(jj); const unsigned kb = k << 16; cgt += (k >= hi) + (kb >= hi); ceq += (k >= lo) + (kb >= lo); }
            ceq -= cgt;
            const int sgt = wave_incl_scan_i(cgt), seq = wave_incl_scan_i(ceq);
            const int tot_gt = __builtin_amdgcn_readlane(sgt, 63);
            int pgt = sgt - cgt, peq = seq - ceq;
            const int need = TOPK - tot_gt;
            LAS unsigned short* dumpp = (LAS unsigned short*)(hist + 256) + lane_o;
#pragma unroll 4
            for (int jj = 0; jj < jn; ++jj) { const unsigned k = DSA_KEY(jj);
                const int s0 = 2 * (jj * 64 + lane_o); const unsigned kb = k << 16;
                { const bool gt = kb >= hi, eq = (kb >= lo) && !gt; LAS unsigned short* d = gt ? sel + pgt : ((eq && peq < need) ? sel + tot_gt + peq : dumpp); *d = (unsigned short)s0; pgt += gt ? 1 : 0; peq += eq ? 1 : 0; }
                { const bool gt = k >= hi, eq = (k >= lo) && !gt; LAS unsigned short* d = gt ? sel + pgt : ((eq && peq < need) ? sel + tot_gt + peq : dumpp); *d = (unsigned short)(s0 + 1); pgt += gt ? 1 : 0; peq += eq ? 1 : 0; }
            }
#undef DSA_KEY
        }
#endif
        __builtin_amdgcn_sched_barrier(0); lds_barrier(); __builtin_amdgcn_sched_barrier(0);
#ifndef DSA_NO_D
        LAS unsigned char* kvb = lds + wave * 16384;
#pragma unroll 1
        for (int rr = 0; rr < ((DSAREP & 4) ? 4 : 2); ++rr) {
            const int rl = 2 * wave + (rr & 1), t = t0 + rl; const size_t q = qb + t;
            const LAS unsigned short* sel = SELL + rl * 256;
            f16x8 qfr[4];
#pragma unroll
            for (int ks = 0; ks < 4; ++ks) { f16x8 v = *(const f16x8*)(QI + q * NQI + (r16 & 7) * 128 + 32 * ks + 8 * g); if (r16 >= 8) v = (f16x8){0, 0, 0, 0, 0, 0, 0, 0}; qfr[ks] = v; }
            float m_run = -1e30f, l_run = 0.f;
            f32x4 oacc[8];
#pragma unroll
            for (int ct = 0; ct < 8; ++ct) oacc[ct] = (f32x4){0.f, 0.f, 0.f, 0.f};
            const int nch = (t < TOPK) ? (t >> 5) + 1 : 8;
            const int lrow = 8 * ((r16 >> 2) & 1) + 4 * (r16 >> 3) + (r16 & 3);
#define DSA_DMA(ch_, buf_) do { _Pragma("unroll") for (int i = 0; i < 8; ++i) { const int R = 4 * i + g; const int rr16 = R & 15; \
                const int key = 32 * (ch_) + 16 * (R >> 4) + 8 * ((rr16 >> 2) & 1) + 4 * (rr16 >> 3) + (rr16 & 3); \
                const unsigned ix = sel[key]; const int srow = (ix == 0xFFFFu) ? 0 : (int)ix; \
                const unsigned lch = (unsigned)r16 ^ ((((unsigned)R & 3u) << 2) | (((unsigned)R >> 2) & 3u)); \
                __builtin_amdgcn_global_load_lds((const unsigned*)(CKV + (qb + srow) * KVL + 8 * lch), (LAS unsigned*)(kvb + (buf_) * 8192 + i * 1024), 16, 0, 0); } } while (0)
            asm volatile("s_waitcnt vmcnt(0)" ::: "memory");
            DSA_DMA(0, 0);
#pragma unroll 1
            for (int ch = 0; ch < nch; ++ch) {
                LAS unsigned char* kb = kvb + (ch & 1) * 8192;
                if (ch + 1 < nch) { DSA_DMA(ch + 1, (ch + 1) & 1); asm volatile("s_waitcnt vmcnt(8)" ::: "memory"); }
                else asm volatile("s_waitcnt vmcnt(0)" ::: "memory");
                f32x4 lg[2];
#pragma unroll
                for (int mt = 0; mt < 2; ++mt) { lg[mt] = (f32x4){0.f, 0.f, 0.f, 0.f};
#pragma unroll
                    for (int ks = 0; ks < 4; ++ks) lg[mt] = __builtin_amdgcn_mfma_f32_16x16x32_f16(*(const LAS f16x8*)(kb + kv_off(16 * mt + lrow, 4 * ks + g)), qfr[ks], lg[mt], 0, 0, 0); }
                float cmax = -INFINITY;
#pragma unroll
                for (int mt = 0; mt < 2; ++mt) { const u32x2 pk = *(const LAS u32x2*)(sel + 32 * ch + 16 * mt + 4 * g);
#pragma unroll
                    for (int e = 0; e < 4; ++e) { const unsigned ix = ((e & 2) ? pk.y : pk.x) >> ((e & 1) * 16) & 0xFFFFu;
                        const int rel = t - (int)ix; const int rc = rel < 128 ? rel : 128;
                        const float v = (ix == 0xFFFFu) ? -INFINITY : lg[mt][e] + BL[(rc < 0 ? 0 : rc) * 8 + (r16 & 7)];
                        lg[mt][e] = v; cmax = fmaxf(cmax, v); } }
                cmax = fmaxf(cmax, __shfl_xor(cmax, 16)); cmax = fmaxf(cmax, __shfl_xor(cmax, 32));
                const float m_new = fmaxf(m_run, cmax); const float alpha = __expf(m_run - m_new); m_run = m_new;
                float ps = 0.f; f16x8 pfr;
#pragma unroll
                for (int mt = 0; mt < 2; ++mt)
#pragma unroll
                    for (int e = 0; e < 4; ++e) { const float p = __expf(lg[mt][e] - m_new); ps += p; pfr[mt * 4 + e] = (f16)p; }
                l_run = l_run * alpha + ps;
#pragma unroll
                for (int ct = 0; ct < 8; ++ct) oacc[ct] *= alpha;
                const int qq = (lane_o & 15) >> 2, pp = lane_o & 3;
                const unsigned rbase = 8 * (g & 1) + 4 * (g >> 1) + qq;
#pragma unroll
                for (int ct = 0; ct < 8; ++ct) {
                    const f16x4 v0 = tr_read16(kb + kv_off(rbase, 2 * ct + (pp >> 1)) + 8 * (pp & 1));
                    const f16x4 v1 = tr_read16(kb + kv_off(rbase + 16, 2 * ct + (pp >> 1)) + 8 * (pp & 1));
                    const f16x8 av = {v0[0], v0[1], v0[2], v0[3], v1[0], v1[1], v1[2], v1[3]};
                    oacc[ct] = __builtin_amdgcn_mfma_f32_16x16x32_f16(av, pfr, oacc[ct], 0, 0, 0);
                }
                asm volatile("s_waitcnt lgkmcnt(0)" ::: "memory");
            }
#undef DSA_DMA
            l_run += __shfl_xor(l_run, 16); l_run += __shfl_xor(l_run, 32);
            const float inv = 1.f / l_run;
            if (r16 < 8) {
#pragma unroll
                for (int ct = 0; ct < 8; ++ct) { u32x2 w; w.x = pkh(oacc[ct][0] * inv, oacc[ct][1] * inv); w.y = pkh(oacc[ct][2] * inv, oacc[ct][3] * inv);
                    *(u32x2*)(OATT + q * KOUT + r16 * 128 + 16 * ct + 4 * g) = w; }
            }
        }
#endif
    }
}

template <int CTRL> __device__ __forceinline__ float dpp_f(float x) { return __builtin_bit_cast(float, __builtin_amdgcn_update_dpp(0, __builtin_bit_cast(int, x), CTRL, 0xF, 0xF, false)); }
__device__ __forceinline__ float row16_sum(float x) { x += dpp_f<0x128>(x); x += dpp_f<0x124>(x); x += dpp_f<0x122>(x); x += dpp_f<0x121>(x); return x; }
constexpr int SCAN_TB = 32;
__device__ __forceinline__ void p7_scan(const Args& a, LAS unsigned char* lds, int vcu, int G, int wave, int lane) {
    unsigned char* ws = a.ws;
    const f16* PROJ = (const f16*)(ws + WS_PROJ); const f16* RWW = (const f16*)(ws + WS_RWW); const f16* RWA = (const f16*)(ws + WS_RWA);
    float* YRAW = (float*)(ws + WS_YRAW);
    for (int u = vcu; u < BATCH * HRW * 2; u += G) {
        const int half = u & 1, h = (u >> 1) & 7, b = u >> 4;
        const int ch = h * 64 + lane;
        const float mu_r = a.in[17][ch], mu_k = a.in[17][512 + ch], mu_v = a.in[17][1024 + ch], kkc = a.in[23][ch], kac = a.in[24][ch];
        const int rr = lane >> 4, qd = lane & 15, irow = half * 32 + wave * 4 + rr;
        float S0 = 0.f, S1 = 0.f, S2 = 0.f, S3 = 0.f;
#define SCAN_LOAD(blk_) do { _Pragma("unroll") for (int tt = 0; tt < 4; ++tt) { const int t = (blk_) * SCAN_TB + wave * 4 + tt; const size_t m = (size_t)(b << 12) + t; \
            const f16* pr = PROJ + m * IN_PAD + h * 64 + lane; \
            st_r[tt] = (float)pr[C_R]; st_k[tt] = (float)pr[C_K]; st_v[tt] = (float)pr[C_V]; \
            if (t > 0) { st_rp[tt] = (float)pr[C_R - IN_PAD]; st_kp[tt] = (float)pr[C_K - IN_PAD]; st_vp[tt] = (float)pr[C_V - IN_PAD]; } else { st_rp[tt] = 0.f; st_kp[tt] = 0.f; st_vp[tt] = 0.f; } \
            st_lw[tt] = (float)RWW[m * RW + ch]; st_av[tt] = (float)RWA[m * RW + ch]; } } while (0)
#define SCAN_WRITE(buf_) do { LAS float* base_ = (LAS float*)(lds + (buf_) * 49152); _Pragma("unroll") for (int tt = 0; tt < 4; ++tt) { const int tl = wave * 4 + tt; \
            const float rs = st_r[tt] + mu_r * (st_rp[tt] - st_r[tt]), ks = st_k[tt] + mu_k * (st_kp[tt] - st_k[tt]), vs = st_v[tt] + mu_v * (st_vp[tt] - st_v[tt]); \
            const float kkv = ks * kkc; const float nrm = sqrtf(wave_sum(kkv * kkv)); const float kkn = kkv / fmaxf(nrm, 1e-12f); \
            const float av = st_av[tt]; const float km = ks * (1.f + (av - 1.f) * kac); \
            base_[0 * 2048 + tl * 64 + lane] = rs; base_[1 * 2048 + tl * 64 + lane] = __expf(st_lw[tt]); base_[2 * 2048 + tl * 64 + lane] = km; \
            base_[3 * 2048 + tl * 64 + lane] = vs; base_[4 * 2048 + tl * 64 + lane] = -kkn; base_[5 * 2048 + tl * 64 + lane] = kkn * av; } } while (0)
        float st_r[4], st_k[4], st_v[4], st_rp[4], st_kp[4], st_vp[4], st_lw[4], st_av[4];
        __syncthreads();
        SCAN_LOAD(0); SCAN_WRITE(0);
        constexpr int NBLK = SEQ / SCAN_TB;
        for (int blk = 0; blk < NBLK; ++blk) {
            __syncthreads();
            if (blk + 1 < NBLK) SCAN_LOAD(blk + 1);
            const LAS float* base = (const LAS float*)(lds + (blk & 1) * 49152);
            for (int tl = 0; tl < SCAN_TB; ++tl) {
                const f32x4 r4 = *(const LAS f32x4*)(base + 0 * 2048 + tl * 64 + 4 * qd), w4 = *(const LAS f32x4*)(base + 1 * 2048 + tl * 64 + 4 * qd), k4 = *(const LAS f32x4*)(base + 2 * 2048 + tl * 64 + 4 * qd);
                const f32x4 a4 = *(const LAS f32x4*)(base + 4 * 2048 + tl * 64 + 4 * qd), b4 = *(const LAS f32x4*)(base + 5 * 2048 + tl * 64 + 4 * qd);
                const float vi = base[3 * 2048 + tl * 64 + irow];
                float sa = S0 * a4[0] + S1 * a4[1] + S2 * a4[2] + S3 * a4[3];
                sa = row16_sum(sa);
                S0 = S0 * w4[0] + sa * b4[0] + vi * k4[0]; S1 = S1 * w4[1] + sa * b4[1] + vi * k4[1]; S2 = S2 * w4[2] + sa * b4[2] + vi * k4[2]; S3 = S3 * w4[3] + sa * b4[3] + vi * k4[3];
                float y = S0 * r4[0] + S1 * r4[1] + S2 * r4[2] + S3 * r4[3];
                y = row16_sum(y);
                if (qd == 0) YRAW[((size_t)(b << 12) + blk * SCAN_TB + tl) * RW + h * 64 + irow] = y;
            }
            if (blk + 1 < NBLK) SCAN_WRITE((blk + 1) & 1);
        }
        __syncthreads();
    }
}

__device__ __forceinline__ void p8_rwkv_post(const Args& a, int vcu, int G, int wave, int lane) {
    unsigned char* ws = a.ws;
    const f16* PROJ = (const f16*)(ws + WS_PROJ); const f16* RWA = (const f16*)(ws + WS_RWA); const f16* RWG = (const f16*)(ws + WS_RWG);
    const float* YRAW = (const float*)(ws + WS_YRAW); f16* OATT = (f16*)(ws + WS_OATT);
    const int gw = vcu * NWAVES + wave, NGW = G * NWAVES;
    for (int it = gw; it < MTOK * HRW; it += NGW) {
        const int m = it >> 3, h = it & 7, ch = h * 64 + lane, t = m & (SEQ - 1);
        const f16* pr = PROJ + (size_t)m * IN_PAD + ch;
        float r = (float)pr[C_R], k = (float)pr[C_K], v = (float)pr[C_V], rp = 0.f, kp = 0.f, vp = 0.f;
        if (t > 0) { rp = (float)pr[C_R - IN_PAD]; kp = (float)pr[C_K - IN_PAD]; vp = (float)pr[C_V - IN_PAD]; }
        const float rs = r + a.in[17][ch] * (rp - r), ks = k + a.in[17][512 + ch] * (kp - k), vs = v + a.in[17][1024 + ch] * (vp - v);
        const float av = (float)RWA[(size_t)m * RW + ch];
        const float km = ks * (1.f + (av - 1.f) * a.in[24][ch]);
        const float y = YRAW[(size_t)m * RW + ch];
        const float mean = wave_sum(y) * (1.f / 64.f); const float dy = y - mean;
        const float var = wave_sum(dy * dy) * (1.f / 64.f);
        const float yn = dy * rsqrtf(var + GN_EPS) * a.in[26][ch] + a.in[27][ch];
        const float bonus = wave_sum(rs * km * a.in[25][ch]) * vs;
        OATT[(size_t)m * KOUT + 1024 + ch] = (f16)((yn + bonus) * (float)RWG[(size_t)m * RW + ch]);
    }
}

typedef short bf16x8 __attribute__((ext_vector_type(8)));
typedef _Float16 f16x4v __attribute__((ext_vector_type(4)));
__device__ __forceinline__ unsigned f2bf(float f) { unsigned u = __builtin_bit_cast(unsigned, f); return (u + 0x7fffu + ((u >> 16) & 1u)) >> 16; }
__device__ __forceinline__ unsigned pkb(float lo, float hi) { return f2bf(lo) | (f2bf(hi) << 16); }
constexpr int XP = 144;
constexpr int XD_OFF = 0, XA_OFF = 9216, XG_OFF = 18432, XG_P = 336;
constexpr int LAB_OFF = 0, LAK_OFF = 9216, LRB_OFF = 18432, LRK_OFF = 27648;
constexpr int AB_OFF = 39936, RB_OFF = AB_OFF + 9216, BB_OFF = RB_OFF + 9216, KB_OFF = BB_OFF + 9216;
constexpr int TT_OFF = 39936, M1T_OFF = TT_OFF + 9216, A2T_OFF = M1T_OFF + 9216, U1T_OFF = A2T_OFF + 9216;
constexpr int AH_OFF = 76800, VH_OFF = AH_OFF + 9216, BP_OFF = VH_OFF + 9216, KP_OFF = BP_OFF + 9216, RH_OFF = KP_OFF + 9216;
constexpr int NRM_OFF = 122880, CUMB_OFF = NRM_OFF + 512, XCONST_OFF = CUMB_OFF + 1024;
constexpr size_t WS_WDT = 28 * MiB, WS_WAT = WS_WDT + 65536, WS_WGT = WS_WAT + 65536;
constexpr size_t WS_RWP = 32 * MiB, WS_RWQ = 64 * MiB, WS_RWR2 = 408 * MiB, WS_RWY1 = 440 * MiB, WS_RWS0 = 472 * MiB, WS_BON = 364 * MiB;
constexpr int NUNIT = BATCH * 64 * HRW;

__device__ __forceinline__ f16x8 rd_row(LAS unsigned char* base, int pitch, int row, int col) { return *(const LAS f16x8*)(base + row * pitch + col * 2); }
__device__ __forceinline__ bf16x8 rd_rowb(LAS unsigned char* base, int pitch, int row, int col) { return *(const LAS bf16x8*)(base + row * pitch + col * 2); }
__device__ __forceinline__ f16x8 rd_tr(LAS unsigned char* base, int k0, int c0, int g, int qq, int pp) {
    const f16x4 v0 = tr_read16(base + (k0 + 8 * g + qq) * XP + (c0 + 4 * pp) * 2), v1 = tr_read16(base + (k0 + 8 * g + 4 + qq) * XP + (c0 + 4 * pp) * 2);
    return (f16x8){v0[0], v0[1], v0[2], v0[3], v1[0], v1[1], v1[2], v1[3]};
}
__device__ __forceinline__ void wr4h(LAS unsigned char* p, const f32x4& v) { u32x2 w; w.x = pkh(v[0], v[1]); w.y = pkh(v[2], v[3]); *(LAS u32x2*)p = w; }
__device__ __forceinline__ float dpp_shr_f(float x, int) { return x; }
template <int CTRL> __device__ __forceinline__ float dpp_z(float x) { return __builtin_bit_cast(float, __builtin_amdgcn_update_dpp(0, __builtin_bit_cast(int, x), CTRL, 0xF, 0xF, true)); }
__device__ __forceinline__ float row16_incl_scan(float x) { x += dpp_z<0x111>(x); x += dpp_z<0x112>(x); x += dpp_z<0x114>(x); x += dpp_z<0x118>(x); return x; }
#define MFMA_H(a, b, c) __builtin_amdgcn_mfma_f32_16x16x32_f16((a), (b), (c), 0, 0, 0)
#define MFMA_B(a, b, c) __builtin_amdgcn_mfma_f32_16x16x32_bf16((a), (b), (c), 0, 0, 0)
#define MFMA_H16(a, b, c) __builtin_amdgcn_mfma_f32_16x16x16f16((a), (b), (c), 0, 0, 0)
__device__ __forceinline__ f16x4 cvt4h(const f32x4& v) { return (f16x4){(f16)v[0], (f16)v[1], (f16)v[2], (f16)v[3]}; }
__device__ __forceinline__ f32x4 cvt4f(const f16x4& v) { return (f32x4){(float)v[0], (float)v[1], (float)v[2], (float)v[3]}; }

__device__ __forceinline__ void p7x_chunks(const Args& a, LAS unsigned char* lds, int vcu, int G, int tid, int wave, int lane) {
    unsigned char* ws = a.ws;
    const f16* PROJ = (const f16*)(ws + WS_PROJ);
    const f16* WDT = (const f16*)(ws + WS_WDT); const f16* WAT = (const f16*)(ws + WS_WAT); const f16* WGT = (const f16*)(ws + WS_WGT);
    f16* RWG = (f16*)(ws + WS_RWG); f16* RWP = (f16*)(ws + WS_RWP); f16* RWQ = (f16*)(ws + WS_RWQ); f16* RWR2 = (f16*)(ws + WS_RWR2); f16* RWY1 = (f16*)(ws + WS_RWY1);
    float* BON = (float*)(ws + WS_BON);
    const float* mu = a.in[17];
    const f32x4 z4 = {0.f, 0.f, 0.f, 0.f};
    const bool bal = (G == 256); const int bxx = blockIdx.x;
    const int nit = bal ? 16 : (NUNIT + G - 1) / G;
#define X_UNIT(itx_) (bal ? ((((bxx & 7) * 64 + (((bxx >> 3) + 32 * (itx_)) >> 3)) * 8 + (((bxx >> 3) + 32 * (itx_)) & 7))) : (vcu + (itx_) * G))
    f16x4 rv0[9], rv1[9], prc[2], pkc[2], pvc[2], prp[2], pkp[2], pvp[2];
    f16x8 wfd[2][2], wfa[2][2], wfg[2][5];
    int h_tab = -1;
#define X_PREFETCH(u_) do { int lp = lane; asm volatile("" : "+v"(lp)); const int h_ = (u_) & 7, c_ = ((u_) >> 3) & 63, b_ = (u_) >> 9; const size_t m0_ = (size_t)(b_ << 12) + c_ * 64; \
        _Pragma("unroll") for (int i = 0; i < 9; ++i) { const int t_ = 8 * wave + i - 1; const bool ok_ = (t_ >= 0 || c_ > 0); const f16* rowp = PROJ + (m0_ + t_) * IN_PAD + C_WD; \
            rv0[i] = (f16x4){0, 0, 0, 0}; rv1[i] = (f16x4){0, 0, 0, 0}; if (ok_) { rv0[i] = *(const f16x4*)(rowp + 4 * lp); if (lp < 8) rv1[i] = *(const f16x4*)(rowp + 256 + 4 * lp); } } \
        _Pragma("unroll") for (int ci = 0; ci < 2; ++ci) { const int chr_ = h_ * 64 + 16 * (2 * (wave >> 2) + ci) + (lp & 15); \
            _Pragma("unroll") for (int ks = 0; ks < 2; ++ks) { wfd[ci][ks] = *(const f16x8*)(WDT + (size_t)chr_ * 64 + 32 * ks + 8 * (lp >> 4)); wfa[ci][ks] = *(const f16x8*)(WAT + (size_t)chr_ * 64 + 32 * ks + 8 * (lp >> 4)); } \
            _Pragma("unroll") for (int ks = 0; ks < 5; ++ks) wfg[ci][ks] = *(const f16x8*)(WGT + (size_t)chr_ * 192 + 32 * ks + 8 * (lp >> 4)); } \
        const int t2_ = 16 * (wave & 3) + (lp & 15); const size_t m_ = m0_ + t2_; \
        _Pragma("unroll") for (int ci = 0; ci < 2; ++ci) { const int ch_ = h_ * 64 + 16 * (2 * (wave >> 2) + ci) + 4 * (lp >> 4); \
            prc[ci] = *(const f16x4*)(PROJ + m_ * IN_PAD + C_R + ch_); pkc[ci] = *(const f16x4*)(PROJ + m_ * IN_PAD + C_K + ch_); pvc[ci] = *(const f16x4*)(PROJ + m_ * IN_PAD + C_V + ch_); \
            prp[ci] = (f16x4){0, 0, 0, 0}; pkp[ci] = (f16x4){0, 0, 0, 0}; pvp[ci] = (f16x4){0, 0, 0, 0}; \
            if ((c_ * 64 + t2_) != 0) { prp[ci] = *(const f16x4*)(PROJ + (m_ - 1) * IN_PAD + C_R + ch_); pkp[ci] = *(const f16x4*)(PROJ + (m_ - 1) * IN_PAD + C_K + ch_); pvp[ci] = *(const f16x4*)(PROJ + (m_ - 1) * IN_PAD + C_V + ch_); } } } while (0)
    { const int u0 = X_UNIT(0); if (u0 < NUNIT) X_PREFETCH(u0); }
#pragma unroll 1
    for (int itx = 0; itx < nit; ++itx) {
        const int u = X_UNIT(itx); if (u >= NUNIT) break;
        const int un = (itx + 1 < nit) ? X_UNIT(itx + 1) : NUNIT;
        int lane_o = lane; asm volatile("" : "+v"(lane_o));
        const int r16 = lane_o & 15, g = lane_o >> 4, qq = r16 >> 2, pp = lane_o & 3;
        const int h = u & 7, c = (u >> 3) & 63, b = u >> 9;
        const size_t m0 = (size_t)(b << 12) + c * 64;
        lds_barrier();
        if (h != h_tab) { h_tab = h;
            if (tid < 64) { const int ch = h * 64 + tid; LAS float* ct = (LAS float*)(lds + XCONST_OFF) + tid;
                ct[0] = mu[ch]; ct[64] = mu[512 + ch]; ct[128] = mu[1024 + ch]; ct[192] = a.in[18][ch]; ct[256] = a.in[20][ch]; ct[320] = a.in[23][ch]; ct[384] = a.in[24][ch]; ct[448] = a.in[25][ch]; } }
        {
            const bool l8 = lane_o < 8;
            const f32x4 mu0 = *(const f32x4*)(mu + 1536 + 4 * lane_o); f32x4 mu1 = {0.f, 0.f, 0.f, 0.f}; if (l8) mu1 = *(const f32x4*)(mu + 1536 + 256 + 4 * lane_o);
            const float kf = lane_o < 16 ? 2.f : 1.f; const bool is_t = lane_o < 16, is_id = (lane_o >= 16 && lane_o < 32);
            LAS unsigned char* d0 = is_t ? lds + XD_OFF + 8 * lane_o : is_id ? lds + XA_OFF + 8 * (lane_o - 16) : lds + XG_OFF + 8 * (lane_o - 32);
            const int p0 = (lane_o < 32) ? XP : XG_P;
#pragma unroll
            for (int i = 0; i < 8; ++i) { const int t = 8 * wave + i; float o[4], o1[4];
#pragma unroll
                for (int e = 0; e < 4; ++e) { const float cu = (float)rv0[i + 1][e], pv = (float)rv0[i][e]; const float x = cu + mu0[e] * (pv - cu);
                    const float sg = 1.f / (1.f + __expf(-kf * x)); o[e] = is_t ? 2.f * sg - 1.f : is_id ? x : sg;
                    const float cu1 = (float)rv1[i + 1][e], pv1 = (float)rv1[i][e]; const float x1 = cu1 + mu1[e] * (pv1 - cu1); o1[e] = 1.f / (1.f + __expf(-x1)); }
                u32x2 w; w.x = pkh(o[0], o[1]); w.y = pkh(o[2], o[3]); *(LAS u32x2*)(d0 + t * p0) = w;
                if (l8) { u32x2 w1; w1.x = pkh(o1[0], o1[1]); w1.y = pkh(o1[2], o1[3]); *(LAS u32x2*)(lds + XG_OFF + t * XG_P + (128 + 4 * lane_o) * 2) = w1; } }
        }
        lds_barrier();
        const int tb = wave & 3, cth = wave >> 2;
        const int t = 16 * tb + r16; const size_t m = m0 + t;
        f32x4 dA[2], aA[2], gA[2];
#pragma unroll
        for (int ci = 0; ci < 2; ++ci) {
            dA[ci] = z4; aA[ci] = z4; gA[ci] = z4;
#pragma unroll
            for (int ks = 0; ks < 2; ++ks) {
                dA[ci] = MFMA_H(wfd[ci][ks], rd_row(lds + XD_OFF, XP, t, 32 * ks + 8 * g), dA[ci]);
                aA[ci] = MFMA_H(wfa[ci][ks], rd_row(lds + XA_OFF, XP, t, 32 * ks + 8 * g), aA[ci]); }
#pragma unroll
            for (int ks = 0; ks < 5; ++ks) gA[ci] = MFMA_H(wfg[ci][ks], rd_row(lds + XG_OFF, XG_P, t, 32 * ks + 8 * g), gA[ci]);
        }
        float lwv[2][4], asg[2][4], rs[2][4], kp[2][4], vs[2][4], kkv[2][4], cl[2][4];
        float pn = 0.f, prk = 0.f;
#pragma unroll
        for (int ci = 0; ci < 2; ++ci) {
            const int chl = 16 * (2 * cth + ci) + 4 * g, ch = h * 64 + chl;
            const f16x4 rc = prc[ci], kc = pkc[ci], vc = pvc[ci], rp = prp[ci], kq = pkp[ci], vp = pvp[ci];
            const LAS float* ct = (const LAS float*)(lds + XCONST_OFF) + chl;
            const f32x4 mur = *(const LAS f32x4*)(ct), muk = *(const LAS f32x4*)(ct + 64), muv = *(const LAS f32x4*)(ct + 128);
            const f32x4 w0 = *(const LAS f32x4*)(ct + 192), a0 = *(const LAS f32x4*)(ct + 256), kkc = *(const LAS f32x4*)(ct + 320), kac = *(const LAS f32x4*)(ct + 384), rkc = *(const LAS f32x4*)(ct + 448);
            float gl[4];
#pragma unroll
            for (int e = 0; e < 4; ++e) {
                const float z = -(w0[e] + dA[ci][e]); const float sp = fmaxf(z, 0.f) + __logf(1.f + __expf(-fabsf(z)));
                lwv[ci][e] = -__expf(-sp - 0.5f);
                asg[ci][e] = sigmoidf_(a0[e] + aA[ci][e]); gl[e] = gA[ci][e];
                rs[ci][e] = (float)rc[e] + mur[e] * ((float)rp[e] - (float)rc[e]);
                const float ks_ = (float)kc[e] + muk[e] * ((float)kq[e] - (float)kc[e]);
                vs[ci][e] = (float)vc[e] + muv[e] * ((float)vp[e] - (float)vc[e]);
                kkv[ci][e] = ks_ * kkc[e]; pn += kkv[ci][e] * kkv[ci][e];
                kp[ci][e] = ks_ * (1.f + (asg[ci][e] - 1.f) * kac[e]);
                prk += rs[ci][e] * kp[ci][e] * rkc[e];
                cl[ci][e] = row16_incl_scan(lwv[ci][e]);
                if (r16 == 15) ((LAS float*)(lds + CUMB_OFF))[tb * 64 + chl + e] = cl[ci][e];
            }
            u32x2 gw; gw.x = pkh(gl[0], gl[1]); gw.y = pkh(gl[2], gl[3]); *(u32x2*)(RWG + m * RW + ch) = gw;
        }
        pn += __shfl_xor(pn, 16); pn += __shfl_xor(pn, 32); prk += __shfl_xor(prk, 16); prk += __shfl_xor(prk, 32);
        if (g == 0) { ((LAS float*)(lds + NRM_OFF))[t * 2 + cth] = pn; BON[((size_t)u * 64 + t) * 2 + cth] = prk; }
        lds_barrier();
        {
            const float nrm = sqrtf(((LAS float*)(lds + NRM_OFF))[t * 2] + ((LAS float*)(lds + NRM_OFF))[t * 2 + 1]); const float inrm = __builtin_amdgcn_rcpf(fmaxf(nrm, 1e-12f));
#pragma unroll
            for (int ci = 0; ci < 2; ++ci) {
                const int chl = 16 * (2 * cth + ci) + 4 * g;
                float Ab[4], Rb[4], Bb[4], Kb[4], Bp[4], Kp[4];
#pragma unroll
                for (int e = 0; e < 4; ++e) {
                    const LAS float* cb = (const LAS float*)(lds + CUMB_OFF) + chl + e;
                    const float b0 = cb[0], b1 = cb[64], b2 = cb[128], b3 = cb[192];
                    const float pre = (tb > 0 ? b0 : 0.f) + (tb > 1 ? b1 : 0.f) + (tb > 2 ? b2 : 0.f);
                    const float cum = cl[ci][e] + pre, cumC = (b0 + b1) + (b2 + b3);
                    const float kkn = kkv[ci][e] * inrm, av = -kkn, bv = kkn * asg[ci][e];
                    const float eg = __expf(cum), egi = __expf(-cum), egc = __expf(cumC - cum);
                    Ab[e] = av * __expf(cum - lwv[ci][e]); Rb[e] = rs[ci][e] * eg; Bb[e] = bv * egi; Kb[e] = kp[ci][e] * egi; Bp[e] = bv * egc; Kp[e] = kp[ci][e] * egc;
                }
                const int ro = t * XP + chl * 2;
                u32x2 w;
                w.x = pkb(Ab[0], Ab[1]); w.y = pkb(Ab[2], Ab[3]); *(LAS u32x2*)(lds + AB_OFF + ro) = w;
                w.x = pkb(Rb[0], Rb[1]); w.y = pkb(Rb[2], Rb[3]); *(LAS u32x2*)(lds + RB_OFF + ro) = w;
                w.x = pkb(Bb[0], Bb[1]); w.y = pkb(Bb[2], Bb[3]); *(LAS u32x2*)(lds + BB_OFF + ro) = w;
                w.x = pkb(Kb[0], Kb[1]); w.y = pkb(Kb[2], Kb[3]); *(LAS u32x2*)(lds + KB_OFF + ro) = w;
                w.x = pkh(Ab[0], Ab[1]); w.y = pkh(Ab[2], Ab[3]); *(LAS u32x2*)(lds + AH_OFF + ro) = w;
                w.x = pkh(Rb[0], Rb[1]); w.y = pkh(Rb[2], Rb[3]); *(LAS u32x2*)(lds + RH_OFF + ro) = w;
                w.x = pkh(vs[ci][0], vs[ci][1]); w.y = pkh(vs[ci][2], vs[ci][3]); *(LAS u32x2*)(lds + VH_OFF + ro) = w;
                w.x = pkh(Bp[0], Bp[1]); w.y = pkh(Bp[2], Bp[3]); *(LAS u32x2*)(lds + BP_OFF + ro) = w;
                w.x = pkh(Kp[0], Kp[1]); w.y = pkh(Kp[2], Kp[3]); *(LAS u32x2*)(lds + KP_OFF + ro) = w;
            }
        }
        lds_barrier();
#pragma unroll 1
        for (int k = 0; k < 5; ++k) {
            const int idx = wave + 8 * k, prod = idx / 10, rem = idx - prod * 10;
            const int tb1 = rem >= 6 ? 3 : rem >= 3 ? 2 : rem >= 1 ? 1 : 0, ub = rem - (tb1 * (tb1 + 1)) / 2;
            LAS unsigned char* X = lds + ((prod < 2) ? AB_OFF : RB_OFF); LAS unsigned char* Y = lds + ((prod & 1) ? KB_OFF : BB_OFF);
            f32x4 acc = z4;
#pragma unroll
            for (int ks = 0; ks < 2; ++ks) acc = MFMA_B(rd_rowb(Y, XP, 16 * ub + r16, 32 * ks + 8 * g), rd_rowb(X, XP, 16 * tb1 + r16, 32 * ks + 8 * g), acc);
            const int tt = 16 * tb1 + r16, tau0 = 16 * ub + 4 * g; const int lim = (prod < 2) ? tt : tt + 1;
#pragma unroll
            for (int e = 0; e < 4; ++e) if (tau0 + e >= lim) acc[e] = 0.f;
            wr4h(lds + LAB_OFF + prod * 9216 + tt * XP + tau0 * 2, acc);
        }
#pragma unroll 1
        for (int k = 0; k < 3; ++k) {
            const int idx = wave + 8 * k, prod = idx / 6, rem = idx - prod * 6;
            const int tb1 = rem >= 5 ? 2 : rem >= 3 ? 1 : 0, ub = (rem >= 5) ? 3 : (rem >= 3) ? rem - 1 : rem + 1;
            wr4h(lds + LAB_OFF + prod * 9216 + (16 * tb1 + r16) * XP + (16 * ub + 4 * g) * 2, z4);
        }
        lds_barrier();
        if (wave == 0) {
            LAS unsigned char* L = lds + LAB_OFF; LAS unsigned char* TT = lds + TT_OFF;
            f32x4 TB[4][4]; f16x4 TAh[4];
            float idn[4];
#pragma unroll
            for (int e = 0; e < 4; ++e) idn[e] = (r16 == 4 * g + e) ? 1.f : 0.f;
#pragma unroll
            for (int i = 0; i < 4; ++i) {
                f16x4 XA = *(const LAS f16x4*)(L + (16 * i + r16) * XP + (16 * i + 4 * g) * 2);
                f16x4 XB = tr_read16(L + (16 * i + 4 * g + qq) * XP + (16 * i + 4 * pp) * 2);
                f32x4 TAf, TBf;
#pragma unroll
                for (int e = 0; e < 4; ++e) { TAf[e] = idn[e] + (float)XA[e]; TBf[e] = idn[e] + (float)XB[e]; }
#pragma unroll
                for (int lv = 0; lv < 3; ++lv) {
                    const f32x4 X2B = MFMA_H16(XA, XB, z4), X2A = MFMA_H16(XB, XA, z4);
                    XA = cvt4h(X2A); XB = cvt4h(X2B);
                    const f16x4 ta = cvt4h(TAf);
                    TBf = MFMA_H16(ta, XB, TBf); TAf = MFMA_H16(XB, ta, TAf);
                }
                TB[i][i] = TBf; TAh[i] = cvt4h(TAf);
            }
#pragma unroll
            for (int d = 1; d < 4; ++d)
#pragma unroll
                for (int j = 0; j + d < 4; ++j) { const int i = j + d;
                    f32x4 M = z4;
#pragma unroll
                    for (int kq2 = j; kq2 < i; ++kq2) M = MFMA_H16(*(const LAS f16x4*)(L + (16 * i + r16) * XP + (16 * kq2 + 4 * g) * 2), cvt4h(TB[kq2][j]), M);
                    TB[i][j] = MFMA_H16(TAh[i], cvt4h(M), z4);
                }
#pragma unroll
            for (int i = 0; i < 4; ++i)
#pragma unroll
                for (int j = 0; j < 4; ++j) wr4h(TT + (16 * j + r16) * XP + (16 * i + 4 * g) * 2, (j <= i) ? TB[i][j] : z4);
        } else {
#pragma unroll 1
            for (int idx = wave - 1; idx < 16; idx += 7) { const int tb1 = idx >> 2, ib = idx & 3;
                f32x4 acc = z4;
#pragma unroll
                for (int ks = 0; ks < 2; ++ks) acc = MFMA_H(rd_row(lds + LAK_OFF, XP, 16 * tb1 + r16, 32 * ks + 8 * g), rd_tr(lds + VH_OFF, 32 * ks, 16 * ib, g, qq, pp), acc);
                wr4h(lds + M1T_OFF + (16 * ib + r16) * XP + (16 * tb1 + 4 * g) * 2, acc);
            }
        }
        lds_barrier();
#pragma unroll 1
        for (int k = 0; k < 4; ++k) {
            const int idx = wave + 8 * k, which = idx >> 4, tb1 = (idx >> 2) & 3, nb = idx & 3;
            f32x4 acc = z4;
#pragma unroll
            for (int ks = 0; ks < 2; ++ks) {
                const f16x8 af = rd_tr(lds + TT_OFF, 32 * ks, 16 * tb1, g, qq, pp);
                const f16x8 bf = which ? rd_row(lds + M1T_OFF, XP, 16 * nb + r16, 32 * ks + 8 * g) : rd_tr(lds + AH_OFF, 32 * ks, 16 * nb, g, qq, pp);
                acc = MFMA_H(af, bf, acc);
            }
            wr4h(lds + (which ? U1T_OFF : A2T_OFF) + (16 * nb + r16) * XP + (16 * tb1 + 4 * g) * 2, acc);
        }
        lds_barrier();
        if (un < NUNIT) X_PREFETCH(un);
#pragma unroll 1
        for (int k = 0; k < 8; ++k) {
            const int idx = wave + 8 * k, kind = idx >> 4, a4 = (idx >> 2) & 3, b4 = idx & 3;
            f32x4 acc = z4;
            if (kind == 0) {
#pragma unroll
                for (int ks = 0; ks < 2; ++ks) acc = MFMA_H(rd_row(lds + A2T_OFF, XP, 16 * a4 + r16, 32 * ks + 8 * g), rd_tr(lds + BP_OFF, 32 * ks, 16 * b4, g, qq, pp), acc);
                if (a4 == b4) { const LAS float* cb = (const LAS float*)(lds + CUMB_OFF) + 16 * b4 + r16; const float gC = __expf((cb[0] + cb[64]) + (cb[128] + cb[192]));
#pragma unroll
                    for (int e = 0; e < 4; ++e) if (4 * g + e == r16) acc[e] += gC; }
                u32x2 w; w.x = pkh(acc[0], acc[1]); w.y = pkh(acc[2], acc[3]);
                *(u32x2*)(RWP + (size_t)u * 4096 + ((b4 * 2 + (a4 >> 1)) * 64 + lane_o) * 8 + (a4 & 1) * 4) = w;
            } else if (kind == 1) {
#pragma unroll
                for (int ks = 0; ks < 2; ++ks) { acc = MFMA_H(rd_tr(lds + BP_OFF, 32 * ks, 16 * a4, g, qq, pp), rd_row(lds + U1T_OFF, XP, 16 * b4 + r16, 32 * ks + 8 * g), acc);
                    acc = MFMA_H(rd_tr(lds + KP_OFF, 32 * ks, 16 * a4, g, qq, pp), rd_tr(lds + VH_OFF, 32 * ks, 16 * b4, g, qq, pp), acc); }
                u32x2 w; w.x = pkh(acc[0], acc[1]); w.y = pkh(acc[2], acc[3]);
                *(u32x2*)(RWQ + (size_t)u * 4096 + ((b4 * 4 + a4) * 64 + lane_o) * 4) = w;
            } else if (kind == 2) {
                { const f16x4 rh4 = *(const LAS f16x4*)(lds + RH_OFF + (16 * b4 + r16) * XP + (16 * a4 + 4 * g) * 2); acc = cvt4f(rh4); }
#pragma unroll
                for (int ks = 0; ks < 2; ++ks) acc = MFMA_H(rd_row(lds + A2T_OFF, XP, 16 * a4 + r16, 32 * ks + 8 * g), rd_row(lds + LRB_OFF, XP, 16 * b4 + r16, 32 * ks + 8 * g), acc);
                u32x2 w; w.x = pkh(acc[0], acc[1]); w.y = pkh(acc[2], acc[3]);
                *(u32x2*)(RWR2 + (size_t)u * 4096 + (16 * b4 + r16) * 64 + 16 * a4 + 4 * g) = w;
            } else {
#pragma unroll
                for (int ks = 0; ks < 2; ++ks) { acc = MFMA_H(rd_row(lds + U1T_OFF, XP, 16 * a4 + r16, 32 * ks + 8 * g), rd_row(lds + LRB_OFF, XP, 16 * b4 + r16, 32 * ks + 8 * g), acc);
                    acc = MFMA_H(rd_tr(lds + VH_OFF, 32 * ks, 16 * a4, g, qq, pp), rd_row(lds + LRK_OFF, XP, 16 * b4 + r16, 32 * ks + 8 * g), acc); }
                u32x2 w; w.x = pkh(acc[0], acc[1]); w.y = pkh(acc[2], acc[3]);
                *(u32x2*)(RWY1 + (size_t)u * 4096 + ((a4 * 4 + b4) * 64 + lane_o) * 4) = w;
            }
        }
    }
}

#undef X_UNIT
#undef X_PREFETCH
struct ChBuf { f16x8 p[4][2]; u32x2 q[4]; };
__device__ __forceinline__ void p7y_chain(const Args& a, int bx0, int G, int wave, int lane) {
    unsigned char* ws = a.ws;
    const f16* RWP = (const f16*)(ws + WS_RWP); const f16* RWQ = (const f16*)(ws + WS_RWQ); f16* RWS0 = (f16*)(ws + WS_RWS0);
    if (wave != 0) return;
#pragma unroll 1
    for (int bx = bx0; bx < 256; bx += G) {
    const int r16 = lane & 15, g = lane >> 4;
    const int b = bx & 7, rest = bx >> 3, h = rest >> 2, it = rest & 3;
    f32x4 S[4];
#pragma unroll
    for (int mt = 0; mt < 4; ++mt) S[mt] = (f32x4){0.f, 0.f, 0.f, 0.f};
    ChBuf B0, B1, B2, B3;
#define CH_LOAD(BUF, c_) do { const size_t uu = ((size_t)(b * 64 + (c_)) * 8 + h); \
        _Pragma("unroll") for (int mo = 0; mo < 4; ++mo) { BUF.q[mo] = *(const u32x2*)(RWQ + uu * 4096 + ((it * 4 + mo) * 64 + lane) * 4); \
            _Pragma("unroll") for (int ks = 0; ks < 2; ++ks) BUF.p[mo][ks] = *(const f16x8*)(RWP + uu * 4096 + ((mo * 2 + ks) * 64 + lane) * 8); } } while (0)
#define CH_STEP(BUF, c_) do { const size_t uu = ((size_t)(b * 64 + (c_)) * 8 + h); f16x8 bfr[2]; \
        _Pragma("unroll") for (int mt = 0; mt < 4; ++mt) { u32x2 w; w.x = pkh(S[mt][0], S[mt][1]); w.y = pkh(S[mt][2], S[mt][3]); \
            *(u32x2*)(RWS0 + uu * 4096 + (16 * it + r16) * 64 + 16 * mt + 4 * g) = w; const f16x4 hv = __builtin_bit_cast(f16x4, w); \
            bfr[mt >> 1][(mt & 1) * 4 + 0] = hv[0]; bfr[mt >> 1][(mt & 1) * 4 + 1] = hv[1]; bfr[mt >> 1][(mt & 1) * 4 + 2] = hv[2]; bfr[mt >> 1][(mt & 1) * 4 + 3] = hv[3]; } \
        _Pragma("unroll") for (int mo = 0; mo < 4; ++mo) { f32x4 n_ = cvt4f(__builtin_bit_cast(f16x4, BUF.q[mo])); \
            _Pragma("unroll") for (int ks = 0; ks < 2; ++ks) n_ = MFMA_H(BUF.p[mo][ks], bfr[ks], n_); S[mo] = n_; } \
        if ((c_) + 4 < 64) CH_LOAD(BUF, (c_) + 4); } while (0)
    CH_LOAD(B0, 0); CH_LOAD(B1, 1); CH_LOAD(B2, 2); CH_LOAD(B3, 3);
#pragma unroll 1
    for (int c = 0; c < 64; c += 4) { CH_STEP(B0, c); CH_STEP(B1, c + 1); CH_STEP(B2, c + 2); CH_STEP(B3, c + 3); }
    }
#undef CH_LOAD
#undef CH_STEP
}

__device__ __forceinline__ void p8z_out(const Args& a, int vcu, int G, int wave, int lane) {
    unsigned char* ws = a.ws;
    const f16* PROJ = (const f16*)(ws + WS_PROJ); const f16* RWG = (const f16*)(ws + WS_RWG);
    const f16* RWR2 = (const f16*)(ws + WS_RWR2); const f16* RWY1 = (const f16*)(ws + WS_RWY1); const f16* RWS0 = (const f16*)(ws + WS_RWS0);
    const float* BON = (const float*)(ws + WS_BON); f16* OATT = (f16*)(ws + WS_OATT);
    const int gw = vcu * NWAVES + wave, NGW = G * NWAVES;
    const bool bal = (G == 256); const int bxx = blockIdx.x;
    const int nit = bal ? 2 : (NUNIT + NGW - 1) / NGW;
#pragma unroll 1
    for (int itx = 0; itx < nit; ++itx) {
        int u;
        if (bal) { const int idx = (bxx >> 3) * 8 + wave + 256 * itx; u = (((bxx & 7) * 64 + (idx >> 3)) * 8 + (idx & 7)); } else { u = gw + itx * NGW; if (u >= NUNIT) break; }
        int lane_o = lane; asm volatile("" : "+v"(lane_o));
        const int r16 = lane_o & 15, g = lane_o >> 4;
        const int h = u & 7, c = (u >> 3) & 63, b = u >> 9;
        const size_t m0 = (size_t)(b << 12) + c * 64;
        f32x4 acc[4][4];
#pragma unroll
        for (int mt = 0; mt < 4; ++mt)
#pragma unroll
            for (int nt = 0; nt < 4; ++nt) acc[mt][nt] = cvt4f(*(const f16x4*)(RWY1 + (size_t)u * 4096 + ((mt * 4 + nt) * 64 + lane_o) * 4));
#pragma unroll
        for (int ks = 0; ks < 2; ++ks) {
            f16x8 sf[4], rf[4];
#pragma unroll
            for (int x = 0; x < 4; ++x) { sf[x] = *(const f16x8*)(RWS0 + (size_t)u * 4096 + (16 * x + r16) * 64 + 32 * ks + 8 * g); rf[x] = *(const f16x8*)(RWR2 + (size_t)u * 4096 + (16 * x + r16) * 64 + 32 * ks + 8 * g); }
#pragma unroll
            for (int mt = 0; mt < 4; ++mt)
#pragma unroll
                for (int nt = 0; nt < 4; ++nt) acc[mt][nt] = MFMA_H(sf[mt], rf[nt], acc[mt][nt]);
        }
#pragma unroll
        for (int nt = 0; nt < 4; ++nt) {
            const int t = 16 * nt + r16; const size_t m = m0 + t;
            float s = 0.f;
#pragma unroll
            for (int mt = 0; mt < 4; ++mt) s += (acc[mt][nt][0] + acc[mt][nt][1]) + (acc[mt][nt][2] + acc[mt][nt][3]);
            s += __shfl_xor(s, 16); s += __shfl_xor(s, 32);
            const float mean = s * (1.f / 64.f); float q = 0.f;
#pragma unroll
            for (int mt = 0; mt < 4; ++mt)
#pragma unroll
                for (int e = 0; e < 4; ++e) { const float d = acc[mt][nt][e] - mean; q += d * d; }
            q += __shfl_xor(q, 16); q += __shfl_xor(q, 32);
            const float rstd = rsqrtf(q * (1.f / 64.f) + GN_EPS);
            const f32x2 bo = *(const f32x2*)(BON + ((size_t)u * 64 + t) * 2); const float bonus = bo[0] + bo[1];
#pragma unroll
            for (int mt = 0; mt < 4; ++mt) {
                const int ch = h * 64 + 16 * mt + 4 * g;
                const f16x4 vc = *(const f16x4*)(PROJ + m * IN_PAD + C_V + ch);
                f16x4 vp = {0, 0, 0, 0}; if ((c * 64 + t) != 0) vp = *(const f16x4*)(PROJ + (m - 1) * IN_PAD + C_V + ch);
                const f32x4 muv = *(const f32x4*)(a.in[17] + 1024 + ch), gn = *(const f32x4*)(a.in[26] + ch), bs = *(const f32x4*)(a.in[27] + ch);
                const f16x4 gg = *(const f16x4*)(RWG + m * RW + ch);
                float o[4];
#pragma unroll
                for (int e = 0; e < 4; ++e) { const float vsv = (float)vc[e] + muv[e] * ((float)vp[e] - (float)vc[e]);
                    o[e] = ((acc[mt][nt][e] - mean) * rstd * gn[e] + bs[e] + bonus * vsv) * (float)gg[e]; }
                u32x2 w; w.x = pkh(o[0], o[1]); w.y = pkh(o[2], o[3]);
                *(u32x2*)(OATT + m * KOUT + 1024 + ch) = w;
            }
        }
    }
}

__device__ __forceinline__ void p10_mid(const Args& a, int vcu, int G, int wave, int lane) {
    unsigned char* ws = a.ws;
    const f16* MIX = (const f16*)(ws + WS_MIX); const float* mod = (const float*)(ws + WS_MOD); f16* HF = (f16*)(ws + WS_H);
    const int gw = vcu * NWAVES + wave, NGW = G * NWAVES;
    for (int m = gw; m < MTOK; m += NGW) {
        const int b = m >> 12; const float* md = mod + b * 6144;
        float mx[16], xv[16]; float s = 0.f;
#pragma unroll
        for (int j = 0; j < 2; ++j) { const int c = 8 * lane + 512 * j; const f16x8 v = *(const f16x8*)(MIX + (size_t)m * D + c);
#pragma unroll
            for (int e = 0; e < 8; ++e) { mx[8 * j + e] = (float)v[e]; s += mx[8 * j + e] * mx[8 * j + e]; }
            const f32x4 x0 = *(const f32x4*)(a.in[0] + (size_t)m * D + c), x1 = *(const f32x4*)(a.in[0] + (size_t)m * D + c + 4);
#pragma unroll
            for (int e = 0; e < 4; ++e) { xv[8 * j + e] = x0[e]; xv[8 * j + 4 + e] = x1[e]; } }
        const float r = rsqrtf(wave_sum(s) * (1.f / D) + NORM_EPS);
        float s1 = 0.f;
#pragma unroll
        for (int j = 0; j < 2; ++j) { const int c = 8 * lane + 512 * j;
#pragma unroll
            for (int e = 0; e < 8; ++e) { const float x1 = xv[8 * j + e] + md[2048 + c + e] * (mx[8 * j + e] * r * a.in[6][c + e]); xv[8 * j + e] = x1; s1 += x1 * x1; }
            *(f32x4*)(a.out + (size_t)m * D + c) = (f32x4){xv[8 * j], xv[8 * j + 1], xv[8 * j + 2], xv[8 * j + 3]};
            *(f32x4*)(a.out + (size_t)m * D + c + 4) = (f32x4){xv[8 * j + 4], xv[8 * j + 5], xv[8 * j + 6], xv[8 * j + 7]}; }
        const float r1 = rsqrtf(wave_sum(s1) * (1.f / D) + NORM_EPS);
#pragma unroll
        for (int j = 0; j < 2; ++j) { const int c = 8 * lane + 512 * j; float y[8];
#pragma unroll
            for (int e = 0; e < 8; ++e) y[e] = xv[8 * j + e] * r1 * a.in[7][c + e] * (1.f + md[4096 + c + e]) + md[3072 + c + e];
            u32x4 w; w.x = pkh(y[0], y[1]); w.y = pkh(y[2], y[3]); w.z = pkh(y[4], y[5]); w.w = pkh(y[6], y[7]);
            *(u32x4*)(HF + (size_t)m * D + c) = w; }
    }
}
__device__ __forceinline__ void p13_final(const Args& a, int vcu, int G, int wave, int lane) {
    unsigned char* ws = a.ws;
    const f16* F = (const f16*)(ws + WS_F); const float* mod = (const float*)(ws + WS_MOD);
    const int gw = vcu * NWAVES + wave, NGW = G * NWAVES;
    for (int m = gw; m < MTOK; m += NGW) {
        const int b = m >> 12; const float* md = mod + b * 6144;
        float fv[16]; float s = 0.f;
#pragma unroll
        for (int j = 0; j < 2; ++j) { const int c = 8 * lane + 512 * j; const f16x8 v = *(const f16x8*)(F + (size_t)m * D + c);
#pragma unroll
            for (int e = 0; e < 8; ++e) { fv[8 * j + e] = (float)v[e]; s += fv[8 * j + e] * fv[8 * j + e]; } }
        const float r = rsqrtf(wave_sum(s) * (1.f / D) + NORM_EPS);
#pragma unroll
        for (int j = 0; j < 2; ++j) { const int c = 8 * lane + 512 * j;
            f32x4 x0 = *(const f32x4*)(a.out + (size_t)m * D + c), x1 = *(const f32x4*)(a.out + (size_t)m * D + c + 4);
#pragma unroll
            for (int e = 0; e < 4; ++e) { x0[e] += md[5120 + c + e] * (fv[8 * j + e] * r * a.in[8][c + e]); x1[e] += md[5120 + c + 4 + e] * (fv[8 * j + 4 + e] * r * a.in[8][c + 4 + e]); }
            *(f32x4*)(a.out + (size_t)m * D + c) = x0; *(f32x4*)(a.out + (size_t)m * D + c + 4) = x1; }
    }
}

constexpr int NPHASE = 14;
__global__ void __launch_bounds__(NWAVES * 64, 2) fwd(Args args) {
    extern __shared__ __attribute__((aligned(16))) unsigned char lds_raw[];
    LAS unsigned char* lds = (LAS unsigned char*)lds_raw;
    const int tid = threadIdx.x, lane = tid & 63, wave = __builtin_amdgcn_readfirstlane(tid >> 6);
    const int G = gridDim.x; const int bx = blockIdx.x; const int vcu = (G % 8 == 0) ? (bx % 8) * (G / 8) + bx / 8 : bx;
    volatile LAS unsigned* MISC = (volatile LAS unsigned*)(lds + MISC_OFF);
    if (tid < 16) MISC[tid] = 0u;
    __syncthreads();
    const int lo = args.ph_lo, hi = args.ph_hi;
    unsigned* barw = (unsigned*)(args.ws + WS_CTL) + CW_BAR;
    XcdBarrier bar; bar.bar = barw; bar.x = 0; bar.st = nullptr;
    if (hi - lo > 1) bar = xcd_barrier_post(barw, MISC);
#ifndef PHMASK
#define PHMASK 0x3FFF
#endif
#ifndef REPMASK
#define REPMASK 0
#endif
#define IN(k) (((PHMASK >> (k)) & 1) && lo <= (k) && (k) < hi)
#define REP(k) for (int rep_ = 0; rep_ < (((REPMASK >> (k)) & 1) ? 2 : 1); ++rep_)
#define SEAM(k) do { if (IN(k) && IN((k) + 1)) xcd_barrier(bar); } while (0)
    unsigned char* ws = args.ws;
    if (IN(0)) REP(0) { if (rep_) __syncthreads(); p0_prologue(args, lds, vcu, G, wave, lane); } SEAM(0);
    if (IN(1)) REP(1) { if (rep_) __syncthreads(); p1_modnorm(args, vcu, G, wave, lane); } SEAM(1);
    if (IN(2)) REP(2) { if (rep_) __syncthreads(); pg8::Gemm g{(const f16*)(ws + WS_H), (const f16*)(ws + WS_WIN), MTOK, IN_PAD, D}; pg8::StaticOrder S; S.init(MTOK, IN_PAD, G, bx);
        pg8::EpiF16 E{(f16*)(ws + WS_PROJ), IN_PAD}; pg8::gemm_phase<pg8::EpiF16, pg8::StaticOrder, true, true>(lds, g, S, E); } SEAM(2);
#ifdef OLD_BASELINE
    if (IN(5)) REP(5) { if (rep_) __syncthreads(); p5_indexer(args, lds, vcu, G, wave, lane); } SEAM(5);
    if (IN(6)) REP(6) { if (rep_) __syncthreads(); p6_attention(args, lds, vcu, G, wave, lane); p3_rwkv_prep(args, lds, vcu, G, tid); } SEAM(6);
    if (IN(7)) REP(7) { if (rep_) __syncthreads(); p7_scan(args, lds, vcu, G, wave, lane); } SEAM(7);
    if (IN(8)) REP(8) { if (rep_) __syncthreads(); p8_rwkv_post(args, vcu, G, wave, lane); } SEAM(8);
#else
#define SEAMX() do { if (hi - lo > 1) xcd_barrier(bar); } while (0)
    if (IN(3)) REP(3) { if (rep_) __syncthreads(); p3_rows(args, vcu, G, wave, lane); }
    if (IN(6)) REP(6) { __syncthreads(); p7x_chunks(args, lds, vcu, G, tid, wave, lane); } SEAMX();
    if (IN(4)) REP(4) { if (rep_) __syncthreads(); pg8::Gemm g{(const f16*)(ws + WS_CQ), (const f16*)(ws + WS_WCQ), MTOK, NQI, QL}; pg8::StaticOrder S; S.init(MTOK, NQI, G, bx);
        pg8::EpiF16 E{(f16*)args.out, NQI}; pg8::gemm_phase<pg8::EpiF16, pg8::StaticOrder, true, true>(lds, g, S, E); }
    if (IN(7)) REP(7) { __syncthreads(); p7y_chain(args, bx, G, wave, lane); } SEAMX();
    if (IN(5)) REP(5) { if (rep_) __syncthreads(); p5_dsa(args, lds, G, bx, tid, wave, lane); }
    if (IN(8)) REP(8) { __syncthreads(); p8z_out(args, vcu, G, wave, lane); } SEAMX();
#endif
    if (IN(9)) REP(9) { if (rep_) __syncthreads(); pg8::Gemm g{(const f16*)(ws + WS_OATT), (const f16*)(ws + WS_WOUT), MTOK, D, KOUT}; pg8::StaticOrder S; S.init(MTOK, D, G, bx);
        pg8::EpiF16 E{(f16*)(ws + WS_MIX), D}; pg8::gemm_phase<pg8::EpiF16, pg8::StaticOrder, true, true>(lds, g, S, E); } SEAM(9);
    if (IN(10)) REP(10) { if (rep_) __syncthreads(); p10_mid(args, vcu, G, wave, lane); } SEAM(10);
    if (IN(11)) REP(11) { if (rep_) __syncthreads(); pg8::Gemm g{(const f16*)(ws + WS_H), (const f16*)(ws + WS_WGU), MTOK, 2 * DFF, D}; pg8::StaticOrder S; S.init(MTOK, 2 * DFF, G, bx);
        pg8::EpiSwiGLU E{(f16*)(ws + WS_ACT), DFF}; pg8::gemm_phase<pg8::EpiSwiGLU, pg8::StaticOrder, true, true>(lds, g, S, E); } SEAM(11);
    if (IN(12)) REP(12) { if (rep_) __syncthreads(); pg8::Gemm g{(const f16*)(ws + WS_ACT), (const f16*)(ws + WS_WDN), MTOK, D, DFF}; pg8::StaticOrder S; S.init(MTOK, D, G, bx);
        pg8::EpiF16 E{(f16*)(ws + WS_F), D}; pg8::gemm_phase<pg8::EpiF16, pg8::StaticOrder, true, true>(lds, g, S, E); } SEAM(12);
    if (IN(13)) REP(13) { if (rep_) __syncthreads(); p13_final(args, vcu, G, wave, lane); }
#undef IN
#undef SEAM
}

#ifndef N_LAUNCH_MODE
#define N_LAUNCH_MODE 1
#endif
extern "C" void kernel_launch(void* const* d_in, const int* in_sizes, int n_in, void* d_out, int out_size, void* d_ws, size_t ws_size, hipStream_t stream) {
    static int grid = 0;
    if (grid == 0) {
        int dev = 0, cus = 0, per_cu = 0;
        if (n_in != 32 || ws_size < WS_END) { fprintf(stderr, "kernel_launch: unexpected n_in %d or ws_size %zu (< %zu)\n", n_in, ws_size, (size_t)WS_END); }
        if (hipGetDevice(&dev) != hipSuccess || hipDeviceGetAttribute(&cus, hipDeviceAttributeMultiprocessorCount, dev) != hipSuccess) { grid = -1; return; }
        if (hipFuncSetAttribute((const void*)fwd, hipFuncAttributeMaxDynamicSharedMemorySize, LDS_BYTES) != hipSuccess) { fprintf(stderr, "kernel_launch: hipFuncSetAttribute failed\n"); grid = -1; return; }
        if (hipOccupancyMaxActiveBlocksPerMultiprocessor(&per_cu, (const void*)fwd, NWAVES * 64, LDS_BYTES) != hipSuccess || per_cu < 1) fprintf(stderr, "kernel_launch: occupancy query says %d\n", per_cu);
        (void)hipGetLastError();
        grid = cus;
    }
    if (grid < 0) return;
    (void)hipMemsetAsync((char*)d_ws + WS_CTL, 0, CTL_ZERO_BYTES, stream);
    Args a{};
    for (int i = 0; i < 32; ++i) a.in[i] = (const float*)d_in[i];
    a.out = (float*)d_out; a.ws = (unsigned char*)d_ws;
    if (N_LAUNCH_MODE == 1) { a.ph_lo = 0; a.ph_hi = NPHASE; hipLaunchKernelGGL(fwd, dim3(grid), dim3(NWAVES * 64), LDS_BYTES, stream, a); }
    else for (int p = 0; p < NPHASE; ++p) { a.ph_lo = p; a.ph_hi = p + 1; hipLaunchKernelGGL(fwd, dim3(grid), dim3(NWAVES * 64), LDS_BYTES, stream, a); }
}
```

```cpp
#include <hip/hip_runtime.h>
#include <cstdio>
#include <cstdint>

#define LAS __attribute__((address_space(3)))
#define GAS __attribute__((address_space(1)))
typedef _Float16 f16;
typedef _Float16 f16x8 __attribute__((ext_vector_type(8)));
typedef _Float16 f16x4 __attribute__((ext_vector_type(4)));
typedef _Float16 f16x2 __attribute__((ext_vector_type(2)));
typedef float f32x4 __attribute__((ext_vector_type(4)));
typedef float f32x2 __attribute__((ext_vector_type(2)));
typedef unsigned u32x4 __attribute__((ext_vector_type(4)));
typedef unsigned u32x2 __attribute__((ext_vector_type(2)));

__device__ __forceinline__ unsigned pkh(float a, float b) { f16x2 v = {(f16)a, (f16)b}; return __builtin_bit_cast(unsigned, v); }
__device__ __forceinline__ float h2f(f16 h) { return (float)h; }

namespace pg8 {
constexpr int BM = 256, BK = 64, HALF = 128, HTB = HALF * BK * 2, STAGE_BYTES = 8 * HTB, NXCD = 8, WGM = 8;
__host__ __device__ __forceinline__ int lds_byte(int r, int c) { const int st = (r >> 4) * 2 + (c >> 5), rr = r & 15, cc = c & 31, ob = rr * 64 + cc * 2; return st * 1024 + (ob ^ (((ob >> 9) & 1) << 5)); }
__host__ __device__ __forceinline__ void stage_rc(int b, int& R, int& C) { const int st = b / 1024, sb = b % 1024, swz = sb ^ (((sb >> 9) & 1) << 5); R = (st >> 1) * 16 + swz / 64; C = (st & 1) * 32 + (swz % 64) / 2; }
__host__ __device__ __forceinline__ int perm32(int rho) { const int n = rho >> 4, i = rho & 15; return 8 * (i >> 2) + 4 * n + (i & 3); }

struct Unit { int pm, pn; };
struct Gemm { const f16* A; const f16* Bt; int M, N, K; };

struct StaticOrder {
    int nM, nN, nwg, G, c;
    __host__ __device__ void init(int M, int N, int G_, int c_) { nM = M / BM; nN = N / BM; nwg = nM * nN; G = G_; c = c_; }
    __host__ __device__ bool next(int i, Unit& u) const {
        const long L = (long)i * G + c; if (L >= nwg) return false;
        int wgid = (int)L; { const int q = nwg / NXCD, r = nwg % NXCD, xcd = wgid % NXCD, off = wgid / NXCD; wgid = (xcd < r ? xcd * (q + 1) : r * (q + 1) + (xcd - r) * q) + off; }
        const int nig = WGM * nN, gid = wgid / nig, fm = gid * WGM, gsz = (nM - fm) < WGM ? (nM - fm) : WGM;
        u.pm = fm + ((wgid % nig) % gsz); u.pn = (wgid % nig) / gsz; return true;
    }
    __device__ __forceinline__ void a_ready(const Unit&) const {}
    __device__ __forceinline__ void done(const Unit&) const {}
};

struct EpiF16 {
    static constexpr bool PERM = true, AFTER_DRAIN = false;
    f16* O; int ldc;
    __device__ __forceinline__ void operator()(const f32x4 (&acc)[2][2][4][2], const Unit& u, int wr, int wc, int fr, int fq) const {
        const int row0 = u.pm * BM + wr * 64 + fr; const int col0 = u.pn * BM + wc * 32 + 8 * fq;
#pragma unroll
        for (int ai = 0; ai < 2; ++ai)
#pragma unroll
            for (int m = 0; m < 4; ++m) { f16* rowp = O + (size_t)(row0 + ai * HALF + m * 16) * ldc + col0;
#pragma unroll
                for (int bj = 0; bj < 2; ++bj) { const f32x4 v0 = acc[ai][bj][m][0], v1 = acc[ai][bj][m][1];
                    u32x4 w; w.x = pkh(v0[0], v0[1]); w.y = pkh(v0[2], v0[3]); w.z = pkh(v1[0], v1[1]); w.w = pkh(v1[2], v1[3]);
                    *(u32x4*)(rowp + bj * HALF) = w; } }
    }
};
struct EpiSwiGLU {
    static constexpr bool PERM = true, AFTER_DRAIN = false;
    f16* O; int ldc;
    __device__ __forceinline__ void operator()(const f32x4 (&acc)[2][2][4][2], const Unit& u, int wr, int wc, int fr, int fq) const {
        const int row0 = u.pm * BM + wr * 64 + fr; const int col0 = u.pn * HALF + wc * 32 + 8 * fq;
#pragma unroll
        for (int ai = 0; ai < 2; ++ai)
#pragma unroll
            for (int m = 0; m < 4; ++m) { f16* rowp = O + (size_t)(row0 + ai * HALF + m * 16) * ldc + col0;
                float o[8];
#pragma unroll
                for (int n = 0; n < 2; ++n)
#pragma unroll
                    for (int j = 0; j < 4; ++j) { const float g = acc[ai][0][m][n][j], up = acc[ai][1][m][n][j]; o[n * 4 + j] = g * __builtin_amdgcn_rcpf(1.0f + __expf(-g)) * up; }
                u32x4 w; w.x = pkh(o[0], o[1]); w.y = pkh(o[2], o[3]); w.z = pkh(o[4], o[5]); w.w = pkh(o[6], o[7]);
                *(u32x4*)rowp = w; }
    }
};

template <class Epi, class Sched, bool ALIGN_EPI = false, bool SP2 = false>
__device__ __forceinline__ void gemm_phase(LAS unsigned char* lds, const Gemm g, const Sched& S, const Epi& E) {
    const int tid = threadIdx.x, wid = __builtin_amdgcn_readfirstlane(tid >> 6), lane = tid & 63, wr = wid >> 2, wc = wid & 3, fr = lane & 15, fq = lane >> 4;
    const int K = g.K, nt = K / BK;
    unsigned voffA[2], voffB[2];
#pragma unroll
    for (int i = 0; i < 2; ++i) { int R, C; stage_rc(tid * 16 + i * 8192, R, C); const int Rb = Epi::PERM ? ((R & ~31) + perm32(R & 31)) : R;
        voffA[i] = (unsigned)(R * K + C) * 2u; voffB[i] = (unsigned)(Rb * K + C) * 2u; }
    const size_t kstep = (size_t)(BK * 2);
    const size_t hstep = (size_t)HALF * K * 2;
    const size_t tstep = 2 * hstep;
    const unsigned ldsw = (unsigned)wid * 1024u;
    const int aoff = lds_byte(wr * 64 + fr, fq * 8), boff = lds_byte(wc * 32 + fr, fq * 8);
#define PG8_SA(b, h) (((b) * 2 + (h)) * HTB)
#define PG8_SB(b, h) ((4 + (b) * 2 + (h)) * HTB)
#define PG8_STAGE(bufoff, gbase, voff) do { _Pragma("unroll") for (int _i = 0; _i < 2; ++_i) \
        __builtin_amdgcn_global_load_lds((const unsigned*)((const char*)(gbase) + (voff)[_i]), (LAS unsigned*)(lds + (bufoff) + ldsw + _i * 8192), 16, 0, 0); } while (0)
#define PG8_LDA(dst, b, h) do { _Pragma("unroll") for (int m = 0; m < 4; ++m) _Pragma("unroll") for (int k = 0; k < 2; ++k) dst[m][k] = *(const LAS f16x8*)(lds + PG8_SA(b, h) + aoff + m * 2048 + k * 1024); } while (0)
#define PG8_LDB(dst, b, h) do { _Pragma("unroll") for (int n = 0; n < 2; ++n) _Pragma("unroll") for (int k = 0; k < 2; ++k) dst[n][k] = *(const LAS f16x8*)(lds + PG8_SB(b, h) + boff + n * 2048 + k * 1024); } while (0)
#define PG8_MMA(ai, bj, At, Bt) do { __builtin_amdgcn_s_setprio(1); _Pragma("unroll") for (int m = 0; m < 4; ++m) _Pragma("unroll") for (int n = 0; n < 2; ++n) _Pragma("unroll") for (int k = 0; k < 2; ++k) \
        acc[ai][bj][m][n] = __builtin_amdgcn_mfma_f32_16x16x32_f16(Bt[n][k], At[m][k], acc[ai][bj][m][n], 0, 0, 0); __builtin_amdgcn_s_setprio(0); } while (0)
#define PG8_WAIT_V(n) asm volatile("s_waitcnt vmcnt(" #n ")" ::: "memory")
#define PG8_WAIT_L(n) asm volatile("s_waitcnt lgkmcnt(" #n ")" ::: "memory")
#define PG8_BAR __builtin_amdgcn_s_barrier()
#define PG8_SCHED __builtin_amdgcn_sched_barrier(0)
    Unit cur, nxt; int ui = 0;
    if (!S.next(0, cur)) return;
    f32x4 acc[2][2][4][2];
#pragma unroll
    for (int a = 0; a < 2; ++a)
#pragma unroll
        for (int b = 0; b < 2; ++b)
#pragma unroll
            for (int m = 0; m < 4; ++m)
#pragma unroll
                for (int n = 0; n < 2; ++n) acc[a][b][m][n] = (f32x4){0.f, 0.f, 0.f, 0.f};
    f16x8 At[4][2], B0[2][2], B1[2][2];
    const char* cA = (const char*)g.A + (size_t)cur.pm * tstep; const char* cB = (const char*)g.Bt + (size_t)cur.pn * tstep;
    S.a_ready(cur);
    if constexpr (SP2) {
        PG8_STAGE(PG8_SB(0, 0), cB, voffB); PG8_STAGE(PG8_SB(0, 1), cB + hstep, voffB); PG8_STAGE(PG8_SA(0, 0), cA, voffA); PG8_STAGE(PG8_SA(0, 1), cA + hstep, voffA);
        if (wr == 1) PG8_BAR;
        PG8_WAIT_V(2); PG8_BAR;
        PG8_STAGE(PG8_SB(1, 0), cB + kstep, voffB); PG8_STAGE(PG8_SA(1, 0), cA + kstep, voffA); PG8_STAGE(PG8_SB(1, 1), cB + hstep + kstep, voffB);
        PG8_WAIT_V(6); PG8_BAR;
    } else {
        PG8_STAGE(PG8_SB(0, 0), cB, voffB); PG8_STAGE(PG8_SA(0, 0), cA, voffA); PG8_STAGE(PG8_SB(0, 1), cB + hstep, voffB); PG8_STAGE(PG8_SA(0, 1), cA + hstep, voffA);
        if (wr == 1) PG8_BAR;
        PG8_WAIT_V(4); PG8_BAR;
        PG8_STAGE(PG8_SB(1, 0), cB + kstep, voffB); PG8_STAGE(PG8_SA(1, 0), cA + kstep, voffA); PG8_STAGE(PG8_SB(1, 1), cB + hstep + kstep, voffB);
        PG8_WAIT_V(6); PG8_BAR;
    }
    for (;;) {
        const bool has_next = S.next(ui + 1, nxt);
        const char* nA = has_next ? (const char*)g.A + (size_t)nxt.pm * tstep : cA; const char* nB = has_next ? (const char*)g.Bt + (size_t)nxt.pn * tstep : cB;
        for (int t = 0; t < nt; t += 2) {
            const bool last = (t == nt - 2);
            const char* a1 = cA + (size_t)(t + 1) * kstep;
            const char* a2 = last ? nA : cA + (size_t)(t + 2) * kstep; const char* b2 = last ? nB : cB + (size_t)(t + 2) * kstep;
            const char* a3 = a2 + kstep; const char* b3 = b2 + kstep;
            if (last && has_next) S.a_ready(nxt);
            if constexpr (SP2) {
            PG8_LDB(B0, 0, 0); PG8_LDB(B1, 0, 1); PG8_SCHED; PG8_LDA(At, 0, 0); PG8_STAGE(PG8_SA(1, 1), a1 + hstep, voffA);
            PG8_WAIT_V(8); PG8_WAIT_L(0); PG8_BAR; PG8_MMA(0, 0, At, B0); PG8_MMA(0, 1, At, B1); PG8_BAR; PG8_SCHED;
            PG8_LDA(At, 0, 1); PG8_STAGE(PG8_SB(0, 0), b2, voffB); PG8_STAGE(PG8_SB(0, 1), b2 + hstep, voffB); PG8_STAGE(PG8_SA(0, 0), a2, voffA);
            PG8_WAIT_V(8); PG8_WAIT_L(0); PG8_BAR; PG8_MMA(1, 0, At, B0); PG8_MMA(1, 1, At, B1); PG8_BAR; PG8_SCHED;
            PG8_LDB(B0, 1, 0); PG8_LDB(B1, 1, 1); PG8_SCHED; PG8_LDA(At, 1, 0); PG8_STAGE(PG8_SA(0, 1), a2 + hstep, voffA);
            PG8_WAIT_V(8); PG8_WAIT_L(0); PG8_BAR; PG8_MMA(0, 0, At, B0); PG8_MMA(0, 1, At, B1); PG8_BAR; PG8_SCHED;
            PG8_LDA(At, 1, 1); PG8_STAGE(PG8_SB(1, 0), b3, voffB); PG8_STAGE(PG8_SB(1, 1), b3 + hstep, voffB); PG8_STAGE(PG8_SA(1, 0), a3, voffA);
            PG8_WAIT_V(8); PG8_WAIT_L(0); PG8_BAR; PG8_MMA(1, 0, At, B0); PG8_MMA(1, 1, At, B1); PG8_BAR; PG8_SCHED;
            } else {
            PG8_LDB(B0, 0, 0); PG8_SCHED; PG8_LDA(At, 0, 0); PG8_STAGE(PG8_SA(1, 1), a1 + hstep, voffA);
            PG8_WAIT_L(8); PG8_BAR; PG8_WAIT_L(0); PG8_MMA(0, 0, At, B0); PG8_BAR; PG8_SCHED;
            PG8_LDB(B1, 0, 1); PG8_STAGE(PG8_SB(0, 0), b2, voffB);
            PG8_BAR; PG8_WAIT_L(0); PG8_MMA(0, 1, At, B1); PG8_BAR;
            PG8_LDA(At, 0, 1); PG8_STAGE(PG8_SA(0, 0), a2, voffA);
            PG8_BAR; PG8_WAIT_L(0); PG8_MMA(1, 0, At, B0); PG8_BAR; PG8_SCHED;
            PG8_STAGE(PG8_SB(0, 1), b2 + hstep, voffB);
            PG8_WAIT_V(6); PG8_BAR; PG8_MMA(1, 1, At, B1); PG8_BAR;
            PG8_LDB(B0, 1, 0); PG8_SCHED; PG8_LDA(At, 1, 0); PG8_STAGE(PG8_SA(0, 1), a2 + hstep, voffA);
            PG8_WAIT_L(8); PG8_BAR; PG8_WAIT_L(0); PG8_MMA(0, 0, At, B0); PG8_BAR; PG8_SCHED;
            PG8_LDB(B1, 1, 1); PG8_STAGE(PG8_SB(1, 0), b3, voffB);
            PG8_BAR; PG8_WAIT_L(0); PG8_MMA(0, 1, At, B1); PG8_BAR;
            PG8_LDA(At, 1, 1); PG8_STAGE(PG8_SA(1, 0), a3, voffA);
            PG8_BAR; PG8_WAIT_L(0); PG8_MMA(1, 0, At, B0); PG8_BAR; PG8_SCHED;
            PG8_STAGE(PG8_SB(1, 1), b3 + hstep, voffB);
            PG8_WAIT_V(6); PG8_BAR; PG8_MMA(1, 1, At, B1); PG8_BAR;
            }
        }
        if constexpr (ALIGN_EPI) { if (wr == 0) PG8_BAR; }
        if constexpr (!Epi::AFTER_DRAIN) { E(acc, cur, wr, wc, fr, fq); S.done(cur); }
        if (!has_next) break;
#pragma unroll
        for (int a = 0; a < 2; ++a)
#pragma unroll
            for (int b = 0; b < 2; ++b)
#pragma unroll
                for (int m = 0; m < 4; ++m)
#pragma unroll
                    for (int n = 0; n < 2; ++n) acc[a][b][m][n] = (f32x4){0.f, 0.f, 0.f, 0.f};
        cur = nxt; cA = nA; cB = nB; ++ui;
        if constexpr (ALIGN_EPI) { if (wr == 1) PG8_BAR; }
    }
    PG8_WAIT_V(0);
    if constexpr (!ALIGN_EPI) { if (wr == 0) PG8_BAR; }
    PG8_BAR;
#undef PG8_SA
#undef PG8_SB
#undef PG8_STAGE
#undef PG8_LDA
#undef PG8_LDB
#undef PG8_MMA
#undef PG8_WAIT_V
#undef PG8_WAIT_L
#undef PG8_BAR
#undef PG8_SCHED
}
}

#define XB_TMO      128
#define XB_XCNT(j)  (256  + 64 * (j))
#define XB_XSUB(j)  (1280 + 64 * (j))
#define XB_XGEN(j)  (2304 + 64 * (j))
#define XB_TOP      3328
#define XB_TOPGEN   3392
#define XCD_BAR_WORDS 3456
#define XB_SPIN_CAP (1u << 18)
__device__ __forceinline__ unsigned xb_ld(unsigned* p)              { return __hip_atomic_load(p, __ATOMIC_RELAXED, __HIP_MEMORY_SCOPE_AGENT); }
__device__ __forceinline__ unsigned xb_add(unsigned* p, unsigned v) { return __hip_atomic_fetch_add(p, v, __ATOMIC_RELAXED, __HIP_MEMORY_SCOPE_AGENT); }
__device__ __forceinline__ unsigned xb_xcc_id() { return (unsigned)__builtin_amdgcn_s_getreg((3 << 11) | 20) & 0xFu; }
#define XB_SPIN(cond, bar) do { unsigned _sp = 0; while (cond) { __builtin_amdgcn_s_sleep(1); \
    if ((++_sp & 255u) == 0u) { if (xb_ld(&(bar)[XB_TMO])) break; if (_sp > XB_SPIN_CAP) { atomicAdd(&(bar)[XB_TMO], 1u); break; } } } } while (0)
struct XcdBarrier { unsigned* bar; unsigned x; volatile LAS unsigned* st; };
__device__ __forceinline__ XcdBarrier xcd_barrier_post(unsigned* bar, volatile LAS unsigned* st) {
    XcdBarrier b; b.bar = bar; b.x = xb_xcc_id(); b.st = st;
    if (threadIdx.x == 0) (void)xb_add(&bar[XB_XCNT(b.x)], 1u);
    return b;
}
__device__ __forceinline__ void xcd_barrier_complete(unsigned* bar, unsigned x, unsigned& nloc, unsigned& nx) {
    const unsigned G = gridDim.x * gridDim.y * gridDim.z;
    unsigned sum, cnt, mine, sp = 0u;
    for (;;) {
        sum = 0u; cnt = 0u; mine = 0u;
#pragma unroll
        for (unsigned j = 0; j < 16; ++j) { const unsigned c = xb_ld(&bar[XB_XCNT(j)]); sum += c; cnt += (c > 0u) ? 1u : 0u; mine = (j == x) ? c : mine; }
        if (sum == G) break;
        __builtin_amdgcn_s_sleep(1);
        if ((++sp & 255u) == 0u) { if (xb_ld(&bar[XB_TMO])) break; if (sp > XB_SPIN_CAP) { atomicAdd(&bar[XB_TMO], 1u); break; } }
    }
    nloc = mine > 0u ? mine : 1u; nx = cnt > 0u ? cnt : 1u;
}
__device__ __forceinline__ void xcd_barrier(const XcdBarrier& b) {
    asm volatile("s_waitcnt vmcnt(0)" ::: "memory");
    __syncthreads();
    if (threadIdx.x == 0) {
        unsigned* bar = b.bar;
        __builtin_amdgcn_s_waitcnt(0);
        unsigned nloc = b.st[0], nx = b.st[1];
        if (nloc == 0u) { xcd_barrier_complete(bar, b.x, nloc, nx); b.st[0] = nloc; b.st[1] = nx; }
        const unsigned old = xb_add(&bar[XB_XSUB(b.x)], 1u);
        const unsigned gen = old / nloc;
        if (old + 1u == (gen + 1u) * nloc) {
            __builtin_amdgcn_fence(__ATOMIC_RELEASE, "agent");
            asm volatile("s_waitcnt vmcnt(0)" ::: "memory");
            const unsigned og = xb_add(&bar[XB_TOP], 1u);
            const unsigned tg = og / nx;
            if (og + 1u == (tg + 1u) * nx) xb_add(&bar[XB_TOPGEN], 1u);
            else XB_SPIN(xb_ld(&bar[XB_TOPGEN]) == tg, bar);
            __builtin_amdgcn_fence(__ATOMIC_ACQUIRE, "agent");
            xb_add(&bar[XB_XGEN(b.x)], 1u);
            asm volatile("s_waitcnt vmcnt(0)" ::: "memory");
        } else {
            XB_SPIN(xb_ld(&bar[XB_XGEN(b.x)]) == gen, bar);
            __builtin_amdgcn_fence(__ATOMIC_ACQUIRE, "agent");
            asm volatile("s_waitcnt vmcnt(0)" ::: "memory");
        }
    }
    __syncthreads();
}

constexpr int BATCH = 8, SEQ = 4096, D = 1024, MTOK = BATCH * SEQ;
constexpr int QL = 256, KVL = 128, IDXD = 64, IDXH = 8, HATT = 8, TOPK = 256;
constexpr int RW = 512, HRW = 8, NRW = 64;
constexpr int IN_COLS = 2280, IN_PAD = 2304;
constexpr int C_CQ = 0, C_CKV = 256, C_IK = 384, C_IW = 448, C_R = 456, C_K = 968, C_V = 1480, C_WD = 1992, C_AD = 2056, C_GD = 2120;
constexpr int DFF = 2816;
constexpr int NQI = 1536;
constexpr int KOUT = 1536;
constexpr float NORM_EPS = 1e-6f, GN_EPS = 64e-5f;

constexpr size_t MiB = 1u << 20;
constexpr size_t WS_CTL = 0, CTL_ZERO_BYTES = 64 * 1024;
constexpr size_t WS_MOD = 1 * MiB;
constexpr size_t WS_WIN = 2 * MiB;
constexpr size_t WS_WCQ = 7 * MiB;
constexpr size_t WS_WOUT = 8 * MiB;
constexpr size_t WS_WGU = 11 * MiB;
constexpr size_t WS_WDN = 22 * MiB;
constexpr size_t WS_H = 32 * MiB;
constexpr size_t WS_RWW = 32 * MiB, WS_RWA = 64 * MiB;
constexpr size_t WS_PROJ = 96 * MiB;
constexpr size_t WS_CQ = 240 * MiB;
constexpr size_t WS_SEL = 240 * MiB;
constexpr size_t WS_OATT = 256 * MiB;
constexpr size_t WS_CKV = 352 * MiB;
constexpr size_t WS_IK16 = 360 * MiB;
constexpr size_t WS_IK32 = 364 * MiB;
constexpr size_t WS_IW = 372 * MiB;
constexpr size_t WS_RWG = 376 * MiB;
constexpr size_t WS_YRAW = 408 * MiB;
constexpr size_t WS_MIX = 408 * MiB;
constexpr size_t WS_ACT = 96 * MiB;
constexpr size_t WS_F = 288 * MiB;
constexpr size_t WS_END = 504 * MiB;

constexpr int CW_BAR = 1024;
constexpr int NWAVES = 8;
constexpr int RING_BYTES = 131072, AUX_OFF = RING_BYTES  , MISC_OFF = 155648, LDS_BYTES = 155904;

struct Args { const float* in[32]; float* out; unsigned char* ws; int ph_lo, ph_hi; };

__device__ __forceinline__ float wave_sum(float v) {
#pragma unroll
    for (int o = 1; o < 64; o <<= 1) v += __shfl_xor(v, o);
    return v;
}
__device__ __forceinline__ void lds_barrier() { asm volatile("s_waitcnt lgkmcnt(0)\n\ts_barrier" ::: "memory"); }
__device__ __forceinline__ float sigmoidf_(float x) { return __builtin_amdgcn_rcpf(1.0f + __expf(-x)); }

__device__ __forceinline__ void p0_transpose_item(const float* W, int K, int N, int Npad, f16* WT, int ldk, int koff, int row_off, int mode, LAS float* scr, int item, int lane) {
    const int nblk = Npad / 32, kb = item / nblk, nb = item % nblk, k0 = 64 * kb, n0 = 32 * nb;
#pragma unroll 8
    for (int i = 0; i < 32; ++i) { const int kk = 2 * i + (lane >> 5); const int n = n0 + (lane & 31); scr[kk * 33 + (lane & 31)] = (n < N && k0 + kk < K) ? W[(size_t)(k0 + kk) * N + n] : 0.f; }
    asm volatile("s_waitcnt lgkmcnt(0)" ::: "memory");
    const int c = lane & 7;
#pragma unroll
    for (int j = 0; j < 4; ++j) { const int nl = (lane >> 3) + 8 * j; const LAS float* s = scr + (8 * c) * 33 + nl;
        u32x4 o; o.x = pkh(s[0 * 33], s[1 * 33]); o.y = pkh(s[2 * 33], s[3 * 33]); o.z = pkh(s[4 * 33], s[5 * 33]); o.w = pkh(s[6 * 33], s[7 * 33]);
        const int n = n0 + nl; int row;
        if (mode == 0) row = row_off + n; else row = (n >> 7) * 256 + (mode == 2 ? 128 : 0) + (n & 127);
        *(u32x4*)(WT + (size_t)row * ldk + koff + k0 + 8 * c) = o; }
    asm volatile("s_waitcnt lgkmcnt(0)" ::: "memory");
}

__device__ __forceinline__ void p0_prologue(const Args& a, LAS unsigned char* lds, int vcu, int G, int wave, int lane) {
    unsigned char* ws = a.ws;
    LAS float* scr = (LAS float*)(lds + wave * 16384);
    const int gw = vcu * NWAVES + wave, NGW = G * NWAVES;
    f16* Win = (f16*)(ws + WS_WIN); f16* Wcq = (f16*)(ws + WS_WCQ); f16* Wout = (f16*)(ws + WS_WOUT); f16* Wgu = (f16*)(ws + WS_WGU); f16* Wdn = (f16*)(ws + WS_WDN);
    constexpr int I_IN = (D / 64) * (IN_PAD / 32), I_IDX = (QL / 64) * (512 / 32), I_OR = (512 / 64) * (D / 32), I_G = (D / 64) * (DFF / 32), I_D = (DFF / 64) * (D / 32);
    constexpr int I_FQ = 4 * 64, I_FO = 16 * 64, I_MOD = 8 * 96, I_LD = 16, I_LG = 48;
    constexpr int NITEMS = I_IN + I_IDX + I_OR + 2 * I_G + I_D + I_FQ + I_FO + 2 * I_LD + I_LG;
    for (int it = gw; it < NITEMS; it += NGW) {
        int r = it;
        if (r < I_IN) { p0_transpose_item(a.in[9], D, IN_COLS, IN_PAD, Win, D, 0, 0, 0, scr, r, lane); continue; } r -= I_IN;
        if (r < I_IDX) { p0_transpose_item(a.in[12], QL, 512, 512, Wcq, QL, 0, 1024, 0, scr, r, lane); continue; } r -= I_IDX;
        if (r < I_OR) { p0_transpose_item(a.in[28] + (size_t)512 * D, 512, D, D, Wout, KOUT, 1024, 0, 0, scr, r, lane); continue; } r -= I_OR;
        if (r < I_G) { p0_transpose_item(a.in[29], D, DFF, DFF, Wgu, D, 0, 0, 1, scr, r, lane); continue; } r -= I_G;
        if (r < I_G) { p0_transpose_item(a.in[30], D, DFF, DFF, Wgu, D, 0, 0, 2, scr, r, lane); continue; } r -= I_G;
        if (r < I_D) { p0_transpose_item(a.in[31], DFF, D, D, Wdn, DFF, 0, 0, 0, scr, r, lane); continue; } r -= I_D;
        if (r < I_FQ) {
            const int rb = r & 3, nb = r >> 2, rr = rb * 64 + lane, n0 = nb * 16, h = n0 >> 7;
            const float* uq = a.in[11] + (size_t)rr * 512 + h * 64; const float* uk = a.in[15] + (size_t)n0 * 64;
            float q[64];
#pragma unroll
            for (int d4 = 0; d4 < 16; ++d4) { const f32x4 v = *(const f32x4*)(uq + 4 * d4); q[4 * d4] = v[0]; q[4 * d4 + 1] = v[1]; q[4 * d4 + 2] = v[2]; q[4 * d4 + 3] = v[3]; }
#pragma unroll 4
            for (int i = 0; i < 16; ++i) { float s = 0.f;
#pragma unroll
                for (int d = 0; d < 64; ++d) s += q[d] * uk[i * 64 + d];
                Wcq[(size_t)(n0 + i) * QL + rr] = (f16)(0.125f * s); }
            continue; } r -= I_FQ;
        if (r < I_FO) {
            const int kb = r & 15, nb = r >> 4, k = kb * 64 + lane, h = k >> 7, n0 = nb * 16;
            const float* uv = a.in[16] + (size_t)k * 64; const float* wo = a.in[28] + (size_t)(h * 64) * D + n0;
            float acc[16];
#pragma unroll
            for (int i = 0; i < 16; ++i) acc[i] = 0.f;
#pragma unroll 8
            for (int d = 0; d < 64; ++d) { const float v = uv[d];
#pragma unroll
                for (int i4 = 0; i4 < 4; ++i4) { const f32x4 w = *(const f32x4*)(wo + (size_t)d * D + 4 * i4); acc[4 * i4] += v * w[0]; acc[4 * i4 + 1] += v * w[1]; acc[4 * i4 + 2] += v * w[2]; acc[4 * i4 + 3] += v * w[3]; } }
#pragma unroll
            for (int i = 0; i < 16; ++i) Wout[(size_t)(n0 + i) * KOUT + k] = (f16)acc[i];
            continue; } r -= I_FO;
        if (r < I_LD) { p0_transpose_item(a.in[19], 64, 512, 512, (f16*)(ws + (28u << 20)), 64, 0, 0, 0, scr, r, lane); continue; } r -= I_LD;
        if (r < I_LD) { p0_transpose_item(a.in[21], 64, 512, 512, (f16*)(ws + (28u << 20) + 65536), 64, 0, 0, 0, scr, r, lane); continue; } r -= I_LD;
        { p0_transpose_item(a.in[22], 160, 512, 512, (f16*)(ws + (28u << 20) + 131072), 192, 0, 0, 0, scr, r, lane); }
    }
    if (vcu < 96) {
        __syncthreads();
        const int tid = wave * 64 + lane;
        for (int e = tid; e < 8 * D; e += 512) { const float cc = a.in[1][e]; *(LAS float*)(lds + (e >> 10) * 16384 + 10496 + (e & 1023) * 4) = cc * sigmoidf_(cc); }
        for (int cb = vcu; cb < 96; cb += G) {
            __syncthreads();
            const int j = cb * 64 + lane; const float* aw = a.in[3] + j;
            float acc[8];
#pragma unroll
            for (int b = 0; b < 8; ++b) acc[b] = 0.f;
            const int kbeg = wave * 128;
#pragma unroll 1
            for (int k0 = 0; k0 < 128; k0 += 16) {
                float wv[16];
#pragma unroll
                for (int i = 0; i < 16; ++i) wv[i] = aw[(size_t)(kbeg + k0 + i) * 6144];
#pragma unroll
                for (int b = 0; b < 8; ++b) {
#pragma unroll
                    for (int i4 = 0; i4 < 4; ++i4) { const f32x4 sv = *(const LAS f32x4*)(lds + b * 16384 + 10496 + (kbeg + k0 + 4 * i4) * 4);
                        acc[b] += sv[0] * wv[4 * i4] + sv[1] * wv[4 * i4 + 1] + sv[2] * wv[4 * i4 + 2] + sv[3] * wv[4 * i4 + 3]; } }
            }
#pragma unroll
            for (int b = 0; b < 8; ++b) *(LAS float*)(lds + wave * 16384 + 8448 + (b * 64 + lane) * 4) = acc[b];
            __syncthreads();
            float sum = 0.f;
#pragma unroll
            for (int w = 0; w < 8; ++w) sum += *(const LAS float*)(lds + w * 16384 + 8448 + (wave * 64 + lane) * 4);
            ((float*)(ws + WS_MOD))[wave * 6144 + j] = sum + a.in[4][j];
        }
    }
}

__device__ __forceinline__ void p1_modnorm(const Args& a, int vcu, int G, int wave, int lane) {
    const int gw = vcu * NWAVES + wave, NGW = G * NWAVES;
    const float* mod = (const float*)(a.ws + WS_MOD); f16* H = (f16*)(a.ws + WS_H);
    for (int m = gw; m < MTOK; m += NGW) {
        const int b = m >> 12;
        const f32x4* xr = (const f32x4*)(a.in[0] + (size_t)m * D) + lane;
        f32x4 v[4]; float s = 0.f;
#pragma unroll
        for (int j = 0; j < 4; ++j) { v[j] = xr[64 * j]; s += (v[j][0] * v[j][0] + v[j][1] * v[j][1]) + (v[j][2] * v[j][2] + v[j][3] * v[j][3]); }
        const float r = rsqrtf(wave_sum(s) * (1.f / D) + NORM_EPS);
        u32x2* o = (u32x2*)(H + (size_t)m * D) + lane;
#pragma unroll
        for (int j = 0; j < 4; ++j) { const int c = 4 * lane + 256 * j;
            const f32x4 g = *(const f32x4*)(a.in[5] + c), sh = *(const f32x4*)(mod + b * 6144 + c), sc = *(const f32x4*)(mod + b * 6144 + 1024 + c);
            f32x4 y;
#pragma unroll
            for (int e = 0; e < 4; ++e) y[e] = v[j][e] * r * g[e] * (1.f + sc[e]) + sh[e];
            u32x2 w; w.x = pkh(y[0], y[1]); w.y = pkh(y[2], y[3]); o[64 * j] = w; }
    }
}

__device__ __forceinline__ void p3_rows(const Args& a, int vcu, int G, int wave, int lane) {
    const int gw = vcu * NWAVES + wave, NGW = G * NWAVES;
    unsigned char* ws = a.ws;
    const f16* PROJ = (const f16*)(ws + WS_PROJ);
    f16* CQ = (f16*)(ws + WS_CQ); f16* CKV = (f16*)(ws + WS_CKV); f16* IK16 = (f16*)(ws + WS_IK16); float* IW = (float*)(ws + WS_IW);
    for (int m = gw; m < MTOK; m += NGW) {
        const f16* pr = PROJ + (size_t)m * IN_PAD;
        const f16x4 q = *(const f16x4*)(pr + C_CQ + 4 * lane);
        const f16x2 kv = *(const f16x2*)(pr + C_CKV + 2 * lane);
        const float ik = (float)pr[C_IK + lane];
        float q0 = (float)q[0], q1 = (float)q[1], q2 = (float)q[2], q3 = (float)q[3], k0 = (float)kv[0], k1 = (float)kv[1];
        const float rq = rsqrtf(wave_sum(q0 * q0 + q1 * q1 + q2 * q2 + q3 * q3) * (1.f / QL) + NORM_EPS);
        const float rk = rsqrtf(wave_sum(k0 * k0 + k1 * k1) * (1.f / KVL) + NORM_EPS);
        const float ri = rsqrtf(wave_sum(ik * ik) * (1.f / IDXD) + NORM_EPS);
        const f32x4 gq = *(const f32x4*)(a.in[10] + 4 * lane); const f32x2 gk = *(const f32x2*)(a.in[13] + 2 * lane); const float gi = a.in[14][lane];
        u32x2 w; w.x = pkh(q0 * rq * gq[0], q1 * rq * gq[1]); w.y = pkh(q2 * rq * gq[2], q3 * rq * gq[3]);
        *(u32x2*)(CQ + (size_t)m * QL + 4 * lane) = w;
        *(unsigned*)(CKV + (size_t)m * KVL + 2 * lane) = pkh(k0 * rk * gk[0], k1 * rk * gk[1]);
        const float ikn = ik * ri * gi;
        IK16[(size_t)m * IDXD + lane] = (f16)ikn;
        if (lane < 8) IW[(size_t)m * 8 + lane] = (float)pr[C_IW + lane] * 0.04419417382415922f;
    }
}
__device__ __forceinline__ void p3_rwkv_prep(const Args& a, LAS unsigned char* lds, int vcu, int G, int tid) {
    unsigned char* ws = a.ws;
    const f16* PROJ = (const f16*)(ws + WS_PROJ);
    f16* RWW = (f16*)(ws + WS_RWW); f16* RWA = (f16*)(ws + WS_RWA); f16* RWG = (f16*)(ws + WS_RWG);
    LAS float* xs = (LAS float*)lds;
    const float* mu = a.in[17];
    const int ch = tid;
    const float w0 = a.in[18][ch], a0 = a.in[20][ch];
    for (int u = vcu; u < MTOK / 16; u += G) {
        const int m0 = u * 16;
        __syncthreads();
        for (int e = tid; e < 16 * 288; e += 512) {
            const int t = e / 288, col = e % 288, m = m0 + t;
            const float cur = (float)PROJ[(size_t)m * IN_PAD + C_WD + col];
            const float prev = ((m & (SEQ - 1)) != 0) ? (float)PROJ[(size_t)(m - 1) * IN_PAD + C_WD + col] : 0.f;
            float v = cur + mu[1536 + col] * (prev - cur);
            if (col < 64) v = tanhf(v); else if (col >= 128) v = sigmoidf_(v);
            xs[t * 288 + col] = v;
        }
        __syncthreads();
        float dl[16], al[16], gl[16];
#pragma unroll
        for (int t = 0; t < 16; ++t) { dl[t] = 0.f; al[t] = 0.f; gl[t] = 0.f; }
        for (int kk = 0; kk < 64; ++kk) {
            const float wd = a.in[19][kk * 512 + ch], wa = a.in[21][kk * 512 + ch];
#pragma unroll
            for (int t = 0; t < 16; ++t) { dl[t] += xs[t * 288 + kk] * wd; al[t] += xs[t * 288 + 64 + kk] * wa; }
        }
        for (int kk = 0; kk < 160; ++kk) {
            const float wg = a.in[22][kk * 512 + ch];
#pragma unroll
            for (int t = 0; t < 16; ++t) gl[t] += xs[t * 288 + 128 + kk] * wg;
        }
#pragma unroll
        for (int t = 0; t < 16; ++t) {
            const float z = -(w0 + dl[t]);
            const float sp = z > 20.f ? z : log1pf(__expf(z));
            const float wlog = -sp - 0.5f;
            const float lw = -__expf(wlog);
            const float av = sigmoidf_(a0 + al[t]);
            const size_t o = (size_t)(m0 + t) * RW + ch;
            RWW[o] = (f16)lw; RWA[o] = (f16)av; RWG[o] = (f16)gl[t];
        }
    }
}

__device__ __forceinline__ unsigned f2key(float f) { const unsigned u = __builtin_bit_cast(unsigned, f); return (u & 0x80000000u) ? ~u : (u | 0x80000000u); }
__device__ __forceinline__ void p5_indexer(const Args& a, LAS unsigned char* lds, int vcu, int G, int wave, int lane) {
    unsigned char* ws = a.ws;
    const f16* QI = (const f16*)a.out;
    const float* IK32 = (const float*)(ws + WS_IK32); const float* IW = (const float*)(ws + WS_IW);
    unsigned short* SEL = (unsigned short*)(ws + WS_SEL);
    LAS float* sc = (LAS float*)(lds + wave * 16384);
    LAS float* iq = (LAS float*)(lds + AUX_OFF + wave * 2048);
    const int gw = vcu * NWAVES + wave, NGW = G * NWAVES;
    for (int q = gw; q < MTOK; q += NGW) {
        const int b = q >> 12, t = q & (SEQ - 1);
        unsigned short* sel = SEL + (size_t)q * TOPK;
        if (t < TOPK) {
#pragma unroll
            for (int j = 0; j < 4; ++j) { const int s = lane + 64 * j; sel[s] = (s <= t) ? (unsigned short)s : (unsigned short)0xFFFF; }
            continue;
        }
        { const f16x8 v = *(const f16x8*)(QI + (size_t)q * NQI + 1024 + 8 * lane);
#pragma unroll
          for (int e = 0; e < 8; ++e) iq[8 * lane + e] = (float)v[e]; }
        float wq[8];
#pragma unroll
        for (int h = 0; h < 8; ++h) wq[h] = IW[(size_t)q * 8 + h];
        asm volatile("s_waitcnt lgkmcnt(0)" ::: "memory");
        const int nj = (t >> 6) + 1;
        for (int j = 0; j < nj; ++j) {
            const int s = j * 64 + lane;
            const float* kr = IK32 + ((size_t)(b << 12) + (s <= t ? s : t)) * IDXD;
            float kx[64];
#pragma unroll
            for (int d4 = 0; d4 < 16; ++d4) { const f32x4 v = *(const f32x4*)(kr + 4 * d4); kx[4 * d4] = v[0]; kx[4 * d4 + 1] = v[1]; kx[4 * d4 + 2] = v[2]; kx[4 * d4 + 3] = v[3]; }
            float score = 0.f;
#pragma unroll
            for (int h = 0; h < 8; ++h) { float d0 = 0.f;
#pragma unroll
                for (int d4 = 0; d4 < 16; ++d4) { const f32x4 qv = *(const LAS f32x4*)(iq + h * 64 + 4 * d4); d0 += qv[0] * kx[4 * d4]; d0 += qv[1] * kx[4 * d4 + 1]; d0 += qv[2] * kx[4 * d4 + 2]; d0 += qv[3] * kx[4 * d4 + 3]; }
                score += wq[h] * fmaxf(d0, 0.f); }
            sc[s] = (s <= t) ? score : -INFINITY;
        }
        asm volatile("s_waitcnt lgkmcnt(0)" ::: "memory");
        const int nvalid = nj * 64;
        unsigned key[64];
#pragma unroll
        for (int j = 0; j < 64; ++j) { const int s = lane * 64 + j; key[j] = (s < nvalid) ? f2key(sc[s]) : 0u; }
        unsigned prefix = 0u;
        for (int bit = 31; bit >= 0; --bit) {
            const unsigned cand = prefix | (1u << bit);
            int c = 0;
#pragma unroll
            for (int j = 0; j < 64; ++j) c += (key[j] >= cand) ? 1 : 0;
#pragma unroll
            for (int o = 1; o < 64; o <<= 1) c += __shfl_xor(c, o);
            if (c >= TOPK) prefix = cand;
        }
        int cgt = 0, ceq = 0;
#pragma unroll
        for (int j = 0; j < 64; ++j) { cgt += (key[j] > prefix) ? 1 : 0; ceq += (key[j] == prefix) ? 1 : 0; }
        int sgt = cgt, seq = ceq;
#pragma unroll
        for (int o = 1; o < 64; o <<= 1) { const int x = __shfl_up(sgt, o), y = __shfl_up(seq, o); if (lane >= o) { sgt += x; seq += y; } }
        const int tot_gt = __shfl(sgt, 63);
        int pos_gt = sgt - cgt, rank_eq = seq - ceq;
        const int need = TOPK - tot_gt;
#pragma unroll
        for (int j = 0; j < 64; ++j) {
            const int s = lane * 64 + j;
            if (key[j] > prefix) { sel[pos_gt] = (unsigned short)s; ++pos_gt; }
            else if (key[j] == prefix) { if (rank_eq < need) sel[tot_gt + rank_eq] = (unsigned short)s; ++rank_eq; }
        }
    }
}

__device__ __forceinline__ int t5_bucket(int rel) {
    if (rel < 16) return rel;
    const int l = 16 + (int)(logf((float)rel * (1.f / 16.f)) / 2.0794415416798357f * 16.f);
    return l < 31 ? l : 31;
}
__device__ __forceinline__ void p6_attention(const Args& a, LAS unsigned char* lds, int vcu, int G, int wave, int lane) {
    unsigned char* ws = a.ws;
    const f16* QI = (const f16*)a.out; const f16* CKV = (const f16*)(ws + WS_CKV);
    const unsigned short* SEL = (const unsigned short*)(ws + WS_SEL);
    f16* OATT = (f16*)(ws + WS_OATT);
    const float* rel_bias = a.in[2];
    LAS float* qa = (LAS float*)(lds + wave * 16384);
    LAS float* pp = (LAS float*)(lds + wave * 16384 + 4096);
    LAS int* sidx = (LAS int*)(lds + wave * 16384 + 12288);
    const int gw = vcu * NWAVES + wave, NGW = G * NWAVES;
    for (int q = gw; q < MTOK; q += NGW) {
        const int b = q >> 12, t = q & (SEQ - 1);
#pragma unroll
        for (int i = 0; i < 2; ++i) { const f16x8 v = *(const f16x8*)(QI + (size_t)q * NQI + 512 * i + 8 * lane);
#pragma unroll
            for (int e = 0; e < 8; ++e) qa[512 * i + 8 * lane + e] = (float)v[e]; }
        asm volatile("s_waitcnt lgkmcnt(0)" ::: "memory");
        float lg[4][8];
        int srow[4]; bool okv[4];
#pragma unroll
        for (int i = 0; i < 4; ++i) {
            const int sraw = SEL[(size_t)q * TOPK + lane + 64 * i];
            okv[i] = sraw != 0xFFFF && sraw <= t;
            srow[i] = okv[i] ? sraw : 0;
            sidx[lane + 64 * i] = okv[i] ? sraw : -1;
#pragma unroll
            for (int h = 0; h < 8; ++h) lg[i][h] = 0.f;
        }
#pragma unroll 1
        for (int c8 = 0; c8 < 16; ++c8) {
            f16x8 kv[4];
#pragma unroll
            for (int i = 0; i < 4; ++i) kv[i] = *(const f16x8*)(CKV + ((size_t)(b << 12) + srow[i]) * KVL + 8 * c8);
#pragma unroll
            for (int h = 0; h < 8; ++h) {
                const f32x4 q0 = *(const LAS f32x4*)(qa + h * 128 + 8 * c8), q1 = *(const LAS f32x4*)(qa + h * 128 + 8 * c8 + 4);
#pragma unroll
                for (int i = 0; i < 4; ++i)
                    lg[i][h] += q0[0] * (float)kv[i][0] + q0[1] * (float)kv[i][1] + q0[2] * (float)kv[i][2] + q0[3] * (float)kv[i][3] + q1[0] * (float)kv[i][4] + q1[1] * (float)kv[i][5] + q1[2] * (float)kv[i][6] + q1[3] * (float)kv[i][7];
            }
        }
#pragma unroll
        for (int i = 0; i < 4; ++i) {
            const int bk = t5_bucket(t - srow[i]);
#pragma unroll
            for (int h = 0; h < 8; ++h) lg[i][h] = okv[i] ? lg[i][h] + rel_bias[bk * 8 + h] : -INFINITY;
        }
#pragma unroll
        for (int h = 0; h < 8; ++h) {
            float mx = fmaxf(fmaxf(lg[0][h], lg[1][h]), fmaxf(lg[2][h], lg[3][h]));
#pragma unroll
            for (int o = 1; o < 64; o <<= 1) mx = fmaxf(mx, __shfl_xor(mx, o));
            float e[4], s = 0.f;
#pragma unroll
            for (int i = 0; i < 4; ++i) { e[i] = __expf(lg[i][h] - mx); s += e[i]; }
            s = wave_sum(s);
            const float inv = 1.f / s;
#pragma unroll
            for (int i = 0; i < 4; ++i) pp[h * 256 + lane + 64 * i] = e[i] * inv;
        }
        asm volatile("s_waitcnt lgkmcnt(0)" ::: "memory");
        float o0[8], o1[8];
#pragma unroll
        for (int h = 0; h < 8; ++h) { o0[h] = 0.f; o1[h] = 0.f; }
        for (int kk = 0; kk < TOPK; ++kk) {
            const int s = sidx[kk];
            if (s < 0) continue;
            const f16x2 kv = *(const f16x2*)(CKV + ((size_t)(b << 12) + s) * KVL + 2 * lane);
            const float v0 = (float)kv[0], v1 = (float)kv[1];
#pragma unroll
            for (int h = 0; h < 8; ++h) { const float p = pp[h * 256 + kk]; o0[h] += p * v0; o1[h] += p * v1; }
        }
#pragma unroll
        for (int h = 0; h < 8; ++h) *(unsigned*)(OATT + (size_t)q * KOUT + h * 128 + 2 * lane) = pkh(o0[h], o1[h]);
        asm volatile("s_waitcnt lgkmcnt(0)" ::: "memory");
    }
}

constexpr int SC_PITCH = 8224, DSA_SEL_OFF = 16 * SC_PITCH, DSA_BL_OFF = DSA_SEL_OFF + 8192, DSA_HIST_OFF = 143936;
static_assert(DSA_BL_OFF + 129 * 8 * 4 <= DSA_HIST_OFF && DSA_HIST_OFF + 8 * 1280 <= MISC_OFF, "DSA LDS map");
typedef short v4i16_t __attribute__((ext_vector_type(4)));
__device__ __forceinline__ unsigned kv_off(unsigned row, unsigned ch) { return 256u * row + 16u * (ch ^ (((row & 3u) << 2) | ((row >> 2) & 3u))); }
__device__ __forceinline__ f16x4 tr_read16(LAS unsigned char* p) { return __builtin_bit_cast(f16x4, __builtin_amdgcn_ds_read_tr16_b64_v4i16((LAS v4i16_t*)p)); }
template <int CTRL, int RMASK> __device__ __forceinline__ int dpp_i(int x) { return __builtin_amdgcn_update_dpp(0, x, CTRL, RMASK, 0xF, false); }
template <int CTRL> __device__ __forceinline__ int dpp_iz(int x) { return __builtin_amdgcn_update_dpp(0, x, CTRL, 0xF, 0xF, true); }
__device__ __forceinline__ int wave_incl_scan_i(int x) { x += dpp_iz<0x111>(x); x += dpp_iz<0x112>(x); x += dpp_iz<0x114>(x); x += dpp_iz<0x118>(x);
    x += dpp_i<0x142, 0xA>(x); x += dpp_i<0x143, 0xC>(x); return x; }
__device__ __forceinline__ void p5_dsa(const Args& a, LAS unsigned char* lds, int G, int bx, int tid, int wave, int lane) {
    unsigned char* ws = a.ws;
    const f16* QI = (const f16*)a.out; const f16* IK16 = (const f16*)(ws + WS_IK16); const float* IW = (const float*)(ws + WS_IW);
    const f16* CKV = (const f16*)(ws + WS_CKV); f16* OATT = (f16*)(ws + WS_OATT);
    LAS unsigned short* SELL = (LAS unsigned short*)(lds + DSA_SEL_OFF);
    LAS float* BL = (LAS float*)(lds + DSA_BL_OFF);
    for (int e = tid; e < 129 * 8; e += 512) { const int rel = e >> 3, h = e & 7; BL[e] = a.in[2][t5_bucket(rel) * 8 + h]; }
    const int nunits = BATCH * (SEQ / 16);
    const bool balanced = (G == 256);
    const int niter = balanced ? 8 : (nunits + G - 1) / G;
#pragma unroll 1
    for (int it = 0; it < niter; ++it) {
        int b, tile;
        if (balanced) { b = bx & 7; const int r = bx >> 3, base = 64 * (it >> 1); tile = (it & 1) ? base + 63 - r : base + r; }
        else { const int u = it * G + bx; if (u >= nunits) break; b = u >> 8; tile = u & 255; }
        int lane_o = lane; asm volatile("" : "+v"(lane_o));
        const int r16 = lane_o & 15, g = lane_o >> 4;
        const int t0 = tile * 16;
        const size_t qb = (size_t)(b << 12);
        const int jn = ((t0 + 15) >> 7) + 1;
        lds_barrier();
#ifndef DSAREP
#define DSAREP 0
#endif
#ifndef DSA_NO_A
        for (int ra_ = 0; ra_ < ((DSAREP & 1) ? 2 : 1); ++ra_)
        if (t0 + 15 >= TOPK) {
            f16x8 afr[8][2]; f32x4 wv[4][2];
#pragma unroll
            for (int mt = 0; mt < 8; ++mt) { const int tg = mt >> 1, hf = mt & 1, t = t0 + 4 * tg + (r16 >> 2), h = 4 * hf + (r16 & 3);
#pragma unroll
                for (int ks = 0; ks < 2; ++ks) afr[mt][ks] = *(const f16x8*)(QI + (qb + t) * NQI + 1024 + h * 64 + 32 * ks + 8 * g); }
#pragma unroll
            for (int tg = 0; tg < 4; ++tg)
#pragma unroll
                for (int hf = 0; hf < 2; ++hf) wv[tg][hf] = *(const f32x4*)(IW + (qb + t0 + 4 * tg + g) * 8 + 4 * hf) * 65536.0f;
            const f32x2 cscale = {1.52587890625e-05f, 1.52587890625e-05f};
            f16x8 bn0[2], bn1[2], bn2[2];
            const f16* ikp = IK16 + (qb + 16 * wave + r16) * IDXD + 8 * g;
#pragma unroll
            for (int ks = 0; ks < 2; ++ks) { bn0[ks] = *(const f16x8*)(ikp + 32 * ks); bn1[ks] = bn0[ks]; bn2[ks] = bn0[ks];
                if (jn > 1) bn1[ks] = *(const f16x8*)(ikp + 128 * IDXD + 32 * ks);
                if (jn > 2) bn2[ks] = *(const f16x8*)(ikp + 256 * IDXD + 32 * ks); }
            for (int j = 0; j < jn; ++j) {
                const int s = 128 * j + 16 * wave + r16;
                f16x8 bfr[2]; bfr[0] = bn0[0]; bfr[1] = bn0[1];
                bn0[0] = bn1[0]; bn0[1] = bn1[1]; bn1[0] = bn2[0]; bn1[1] = bn2[1];
                if (j + 3 < jn) {
#pragma unroll
                    for (int ks = 0; ks < 2; ++ks) bn2[ks] = *(const f16x8*)(ikp + (size_t)(128 * (j + 3)) * IDXD + 32 * ks); }
                f32x4 acc[8];
#pragma unroll
                for (int mt = 0; mt < 8; ++mt) { acc[mt] = __builtin_amdgcn_mfma_f32_16x16x32_f16(afr[mt][0], bfr[0], (f32x4){0.f, 0.f, 0.f, 0.f}, 0, 0, 0);
                    acc[mt] = __builtin_amdgcn_mfma_f32_16x16x32_f16(afr[mt][1], bfr[1], acc[mt], 0, 0, 0); }
                asm volatile("s_nop 15\n\ts_nop 7" :: "v"(acc[0]), "v"(acc[1]), "v"(acc[2]), "v"(acc[3]), "v"(acc[4]), "v"(acc[5]), "v"(acc[6]), "v"(acc[7]));
                float scv[4];
#pragma unroll
                for (int tg = 0; tg < 4; ++tg) { f32x2 s2 = {0.f, 0.f};
#pragma unroll
                    for (int hf = 0; hf < 2; ++hf)
#pragma unroll
                        for (int p = 0; p < 2; ++p) { const f32x2 av = {acc[2 * tg + hf][2 * p], acc[2 * tg + hf][2 * p + 1]}; f32x2 r;
                            asm volatile("v_pk_mul_f32 %0, %1, %2 clamp" : "=v"(r) : "v"(av), "v"(cscale));
                            const f32x2 wp = {wv[tg][hf][2 * p], wv[tg][hf][2 * p + 1]}; s2 = r * wp + s2; }
                    scv[tg] = s2[0] + s2[1]; }
                if (j == jn - 1) {
#pragma unroll
                    for (int tg = 0; tg < 4; ++tg) if (s > t0 + 4 * tg + g) scv[tg] = -INFINITY; }
#pragma unroll
                for (int pr = 0; pr < 2; ++pr) {
                    const unsigned x = pkh(scv[2 * pr], scv[2 * pr + 1]);
                    const unsigned k2 = x ^ ((((x >> 15) & 0x00010001u) * 0x7FFFu) | 0x80008000u);
                    *(LAS unsigned short*)(lds + (4 * (2 * pr) + g) * SC_PITCH + s * 2) = (unsigned short)(k2 & 0xFFFFu);
                    *(LAS unsigned short*)(lds + (4 * (2 * pr + 1) + g) * SC_PITCH + s * 2) = (unsigned short)(k2 >> 16); }
            }
        }
#endif
        __builtin_amdgcn_sched_barrier(0); lds_barrier(); __builtin_amdgcn_sched_barrier(0);
#ifndef DSA_NO_C
#pragma unroll 1
        for (int rr = 0; rr < ((DSAREP & 2) ? 4 : 2); ++rr) {
            const int rl = 2 * wave + (rr & 1), t = t0 + rl;
            LAS unsigned short* sel = SELL + rl * 256;
            if (t < TOPK) {
#pragma unroll
                for (int k = 0; k < 4; ++k) { const int jx = lane_o + 64 * k; sel[jx] = (jx <= t) ? (unsigned short)jx : (unsigned short)0xFFFF; }
                continue;
            }
            const LAS unsigned* srow = (const LAS unsigned*)(lds + rl * SC_PITCH) + lane_o;
#define DSA_KEY(jj_) (srow[(jj_) * 64])
            LAS unsigned* hist = (LAS unsigned*)(lds + DSA_HIST_OFF + wave * 1280);
            unsigned prefix = 0u; int kneed = TOPK;
#pragma unroll 1
            for (int pass = 0; pass < 2; ++pass) {
                *(LAS u32x4*)(hist + 4 * lane_o) = (u32x4){0u, 0u, 0u, 0u};
                asm volatile("s_waitcnt lgkmcnt(0)" ::: "memory");
                if (pass == 0) {
#pragma unroll 4
                    for (int jj = 0; jj < jn; ++jj) { const unsigned k = DSA_KEY(jj);
                        __hip_atomic_fetch_add(hist + (k >> 24), 1u, __ATOMIC_RELAXED, __HIP_MEMORY_SCOPE_WORKGROUP);
                        __hip_atomic_fetch_add(hist + ((k >> 8) & 0xFFu), 1u, __ATOMIC_RELAXED, __HIP_MEMORY_SCOPE_WORKGROUP);
                        if (DSAREP & 8) { __hip_atomic_fetch_add(hist + (k >> 24), 1u, __ATOMIC_RELAXED, __HIP_MEMORY_SCOPE_WORKGROUP); __hip_atomic_fetch_add(hist + ((k >> 8) & 0xFFu), 1u, __ATOMIC_RELAXED, __HIP_MEMORY_SCOPE_WORKGROUP);
                            __hip_atomic_fetch_add(hist + (k >> 24), 0xFFFFFFFFu, __ATOMIC_RELAXED, __HIP_MEMORY_SCOPE_WORKGROUP); __hip_atomic_fetch_add(hist + ((k >> 8) & 0xFFu), 0xFFFFFFFFu, __ATOMIC_RELAXED, __HIP_MEMORY_SCOPE_WORKGROUP); } }
                } else {
#pragma unroll 4
                    for (int jj = 0; jj < jn; ++jj) { const unsigned k = DSA_KEY(jj);
                        const unsigned dump = 256u + (unsigned)lane_o;
                        __hip_atomic_fetch_add(hist + (((k >> 24) == prefix) ? ((k >> 16) & 0xFFu) : dump), 1u, __ATOMIC_RELAXED, __HIP_MEMORY_SCOPE_WORKGROUP);
                        __hip_atomic_fetch_add(hist + ((((k >> 8) & 0xFFu) == prefix) ? (k & 0xFFu) : dump), 1u, __ATOMIC_RELAXED, __HIP_MEMORY_SCOPE_WORKGROUP); }
                }
                asm volatile("s_waitcnt lgkmcnt(0)" ::: "memory");
                const u32x4 hv = *(const LAS u32x4*)(hist + 4 * lane_o);
                const int sl = (int)(hv.x + hv.y + hv.z + hv.w);
                const int pre = wave_incl_scan_i(sl);
                const int tot = __builtin_amdgcn_readlane(pre, 63);
                const int S = tot - pre + sl;
                const int excl = S - sl;
                const unsigned long long bm = __ballot(excl < kneed && S >= kneed);
                const int L = bm ? (int)__builtin_ctzll(bm) : 0;
                const int ex = __builtin_amdgcn_readlane(excl, L); const int h1 = __builtin_amdgcn_readlane((int)hv.y, L), h2 = __builtin_amdgcn_readlane((int)hv.z, L), h3 = __builtin_amdgcn_readlane((int)hv.w, L);
                int cabove = ex, bin;
                if (cabove + h3 >= kneed) bin = 3; else { cabove += h3;
                    if (cabove + h2 >= kneed) bin = 2; else { cabove += h2;
                        if (cabove + h1 >= kneed) bin = 1; else { cabove += h1; bin = 0; } } }
                prefix = (prefix << 8) | (unsigned)(4 * L + bin); kneed -= cabove;
            }
            const unsigned lo = prefix << 16, hi = (prefix + 1u) << 16;
            const int tot_gt = TOPK - kneed, need = kneed;
            LAS unsigned short* dumpp = (LAS unsigned short*)(hist + 256) + lane_o;
            for (int er_ = 0; er_ < ((DSAREP & 16) ? 2 : 1); ++er_) {
            int base = 0, tbase = 0;
#pragma unroll 2
            for (int jj = 0; jj < jn; ++jj) { const unsigned k = DSA_KEY(jj);
                const int s0 = 2 * (jj * 64 + lane_o); const unsigned kb = k << 16;
                const bool g0 = kb >= hi, g1 = k >= hi;
                const unsigned long long m0 = __ballot(g0), m1 = __ballot(g1);
                const int p0 = base + (int)__builtin_amdgcn_mbcnt_hi((unsigned)(m0 >> 32), __builtin_amdgcn_mbcnt_lo((unsigned)m0, 0u)); base += __popcll(m0);
                const int p1 = base + (int)__builtin_amdgcn_mbcnt_hi((unsigned)(m1 >> 32), __builtin_amdgcn_mbcnt_lo((unsigned)m1, 0u)); base += __popcll(m1);
                *(g0 ? sel + p0 : dumpp) = (unsigned short)s0;
                *(g1 ? sel + p1 : dumpp) = (unsigned short)(s0 + 1);
                const bool e0 = (kb >= lo) && !g0, e1 = (k >= lo) && !g1;
                const unsigned long long t0m = __ballot(e0), t1m = __ballot(e1);
                if (t0m | t1m) {
                    const int r0 = tbase + (int)__builtin_amdgcn_mbcnt_hi((unsigned)(t0m >> 32), __builtin_amdgcn_mbcnt_lo((unsigned)t0m, 0u)); tbase += __popcll(t0m);
                    const int r1 = tbase + (int)__builtin_amdgcn_mbcnt_hi((unsigned)(t1m >> 32), __builtin_amdgcn_mbcnt_lo((unsigned)t1m, 0u)); tbase += __popcll(t1m);
                    if (e0 && r0 < need) sel[tot_gt + r0] = (unsigned short)s0;
                    if (e1 && r1 < need) sel[tot_gt + r1] = (unsigned short)(s0 + 1);
                }
            }
            }
#undef DSA_KEY
        }
#endif
        __builtin_amdgcn_sched_barrier(0); lds_barrier(); __builtin_amdgcn_sched_barrier(0);
#ifndef DSA_NO_D
        LAS unsigned char* kvb = lds + wave * 16384;
#pragma unroll 1
        for (int rr = 0; rr < ((DSAREP & 4) ? 4 : 2); ++rr) {
            const int rl = 2 * wave + (rr & 1), t = t0 + rl; const size_t q = qb + t;
            const LAS unsigned short* sel = SELL + rl * 256;
            f16x8 qfr[4];
#pragma unroll
            for (int ks = 0; ks < 4; ++ks) { f16x8 v = *(const f16x8*)(QI + q * NQI + (r16 & 7) * 128 + 32 * ks + 8 * g); if (r16 >= 8) v = (f16x8){0, 0, 0, 0, 0, 0, 0, 0}; qfr[ks] = v; }
            float m_run = -1e30f, l_run = 0.f;
            f32x4 oacc[8];
#pragma unroll
            for (int ct = 0; ct < 8; ++ct) oacc[ct] = (f32x4){0.f, 0.f, 0.f, 0.f};
            const int nch = (t < TOPK) ? (t >> 5) + 1 : 8;
            const int lrow = 8 * ((r16 >> 2) & 1) + 4 * (r16 >> 3) + (r16 & 3);
#define DSA_DMA(ch_, buf_) do { _Pragma("unroll") for (int i = 0; i < 8; ++i) { const int R = 4 * i + g; const int rr16 = R & 15; \
                const int key = 32 * (ch_) + 16 * (R >> 4) + 8 * ((rr16 >> 2) & 1) + 4 * (rr16 >> 3) + (rr16 & 3); \
                const unsigned ix = sel[key]; const int srow = (ix == 0xFFFFu) ? 0 : (int)ix; \
                const unsigned lch = (unsigned)r16 ^ ((((unsigned)R & 3u) << 2) | (((unsigned)R >> 2) & 3u)); \
                __builtin_amdgcn_global_load_lds((const unsigned*)(CKV + (qb + srow) * KVL + 8 * lch), (LAS unsigned*)(kvb + (buf_) * 8192 + i * 1024), 16, 0, 0); } } while (0)
            asm volatile("s_waitcnt vmcnt(0)" ::: "memory");
            DSA_DMA(0, 0);
#pragma unroll 1
            for (int ch = 0; ch < nch; ++ch) {
                LAS unsigned char* kb = kvb + (ch & 1) * 8192;
                if (ch + 1 < nch) { DSA_DMA(ch + 1, (ch + 1) & 1); asm volatile("s_waitcnt vmcnt(8)" ::: "memory"); }
                else asm volatile("s_waitcnt vmcnt(0)" ::: "memory");
                f32x4 lg[2];
#pragma unroll
                for (int mt = 0; mt < 2; ++mt) { lg[mt] = (f32x4){0.f, 0.f, 0.f, 0.f};
#pragma unroll
                    for (int ks = 0; ks < 4; ++ks) lg[mt] = __builtin_amdgcn_mfma_f32_16x16x32_f16(*(const LAS f16x8*)(kb + kv_off(16 * mt + lrow, 4 * ks + g)), qfr[ks], lg[mt], 0, 0, 0); }
                float cmax = -INFINITY;
#pragma unroll
                for (int mt = 0; mt < 2; ++mt) { const u32x2 pk = *(const LAS u32x2*)(sel + 32 * ch + 16 * mt + 4 * g);
#pragma unroll
                    for (int e = 0; e < 4; ++e) { const unsigned ix = ((e & 2) ? pk.y : pk.x) >> ((e & 1) * 16) & 0xFFFFu;
                        const int rel = t - (int)ix; const int rc = rel < 128 ? rel : 128;
                        const float v = (ix == 0xFFFFu) ? -INFINITY : lg[mt][e] + BL[(rc < 0 ? 0 : rc) * 8 + (r16 & 7)];
                        lg[mt][e] = v; cmax = fmaxf(cmax, v); } }
                cmax = fmaxf(cmax, __shfl_xor(cmax, 16)); cmax = fmaxf(cmax, __shfl_xor(cmax, 32));
                const float m_new = fmaxf(m_run, cmax); const float alpha = __expf(m_run - m_new); m_run = m_new;
                float ps = 0.f; f16x8 pfr;
#pragma unroll
                for (int mt = 0; mt < 2; ++mt)
#pragma unroll
                    for (int e = 0; e < 4; ++e) { const float p = __expf(lg[mt][e] - m_new); ps += p; pfr[mt * 4 + e] = (f16)p; }
                l_run = l_run * alpha + ps;
#pragma unroll
                for (int ct = 0; ct < 8; ++ct) oacc[ct] *= alpha;
                const int qq = (lane_o & 15) >> 2, pp = lane_o & 3;
                const unsigned rbase = 8 * (g & 1) + 4 * (g >> 1) + qq;
#pragma unroll
                for (int ct = 0; ct < 8; ++ct) {
                    const f16x4 v0 = tr_read16(kb + kv_off(rbase, 2 * ct + (pp >> 1)) + 8 * (pp & 1));
                    const f16x4 v1 = tr_read16(kb + kv_off(rbase + 16, 2 * ct + (pp >> 1)) + 8 * (pp & 1));
                    const f16x8 av = {v0[0], v0[1], v0[2], v0[3], v1[0], v1[1], v1[2], v1[3]};
                    oacc[ct] = __builtin_amdgcn_mfma_f32_16x16x32_f16(av, pfr, oacc[ct], 0, 0, 0);
                }
                asm volatile("s_waitcnt lgkmcnt(0)" ::: "memory");
            }
#undef DSA_DMA
            l_run += __shfl_xor(l_run, 16); l_run += __shfl_xor(l_run, 32);
            const float inv = 1.f / l_run;
            if (r16 < 8) {
#pragma unroll
                for (int ct = 0; ct < 8; ++ct) { u32x2 w; w.x = pkh(oacc[ct][0] * inv, oacc[ct][1] * inv); w.y = pkh(oacc[ct][2] * inv, oacc[ct][3] * inv);
                    *(u32x2*)(OATT + q * KOUT + r16 * 128 + 16 * ct + 4 * g) = w; }
            }
        }
#endif
    }
}

template <int CTRL> __device__ __forceinline__ float dpp_f(float x) { return __builtin_bit_cast(float, __builtin_amdgcn_update_dpp(0, __builtin_bit_cast(int, x), CTRL, 0xF, 0xF, false)); }
__device__ __forceinline__ float row16_sum(float x) { x += dpp_f<0x128>(x); x += dpp_f<0x124>(x); x += dpp_f<0x122>(x); x += dpp_f<0x121>(x); return x; }
constexpr int SCAN_TB = 32;
__device__ __forceinline__ void p7_scan(const Args& a, LAS unsigned char* lds, int vcu, int G, int wave, int lane) {
    unsigned char* ws = a.ws;
    const f16* PROJ = (const f16*)(ws + WS_PROJ); const f16* RWW = (const f16*)(ws + WS_RWW); const f16* RWA = (const f16*)(ws + WS_RWA);
    float* YRAW = (float*)(ws + WS_YRAW);
    for (int u = vcu; u < BATCH * HRW * 2; u += G) {
        const int half = u & 1, h = (u >> 1) & 7, b = u >> 4;
        const int ch = h * 64 + lane;
        const float mu_r = a.in[17][ch], mu_k = a.in[17][512 + ch], mu_v = a.in[17][1024 + ch], kkc = a.in[23][ch], kac = a.in[24][ch];
        const int rr = lane >> 4, qd = lane & 15, irow = half * 32 + wave * 4 + rr;
        float S0 = 0.f, S1 = 0.f, S2 = 0.f, S3 = 0.f;
#define SCAN_LOAD(blk_) do { _Pragma("unroll") for (int tt = 0; tt < 4; ++tt) { const int t = (blk_) * SCAN_TB + wave * 4 + tt; const size_t m = (size_t)(b << 12) + t; \
            const f16* pr = PROJ + m * IN_PAD + h * 64 + lane; \
            st_r[tt] = (float)pr[C_R]; st_k[tt] = (float)pr[C_K]; st_v[tt] = (float)pr[C_V]; \
            if (t > 0) { st_rp[tt] = (float)pr[C_R - IN_PAD]; st_kp[tt] = (float)pr[C_K - IN_PAD]; st_vp[tt] = (float)pr[C_V - IN_PAD]; } else { st_rp[tt] = 0.f; st_kp[tt] = 0.f; st_vp[tt] = 0.f; } \
            st_lw[tt] = (float)RWW[m * RW + ch]; st_av[tt] = (float)RWA[m * RW + ch]; } } while (0)
#define SCAN_WRITE(buf_) do { LAS float* base_ = (LAS float*)(lds + (buf_) * 49152); _Pragma("unroll") for (int tt = 0; tt < 4; ++tt) { const int tl = wave * 4 + tt; \
            const float rs = st_r[tt] + mu_r * (st_rp[tt] - st_r[tt]), ks = st_k[tt] + mu_k * (st_kp[tt] - st_k[tt]), vs = st_v[tt] + mu_v * (st_vp[tt] - st_v[tt]); \
            const float kkv = ks * kkc; const float nrm = sqrtf(wave_sum(kkv * kkv)); const float kkn = kkv / fmaxf(nrm, 1e-12f); \
            const float av = st_av[tt]; const float km = ks * (1.f + (av - 1.f) * kac); \
            base_[0 * 2048 + tl * 64 + lane] = rs; base_[1 * 2048 + tl * 64 + lane] = __expf(st_lw[tt]); base_[2 * 2048 + tl * 64 + lane] = km; \
            base_[3 * 2048 + tl * 64 + lane] = vs; base_[4 * 2048 + tl * 64 + lane] = -kkn; base_[5 * 2048 + tl * 64 + lane] = kkn * av; } } while (0)
        float st_r[4], st_k[4], st_v[4], st_rp[4], st_kp[4], st_vp[4], st_lw[4], st_av[4];
        __syncthreads();
        SCAN_LOAD(0); SCAN_WRITE(0);
        constexpr int NBLK = SEQ / SCAN_TB;
        for (int blk = 0; blk < NBLK; ++blk) {
            __syncthreads();
            if (blk + 1 < NBLK) SCAN_LOAD(blk + 1);
            const LAS float* base = (const LAS float*)(lds + (blk & 1) * 49152);
            for (int tl = 0; tl < SCAN_TB; ++tl) {
                const f32x4 r4 = *(const LAS f32x4*)(base + 0 * 2048 + tl * 64 + 4 * qd), w4 = *(const LAS f32x4*)(base + 1 * 2048 + tl * 64 + 4 * qd), k4 = *(const LAS f32x4*)(base + 2 * 2048 + tl * 64 + 4 * qd);
                const f32x4 a4 = *(const LAS f32x4*)(base + 4 * 2048 + tl * 64 + 4 * qd), b4 = *(const LAS f32x4*)(base + 5 * 2048 + tl * 64 + 4 * qd);
                const float vi = base[3 * 2048 + tl * 64 + irow];
                float sa = S0 * a4[0] + S1 * a4[1] + S2 * a4[2] + S3 * a4[3];
                sa = row16_sum(sa);
                S0 = S0 * w4[0] + sa * b4[0] + vi * k4[0]; S1 = S1 * w4[1] + sa * b4[1] + vi * k4[1]; S2 = S2 * w4[2] + sa * b4[2] + vi * k4[2]; S3 = S3 * w4[3] + sa * b4[3] + vi * k4[3];
                float y = S0 * r4[0] + S1 * r4[1] + S2 * r4[2] + S3 * r4[3];
                y = row16_sum(y);
                if (qd == 0) YRAW[((size_t)(b << 12) + blk * SCAN_TB + tl) * RW + h * 64 + irow] = y;
            }
            if (blk + 1 < NBLK) SCAN_WRITE((blk + 1) & 1);
        }
        __syncthreads();
    }
}

__device__ __forceinline__ void p8_rwkv_post(const Args& a, int vcu, int G, int wave, int lane) {
    unsigned char* ws = a.ws;
    const f16* PROJ = (const f16*)(ws + WS_PROJ); const f16* RWA = (const f16*)(ws + WS_RWA); const f16* RWG = (const f16*)(ws + WS_RWG);
    const float* YRAW = (const float*)(ws + WS_YRAW); f16* OATT = (f16*)(ws + WS_OATT);
    const int gw = vcu * NWAVES + wave, NGW = G * NWAVES;
    for (int it = gw; it < MTOK * HRW; it += NGW) {
        const int m = it >> 3, h = it & 7, ch = h * 64 + lane, t = m & (SEQ - 1);
        const f16* pr = PROJ + (size_t)m * IN_PAD + ch;
        float r = (float)pr[C_R], k = (float)pr[C_K], v = (float)pr[C_V], rp = 0.f, kp = 0.f, vp = 0.f;
        if (t > 0) { rp = (float)pr[C_R - IN_PAD]; kp = (float)pr[C_K - IN_PAD]; vp = (float)pr[C_V - IN_PAD]; }
        const float rs = r + a.in[17][ch] * (rp - r), ks = k + a.in[17][512 + ch] * (kp - k), vs = v + a.in[17][1024 + ch] * (vp - v);
        const float av = (float)RWA[(size_t)m * RW + ch];
        const float km = ks * (1.f + (av - 1.f) * a.in[24][ch]);
        const float y = YRAW[(size_t)m * RW + ch];
        const float mean = wave_sum(y) * (1.f / 64.f); const float dy = y - mean;
        const float var = wave_sum(dy * dy) * (1.f / 64.f);
        const float yn = dy * rsqrtf(var + GN_EPS) * a.in[26][ch] + a.in[27][ch];
        const float bonus = wave_sum(rs * km * a.in[25][ch]) * vs;
        OATT[(size_t)m * KOUT + 1024 + ch] = (f16)((yn + bonus) * (float)RWG[(size_t)m * RW + ch]);
    }
}

typedef short bf16x8 __attribute__((ext_vector_type(8)));
typedef _Float16 f16x4v __attribute__((ext_vector_type(4)));
__device__ __forceinline__ unsigned f2bf(float f) { unsigned u = __builtin_bit_cast(unsigned, f); return (u + 0x7fffu + ((u >> 16) & 1u)) >> 16; }
__device__ __forceinline__ unsigned pkb(float lo, float hi) { unsigned r; asm("v_cvt_pk_bf16_f32 %0, %1, %2" : "=v"(r) : "v"(lo), "v"(hi)); return r; }
constexpr int XP = 144;
constexpr int XD_OFF = 0, XA_OFF = 9216, XG_OFF = 18432, XG_P = 336;
constexpr int LAB_OFF = 0, LAK_OFF = 9216, LRB_OFF = 18432, LRK_OFF = 27648;
constexpr int AB_OFF = 39936, RB_OFF = AB_OFF + 9216, BB_OFF = RB_OFF + 9216, KB_OFF = BB_OFF + 9216;
constexpr int TT_OFF = 39936, M1T_OFF = TT_OFF + 9216, A2T_OFF = M1T_OFF + 9216, U1T_OFF = A2T_OFF + 9216;
constexpr int AH_OFF = 76800, VH_OFF = AH_OFF + 9216, BP_OFF = VH_OFF + 9216, KP_OFF = BP_OFF + 9216, RH_OFF = KP_OFF + 9216;
constexpr int NRM_OFF = 122880, CUMB_OFF = NRM_OFF + 512, XCONST_OFF = CUMB_OFF + 1024;
constexpr size_t WS_WDT = 28 * MiB, WS_WAT = WS_WDT + 65536, WS_WGT = WS_WAT + 65536;
constexpr size_t WS_RWP = 32 * MiB, WS_RWQ = 64 * MiB, WS_RWR2 = 408 * MiB, WS_RWY1 = 440 * MiB, WS_RWS0 = 472 * MiB, WS_BON = 364 * MiB;
constexpr int NUNIT = BATCH * 64 * HRW;

__device__ __forceinline__ f16x8 rd_row(LAS unsigned char* base, int pitch, int row, int col) { return *(const LAS f16x8*)(base + row * pitch + col * 2); }
__device__ __forceinline__ bf16x8 rd_rowb(LAS unsigned char* base, int pitch, int row, int col) { return *(const LAS bf16x8*)(base + row * pitch + col * 2); }
__device__ __forceinline__ f16x8 rd_tr(LAS unsigned char* base, int k0, int c0, int g, int qq, int pp) {
    const f16x4 v0 = tr_read16(base + (k0 + 8 * g + qq) * XP + (c0 + 4 * pp) * 2), v1 = tr_read16(base + (k0 + 8 * g + 4 + qq) * XP + (c0 + 4 * pp) * 2);
    return (f16x8){v0[0], v0[1], v0[2], v0[3], v1[0], v1[1], v1[2], v1[3]};
}
__device__ __forceinline__ void wr4h(LAS unsigned char* p, const f32x4& v) { u32x2 w; w.x = pkh(v[0], v[1]); w.y = pkh(v[2], v[3]); *(LAS u32x2*)p = w; }
__device__ __forceinline__ float dpp_shr_f(float x, int) { return x; }
template <int CTRL> __device__ __forceinline__ float dpp_z(float x) { return __builtin_bit_cast(float, __builtin_amdgcn_update_dpp(0, __builtin_bit_cast(int, x), CTRL, 0xF, 0xF, true)); }
__device__ __forceinline__ float row16_incl_scan(float x) { x += dpp_z<0x111>(x); x += dpp_z<0x112>(x); x += dpp_z<0x114>(x); x += dpp_z<0x118>(x); return x; }
#define MFMA_H(a, b, c) __builtin_amdgcn_mfma_f32_16x16x32_f16((a), (b), (c), 0, 0, 0)
#define MFMA_B(a, b, c) __builtin_amdgcn_mfma_f32_16x16x32_bf16((a), (b), (c), 0, 0, 0)
#define MFMA_H16(a, b, c) __builtin_amdgcn_mfma_f32_16x16x16f16((a), (b), (c), 0, 0, 0)
__device__ __forceinline__ f16x4 cvt4h(const f32x4& v) { return (f16x4){(f16)v[0], (f16)v[1], (f16)v[2], (f16)v[3]}; }
__device__ __forceinline__ f32x4 cvt4f(const f16x4& v) { return (f32x4){(float)v[0], (float)v[1], (float)v[2], (float)v[3]}; }

__device__ __forceinline__ void p7x_chunks(const Args& a, LAS unsigned char* lds, int vcu, int G, int tid, int wave, int lane) {
    unsigned char* ws = a.ws;
    const f16* PROJ = (const f16*)(ws + WS_PROJ);
    const f16* WDT = (const f16*)(ws + WS_WDT); const f16* WAT = (const f16*)(ws + WS_WAT); const f16* WGT = (const f16*)(ws + WS_WGT);
    f16* RWG = (f16*)(ws + WS_RWG); f16* RWP = (f16*)(ws + WS_RWP); f16* RWQ = (f16*)(ws + WS_RWQ); f16* RWR2 = (f16*)(ws + WS_RWR2); f16* RWY1 = (f16*)(ws + WS_RWY1);
    float* BON = (float*)(ws + WS_BON);
    const float* mu = a.in[17];
    const f32x4 z4 = {0.f, 0.f, 0.f, 0.f};
    const bool bal = (G == 256); const int bxx = blockIdx.x;
    const int nit = bal ? 16 : (NUNIT + G - 1) / G;
#define X_UNIT(itx_) (bal ? ((((bxx & 7) * 64 + (((bxx >> 3) + 32 * (itx_)) >> 3)) * 8 + (((bxx >> 3) + 32 * (itx_)) & 7))) : (vcu + (itx_) * G))
    f16x4 rv0[9], rv1c, rv1p, prc[2], pkc[2], pvc[2], prp[2], pkp[2], pvp[2];
    f16x8 wfd[2][2], wfa[2][2], wfg[2][5];
    int h_tab = -1;
#define X_PREFETCH(u_) do { int lp = lane; asm volatile("" : "+v"(lp)); const int h_ = (u_) & 7, c_ = ((u_) >> 3) & 63, b_ = (u_) >> 9; const size_t m0_ = (size_t)(b_ << 12) + c_ * 64; \
        _Pragma("unroll") for (int i = 0; i < 9; ++i) { const int t_ = 8 * wave + i - 1; const bool ok_ = (t_ >= 0 || c_ > 0); const f16* rowp = PROJ + (m0_ + t_) * IN_PAD + C_WD; \
            rv0[i] = (f16x4){0, 0, 0, 0}; if (ok_) rv0[i] = *(const f16x4*)(rowp + 4 * lp); } \
        { const int t1_ = 8 * wave + (lp >> 3); const f16* rp1 = PROJ + (m0_ + t1_) * IN_PAD + C_WD + 256 + 4 * (lp & 7); rv1c = *(const f16x4*)rp1; rv1p = (f16x4){0, 0, 0, 0}; if (t1_ > 0 || c_ > 0) rv1p = *(const f16x4*)(rp1 - IN_PAD); } \
        _Pragma("unroll") for (int ci = 0; ci < 2; ++ci) { const int chr_ = h_ * 64 + 16 * (2 * (wave >> 2) + ci) + (lp & 15); \
            _Pragma("unroll") for (int ks = 0; ks < 2; ++ks) { wfd[ci][ks] = *(const f16x8*)(WDT + (size_t)chr_ * 64 + 32 * ks + 8 * (lp >> 4)); wfa[ci][ks] = *(const f16x8*)(WAT + (size_t)chr_ * 64 + 32 * ks + 8 * (lp >> 4)); } \
            _Pragma("unroll") for (int ks = 0; ks < 5; ++ks) wfg[ci][ks] = *(const f16x8*)(WGT + (size_t)chr_ * 192 + 32 * ks + 8 * (lp >> 4)); } \
        const int t2_ = 16 * (wave & 3) + (lp & 15); const size_t m_ = m0_ + t2_; \
        _Pragma("unroll") for (int ci = 0; ci < 2; ++ci) { const int ch_ = h_ * 64 + 16 * (2 * (wave >> 2) + ci) + 4 * (lp >> 4); \
            prc[ci] = *(const f16x4*)(PROJ + m_ * IN_PAD + C_R + ch_); pkc[ci] = *(const f16x4*)(PROJ + m_ * IN_PAD + C_K + ch_); pvc[ci] = *(const f16x4*)(PROJ + m_ * IN_PAD + C_V + ch_); \
            prp[ci] = (f16x4){0, 0, 0, 0}; pkp[ci] = (f16x4){0, 0, 0, 0}; pvp[ci] = (f16x4){0, 0, 0, 0}; \
            if ((c_ * 64 + t2_) != 0) { prp[ci] = *(const f16x4*)(PROJ + (m_ - 1) * IN_PAD + C_R + ch_); pkp[ci] = *(const f16x4*)(PROJ + (m_ - 1) * IN_PAD + C_K + ch_); pvp[ci] = *(const f16x4*)(PROJ + (m_ - 1) * IN_PAD + C_V + ch_); } } } while (0)
    { const int u0 = X_UNIT(0); if (u0 < NUNIT) X_PREFETCH(u0); }
#pragma unroll 1
    for (int itx = 0; itx < nit; ++itx) {
        const int u = X_UNIT(itx); if (u >= NUNIT) break;
        const int un = (itx + 1 < nit) ? X_UNIT(itx + 1) : NUNIT;
        int lane_o = lane; asm volatile("" : "+v"(lane_o));
        const int r16 = lane_o & 15, g = lane_o >> 4, qq = r16 >> 2, pp = lane_o & 3;
        const int h = u & 7, c = (u >> 3) & 63, b = u >> 9;
        const size_t m0 = (size_t)(b << 12) + c * 64;
        lds_barrier();
        if (h != h_tab) { h_tab = h;
            if (tid < 64) { const int ch = h * 64 + tid; LAS float* ct = (LAS float*)(lds + XCONST_OFF) + tid;
                ct[0] = mu[ch]; ct[64] = mu[512 + ch]; ct[128] = mu[1024 + ch]; ct[192] = a.in[18][ch]; ct[256] = a.in[20][ch]; ct[320] = a.in[23][ch]; ct[384] = a.in[24][ch]; ct[448] = a.in[25][ch]; } }
        {
            const f32x4 mu0 = *(const f32x4*)(mu + 1536 + 4 * lane_o); const f32x4 mu1 = *(const f32x4*)(mu + 1536 + 256 + 4 * (lane_o & 7));
            const float kf = lane_o < 16 ? 2.f : 1.f; const bool is_t = lane_o < 16, is_id = (lane_o >= 16 && lane_o < 32);
            LAS unsigned char* d0 = is_t ? lds + XD_OFF + 8 * lane_o : is_id ? lds + XA_OFF + 8 * (lane_o - 16) : lds + XG_OFF + 8 * (lane_o - 32);
            const int p0 = (lane_o < 32) ? XP : XG_P;
#pragma unroll
            for (int i = 0; i < 8; ++i) { const int t = 8 * wave + i; float o[4];
#pragma unroll
                for (int e = 0; e < 4; ++e) { const float cu = (float)rv0[i + 1][e], pv = (float)rv0[i][e]; const float x = cu + mu0[e] * (pv - cu);
                    const float sg = __builtin_amdgcn_rcpf(1.f + __expf(-kf * x)); o[e] = is_t ? 2.f * sg - 1.f : is_id ? x : sg; }
                u32x2 w; w.x = pkh(o[0], o[1]); w.y = pkh(o[2], o[3]); *(LAS u32x2*)(d0 + t * p0) = w; }
            {
                float o1[4];
#pragma unroll
                for (int e = 0; e < 4; ++e) { const float cu1 = (float)rv1c[e], pv1 = (float)rv1p[e]; const float x1 = cu1 + mu1[e] * (pv1 - cu1); o1[e] = __builtin_amdgcn_rcpf(1.f + __expf(-x1)); }
                u32x2 w1; w1.x = pkh(o1[0], o1[1]); w1.y = pkh(o1[2], o1[3]); *(LAS u32x2*)(lds + XG_OFF + (8 * wave + (lane_o >> 3)) * XG_P + (128 + 4 * (lane_o & 7)) * 2) = w1; }
        }
        lds_barrier();
        const int tb = wave & 3, cth = wave >> 2;
        const int t = 16 * tb + r16; const size_t m = m0 + t;
        f32x4 dA[2], aA[2], gA[2];
#pragma unroll
        for (int ci = 0; ci < 2; ++ci) {
            dA[ci] = z4; aA[ci] = z4; gA[ci] = z4;
#pragma unroll
            for (int ks = 0; ks < 2; ++ks) {
                dA[ci] = MFMA_H(wfd[ci][ks], rd_row(lds + XD_OFF, XP, t, 32 * ks + 8 * g), dA[ci]);
                aA[ci] = MFMA_H(wfa[ci][ks], rd_row(lds + XA_OFF, XP, t, 32 * ks + 8 * g), aA[ci]); }
#pragma unroll
            for (int ks = 0; ks < 5; ++ks) gA[ci] = MFMA_H(wfg[ci][ks], rd_row(lds + XG_OFF, XG_P, t, 32 * ks + 8 * g), gA[ci]);
        }
        float lwv[2][4], asg[2][4], rs[2][4], kp[2][4], vs[2][4], kkv[2][4], cl[2][4];
        float pn = 0.f, prk = 0.f;
#pragma unroll
        for (int ci = 0; ci < 2; ++ci) {
            const int chl = 16 * (2 * cth + ci) + 4 * g, ch = h * 64 + chl;
            const f16x4 rc = prc[ci], kc = pkc[ci], vc = pvc[ci], rp = prp[ci], kq = pkp[ci], vp = pvp[ci];
            const LAS float* ct = (const LAS float*)(lds + XCONST_OFF) + chl;
            const f32x4 mur = *(const LAS f32x4*)(ct), muk = *(const LAS f32x4*)(ct + 64), muv = *(const LAS f32x4*)(ct + 128);
            const f32x4 w0 = *(const LAS f32x4*)(ct + 192), a0 = *(const LAS f32x4*)(ct + 256), kkc = *(const LAS f32x4*)(ct + 320), kac = *(const LAS f32x4*)(ct + 384), rkc = *(const LAS f32x4*)(ct + 448);
            float gl[4];
#pragma unroll
            for (int e = 0; e < 4; ++e) {
                const float z = -(w0[e] + dA[ci][e]); const float sp = fmaxf(z, 0.f) + __logf(1.f + __expf(-fabsf(z)));
                lwv[ci][e] = -__expf(-sp - 0.5f);
                asg[ci][e] = sigmoidf_(a0[e] + aA[ci][e]); gl[e] = gA[ci][e];
                rs[ci][e] = (float)rc[e] + mur[e] * ((float)rp[e] - (float)rc[e]);
                const float ks_ = (float)kc[e] + muk[e] * ((float)kq[e] - (float)kc[e]);
                vs[ci][e] = (float)vc[e] + muv[e] * ((float)vp[e] - (float)vc[e]);
                kkv[ci][e] = ks_ * kkc[e]; pn += kkv[ci][e] * kkv[ci][e];
                kp[ci][e] = ks_ * (1.f + (asg[ci][e] - 1.f) * kac[e]);
                prk += rs[ci][e] * kp[ci][e] * rkc[e];
                cl[ci][e] = row16_incl_scan(lwv[ci][e]);
                if (r16 == 15) ((LAS float*)(lds + CUMB_OFF))[tb * 64 + chl + e] = cl[ci][e];
            }
            u32x2 gw; gw.x = pkh(gl[0], gl[1]); gw.y = pkh(gl[2], gl[3]); *(u32x2*)(RWG + m * RW + ch) = gw;
        }
        pn += __shfl_xor(pn, 16); pn += __shfl_xor(pn, 32); prk += __shfl_xor(prk, 16); prk += __shfl_xor(prk, 32);
        if (g == 0) { ((LAS float*)(lds + NRM_OFF))[t * 2 + cth] = pn; BON[((size_t)u * 64 + t) * 2 + cth] = prk; }
        lds_barrier();
        {
            const float nrm = sqrtf(((LAS float*)(lds + NRM_OFF))[t * 2] + ((LAS float*)(lds + NRM_OFF))[t * 2 + 1]); const float inrm = __builtin_amdgcn_rcpf(fmaxf(nrm, 1e-12f));
#pragma unroll
            for (int ci = 0; ci < 2; ++ci) {
                const int chl = 16 * (2 * cth + ci) + 4 * g;
                float Ab[4], Rb[4], Bb[4], Kb[4], Bp[4], Kp[4];
                const LAS float* cbp = (const LAS float*)(lds + CUMB_OFF) + chl;
                const f32x4 cb0 = *(const LAS f32x4*)(cbp), cb1 = *(const LAS f32x4*)(cbp + 64), cb2 = *(const LAS f32x4*)(cbp + 128), cb3 = *(const LAS f32x4*)(cbp + 192);
#pragma unroll
                for (int e = 0; e < 4; ++e) {
                    const float b0 = cb0[e], b1 = cb1[e], b2 = cb2[e], b3 = cb3[e];
                    const float pre = (tb > 0 ? b0 : 0.f) + (tb > 1 ? b1 : 0.f) + (tb > 2 ? b2 : 0.f);
                    const float cum = cl[ci][e] + pre, cumC = (b0 + b1) + (b2 + b3);
                    const float kkn = kkv[ci][e] * inrm, av = -kkn, bv = kkn * asg[ci][e];
                    const float eg = __expf(cum), egi = __expf(-cum), egc = __expf(cumC - cum);
                    Ab[e] = av * __expf(cum - lwv[ci][e]); Rb[e] = rs[ci][e] * eg; Bb[e] = bv * egi; Kb[e] = kp[ci][e] * egi; Bp[e] = bv * egc; Kp[e] = kp[ci][e] * egc;
                }
                const int ro = t * XP + chl * 2;
                u32x2 w;
                w.x = pkb(Ab[0], Ab[1]); w.y = pkb(Ab[2], Ab[3]); *(LAS u32x2*)(lds + AB_OFF + ro) = w;
                w.x = pkb(Rb[0], Rb[1]); w.y = pkb(Rb[2], Rb[3]); *(LAS u32x2*)(lds + RB_OFF + ro) = w;
                w.x = pkb(Bb[0], Bb[1]); w.y = pkb(Bb[2], Bb[3]); *(LAS u32x2*)(lds + BB_OFF + ro) = w;
                w.x = pkb(Kb[0], Kb[1]); w.y = pkb(Kb[2], Kb[3]); *(LAS u32x2*)(lds + KB_OFF + ro) = w;
                w.x = pkh(Ab[0], Ab[1]); w.y = pkh(Ab[2], Ab[3]); *(LAS u32x2*)(lds + AH_OFF + ro) = w;
                w.x = pkh(Rb[0], Rb[1]); w.y = pkh(Rb[2], Rb[3]); *(LAS u32x2*)(lds + RH_OFF + ro) = w;
                w.x = pkh(vs[ci][0], vs[ci][1]); w.y = pkh(vs[ci][2], vs[ci][3]); *(LAS u32x2*)(lds + VH_OFF + ro) = w;
                w.x = pkh(Bp[0], Bp[1]); w.y = pkh(Bp[2], Bp[3]); *(LAS u32x2*)(lds + BP_OFF + ro) = w;
                w.x = pkh(Kp[0], Kp[1]); w.y = pkh(Kp[2], Kp[3]); *(LAS u32x2*)(lds + KP_OFF + ro) = w;
            }
        }
        lds_barrier();
#pragma unroll 1
        for (int k = 0; k < 5; ++k) {
            const int idx = wave + 8 * k, prod = idx / 10, rem = idx - prod * 10;
            const int tb1 = rem >= 6 ? 3 : rem >= 3 ? 2 : rem >= 1 ? 1 : 0, ub = rem - (tb1 * (tb1 + 1)) / 2;
            LAS unsigned char* X = lds + ((prod < 2) ? AB_OFF : RB_OFF); LAS unsigned char* Y = lds + ((prod & 1) ? KB_OFF : BB_OFF);
            f32x4 acc = z4;
#pragma unroll
            for (int ks = 0; ks < 2; ++ks) acc = MFMA_B(rd_rowb(Y, XP, 16 * ub + r16, 32 * ks + 8 * g), rd_rowb(X, XP, 16 * tb1 + r16, 32 * ks + 8 * g), acc);
            const int tt = 16 * tb1 + r16, tau0 = 16 * ub + 4 * g; const int lim = (prod < 2) ? tt : tt + 1;
#pragma unroll
            for (int e = 0; e < 4; ++e) if (tau0 + e >= lim) acc[e] = 0.f;
            wr4h(lds + LAB_OFF + prod * 9216 + tt * XP + tau0 * 2, acc);
        }
#pragma unroll 1
        for (int k = 0; k < 3; ++k) {
            const int idx = wave + 8 * k, prod = idx / 6, rem = idx - prod * 6;
            const int tb1 = rem >= 5 ? 2 : rem >= 3 ? 1 : 0, ub = (rem >= 5) ? 3 : (rem >= 3) ? rem - 1 : rem + 1;
            wr4h(lds + LAB_OFF + prod * 9216 + (16 * tb1 + r16) * XP + (16 * ub + 4 * g) * 2, z4);
        }
        lds_barrier();
        if (wave == 0) {
            LAS unsigned char* L = lds + LAB_OFF; LAS unsigned char* TT = lds + TT_OFF;
            f32x4 TB[4][4]; f16x4 TAh[4];
            float idn[4];
#pragma unroll
            for (int e = 0; e < 4; ++e) idn[e] = (r16 == 4 * g + e) ? 1.f : 0.f;
#pragma unroll
            for (int i = 0; i < 4; ++i) {
                f16x4 XA = *(const LAS f16x4*)(L + (16 * i + r16) * XP + (16 * i + 4 * g) * 2);
                f16x4 XB = tr_read16(L + (16 * i + 4 * g + qq) * XP + (16 * i + 4 * pp) * 2);
                f32x4 TAf, TBf;
#pragma unroll
                for (int e = 0; e < 4; ++e) { TAf[e] = idn[e] + (float)XA[e]; TBf[e] = idn[e] + (float)XB[e]; }
#pragma unroll
                for (int lv = 0; lv < 3; ++lv) {
                    const f32x4 X2B = MFMA_H16(XA, XB, z4), X2A = MFMA_H16(XB, XA, z4);
                    XA = cvt4h(X2A); XB = cvt4h(X2B);
                    const f16x4 ta = cvt4h(TAf);
                    TBf = MFMA_H16(ta, XB, TBf); TAf = MFMA_H16(XB, ta, TAf);
                }
                TB[i][i] = TBf; TAh[i] = cvt4h(TAf);
            }
#pragma unroll
            for (int d = 1; d < 4; ++d)
#pragma unroll
                for (int j = 0; j + d < 4; ++j) { const int i = j + d;
                    f32x4 M = z4;
#pragma unroll
                    for (int kq2 = j; kq2 < i; ++kq2) M = MFMA_H16(*(const LAS f16x4*)(L + (16 * i + r16) * XP + (16 * kq2 + 4 * g) * 2), cvt4h(TB[kq2][j]), M);
                    TB[i][j] = MFMA_H16(TAh[i], cvt4h(M), z4);
                }
#pragma unroll
            for (int i = 0; i < 4; ++i)
#pragma unroll
                for (int j = 0; j < 4; ++j) wr4h(TT + (16 * j + r16) * XP + (16 * i + 4 * g) * 2, (j <= i) ? TB[i][j] : z4);
        } else {
#pragma unroll 1
            for (int idx = wave - 1; idx < 16; idx += 7) { const int tb1 = idx >> 2, ib = idx & 3;
                f32x4 acc = z4;
#pragma unroll
                for (int ks = 0; ks < 2; ++ks) acc = MFMA_H(rd_row(lds + LAK_OFF, XP, 16 * tb1 + r16, 32 * ks + 8 * g), rd_tr(lds + VH_OFF, 32 * ks, 16 * ib, g, qq, pp), acc);
                wr4h(lds + M1T_OFF + (16 * ib + r16) * XP + (16 * tb1 + 4 * g) * 2, acc);
            }
        }
        lds_barrier();
#pragma unroll 1
        for (int k = 0; k < 4; ++k) {
            const int idx = wave + 8 * k, which = idx >> 4, tb1 = (idx >> 2) & 3, nb = idx & 3;
            f32x4 acc = z4;
#pragma unroll
            for (int ks = 0; ks < 2; ++ks) {
                const f16x8 af = rd_tr(lds + TT_OFF, 32 * ks, 16 * tb1, g, qq, pp);
                const f16x8 bf = which ? rd_row(lds + M1T_OFF, XP, 16 * nb + r16, 32 * ks + 8 * g) : rd_tr(lds + AH_OFF, 32 * ks, 16 * nb, g, qq, pp);
                acc = MFMA_H(af, bf, acc);
            }
            wr4h(lds + (which ? U1T_OFF : A2T_OFF) + (16 * nb + r16) * XP + (16 * tb1 + 4 * g) * 2, acc);
        }
        lds_barrier();
        if (un < NUNIT) X_PREFETCH(un);
#pragma unroll 1
        for (int k = 0; k < 8; ++k) {
            const int idx = wave + 8 * k, kind = idx >> 4, a4 = (idx >> 2) & 3, b4 = idx & 3;
            f32x4 acc = z4;
            if (kind == 0) {
#pragma unroll
                for (int ks = 0; ks < 2; ++ks) acc = MFMA_H(rd_row(lds + A2T_OFF, XP, 16 * a4 + r16, 32 * ks + 8 * g), rd_tr(lds + BP_OFF, 32 * ks, 16 * b4, g, qq, pp), acc);
                if (a4 == b4) { const LAS float* cb = (const LAS float*)(lds + CUMB_OFF) + 16 * b4 + r16; const float gC = __expf((cb[0] + cb[64]) + (cb[128] + cb[192]));
#pragma unroll
                    for (int e = 0; e < 4; ++e) if (4 * g + e == r16) acc[e] += gC; }
                u32x2 w; w.x = pkh(acc[0], acc[1]); w.y = pkh(acc[2], acc[3]);
                *(u32x2*)(RWP + (size_t)u * 4096 + ((b4 * 2 + (a4 >> 1)) * 64 + lane_o) * 8 + (a4 & 1) * 4) = w;
            } else if (kind == 1) {
#pragma unroll
                for (int ks = 0; ks < 2; ++ks) { acc = MFMA_H(rd_tr(lds + BP_OFF, 32 * ks, 16 * a4, g, qq, pp), rd_row(lds + U1T_OFF, XP, 16 * b4 + r16, 32 * ks + 8 * g), acc);
                    acc = MFMA_H(rd_tr(lds + KP_OFF, 32 * ks, 16 * a4, g, qq, pp), rd_tr(lds + VH_OFF, 32 * ks, 16 * b4, g, qq, pp), acc); }
                u32x2 w; w.x = pkh(acc[0], acc[1]); w.y = pkh(acc[2], acc[3]);
                *(u32x2*)(RWQ + (size_t)u * 4096 + ((b4 * 4 + a4) * 64 + lane_o) * 4) = w;
            } else if (kind == 2) {
                { const f16x4 rh4 = *(const LAS f16x4*)(lds + RH_OFF + (16 * b4 + r16) * XP + (16 * a4 + 4 * g) * 2); acc = cvt4f(rh4); }
#pragma unroll
                for (int ks = 0; ks < 2; ++ks) acc = MFMA_H(rd_row(lds + A2T_OFF, XP, 16 * a4 + r16, 32 * ks + 8 * g), rd_row(lds + LRB_OFF, XP, 16 * b4 + r16, 32 * ks + 8 * g), acc);
                u32x2 w; w.x = pkh(acc[0], acc[1]); w.y = pkh(acc[2], acc[3]);
                *(u32x2*)(RWR2 + (size_t)u * 4096 + (16 * b4 + r16) * 64 + 16 * a4 + 4 * g) = w;
            } else {
#pragma unroll
                for (int ks = 0; ks < 2; ++ks) { acc = MFMA_H(rd_row(lds + U1T_OFF, XP, 16 * a4 + r16, 32 * ks + 8 * g), rd_row(lds + LRB_OFF, XP, 16 * b4 + r16, 32 * ks + 8 * g), acc);
                    acc = MFMA_H(rd_tr(lds + VH_OFF, 32 * ks, 16 * a4, g, qq, pp), rd_row(lds + LRK_OFF, XP, 16 * b4 + r16, 32 * ks + 8 * g), acc); }
                u32x2 w; w.x = pkh(acc[0], acc[1]); w.y = pkh(acc[2], acc[3]);
                *(u32x2*)(RWY1 + (size_t)u * 4096 + ((a4 * 4 + b4) * 64 + lane_o) * 4) = w;
            }
        }
    }
}

#undef X_UNIT
#undef X_PREFETCH
struct ChBuf { f16x8 p[4][2]; u32x2 q[4]; };
__device__ __forceinline__ void p7y_chain(const Args& a, int bx0, int G, int wave, int lane) {
    unsigned char* ws = a.ws;
    const f16* RWP = (const f16*)(ws + WS_RWP); const f16* RWQ = (const f16*)(ws + WS_RWQ); f16* RWS0 = (f16*)(ws + WS_RWS0);
    if (wave != 0) return;
#pragma unroll 1
    for (int bx = bx0; bx < 256; bx += G) {
    const int r16 = lane & 15, g = lane >> 4;
    const int b = bx & 7, rest = bx >> 3, h = rest >> 2, it = rest & 3;
    f32x4 S[4];
#pragma unroll
    for (int mt = 0; mt < 4; ++mt) S[mt] = (f32x4){0.f, 0.f, 0.f, 0.f};
    ChBuf B0, B1, B2, B3;
#define CH_LOAD(BUF, c_) do { const size_t uu = ((size_t)(b * 64 + (c_)) * 8 + h); \
        _Pragma("unroll") for (int mo = 0; mo < 4; ++mo) { BUF.q[mo] = *(const u32x2*)(RWQ + uu * 4096 + ((it * 4 + mo) * 64 + lane) * 4); \
            _Pragma("unroll") for (int ks = 0; ks < 2; ++ks) BUF.p[mo][ks] = *(const f16x8*)(RWP + uu * 4096 + ((mo * 2 + ks) * 64 + lane) * 8); } } while (0)
#define CH_STEP(BUF, c_) do { const size_t uu = ((size_t)(b * 64 + (c_)) * 8 + h); f16x8 bfr[2]; \
        _Pragma("unroll") for (int mt = 0; mt < 4; ++mt) { u32x2 w; w.x = pkh(S[mt][0], S[mt][1]); w.y = pkh(S[mt][2], S[mt][3]); \
            *(u32x2*)(RWS0 + uu * 4096 + (16 * it + r16) * 64 + 16 * mt + 4 * g) = w; const f16x4 hv = __builtin_bit_cast(f16x4, w); \
            bfr[mt >> 1][(mt & 1) * 4 + 0] = hv[0]; bfr[mt >> 1][(mt & 1) * 4 + 1] = hv[1]; bfr[mt >> 1][(mt & 1) * 4 + 2] = hv[2]; bfr[mt >> 1][(mt & 1) * 4 + 3] = hv[3]; } \
        _Pragma("unroll") for (int mo = 0; mo < 4; ++mo) { f32x4 n_ = cvt4f(__builtin_bit_cast(f16x4, BUF.q[mo])); \
            _Pragma("unroll") for (int ks = 0; ks < 2; ++ks) n_ = MFMA_H(BUF.p[mo][ks], bfr[ks], n_); S[mo] = n_; } \
        if ((c_) + 4 < 64) CH_LOAD(BUF, (c_) + 4); } while (0)
    CH_LOAD(B0, 0); CH_LOAD(B1, 1); CH_LOAD(B2, 2); CH_LOAD(B3, 3);
#pragma unroll 1
    for (int c = 0; c < 64; c += 4) { CH_STEP(B0, c); CH_STEP(B1, c + 1); CH_STEP(B2, c + 2); CH_STEP(B3, c + 3); }
    }
#undef CH_LOAD
#undef CH_STEP
}

__device__ __forceinline__ void p8z_out(const Args& a, int vcu, int G, int wave, int lane) {
    unsigned char* ws = a.ws;
    const f16* PROJ = (const f16*)(ws + WS_PROJ); const f16* RWG = (const f16*)(ws + WS_RWG);
    const f16* RWR2 = (const f16*)(ws + WS_RWR2); const f16* RWY1 = (const f16*)(ws + WS_RWY1); const f16* RWS0 = (const f16*)(ws + WS_RWS0);
    const float* BON = (const float*)(ws + WS_BON); f16* OATT = (f16*)(ws + WS_OATT);
    const int gw = vcu * NWAVES + wave, NGW = G * NWAVES;
    const bool bal = (G == 256); const int bxx = blockIdx.x;
    const int nit = bal ? 2 : (NUNIT + NGW - 1) / NGW;
#pragma unroll 1
    for (int itx = 0; itx < nit; ++itx) {
        int u;
        if (bal) { const int idx = (bxx >> 3) * 8 + wave + 256 * itx; u = (((bxx & 7) * 64 + (idx >> 3)) * 8 + (idx & 7)); } else { u = gw + itx * NGW; if (u >= NUNIT) break; }
        int lane_o = lane; asm volatile("" : "+v"(lane_o));
        const int r16 = lane_o & 15, g = lane_o >> 4;
        const int h = u & 7, c = (u >> 3) & 63, b = u >> 9;
        const size_t m0 = (size_t)(b << 12) + c * 64;
        f32x4 acc[4][4];
#pragma unroll
        for (int mt = 0; mt < 4; ++mt)
#pragma unroll
            for (int nt = 0; nt < 4; ++nt) acc[mt][nt] = cvt4f(*(const f16x4*)(RWY1 + (size_t)u * 4096 + ((mt * 4 + nt) * 64 + lane_o) * 4));
#pragma unroll
        for (int ks = 0; ks < 2; ++ks) {
            f16x8 sf[4], rf[4];
#pragma unroll
            for (int x = 0; x < 4; ++x) { sf[x] = *(const f16x8*)(RWS0 + (size_t)u * 4096 + (16 * x + r16) * 64 + 32 * ks + 8 * g); rf[x] = *(const f16x8*)(RWR2 + (size_t)u * 4096 + (16 * x + r16) * 64 + 32 * ks + 8 * g); }
#pragma unroll
            for (int mt = 0; mt < 4; ++mt)
#pragma unroll
                for (int nt = 0; nt < 4; ++nt) acc[mt][nt] = MFMA_H(sf[mt], rf[nt], acc[mt][nt]);
        }
#pragma unroll
        for (int nt = 0; nt < 4; ++nt) {
            const int t = 16 * nt + r16; const size_t m = m0 + t;
            float s = 0.f;
#pragma unroll
            for (int mt = 0; mt < 4; ++mt) s += (acc[mt][nt][0] + acc[mt][nt][1]) + (acc[mt][nt][2] + acc[mt][nt][3]);
            s += __shfl_xor(s, 16); s += __shfl_xor(s, 32);
            const float mean = s * (1.f / 64.f); float q = 0.f;
#pragma unroll
            for (int mt = 0; mt < 4; ++mt)
#pragma unroll
                for (int e = 0; e < 4; ++e) { const float d = acc[mt][nt][e] - mean; q += d * d; }
            q += __shfl_xor(q, 16); q += __shfl_xor(q, 32);
            const float rstd = rsqrtf(q * (1.f / 64.f) + GN_EPS);
            const f32x2 bo = *(const f32x2*)(BON + ((size_t)u * 64 + t) * 2); const float bonus = bo[0] + bo[1];
#pragma unroll
            for (int mt = 0; mt < 4; ++mt) {
                const int ch = h * 64 + 16 * mt + 4 * g;
                const f16x4 vc = *(const f16x4*)(PROJ + m * IN_PAD + C_V + ch);
                f16x4 vp = {0, 0, 0, 0}; if ((c * 64 + t) != 0) vp = *(const f16x4*)(PROJ + (m - 1) * IN_PAD + C_V + ch);
                const f32x4 muv = *(const f32x4*)(a.in[17] + 1024 + ch), gn = *(const f32x4*)(a.in[26] + ch), bs = *(const f32x4*)(a.in[27] + ch);
                const f16x4 gg = *(const f16x4*)(RWG + m * RW + ch);
                float o[4];
#pragma unroll
                for (int e = 0; e < 4; ++e) { const float vsv = (float)vc[e] + muv[e] * ((float)vp[e] - (float)vc[e]);
                    o[e] = ((acc[mt][nt][e] - mean) * rstd * gn[e] + bs[e] + bonus * vsv) * (float)gg[e]; }
                u32x2 w; w.x = pkh(o[0], o[1]); w.y = pkh(o[2], o[3]);
                *(u32x2*)(OATT + m * KOUT + 1024 + ch) = w;
            }
        }
    }
}

__device__ __forceinline__ void p10_mid(const Args& a, int vcu, int G, int wave, int lane) {
    unsigned char* ws = a.ws;
    const f16* MIX = (const f16*)(ws + WS_MIX); const float* mod = (const float*)(ws + WS_MOD); f16* HF = (f16*)(ws + WS_H);
    const int gw = vcu * NWAVES + wave, NGW = G * NWAVES;
    for (int m = gw; m < MTOK; m += NGW) {
        const int b = m >> 12; const float* md = mod + b * 6144;
        float mx[16], xv[16]; float s = 0.f;
#pragma unroll
        for (int j = 0; j < 2; ++j) { const int c = 8 * lane + 512 * j; const f16x8 v = *(const f16x8*)(MIX + (size_t)m * D + c);
#pragma unroll
            for (int e = 0; e < 8; ++e) { mx[8 * j + e] = (float)v[e]; s += mx[8 * j + e] * mx[8 * j + e]; }
            const f32x4 x0 = *(const f32x4*)(a.in[0] + (size_t)m * D + c), x1 = *(const f32x4*)(a.in[0] + (size_t)m * D + c + 4);
#pragma unroll
            for (int e = 0; e < 4; ++e) { xv[8 * j + e] = x0[e]; xv[8 * j + 4 + e] = x1[e]; } }
        const float r = rsqrtf(wave_sum(s) * (1.f / D) + NORM_EPS);
        float s1 = 0.f;
#pragma unroll
        for (int j = 0; j < 2; ++j) { const int c = 8 * lane + 512 * j;
#pragma unroll
            for (int e = 0; e < 8; ++e) { const float x1 = xv[8 * j + e] + md[2048 + c + e] * (mx[8 * j + e] * r * a.in[6][c + e]); xv[8 * j + e] = x1; s1 += x1 * x1; }
            *(f32x4*)(a.out + (size_t)m * D + c) = (f32x4){xv[8 * j], xv[8 * j + 1], xv[8 * j + 2], xv[8 * j + 3]};
            *(f32x4*)(a.out + (size_t)m * D + c + 4) = (f32x4){xv[8 * j + 4], xv[8 * j + 5], xv[8 * j + 6], xv[8 * j + 7]}; }
        const float r1 = rsqrtf(wave_sum(s1) * (1.f / D) + NORM_EPS);
#pragma unroll
        for (int j = 0; j < 2; ++j) { const int c = 8 * lane + 512 * j; float y[8];
#pragma unroll
            for (int e = 0; e < 8; ++e) y[e] = xv[8 * j + e] * r1 * a.in[7][c + e] * (1.f + md[4096 + c + e]) + md[3072 + c + e];
            u32x4 w; w.x = pkh(y[0], y[1]); w.y = pkh(y[2], y[3]); w.z = pkh(y[4], y[5]); w.w = pkh(y[6], y[7]);
            *(u32x4*)(HF + (size_t)m * D + c) = w; }
    }
}
__device__ __forceinline__ void p13_final(const Args& a, int vcu, int G, int wave, int lane) {
    unsigned char* ws = a.ws;
    const f16* F = (const f16*)(ws + WS_F); const float* mod = (const float*)(ws + WS_MOD);
    const int gw = vcu * NWAVES + wave, NGW = G * NWAVES;
    for (int m = gw; m < MTOK; m += NGW) {
        const int b = m >> 12; const float* md = mod + b * 6144;
        float fv[16]; float s = 0.f;
#pragma unroll
        for (int j = 0; j < 2; ++j) { const int c = 8 * lane + 512 * j; const f16x8 v = *(const f16x8*)(F + (size_t)m * D + c);
#pragma unroll
            for (int e = 0; e < 8; ++e) { fv[8 * j + e] = (float)v[e]; s += fv[8 * j + e] * fv[8 * j + e]; } }
        const float r = rsqrtf(wave_sum(s) * (1.f / D) + NORM_EPS);
#pragma unroll
        for (int j = 0; j < 2; ++j) { const int c = 8 * lane + 512 * j;
            f32x4 x0 = *(const f32x4*)(a.out + (size_t)m * D + c), x1 = *(const f32x4*)(a.out + (size_t)m * D + c + 4);
#pragma unroll
            for (int e = 0; e < 4; ++e) { x0[e] += md[5120 + c + e] * (fv[8 * j + e] * r * a.in[8][c + e]); x1[e] += md[5120 + c + 4 + e] * (fv[8 * j + 4 + e] * r * a.in[8][c + 4 + e]); }
            *(f32x4*)(a.out + (size_t)m * D + c) = x0; *(f32x4*)(a.out + (size_t)m * D + c + 4) = x1; }
    }
}

constexpr int NPHASE = 14;
__global__ void __launch_bounds__(NWAVES * 64, 2) fwd(Args args) {
    extern __shared__ __attribute__((aligned(16))) unsigned char lds_raw[];
    LAS unsigned char* lds = (LAS unsigned char*)lds_raw;
    const int tid = threadIdx.x, lane = tid & 63, wave = __builtin_amdgcn_readfirstlane(tid >> 6);
    const int G = gridDim.x; const int bx = blockIdx.x; const int vcu = (G % 8 == 0) ? (bx % 8) * (G / 8) + bx / 8 : bx;
    volatile LAS unsigned* MISC = (volatile LAS unsigned*)(lds + MISC_OFF);
    if (tid < 16) MISC[tid] = 0u;
    __syncthreads();
    const int lo = args.ph_lo, hi = args.ph_hi;
    unsigned* barw = (unsigned*)(args.ws + WS_CTL) + CW_BAR;
    XcdBarrier bar; bar.bar = barw; bar.x = 0; bar.st = nullptr;
    if (hi - lo > 1) bar = xcd_barrier_post(barw, MISC);
#ifndef PHMASK
#define PHMASK 0x3FFF
#endif
#ifndef REPMASK
#define REPMASK 0
#endif
#define IN(k) (((PHMASK >> (k)) & 1) && lo <= (k) && (k) < hi)
#define REP(k) for (int rep_ = 0; rep_ < (((REPMASK >> (k)) & 1) ? 2 : 1); ++rep_)
#define SEAM(k) do { if (IN(k) && IN((k) + 1)) xcd_barrier(bar); } while (0)
    unsigned char* ws = args.ws;
    if (IN(0)) REP(0) { if (rep_) __syncthreads(); p0_prologue(args, lds, vcu, G, wave, lane); } SEAM(0);
    if (IN(1)) REP(1) { if (rep_) __syncthreads(); p1_modnorm(args, vcu, G, wave, lane); } SEAM(1);
    if (IN(2)) REP(2) { if (rep_) __syncthreads(); pg8::Gemm g{(const f16*)(ws + WS_H), (const f16*)(ws + WS_WIN), MTOK, IN_PAD, D}; pg8::StaticOrder S; S.init(MTOK, IN_PAD, G, bx);
        pg8::EpiF16 E{(f16*)(ws + WS_PROJ), IN_PAD}; pg8::gemm_phase<pg8::EpiF16, pg8::StaticOrder, true, true>(lds, g, S, E); } SEAM(2);
#ifdef OLD_BASELINE
    if (IN(5)) REP(5) { if (rep_) __syncthreads(); p5_indexer(args, lds, vcu, G, wave, lane); } SEAM(5);
    if (IN(6)) REP(6) { if (rep_) __syncthreads(); p6_attention(args, lds, vcu, G, wave, lane); p3_rwkv_prep(args, lds, vcu, G, tid); } SEAM(6);
    if (IN(7)) REP(7) { if (rep_) __syncthreads(); p7_scan(args, lds, vcu, G, wave, lane); } SEAM(7);
    if (IN(8)) REP(8) { if (rep_) __syncthreads(); p8_rwkv_post(args, vcu, G, wave, lane); } SEAM(8);
#else
#define SEAMX() do { if (hi - lo > 1) xcd_barrier(bar); } while (0)
    if (IN(3)) REP(3) { if (rep_) __syncthreads(); p3_rows(args, vcu, G, wave, lane); }
    if (IN(6)) REP(6) { __syncthreads(); p7x_chunks(args, lds, vcu, G, tid, wave, lane); } SEAMX();
    if (IN(4)) REP(4) { if (rep_) __syncthreads(); pg8::Gemm g{(const f16*)(ws + WS_CQ), (const f16*)(ws + WS_WCQ), MTOK, NQI, QL}; pg8::StaticOrder S; S.init(MTOK, NQI, G, bx);
        pg8::EpiF16 E{(f16*)args.out, NQI}; pg8::gemm_phase<pg8::EpiF16, pg8::StaticOrder, true, true>(lds, g, S, E); }
    if (IN(7)) REP(7) { __syncthreads(); p7y_chain(args, bx, G, wave, lane); } SEAMX();
    if (IN(5)) REP(5) { if (rep_) __syncthreads(); p5_dsa(args, lds, G, bx, tid, wave, lane); }
    if (IN(8)) REP(8) { __syncthreads(); p8z_out(args, vcu, G, wave, lane); } SEAMX();
#endif
    if (IN(9)) REP(9) { if (rep_) __syncthreads(); pg8::Gemm g{(const f16*)(ws + WS_OATT), (const f16*)(ws + WS_WOUT), MTOK, D, KOUT}; pg8::StaticOrder S; S.init(MTOK, D, G, bx);
        pg8::EpiF16 E{(f16*)(ws + WS_MIX), D}; pg8::gemm_phase<pg8::EpiF16, pg8::StaticOrder, true, true>(lds, g, S, E); } SEAM(9);
    if (IN(10)) REP(10) { if (rep_) __syncthreads(); p10_mid(args, vcu, G, wave, lane); } SEAM(10);
    if (IN(11)) REP(11) { if (rep_) __syncthreads(); pg8::Gemm g{(const f16*)(ws + WS_H), (const f16*)(ws + WS_WGU), MTOK, 2 * DFF, D}; pg8::StaticOrder S; S.init(MTOK, 2 * DFF, G, bx);
        pg8::EpiSwiGLU E{(f16*)(ws + WS_ACT), DFF}; pg8::gemm_phase<pg8::EpiSwiGLU, pg8::StaticOrder, true, true>(lds, g, S, E); } SEAM(11);
    if (IN(12)) REP(12) { if (rep_) __syncthreads(); pg8::Gemm g{(const f16*)(ws + WS_ACT), (const f16*)(ws + WS_WDN), MTOK, D, DFF}; pg8::StaticOrder S; S.init(MTOK, D, G, bx);
        pg8::EpiF16 E{(f16*)(ws + WS_F), D}; pg8::gemm_phase<pg8::EpiF16, pg8::StaticOrder, true, true>(lds, g, S, E); } SEAM(12);
    if (IN(13)) REP(13) { if (rep_) __syncthreads(); p13_final(args, vcu, G, wave, lane); }
#undef IN
#undef SEAM
}

#ifndef N_LAUNCH_MODE
#define N_LAUNCH_MODE 1
#endif
extern "C" void kernel_launch(void* const* d_in, const int* in_sizes, int n_in, void* d_out, int out_size, void* d_ws, size_t ws_size, hipStream_t stream) {
    static int grid = 0;
    if (grid == 0) {
        int dev = 0, cus = 0, per_cu = 0;
        if (n_in != 32 || ws_size < WS_END) { fprintf(stderr, "kernel_launch: unexpected n_in %d or ws_size %zu (< %zu)\n", n_in, ws_size, (size_t)WS_END); }
        if (hipGetDevice(&dev) != hipSuccess || hipDeviceGetAttribute(&cus, hipDeviceAttributeMultiprocessorCount, dev) != hipSuccess) { grid = -1; return; }
        if (hipFuncSetAttribute((const void*)fwd, hipFuncAttributeMaxDynamicSharedMemorySize, LDS_BYTES) != hipSuccess) { fprintf(stderr, "kernel_launch: hipFuncSetAttribute failed\n"); grid = -1; return; }
        if (hipOccupancyMaxActiveBlocksPerMultiprocessor(&per_cu, (const void*)fwd, NWAVES * 64, LDS_BYTES) != hipSuccess || per_cu < 1) fprintf(stderr, "kernel_launch: occupancy query says %d\n", per_cu);
        (void)hipGetLastError();
        grid = cus;
    }
    if (grid < 0) return;
    (void)hipMemsetAsync((char*)d_ws + WS_CTL, 0, CTL_ZERO_BYTES, stream);
    Args a{};
    for (int i = 0; i < 32; ++i) a.in[i] = (const float*)d_in[i];
    a.out = (float*)d_out; a.ws = (unsigned char*)d_ws;
    if (N_LAUNCH_MODE == 1) { a.ph_lo = 0; a.ph_hi = NPHASE; hipLaunchKernelGGL(fwd, dim3(grid), dim3(NWAVES * 64), LDS_BYTES, stream, a); }
    else for (int p = 0; p < NPHASE; ++p) { a.ph_lo = p; a.ph_hi = p + 1; hipLaunchKernelGGL(fwd, dim3(grid), dim3(NWAVES * 64), LDS_BYTES, stream, a); }
}
```

```cpp
#include <hip/hip_runtime.h>
#include <cstdio>
#include <cstdint>

#define LAS __attribute__((address_space(3)))
#define GAS __attribute__((address_space(1)))
typedef _Float16 f16;
typedef _Float16 f16x8 __attribute__((ext_vector_type(8)));
typedef _Float16 f16x4 __attribute__((ext_vector_type(4)));
typedef _Float16 f16x2 __attribute__((ext_vector_type(2)));
typedef float f32x4 __attribute__((ext_vector_type(4)));
typedef float f32x2 __attribute__((ext_vector_type(2)));
typedef unsigned u32x4 __attribute__((ext_vector_type(4)));
typedef unsigned u32x2 __attribute__((ext_vector_type(2)));

__device__ __forceinline__ unsigned pkh(float a, float b) { f16x2 v = {(f16)a, (f16)b}; return __builtin_bit_cast(unsigned, v); }
__device__ __forceinline__ float h2f(f16 h) { return (float)h; }

namespace pg8 {
constexpr int BM = 256, BK = 64, HALF = 128, HTB = HALF * BK * 2, STAGE_BYTES = 8 * HTB, NXCD = 8, WGM = 8;
__host__ __device__ __forceinline__ int lds_byte(int r, int c) { const int st = (r >> 4) * 2 + (c >> 5), rr = r & 15, cc = c & 31, ob = rr * 64 + cc * 2; return st * 1024 + (ob ^ (((ob >> 9) & 1) << 5)); }
__host__ __device__ __forceinline__ void stage_rc(int b, int& R, int& C) { const int st = b / 1024, sb = b % 1024, swz = sb ^ (((sb >> 9) & 1) << 5); R = (st >> 1) * 16 + swz / 64; C = (st & 1) * 32 + (swz % 64) / 2; }
__host__ __device__ __forceinline__ int perm32(int rho) { const int n = rho >> 4, i = rho & 15; return 8 * (i >> 2) + 4 * n + (i & 3); }

struct Unit { int pm, pn; };
struct Gemm { const f16* A; const f16* Bt; int M, N, K; };

struct StaticOrder {
    int nM, nN, nwg, G, c;
    __host__ __device__ void init(int M, int N, int G_, int c_) { nM = M / BM; nN = N / BM; nwg = nM * nN; G = G_; c = c_; }
    __host__ __device__ bool next(int i, Unit& u) const {
        const long L = (long)i * G + c; if (L >= nwg) return false;
        int wgid = (int)L; { const int q = nwg / NXCD, r = nwg % NXCD, xcd = wgid % NXCD, off = wgid / NXCD; wgid = (xcd < r ? xcd * (q + 1) : r * (q + 1) + (xcd - r) * q) + off; }
        const int nig = WGM * nN, gid = wgid / nig, fm = gid * WGM, gsz = (nM - fm) < WGM ? (nM - fm) : WGM;
        u.pm = fm + ((wgid % nig) % gsz); u.pn = (wgid % nig) / gsz; return true;
    }
    __device__ __forceinline__ void a_ready(const Unit&) const {}
    __device__ __forceinline__ void done(const Unit&) const {}
};

struct EpiF16 {
    static constexpr bool PERM = true, AFTER_DRAIN = false;
    f16* O; int ldc;
    __device__ __forceinline__ void operator()(const f32x4 (&acc)[2][2][4][2], const Unit& u, int wr, int wc, int fr, int fq) const {
        const int row0 = u.pm * BM + wr * 64 + fr; const int col0 = u.pn * BM + wc * 32 + 8 * fq;
#pragma unroll
        for (int ai = 0; ai < 2; ++ai)
#pragma unroll
            for (int m = 0; m < 4; ++m) { f16* rowp = O + (size_t)(row0 + ai * HALF + m * 16) * ldc + col0;
#pragma unroll
                for (int bj = 0; bj < 2; ++bj) { const f32x4 v0 = acc[ai][bj][m][0], v1 = acc[ai][bj][m][1];
                    u32x4 w; w.x = pkh(v0[0], v0[1]); w.y = pkh(v0[2], v0[3]); w.z = pkh(v1[0], v1[1]); w.w = pkh(v1[2], v1[3]);
                    *(u32x4*)(rowp + bj * HALF) = w; } }
    }
};
struct EpiSwiGLU {
    static constexpr bool PERM = true, AFTER_DRAIN = false;
    f16* O; int ldc;
    __device__ __forceinline__ void operator()(const f32x4 (&acc)[2][2][4][2], const Unit& u, int wr, int wc, int fr, int fq) const {
        const int row0 = u.pm * BM + wr * 64 + fr; const int col0 = u.pn * HALF + wc * 32 + 8 * fq;
#pragma unroll
        for (int ai = 0; ai < 2; ++ai)
#pragma unroll
            for (int m = 0; m < 4; ++m) { f16* rowp = O + (size_t)(row0 + ai * HALF + m * 16) * ldc + col0;
                float o[8];
#pragma unroll
                for (int n = 0; n < 2; ++n)
#pragma unroll
                    for (int j = 0; j < 4; ++j) { const float g = acc[ai][0][m][n][j], up = acc[ai][1][m][n][j]; o[n * 4 + j] = g * __builtin_amdgcn_rcpf(1.0f + __expf(-g)) * up; }
                u32x4 w; w.x = pkh(o[0], o[1]); w.y = pkh(o[2], o[3]); w.z = pkh(o[4], o[5]); w.w = pkh(o[6], o[7]);
                *(u32x4*)rowp = w; }
    }
};

template <class Epi, class Sched, bool ALIGN_EPI = false, bool SP2 = false>
__device__ __forceinline__ void gemm_phase(LAS unsigned char* lds, const Gemm g, const Sched& S, const Epi& E) {
    const int tid = threadIdx.x, wid = __builtin_amdgcn_readfirstlane(tid >> 6), lane = tid & 63, wr = wid >> 2, wc = wid & 3, fr = lane & 15, fq = lane >> 4;
    const int K = g.K, nt = K / BK;
    unsigned voffA[2], voffB[2];
#pragma unroll
    for (int i = 0; i < 2; ++i) { int R, C; stage_rc(tid * 16 + i * 8192, R, C); const int Rb = Epi::PERM ? ((R & ~31) + perm32(R & 31)) : R;
        voffA[i] = (unsigned)(R * K + C) * 2u; voffB[i] = (unsigned)(Rb * K + C) * 2u; }
    const size_t kstep = (size_t)(BK * 2);
    const size_t hstep = (size_t)HALF * K * 2;
    const size_t tstep = 2 * hstep;
    const unsigned ldsw = (unsigned)wid * 1024u;
    const int aoff = lds_byte(wr * 64 + fr, fq * 8), boff = lds_byte(wc * 32 + fr, fq * 8);
#define PG8_SA(b, h) (((b) * 2 + (h)) * HTB)
#define PG8_SB(b, h) ((4 + (b) * 2 + (h)) * HTB)
#define PG8_STAGE(bufoff, gbase, voff) do { _Pragma("unroll") for (int _i = 0; _i < 2; ++_i) \
        __builtin_amdgcn_global_load_lds((const unsigned*)((const char*)(gbase) + (voff)[_i]), (LAS unsigned*)(lds + (bufoff) + ldsw + _i * 8192), 16, 0, 0); } while (0)
#define PG8_LDA(dst, b, h) do { _Pragma("unroll") for (int m = 0; m < 4; ++m) _Pragma("unroll") for (int k = 0; k < 2; ++k) dst[m][k] = *(const LAS f16x8*)(lds + PG8_SA(b, h) + aoff + m * 2048 + k * 1024); } while (0)
#define PG8_LDB(dst, b, h) do { _Pragma("unroll") for (int n = 0; n < 2; ++n) _Pragma("unroll") for (int k = 0; k < 2; ++k) dst[n][k] = *(const LAS f16x8*)(lds + PG8_SB(b, h) + boff + n * 2048 + k * 1024); } while (0)
#define PG8_MMA(ai, bj, At, Bt) do { __builtin_amdgcn_s_setprio(1); _Pragma("unroll") for (int m = 0; m < 4; ++m) _Pragma("unroll") for (int n = 0; n < 2; ++n) _Pragma("unroll") for (int k = 0; k < 2; ++k) \
        acc[ai][bj][m][n] = __builtin_amdgcn_mfma_f32_16x16x32_f16(Bt[n][k], At[m][k], acc[ai][bj][m][n], 0, 0, 0); __builtin_amdgcn_s_setprio(0); } while (0)
#define PG8_WAIT_V(n) asm volatile("s_waitcnt vmcnt(" #n ")" ::: "memory")
#define PG8_WAIT_L(n) asm volatile("s_waitcnt lgkmcnt(" #n ")" ::: "memory")
#define PG8_BAR __builtin_amdgcn_s_barrier()
#define PG8_SCHED __builtin_amdgcn_sched_barrier(0)
    Unit cur, nxt; int ui = 0;
    if (!S.next(0, cur)) return;
    f32x4 acc[2][2][4][2];
#pragma unroll
    for (int a = 0; a < 2; ++a)
#pragma unroll
        for (int b = 0; b < 2; ++b)
#pragma unroll
            for (int m = 0; m < 4; ++m)
#pragma unroll
                for (int n = 0; n < 2; ++n) acc[a][b][m][n] = (f32x4){0.f, 0.f, 0.f, 0.f};
    f16x8 At[4][2], B0[2][2], B1[2][2];
    const char* cA = (const char*)g.A + (size_t)cur.pm * tstep; const char* cB = (const char*)g.Bt + (size_t)cur.pn * tstep;
    S.a_ready(cur);
    if constexpr (SP2) {
        PG8_STAGE(PG8_SB(0, 0), cB, voffB); PG8_STAGE(PG8_SB(0, 1), cB + hstep, voffB); PG8_STAGE(PG8_SA(0, 0), cA, voffA); PG8_STAGE(PG8_SA(0, 1), cA + hstep, voffA);
        if (wr == 1) PG8_BAR;
        PG8_WAIT_V(2); PG8_BAR;
        PG8_STAGE(PG8_SB(1, 0), cB + kstep, voffB); PG8_STAGE(PG8_SA(1, 0), cA + kstep, voffA); PG8_STAGE(PG8_SB(1, 1), cB + hstep + kstep, voffB);
        PG8_WAIT_V(6); PG8_BAR;
    } else {
        PG8_STAGE(PG8_SB(0, 0), cB, voffB); PG8_STAGE(PG8_SA(0, 0), cA, voffA); PG8_STAGE(PG8_SB(0, 1), cB + hstep, voffB); PG8_STAGE(PG8_SA(0, 1), cA + hstep, voffA);
        if (wr == 1) PG8_BAR;
        PG8_WAIT_V(4); PG8_BAR;
        PG8_STAGE(PG8_SB(1, 0), cB + kstep, voffB); PG8_STAGE(PG8_SA(1, 0), cA + kstep, voffA); PG8_STAGE(PG8_SB(1, 1), cB + hstep + kstep, voffB);
        PG8_WAIT_V(6); PG8_BAR;
    }
    for (;;) {
        const bool has_next = S.next(ui + 1, nxt);
        const char* nA = has_next ? (const char*)g.A + (size_t)nxt.pm * tstep : cA; const char* nB = has_next ? (const char*)g.Bt + (size_t)nxt.pn * tstep : cB;
        for (int t = 0; t < nt; t += 2) {
            const bool last = (t == nt - 2);
            const char* a1 = cA + (size_t)(t + 1) * kstep;
            const char* a2 = last ? nA : cA + (size_t)(t + 2) * kstep; const char* b2 = last ? nB : cB + (size_t)(t + 2) * kstep;
            const char* a3 = a2 + kstep; const char* b3 = b2 + kstep;
            if (last && has_next) S.a_ready(nxt);
            if constexpr (SP2) {
            PG8_LDB(B0, 0, 0); PG8_LDB(B1, 0, 1); PG8_SCHED; PG8_LDA(At, 0, 0); PG8_STAGE(PG8_SA(1, 1), a1 + hstep, voffA);
            PG8_WAIT_V(8); PG8_WAIT_L(0); PG8_BAR; PG8_MMA(0, 0, At, B0); PG8_MMA(0, 1, At, B1); PG8_BAR; PG8_SCHED;
            PG8_LDA(At, 0, 1); PG8_STAGE(PG8_SB(0, 0), b2, voffB); PG8_STAGE(PG8_SB(0, 1), b2 + hstep, voffB); PG8_STAGE(PG8_SA(0, 0), a2, voffA);
            PG8_WAIT_V(8); PG8_WAIT_L(0); PG8_BAR; PG8_MMA(1, 0, At, B0); PG8_MMA(1, 1, At, B1); PG8_BAR; PG8_SCHED;
            PG8_LDB(B0, 1, 0); PG8_LDB(B1, 1, 1); PG8_SCHED; PG8_LDA(At, 1, 0); PG8_STAGE(PG8_SA(0, 1), a2 + hstep, voffA);
            PG8_WAIT_V(8); PG8_WAIT_L(0); PG8_BAR; PG8_MMA(0, 0, At, B0); PG8_MMA(0, 1, At, B1); PG8_BAR; PG8_SCHED;
            PG8_LDA(At, 1, 1); PG8_STAGE(PG8_SB(1, 0), b3, voffB); PG8_STAGE(PG8_SB(1, 1), b3 + hstep, voffB); PG8_STAGE(PG8_SA(1, 0), a3, voffA);
            PG8_WAIT_V(8); PG8_WAIT_L(0); PG8_BAR; PG8_MMA(1, 0, At, B0); PG8_MMA(1, 1, At, B1); PG8_BAR; PG8_SCHED;
            } else {
            PG8_LDB(B0, 0, 0); PG8_SCHED; PG8_LDA(At, 0, 0); PG8_STAGE(PG8_SA(1, 1), a1 + hstep, voffA);
            PG8_WAIT_L(8); PG8_BAR; PG8_WAIT_L(0); PG8_MMA(0, 0, At, B0); PG8_BAR; PG8_SCHED;
            PG8_LDB(B1, 0, 1); PG8_STAGE(PG8_SB(0, 0), b2, voffB);
            PG8_BAR; PG8_WAIT_L(0); PG8_MMA(0, 1, At, B1); PG8_BAR;
            PG8_LDA(At, 0, 1); PG8_STAGE(PG8_SA(0, 0), a2, voffA);
            PG8_BAR; PG8_WAIT_L(0); PG8_MMA(1, 0, At, B0); PG8_BAR; PG8_SCHED;
            PG8_STAGE(PG8_SB(0, 1), b2 + hstep, voffB);
            PG8_WAIT_V(6); PG8_BAR; PG8_MMA(1, 1, At, B1); PG8_BAR;
            PG8_LDB(B0, 1, 0); PG8_SCHED; PG8_LDA(At, 1, 0); PG8_STAGE(PG8_SA(0, 1), a2 + hstep, voffA);
            PG8_WAIT_L(8); PG8_BAR; PG8_WAIT_L(0); PG8_MMA(0, 0, At, B0); PG8_BAR; PG8_SCHED;
            PG8_LDB(B1, 1, 1); PG8_STAGE(PG8_SB(1, 0), b3, voffB);
            PG8_BAR; PG8_WAIT_L(0); PG8_MMA(0, 1, At, B1); PG8_BAR;
            PG8_LDA(At, 1, 1); PG8_STAGE(PG8_SA(1, 0), a3, voffA);
            PG8_BAR; PG8_WAIT_L(0); PG8_MMA(1, 0, At, B0); PG8_BAR; PG8_SCHED;
            PG8_STAGE(PG8_SB(1, 1), b3 + hstep, voffB);
            PG8_WAIT_V(6); PG8_BAR; PG8_MMA(1, 1, At, B1); PG8_BAR;
            }
        }
        if constexpr (ALIGN_EPI) { if (wr == 0) PG8_BAR; }
        if constexpr (!Epi::AFTER_DRAIN) { E(acc, cur, wr, wc, fr, fq); S.done(cur); }
        if (!has_next) break;
#pragma unroll
        for (int a = 0; a < 2; ++a)
#pragma unroll
            for (int b = 0; b < 2; ++b)
#pragma unroll
                for (int m = 0; m < 4; ++m)
#pragma unroll
                    for (int n = 0; n < 2; ++n) acc[a][b][m][n] = (f32x4){0.f, 0.f, 0.f, 0.f};
        cur = nxt; cA = nA; cB = nB; ++ui;
        if constexpr (ALIGN_EPI) { if (wr == 1) PG8_BAR; }
    }
    PG8_WAIT_V(0);
    if constexpr (!ALIGN_EPI) { if (wr == 0) PG8_BAR; }
    PG8_BAR;
#undef PG8_SA
#undef PG8_SB
#undef PG8_STAGE
#undef PG8_LDA
#undef PG8_LDB
#undef PG8_MMA
#undef PG8_WAIT_V
#undef PG8_WAIT_L
#undef PG8_BAR
#undef PG8_SCHED
}
}

#define XB_TMO      128
#define XB_XCNT(j)  (256  + 64 * (j))
#define XB_XSUB(j)  (1280 + 64 * (j))
#define XB_XGEN(j)  (2304 + 64 * (j))
#define XB_TOP      3328
#define XB_TOPGEN   3392
#define XCD_BAR_WORDS 3456
#define XB_SPIN_CAP (1u << 18)
__device__ __forceinline__ unsigned xb_ld(unsigned* p)              { return __hip_atomic_load(p, __ATOMIC_RELAXED, __HIP_MEMORY_SCOPE_AGENT); }
__device__ __forceinline__ unsigned xb_add(unsigned* p, unsigned v) { return __hip_atomic_fetch_add(p, v, __ATOMIC_RELAXED, __HIP_MEMORY_SCOPE_AGENT); }
__device__ __forceinline__ unsigned xb_xcc_id() { return (unsigned)__builtin_amdgcn_s_getreg((3 << 11) | 20) & 0xFu; }
#define XB_SPIN(cond, bar) do { unsigned _sp = 0; while (cond) { __builtin_amdgcn_s_sleep(1); \
    if ((++_sp & 255u) == 0u) { if (xb_ld(&(bar)[XB_TMO])) break; if (_sp > XB_SPIN_CAP) { atomicAdd(&(bar)[XB_TMO], 1u); break; } } } } while (0)
struct XcdBarrier { unsigned* bar; unsigned x; volatile LAS unsigned* st; };
__device__ __forceinline__ XcdBarrier xcd_barrier_post(unsigned* bar, volatile LAS unsigned* st) {
    XcdBarrier b; b.bar = bar; b.x = xb_xcc_id(); b.st = st;
    if (threadIdx.x == 0) (void)xb_add(&bar[XB_XCNT(b.x)], 1u);
    return b;
}
__device__ __forceinline__ void xcd_barrier_complete(unsigned* bar, unsigned x, unsigned& nloc, unsigned& nx) {
    const unsigned G = gridDim.x * gridDim.y * gridDim.z;
    unsigned sum, cnt, mine, sp = 0u;
    for (;;) {
        sum = 0u; cnt = 0u; mine = 0u;
#pragma unroll
        for (unsigned j = 0; j < 16; ++j) { const unsigned c = xb_ld(&bar[XB_XCNT(j)]); sum += c; cnt += (c > 0u) ? 1u : 0u; mine = (j == x) ? c : mine; }
        if (sum == G) break;
        __builtin_amdgcn_s_sleep(1);
        if ((++sp & 255u) == 0u) { if (xb_ld(&bar[XB_TMO])) break; if (sp > XB_SPIN_CAP) { atomicAdd(&bar[XB_TMO], 1u); break; } }
    }
    nloc = mine > 0u ? mine : 1u; nx = cnt > 0u ? cnt : 1u;
}
__device__ __forceinline__ void xcd_barrier(const XcdBarrier& b) {
    asm volatile("s_waitcnt vmcnt(0)" ::: "memory");
    __syncthreads();
    if (threadIdx.x == 0) {
        unsigned* bar = b.bar;
        __builtin_amdgcn_s_waitcnt(0);
        unsigned nloc = b.st[0], nx = b.st[1];
        if (nloc == 0u) { xcd_barrier_complete(bar, b.x, nloc, nx); b.st[0] = nloc; b.st[1] = nx; }
        const unsigned old = xb_add(&bar[XB_XSUB(b.x)], 1u);
        const unsigned gen = old / nloc;
        if (old + 1u == (gen + 1u) * nloc) {
            __builtin_amdgcn_fence(__ATOMIC_RELEASE, "agent");
            asm volatile("s_waitcnt vmcnt(0)" ::: "memory");
            const unsigned og = xb_add(&bar[XB_TOP], 1u);
            const unsigned tg = og / nx;
            if (og + 1u == (tg + 1u) * nx) xb_add(&bar[XB_TOPGEN], 1u);
            else XB_SPIN(xb_ld(&bar[XB_TOPGEN]) == tg, bar);
            __builtin_amdgcn_fence(__ATOMIC_ACQUIRE, "agent");
            xb_add(&bar[XB_XGEN(b.x)], 1u);
            asm volatile("s_waitcnt vmcnt(0)" ::: "memory");
        } else {
            XB_SPIN(xb_ld(&bar[XB_XGEN(b.x)]) == gen, bar);
            __builtin_amdgcn_fence(__ATOMIC_ACQUIRE, "agent");
            asm volatile("s_waitcnt vmcnt(0)" ::: "memory");
        }
    }
    __syncthreads();
}

constexpr int BATCH = 8, SEQ = 4096, D = 1024, MTOK = BATCH * SEQ;
constexpr int QL = 256, KVL = 128, IDXD = 64, IDXH = 8, HATT = 8, TOPK = 256;
constexpr int RW = 512, HRW = 8, NRW = 64;
constexpr int IN_COLS = 2280, IN_PAD = 2304;
constexpr int C_CQ = 0, C_CKV = 256, C_IK = 384, C_IW = 448, C_R = 456, C_K = 968, C_V = 1480, C_WD = 1992, C_AD = 2056, C_GD = 2120;
constexpr int DFF = 2816;
constexpr int NQI = 1536;
constexpr int KOUT = 1536;
constexpr float NORM_EPS = 1e-6f, GN_EPS = 64e-5f;

constexpr size_t MiB = 1u << 20;
constexpr size_t WS_CTL = 0, CTL_ZERO_BYTES = 64 * 1024;
constexpr size_t WS_MOD = 1 * MiB;
constexpr size_t WS_WIN = 2 * MiB;
constexpr size_t WS_WCQ = 7 * MiB;
constexpr size_t WS_WOUT = 8 * MiB;
constexpr size_t WS_WGU = 11 * MiB;
constexpr size_t WS_WDN = 22 * MiB;
constexpr size_t WS_H = 32 * MiB;
constexpr size_t WS_RWW = 32 * MiB, WS_RWA = 64 * MiB;
constexpr size_t WS_PROJ = 96 * MiB;
constexpr size_t WS_CQ = 240 * MiB;
constexpr size_t WS_SEL = 240 * MiB;
constexpr size_t WS_OATT = 256 * MiB;
constexpr size_t WS_CKV = 352 * MiB;
constexpr size_t WS_IK16 = 360 * MiB;
constexpr size_t WS_IK32 = 364 * MiB;
constexpr size_t WS_IW = 372 * MiB;
constexpr size_t WS_RWG = 376 * MiB;
constexpr size_t WS_YRAW = 408 * MiB;
constexpr size_t WS_MIX = 408 * MiB;
constexpr size_t WS_ACT = 96 * MiB;
constexpr size_t WS_F = 288 * MiB;
constexpr size_t WS_CKV8 = 368 * MiB;
constexpr size_t WS_END = 504 * MiB;

constexpr int CW_BAR = 1024;
constexpr int NWAVES = 8;
constexpr int RING_BYTES = 131072, AUX_OFF = RING_BYTES  , MISC_OFF = 155648, LDS_BYTES = 155904;

struct Args { const float* in[32]; float* out; unsigned char* ws; int ph_lo, ph_hi; };

__device__ __forceinline__ float wave_sum(float v) {
#pragma unroll
    for (int o = 1; o < 64; o <<= 1) v += __shfl_xor(v, o);
    return v;
}
__device__ __forceinline__ void lds_barrier() { asm volatile("s_waitcnt lgkmcnt(0)\n\ts_barrier" ::: "memory"); }
__device__ __forceinline__ float sigmoidf_(float x) { return __builtin_amdgcn_rcpf(1.0f + __expf(-x)); }

__device__ __forceinline__ void p0_transpose_item(const float* W, int K, int N, int Npad, f16* WT, int ldk, int koff, int row_off, int mode, LAS float* scr, int item, int lane) {
    const int nblk = Npad / 32, kb = item / nblk, nb = item % nblk, k0 = 64 * kb, n0 = 32 * nb;
#pragma unroll 8
    for (int i = 0; i < 32; ++i) { const int kk = 2 * i + (lane >> 5); const int n = n0 + (lane & 31); scr[kk * 33 + (lane & 31)] = (n < N && k0 + kk < K) ? W[(size_t)(k0 + kk) * N + n] : 0.f; }
    asm volatile("s_waitcnt lgkmcnt(0)" ::: "memory");
    const int c = lane & 7;
#pragma unroll
    for (int j = 0; j < 4; ++j) { const int nl = (lane >> 3) + 8 * j; const LAS float* s = scr + (8 * c) * 33 + nl;
        u32x4 o; o.x = pkh(s[0 * 33], s[1 * 33]); o.y = pkh(s[2 * 33], s[3 * 33]); o.z = pkh(s[4 * 33], s[5 * 33]); o.w = pkh(s[6 * 33], s[7 * 33]);
        const int n = n0 + nl; int row;
        if (mode == 0) row = row_off + n; else row = (n >> 7) * 256 + (mode == 2 ? 128 : 0) + (n & 127);
        *(u32x4*)(WT + (size_t)row * ldk + koff + k0 + 8 * c) = o; }
    asm volatile("s_waitcnt lgkmcnt(0)" ::: "memory");
}

__device__ __forceinline__ void p0_prologue(const Args& a, LAS unsigned char* lds, int vcu, int G, int wave, int lane) {
    unsigned char* ws = a.ws;
    LAS float* scr = (LAS float*)(lds + wave * 16384);
    const int gw = vcu * NWAVES + wave, NGW = G * NWAVES;
    f16* Win = (f16*)(ws + WS_WIN); f16* Wcq = (f16*)(ws + WS_WCQ); f16* Wout = (f16*)(ws + WS_WOUT); f16* Wgu = (f16*)(ws + WS_WGU); f16* Wdn = (f16*)(ws + WS_WDN);
    constexpr int I_IN = (D / 64) * (IN_PAD / 32), I_IDX = (QL / 64) * (512 / 32), I_OR = (512 / 64) * (D / 32), I_G = (D / 64) * (DFF / 32), I_D = (DFF / 64) * (D / 32);
    constexpr int I_FQ = 4 * 64, I_FO = 16 * 64, I_MOD = 8 * 96, I_LD = 16, I_LG = 48;
    constexpr int NITEMS = I_IN + I_IDX + I_OR + 2 * I_G + I_D + I_FQ + I_FO + 2 * I_LD + I_LG;
    for (int it = gw; it < NITEMS; it += NGW) {
        int r = it;
        if (r < I_IN) { p0_transpose_item(a.in[9], D, IN_COLS, IN_PAD, Win, D, 0, 0, 0, scr, r, lane); continue; } r -= I_IN;
        if (r < I_IDX) { p0_transpose_item(a.in[12], QL, 512, 512, Wcq, QL, 0, 1024, 0, scr, r, lane); continue; } r -= I_IDX;
        if (r < I_OR) { p0_transpose_item(a.in[28] + (size_t)512 * D, 512, D, D, Wout, KOUT, 1024, 0, 0, scr, r, lane); continue; } r -= I_OR;
        if (r < I_G) { p0_transpose_item(a.in[29], D, DFF, DFF, Wgu, D, 0, 0, 1, scr, r, lane); continue; } r -= I_G;
        if (r < I_G) { p0_transpose_item(a.in[30], D, DFF, DFF, Wgu, D, 0, 0, 2, scr, r, lane); continue; } r -= I_G;
        if (r < I_D) { p0_transpose_item(a.in[31], DFF, D, D, Wdn, DFF, 0, 0, 0, scr, r, lane); continue; } r -= I_D;
        if (r < I_FQ) {
            const int rb = r & 3, nb = r >> 2, rr = rb * 64 + lane, n0 = nb * 16, h = n0 >> 7;
            const float* uq = a.in[11] + (size_t)rr * 512 + h * 64; const float* uk = a.in[15] + (size_t)n0 * 64;
            float q[64];
#pragma unroll
            for (int d4 = 0; d4 < 16; ++d4) { const f32x4 v = *(const f32x4*)(uq + 4 * d4); q[4 * d4] = v[0]; q[4 * d4 + 1] = v[1]; q[4 * d4 + 2] = v[2]; q[4 * d4 + 3] = v[3]; }
#pragma unroll 4
            for (int i = 0; i < 16; ++i) { float s = 0.f;
#pragma unroll
                for (int d = 0; d < 64; ++d) s += q[d] * uk[i * 64 + d];
                Wcq[(size_t)(n0 + i) * QL + rr] = (f16)(0.125f * s); }
            continue; } r -= I_FQ;
        if (r < I_FO) {
            const int kb = r & 15, nb = r >> 4, k = kb * 64 + lane, h = k >> 7, n0 = nb * 16;
            const float* uv = a.in[16] + (size_t)k * 64; const float* wo = a.in[28] + (size_t)(h * 64) * D + n0;
            float acc[16];
#pragma unroll
            for (int i = 0; i < 16; ++i) acc[i] = 0.f;
#pragma unroll 8
            for (int d = 0; d < 64; ++d) { const float v = uv[d];
#pragma unroll
                for (int i4 = 0; i4 < 4; ++i4) { const f32x4 w = *(const f32x4*)(wo + (size_t)d * D + 4 * i4); acc[4 * i4] += v * w[0]; acc[4 * i4 + 1] += v * w[1]; acc[4 * i4 + 2] += v * w[2]; acc[4 * i4 + 3] += v * w[3]; } }
#pragma unroll
            for (int i = 0; i < 16; ++i) Wout[(size_t)(n0 + i) * KOUT + k] = (f16)acc[i];
            continue; } r -= I_FO;
        if (r < I_LD) { p0_transpose_item(a.in[19], 64, 512, 512, (f16*)(ws + (28u << 20)), 64, 0, 0, 0, scr, r, lane); continue; } r -= I_LD;
        if (r < I_LD) { p0_transpose_item(a.in[21], 64, 512, 512, (f16*)(ws + (28u << 20) + 65536), 64, 0, 0, 0, scr, r, lane); continue; } r -= I_LD;
        { p0_transpose_item(a.in[22], 160, 512, 512, (f16*)(ws + (28u << 20) + 131072), 192, 0, 0, 0, scr, r, lane); }
    }
    if (vcu < 96) {
        __syncthreads();
        const int tid = wave * 64 + lane;
        for (int e = tid; e < 8 * D; e += 512) { const float cc = a.in[1][e]; *(LAS float*)(lds + (e >> 10) * 16384 + 10496 + (e & 1023) * 4) = cc * sigmoidf_(cc); }
        for (int cb = vcu; cb < 96; cb += G) {
            __syncthreads();
            const int j = cb * 64 + lane; const float* aw = a.in[3] + j;
            float acc[8];
#pragma unroll
            for (int b = 0; b < 8; ++b) acc[b] = 0.f;
            const int kbeg = wave * 128;
#pragma unroll 1
            for (int k0 = 0; k0 < 128; k0 += 16) {
                float wv[16];
#pragma unroll
                for (int i = 0; i < 16; ++i) wv[i] = aw[(size_t)(kbeg + k0 + i) * 6144];
#pragma unroll
                for (int b = 0; b < 8; ++b) {
#pragma unroll
                    for (int i4 = 0; i4 < 4; ++i4) { const f32x4 sv = *(const LAS f32x4*)(lds + b * 16384 + 10496 + (kbeg + k0 + 4 * i4) * 4);
                        acc[b] += sv[0] * wv[4 * i4] + sv[1] * wv[4 * i4 + 1] + sv[2] * wv[4 * i4 + 2] + sv[3] * wv[4 * i4 + 3]; } }
            }
#pragma unroll
            for (int b = 0; b < 8; ++b) *(LAS float*)(lds + wave * 16384 + 8448 + (b * 64 + lane) * 4) = acc[b];
            __syncthreads();
            float sum = 0.f;
#pragma unroll
            for (int w = 0; w < 8; ++w) sum += *(const LAS float*)(lds + w * 16384 + 8448 + (wave * 64 + lane) * 4);
            ((float*)(ws + WS_MOD))[wave * 6144 + j] = sum + a.in[4][j];
        }
    }
}

__device__ __forceinline__ void p1_modnorm(const Args& a, int vcu, int G, int wave, int lane) {
    const int gw = vcu * NWAVES + wave, NGW = G * NWAVES;
    const float* mod = (const float*)(a.ws + WS_MOD); f16* H = (f16*)(a.ws + WS_H);
    for (int m = gw; m < MTOK; m += NGW) {
        const int b = m >> 12;
        const f32x4* xr = (const f32x4*)(a.in[0] + (size_t)m * D) + lane;
        f32x4 v[4]; float s = 0.f;
#pragma unroll
        for (int j = 0; j < 4; ++j) { v[j] = xr[64 * j]; s += (v[j][0] * v[j][0] + v[j][1] * v[j][1]) + (v[j][2] * v[j][2] + v[j][3] * v[j][3]); }
        const float r = rsqrtf(wave_sum(s) * (1.f / D) + NORM_EPS);
        u32x2* o = (u32x2*)(H + (size_t)m * D) + lane;
#pragma unroll
        for (int j = 0; j < 4; ++j) { const int c = 4 * lane + 256 * j;
            const f32x4 g = *(const f32x4*)(a.in[5] + c), sh = *(const f32x4*)(mod + b * 6144 + c), sc = *(const f32x4*)(mod + b * 6144 + 1024 + c);
            f32x4 y;
#pragma unroll
            for (int e = 0; e < 4; ++e) y[e] = v[j][e] * r * g[e] * (1.f + sc[e]) + sh[e];
            u32x2 w; w.x = pkh(y[0], y[1]); w.y = pkh(y[2], y[3]); o[64 * j] = w; }
    }
}

__device__ __forceinline__ void p3_rows(const Args& a, int vcu, int G, int wave, int lane) {
    const int gw = vcu * NWAVES + wave, NGW = G * NWAVES;
    unsigned char* ws = a.ws;
    const f16* PROJ = (const f16*)(ws + WS_PROJ);
    f16* CQ = (f16*)(ws + WS_CQ); f16* CKV = (f16*)(ws + WS_CKV); f16* IK16 = (f16*)(ws + WS_IK16); float* IW = (float*)(ws + WS_IW);
    for (int m = gw; m < MTOK; m += NGW) {
        const f16* pr = PROJ + (size_t)m * IN_PAD;
        const f16x4 q = *(const f16x4*)(pr + C_CQ + 4 * lane);
        const f16x2 kv = *(const f16x2*)(pr + C_CKV + 2 * lane);
        const float ik = (float)pr[C_IK + lane];
        float q0 = (float)q[0], q1 = (float)q[1], q2 = (float)q[2], q3 = (float)q[3], k0 = (float)kv[0], k1 = (float)kv[1];
        const float rq = rsqrtf(wave_sum(q0 * q0 + q1 * q1 + q2 * q2 + q3 * q3) * (1.f / QL) + NORM_EPS);
        const float rk = rsqrtf(wave_sum(k0 * k0 + k1 * k1) * (1.f / KVL) + NORM_EPS);
        const float ri = rsqrtf(wave_sum(ik * ik) * (1.f / IDXD) + NORM_EPS);
        const f32x4 gq = *(const f32x4*)(a.in[10] + 4 * lane); const f32x2 gk = *(const f32x2*)(a.in[13] + 2 * lane); const float gi = a.in[14][lane];
        u32x2 w; w.x = pkh(q0 * rq * gq[0], q1 * rq * gq[1]); w.y = pkh(q2 * rq * gq[2], q3 * rq * gq[3]);
        *(u32x2*)(CQ + (size_t)m * QL + 4 * lane) = w;
        ((unsigned short*)(ws + WS_CKV8))[(size_t)m * 64 + lane] = (unsigned short)__builtin_amdgcn_cvt_pk_fp8_f32(k0 * rk * gk[0], k1 * rk * gk[1], 0, false);
        const float ikn = ik * ri * gi;
        IK16[(size_t)m * IDXD + lane] = (f16)ikn;
        if (lane < 8) IW[(size_t)m * 8 + lane] = (float)pr[C_IW + lane] * 0.04419417382415922f;
    }
}
__device__ __forceinline__ void p3_rwkv_prep(const Args& a, LAS unsigned char* lds, int vcu, int G, int tid) {
    unsigned char* ws = a.ws;
    const f16* PROJ = (const f16*)(ws + WS_PROJ);
    f16* RWW = (f16*)(ws + WS_RWW); f16* RWA = (f16*)(ws + WS_RWA); f16* RWG = (f16*)(ws + WS_RWG);
    LAS float* xs = (LAS float*)lds;
    const float* mu = a.in[17];
    const int ch = tid;
    const float w0 = a.in[18][ch], a0 = a.in[20][ch];
    for (int u = vcu; u < MTOK / 16; u += G) {
        const int m0 = u * 16;
        __syncthreads();
        for (int e = tid; e < 16 * 288; e += 512) {
            const int t = e / 288, col = e % 288, m = m0 + t;
            const float cur = (float)PROJ[(size_t)m * IN_PAD + C_WD + col];
            const float prev = ((m & (SEQ - 1)) != 0) ? (float)PROJ[(size_t)(m - 1) * IN_PAD + C_WD + col] : 0.f;
            float v = cur + mu[1536 + col] * (prev - cur);
            if (col < 64) v = tanhf(v); else if (col >= 128) v = sigmoidf_(v);
            xs[t * 288 + col] = v;
        }
        __syncthreads();
        float dl[16], al[16], gl[16];
#pragma unroll
        for (int t = 0; t < 16; ++t) { dl[t] = 0.f; al[t] = 0.f; gl[t] = 0.f; }
        for (int kk = 0; kk < 64; ++kk) {
            const float wd = a.in[19][kk * 512 + ch], wa = a.in[21][kk * 512 + ch];
#pragma unroll
            for (int t = 0; t < 16; ++t) { dl[t] += xs[t * 288 + kk] * wd; al[t] += xs[t * 288 + 64 + kk] * wa; }
        }
        for (int kk = 0; kk < 160; ++kk) {
            const float wg = a.in[22][kk * 512 + ch];
#pragma unroll
            for (int t = 0; t < 16; ++t) gl[t] += xs[t * 288 + 128 + kk] * wg;
        }
#pragma unroll
        for (int t = 0; t < 16; ++t) {
            const float z = -(w0 + dl[t]);
            const float sp = z > 20.f ? z : log1pf(__expf(z));
            const float wlog = -sp - 0.5f;
            const float lw = -__expf(wlog);
            const float av = sigmoidf_(a0 + al[t]);
            const size_t o = (size_t)(m0 + t) * RW + ch;
            RWW[o] = (f16)lw; RWA[o] = (f16)av; RWG[o] = (f16)gl[t];
        }
    }
}

__device__ __forceinline__ unsigned f2key(float f) { const unsigned u = __builtin_bit_cast(unsigned, f); return (u & 0x80000000u) ? ~u : (u | 0x80000000u); }
__device__ __forceinline__ void p5_indexer(const Args& a, LAS unsigned char* lds, int vcu, int G, int wave, int lane) {
    unsigned char* ws = a.ws;
    const f16* QI = (const f16*)a.out;
    const float* IK32 = (const float*)(ws + WS_IK32); const float* IW = (const float*)(ws + WS_IW);
    unsigned short* SEL = (unsigned short*)(ws + WS_SEL);
    LAS float* sc = (LAS float*)(lds + wave * 16384);
    LAS float* iq = (LAS float*)(lds + AUX_OFF + wave * 2048);
    const int gw = vcu * NWAVES + wave, NGW = G * NWAVES;
    for (int q = gw; q < MTOK; q += NGW) {
        const int b = q >> 12, t = q & (SEQ - 1);
        unsigned short* sel = SEL + (size_t)q * TOPK;
        if (t < TOPK) {
#pragma unroll
            for (int j = 0; j < 4; ++j) { const int s = lane + 64 * j; sel[s] = (s <= t) ? (unsigned short)s : (unsigned short)0xFFFF; }
            continue;
        }
        { const f16x8 v = *(const f16x8*)(QI + (size_t)q * NQI + 1024 + 8 * lane);
#pragma unroll
          for (int e = 0; e < 8; ++e) iq[8 * lane + e] = (float)v[e]; }
        float wq[8];
#pragma unroll
        for (int h = 0; h < 8; ++h) wq[h] = IW[(size_t)q * 8 + h];
        asm volatile("s_waitcnt lgkmcnt(0)" ::: "memory");
        const int nj = (t >> 6) + 1;
        for (int j = 0; j < nj; ++j) {
            const int s = j * 64 + lane;
            const float* kr = IK32 + ((size_t)(b << 12) + (s <= t ? s : t)) * IDXD;
            float kx[64];
#pragma unroll
            for (int d4 = 0; d4 < 16; ++d4) { const f32x4 v = *(const f32x4*)(kr + 4 * d4); kx[4 * d4] = v[0]; kx[4 * d4 + 1] = v[1]; kx[4 * d4 + 2] = v[2]; kx[4 * d4 + 3] = v[3]; }
            float score = 0.f;
#pragma unroll
            for (int h = 0; h < 8; ++h) { float d0 = 0.f;
#pragma unroll
                for (int d4 = 0; d4 < 16; ++d4) { const f32x4 qv = *(const LAS f32x4*)(iq + h * 64 + 4 * d4); d0 += qv[0] * kx[4 * d4]; d0 += qv[1] * kx[4 * d4 + 1]; d0 += qv[2] * kx[4 * d4 + 2]; d0 += qv[3] * kx[4 * d4 + 3]; }
                score += wq[h] * fmaxf(d0, 0.f); }
            sc[s] = (s <= t) ? score : -INFINITY;
        }
        asm volatile("s_waitcnt lgkmcnt(0)" ::: "memory");
        const int nvalid = nj * 64;
        unsigned key[64];
#pragma unroll
        for (int j = 0; j < 64; ++j) { const int s = lane * 64 + j; key[j] = (s < nvalid) ? f2key(sc[s]) : 0u; }
        unsigned prefix = 0u;
        for (int bit = 31; bit >= 0; --bit) {
            const unsigned cand = prefix | (1u << bit);
            int c = 0;
#pragma unroll
            for (int j = 0; j < 64; ++j) c += (key[j] >= cand) ? 1 : 0;
#pragma unroll
            for (int o = 1; o < 64; o <<= 1) c += __shfl_xor(c, o);
            if (c >= TOPK) prefix = cand;
        }
        int cgt = 0, ceq = 0;
#pragma unroll
        for (int j = 0; j < 64; ++j) { cgt += (key[j] > prefix) ? 1 : 0; ceq += (key[j] == prefix) ? 1 : 0; }
        int sgt = cgt, seq = ceq;
#pragma unroll
        for (int o = 1; o < 64; o <<= 1) { const int x = __shfl_up(sgt, o), y = __shfl_up(seq, o); if (lane >= o) { sgt += x; seq += y; } }
        const int tot_gt = __shfl(sgt, 63);
        int pos_gt = sgt - cgt, rank_eq = seq - ceq;
        const int need = TOPK - tot_gt;
#pragma unroll
        for (int j = 0; j < 64; ++j) {
            const int s = lane * 64 + j;
            if (key[j] > prefix) { sel[pos_gt] = (unsigned short)s; ++pos_gt; }
            else if (key[j] == prefix) { if (rank_eq < need) sel[tot_gt + rank_eq] = (unsigned short)s; ++rank_eq; }
        }
    }
}

__device__ __forceinline__ int t5_bucket(int rel) {
    if (rel < 16) return rel;
    const int l = 16 + (int)(logf((float)rel * (1.f / 16.f)) / 2.0794415416798357f * 16.f);
    return l < 31 ? l : 31;
}
__device__ __forceinline__ void p6_attention(const Args& a, LAS unsigned char* lds, int vcu, int G, int wave, int lane) {
    unsigned char* ws = a.ws;
    const f16* QI = (const f16*)a.out; const f16* CKV = (const f16*)(ws + WS_CKV);
    const unsigned short* SEL = (const unsigned short*)(ws + WS_SEL);
    f16* OATT = (f16*)(ws + WS_OATT);
    const float* rel_bias = a.in[2];
    LAS float* qa = (LAS float*)(lds + wave * 16384);
    LAS float* pp = (LAS float*)(lds + wave * 16384 + 4096);
    LAS int* sidx = (LAS int*)(lds + wave * 16384 + 12288);
    const int gw = vcu * NWAVES + wave, NGW = G * NWAVES;
    for (int q = gw; q < MTOK; q += NGW) {
        const int b = q >> 12, t = q & (SEQ - 1);
#pragma unroll
        for (int i = 0; i < 2; ++i) { const f16x8 v = *(const f16x8*)(QI + (size_t)q * NQI + 512 * i + 8 * lane);
#pragma unroll
            for (int e = 0; e < 8; ++e) qa[512 * i + 8 * lane + e] = (float)v[e]; }
        asm volatile("s_waitcnt lgkmcnt(0)" ::: "memory");
        float lg[4][8];
        int srow[4]; bool okv[4];
#pragma unroll
        for (int i = 0; i < 4; ++i) {
            const int sraw = SEL[(size_t)q * TOPK + lane + 64 * i];
            okv[i] = sraw != 0xFFFF && sraw <= t;
            srow[i] = okv[i] ? sraw : 0;
            sidx[lane + 64 * i] = okv[i] ? sraw : -1;
#pragma unroll
            for (int h = 0; h < 8; ++h) lg[i][h] = 0.f;
        }
#pragma unroll 1
        for (int c8 = 0; c8 < 16; ++c8) {
            f16x8 kv[4];
#pragma unroll
            for (int i = 0; i < 4; ++i) kv[i] = *(const f16x8*)(CKV + ((size_t)(b << 12) + srow[i]) * KVL + 8 * c8);
#pragma unroll
            for (int h = 0; h < 8; ++h) {
                const f32x4 q0 = *(const LAS f32x4*)(qa + h * 128 + 8 * c8), q1 = *(const LAS f32x4*)(qa + h * 128 + 8 * c8 + 4);
#pragma unroll
                for (int i = 0; i < 4; ++i)
                    lg[i][h] += q0[0] * (float)kv[i][0] + q0[1] * (float)kv[i][1] + q0[2] * (float)kv[i][2] + q0[3] * (float)kv[i][3] + q1[0] * (float)kv[i][4] + q1[1] * (float)kv[i][5] + q1[2] * (float)kv[i][6] + q1[3] * (float)kv[i][7];
            }
        }
#pragma unroll
        for (int i = 0; i < 4; ++i) {
            const int bk = t5_bucket(t - srow[i]);
#pragma unroll
            for (int h = 0; h < 8; ++h) lg[i][h] = okv[i] ? lg[i][h] + rel_bias[bk * 8 + h] : -INFINITY;
        }
#pragma unroll
        for (int h = 0; h < 8; ++h) {
            float mx = fmaxf(fmaxf(lg[0][h], lg[1][h]), fmaxf(lg[2][h], lg[3][h]));
#pragma unroll
            for (int o = 1; o < 64; o <<= 1) mx = fmaxf(mx, __shfl_xor(mx, o));
            float e[4], s = 0.f;
#pragma unroll
            for (int i = 0; i < 4; ++i) { e[i] = __expf(lg[i][h] - mx); s += e[i]; }
            s = wave_sum(s);
            const float inv = 1.f / s;
#pragma unroll
            for (int i = 0; i < 4; ++i) pp[h * 256 + lane + 64 * i] = e[i] * inv;
        }
        asm volatile("s_waitcnt lgkmcnt(0)" ::: "memory");
        float o0[8], o1[8];
#pragma unroll
        for (int h = 0; h < 8; ++h) { o0[h] = 0.f; o1[h] = 0.f; }
        for (int kk = 0; kk < TOPK; ++kk) {
            const int s = sidx[kk];
            if (s < 0) continue;
            const f16x2 kv = *(const f16x2*)(CKV + ((size_t)(b << 12) + s) * KVL + 2 * lane);
            const float v0 = (float)kv[0], v1 = (float)kv[1];
#pragma unroll
            for (int h = 0; h < 8; ++h) { const float p = pp[h * 256 + kk]; o0[h] += p * v0; o1[h] += p * v1; }
        }
#pragma unroll
        for (int h = 0; h < 8; ++h) *(unsigned*)(OATT + (size_t)q * KOUT + h * 128 + 2 * lane) = pkh(o0[h], o1[h]);
        asm volatile("s_waitcnt lgkmcnt(0)" ::: "memory");
    }
}

constexpr int SC_PITCH = 8224, DSA_SEL_OFF = 16 * SC_PITCH, DSA_BL_OFF = DSA_SEL_OFF + 8192, DSA_HIST_OFF = 143936;
static_assert(DSA_BL_OFF + 129 * 8 * 4 <= DSA_HIST_OFF && DSA_HIST_OFF + 8 * 1280 <= MISC_OFF, "DSA LDS map");
typedef short v4i16_t __attribute__((ext_vector_type(4)));
__device__ __forceinline__ unsigned kv_off(unsigned row, unsigned ch) { return 256u * row + 16u * (ch ^ (((row & 3u) << 2) | ((row >> 2) & 3u))); }
__device__ __forceinline__ f16x4 tr_read16(LAS unsigned char* p) { return __builtin_bit_cast(f16x4, __builtin_amdgcn_ds_read_tr16_b64_v4i16((LAS v4i16_t*)p)); }
template <int CTRL, int RMASK> __device__ __forceinline__ int dpp_i(int x) { return __builtin_amdgcn_update_dpp(0, x, CTRL, RMASK, 0xF, false); }
template <int CTRL> __device__ __forceinline__ int dpp_iz(int x) { return __builtin_amdgcn_update_dpp(0, x, CTRL, 0xF, 0xF, true); }
__device__ __forceinline__ int wave_incl_scan_i(int x) { x += dpp_iz<0x111>(x); x += dpp_iz<0x112>(x); x += dpp_iz<0x114>(x); x += dpp_iz<0x118>(x);
    x += dpp_i<0x142, 0xA>(x); x += dpp_i<0x143, 0xC>(x); return x; }
__device__ __forceinline__ void p5_dsa(const Args& a, LAS unsigned char* lds, int G, int bx, int tid, int wave, int lane) {
    unsigned char* ws = a.ws;
    const f16* QI = (const f16*)a.out; const f16* IK16 = (const f16*)(ws + WS_IK16); const float* IW = (const float*)(ws + WS_IW);
    const f16* CKV = (const f16*)(ws + WS_CKV); f16* OATT = (f16*)(ws + WS_OATT);
    LAS unsigned short* SELL = (LAS unsigned short*)(lds + DSA_SEL_OFF);
    LAS float* BL = (LAS float*)(lds + DSA_BL_OFF);
    for (int e = tid; e < 129 * 8; e += 512) { const int rel = e >> 3, h = e & 7; BL[e] = a.in[2][t5_bucket(rel) * 8 + h]; }
    const int nunits = BATCH * (SEQ / 16);
    const bool balanced = (G == 256);
    const int niter = balanced ? 8 : (nunits + G - 1) / G;
#pragma unroll 1
    for (int it = 0; it < niter; ++it) {
        int b, tile;
        if (balanced) { b = bx & 7; const int r = bx >> 3, base = 64 * (it >> 1); tile = (it & 1) ? base + 63 - r : base + r; }
        else { const int u = it * G + bx; if (u >= nunits) break; b = u >> 8; tile = u & 255; }
        int lane_o = lane; asm volatile("" : "+v"(lane_o));
        const int r16 = lane_o & 15, g = lane_o >> 4;
        const int t0 = tile * 16;
        const size_t qb = (size_t)(b << 12);
        const int jn = ((t0 + 15) >> 7) + 1;
        lds_barrier();
#ifndef DSAREP
#define DSAREP 0
#endif
#ifndef DSA_NO_A
        for (int ra_ = 0; ra_ < ((DSAREP & 1) ? 2 : 1); ++ra_)
        if (t0 + 15 >= TOPK) {
            f16x8 afr[8][2]; f32x4 wv[4][2];
#pragma unroll
            for (int mt = 0; mt < 8; ++mt) { const int tg = mt >> 1, hf = mt & 1, t = t0 + 4 * tg + (r16 >> 2), h = 4 * hf + (r16 & 3);
#pragma unroll
                for (int ks = 0; ks < 2; ++ks) afr[mt][ks] = *(const f16x8*)(QI + (qb + t) * NQI + 1024 + h * 64 + 32 * ks + 8 * g); }
#pragma unroll
            for (int tg = 0; tg < 4; ++tg)
#pragma unroll
                for (int hf = 0; hf < 2; ++hf) wv[tg][hf] = *(const f32x4*)(IW + (qb + t0 + 4 * tg + g) * 8 + 4 * hf) * 65536.0f;
            const f32x2 cscale = {1.52587890625e-05f, 1.52587890625e-05f};
            f16x8 bn0[2], bn1[2], bn2[2];
            const f16* ikp = IK16 + (qb + 16 * wave + r16) * IDXD + 8 * g;
#pragma unroll
            for (int ks = 0; ks < 2; ++ks) { bn0[ks] = *(const f16x8*)(ikp + 32 * ks); bn1[ks] = bn0[ks]; bn2[ks] = bn0[ks];
                if (jn > 1) bn1[ks] = *(const f16x8*)(ikp + 128 * IDXD + 32 * ks);
                if (jn > 2) bn2[ks] = *(const f16x8*)(ikp + 256 * IDXD + 32 * ks); }
            for (int j = 0; j < jn; ++j) {
                const int s = 128 * j + 16 * wave + r16;
                f16x8 bfr[2]; bfr[0] = bn0[0]; bfr[1] = bn0[1];
                bn0[0] = bn1[0]; bn0[1] = bn1[1]; bn1[0] = bn2[0]; bn1[1] = bn2[1];
                if (j + 3 < jn) {
#pragma unroll
                    for (int ks = 0; ks < 2; ++ks) bn2[ks] = *(const f16x8*)(ikp + (size_t)(128 * (j + 3)) * IDXD + 32 * ks); }
                f32x4 acc[8];
#pragma unroll
                for (int mt = 0; mt < 8; ++mt) { acc[mt] = __builtin_amdgcn_mfma_f32_16x16x32_f16(afr[mt][0], bfr[0], (f32x4){0.f, 0.f, 0.f, 0.f}, 0, 0, 0);
                    acc[mt] = __builtin_amdgcn_mfma_f32_16x16x32_f16(afr[mt][1], bfr[1], acc[mt], 0, 0, 0); }
                asm volatile("s_nop 15\n\ts_nop 7" :: "v"(acc[0]), "v"(acc[1]), "v"(acc[2]), "v"(acc[3]), "v"(acc[4]), "v"(acc[5]), "v"(acc[6]), "v"(acc[7]));
                float scv[4];
#pragma unroll
                for (int tg = 0; tg < 4; ++tg) { f32x2 s2 = {0.f, 0.f};
#pragma unroll
                    for (int hf = 0; hf < 2; ++hf)
#pragma unroll
                        for (int p = 0; p < 2; ++p) { const f32x2 av = {acc[2 * tg + hf][2 * p], acc[2 * tg + hf][2 * p + 1]}; f32x2 r;
                            asm volatile("v_pk_mul_f32 %0, %1, %2 clamp" : "=v"(r) : "v"(av), "v"(cscale));
                            const f32x2 wp = {wv[tg][hf][2 * p], wv[tg][hf][2 * p + 1]}; s2 = r * wp + s2; }
                    scv[tg] = s2[0] + s2[1]; }
                if (j == jn - 1) {
#pragma unroll
                    for (int tg = 0; tg < 4; ++tg) if (s > t0 + 4 * tg + g) scv[tg] = -INFINITY; }
#pragma unroll
                for (int pr = 0; pr < 2; ++pr) {
                    const unsigned x = pkh(scv[2 * pr], scv[2 * pr + 1]);
                    const unsigned k2 = x ^ ((((x >> 15) & 0x00010001u) * 0x7FFFu) | 0x80008000u);
                    *(LAS unsigned short*)(lds + (4 * (2 * pr) + g) * SC_PITCH + s * 2) = (unsigned short)(k2 & 0xFFFFu);
                    *(LAS unsigned short*)(lds + (4 * (2 * pr + 1) + g) * SC_PITCH + s * 2) = (unsigned short)(k2 >> 16); }
            }
        }
#endif
        __builtin_amdgcn_sched_barrier(0); lds_barrier(); __builtin_amdgcn_sched_barrier(0);
#ifndef DSA_NO_C
#pragma unroll 1
        for (int rr = 0; rr < ((DSAREP & 2) ? 4 : 2); ++rr) {
            const int rl = 2 * wave + (rr & 1), t = t0 + rl;
            LAS unsigned short* sel = SELL + rl * 256;
            if (t < TOPK) {
#pragma unroll
                for (int k = 0; k < 4; ++k) { const int jx = lane_o + 64 * k; sel[jx] = (jx <= t) ? (unsigned short)jx : (unsigned short)0xFFFF; }
                continue;
            }
            const LAS unsigned* srow = (const LAS unsigned*)(lds + rl * SC_PITCH) + lane_o;
#define DSA_KEY(jj_) (srow[(jj_) * 64])
            LAS unsigned* hist = (LAS unsigned*)(lds + DSA_HIST_OFF + wave * 1280);
            unsigned prefix = 0u; int kneed = TOPK;
#pragma unroll 1
            for (int pass = 0; pass < 2; ++pass) {
                *(LAS u32x4*)(hist + 4 * lane_o) = (u32x4){0u, 0u, 0u, 0u};
                asm volatile("s_waitcnt lgkmcnt(0)" ::: "memory");
                if (pass == 0) {
#pragma unroll 4
                    for (int jj = 0; jj < jn; ++jj) { const unsigned k = DSA_KEY(jj);
                        __hip_atomic_fetch_add(hist + (k >> 24), 1u, __ATOMIC_RELAXED, __HIP_MEMORY_SCOPE_WORKGROUP);
                        __hip_atomic_fetch_add(hist + ((k >> 8) & 0xFFu), 1u, __ATOMIC_RELAXED, __HIP_MEMORY_SCOPE_WORKGROUP);
                        if (DSAREP & 8) { __hip_atomic_fetch_add(hist + (k >> 24), 1u, __ATOMIC_RELAXED, __HIP_MEMORY_SCOPE_WORKGROUP); __hip_atomic_fetch_add(hist + ((k >> 8) & 0xFFu), 1u, __ATOMIC_RELAXED, __HIP_MEMORY_SCOPE_WORKGROUP);
                            __hip_atomic_fetch_add(hist + (k >> 24), 0xFFFFFFFFu, __ATOMIC_RELAXED, __HIP_MEMORY_SCOPE_WORKGROUP); __hip_atomic_fetch_add(hist + ((k >> 8) & 0xFFu), 0xFFFFFFFFu, __ATOMIC_RELAXED, __HIP_MEMORY_SCOPE_WORKGROUP); } }
                } else {
#pragma unroll 4
                    for (int jj = 0; jj < jn; ++jj) { const unsigned k = DSA_KEY(jj);
                        const unsigned dump = 256u + (unsigned)lane_o;
                        __hip_atomic_fetch_add(hist + (((k >> 24) == prefix) ? ((k >> 16) & 0xFFu) : dump), 1u, __ATOMIC_RELAXED, __HIP_MEMORY_SCOPE_WORKGROUP);
                        __hip_atomic_fetch_add(hist + ((((k >> 8) & 0xFFu) == prefix) ? (k & 0xFFu) : dump), 1u, __ATOMIC_RELAXED, __HIP_MEMORY_SCOPE_WORKGROUP); }
                }
                asm volatile("s_waitcnt lgkmcnt(0)" ::: "memory");
                const u32x4 hv = *(const LAS u32x4*)(hist + 4 * lane_o);
                const int sl = (int)(hv.x + hv.y + hv.z + hv.w);
                const int pre = wave_incl_scan_i(sl);
                const int tot = __builtin_amdgcn_readlane(pre, 63);
                const int S = tot - pre + sl;
                const int excl = S - sl;
                const unsigned long long bm = __ballot(excl < kneed && S >= kneed);
                const int L = bm ? (int)__builtin_ctzll(bm) : 0;
                const int ex = __builtin_amdgcn_readlane(excl, L); const int h1 = __builtin_amdgcn_readlane((int)hv.y, L), h2 = __builtin_amdgcn_readlane((int)hv.z, L), h3 = __builtin_amdgcn_readlane((int)hv.w, L);
                int cabove = ex, bin;
                if (cabove + h3 >= kneed) bin = 3; else { cabove += h3;
                    if (cabove + h2 >= kneed) bin = 2; else { cabove += h2;
                        if (cabove + h1 >= kneed) bin = 1; else { cabove += h1; bin = 0; } } }
                prefix = (prefix << 8) | (unsigned)(4 * L + bin); kneed -= cabove;
            }
            const unsigned lo = prefix << 16, hi = (prefix + 1u) << 16;
            const int tot_gt = TOPK - kneed, need = kneed;
            LAS unsigned short* dumpp = (LAS unsigned short*)(hist + 256) + lane_o;
            for (int er_ = 0; er_ < ((DSAREP & 16) ? 2 : 1); ++er_) {
            int base = 0, tbase = 0;
#pragma unroll 2
            for (int jj = 0; jj < jn; ++jj) { const unsigned k = DSA_KEY(jj);
                const int s0 = 2 * (jj * 64 + lane_o); const unsigned kb = k << 16;
                const bool g0 = kb >= hi, g1 = k >= hi;
                const unsigned long long m0 = __ballot(g0), m1 = __ballot(g1);
                const int p0 = base + (int)__builtin_amdgcn_mbcnt_hi((unsigned)(m0 >> 32), __builtin_amdgcn_mbcnt_lo((unsigned)m0, 0u)); base += __popcll(m0);
                const int p1 = base + (int)__builtin_amdgcn_mbcnt_hi((unsigned)(m1 >> 32), __builtin_amdgcn_mbcnt_lo((unsigned)m1, 0u)); base += __popcll(m1);
                *(g0 ? sel + p0 : dumpp) = (unsigned short)s0;
                *(g1 ? sel + p1 : dumpp) = (unsigned short)(s0 + 1);
                const bool e0 = (kb >= lo) && !g0, e1 = (k >= lo) && !g1;
                const unsigned long long t0m = __ballot(e0), t1m = __ballot(e1);
                if (t0m | t1m) {
                    const int r0 = tbase + (int)__builtin_amdgcn_mbcnt_hi((unsigned)(t0m >> 32), __builtin_amdgcn_mbcnt_lo((unsigned)t0m, 0u)); tbase += __popcll(t0m);
                    const int r1 = tbase + (int)__builtin_amdgcn_mbcnt_hi((unsigned)(t1m >> 32), __builtin_amdgcn_mbcnt_lo((unsigned)t1m, 0u)); tbase += __popcll(t1m);
                    if (e0 && r0 < need) sel[tot_gt + r0] = (unsigned short)s0;
                    if (e1 && r1 < need) sel[tot_gt + r1] = (unsigned short)(s0 + 1);
                }
            }
            }
#undef DSA_KEY
        }
#endif
        __builtin_amdgcn_sched_barrier(0); lds_barrier(); __builtin_amdgcn_sched_barrier(0);
#ifndef DSA_NO_D
        LAS unsigned char* kvb = lds + wave * 16384;
        const unsigned char* CKV8 = ws + WS_CKV8;
#pragma unroll 1
        for (int rr = 0; rr < ((DSAREP & 4) ? 4 : 2); ++rr) {
            const int rl = 2 * wave + (rr & 1), t = t0 + rl; const size_t q = qb + t;
            const LAS unsigned short* sel = SELL + rl * 256;
            long qf8[4];
#pragma unroll
            for (int ks = 0; ks < 4; ++ks) { const f16x8 v = *(const f16x8*)(QI + q * NQI + (r16 & 7) * 128 + 32 * ks + 8 * g); const float zs = (r16 >= 8) ? 0.f : 64.f;
                int lo32 = __builtin_amdgcn_cvt_pk_fp8_f32((float)v[0] * zs, (float)v[1] * zs, 0, false); lo32 = __builtin_amdgcn_cvt_pk_fp8_f32((float)v[2] * zs, (float)v[3] * zs, lo32, true);
                int hi32 = __builtin_amdgcn_cvt_pk_fp8_f32((float)v[4] * zs, (float)v[5] * zs, 0, false); hi32 = __builtin_amdgcn_cvt_pk_fp8_f32((float)v[6] * zs, (float)v[7] * zs, hi32, true);
                qf8[ks] = (long)(((unsigned long long)(unsigned)hi32 << 32) | (unsigned)lo32); }
            float m_run = -1e30f, l_run = 0.f;
            f32x4 oE[4], oO[4];
#pragma unroll
            for (int cb = 0; cb < 4; ++cb) { oE[cb] = (f32x4){0.f, 0.f, 0.f, 0.f}; oO[cb] = (f32x4){0.f, 0.f, 0.f, 0.f}; }
            const int nch = (t < TOPK) ? (t >> 5) + 1 : 8;
#define DSA_DMA(ch_, buf_) do { _Pragma("unroll") for (int i = 0; i < 4; ++i) { const int R = 8 * i + (lane_o >> 3); \
                const unsigned ix = sel[32 * (ch_) + R]; const int srow = (ix == 0xFFFFu) ? 0 : (int)ix; \
                const unsigned lch = ((unsigned)lane_o & 7u) ^ ((unsigned)R & 7u); \
                __builtin_amdgcn_global_load_lds((const unsigned*)(CKV8 + (qb + srow) * 128 + 16 * lch), (LAS unsigned*)(kvb + (buf_) * 4096 + i * 1024), 16, 0, 0); } } while (0)
            asm volatile("s_waitcnt vmcnt(0)" ::: "memory");
            DSA_DMA(0, 0);
            const int qq = (lane_o & 15) >> 2, pp = lane_o & 3;
#pragma unroll 1
            for (int ch = 0; ch < nch; ++ch) {
                LAS unsigned char* kb = kvb + (ch & 1) * 4096;
                if (ch + 1 < nch) { DSA_DMA(ch + 1, (ch + 1) & 1); asm volatile("s_waitcnt vmcnt(4)" ::: "memory"); }
                else asm volatile("s_waitcnt vmcnt(0)" ::: "memory");
                f32x4 lg[2];
#pragma unroll
                for (int mt = 0; mt < 2; ++mt) { lg[mt] = (f32x4){0.f, 0.f, 0.f, 0.f}; const int row = 16 * mt + r16;
#pragma unroll
                    for (int ks = 0; ks < 4; ++ks) lg[mt] = __builtin_amdgcn_mfma_f32_16x16x32_fp8_fp8(*(const LAS long*)(kb + row * 128 + 16 * ((2 * ks + (g >> 1)) ^ (row & 7)) + 8 * (g & 1)), qf8[ks], lg[mt], 0, 0, 0); }
                float cmax = -INFINITY;
#pragma unroll
                for (int mt = 0; mt < 2; ++mt) { const u32x2 pk = *(const LAS u32x2*)(sel + 32 * ch + 16 * mt + 4 * g);
#pragma unroll
                    for (int e = 0; e < 4; ++e) { const unsigned ix = ((e & 2) ? pk.y : pk.x) >> ((e & 1) * 16) & 0xFFFFu;
                        const int rel = t - (int)ix; const int rc = rel < 128 ? rel : 128;
                        const float v = (ix == 0xFFFFu) ? -INFINITY : lg[mt][e] * 0.015625f + BL[(rc < 0 ? 0 : rc) * 8 + (r16 & 7)];
                        lg[mt][e] = v; cmax = fmaxf(cmax, v); } }
                cmax = fmaxf(cmax, __shfl_xor(cmax, 16)); cmax = fmaxf(cmax, __shfl_xor(cmax, 32));
                const float m_new = fmaxf(m_run, cmax); const float alpha = __expf(m_run - m_new); m_run = m_new;
                float ps = 0.f, pv[8];
#pragma unroll
                for (int mt = 0; mt < 2; ++mt)
#pragma unroll
                    for (int e = 0; e < 4; ++e) { const float p = __expf(lg[mt][e] - m_new); ps += p; pv[mt * 4 + e] = p; }
                int plo = __builtin_amdgcn_cvt_pk_fp8_f32(pv[0], pv[1], 0, false); plo = __builtin_amdgcn_cvt_pk_fp8_f32(pv[2], pv[3], plo, true);
                int phi = __builtin_amdgcn_cvt_pk_fp8_f32(pv[4], pv[5], 0, false); phi = __builtin_amdgcn_cvt_pk_fp8_f32(pv[6], pv[7], phi, true);
                const long pf8 = (long)(((unsigned long long)(unsigned)phi << 32) | (unsigned)plo);
                l_run = l_run * alpha + ps;
#pragma unroll
                for (int cb = 0; cb < 4; ++cb) { oE[cb] *= alpha; oO[cb] *= alpha; }
#pragma unroll
                for (int cb = 0; cb < 4; ++cb) {
                    const int r1 = 4 * g + qq, r2 = 16 + 4 * g + qq;
                    const u32x2 d1 = __builtin_bit_cast(u32x2, tr_read16(kb + r1 * 128 + 16 * ((2 * cb + (pp >> 1)) ^ (r1 & 7)) + 8 * (pp & 1)));
                    const u32x2 d2 = __builtin_bit_cast(u32x2, tr_read16(kb + r2 * 128 + 16 * ((2 * cb + (pp >> 1)) ^ (r2 & 7)) + 8 * (pp & 1)));
                    const unsigned xe0 = __builtin_amdgcn_perm(d1.y, d1.x, 0x06040200u), xo0 = __builtin_amdgcn_perm(d1.y, d1.x, 0x07050301u);
                    const unsigned xe1 = __builtin_amdgcn_perm(d2.y, d2.x, 0x06040200u), xo1 = __builtin_amdgcn_perm(d2.y, d2.x, 0x07050301u);
                    oE[cb] = __builtin_amdgcn_mfma_f32_16x16x32_fp8_fp8((long)(((unsigned long long)xe1 << 32) | xe0), pf8, oE[cb], 0, 0, 0);
                    oO[cb] = __builtin_amdgcn_mfma_f32_16x16x32_fp8_fp8((long)(((unsigned long long)xo1 << 32) | xo0), pf8, oO[cb], 0, 0, 0);
                }
                asm volatile("s_waitcnt lgkmcnt(0)" ::: "memory");
            }
#undef DSA_DMA
            l_run += __shfl_xor(l_run, 16); l_run += __shfl_xor(l_run, 32);
            const float inv = 1.f / l_run;
            if (r16 < 8) {
#pragma unroll
                for (int cb = 0; cb < 4; ++cb) { u32x4 w; w.x = pkh(oE[cb][0] * inv, oO[cb][0] * inv); w.y = pkh(oE[cb][1] * inv, oO[cb][1] * inv); w.z = pkh(oE[cb][2] * inv, oO[cb][2] * inv); w.w = pkh(oE[cb][3] * inv, oO[cb][3] * inv);
                    *(u32x4*)(OATT + q * KOUT + r16 * 128 + 32 * cb + 8 * g) = w; }
            }
        }
#endif
    }
}

template <int CTRL> __device__ __forceinline__ float dpp_f(float x) { return __builtin_bit_cast(float, __builtin_amdgcn_update_dpp(0, __builtin_bit_cast(int, x), CTRL, 0xF, 0xF, false)); }
__device__ __forceinline__ float row16_sum(float x) { x += dpp_f<0x128>(x); x += dpp_f<0x124>(x); x += dpp_f<0x122>(x); x += dpp_f<0x121>(x); return x; }
constexpr int SCAN_TB = 32;
__device__ __forceinline__ void p7_scan(const Args& a, LAS unsigned char* lds, int vcu, int G, int wave, int lane) {
    unsigned char* ws = a.ws;
    const f16* PROJ = (const f16*)(ws + WS_PROJ); const f16* RWW = (const f16*)(ws + WS_RWW); const f16* RWA = (const f16*)(ws + WS_RWA);
    float* YRAW = (float*)(ws + WS_YRAW);
    for (int u = vcu; u < BATCH * HRW * 2; u += G) {
        const int half = u & 1, h = (u >> 1) & 7, b = u >> 4;
        const int ch = h * 64 + lane;
        const float mu_r = a.in[17][ch], mu_k = a.in[17][512 + ch], mu_v = a.in[17][1024 + ch], kkc = a.in[23][ch], kac = a.in[24][ch];
        const int rr = lane >> 4, qd = lane & 15, irow = half * 32 + wave * 4 + rr;
        float S0 = 0.f, S1 = 0.f, S2 = 0.f, S3 = 0.f;
#define SCAN_LOAD(blk_) do { _Pragma("unroll") for (int tt = 0; tt < 4; ++tt) { const int t = (blk_) * SCAN_TB + wave * 4 + tt; const size_t m = (size_t)(b << 12) + t; \
            const f16* pr = PROJ + m * IN_PAD + h * 64 + lane; \
            st_r[tt] = (float)pr[C_R]; st_k[tt] = (float)pr[C_K]; st_v[tt] = (float)pr[C_V]; \
            if (t > 0) { st_rp[tt] = (float)pr[C_R - IN_PAD]; st_kp[tt] = (float)pr[C_K - IN_PAD]; st_vp[tt] = (float)pr[C_V - IN_PAD]; } else { st_rp[tt] = 0.f; st_kp[tt] = 0.f; st_vp[tt] = 0.f; } \
            st_lw[tt] = (float)RWW[m * RW + ch]; st_av[tt] = (float)RWA[m * RW + ch]; } } while (0)
#define SCAN_WRITE(buf_) do { LAS float* base_ = (LAS float*)(lds + (buf_) * 49152); _Pragma("unroll") for (int tt = 0; tt < 4; ++tt) { const int tl = wave * 4 + tt; \
            const float rs = st_r[tt] + mu_r * (st_rp[tt] - st_r[tt]), ks = st_k[tt] + mu_k * (st_kp[tt] - st_k[tt]), vs = st_v[tt] + mu_v * (st_vp[tt] - st_v[tt]); \
            const float kkv = ks * kkc; const float nrm = sqrtf(wave_sum(kkv * kkv)); const float kkn = kkv / fmaxf(nrm, 1e-12f); \
            const float av = st_av[tt]; const float km = ks * (1.f + (av - 1.f) * kac); \
            base_[0 * 2048 + tl * 64 + lane] = rs; base_[1 * 2048 + tl * 64 + lane] = __expf(st_lw[tt]); base_[2 * 2048 + tl * 64 + lane] = km; \
            base_[3 * 2048 + tl * 64 + lane] = vs; base_[4 * 2048 + tl * 64 + lane] = -kkn; base_[5 * 2048 + tl * 64 + lane] = kkn * av; } } while (0)
        float st_r[4], st_k[4], st_v[4], st_rp[4], st_kp[4], st_vp[4], st_lw[4], st_av[4];
        __syncthreads();
        SCAN_LOAD(0); SCAN_WRITE(0);
        constexpr int NBLK = SEQ / SCAN_TB;
        for (int blk = 0; blk < NBLK; ++blk) {
            __syncthreads();
            if (blk + 1 < NBLK) SCAN_LOAD(blk + 1);
            const LAS float* base = (const LAS float*)(lds + (blk & 1) * 49152);
            for (int tl = 0; tl < SCAN_TB; ++tl) {
                const f32x4 r4 = *(const LAS f32x4*)(base + 0 * 2048 + tl * 64 + 4 * qd), w4 = *(const LAS f32x4*)(base + 1 * 2048 + tl * 64 + 4 * qd), k4 = *(const LAS f32x4*)(base + 2 * 2048 + tl * 64 + 4 * qd);
                const f32x4 a4 = *(const LAS f32x4*)(base + 4 * 2048 + tl * 64 + 4 * qd), b4 = *(const LAS f32x4*)(base + 5 * 2048 + tl * 64 + 4 * qd);
                const float vi = base[3 * 2048 + tl * 64 + irow];
                float sa = S0 * a4[0] + S1 * a4[1] + S2 * a4[2] + S3 * a4[3];
                sa = row16_sum(sa);
                S0 = S0 * w4[0] + sa * b4[0] + vi * k4[0]; S1 = S1 * w4[1] + sa * b4[1] + vi * k4[1]; S2 = S2 * w4[2] + sa * b4[2] + vi * k4[2]; S3 = S3 * w4[3] + sa * b4[3] + vi * k4[3];
                float y = S0 * r4[0] + S1 * r4[1] + S2 * r4[2] + S3 * r4[3];
                y = row16_sum(y);
                if (qd == 0) YRAW[((size_t)(b << 12) + blk * SCAN_TB + tl) * RW + h * 64 + irow] = y;
            }
            if (blk + 1 < NBLK) SCAN_WRITE((blk + 1) & 1);
        }
        __syncthreads();
    }
}

__device__ __forceinline__ void p8_rwkv_post(const Args& a, int vcu, int G, int wave, int lane) {
    unsigned char* ws = a.ws;
    const f16* PROJ = (const f16*)(ws + WS_PROJ); const f16* RWA = (const f16*)(ws + WS_RWA); const f16* RWG = (const f16*)(ws + WS_RWG);
    const float* YRAW = (const float*)(ws + WS_YRAW); f16* OATT = (f16*)(ws + WS_OATT);
    const int gw = vcu * NWAVES + wave, NGW = G * NWAVES;
    for (int it = gw; it < MTOK * HRW; it += NGW) {
        const int m = it >> 3, h = it & 7, ch = h * 64 + lane, t = m & (SEQ - 1);
        const f16* pr = PROJ + (size_t)m * IN_PAD + ch;
        float r = (float)pr[C_R], k = (float)pr[C_K], v = (float)pr[C_V], rp = 0.f, kp = 0.f, vp = 0.f;
        if (t > 0) { rp = (float)pr[C_R - IN_PAD]; kp = (float)pr[C_K - IN_PAD]; vp = (float)pr[C_V - IN_PAD]; }
        const float rs = r + a.in[17][ch] * (rp - r), ks = k + a.in[17][512 + ch] * (kp - k), vs = v + a.in[17][1024 + ch] * (vp - v);
        const float av = (float)RWA[(size_t)m * RW + ch];
        const float km = ks * (1.f + (av - 1.f) * a.in[24][ch]);
        const float y = YRAW[(size_t)m * RW + ch];
        const float mean = wave_sum(y) * (1.f / 64.f); const float dy = y - mean;
        const float var = wave_sum(dy * dy) * (1.f / 64.f);
        const float yn = dy * rsqrtf(var + GN_EPS) * a.in[26][ch] + a.in[27][ch];
        const float bonus = wave_sum(rs * km * a.in[25][ch]) * vs;
        OATT[(size_t)m * KOUT + 1024 + ch] = (f16)((yn + bonus) * (float)RWG[(size_t)m * RW + ch]);
    }
}

typedef short bf16x8 __attribute__((ext_vector_type(8)));
typedef _Float16 f16x4v __attribute__((ext_vector_type(4)));
__device__ __forceinline__ unsigned f2bf(float f) { unsigned u = __builtin_bit_cast(unsigned, f); return (u + 0x7fffu + ((u >> 16) & 1u)) >> 16; }
__device__ __forceinline__ unsigned pkb(float lo, float hi) { unsigned r; asm("v_cvt_pk_bf16_f32 %0, %1, %2" : "=v"(r) : "v"(lo), "v"(hi)); return r; }
constexpr int XP = 144;
constexpr int XD_OFF = 0, XA_OFF = 9216, XG_OFF = 18432, XG_P = 336;
constexpr int LAB_OFF = 0, LAK_OFF = 9216, LRB_OFF = 18432, LRK_OFF = 27648;
constexpr int AB_OFF = 39936, RB_OFF = AB_OFF + 9216, BB_OFF = RB_OFF + 9216, KB_OFF = BB_OFF + 9216;
constexpr int TT_OFF = 39936, M1T_OFF = TT_OFF + 9216, A2T_OFF = M1T_OFF + 9216, U1T_OFF = A2T_OFF + 9216;
constexpr int AH_OFF = 76800, VH_OFF = AH_OFF + 9216, BP_OFF = VH_OFF + 9216, KP_OFF = BP_OFF + 9216, RH_OFF = KP_OFF + 9216;
constexpr int NRM_OFF = 122880, CUMB_OFF = NRM_OFF + 512, XCONST_OFF = CUMB_OFF + 1024;
constexpr size_t WS_WDT = 28 * MiB, WS_WAT = WS_WDT + 65536, WS_WGT = WS_WAT + 65536;
constexpr size_t WS_RWP = 32 * MiB, WS_RWQ = 64 * MiB, WS_RWR2 = 408 * MiB, WS_RWY1 = 440 * MiB, WS_RWS0 = 472 * MiB, WS_BON = 364 * MiB;
constexpr int NUNIT = BATCH * 64 * HRW;

__device__ __forceinline__ f16x8 rd_row(LAS unsigned char* base, int pitch, int row, int col) { return *(const LAS f16x8*)(base + row * pitch + col * 2); }
__device__ __forceinline__ bf16x8 rd_rowb(LAS unsigned char* base, int pitch, int row, int col) { return *(const LAS bf16x8*)(base + row * pitch + col * 2); }
__device__ __forceinline__ f16x8 rd_tr(LAS unsigned char* base, int k0, int c0, int g, int qq, int pp) {
    const f16x4 v0 = tr_read16(base + (k0 + 8 * g + qq) * XP + (c0 + 4 * pp) * 2), v1 = tr_read16(base + (k0 + 8 * g + 4 + qq) * XP + (c0 + 4 * pp) * 2);
    return (f16x8){v0[0], v0[1], v0[2], v0[3], v1[0], v1[1], v1[2], v1[3]};
}
__device__ __forceinline__ void wr4h(LAS unsigned char* p, const f32x4& v) { u32x2 w; w.x = pkh(v[0], v[1]); w.y = pkh(v[2], v[3]); *(LAS u32x2*)p = w; }
__device__ __forceinline__ float dpp_shr_f(float x, int) { return x; }
template <int CTRL> __device__ __forceinline__ float dpp_z(float x) { return __builtin_bit_cast(float, __builtin_amdgcn_update_dpp(0, __builtin_bit_cast(int, x), CTRL, 0xF, 0xF, true)); }
__device__ __forceinline__ float row16_incl_scan(float x) { x += dpp_z<0x111>(x); x += dpp_z<0x112>(x); x += dpp_z<0x114>(x); x += dpp_z<0x118>(x); return x; }
#define MFMA_H(a, b, c) __builtin_amdgcn_mfma_f32_16x16x32_f16((a), (b), (c), 0, 0, 0)
#define MFMA_B(a, b, c) __builtin_amdgcn_mfma_f32_16x16x32_bf16((a), (b), (c), 0, 0, 0)
#define MFMA_H16(a, b, c) __builtin_amdgcn_mfma_f32_16x16x16f16((a), (b), (c), 0, 0, 0)
__device__ __forceinline__ f16x4 cvt4h(const f32x4& v) { return (f16x4){(f16)v[0], (f16)v[1], (f16)v[2], (f16)v[3]}; }
__device__ __forceinline__ f32x4 cvt4f(const f16x4& v) { return (f32x4){(float)v[0], (float)v[1], (float)v[2], (float)v[3]}; }

__device__ __forceinline__ void p7x_chunks(const Args& a, LAS unsigned char* lds, int vcu, int G, int tid, int wave, int lane) {
    unsigned char* ws = a.ws;
    const f16* PROJ = (const f16*)(ws + WS_PROJ);
    const f16* WDT = (const f16*)(ws + WS_WDT); const f16* WAT = (const f16*)(ws + WS_WAT); const f16* WGT = (const f16*)(ws + WS_WGT);
    f16* RWG = (f16*)(ws + WS_RWG); f16* RWP = (f16*)(ws + WS_RWP); f16* RWQ = (f16*)(ws + WS_RWQ); f16* RWR2 = (f16*)(ws + WS_RWR2); f16* RWY1 = (f16*)(ws + WS_RWY1);
    float* BON = (float*)(ws + WS_BON);
    const float* mu = a.in[17];
    const f32x4 z4 = {0.f, 0.f, 0.f, 0.f};
    const bool bal = (G == 256); const int bxx = blockIdx.x;
    const int nit = bal ? 16 : (NUNIT + G - 1) / G;
#define X_UNIT(itx_) (bal ? ((((bxx & 7) * 64 + (((bxx >> 3) + 32 * (itx_)) >> 3)) * 8 + (((bxx >> 3) + 32 * (itx_)) & 7))) : (vcu + (itx_) * G))
    f16x4 rv0[9], rv1c, rv1p, prc[2], pkc[2], pvc[2], prp[2], pkp[2], pvp[2];
    f16x8 wfd[2][2], wfa[2][2], wfg[2][5];
    int h_tab = -1;
#define X_PREFETCH(u_) do { int lp = lane; asm volatile("" : "+v"(lp)); const int h_ = (u_) & 7, c_ = ((u_) >> 3) & 63, b_ = (u_) >> 9; const size_t m0_ = (size_t)(b_ << 12) + c_ * 64; \
        _Pragma("unroll") for (int i = 0; i < 9; ++i) { const int t_ = 8 * wave + i - 1; const bool ok_ = (t_ >= 0 || c_ > 0); const f16* rowp = PROJ + (m0_ + t_) * IN_PAD + C_WD; \
            rv0[i] = (f16x4){0, 0, 0, 0}; if (ok_) rv0[i] = *(const f16x4*)(rowp + 4 * lp); } \
        { const int t1_ = 8 * wave + (lp >> 3); const f16* rp1 = PROJ + (m0_ + t1_) * IN_PAD + C_WD + 256 + 4 * (lp & 7); rv1c = *(const f16x4*)rp1; rv1p = (f16x4){0, 0, 0, 0}; if (t1_ > 0 || c_ > 0) rv1p = *(const f16x4*)(rp1 - IN_PAD); } \
        _Pragma("unroll") for (int ci = 0; ci < 2; ++ci) { const int chr_ = h_ * 64 + 16 * (2 * (wave >> 2) + ci) + (lp & 15); \
            _Pragma("unroll") for (int ks = 0; ks < 2; ++ks) { wfd[ci][ks] = *(const f16x8*)(WDT + (size_t)chr_ * 64 + 32 * ks + 8 * (lp >> 4)); wfa[ci][ks] = *(const f16x8*)(WAT + (size_t)chr_ * 64 + 32 * ks + 8 * (lp >> 4)); } \
            _Pragma("unroll") for (int ks = 0; ks < 5; ++ks) wfg[ci][ks] = *(const f16x8*)(WGT + (size_t)chr_ * 192 + 32 * ks + 8 * (lp >> 4)); } \
        const int t2_ = 16 * (wave & 3) + (lp & 15); const size_t m_ = m0_ + t2_; \
        _Pragma("unroll") for (int ci = 0; ci < 2; ++ci) { const int ch_ = h_ * 64 + 16 * (2 * (wave >> 2) + ci) + 4 * (lp >> 4); \
            prc[ci] = *(const f16x4*)(PROJ + m_ * IN_PAD + C_R + ch_); pkc[ci] = *(const f16x4*)(PROJ + m_ * IN_PAD + C_K + ch_); pvc[ci] = *(const f16x4*)(PROJ + m_ * IN_PAD + C_V + ch_); \
            prp[ci] = (f16x4){0, 0, 0, 0}; pkp[ci] = (f16x4){0, 0, 0, 0}; pvp[ci] = (f16x4){0, 0, 0, 0}; \
            if ((c_ * 64 + t2_) != 0) { prp[ci] = *(const f16x4*)(PROJ + (m_ - 1) * IN_PAD + C_R + ch_); pkp[ci] = *(const f16x4*)(PROJ + (m_ - 1) * IN_PAD + C_K + ch_); pvp[ci] = *(const f16x4*)(PROJ + (m_ - 1) * IN_PAD + C_V + ch_); } } } while (0)
    { const int u0 = X_UNIT(0); if (u0 < NUNIT) X_PREFETCH(u0); }
#pragma unroll 1
    for (int itx = 0; itx < nit; ++itx) {
        const int u = X_UNIT(itx); if (u >= NUNIT) break;
        const int un = (itx + 1 < nit) ? X_UNIT(itx + 1) : NUNIT;
        int lane_o = lane; asm volatile("" : "+v"(lane_o));
        const int r16 = lane_o & 15, g = lane_o >> 4, qq = r16 >> 2, pp = lane_o & 3;
        const int h = u & 7, c = (u >> 3) & 63, b = u >> 9;
        const size_t m0 = (size_t)(b << 12) + c * 64;
        lds_barrier();
        if (h != h_tab) { h_tab = h;
            if (tid < 64) { const int ch = h * 64 + tid; LAS float* ct = (LAS float*)(lds + XCONST_OFF) + tid;
                ct[0] = mu[ch]; ct[64] = mu[512 + ch]; ct[128] = mu[1024 + ch]; ct[192] = a.in[18][ch]; ct[256] = a.in[20][ch]; ct[320] = a.in[23][ch]; ct[384] = a.in[24][ch]; ct[448] = a.in[25][ch]; } }
        {
            const f32x4 mu0 = *(const f32x4*)(mu + 1536 + 4 * lane_o); const f32x4 mu1 = *(const f32x4*)(mu + 1536 + 256 + 4 * (lane_o & 7));
            const float kf = lane_o < 16 ? 2.f : 1.f; const bool is_t = lane_o < 16, is_id = (lane_o >= 16 && lane_o < 32);
            LAS unsigned char* d0 = is_t ? lds + XD_OFF + 8 * lane_o : is_id ? lds + XA_OFF + 8 * (lane_o - 16) : lds + XG_OFF + 8 * (lane_o - 32);
            const int p0 = (lane_o < 32) ? XP : XG_P;
#pragma unroll
            for (int i = 0; i < 8; ++i) { const int t = 8 * wave + i; float o[4];
#pragma unroll
                for (int e = 0; e < 4; ++e) { const float cu = (float)rv0[i + 1][e], pv = (float)rv0[i][e]; const float x = cu + mu0[e] * (pv - cu);
                    const float sg = __builtin_amdgcn_rcpf(1.f + __expf(-kf * x)); o[e] = is_t ? 2.f * sg - 1.f : is_id ? x : sg; }
                u32x2 w; w.x = pkh(o[0], o[1]); w.y = pkh(o[2], o[3]); *(LAS u32x2*)(d0 + t * p0) = w; }
            {
                float o1[4];
#pragma unroll
                for (int e = 0; e < 4; ++e) { const float cu1 = (float)rv1c[e], pv1 = (float)rv1p[e]; const float x1 = cu1 + mu1[e] * (pv1 - cu1); o1[e] = __builtin_amdgcn_rcpf(1.f + __expf(-x1)); }
                u32x2 w1; w1.x = pkh(o1[0], o1[1]); w1.y = pkh(o1[2], o1[3]); *(LAS u32x2*)(lds + XG_OFF + (8 * wave + (lane_o >> 3)) * XG_P + (128 + 4 * (lane_o & 7)) * 2) = w1; }
        }
        lds_barrier();
        const int tb = wave & 3, cth = wave >> 2;
        const int t = 16 * tb + r16; const size_t m = m0 + t;
        f32x4 dA[2], aA[2], gA[2];
#pragma unroll
        for (int ci = 0; ci < 2; ++ci) {
            dA[ci] = z4; aA[ci] = z4; gA[ci] = z4;
#pragma unroll
            for (int ks = 0; ks < 2; ++ks) {
                dA[ci] = MFMA_H(wfd[ci][ks], rd_row(lds + XD_OFF, XP, t, 32 * ks + 8 * g), dA[ci]);
                aA[ci] = MFMA_H(wfa[ci][ks], rd_row(lds + XA_OFF, XP, t, 32 * ks + 8 * g), aA[ci]); }
#pragma unroll
            for (int ks = 0; ks < 5; ++ks) gA[ci] = MFMA_H(wfg[ci][ks], rd_row(lds + XG_OFF, XG_P, t, 32 * ks + 8 * g), gA[ci]);
        }
        float lwv[2][4], asg[2][4], rs[2][4], kp[2][4], vs[2][4], kkv[2][4], cl[2][4];
        float pn = 0.f, prk = 0.f;
#pragma unroll
        for (int ci = 0; ci < 2; ++ci) {
            const int chl = 16 * (2 * cth + ci) + 4 * g, ch = h * 64 + chl;
            const f16x4 rc = prc[ci], kc = pkc[ci], vc = pvc[ci], rp = prp[ci], kq = pkp[ci], vp = pvp[ci];
            const LAS float* ct = (const LAS float*)(lds + XCONST_OFF) + chl;
            const f32x4 mur = *(const LAS f32x4*)(ct), muk = *(const LAS f32x4*)(ct + 64), muv = *(const LAS f32x4*)(ct + 128);
            const f32x4 w0 = *(const LAS f32x4*)(ct + 192), a0 = *(const LAS f32x4*)(ct + 256), kkc = *(const LAS f32x4*)(ct + 320), kac = *(const LAS f32x4*)(ct + 384), rkc = *(const LAS f32x4*)(ct + 448);
            float gl[4];
#pragma unroll
            for (int e = 0; e < 4; ++e) {
                const float z = -(w0[e] + dA[ci][e]); const float sp = fmaxf(z, 0.f) + __logf(1.f + __expf(-fabsf(z)));
                lwv[ci][e] = -__expf(-sp - 0.5f);
                asg[ci][e] = sigmoidf_(a0[e] + aA[ci][e]); gl[e] = gA[ci][e];
                rs[ci][e] = (float)rc[e] + mur[e] * ((float)rp[e] - (float)rc[e]);
                const float ks_ = (float)kc[e] + muk[e] * ((float)kq[e] - (float)kc[e]);
                vs[ci][e] = (float)vc[e] + muv[e] * ((float)vp[e] - (float)vc[e]);
                kkv[ci][e] = ks_ * kkc[e]; pn += kkv[ci][e] * kkv[ci][e];
                kp[ci][e] = ks_ * (1.f + (asg[ci][e] - 1.f) * kac[e]);
                prk += rs[ci][e] * kp[ci][e] * rkc[e];
                cl[ci][e] = row16_incl_scan(lwv[ci][e]);
                if (r16 == 15) ((LAS float*)(lds + CUMB_OFF))[tb * 64 + chl + e] = cl[ci][e];
            }
            u32x2 gw; gw.x = pkh(gl[0], gl[1]); gw.y = pkh(gl[2], gl[3]); *(u32x2*)(RWG + m * RW + ch) = gw;
        }
        pn += __shfl_xor(pn, 16); pn += __shfl_xor(pn, 32); prk += __shfl_xor(prk, 16); prk += __shfl_xor(prk, 32);
        if (g == 0) { ((LAS float*)(lds + NRM_OFF))[t * 2 + cth] = pn; BON[((size_t)u * 64 + t) * 2 + cth] = prk; }
        lds_barrier();
        {
            const float nrm = sqrtf(((LAS float*)(lds + NRM_OFF))[t * 2] + ((LAS float*)(lds + NRM_OFF))[t * 2 + 1]); const float inrm = __builtin_amdgcn_rcpf(fmaxf(nrm, 1e-12f));
#pragma unroll
            for (int ci = 0; ci < 2; ++ci) {
                const int chl = 16 * (2 * cth + ci) + 4 * g;
                float Ab[4], Rb[4], Bb[4], Kb[4], Bp[4], Kp[4];
                const LAS float* cbp = (const LAS float*)(lds + CUMB_OFF) + chl;
                const f32x4 cb0 = *(const LAS f32x4*)(cbp), cb1 = *(const LAS f32x4*)(cbp + 64), cb2 = *(const LAS f32x4*)(cbp + 128), cb3 = *(const LAS f32x4*)(cbp + 192);
#pragma unroll
                for (int e = 0; e < 4; ++e) {
                    const float b0 = cb0[e], b1 = cb1[e], b2 = cb2[e], b3 = cb3[e];
                    const float pre = (tb > 0 ? b0 : 0.f) + (tb > 1 ? b1 : 0.f) + (tb > 2 ? b2 : 0.f);
                    const float cum = cl[ci][e] + pre, cumC = (b0 + b1) + (b2 + b3);
                    const float kkn = kkv[ci][e] * inrm, av = -kkn, bv = kkn * asg[ci][e];
                    const float eg = __expf(cum), egi = __expf(-cum), egc = __expf(cumC - cum);
                    Ab[e] = av * __expf(cum - lwv[ci][e]); Rb[e] = rs[ci][e] * eg; Bb[e] = bv * egi; Kb[e] = kp[ci][e] * egi; Bp[e] = bv * egc; Kp[e] = kp[ci][e] * egc;
                }
                const int ro = t * XP + chl * 2;
                u32x2 w;
                w.x = pkb(Ab[0], Ab[1]); w.y = pkb(Ab[2], Ab[3]); *(LAS u32x2*)(lds + AB_OFF + ro) = w;
                w.x = pkb(Rb[0], Rb[1]); w.y = pkb(Rb[2], Rb[3]); *(LAS u32x2*)(lds + RB_OFF + ro) = w;
                w.x = pkb(Bb[0], Bb[1]); w.y = pkb(Bb[2], Bb[3]); *(LAS u32x2*)(lds + BB_OFF + ro) = w;
                w.x = pkb(Kb[0], Kb[1]); w.y = pkb(Kb[2], Kb[3]); *(LAS u32x2*)(lds + KB_OFF + ro) = w;
                w.x = pkh(Ab[0], Ab[1]); w.y = pkh(Ab[2], Ab[3]); *(LAS u32x2*)(lds + AH_OFF + ro) = w;
                w.x = pkh(Rb[0], Rb[1]); w.y = pkh(Rb[2], Rb[3]); *(LAS u32x2*)(lds + RH_OFF + ro) = w;
                w.x = pkh(vs[ci][0], vs[ci][1]); w.y = pkh(vs[ci][2], vs[ci][3]); *(LAS u32x2*)(lds + VH_OFF + ro) = w;
                w.x = pkh(Bp[0], Bp[1]); w.y = pkh(Bp[2], Bp[3]); *(LAS u32x2*)(lds + BP_OFF + ro) = w;
                w.x = pkh(Kp[0], Kp[1]); w.y = pkh(Kp[2], Kp[3]); *(LAS u32x2*)(lds + KP_OFF + ro) = w;
            }
        }
        lds_barrier();
#pragma unroll 1
        for (int k = 0; k < 5; ++k) {
            const int idx = wave + 8 * k, prod = idx / 10, rem = idx - prod * 10;
            const int tb1 = rem >= 6 ? 3 : rem >= 3 ? 2 : rem >= 1 ? 1 : 0, ub = rem - (tb1 * (tb1 + 1)) / 2;
            LAS unsigned char* X = lds + ((prod < 2) ? AB_OFF : RB_OFF); LAS unsigned char* Y = lds + ((prod & 1) ? KB_OFF : BB_OFF);
            f32x4 acc = z4;
#pragma unroll
            for (int ks = 0; ks < 2; ++ks) acc = MFMA_B(rd_rowb(Y, XP, 16 * ub + r16, 32 * ks + 8 * g), rd_rowb(X, XP, 16 * tb1 + r16, 32 * ks + 8 * g), acc);
            const int tt = 16 * tb1 + r16, tau0 = 16 * ub + 4 * g; const int lim = (prod < 2) ? tt : tt + 1;
#pragma unroll
            for (int e = 0; e < 4; ++e) if (tau0 + e >= lim) acc[e] = 0.f;
            wr4h(lds + LAB_OFF + prod * 9216 + tt * XP + tau0 * 2, acc);
        }
#pragma unroll 1
        for (int k = 0; k < 3; ++k) {
            const int idx = wave + 8 * k, prod = idx / 6, rem = idx - prod * 6;
            const int tb1 = rem >= 5 ? 2 : rem >= 3 ? 1 : 0, ub = (rem >= 5) ? 3 : (rem >= 3) ? rem - 1 : rem + 1;
            wr4h(lds + LAB_OFF + prod * 9216 + (16 * tb1 + r16) * XP + (16 * ub + 4 * g) * 2, z4);
        }
        lds_barrier();
        if (wave == 0) {
            LAS unsigned char* L = lds + LAB_OFF; LAS unsigned char* TT = lds + TT_OFF;
            f32x4 TB[4][4]; f16x4 TAh[4];
            float idn[4];
#pragma unroll
            for (int e = 0; e < 4; ++e) idn[e] = (r16 == 4 * g + e) ? 1.f : 0.f;
#pragma unroll
            for (int i = 0; i < 4; ++i) {
                f16x4 XA = *(const LAS f16x4*)(L + (16 * i + r16) * XP + (16 * i + 4 * g) * 2);
                f16x4 XB = tr_read16(L + (16 * i + 4 * g + qq) * XP + (16 * i + 4 * pp) * 2);
                f32x4 TAf, TBf;
#pragma unroll
                for (int e = 0; e < 4; ++e) { TAf[e] = idn[e] + (float)XA[e]; TBf[e] = idn[e] + (float)XB[e]; }
#pragma unroll
                for (int lv = 0; lv < 3; ++lv) {
                    const f32x4 X2B = MFMA_H16(XA, XB, z4), X2A = MFMA_H16(XB, XA, z4);
                    XA = cvt4h(X2A); XB = cvt4h(X2B);
                    const f16x4 ta = cvt4h(TAf);
                    TBf = MFMA_H16(ta, XB, TBf); TAf = MFMA_H16(XB, ta, TAf);
                }
                TB[i][i] = TBf; TAh[i] = cvt4h(TAf);
            }
#pragma unroll
            for (int d = 1; d < 4; ++d)
#pragma unroll
                for (int j = 0; j + d < 4; ++j) { const int i = j + d;
                    f32x4 M = z4;
#pragma unroll
                    for (int kq2 = j; kq2 < i; ++kq2) M = MFMA_H16(*(const LAS f16x4*)(L + (16 * i + r16) * XP + (16 * kq2 + 4 * g) * 2), cvt4h(TB[kq2][j]), M);
                    TB[i][j] = MFMA_H16(TAh[i], cvt4h(M), z4);
                }
#pragma unroll
            for (int i = 0; i < 4; ++i)
#pragma unroll
                for (int j = 0; j < 4; ++j) wr4h(TT + (16 * j + r16) * XP + (16 * i + 4 * g) * 2, (j <= i) ? TB[i][j] : z4);
        } else {
#pragma unroll 1
            for (int idx = wave - 1; idx < 16; idx += 7) { const int tb1 = idx >> 2, ib = idx & 3;
                f32x4 acc = z4;
#pragma unroll
                for (int ks = 0; ks < 2; ++ks) acc = MFMA_H(rd_row(lds + LAK_OFF, XP, 16 * tb1 + r16, 32 * ks + 8 * g), rd_tr(lds + VH_OFF, 32 * ks, 16 * ib, g, qq, pp), acc);
                wr4h(lds + M1T_OFF + (16 * ib + r16) * XP + (16 * tb1 + 4 * g) * 2, acc);
            }
        }
        lds_barrier();
#pragma unroll 1
        for (int k = 0; k < 4; ++k) {
            const int idx = wave + 8 * k, which = idx >> 4, tb1 = (idx >> 2) & 3, nb = idx & 3;
            f32x4 acc = z4;
#pragma unroll
            for (int ks = 0; ks < 2; ++ks) {
                const f16x8 af = rd_tr(lds + TT_OFF, 32 * ks, 16 * tb1, g, qq, pp);
                const f16x8 bf = which ? rd_row(lds + M1T_OFF, XP, 16 * nb + r16, 32 * ks + 8 * g) : rd_tr(lds + AH_OFF, 32 * ks, 16 * nb, g, qq, pp);
                acc = MFMA_H(af, bf, acc);
            }
            wr4h(lds + (which ? U1T_OFF : A2T_OFF) + (16 * nb + r16) * XP + (16 * tb1 + 4 * g) * 2, acc);
        }
        lds_barrier();
        if (un < NUNIT) X_PREFETCH(un);
#pragma unroll 1
        for (int k = 0; k < 8; ++k) {
            const int idx = wave + 8 * k, kind = idx >> 4, a4 = (idx >> 2) & 3, b4 = idx & 3;
            f32x4 acc = z4;
            if (kind == 0) {
#pragma unroll
                for (int ks = 0; ks < 2; ++ks) acc = MFMA_H(rd_row(lds + A2T_OFF, XP, 16 * a4 + r16, 32 * ks + 8 * g), rd_tr(lds + BP_OFF, 32 * ks, 16 * b4, g, qq, pp), acc);
                if (a4 == b4) { const LAS float* cb = (const LAS float*)(lds + CUMB_OFF) + 16 * b4 + r16; const float gC = __expf((cb[0] + cb[64]) + (cb[128] + cb[192]));
#pragma unroll
                    for (int e = 0; e < 4; ++e) if (4 * g + e == r16) acc[e] += gC; }
                u32x2 w; w.x = pkh(acc[0], acc[1]); w.y = pkh(acc[2], acc[3]);
                *(u32x2*)(RWP + (size_t)u * 4096 + ((b4 * 2 + (a4 >> 1)) * 64 + lane_o) * 8 + (a4 & 1) * 4) = w;
            } else if (kind == 1) {
#pragma unroll
                for (int ks = 0; ks < 2; ++ks) { acc = MFMA_H(rd_tr(lds + BP_OFF, 32 * ks, 16 * a4, g, qq, pp), rd_row(lds + U1T_OFF, XP, 16 * b4 + r16, 32 * ks + 8 * g), acc);
                    acc = MFMA_H(rd_tr(lds + KP_OFF, 32 * ks, 16 * a4, g, qq, pp), rd_tr(lds + VH_OFF, 32 * ks, 16 * b4, g, qq, pp), acc); }
                u32x2 w; w.x = pkh(acc[0], acc[1]); w.y = pkh(acc[2], acc[3]);
                *(u32x2*)(RWQ + (size_t)u * 4096 + ((b4 * 4 + a4) * 64 + lane_o) * 4) = w;
            } else if (kind == 2) {
                { const f16x4 rh4 = *(const LAS f16x4*)(lds + RH_OFF + (16 * b4 + r16) * XP + (16 * a4 + 4 * g) * 2); acc = cvt4f(rh4); }
#pragma unroll
                for (int ks = 0; ks < 2; ++ks) acc = MFMA_H(rd_row(lds + A2T_OFF, XP, 16 * a4 + r16, 32 * ks + 8 * g), rd_row(lds + LRB_OFF, XP, 16 * b4 + r16, 32 * ks + 8 * g), acc);
                u32x2 w; w.x = pkh(acc[0], acc[1]); w.y = pkh(acc[2], acc[3]);
                *(u32x2*)(RWR2 + (size_t)u * 4096 + (16 * b4 + r16) * 64 + 16 * a4 + 4 * g) = w;
            } else {
#pragma unroll
                for (int ks = 0; ks < 2; ++ks) { acc = MFMA_H(rd_row(lds + U1T_OFF, XP, 16 * a4 + r16, 32 * ks + 8 * g), rd_row(lds + LRB_OFF, XP, 16 * b4 + r16, 32 * ks + 8 * g), acc);
                    acc = MFMA_H(rd_tr(lds + VH_OFF, 32 * ks, 16 * a4, g, qq, pp), rd_row(lds + LRK_OFF, XP, 16 * b4 + r16, 32 * ks + 8 * g), acc); }
                u32x2 w; w.x = pkh(acc[0], acc[1]); w.y = pkh(acc[2], acc[3]);
                *(u32x2*)(RWY1 + (size_t)u * 4096 + ((a4 * 4 + b4) * 64 + lane_o) * 4) = w;
            }
        }
    }
}

#undef X_UNIT
#undef X_PREFETCH
struct ChBuf { f16x8 p[4][2]; u32x2 q[4]; };
__device__ __forceinline__ void p7y_chain(const Args& a, int bx0, int G, int wave, int lane) {
    unsigned char* ws = a.ws;
    const f16* RWP = (const f16*)(ws + WS_RWP); const f16* RWQ = (const f16*)(ws + WS_RWQ); f16* RWS0 = (f16*)(ws + WS_RWS0);
    if (wave != 0) return;
#pragma unroll 1
    for (int bx = bx0; bx < 256; bx += G) {
    const int r16 = lane & 15, g = lane >> 4;
    const int b = bx & 7, rest = bx >> 3, h = rest >> 2, it = rest & 3;
    f32x4 S[4];
#pragma unroll
    for (int mt = 0; mt < 4; ++mt) S[mt] = (f32x4){0.f, 0.f, 0.f, 0.f};
    ChBuf B0, B1, B2, B3;
#define CH_LOAD(BUF, c_) do { const size_t uu = ((size_t)(b * 64 + (c_)) * 8 + h); \
        _Pragma("unroll") for (int mo = 0; mo < 4; ++mo) { BUF.q[mo] = *(const u32x2*)(RWQ + uu * 4096 + ((it * 4 + mo) * 64 + lane) * 4); \
            _Pragma("unroll") for (int ks = 0; ks < 2; ++ks) BUF.p[mo][ks] = *(const f16x8*)(RWP + uu * 4096 + ((mo * 2 + ks) * 64 + lane) * 8); } } while (0)
#define CH_STEP(BUF, c_) do { const size_t uu = ((size_t)(b * 64 + (c_)) * 8 + h); f16x8 bfr[2]; \
        _Pragma("unroll") for (int mt = 0; mt < 4; ++mt) { u32x2 w; w.x = pkh(S[mt][0], S[mt][1]); w.y = pkh(S[mt][2], S[mt][3]); \
            *(u32x2*)(RWS0 + uu * 4096 + (16 * it + r16) * 64 + 16 * mt + 4 * g) = w; const f16x4 hv = __builtin_bit_cast(f16x4, w); \
            bfr[mt >> 1][(mt & 1) * 4 + 0] = hv[0]; bfr[mt >> 1][(mt & 1) * 4 + 1] = hv[1]; bfr[mt >> 1][(mt & 1) * 4 + 2] = hv[2]; bfr[mt >> 1][(mt & 1) * 4 + 3] = hv[3]; } \
        _Pragma("unroll") for (int mo = 0; mo < 4; ++mo) { f32x4 n_ = cvt4f(__builtin_bit_cast(f16x4, BUF.q[mo])); \
            _Pragma("unroll") for (int ks = 0; ks < 2; ++ks) n_ = MFMA_H(BUF.p[mo][ks], bfr[ks], n_); S[mo] = n_; } \
        if ((c_) + 4 < 64) CH_LOAD(BUF, (c_) + 4); } while (0)
    CH_LOAD(B0, 0); CH_LOAD(B1, 1); CH_LOAD(B2, 2); CH_LOAD(B3, 3);
#pragma unroll 1
    for (int c = 0; c < 64; c += 4) { CH_STEP(B0, c); CH_STEP(B1, c + 1); CH_STEP(B2, c + 2); CH_STEP(B3, c + 3); }
    }
#undef CH_LOAD
#undef CH_STEP
}

__device__ __forceinline__ void p8z_out(const Args& a, int vcu, int G, int wave, int lane) {
    unsigned char* ws = a.ws;
    const f16* PROJ = (const f16*)(ws + WS_PROJ); const f16* RWG = (const f16*)(ws + WS_RWG);
    const f16* RWR2 = (const f16*)(ws + WS_RWR2); const f16* RWY1 = (const f16*)(ws + WS_RWY1); const f16* RWS0 = (const f16*)(ws + WS_RWS0);
    const float* BON = (const float*)(ws + WS_BON); f16* OATT = (f16*)(ws + WS_OATT);
    const int gw = vcu * NWAVES + wave, NGW = G * NWAVES;
    const bool bal = (G == 256); const int bxx = blockIdx.x;
    const int nit = bal ? 2 : (NUNIT + NGW - 1) / NGW;
#pragma unroll 1
    for (int itx = 0; itx < nit; ++itx) {
        int u;
        if (bal) { const int idx = (bxx >> 3) * 8 + wave + 256 * itx; u = (((bxx & 7) * 64 + (idx >> 3)) * 8 + (idx & 7)); } else { u = gw + itx * NGW; if (u >= NUNIT) break; }
        int lane_o = lane; asm volatile("" : "+v"(lane_o));
        const int r16 = lane_o & 15, g = lane_o >> 4;
        const int h = u & 7, c = (u >> 3) & 63, b = u >> 9;
        const size_t m0 = (size_t)(b << 12) + c * 64;
        f32x4 acc[4][4];
#pragma unroll
        for (int mt = 0; mt < 4; ++mt)
#pragma unroll
            for (int nt = 0; nt < 4; ++nt) acc[mt][nt] = cvt4f(*(const f16x4*)(RWY1 + (size_t)u * 4096 + ((mt * 4 + nt) * 64 + lane_o) * 4));
#pragma unroll
        for (int ks = 0; ks < 2; ++ks) {
            f16x8 sf[4], rf[4];
#pragma unroll
            for (int x = 0; x < 4; ++x) { sf[x] = *(const f16x8*)(RWS0 + (size_t)u * 4096 + (16 * x + r16) * 64 + 32 * ks + 8 * g); rf[x] = *(const f16x8*)(RWR2 + (size_t)u * 4096 + (16 * x + r16) * 64 + 32 * ks + 8 * g); }
#pragma unroll
            for (int mt = 0; mt < 4; ++mt)
#pragma unroll
                for (int nt = 0; nt < 4; ++nt) acc[mt][nt] = MFMA_H(sf[mt], rf[nt], acc[mt][nt]);
        }
#pragma unroll
        for (int nt = 0; nt < 4; ++nt) {
            const int t = 16 * nt + r16; const size_t m = m0 + t;
            float s = 0.f;
#pragma unroll
            for (int mt = 0; mt < 4; ++mt) s += (acc[mt][nt][0] + acc[mt][nt][1]) + (acc[mt][nt][2] + acc[mt][nt][3]);
            s += __shfl_xor(s, 16); s += __shfl_xor(s, 32);
            const float mean = s * (1.f / 64.f); float q = 0.f;
#pragma unroll
            for (int mt = 0; mt < 4; ++mt)
#pragma unroll
                for (int e = 0; e < 4; ++e) { const float d = acc[mt][nt][e] - mean; q += d * d; }
            q += __shfl_xor(q, 16); q += __shfl_xor(q, 32);
            const float rstd = rsqrtf(q * (1.f / 64.f) + GN_EPS);
            const f32x2 bo = *(const f32x2*)(BON + ((size_t)u * 64 + t) * 2); const float bonus = bo[0] + bo[1];
#pragma unroll
            for (int mt = 0; mt < 4; ++mt) {
                const int ch = h * 64 + 16 * mt + 4 * g;
                const f16x4 vc = *(const f16x4*)(PROJ + m * IN_PAD + C_V + ch);
                f16x4 vp = {0, 0, 0, 0}; if ((c * 64 + t) != 0) vp = *(const f16x4*)(PROJ + (m - 1) * IN_PAD + C_V + ch);
                const f32x4 muv = *(const f32x4*)(a.in[17] + 1024 + ch), gn = *(const f32x4*)(a.in[26] + ch), bs = *(const f32x4*)(a.in[27] + ch);
                const f16x4 gg = *(const f16x4*)(RWG + m * RW + ch);
                float o[4];
#pragma unroll
                for (int e = 0; e < 4; ++e) { const float vsv = (float)vc[e] + muv[e] * ((float)vp[e] - (float)vc[e]);
                    o[e] = ((acc[mt][nt][e] - mean) * rstd * gn[e] + bs[e] + bonus * vsv) * (float)gg[e]; }
                u32x2 w; w.x = pkh(o[0], o[1]); w.y = pkh(o[2], o[3]);
                *(u32x2*)(OATT + m * KOUT + 1024 + ch) = w;
            }
        }
    }
}

__device__ __forceinline__ void p10_mid(const Args& a, int vcu, int G, int wave, int lane) {
    unsigned char* ws = a.ws;
    const f16* MIX = (const f16*)(ws + WS_MIX); const float* mod = (const float*)(ws + WS_MOD); f16* HF = (f16*)(ws + WS_H);
    const int gw = vcu * NWAVES + wave, NGW = G * NWAVES;
    for (int m = gw; m < MTOK; m += NGW) {
        const int b = m >> 12; const float* md = mod + b * 6144;
        float mx[16], xv[16]; float s = 0.f;
#pragma unroll
        for (int j = 0; j < 2; ++j) { const int c = 8 * lane + 512 * j; const f16x8 v = *(const f16x8*)(MIX + (size_t)m * D + c);
#pragma unroll
            for (int e = 0; e < 8; ++e) { mx[8 * j + e] = (float)v[e]; s += mx[8 * j + e] * mx[8 * j + e]; }
            const f32x4 x0 = *(const f32x4*)(a.in[0] + (size_t)m * D + c), x1 = *(const f32x4*)(a.in[0] + (size_t)m * D + c + 4);
#pragma unroll
            for (int e = 0; e < 4; ++e) { xv[8 * j + e] = x0[e]; xv[8 * j + 4 + e] = x1[e]; } }
        const float r = rsqrtf(wave_sum(s) * (1.f / D) + NORM_EPS);
        float s1 = 0.f;
#pragma unroll
        for (int j = 0; j < 2; ++j) { const int c = 8 * lane + 512 * j;
#pragma unroll
            for (int e = 0; e < 8; ++e) { const float x1 = xv[8 * j + e] + md[2048 + c + e] * (mx[8 * j + e] * r * a.in[6][c + e]); xv[8 * j + e] = x1; s1 += x1 * x1; }
            *(f32x4*)(a.out + (size_t)m * D + c) = (f32x4){xv[8 * j], xv[8 * j + 1], xv[8 * j + 2], xv[8 * j + 3]};
            *(f32x4*)(a.out + (size_t)m * D + c + 4) = (f32x4){xv[8 * j + 4], xv[8 * j + 5], xv[8 * j + 6], xv[8 * j + 7]}; }
        const float r1 = rsqrtf(wave_sum(s1) * (1.f / D) + NORM_EPS);
#pragma unroll
        for (int j = 0; j < 2; ++j) { const int c = 8 * lane + 512 * j; float y[8];
#pragma unroll
            for (int e = 0; e < 8; ++e) y[e] = xv[8 * j + e] * r1 * a.in[7][c + e] * (1.f + md[4096 + c + e]) + md[3072 + c + e];
            u32x4 w; w.x = pkh(y[0], y[1]); w.y = pkh(y[2], y[3]); w.z = pkh(y[4], y[5]); w.w = pkh(y[6], y[7]);
            *(u32x4*)(HF + (size_t)m * D + c) = w; }
    }
}
__device__ __forceinline__ void p13_final(const Args& a, int vcu, int G, int wave, int lane) {
    unsigned char* ws = a.ws;
    const f16* F = (const f16*)(ws + WS_F); const float* mod = (const float*)(ws + WS_MOD);
    const int gw = vcu * NWAVES + wave, NGW = G * NWAVES;
    for (int m = gw; m < MTOK; m += NGW) {
        const int b = m >> 12; const float* md = mod + b * 6144;
        float fv[16]; float s = 0.f;
#pragma unroll
        for (int j = 0; j < 2; ++j) { const int c = 8 * lane + 512 * j; const f16x8 v = *(const f16x8*)(F + (size_t)m * D + c);
#pragma unroll
            for (int e = 0; e < 8; ++e) { fv[8 * j + e] = (float)v[e]; s += fv[8 * j + e] * fv[8 * j + e]; } }
        const float r = rsqrtf(wave_sum(s) * (1.f / D) + NORM_EPS);
#pragma unroll
        for (int j = 0; j < 2; ++j) { const int c = 8 * lane + 512 * j;
            f32x4 x0 = *(const f32x4*)(a.out + (size_t)m * D + c), x1 = *(const f32x4*)(a.out + (size_t)m * D + c + 4);
#pragma unroll
            for (int e = 0; e < 4; ++e) { x0[e] += md[5120 + c + e] * (fv[8 * j + e] * r * a.in[8][c + e]); x1[e] += md[5120 + c + 4 + e] * (fv[8 * j + 4 + e] * r * a.in[8][c + 4 + e]); }
            *(f32x4*)(a.out + (size_t)m * D + c) = x0; *(f32x4*)(a.out + (size_t)m * D + c + 4) = x1; }
    }
}

constexpr int NPHASE = 14;
__global__ void __launch_bounds__(NWAVES * 64, 2) fwd(Args args) {
    extern __shared__ __attribute__((aligned(16))) unsigned char lds_raw[];
    LAS unsigned char* lds = (LAS unsigned char*)lds_raw;
    const int tid = threadIdx.x, lane = tid & 63, wave = __builtin_amdgcn_readfirstlane(tid >> 6);
    const int G = gridDim.x; const int bx = blockIdx.x; const int vcu = (G % 8 == 0) ? (bx % 8) * (G / 8) + bx / 8 : bx;
    volatile LAS unsigned* MISC = (volatile LAS unsigned*)(lds + MISC_OFF);
    if (tid < 16) MISC[tid] = 0u;
    __syncthreads();
    const int lo = args.ph_lo, hi = args.ph_hi;
    unsigned* barw = (unsigned*)(args.ws + WS_CTL) + CW_BAR;
    XcdBarrier bar; bar.bar = barw; bar.x = 0; bar.st = nullptr;
    if (hi - lo > 1) bar = xcd_barrier_post(barw, MISC);
#ifndef PHMASK
#define PHMASK 0x3FFF
#endif
#ifndef REPMASK
#define REPMASK 0
#endif
#define IN(k) (((PHMASK >> (k)) & 1) && lo <= (k) && (k) < hi)
#define REP(k) for (int rep_ = 0; rep_ < (((REPMASK >> (k)) & 1) ? 2 : 1); ++rep_)
#define SEAM(k) do { if (IN(k) && IN((k) + 1)) xcd_barrier(bar); } while (0)
    unsigned char* ws = args.ws;
    if (IN(0)) REP(0) { if (rep_) __syncthreads(); p0_prologue(args, lds, vcu, G, wave, lane); } SEAM(0);
    if (IN(1)) REP(1) { if (rep_) __syncthreads(); p1_modnorm(args, vcu, G, wave, lane); } SEAM(1);
    if (IN(2)) REP(2) { if (rep_) __syncthreads(); pg8::Gemm g{(const f16*)(ws + WS_H), (const f16*)(ws + WS_WIN), MTOK, IN_PAD, D}; pg8::StaticOrder S; S.init(MTOK, IN_PAD, G, bx);
        pg8::EpiF16 E{(f16*)(ws + WS_PROJ), IN_PAD}; pg8::gemm_phase<pg8::EpiF16, pg8::StaticOrder, true, true>(lds, g, S, E); } SEAM(2);
#ifdef OLD_BASELINE
    if (IN(5)) REP(5) { if (rep_) __syncthreads(); p5_indexer(args, lds, vcu, G, wave, lane); } SEAM(5);
    if (IN(6)) REP(6) { if (rep_) __syncthreads(); p6_attention(args, lds, vcu, G, wave, lane); p3_rwkv_prep(args, lds, vcu, G, tid); } SEAM(6);
    if (IN(7)) REP(7) { if (rep_) __syncthreads(); p7_scan(args, lds, vcu, G, wave, lane); } SEAM(7);
    if (IN(8)) REP(8) { if (rep_) __syncthreads(); p8_rwkv_post(args, vcu, G, wave, lane); } SEAM(8);
#else
#define SEAMX() do { if (hi - lo > 1) xcd_barrier(bar); } while (0)
    if (IN(3)) REP(3) { if (rep_) __syncthreads(); p3_rows(args, vcu, G, wave, lane); }
    if (IN(6)) REP(6) { __syncthreads(); p7x_chunks(args, lds, vcu, G, tid, wave, lane); } SEAMX();
    if (IN(4)) REP(4) { if (rep_) __syncthreads(); pg8::Gemm g{(const f16*)(ws + WS_CQ), (const f16*)(ws + WS_WCQ), MTOK, NQI, QL}; pg8::StaticOrder S; S.init(MTOK, NQI, G, bx);
        pg8::EpiF16 E{(f16*)args.out, NQI}; pg8::gemm_phase<pg8::EpiF16, pg8::StaticOrder, true, true>(lds, g, S, E); }
    if (IN(7)) REP(7) { __syncthreads(); p7y_chain(args, bx, G, wave, lane); } SEAMX();
    if (IN(5)) REP(5) { if (rep_) __syncthreads(); p5_dsa(args, lds, G, bx, tid, wave, lane); }
    if (IN(8)) REP(8) { __syncthreads(); p8z_out(args, vcu, G, wave, lane); } SEAMX();
#endif
    if (IN(9)) REP(9) { if (rep_) __syncthreads(); pg8::Gemm g{(const f16*)(ws + WS_OATT), (const f16*)(ws + WS_WOUT), MTOK, D, KOUT}; pg8::StaticOrder S; S.init(MTOK, D, G, bx);
        pg8::EpiF16 E{(f16*)(ws + WS_MIX), D}; pg8::gemm_phase<pg8::EpiF16, pg8::StaticOrder, true, true>(lds, g, S, E); } SEAM(9);
    if (IN(10)) REP(10) { if (rep_) __syncthreads(); p10_mid(args, vcu, G, wave, lane); } SEAM(10);
    if (IN(11)) REP(11) { if (rep_) __syncthreads(); pg8::Gemm g{(const f16*)(ws + WS_H), (const f16*)(ws + WS_WGU), MTOK, 2 * DFF, D}; pg8::StaticOrder S; S.init(MTOK, 2 * DFF, G, bx);
        pg8::EpiSwiGLU E{(f16*)(ws + WS_ACT), DFF}; pg8::gemm_phase<pg8::EpiSwiGLU, pg8::StaticOrder, true, true>(lds, g, S, E); } SEAM(11);
    if (IN(12)) REP(12) { if (rep_) __syncthreads(); pg8::Gemm g{(const f16*)(ws + WS_ACT), (const f16*)(ws + WS_WDN), MTOK, D, DFF}; pg8::StaticOrder S; S.init(MTOK, D, G, bx);
        pg8::EpiF16 E{(f16*)(ws + WS_F), D}; pg8::gemm_phase<pg8::EpiF16, pg8::StaticOrder, true, true>(lds, g, S, E); } SEAM(12);
    if (IN(13)) REP(13) { if (rep_) __syncthreads(); p13_final(args, vcu, G, wave, lane); }
#undef IN
#undef SEAM
}

#ifndef N_LAUNCH_MODE
#define N_LAUNCH_MODE 1
#endif
extern "C" void kernel_launch(void* const* d_in, const int* in_sizes, int n_in, void* d_out, int out_size, void* d_ws, size_t ws_size, hipStream_t stream) {
    static int grid = 0;
    if (grid == 0) {
        int dev = 0, cus = 0, per_cu = 0;
        if (n_in != 32 || ws_size < WS_END) { fprintf(stderr, "kernel_launch: unexpected n_in %d or ws_size %zu (< %zu)\n", n_in, ws_size, (size_t)WS_END); }
        if (hipGetDevice(&dev) != hipSuccess || hipDeviceGetAttribute(&cus, hipDeviceAttributeMultiprocessorCount, dev) != hipSuccess) { grid = -1; return; }
        if (hipFuncSetAttribute((const void*)fwd, hipFuncAttributeMaxDynamicSharedMemorySize, LDS_BYTES) != hipSuccess) { fprintf(stderr, "kernel_launch: hipFuncSetAttribute failed\n"); grid = -1; return; }
        if (hipOccupancyMaxActiveBlocksPerMultiprocessor(&per_cu, (const void*)fwd, NWAVES * 64, LDS_BYTES) != hipSuccess || per_cu < 1) fprintf(stderr, "kernel_launch: occupancy query says %d\n", per_cu);
        (void)hipGetLastError();
        grid = cus;
    }
    if (grid < 0) return;
    (void)hipMemsetAsync((char*)d_ws + WS_CTL, 0, CTL_ZERO_BYTES, stream);
    Args a{};
    for (int i = 0; i < 32; ++i) a.in[i] = (const float*)d_in[i];
    a.out = (float*)d_out; a.ws = (unsigned char*)d_ws;
    if (N_LAUNCH_MODE == 1) { a.ph_lo = 0; a.ph_hi = NPHASE; hipLaunchKernelGGL(fwd, dim3(grid), dim3(NWAVES * 64), LDS_BYTES, stream, a); }
    else for (int p = 0; p < NPHASE; ++p) { a.ph_lo = p; a.ph_hi = p + 1; hipLaunchKernelGGL(fwd, dim3(grid), dim3(NWAVES * 64), LDS_BYTES, stream, a); }
}
```

```cpp
#include <hip/hip_runtime.h>
#include <cstdio>
#include <cstdint>

#define LAS __attribute__((address_space(3)))
#define GAS __attribute__((address_space(1)))
typedef _Float16 f16;
typedef _Float16 f16x8 __attribute__((ext_vector_type(8)));
typedef _Float16 f16x4 __attribute__((ext_vector_type(4)));
typedef _Float16 f16x2 __attribute__((ext_vector_type(2)));
typedef float f32x4 __attribute__((ext_vector_type(4)));
typedef float f32x2 __attribute__((ext_vector_type(2)));
typedef unsigned u32x4 __attribute__((ext_vector_type(4)));
typedef unsigned u32x2 __attribute__((ext_vector_type(2)));

__device__ __forceinline__ unsigned pkh(float a, float b) { f16x2 v = {(f16)a, (f16)b}; return __builtin_bit_cast(unsigned, v); }
__device__ __forceinline__ float h2f(f16 h) { return (float)h; }

namespace pg8 {
constexpr int BM = 256, BK = 64, HALF = 128, HTB = HALF * BK * 2, STAGE_BYTES = 8 * HTB, NXCD = 8, WGM = 8;
__host__ __device__ __forceinline__ int lds_byte(int r, int c) { const int st = (r >> 4) * 2 + (c >> 5), rr = r & 15, cc = c & 31, ob = rr * 64 + cc * 2; return st * 1024 + (ob ^ (((ob >> 9) & 1) << 5)); }
__host__ __device__ __forceinline__ void stage_rc(int b, int& R, int& C) { const int st = b / 1024, sb = b % 1024, swz = sb ^ (((sb >> 9) & 1) << 5); R = (st >> 1) * 16 + swz / 64; C = (st & 1) * 32 + (swz % 64) / 2; }
__host__ __device__ __forceinline__ int perm32(int rho) { const int n = rho >> 4, i = rho & 15; return 8 * (i >> 2) + 4 * n + (i & 3); }

struct Unit { int pm, pn; };
struct Gemm { const f16* A; const f16* Bt; int M, N, K; };

struct StaticOrder {
    int nM, nN, nwg, G, c;
    __host__ __device__ void init(int M, int N, int G_, int c_) { nM = M / BM; nN = N / BM; nwg = nM * nN; G = G_; c = c_; }
    __host__ __device__ bool next(int i, Unit& u) const {
        const long L = (long)i * G + c; if (L >= nwg) return false;
        int wgid = (int)L; { const int q = nwg / NXCD, r = nwg % NXCD, xcd = wgid % NXCD, off = wgid / NXCD; wgid = (xcd < r ? xcd * (q + 1) : r * (q + 1) + (xcd - r) * q) + off; }
        const int nig = WGM * nN, gid = wgid / nig, fm = gid * WGM, gsz = (nM - fm) < WGM ? (nM - fm) : WGM;
        u.pm = fm + ((wgid % nig) % gsz); u.pn = (wgid % nig) / gsz; return true;
    }
    __device__ __forceinline__ void a_ready(const Unit&) const {}
    __device__ __forceinline__ void done(const Unit&) const {}
};

struct EpiF16 {
    static constexpr bool PERM = true, AFTER_DRAIN = false;
    f16* O; int ldc;
    __device__ __forceinline__ void operator()(const f32x4 (&acc)[2][2][4][2], const Unit& u, int wr, int wc, int fr, int fq) const {
        const int row0 = u.pm * BM + wr * 64 + fr; const int col0 = u.pn * BM + wc * 32 + 8 * fq;
#pragma unroll
        for (int ai = 0; ai < 2; ++ai)
#pragma unroll
            for (int m = 0; m < 4; ++m) { f16* rowp = O + (size_t)(row0 + ai * HALF + m * 16) * ldc + col0;
#pragma unroll
                for (int bj = 0; bj < 2; ++bj) { const f32x4 v0 = acc[ai][bj][m][0], v1 = acc[ai][bj][m][1];
                    u32x4 w; w.x = pkh(v0[0], v0[1]); w.y = pkh(v0[2], v0[3]); w.z = pkh(v1[0], v1[1]); w.w = pkh(v1[2], v1[3]);
                    *(u32x4*)(rowp + bj * HALF) = w; } }
    }
};
struct EpiSwiGLU {
    static constexpr bool PERM = true, AFTER_DRAIN = false;
    f16* O; int ldc;
    __device__ __forceinline__ void operator()(const f32x4 (&acc)[2][2][4][2], const Unit& u, int wr, int wc, int fr, int fq) const {
        const int row0 = u.pm * BM + wr * 64 + fr; const int col0 = u.pn * HALF + wc * 32 + 8 * fq;
#pragma unroll
        for (int ai = 0; ai < 2; ++ai)
#pragma unroll
            for (int m = 0; m < 4; ++m) { f16* rowp = O + (size_t)(row0 + ai * HALF + m * 16) * ldc + col0;
                float o[8];
#pragma unroll
                for (int n = 0; n < 2; ++n)
#pragma unroll
                    for (int j = 0; j < 4; ++j) { const float g = acc[ai][0][m][n][j], up = acc[ai][1][m][n][j]; o[n * 4 + j] = g * __builtin_amdgcn_rcpf(1.0f + __expf(-g)) * up; }
                u32x4 w; w.x = pkh(o[0], o[1]); w.y = pkh(o[2], o[3]); w.z = pkh(o[4], o[5]); w.w = pkh(o[6], o[7]);
                *(u32x4*)rowp = w; }
    }
};

template <class Epi, class Sched, bool ALIGN_EPI = false, bool SP2 = false>
__device__ __forceinline__ void gemm_phase(LAS unsigned char* lds, const Gemm g, const Sched& S, const Epi& E) {
    const int tid = threadIdx.x, wid = __builtin_amdgcn_readfirstlane(tid >> 6), lane = tid & 63, wr = wid >> 2, wc = wid & 3, fr = lane & 15, fq = lane >> 4;
    const int K = g.K, nt = K / BK;
    unsigned voffA[2], voffB[2];
#pragma unroll
    for (int i = 0; i < 2; ++i) { int R, C; stage_rc(tid * 16 + i * 8192, R, C); const int Rb = Epi::PERM ? ((R & ~31) + perm32(R & 31)) : R;
        voffA[i] = (unsigned)(R * K + C) * 2u; voffB[i] = (unsigned)(Rb * K + C) * 2u; }
    const size_t kstep = (size_t)(BK * 2);
    const size_t hstep = (size_t)HALF * K * 2;
    const size_t tstep = 2 * hstep;
    const unsigned ldsw = (unsigned)wid * 1024u;
    const int aoff = lds_byte(wr * 64 + fr, fq * 8), boff = lds_byte(wc * 32 + fr, fq * 8);
#define PG8_SA(b, h) (((b) * 2 + (h)) * HTB)
#define PG8_SB(b, h) ((4 + (b) * 2 + (h)) * HTB)
#define PG8_STAGE(bufoff, gbase, voff) do { _Pragma("unroll") for (int _i = 0; _i < 2; ++_i) \
        __builtin_amdgcn_global_load_lds((const unsigned*)((const char*)(gbase) + (voff)[_i]), (LAS unsigned*)(lds + (bufoff) + ldsw + _i * 8192), 16, 0, 0); } while (0)
#define PG8_LDA(dst, b, h) do { _Pragma("unroll") for (int m = 0; m < 4; ++m) _Pragma("unroll") for (int k = 0; k < 2; ++k) dst[m][k] = *(const LAS f16x8*)(lds + PG8_SA(b, h) + aoff + m * 2048 + k * 1024); } while (0)
#define PG8_LDB(dst, b, h) do { _Pragma("unroll") for (int n = 0; n < 2; ++n) _Pragma("unroll") for (int k = 0; k < 2; ++k) dst[n][k] = *(const LAS f16x8*)(lds + PG8_SB(b, h) + boff + n * 2048 + k * 1024); } while (0)
#define PG8_MMA(ai, bj, At, Bt) do { __builtin_amdgcn_s_setprio(1); _Pragma("unroll") for (int m = 0; m < 4; ++m) _Pragma("unroll") for (int n = 0; n < 2; ++n) _Pragma("unroll") for (int k = 0; k < 2; ++k) \
        acc[ai][bj][m][n] = __builtin_amdgcn_mfma_f32_16x16x32_f16(Bt[n][k], At[m][k], acc[ai][bj][m][n], 0, 0, 0); __builtin_amdgcn_s_setprio(0); } while (0)
#define PG8_WAIT_V(n) asm volatile("s_waitcnt vmcnt(" #n ")" ::: "memory")
#define PG8_WAIT_L(n) asm volatile("s_waitcnt lgkmcnt(" #n ")" ::: "memory")
#define PG8_BAR __builtin_amdgcn_s_barrier()
#define PG8_SCHED __builtin_amdgcn_sched_barrier(0)
    Unit cur, nxt; int ui = 0;
    if (!S.next(0, cur)) return;
    f32x4 acc[2][2][4][2];
#pragma unroll
    for (int a = 0; a < 2; ++a)
#pragma unroll
        for (int b = 0; b < 2; ++b)
#pragma unroll
            for (int m = 0; m < 4; ++m)
#pragma unroll
                for (int n = 0; n < 2; ++n) acc[a][b][m][n] = (f32x4){0.f, 0.f, 0.f, 0.f};
    f16x8 At[4][2], B0[2][2], B1[2][2];
    const char* cA = (const char*)g.A + (size_t)cur.pm * tstep; const char* cB = (const char*)g.Bt + (size_t)cur.pn * tstep;
    S.a_ready(cur);
    if constexpr (SP2) {
        PG8_STAGE(PG8_SB(0, 0), cB, voffB); PG8_STAGE(PG8_SB(0, 1), cB + hstep, voffB); PG8_STAGE(PG8_SA(0, 0), cA, voffA); PG8_STAGE(PG8_SA(0, 1), cA + hstep, voffA);
        if (wr == 1) PG8_BAR;
        PG8_WAIT_V(2); PG8_BAR;
        PG8_STAGE(PG8_SB(1, 0), cB + kstep, voffB); PG8_STAGE(PG8_SA(1, 0), cA + kstep, voffA); PG8_STAGE(PG8_SB(1, 1), cB + hstep + kstep, voffB);
        PG8_WAIT_V(6); PG8_BAR;
    } else {
        PG8_STAGE(PG8_SB(0, 0), cB, voffB); PG8_STAGE(PG8_SA(0, 0), cA, voffA); PG8_STAGE(PG8_SB(0, 1), cB + hstep, voffB); PG8_STAGE(PG8_SA(0, 1), cA + hstep, voffA);
        if (wr == 1) PG8_BAR;
        PG8_WAIT_V(4); PG8_BAR;
        PG8_STAGE(PG8_SB(1, 0), cB + kstep, voffB); PG8_STAGE(PG8_SA(1, 0), cA + kstep, voffA); PG8_STAGE(PG8_SB(1, 1), cB + hstep + kstep, voffB);
        PG8_WAIT_V(6); PG8_BAR;
    }
    for (;;) {
        const bool has_next = S.next(ui + 1, nxt);
        const char* nA = has_next ? (const char*)g.A + (size_t)nxt.pm * tstep : cA; const char* nB = has_next ? (const char*)g.Bt + (size_t)nxt.pn * tstep : cB;
        for (int t = 0; t < nt; t += 2) {
            const bool last = (t == nt - 2);
            const char* a1 = cA + (size_t)(t + 1) * kstep;
            const char* a2 = last ? nA : cA + (size_t)(t + 2) * kstep; const char* b2 = last ? nB : cB + (size_t)(t + 2) * kstep;
            const char* a3 = a2 + kstep; const char* b3 = b2 + kstep;
            if (last && has_next) S.a_ready(nxt);
            if constexpr (SP2) {
            PG8_LDB(B0, 0, 0); PG8_LDB(B1, 0, 1); PG8_SCHED; PG8_LDA(At, 0, 0); PG8_STAGE(PG8_SA(1, 1), a1 + hstep, voffA);
            PG8_WAIT_V(8); PG8_WAIT_L(0); PG8_BAR; PG8_MMA(0, 0, At, B0); PG8_MMA(0, 1, At, B1); PG8_BAR; PG8_SCHED;
            PG8_LDA(At, 0, 1); PG8_STAGE(PG8_SB(0, 0), b2, voffB); PG8_STAGE(PG8_SB(0, 1), b2 + hstep, voffB); PG8_STAGE(PG8_SA(0, 0), a2, voffA);
            PG8_WAIT_V(8); PG8_WAIT_L(0); PG8_BAR; PG8_MMA(1, 0, At, B0); PG8_MMA(1, 1, At, B1); PG8_BAR; PG8_SCHED;
            PG8_LDB(B0, 1, 0); PG8_LDB(B1, 1, 1); PG8_SCHED; PG8_LDA(At, 1, 0); PG8_STAGE(PG8_SA(0, 1), a2 + hstep, voffA);
            PG8_WAIT_V(8); PG8_WAIT_L(0); PG8_BAR; PG8_MMA(0, 0, At, B0); PG8_MMA(0, 1, At, B1); PG8_BAR; PG8_SCHED;
            PG8_LDA(At, 1, 1); PG8_STAGE(PG8_SB(1, 0), b3, voffB); PG8_STAGE(PG8_SB(1, 1), b3 + hstep, voffB); PG8_STAGE(PG8_SA(1, 0), a3, voffA);
            PG8_WAIT_V(8); PG8_WAIT_L(0); PG8_BAR; PG8_MMA(1, 0, At, B0); PG8_MMA(1, 1, At, B1); PG8_BAR; PG8_SCHED;
            } else {
            PG8_LDB(B0, 0, 0); PG8_SCHED; PG8_LDA(At, 0, 0); PG8_STAGE(PG8_SA(1, 1), a1 + hstep, voffA);
            PG8_WAIT_L(8); PG8_BAR; PG8_WAIT_L(0); PG8_MMA(0, 0, At, B0); PG8_BAR; PG8_SCHED;
            PG8_LDB(B1, 0, 1); PG8_STAGE(PG8_SB(0, 0), b2, voffB);
            PG8_BAR; PG8_WAIT_L(0); PG8_MMA(0, 1, At, B1); PG8_BAR;
            PG8_LDA(At, 0, 1); PG8_STAGE(PG8_SA(0, 0), a2, voffA);
            PG8_BAR; PG8_WAIT_L(0); PG8_MMA(1, 0, At, B0); PG8_BAR; PG8_SCHED;
            PG8_STAGE(PG8_SB(0, 1), b2 + hstep, voffB);
            PG8_WAIT_V(6); PG8_BAR; PG8_MMA(1, 1, At, B1); PG8_BAR;
            PG8_LDB(B0, 1, 0); PG8_SCHED; PG8_LDA(At, 1, 0); PG8_STAGE(PG8_SA(0, 1), a2 + hstep, voffA);
            PG8_WAIT_L(8); PG8_BAR; PG8_WAIT_L(0); PG8_MMA(0, 0, At, B0); PG8_BAR; PG8_SCHED;
            PG8_LDB(B1, 1, 1); PG8_STAGE(PG8_SB(1, 0), b3, voffB);
            PG8_BAR; PG8_WAIT_L(0); PG8_MMA(0, 1, At, B1); PG8_BAR;
            PG8_LDA(At, 1, 1); PG8_STAGE(PG8_SA(1, 0), a3, voffA);
            PG8_BAR; PG8_WAIT_L(0); PG8_MMA(1, 0, At, B0); PG8_BAR; PG8_SCHED;
            PG8_STAGE(PG8_SB(1, 1), b3 + hstep, voffB);
            PG8_WAIT_V(6); PG8_BAR; PG8_MMA(1, 1, At, B1); PG8_BAR;
            }
        }
        if constexpr (ALIGN_EPI) { if (wr == 0) PG8_BAR; }
        if constexpr (!Epi::AFTER_DRAIN) { E(acc, cur, wr, wc, fr, fq); S.done(cur); }
        if (!has_next) break;
#pragma unroll
        for (int a = 0; a < 2; ++a)
#pragma unroll
            for (int b = 0; b < 2; ++b)
#pragma unroll
                for (int m = 0; m < 4; ++m)
#pragma unroll
                    for (int n = 0; n < 2; ++n) acc[a][b][m][n] = (f32x4){0.f, 0.f, 0.f, 0.f};
        cur = nxt; cA = nA; cB = nB; ++ui;
        if constexpr (ALIGN_EPI) { if (wr == 1) PG8_BAR; }
    }
    PG8_WAIT_V(0);
    if constexpr (!ALIGN_EPI) { if (wr == 0) PG8_BAR; }
    PG8_BAR;
#undef PG8_SA
#undef PG8_SB
#undef PG8_STAGE
#undef PG8_LDA
#undef PG8_LDB
#undef PG8_MMA
#undef PG8_WAIT_V
#undef PG8_WAIT_L
#undef PG8_BAR
#undef PG8_SCHED
}
}

#define XB_TMO      128
#define XB_XCNT(j)  (256  + 64 * (j))
#define XB_XSUB(j)  (1280 + 64 * (j))
#define XB_XGEN(j)  (2304 + 64 * (j))
#define XB_TOP      3328
#define XB_TOPGEN   3392
#define XCD_BAR_WORDS 3456
#define XB_SPIN_CAP (1u << 18)
__device__ __forceinline__ unsigned xb_ld(unsigned* p)              { return __hip_atomic_load(p, __ATOMIC_RELAXED, __HIP_MEMORY_SCOPE_AGENT); }
__device__ __forceinline__ unsigned xb_add(unsigned* p, unsigned v) { return __hip_atomic_fetch_add(p, v, __ATOMIC_RELAXED, __HIP_MEMORY_SCOPE_AGENT); }
__device__ __forceinline__ unsigned xb_xcc_id() { return (unsigned)__builtin_amdgcn_s_getreg((3 << 11) | 20) & 0xFu; }
#define XB_SPIN(cond, bar) do { unsigned _sp = 0; while (cond) { __builtin_amdgcn_s_sleep(1); \
    if ((++_sp & 255u) == 0u) { if (xb_ld(&(bar)[XB_TMO])) break; if (_sp > XB_SPIN_CAP) { atomicAdd(&(bar)[XB_TMO], 1u); break; } } } } while (0)
struct XcdBarrier { unsigned* bar; unsigned x; volatile LAS unsigned* st; };
__device__ __forceinline__ XcdBarrier xcd_barrier_post(unsigned* bar, volatile LAS unsigned* st) {
    XcdBarrier b; b.bar = bar; b.x = xb_xcc_id(); b.st = st;
    if (threadIdx.x == 0) (void)xb_add(&bar[XB_XCNT(b.x)], 1u);
    return b;
}
__device__ __forceinline__ void xcd_barrier_complete(unsigned* bar, unsigned x, unsigned& nloc, unsigned& nx) {
    const unsigned G = gridDim.x * gridDim.y * gridDim.z;
    unsigned sum, cnt, mine, sp = 0u;
    for (;;) {
        sum = 0u; cnt = 0u; mine = 0u;
#pragma unroll
        for (unsigned j = 0; j < 16; ++j) { const unsigned c = xb_ld(&bar[XB_XCNT(j)]); sum += c; cnt += (c > 0u) ? 1u : 0u; mine = (j == x) ? c : mine; }
        if (sum == G) break;
        __builtin_amdgcn_s_sleep(1);
        if ((++sp & 255u) == 0u) { if (xb_ld(&bar[XB_TMO])) break; if (sp > XB_SPIN_CAP) { atomicAdd(&bar[XB_TMO], 1u); break; } }
    }
    nloc = mine > 0u ? mine : 1u; nx = cnt > 0u ? cnt : 1u;
}
__device__ __forceinline__ void xcd_barrier(const XcdBarrier& b) {
    asm volatile("s_waitcnt vmcnt(0)" ::: "memory");
    __syncthreads();
    if (threadIdx.x == 0) {
        unsigned* bar = b.bar;
        __builtin_amdgcn_s_waitcnt(0);
        unsigned nloc = b.st[0], nx = b.st[1];
        if (nloc == 0u) { xcd_barrier_complete(bar, b.x, nloc, nx); b.st[0] = nloc; b.st[1] = nx; }
        const unsigned old = xb_add(&bar[XB_XSUB(b.x)], 1u);
        const unsigned gen = old / nloc;
        if (old + 1u == (gen + 1u) * nloc) {
            __builtin_amdgcn_fence(__ATOMIC_RELEASE, "agent");
            asm volatile("s_waitcnt vmcnt(0)" ::: "memory");
            const unsigned og = xb_add(&bar[XB_TOP], 1u);
            const unsigned tg = og / nx;
            if (og + 1u == (tg + 1u) * nx) xb_add(&bar[XB_TOPGEN], 1u);
            else XB_SPIN(xb_ld(&bar[XB_TOPGEN]) == tg, bar);
            __builtin_amdgcn_fence(__ATOMIC_ACQUIRE, "agent");
            xb_add(&bar[XB_XGEN(b.x)], 1u);
            asm volatile("s_waitcnt vmcnt(0)" ::: "memory");
        } else {
            XB_SPIN(xb_ld(&bar[XB_XGEN(b.x)]) == gen, bar);
            __builtin_amdgcn_fence(__ATOMIC_ACQUIRE, "agent");
            asm volatile("s_waitcnt vmcnt(0)" ::: "memory");
        }
    }
    __syncthreads();
}

constexpr int BATCH = 8, SEQ = 4096, D = 1024, MTOK = BATCH * SEQ;
constexpr int QL = 256, KVL = 128, IDXD = 64, IDXH = 8, HATT = 8, TOPK = 256;
constexpr int RW = 512, HRW = 8, NRW = 64;
constexpr int IN_COLS = 2280, IN_PAD = 2304;
constexpr int C_CQ = 0, C_CKV = 256, C_IK = 384, C_IW = 448, C_R = 456, C_K = 968, C_V = 1480, C_WD = 1992, C_AD = 2056, C_GD = 2120;
constexpr int DFF = 2816;
constexpr int NQI = 1536;
constexpr int KOUT = 1536;
constexpr float NORM_EPS = 1e-6f, GN_EPS = 64e-5f;

constexpr size_t MiB = 1u << 20;
constexpr size_t WS_CTL = 0, CTL_ZERO_BYTES = 64 * 1024;
constexpr size_t WS_MOD = 1 * MiB;
constexpr size_t WS_WIN = 2 * MiB;
constexpr size_t WS_WCQ = 7 * MiB;
constexpr size_t WS_WOUT = 8 * MiB;
constexpr size_t WS_WGU = 11 * MiB;
constexpr size_t WS_WDN = 22 * MiB;
constexpr size_t WS_H = 32 * MiB;
constexpr size_t WS_RWW = 32 * MiB, WS_RWA = 64 * MiB;
constexpr size_t WS_PROJ = 96 * MiB;
constexpr size_t WS_CQ = 240 * MiB;
constexpr size_t WS_SEL = 240 * MiB;
constexpr size_t WS_OATT = 256 * MiB;
constexpr size_t WS_CKV = 352 * MiB;
constexpr size_t WS_IK16 = 360 * MiB;
constexpr size_t WS_IK32 = 364 * MiB;
constexpr size_t WS_IW = 372 * MiB;
constexpr size_t WS_RWG = 376 * MiB;
constexpr size_t WS_YRAW = 408 * MiB;
constexpr size_t WS_MIX = 408 * MiB;
constexpr size_t WS_ACT = 96 * MiB;
constexpr size_t WS_F = 288 * MiB;
constexpr size_t WS_CKV8 = 368 * MiB;
constexpr size_t WS_END = 504 * MiB;

constexpr int CW_BAR = 1024;
constexpr int NWAVES = 8;
constexpr int RING_BYTES = 131072, AUX_OFF = RING_BYTES  , MISC_OFF = 155648, LDS_BYTES = 155904;

struct Args { const float* in[32]; float* out; unsigned char* ws; int ph_lo, ph_hi; };

__device__ __forceinline__ float wave_sum(float v) {
#pragma unroll
    for (int o = 1; o < 64; o <<= 1) v += __shfl_xor(v, o);
    return v;
}
__device__ __forceinline__ void lds_barrier() { asm volatile("s_waitcnt lgkmcnt(0)\n\ts_barrier" ::: "memory"); }
__device__ __forceinline__ float sigmoidf_(float x) { return __builtin_amdgcn_rcpf(1.0f + __expf(-x)); }

__device__ __forceinline__ void p0_transpose_item(const float* W, int K, int N, int Npad, f16* WT, int ldk, int koff, int row_off, int mode, LAS float* scr, int item, int lane) {
    const int nblk = Npad / 32, kb = item / nblk, nb = item % nblk, k0 = 64 * kb, n0 = 32 * nb;
#pragma unroll 8
    for (int i = 0; i < 32; ++i) { const int kk = 2 * i + (lane >> 5); const int n = n0 + (lane & 31); scr[kk * 33 + (lane & 31)] = (n < N && k0 + kk < K) ? W[(size_t)(k0 + kk) * N + n] : 0.f; }
    asm volatile("s_waitcnt lgkmcnt(0)" ::: "memory");
    const int c = lane & 7;
#pragma unroll
    for (int j = 0; j < 4; ++j) { const int nl = (lane >> 3) + 8 * j; const LAS float* s = scr + (8 * c) * 33 + nl;
        u32x4 o; o.x = pkh(s[0 * 33], s[1 * 33]); o.y = pkh(s[2 * 33], s[3 * 33]); o.z = pkh(s[4 * 33], s[5 * 33]); o.w = pkh(s[6 * 33], s[7 * 33]);
        const int n = n0 + nl; int row;
        if (mode == 0) row = row_off + n; else row = (n >> 7) * 256 + (mode == 2 ? 128 : 0) + (n & 127);
        *(u32x4*)(WT + (size_t)row * ldk + koff + k0 + 8 * c) = o; }
    asm volatile("s_waitcnt lgkmcnt(0)" ::: "memory");
}

__device__ __forceinline__ void p0_prologue(const Args& a, LAS unsigned char* lds, int vcu, int G, int wave, int lane) {
    unsigned char* ws = a.ws;
    LAS float* scr = (LAS float*)(lds + wave * 16384);
    const int gw = vcu * NWAVES + wave, NGW = G * NWAVES;
    f16* Win = (f16*)(ws + WS_WIN); f16* Wcq = (f16*)(ws + WS_WCQ); f16* Wout = (f16*)(ws + WS_WOUT); f16* Wgu = (f16*)(ws + WS_WGU); f16* Wdn = (f16*)(ws + WS_WDN);
    constexpr int I_IN = (D / 64) * (IN_PAD / 32), I_IDX = (QL / 64) * (512 / 32), I_OR = (512 / 64) * (D / 32), I_G = (D / 64) * (DFF / 32), I_D = (DFF / 64) * (D / 32);
    constexpr int I_FQ = 4 * 64, I_FO = 16 * 64, I_MOD = 8 * 96, I_LD = 16, I_LG = 48;
    constexpr int NITEMS = I_IN + I_IDX + I_OR + 2 * I_G + I_D + I_FQ + I_FO + 2 * I_LD + I_LG;
    for (int it = gw; it < NITEMS; it += NGW) {
        int r = it;
        if (r < I_IN) { p0_transpose_item(a.in[9], D, IN_COLS, IN_PAD, Win, D, 0, 0, 0, scr, r, lane); continue; } r -= I_IN;
        if (r < I_IDX) { p0_transpose_item(a.in[12], QL, 512, 512, Wcq, QL, 0, 1024, 0, scr, r, lane); continue; } r -= I_IDX;
        if (r < I_OR) { p0_transpose_item(a.in[28] + (size_t)512 * D, 512, D, D, Wout, KOUT, 1024, 0, 0, scr, r, lane); continue; } r -= I_OR;
        if (r < I_G) { p0_transpose_item(a.in[29], D, DFF, DFF, Wgu, D, 0, 0, 1, scr, r, lane); continue; } r -= I_G;
        if (r < I_G) { p0_transpose_item(a.in[30], D, DFF, DFF, Wgu, D, 0, 0, 2, scr, r, lane); continue; } r -= I_G;
        if (r < I_D) { p0_transpose_item(a.in[31], DFF, D, D, Wdn, DFF, 0, 0, 0, scr, r, lane); continue; } r -= I_D;
        if (r < I_FQ) {
            const int rb = r & 3, nb = r >> 2, rr = rb * 64 + lane, n0 = nb * 16, h = n0 >> 7;
            const float* uq = a.in[11] + (size_t)rr * 512 + h * 64; const float* uk = a.in[15] + (size_t)n0 * 64;
            float q[64];
#pragma unroll
            for (int d4 = 0; d4 < 16; ++d4) { const f32x4 v = *(const f32x4*)(uq + 4 * d4); q[4 * d4] = v[0]; q[4 * d4 + 1] = v[1]; q[4 * d4 + 2] = v[2]; q[4 * d4 + 3] = v[3]; }
#pragma unroll 4
            for (int i = 0; i < 16; ++i) { float s = 0.f;
#pragma unroll
                for (int d = 0; d < 64; ++d) s += q[d] * uk[i * 64 + d];
                Wcq[(size_t)(n0 + i) * QL + rr] = (f16)(0.125f * s); }
            continue; } r -= I_FQ;
        if (r < I_FO) {
            const int kb = r & 15, nb = r >> 4, k = kb * 64 + lane, h = k >> 7, n0 = nb * 16;
            const float* uv = a.in[16] + (size_t)k * 64; const float* wo = a.in[28] + (size_t)(h * 64) * D + n0;
            float acc[16];
#pragma unroll
            for (int i = 0; i < 16; ++i) acc[i] = 0.f;
#pragma unroll 8
            for (int d = 0; d < 64; ++d) { const float v = uv[d];
#pragma unroll
                for (int i4 = 0; i4 < 4; ++i4) { const f32x4 w = *(const f32x4*)(wo + (size_t)d * D + 4 * i4); acc[4 * i4] += v * w[0]; acc[4 * i4 + 1] += v * w[1]; acc[4 * i4 + 2] += v * w[2]; acc[4 * i4 + 3] += v * w[3]; } }
#pragma unroll
            for (int i = 0; i < 16; ++i) Wout[(size_t)(n0 + i) * KOUT + k] = (f16)acc[i];
            continue; } r -= I_FO;
        if (r < I_LD) { p0_transpose_item(a.in[19], 64, 512, 512, (f16*)(ws + (28u << 20)), 64, 0, 0, 0, scr, r, lane); continue; } r -= I_LD;
        if (r < I_LD) { p0_transpose_item(a.in[21], 64, 512, 512, (f16*)(ws + (28u << 20) + 65536), 64, 0, 0, 0, scr, r, lane); continue; } r -= I_LD;
        { p0_transpose_item(a.in[22], 160, 512, 512, (f16*)(ws + (28u << 20) + 131072), 192, 0, 0, 0, scr, r, lane); }
    }
    if (vcu < 96) {
        __syncthreads();
        const int tid = wave * 64 + lane;
        for (int e = tid; e < 8 * D; e += 512) { const float cc = a.in[1][e]; *(LAS float*)(lds + (e >> 10) * 16384 + 10496 + (e & 1023) * 4) = cc * sigmoidf_(cc); }
        for (int cb = vcu; cb < 96; cb += G) {
            __syncthreads();
            const int j = cb * 64 + lane; const float* aw = a.in[3] + j;
            float acc[8];
#pragma unroll
            for (int b = 0; b < 8; ++b) acc[b] = 0.f;
            const int kbeg = wave * 128;
#pragma unroll 1
            for (int k0 = 0; k0 < 128; k0 += 16) {
                float wv[16];
#pragma unroll
                for (int i = 0; i < 16; ++i) wv[i] = aw[(size_t)(kbeg + k0 + i) * 6144];
#pragma unroll
                for (int b = 0; b < 8; ++b) {
#pragma unroll
                    for (int i4 = 0; i4 < 4; ++i4) { const f32x4 sv = *(const LAS f32x4*)(lds + b * 16384 + 10496 + (kbeg + k0 + 4 * i4) * 4);
                        acc[b] += sv[0] * wv[4 * i4] + sv[1] * wv[4 * i4 + 1] + sv[2] * wv[4 * i4 + 2] + sv[3] * wv[4 * i4 + 3]; } }
            }
#pragma unroll
            for (int b = 0; b < 8; ++b) *(LAS float*)(lds + wave * 16384 + 8448 + (b * 64 + lane) * 4) = acc[b];
            __syncthreads();
            float sum = 0.f;
#pragma unroll
            for (int w = 0; w < 8; ++w) sum += *(const LAS float*)(lds + w * 16384 + 8448 + (wave * 64 + lane) * 4);
            ((float*)(ws + WS_MOD))[wave * 6144 + j] = sum + a.in[4][j];
        }
    }
}

__device__ __forceinline__ void p1_modnorm(const Args& a, int vcu, int G, int wave, int lane) {
    const int gw = vcu * NWAVES + wave, NGW = G * NWAVES;
    const float* mod = (const float*)(a.ws + WS_MOD); f16* H = (f16*)(a.ws + WS_H);
    for (int m = gw; m < MTOK; m += NGW) {
        const int b = m >> 12;
        const f32x4* xr = (const f32x4*)(a.in[0] + (size_t)m * D) + lane;
        f32x4 v[4]; float s = 0.f;
#pragma unroll
        for (int j = 0; j < 4; ++j) { v[j] = xr[64 * j]; s += (v[j][0] * v[j][0] + v[j][1] * v[j][1]) + (v[j][2] * v[j][2] + v[j][3] * v[j][3]); }
        const float r = rsqrtf(wave_sum(s) * (1.f / D) + NORM_EPS);
        u32x2* o = (u32x2*)(H + (size_t)m * D) + lane;
#pragma unroll
        for (int j = 0; j < 4; ++j) { const int c = 4 * lane + 256 * j;
            const f32x4 g = *(const f32x4*)(a.in[5] + c), sh = *(const f32x4*)(mod + b * 6144 + c), sc = *(const f32x4*)(mod + b * 6144 + 1024 + c);
            f32x4 y;
#pragma unroll
            for (int e = 0; e < 4; ++e) y[e] = v[j][e] * r * g[e] * (1.f + sc[e]) + sh[e];
            u32x2 w; w.x = pkh(y[0], y[1]); w.y = pkh(y[2], y[3]); o[64 * j] = w; }
    }
}

__device__ __forceinline__ void p3_rows(const Args& a, int vcu, int G, int wave, int lane) {
    const int gw = vcu * NWAVES + wave, NGW = G * NWAVES;
    unsigned char* ws = a.ws;
    const f16* PROJ = (const f16*)(ws + WS_PROJ);
    f16* CQ = (f16*)(ws + WS_CQ); f16* CKV = (f16*)(ws + WS_CKV); f16* IK16 = (f16*)(ws + WS_IK16); float* IW = (float*)(ws + WS_IW);
    for (int m = gw; m < MTOK; m += NGW) {
        const f16* pr = PROJ + (size_t)m * IN_PAD;
        const f16x4 q = *(const f16x4*)(pr + C_CQ + 4 * lane);
        const f16x2 kv = *(const f16x2*)(pr + C_CKV + 2 * lane);
        const float ik = (float)pr[C_IK + lane];
        float q0 = (float)q[0], q1 = (float)q[1], q2 = (float)q[2], q3 = (float)q[3], k0 = (float)kv[0], k1 = (float)kv[1];
        const float rq = rsqrtf(wave_sum(q0 * q0 + q1 * q1 + q2 * q2 + q3 * q3) * (1.f / QL) + NORM_EPS);
        const float rk = rsqrtf(wave_sum(k0 * k0 + k1 * k1) * (1.f / KVL) + NORM_EPS);
        const float ri = rsqrtf(wave_sum(ik * ik) * (1.f / IDXD) + NORM_EPS);
        const f32x4 gq = *(const f32x4*)(a.in[10] + 4 * lane); const f32x2 gk = *(const f32x2*)(a.in[13] + 2 * lane); const float gi = a.in[14][lane];
        u32x2 w; w.x = pkh(q0 * rq * gq[0], q1 * rq * gq[1]); w.y = pkh(q2 * rq * gq[2], q3 * rq * gq[3]);
        *(u32x2*)(CQ + (size_t)m * QL + 4 * lane) = w;
        ((unsigned short*)(ws + WS_CKV8))[(size_t)m * 64 + lane] = (unsigned short)__builtin_amdgcn_cvt_pk_fp8_f32(k0 * rk * gk[0], k1 * rk * gk[1], 0, false);
        const float ikn = ik * ri * gi;
        IK16[(size_t)m * IDXD + lane] = (f16)ikn;
        if (lane < 8) IW[(size_t)m * 8 + lane] = (float)pr[C_IW + lane] * 0.04419417382415922f;
    }
}
__device__ __forceinline__ void p3_rwkv_prep(const Args& a, LAS unsigned char* lds, int vcu, int G, int tid) {
    unsigned char* ws = a.ws;
    const f16* PROJ = (const f16*)(ws + WS_PROJ);
    f16* RWW = (f16*)(ws + WS_RWW); f16* RWA = (f16*)(ws + WS_RWA); f16* RWG = (f16*)(ws + WS_RWG);
    LAS float* xs = (LAS float*)lds;
    const float* mu = a.in[17];
    const int ch = tid;
    const float w0 = a.in[18][ch], a0 = a.in[20][ch];
    for (int u = vcu; u < MTOK / 16; u += G) {
        const int m0 = u * 16;
        __syncthreads();
        for (int e = tid; e < 16 * 288; e += 512) {
            const int t = e / 288, col = e % 288, m = m0 + t;
            const float cur = (float)PROJ[(size_t)m * IN_PAD + C_WD + col];
            const float prev = ((m & (SEQ - 1)) != 0) ? (float)PROJ[(size_t)(m - 1) * IN_PAD + C_WD + col] : 0.f;
            float v = cur + mu[1536 + col] * (prev - cur);
            if (col < 64) v = tanhf(v); else if (col >= 128) v = sigmoidf_(v);
            xs[t * 288 + col] = v;
        }
        __syncthreads();
        float dl[16], al[16], gl[16];
#pragma unroll
        for (int t = 0; t < 16; ++t) { dl[t] = 0.f; al[t] = 0.f; gl[t] = 0.f; }
        for (int kk = 0; kk < 64; ++kk) {
            const float wd = a.in[19][kk * 512 + ch], wa = a.in[21][kk * 512 + ch];
#pragma unroll
            for (int t = 0; t < 16; ++t) { dl[t] += xs[t * 288 + kk] * wd; al[t] += xs[t * 288 + 64 + kk] * wa; }
        }
        for (int kk = 0; kk < 160; ++kk) {
            const float wg = a.in[22][kk * 512 + ch];
#pragma unroll
            for (int t = 0; t < 16; ++t) gl[t] += xs[t * 288 + 128 + kk] * wg;
        }
#pragma unroll
        for (int t = 0; t < 16; ++t) {
            const float z = -(w0 + dl[t]);
            const float sp = z > 20.f ? z : log1pf(__expf(z));
            const float wlog = -sp - 0.5f;
            const float lw = -__expf(wlog);
            const float av = sigmoidf_(a0 + al[t]);
            const size_t o = (size_t)(m0 + t) * RW + ch;
            RWW[o] = (f16)lw; RWA[o] = (f16)av; RWG[o] = (f16)gl[t];
        }
    }
}

__device__ __forceinline__ unsigned f2key(float f) { const unsigned u = __builtin_bit_cast(unsigned, f); return (u & 0x80000000u) ? ~u : (u | 0x80000000u); }
__device__ __forceinline__ void p5_indexer(const Args& a, LAS unsigned char* lds, int vcu, int G, int wave, int lane) {
    unsigned char* ws = a.ws;
    const f16* QI = (const f16*)a.out;
    const float* IK32 = (const float*)(ws + WS_IK32); const float* IW = (const float*)(ws + WS_IW);
    unsigned short* SEL = (unsigned short*)(ws + WS_SEL);
    LAS float* sc = (LAS float*)(lds + wave * 16384);
    LAS float* iq = (LAS float*)(lds + AUX_OFF + wave * 2048);
    const int gw = vcu * NWAVES + wave, NGW = G * NWAVES;
    for (int q = gw; q < MTOK; q += NGW) {
        const int b = q >> 12, t = q & (SEQ - 1);
        unsigned short* sel = SEL + (size_t)q * TOPK;
        if (t < TOPK) {
#pragma unroll
            for (int j = 0; j < 4; ++j) { const int s = lane + 64 * j; sel[s] = (s <= t) ? (unsigned short)s : (unsigned short)0xFFFF; }
            continue;
        }
        { const f16x8 v = *(const f16x8*)(QI + (size_t)q * NQI + 1024 + 8 * lane);
#pragma unroll
          for (int e = 0; e < 8; ++e) iq[8 * lane + e] = (float)v[e]; }
        float wq[8];
#pragma unroll
        for (int h = 0; h < 8; ++h) wq[h] = IW[(size_t)q * 8 + h];
        asm volatile("s_waitcnt lgkmcnt(0)" ::: "memory");
        const int nj = (t >> 6) + 1;
        for (int j = 0; j < nj; ++j) {
            const int s = j * 64 + lane;
            const float* kr = IK32 + ((size_t)(b << 12) + (s <= t ? s : t)) * IDXD;
            float kx[64];
#pragma unroll
            for (int d4 = 0; d4 < 16; ++d4) { const f32x4 v = *(const f32x4*)(kr + 4 * d4); kx[4 * d4] = v[0]; kx[4 * d4 + 1] = v[1]; kx[4 * d4 + 2] = v[2]; kx[4 * d4 + 3] = v[3]; }
            float score = 0.f;
#pragma unroll
            for (int h = 0; h < 8; ++h) { float d0 = 0.f;
#pragma unroll
                for (int d4 = 0; d4 < 16; ++d4) { const f32x4 qv = *(const LAS f32x4*)(iq + h * 64 + 4 * d4); d0 += qv[0] * kx[4 * d4]; d0 += qv[1] * kx[4 * d4 + 1]; d0 += qv[2] * kx[4 * d4 + 2]; d0 += qv[3] * kx[4 * d4 + 3]; }
                score += wq[h] * fmaxf(d0, 0.f); }
            sc[s] = (s <= t) ? score : -INFINITY;
        }
        asm volatile("s_waitcnt lgkmcnt(0)" ::: "memory");
        const int nvalid = nj * 64;
        unsigned key[64];
#pragma unroll
        for (int j = 0; j < 64; ++j) { const int s = lane * 64 + j; key[j] = (s < nvalid) ? f2key(sc[s]) : 0u; }
        unsigned prefix = 0u;
        for (int bit = 31; bit >= 0; --bit) {
            const unsigned cand = prefix | (1u << bit);
            int c = 0;
#pragma unroll
            for (int j = 0; j < 64; ++j) c += (key[j] >= cand) ? 1 : 0;
#pragma unroll
            for (int o = 1; o < 64; o <<= 1) c += __shfl_xor(c, o);
            if (c >= TOPK) prefix = cand;
        }
        int cgt = 0, ceq = 0;
#pragma unroll
        for (int j = 0; j < 64; ++j) { cgt += (key[j] > prefix) ? 1 : 0; ceq += (key[j] == prefix) ? 1 : 0; }
        int sgt = cgt, seq = ceq;
#pragma unroll
        for (int o = 1; o < 64; o <<= 1) { const int x = __shfl_up(sgt, o), y = __shfl_up(seq, o); if (lane >= o) { sgt += x; seq += y; } }
        const int tot_gt = __shfl(sgt, 63);
        int pos_gt = sgt - cgt, rank_eq = seq - ceq;
        const int need = TOPK - tot_gt;
#pragma unroll
        for (int j = 0; j < 64; ++j) {
            const int s = lane * 64 + j;
            if (key[j] > prefix) { sel[pos_gt] = (unsigned short)s; ++pos_gt; }
            else if (key[j] == prefix) { if (rank_eq < need) sel[tot_gt + rank_eq] = (unsigned short)s; ++rank_eq; }
        }
    }
}

__device__ __forceinline__ int t5_bucket(int rel) {
    if (rel < 16) return rel;
    const int l = 16 + (int)(logf((float)rel * (1.f / 16.f)) / 2.0794415416798357f * 16.f);
    return l < 31 ? l : 31;
}
__device__ __forceinline__ void p6_attention(const Args& a, LAS unsigned char* lds, int vcu, int G, int wave, int lane) {
    unsigned char* ws = a.ws;
    const f16* QI = (const f16*)a.out; const f16* CKV = (const f16*)(ws + WS_CKV);
    const unsigned short* SEL = (const unsigned short*)(ws + WS_SEL);
    f16* OATT = (f16*)(ws + WS_OATT);
    const float* rel_bias = a.in[2];
    LAS float* qa = (LAS float*)(lds + wave * 16384);
    LAS float* pp = (LAS float*)(lds + wave * 16384 + 4096);
    LAS int* sidx = (LAS int*)(lds + wave * 16384 + 12288);
    const int gw = vcu * NWAVES + wave, NGW = G * NWAVES;
    for (int q = gw; q < MTOK; q += NGW) {
        const int b = q >> 12, t = q & (SEQ - 1);
#pragma unroll
        for (int i = 0; i < 2; ++i) { const f16x8 v = *(const f16x8*)(QI + (size_t)q * NQI + 512 * i + 8 * lane);
#pragma unroll
            for (int e = 0; e < 8; ++e) qa[512 * i + 8 * lane + e] = (float)v[e]; }
        asm volatile("s_waitcnt lgkmcnt(0)" ::: "memory");
        float lg[4][8];
        int srow[4]; bool okv[4];
#pragma unroll
        for (int i = 0; i < 4; ++i) {
            const int sraw = SEL[(size_t)q * TOPK + lane + 64 * i];
            okv[i] = sraw != 0xFFFF && sraw <= t;
            srow[i] = okv[i] ? sraw : 0;
            sidx[lane + 64 * i] = okv[i] ? sraw : -1;
#pragma unroll
            for (int h = 0; h < 8; ++h) lg[i][h] = 0.f;
        }
#pragma unroll 1
        for (int c8 = 0; c8 < 16; ++c8) {
            f16x8 kv[4];
#pragma unroll
            for (int i = 0; i < 4; ++i) kv[i] = *(const f16x8*)(CKV + ((size_t)(b << 12) + srow[i]) * KVL + 8 * c8);
#pragma unroll
            for (int h = 0; h < 8; ++h) {
                const f32x4 q0 = *(const LAS f32x4*)(qa + h * 128 + 8 * c8), q1 = *(const LAS f32x4*)(qa + h * 128 + 8 * c8 + 4);
#pragma unroll
                for (int i = 0; i < 4; ++i)
                    lg[i][h] += q0[0] * (float)kv[i][0] + q0[1] * (float)kv[i][1] + q0[2] * (float)kv[i][2] + q0[3] * (float)kv[i][3] + q1[0] * (float)kv[i][4] + q1[1] * (float)kv[i][5] + q1[2] * (float)kv[i][6] + q1[3] * (float)kv[i][7];
            }
        }
#pragma unroll
        for (int i = 0; i < 4; ++i) {
            const int bk = t5_bucket(t - srow[i]);
#pragma unroll
            for (int h = 0; h < 8; ++h) lg[i][h] = okv[i] ? lg[i][h] + rel_bias[bk * 8 + h] : -INFINITY;
        }
#pragma unroll
        for (int h = 0; h < 8; ++h) {
            float mx = fmaxf(fmaxf(lg[0][h], lg[1][h]), fmaxf(lg[2][h], lg[3][h]));
#pragma unroll
            for (int o = 1; o < 64; o <<= 1) mx = fmaxf(mx, __shfl_xor(mx, o));
            float e[4], s = 0.f;
#pragma unroll
            for (int i = 0; i < 4; ++i) { e[i] = __expf(lg[i][h] - mx); s += e[i]; }
            s = wave_sum(s);
            const float inv = 1.f / s;
#pragma unroll
            for (int i = 0; i < 4; ++i) pp[h * 256 + lane + 64 * i] = e[i] * inv;
        }
        asm volatile("s_waitcnt lgkmcnt(0)" ::: "memory");
        float o0[8], o1[8];
#pragma unroll
        for (int h = 0; h < 8; ++h) { o0[h] = 0.f; o1[h] = 0.f; }
        for (int kk = 0; kk < TOPK; ++kk) {
            const int s = sidx[kk];
            if (s < 0) continue;
            const f16x2 kv = *(const f16x2*)(CKV + ((size_t)(b << 12) + s) * KVL + 2 * lane);
            const float v0 = (float)kv[0], v1 = (float)kv[1];
#pragma unroll
            for (int h = 0; h < 8; ++h) { const float p = pp[h * 256 + kk]; o0[h] += p * v0; o1[h] += p * v1; }
        }
#pragma unroll
        for (int h = 0; h < 8; ++h) *(unsigned*)(OATT + (size_t)q * KOUT + h * 128 + 2 * lane) = pkh(o0[h], o1[h]);
        asm volatile("s_waitcnt lgkmcnt(0)" ::: "memory");
    }
}

constexpr int SC_PITCH = 8224, DSA_SEL_OFF = 16 * SC_PITCH, DSA_BL_OFF = DSA_SEL_OFF + 8192, DSA_HIST_OFF = 143936;
static_assert(DSA_BL_OFF + 129 * 8 * 4 <= DSA_HIST_OFF && DSA_HIST_OFF + 8 * 1280 <= MISC_OFF, "DSA LDS map");
typedef short v4i16_t __attribute__((ext_vector_type(4)));
__device__ __forceinline__ unsigned kv_off(unsigned row, unsigned ch) { return 256u * row + 16u * (ch ^ (((row & 3u) << 2) | ((row >> 2) & 3u))); }
__device__ __forceinline__ f16x4 tr_read16(LAS unsigned char* p) { return __builtin_bit_cast(f16x4, __builtin_amdgcn_ds_read_tr16_b64_v4i16((LAS v4i16_t*)p)); }
template <int CTRL, int RMASK> __device__ __forceinline__ int dpp_i(int x) { return __builtin_amdgcn_update_dpp(0, x, CTRL, RMASK, 0xF, false); }
template <int CTRL> __device__ __forceinline__ int dpp_iz(int x) { return __builtin_amdgcn_update_dpp(0, x, CTRL, 0xF, 0xF, true); }
__device__ __forceinline__ int wave_incl_scan_i(int x) { x += dpp_iz<0x111>(x); x += dpp_iz<0x112>(x); x += dpp_iz<0x114>(x); x += dpp_iz<0x118>(x);
    x += dpp_i<0x142, 0xA>(x); x += dpp_i<0x143, 0xC>(x); return x; }
__device__ __forceinline__ void p5_dsa(const Args& a, LAS unsigned char* lds, int G, int bx, int tid, int wave, int lane) {
    unsigned char* ws = a.ws;
    const f16* QI = (const f16*)a.out; const f16* IK16 = (const f16*)(ws + WS_IK16); const float* IW = (const float*)(ws + WS_IW);
    const f16* CKV = (const f16*)(ws + WS_CKV); f16* OATT = (f16*)(ws + WS_OATT);
    LAS unsigned short* SELL = (LAS unsigned short*)(lds + DSA_SEL_OFF);
    LAS float* BL = (LAS float*)(lds + DSA_BL_OFF);
    for (int e = tid; e < 129 * 8; e += 512) { const int rel = e >> 3, h = e & 7; BL[e] = a.in[2][t5_bucket(rel) * 8 + h]; }
    const int nunits = BATCH * (SEQ / 16);
    const bool balanced = (G == 256);
    const int niter = balanced ? 8 : (nunits + G - 1) / G;
#pragma unroll 1
    for (int it = 0; it < niter; ++it) {
        int b, tile;
        if (balanced) { b = bx & 7; const int r = bx >> 3, base = 64 * (it >> 1); tile = (it & 1) ? base + 63 - r : base + r; }
        else { const int u = it * G + bx; if (u >= nunits) break; b = u >> 8; tile = u & 255; }
        int lane_o = lane; asm volatile("" : "+v"(lane_o));
        const int r16 = lane_o & 15, g = lane_o >> 4;
        const int t0 = tile * 16;
        const size_t qb = (size_t)(b << 12);
        const int jn = ((t0 + 15) >> 7) + 1;
        lds_barrier();
#ifndef DSAREP
#define DSAREP 0
#endif
#ifndef DSA_NO_A
        for (int ra_ = 0; ra_ < ((DSAREP & 1) ? 2 : 1); ++ra_)
        if (t0 + 15 >= TOPK) {
            f16x8 afr[8][2]; f32x4 wv[4][2];
#pragma unroll
            for (int mt = 0; mt < 8; ++mt) { const int tg = mt >> 1, hf = mt & 1, t = t0 + 4 * tg + (r16 >> 2), h = 4 * hf + (r16 & 3);
#pragma unroll
                for (int ks = 0; ks < 2; ++ks) afr[mt][ks] = *(const f16x8*)(QI + (qb + t) * NQI + 1024 + h * 64 + 32 * ks + 8 * g); }
#pragma unroll
            for (int tg = 0; tg < 4; ++tg)
#pragma unroll
                for (int hf = 0; hf < 2; ++hf) wv[tg][hf] = *(const f32x4*)(IW + (qb + t0 + 4 * tg + g) * 8 + 4 * hf) * 65536.0f;
            const f32x2 cscale = {1.52587890625e-05f, 1.52587890625e-05f};
            f16x8 bn0[2], bn1[2], bn2[2];
            const f16* ikp = IK16 + (qb + 16 * wave + r16) * IDXD + 8 * g;
#pragma unroll
            for (int ks = 0; ks < 2; ++ks) { bn0[ks] = *(const f16x8*)(ikp + 32 * ks); bn1[ks] = bn0[ks]; bn2[ks] = bn0[ks];
                if (jn > 1) bn1[ks] = *(const f16x8*)(ikp + 128 * IDXD + 32 * ks);
                if (jn > 2) bn2[ks] = *(const f16x8*)(ikp + 256 * IDXD + 32 * ks); }
            for (int j = 0; j < jn; ++j) {
                const int s = 128 * j + 16 * wave + r16;
                f16x8 bfr[2]; bfr[0] = bn0[0]; bfr[1] = bn0[1];
                bn0[0] = bn1[0]; bn0[1] = bn1[1]; bn1[0] = bn2[0]; bn1[1] = bn2[1];
                if (j + 3 < jn) {
#pragma unroll
                    for (int ks = 0; ks < 2; ++ks) bn2[ks] = *(const f16x8*)(ikp + (size_t)(128 * (j + 3)) * IDXD + 32 * ks); }
                f32x4 acc[8];
#pragma unroll
                for (int mt = 0; mt < 8; ++mt) { acc[mt] = __builtin_amdgcn_mfma_f32_16x16x32_f16(afr[mt][0], bfr[0], (f32x4){0.f, 0.f, 0.f, 0.f}, 0, 0, 0);
                    acc[mt] = __builtin_amdgcn_mfma_f32_16x16x32_f16(afr[mt][1], bfr[1], acc[mt], 0, 0, 0); }
                asm volatile("s_nop 15\n\ts_nop 7" :: "v"(acc[0]), "v"(acc[1]), "v"(acc[2]), "v"(acc[3]), "v"(acc[4]), "v"(acc[5]), "v"(acc[6]), "v"(acc[7]));
                float scv[4];
#pragma unroll
                for (int tg = 0; tg < 4; ++tg) { f32x2 s2 = {0.f, 0.f};
#pragma unroll
                    for (int hf = 0; hf < 2; ++hf)
#pragma unroll
                        for (int p = 0; p < 2; ++p) { const f32x2 av = {acc[2 * tg + hf][2 * p], acc[2 * tg + hf][2 * p + 1]}; f32x2 r;
                            asm volatile("v_pk_mul_f32 %0, %1, %2 clamp" : "=v"(r) : "v"(av), "v"(cscale));
                            const f32x2 wp = {wv[tg][hf][2 * p], wv[tg][hf][2 * p + 1]}; s2 = r * wp + s2; }
                    scv[tg] = s2[0] + s2[1]; }
                if (j == jn - 1) {
#pragma unroll
                    for (int tg = 0; tg < 4; ++tg) if (s > t0 + 4 * tg + g) scv[tg] = -INFINITY; }
#pragma unroll
                for (int pr = 0; pr < 2; ++pr) {
                    const unsigned x = pkh(scv[2 * pr], scv[2 * pr + 1]);
                    const unsigned k2 = x ^ ((((x >> 15) & 0x00010001u) * 0x7FFFu) | 0x80008000u);
                    *(LAS unsigned short*)(lds + (4 * (2 * pr) + g) * SC_PITCH + s * 2) = (unsigned short)(k2 & 0xFFFFu);
                    *(LAS unsigned short*)(lds + (4 * (2 * pr + 1) + g) * SC_PITCH + s * 2) = (unsigned short)(k2 >> 16); }
            }
        }
#endif
        __builtin_amdgcn_sched_barrier(0); lds_barrier(); __builtin_amdgcn_sched_barrier(0);
#ifndef DSA_NO_C
#pragma unroll 1
        for (int rr = 0; rr < ((DSAREP & 2) ? 4 : 2); ++rr) {
            const int rl = 2 * wave + (rr & 1), t = t0 + rl;
            LAS unsigned short* sel = SELL + rl * 256;
            if (t < TOPK) {
#pragma unroll
                for (int k = 0; k < 4; ++k) { const int jx = lane_o + 64 * k; sel[jx] = (jx <= t) ? (unsigned short)jx : (unsigned short)0xFFFF; }
                continue;
            }
            const LAS unsigned* srow = (const LAS unsigned*)(lds + rl * SC_PITCH) + lane_o;
#define DSA_KEY(jj_) (srow[(jj_) * 64])
            LAS unsigned* hist = (LAS unsigned*)(lds + DSA_HIST_OFF + wave * 1280);
            unsigned prefix = 0u; int kneed = TOPK;
#pragma unroll 1
            for (int pass = 0; pass < 2; ++pass) {
                *(LAS u32x4*)(hist + 4 * lane_o) = (u32x4){0u, 0u, 0u, 0u};
                asm volatile("s_waitcnt lgkmcnt(0)" ::: "memory");
                if (pass == 0) {
#pragma unroll 4
                    for (int jj = 0; jj < jn; ++jj) { const unsigned k = DSA_KEY(jj);
                        __hip_atomic_fetch_add(hist + (k >> 24), 1u, __ATOMIC_RELAXED, __HIP_MEMORY_SCOPE_WORKGROUP);
                        __hip_atomic_fetch_add(hist + ((k >> 8) & 0xFFu), 1u, __ATOMIC_RELAXED, __HIP_MEMORY_SCOPE_WORKGROUP);
                        if (DSAREP & 8) { __hip_atomic_fetch_add(hist + (k >> 24), 1u, __ATOMIC_RELAXED, __HIP_MEMORY_SCOPE_WORKGROUP); __hip_atomic_fetch_add(hist + ((k >> 8) & 0xFFu), 1u, __ATOMIC_RELAXED, __HIP_MEMORY_SCOPE_WORKGROUP);
                            __hip_atomic_fetch_add(hist + (k >> 24), 0xFFFFFFFFu, __ATOMIC_RELAXED, __HIP_MEMORY_SCOPE_WORKGROUP); __hip_atomic_fetch_add(hist + ((k >> 8) & 0xFFu), 0xFFFFFFFFu, __ATOMIC_RELAXED, __HIP_MEMORY_SCOPE_WORKGROUP); } }
                } else {
#pragma unroll 4
                    for (int jj = 0; jj < jn; ++jj) { const unsigned k = DSA_KEY(jj);
                        const unsigned dump = 256u + (unsigned)lane_o;
                        __hip_atomic_fetch_add(hist + (((k >> 24) == prefix) ? ((k >> 16) & 0xFFu) : dump), 1u, __ATOMIC_RELAXED, __HIP_MEMORY_SCOPE_WORKGROUP);
                        __hip_atomic_fetch_add(hist + ((((k >> 8) & 0xFFu) == prefix) ? (k & 0xFFu) : dump), 1u, __ATOMIC_RELAXED, __HIP_MEMORY_SCOPE_WORKGROUP); }
                }
                asm volatile("s_waitcnt lgkmcnt(0)" ::: "memory");
                const u32x4 hv = *(const LAS u32x4*)(hist + 4 * lane_o);
                const int sl = (int)(hv.x + hv.y + hv.z + hv.w);
                const int pre = wave_incl_scan_i(sl);
                const int tot = __builtin_amdgcn_readlane(pre, 63);
                const int S = tot - pre + sl;
                const int excl = S - sl;
                const unsigned long long bm = __ballot(excl < kneed && S >= kneed);
                const int L = bm ? (int)__builtin_ctzll(bm) : 0;
                const int ex = __builtin_amdgcn_readlane(excl, L); const int h1 = __builtin_amdgcn_readlane((int)hv.y, L), h2 = __builtin_amdgcn_readlane((int)hv.z, L), h3 = __builtin_amdgcn_readlane((int)hv.w, L);
                int cabove = ex, bin;
                if (cabove + h3 >= kneed) bin = 3; else { cabove += h3;
                    if (cabove + h2 >= kneed) bin = 2; else { cabove += h2;
                        if (cabove + h1 >= kneed) bin = 1; else { cabove += h1; bin = 0; } } }
                prefix = (prefix << 8) | (unsigned)(4 * L + bin); kneed -= cabove;
            }
            const unsigned lo = prefix << 16, hi = (prefix + 1u) << 16;
            const int tot_gt = TOPK - kneed, need = kneed;
            LAS unsigned short* dumpp = (LAS unsigned short*)(hist + 256) + lane_o;
            for (int er_ = 0; er_ < ((DSAREP & 16) ? 2 : 1); ++er_) {
            int base = 0, tbase = 0;
#pragma unroll 2
            for (int jj = 0; jj < jn; ++jj) { const unsigned k = DSA_KEY(jj);
                const int s0 = 2 * (jj * 64 + lane_o); const unsigned kb = k << 16;
                const bool g0 = kb >= hi, g1 = k >= hi;
                const unsigned long long m0 = __ballot(g0), m1 = __ballot(g1);
                const int p0 = base + (int)__builtin_amdgcn_mbcnt_hi((unsigned)(m0 >> 32), __builtin_amdgcn_mbcnt_lo((unsigned)m0, 0u)); base += __popcll(m0);
                const int p1 = base + (int)__builtin_amdgcn_mbcnt_hi((unsigned)(m1 >> 32), __builtin_amdgcn_mbcnt_lo((unsigned)m1, 0u)); base += __popcll(m1);
                *(g0 ? sel + p0 : dumpp) = (unsigned short)s0;
                *(g1 ? sel + p1 : dumpp) = (unsigned short)(s0 + 1);
                const bool e0 = (kb >= lo) && !g0, e1 = (k >= lo) && !g1;
                const unsigned long long t0m = __ballot(e0), t1m = __ballot(e1);
                if (t0m | t1m) {
                    const int r0 = tbase + (int)__builtin_amdgcn_mbcnt_hi((unsigned)(t0m >> 32), __builtin_amdgcn_mbcnt_lo((unsigned)t0m, 0u)); tbase += __popcll(t0m);
                    const int r1 = tbase + (int)__builtin_amdgcn_mbcnt_hi((unsigned)(t1m >> 32), __builtin_amdgcn_mbcnt_lo((unsigned)t1m, 0u)); tbase += __popcll(t1m);
                    if (e0 && r0 < need) sel[tot_gt + r0] = (unsigned short)s0;
                    if (e1 && r1 < need) sel[tot_gt + r1] = (unsigned short)(s0 + 1);
                }
            }
            }
#undef DSA_KEY
        }
#endif
        __builtin_amdgcn_sched_barrier(0); lds_barrier(); __builtin_amdgcn_sched_barrier(0);
#ifndef DSA_NO_D
        LAS unsigned char* kvb = lds + wave * 16384;
        const unsigned char* CKV8 = ws + WS_CKV8;
#pragma unroll 1
        for (int rr = 0; rr < ((DSAREP & 4) ? 4 : 2); ++rr) {
            const int rl = 2 * wave + (rr & 1), t = t0 + rl; const size_t q = qb + t;
            const LAS unsigned short* sel = SELL + rl * 256;
            long qf8[4];
#pragma unroll
            for (int ks = 0; ks < 4; ++ks) { const f16x8 v = *(const f16x8*)(QI + q * NQI + (r16 & 7) * 128 + 32 * ks + 8 * g); const float zs = (r16 >= 8) ? 0.f : 64.f;
                int lo32 = __builtin_amdgcn_cvt_pk_fp8_f32((float)v[0] * zs, (float)v[1] * zs, 0, false); lo32 = __builtin_amdgcn_cvt_pk_fp8_f32((float)v[2] * zs, (float)v[3] * zs, lo32, true);
                int hi32 = __builtin_amdgcn_cvt_pk_fp8_f32((float)v[4] * zs, (float)v[5] * zs, 0, false); hi32 = __builtin_amdgcn_cvt_pk_fp8_f32((float)v[6] * zs, (float)v[7] * zs, hi32, true);
                qf8[ks] = (long)(((unsigned long long)(unsigned)hi32 << 32) | (unsigned)lo32); }
            const LAS float* BLh = BL + (r16 & 7);
            float m_run = -1e30f, l_run = 0.f;
            f32x4 oE[4], oO[4];
#pragma unroll
            for (int cb = 0; cb < 4; ++cb) { oE[cb] = (f32x4){0.f, 0.f, 0.f, 0.f}; oO[cb] = (f32x4){0.f, 0.f, 0.f, 0.f}; }
            const int nch = (t < TOPK) ? (t >> 5) + 1 : 8;
#define DSA_DMA(ch_, buf_) do { unsigned so_[4]; _Pragma("unroll") for (int i = 0; i < 4; ++i) { const int R = 8 * i + (lane_o >> 3); \
                const unsigned ix = sel[32 * (ch_) + R]; const unsigned srow = (ix == 0xFFFFu) ? 0u : ix; so_[i] = srow * 128u + 16u * (((unsigned)lane_o & 7u) ^ ((unsigned)R & 7u)); } \
            _Pragma("unroll") for (int i = 0; i < 4; ++i) __builtin_amdgcn_global_load_lds((const unsigned*)(ckvb + so_[i]), (LAS unsigned*)(kvb + (buf_) * 4096 + i * 1024), 16, 0, 0); } while (0)
            const unsigned char* ckvb = CKV8 + qb * 128;
            asm volatile("s_waitcnt vmcnt(0)" ::: "memory");
            DSA_DMA(0, 0);
            const int qq = (lane_o & 15) >> 2, pp = lane_o & 3;
            unsigned offA[2][4], offT[4][2];
#pragma unroll
            for (int mt = 0; mt < 2; ++mt) { const int row = 16 * mt + r16;
#pragma unroll
                for (int ks = 0; ks < 4; ++ks) offA[mt][ks] = row * 128 + 16 * ((2 * ks + (g >> 1)) ^ (row & 7)) + 8 * (g & 1); }
#pragma unroll
            for (int cb = 0; cb < 4; ++cb) { const int r1 = 4 * g + qq, r2 = 16 + 4 * g + qq;
                offT[cb][0] = r1 * 128 + 16 * ((2 * cb + (pp >> 1)) ^ (r1 & 7)) + 8 * (pp & 1); offT[cb][1] = r2 * 128 + 16 * ((2 * cb + (pp >> 1)) ^ (r2 & 7)) + 8 * (pp & 1); }
#pragma unroll 1
            for (int ch = 0; ch < nch; ++ch) {
                asm volatile("s_waitcnt vmcnt(0)" ::: "memory");
                long af[2][4]; u32x2 td[4][2];
#pragma unroll
                for (int mt = 0; mt < 2; ++mt)
#pragma unroll
                    for (int ks = 0; ks < 4; ++ks) af[mt][ks] = *(const LAS long*)(kvb + offA[mt][ks]);
#pragma unroll
                for (int cb = 0; cb < 4; ++cb) { td[cb][0] = __builtin_bit_cast(u32x2, tr_read16(kvb + offT[cb][0])); td[cb][1] = __builtin_bit_cast(u32x2, tr_read16(kvb + offT[cb][1])); }
                u32x2 pk2[2]; float bvv[2][4]; bool inv4[2][4];
#pragma unroll
                for (int mt = 0; mt < 2; ++mt) { pk2[mt] = *(const LAS u32x2*)(sel + 32 * ch + 16 * mt + 4 * g);
#pragma unroll
                    for (int e = 0; e < 4; ++e) { const unsigned ix = ((e & 2) ? pk2[mt].y : pk2[mt].x) >> ((e & 1) * 16) & 0xFFFFu;
                        const int rel = t - (int)ix; const int rc = min(max(rel, 0), 128);
                        inv4[mt][e] = (ix == 0xFFFFu); bvv[mt][e] = BLh[rc * 8]; } }
                asm volatile("s_waitcnt lgkmcnt(0)" : "+v"(bvv[0][0]), "+v"(bvv[0][1]), "+v"(bvv[0][2]), "+v"(bvv[0][3]), "+v"(bvv[1][0]), "+v"(bvv[1][1]), "+v"(bvv[1][2]), "+v"(bvv[1][3]) :: "memory");
                if (ch + 1 < nch) DSA_DMA(ch + 1, 0);
                f32x4 lg[2];
#pragma unroll
                for (int mt = 0; mt < 2; ++mt) { lg[mt] = (f32x4){0.f, 0.f, 0.f, 0.f};
#pragma unroll
                    for (int ks = 0; ks < 4; ++ks) lg[mt] = __builtin_amdgcn_mfma_f32_16x16x32_fp8_fp8(af[mt][ks], qf8[ks], lg[mt], 0, 0, 0); }
                float cmax = -INFINITY;
#pragma unroll
                for (int mt = 0; mt < 2; ++mt)
#pragma unroll
                    for (int e = 0; e < 4; ++e) { const float v = inv4[mt][e] ? -INFINITY : lg[mt][e] * 0.015625f + bvv[mt][e]; lg[mt][e] = v; cmax = fmaxf(cmax, v); }
                cmax = fmaxf(cmax, __shfl_xor(cmax, 16)); cmax = fmaxf(cmax, __shfl_xor(cmax, 32));
                const float m_new = fmaxf(m_run, cmax); const float alpha = __expf(m_run - m_new); m_run = m_new;
                float ps = 0.f, pv[8];
#pragma unroll
                for (int mt = 0; mt < 2; ++mt)
#pragma unroll
                    for (int e = 0; e < 4; ++e) { const float p = __expf(lg[mt][e] - m_new); ps += p; pv[mt * 4 + e] = p; }
                int plo = __builtin_amdgcn_cvt_pk_fp8_f32(pv[0], pv[1], 0, false); plo = __builtin_amdgcn_cvt_pk_fp8_f32(pv[2], pv[3], plo, true);
                int phi = __builtin_amdgcn_cvt_pk_fp8_f32(pv[4], pv[5], 0, false); phi = __builtin_amdgcn_cvt_pk_fp8_f32(pv[6], pv[7], phi, true);
                const long pf8 = (long)(((unsigned long long)(unsigned)phi << 32) | (unsigned)plo);
                l_run = l_run * alpha + ps;
#pragma unroll
                for (int cb = 0; cb < 4; ++cb) { oE[cb] *= alpha; oO[cb] *= alpha; }
#pragma unroll
                for (int cb = 0; cb < 4; ++cb) {
                    const u32x2 d1 = td[cb][0], d2 = td[cb][1];
                    const unsigned xe0 = __builtin_amdgcn_perm(d1.y, d1.x, 0x06040200u), xo0 = __builtin_amdgcn_perm(d1.y, d1.x, 0x07050301u);
                    const unsigned xe1 = __builtin_amdgcn_perm(d2.y, d2.x, 0x06040200u), xo1 = __builtin_amdgcn_perm(d2.y, d2.x, 0x07050301u);
                    oE[cb] = __builtin_amdgcn_mfma_f32_16x16x32_fp8_fp8((long)(((unsigned long long)xe1 << 32) | xe0), pf8, oE[cb], 0, 0, 0);
                    oO[cb] = __builtin_amdgcn_mfma_f32_16x16x32_fp8_fp8((long)(((unsigned long long)xo1 << 32) | xo0), pf8, oO[cb], 0, 0, 0);
                }
            }
#undef DSA_DMA
            l_run += __shfl_xor(l_run, 16); l_run += __shfl_xor(l_run, 32);
            const float inv = 1.f / l_run;
            if (r16 < 8) {
#pragma unroll
                for (int cb = 0; cb < 4; ++cb) { u32x4 w; w.x = pkh(oE[cb][0] * inv, oO[cb][0] * inv); w.y = pkh(oE[cb][1] * inv, oO[cb][1] * inv); w.z = pkh(oE[cb][2] * inv, oO[cb][2] * inv); w.w = pkh(oE[cb][3] * inv, oO[cb][3] * inv);
                    *(u32x4*)(OATT + q * KOUT + r16 * 128 + 32 * cb + 8 * g) = w; }
            }
        }
#endif
    }
}

template <int CTRL> __device__ __forceinline__ float dpp_f(float x) { return __builtin_bit_cast(float, __builtin_amdgcn_update_dpp(0, __builtin_bit_cast(int, x), CTRL, 0xF, 0xF, false)); }
__device__ __forceinline__ float row16_sum(float x) { x += dpp_f<0x128>(x); x += dpp_f<0x124>(x); x += dpp_f<0x122>(x); x += dpp_f<0x121>(x); return x; }
constexpr int SCAN_TB = 32;
__device__ __forceinline__ void p7_scan(const Args& a, LAS unsigned char* lds, int vcu, int G, int wave, int lane) {
    unsigned char* ws = a.ws;
    const f16* PROJ = (const f16*)(ws + WS_PROJ); const f16* RWW = (const f16*)(ws + WS_RWW); const f16* RWA = (const f16*)(ws + WS_RWA);
    float* YRAW = (float*)(ws + WS_YRAW);
    for (int u = vcu; u < BATCH * HRW * 2; u += G) {
        const int half = u & 1, h = (u >> 1) & 7, b = u >> 4;
        const int ch = h * 64 + lane;
        const float mu_r = a.in[17][ch], mu_k = a.in[17][512 + ch], mu_v = a.in[17][1024 + ch], kkc = a.in[23][ch], kac = a.in[24][ch];
        const int rr = lane >> 4, qd = lane & 15, irow = half * 32 + wave * 4 + rr;
        float S0 = 0.f, S1 = 0.f, S2 = 0.f, S3 = 0.f;
#define SCAN_LOAD(blk_) do { _Pragma("unroll") for (int tt = 0; tt < 4; ++tt) { const int t = (blk_) * SCAN_TB + wave * 4 + tt; const size_t m = (size_t)(b << 12) + t; \
            const f16* pr = PROJ + m * IN_PAD + h * 64 + lane; \
            st_r[tt] = (float)pr[C_R]; st_k[tt] = (float)pr[C_K]; st_v[tt] = (float)pr[C_V]; \
            if (t > 0) { st_rp[tt] = (float)pr[C_R - IN_PAD]; st_kp[tt] = (float)pr[C_K - IN_PAD]; st_vp[tt] = (float)pr[C_V - IN_PAD]; } else { st_rp[tt] = 0.f; st_kp[tt] = 0.f; st_vp[tt] = 0.f; } \
            st_lw[tt] = (float)RWW[m * RW + ch]; st_av[tt] = (float)RWA[m * RW + ch]; } } while (0)
#define SCAN_WRITE(buf_) do { LAS float* base_ = (LAS float*)(lds + (buf_) * 49152); _Pragma("unroll") for (int tt = 0; tt < 4; ++tt) { const int tl = wave * 4 + tt; \
            const float rs = st_r[tt] + mu_r * (st_rp[tt] - st_r[tt]), ks = st_k[tt] + mu_k * (st_kp[tt] - st_k[tt]), vs = st_v[tt] + mu_v * (st_vp[tt] - st_v[tt]); \
            const float kkv = ks * kkc; const float nrm = sqrtf(wave_sum(kkv * kkv)); const float kkn = kkv / fmaxf(nrm, 1e-12f); \
            const float av = st_av[tt]; const float km = ks * (1.f + (av - 1.f) * kac); \
            base_[0 * 2048 + tl * 64 + lane] = rs; base_[1 * 2048 + tl * 64 + lane] = __expf(st_lw[tt]); base_[2 * 2048 + tl * 64 + lane] = km; \
            base_[3 * 2048 + tl * 64 + lane] = vs; base_[4 * 2048 + tl * 64 + lane] = -kkn; base_[5 * 2048 + tl * 64 + lane] = kkn * av; } } while (0)
        float st_r[4], st_k[4], st_v[4], st_rp[4], st_kp[4], st_vp[4], st_lw[4], st_av[4];
        __syncthreads();
        SCAN_LOAD(0); SCAN_WRITE(0);
        constexpr int NBLK = SEQ / SCAN_TB;
        for (int blk = 0; blk < NBLK; ++blk) {
            __syncthreads();
            if (blk + 1 < NBLK) SCAN_LOAD(blk + 1);
            const LAS float* base = (const LAS float*)(lds + (blk & 1) * 49152);
            for (int tl = 0; tl < SCAN_TB; ++tl) {
                const f32x4 r4 = *(const LAS f32x4*)(base + 0 * 2048 + tl * 64 + 4 * qd), w4 = *(const LAS f32x4*)(base + 1 * 2048 + tl * 64 + 4 * qd), k4 = *(const LAS f32x4*)(base + 2 * 2048 + tl * 64 + 4 * qd);
                const f32x4 a4 = *(const LAS f32x4*)(base + 4 * 2048 + tl * 64 + 4 * qd), b4 = *(const LAS f32x4*)(base + 5 * 2048 + tl * 64 + 4 * qd);
                const float vi = base[3 * 2048 + tl * 64 + irow];
                float sa = S0 * a4[0] + S1 * a4[1] + S2 * a4[2] + S3 * a4[3];
                sa = row16_sum(sa);
                S0 = S0 * w4[0] + sa * b4[0] + vi * k4[0]; S1 = S1 * w4[1] + sa * b4[1] + vi * k4[1]; S2 = S2 * w4[2] + sa * b4[2] + vi * k4[2]; S3 = S3 * w4[3] + sa * b4[3] + vi * k4[3];
                float y = S0 * r4[0] + S1 * r4[1] + S2 * r4[2] + S3 * r4[3];
                y = row16_sum(y);
                if (qd == 0) YRAW[((size_t)(b << 12) + blk * SCAN_TB + tl) * RW + h * 64 + irow] = y;
            }
            if (blk + 1 < NBLK) SCAN_WRITE((blk + 1) & 1);
        }
        __syncthreads();
    }
}

__device__ __forceinline__ void p8_rwkv_post(const Args& a, int vcu, int G, int wave, int lane) {
    unsigned char* ws = a.ws;
    const f16* PROJ = (const f16*)(ws + WS_PROJ); const f16* RWA = (const f16*)(ws + WS_RWA); const f16* RWG = (const f16*)(ws + WS_RWG);
    const float* YRAW = (const float*)(ws + WS_YRAW); f16* OATT = (f16*)(ws + WS_OATT);
    const int gw = vcu * NWAVES + wave, NGW = G * NWAVES;
    for (int it = gw; it < MTOK * HRW; it += NGW) {
        const int m = it >> 3, h = it & 7, ch = h * 64 + lane, t = m & (SEQ - 1);
        const f16* pr = PROJ + (size_t)m * IN_PAD + ch;
        float r = (float)pr[C_R], k = (float)pr[C_K], v = (float)pr[C_V], rp = 0.f, kp = 0.f, vp = 0.f;
        if (t > 0) { rp = (float)pr[C_R - IN_PAD]; kp = (float)pr[C_K - IN_PAD]; vp = (float)pr[C_V - IN_PAD]; }
        const float rs = r + a.in[17][ch] * (rp - r), ks = k + a.in[17][512 + ch] * (kp - k), vs = v + a.in[17][1024 + ch] * (vp - v);
        const float av = (float)RWA[(size_t)m * RW + ch];
        const float km = ks * (1.f + (av - 1.f) * a.in[24][ch]);
        const float y = YRAW[(size_t)m * RW + ch];
        const float mean = wave_sum(y) * (1.f / 64.f); const float dy = y - mean;
        const float var = wave_sum(dy * dy) * (1.f / 64.f);
        const float yn = dy * rsqrtf(var + GN_EPS) * a.in[26][ch] + a.in[27][ch];
        const float bonus = wave_sum(rs * km * a.in[25][ch]) * vs;
        OATT[(size_t)m * KOUT + 1024 + ch] = (f16)((yn + bonus) * (float)RWG[(size_t)m * RW + ch]);
    }
}

typedef short bf16x8 __attribute__((ext_vector_type(8)));
typedef _Float16 f16x4v __attribute__((ext_vector_type(4)));
__device__ __forceinline__ unsigned f2bf(float f) { unsigned u = __builtin_bit_cast(unsigned, f); return (u + 0x7fffu + ((u >> 16) & 1u)) >> 16; }
__device__ __forceinline__ unsigned pkb(float lo, float hi) { unsigned r; asm("v_cvt_pk_bf16_f32 %0, %1, %2" : "=v"(r) : "v"(lo), "v"(hi)); return r; }
constexpr int XP = 144;
constexpr int XD_OFF = 0, XA_OFF = 9216, XG_OFF = 18432, XG_P = 336;
constexpr int LAB_OFF = 0, LAK_OFF = 9216, LRB_OFF = 18432, LRK_OFF = 27648;
constexpr int AB_OFF = 39936, RB_OFF = AB_OFF + 9216, BB_OFF = RB_OFF + 9216, KB_OFF = BB_OFF + 9216;
constexpr int TT_OFF = 39936, M1T_OFF = TT_OFF + 9216, A2T_OFF = M1T_OFF + 9216, U1T_OFF = A2T_OFF + 9216;
constexpr int AH_OFF = 76800, VH_OFF = AH_OFF + 9216, BP_OFF = VH_OFF + 9216, KP_OFF = BP_OFF + 9216, RH_OFF = KP_OFF + 9216;
constexpr int NRM_OFF = 122880, CUMB_OFF = NRM_OFF + 512, XCONST_OFF = CUMB_OFF + 1024;
constexpr size_t WS_WDT = 28 * MiB, WS_WAT = WS_WDT + 65536, WS_WGT = WS_WAT + 65536;
constexpr size_t WS_RWP = 32 * MiB, WS_RWQ = 64 * MiB, WS_RWR2 = 408 * MiB, WS_RWY1 = 440 * MiB, WS_RWS0 = 472 * MiB, WS_BON = 364 * MiB;
constexpr int NUNIT = BATCH * 64 * HRW;

__device__ __forceinline__ f16x8 rd_row(LAS unsigned char* base, int pitch, int row, int col) { return *(const LAS f16x8*)(base + row * pitch + col * 2); }
__device__ __forceinline__ bf16x8 rd_rowb(LAS unsigned char* base, int pitch, int row, int col) { return *(const LAS bf16x8*)(base + row * pitch + col * 2); }
__device__ __forceinline__ f16x8 rd_tr(LAS unsigned char* base, int k0, int c0, int g, int qq, int pp) {
    const f16x4 v0 = tr_read16(base + (k0 + 8 * g + qq) * XP + (c0 + 4 * pp) * 2), v1 = tr_read16(base + (k0 + 8 * g + 4 + qq) * XP + (c0 + 4 * pp) * 2);
    return (f16x8){v0[0], v0[1], v0[2], v0[3], v1[0], v1[1], v1[2], v1[3]};
}
__device__ __forceinline__ void wr4h(LAS unsigned char* p, const f32x4& v) { u32x2 w; w.x = pkh(v[0], v[1]); w.y = pkh(v[2], v[3]); *(LAS u32x2*)p = w; }
__device__ __forceinline__ float dpp_shr_f(float x, int) { return x; }
template <int CTRL> __device__ __forceinline__ float dpp_z(float x) { return __builtin_bit_cast(float, __builtin_amdgcn_update_dpp(0, __builtin_bit_cast(int, x), CTRL, 0xF, 0xF, true)); }
__device__ __forceinline__ float row16_incl_scan(float x) { x += dpp_z<0x111>(x); x += dpp_z<0x112>(x); x += dpp_z<0x114>(x); x += dpp_z<0x118>(x); return x; }
#define MFMA_H(a, b, c) __builtin_amdgcn_mfma_f32_16x16x32_f16((a), (b), (c), 0, 0, 0)
#define MFMA_B(a, b, c) __builtin_amdgcn_mfma_f32_16x16x32_bf16((a), (b), (c), 0, 0, 0)
#define MFMA_H16(a, b, c) __builtin_amdgcn_mfma_f32_16x16x16f16((a), (b), (c), 0, 0, 0)
__device__ __forceinline__ f16x4 cvt4h(const f32x4& v) { return (f16x4){(f16)v[0], (f16)v[1], (f16)v[2], (f16)v[3]}; }
__device__ __forceinline__ f32x4 cvt4f(const f16x4& v) { return (f32x4){(float)v[0], (float)v[1], (float)v[2], (float)v[3]}; }

__device__ __forceinline__ void p7x_chunks(const Args& a, LAS unsigned char* lds, int vcu, int G, int tid, int wave, int lane) {
    unsigned char* ws = a.ws;
    const f16* PROJ = (const f16*)(ws + WS_PROJ);
    const f16* WDT = (const f16*)(ws + WS_WDT); const f16* WAT = (const f16*)(ws + WS_WAT); const f16* WGT = (const f16*)(ws + WS_WGT);
    f16* RWG = (f16*)(ws + WS_RWG); f16* RWP = (f16*)(ws + WS_RWP); f16* RWQ = (f16*)(ws + WS_RWQ); f16* RWR2 = (f16*)(ws + WS_RWR2); f16* RWY1 = (f16*)(ws + WS_RWY1);
    float* BON = (float*)(ws + WS_BON);
    const float* mu = a.in[17];
    const f32x4 z4 = {0.f, 0.f, 0.f, 0.f};
    const bool bal = (G == 256); const int bxx = blockIdx.x;
    const int nit = bal ? 16 : (NUNIT + G - 1) / G;
#define X_UNIT(itx_) (bal ? ((((bxx & 7) * 64 + (((bxx >> 3) + 32 * (itx_)) >> 3)) * 8 + (((bxx >> 3) + 32 * (itx_)) & 7))) : (vcu + (itx_) * G))
    f16x4 rv0[9], rv1c, rv1p, prc[2], pkc[2], pvc[2], prp[2], pkp[2], pvp[2];
    f16x8 wfd[2][2], wfa[2][2], wfg[2][5];
    int h_tab = -1;
#define X_PREFETCH(u_) do { int lp = lane; asm volatile("" : "+v"(lp)); const int h_ = (u_) & 7, c_ = ((u_) >> 3) & 63, b_ = (u_) >> 9; const size_t m0_ = (size_t)(b_ << 12) + c_ * 64; \
        _Pragma("unroll") for (int i = 0; i < 9; ++i) { const int t_ = 8 * wave + i - 1; const bool ok_ = (t_ >= 0 || c_ > 0); const f16* rowp = PROJ + (m0_ + t_) * IN_PAD + C_WD; \
            rv0[i] = (f16x4){0, 0, 0, 0}; if (ok_) rv0[i] = *(const f16x4*)(rowp + 4 * lp); } \
        { const int t1_ = 8 * wave + (lp >> 3); const f16* rp1 = PROJ + (m0_ + t1_) * IN_PAD + C_WD + 256 + 4 * (lp & 7); rv1c = *(const f16x4*)rp1; rv1p = (f16x4){0, 0, 0, 0}; if (t1_ > 0 || c_ > 0) rv1p = *(const f16x4*)(rp1 - IN_PAD); } \
        _Pragma("unroll") for (int ci = 0; ci < 2; ++ci) { const int chr_ = h_ * 64 + 16 * (2 * (wave >> 2) + ci) + (lp & 15); \
            _Pragma("unroll") for (int ks = 0; ks < 2; ++ks) { wfd[ci][ks] = *(const f16x8*)(WDT + (size_t)chr_ * 64 + 32 * ks + 8 * (lp >> 4)); wfa[ci][ks] = *(const f16x8*)(WAT + (size_t)chr_ * 64 + 32 * ks + 8 * (lp >> 4)); } \
            _Pragma("unroll") for (int ks = 0; ks < 5; ++ks) wfg[ci][ks] = *(const f16x8*)(WGT + (size_t)chr_ * 192 + 32 * ks + 8 * (lp >> 4)); } \
        const int t2_ = 16 * (wave & 3) + (lp & 15); const size_t m_ = m0_ + t2_; \
        _Pragma("unroll") for (int ci = 0; ci < 2; ++ci) { const int ch_ = h_ * 64 + 16 * (2 * (wave >> 2) + ci) + 4 * (lp >> 4); \
            prc[ci] = *(const f16x4*)(PROJ + m_ * IN_PAD + C_R + ch_); pkc[ci] = *(const f16x4*)(PROJ + m_ * IN_PAD + C_K + ch_); pvc[ci] = *(const f16x4*)(PROJ + m_ * IN_PAD + C_V + ch_); \
            prp[ci] = (f16x4){0, 0, 0, 0}; pkp[ci] = (f16x4){0, 0, 0, 0}; pvp[ci] = (f16x4){0, 0, 0, 0}; \
            if ((c_ * 64 + t2_) != 0) { prp[ci] = *(const f16x4*)(PROJ + (m_ - 1) * IN_PAD + C_R + ch_); pkp[ci] = *(const f16x4*)(PROJ + (m_ - 1) * IN_PAD + C_K + ch_); pvp[ci] = *(const f16x4*)(PROJ + (m_ - 1) * IN_PAD + C_V + ch_); } } } while (0)
    { const int u0 = X_UNIT(0); if (u0 < NUNIT) X_PREFETCH(u0); }
#pragma unroll 1
    for (int itx = 0; itx < nit; ++itx) {
        const int u = X_UNIT(itx); if (u >= NUNIT) break;
        const int un = (itx + 1 < nit) ? X_UNIT(itx + 1) : NUNIT;
        int lane_o = lane; asm volatile("" : "+v"(lane_o));
        const int r16 = lane_o & 15, g = lane_o >> 4, qq = r16 >> 2, pp = lane_o & 3;
        const int h = u & 7, c = (u >> 3) & 63, b = u >> 9;
        const size_t m0 = (size_t)(b << 12) + c * 64;
        lds_barrier();
        if (h != h_tab) { h_tab = h;
            if (tid < 64) { const int ch = h * 64 + tid; LAS float* ct = (LAS float*)(lds + XCONST_OFF) + tid;
                ct[0] = mu[ch]; ct[64] = mu[512 + ch]; ct[128] = mu[1024 + ch]; ct[192] = a.in[18][ch]; ct[256] = a.in[20][ch]; ct[320] = a.in[23][ch]; ct[384] = a.in[24][ch]; ct[448] = a.in[25][ch]; } }
        {
            const f32x4 mu0 = *(const f32x4*)(mu + 1536 + 4 * lane_o); const f32x4 mu1 = *(const f32x4*)(mu + 1536 + 256 + 4 * (lane_o & 7));
            const float kf = lane_o < 16 ? 2.f : 1.f; const bool is_t = lane_o < 16, is_id = (lane_o >= 16 && lane_o < 32);
            LAS unsigned char* d0 = is_t ? lds + XD_OFF + 8 * lane_o : is_id ? lds + XA_OFF + 8 * (lane_o - 16) : lds + XG_OFF + 8 * (lane_o - 32);
            const int p0 = (lane_o < 32) ? XP : XG_P;
#pragma unroll
            for (int i = 0; i < 8; ++i) { const int t = 8 * wave + i; float o[4];
#pragma unroll
                for (int e = 0; e < 4; ++e) { const float cu = (float)rv0[i + 1][e], pv = (float)rv0[i][e]; const float x = cu + mu0[e] * (pv - cu);
                    const float sg = __builtin_amdgcn_rcpf(1.f + __expf(-kf * x)); o[e] = is_t ? 2.f * sg - 1.f : is_id ? x : sg; }
                u32x2 w; w.x = pkh(o[0], o[1]); w.y = pkh(o[2], o[3]); *(LAS u32x2*)(d0 + t * p0) = w; }
            {
                float o1[4];
#pragma unroll
                for (int e = 0; e < 4; ++e) { const float cu1 = (float)rv1c[e], pv1 = (float)rv1p[e]; const float x1 = cu1 + mu1[e] * (pv1 - cu1); o1[e] = __builtin_amdgcn_rcpf(1.f + __expf(-x1)); }
                u32x2 w1; w1.x = pkh(o1[0], o1[1]); w1.y = pkh(o1[2], o1[3]); *(LAS u32x2*)(lds + XG_OFF + (8 * wave + (lane_o >> 3)) * XG_P + (128 + 4 * (lane_o & 7)) * 2) = w1; }
        }
        lds_barrier();
        const int tb = wave & 3, cth = wave >> 2;
        const int t = 16 * tb + r16; const size_t m = m0 + t;
        f32x4 dA[2], aA[2], gA[2];
#pragma unroll
        for (int ci = 0; ci < 2; ++ci) {
            dA[ci] = z4; aA[ci] = z4; gA[ci] = z4;
#pragma unroll
            for (int ks = 0; ks < 2; ++ks) {
                dA[ci] = MFMA_H(wfd[ci][ks], rd_row(lds + XD_OFF, XP, t, 32 * ks + 8 * g), dA[ci]);
                aA[ci] = MFMA_H(wfa[ci][ks], rd_row(lds + XA_OFF, XP, t, 32 * ks + 8 * g), aA[ci]); }
#pragma unroll
            for (int ks = 0; ks < 5; ++ks) gA[ci] = MFMA_H(wfg[ci][ks], rd_row(lds + XG_OFF, XG_P, t, 32 * ks + 8 * g), gA[ci]);
        }
        float lwv[2][4], asg[2][4], rs[2][4], kp[2][4], vs[2][4], kkv[2][4], cl[2][4];
        float pn = 0.f, prk = 0.f;
#pragma unroll
        for (int ci = 0; ci < 2; ++ci) {
            const int chl = 16 * (2 * cth + ci) + 4 * g, ch = h * 64 + chl;
            const f16x4 rc = prc[ci], kc = pkc[ci], vc = pvc[ci], rp = prp[ci], kq = pkp[ci], vp = pvp[ci];
            const LAS float* ct = (const LAS float*)(lds + XCONST_OFF) + chl;
            const f32x4 mur = *(const LAS f32x4*)(ct), muk = *(const LAS f32x4*)(ct + 64), muv = *(const LAS f32x4*)(ct + 128);
            const f32x4 w0 = *(const LAS f32x4*)(ct + 192), a0 = *(const LAS f32x4*)(ct + 256), kkc = *(const LAS f32x4*)(ct + 320), kac = *(const LAS f32x4*)(ct + 384), rkc = *(const LAS f32x4*)(ct + 448);
            float gl[4];
#pragma unroll
            for (int e = 0; e < 4; ++e) {
                const float z = -(w0[e] + dA[ci][e]); const float sp = fmaxf(z, 0.f) + __logf(1.f + __expf(-fabsf(z)));
                lwv[ci][e] = -__expf(-sp - 0.5f);
                asg[ci][e] = sigmoidf_(a0[e] + aA[ci][e]); gl[e] = gA[ci][e];
                rs[ci][e] = (float)rc[e] + mur[e] * ((float)rp[e] - (float)rc[e]);
                const float ks_ = (float)kc[e] + muk[e] * ((float)kq[e] - (float)kc[e]);
                vs[ci][e] = (float)vc[e] + muv[e] * ((float)vp[e] - (float)vc[e]);
                kkv[ci][e] = ks_ * kkc[e]; pn += kkv[ci][e] * kkv[ci][e];
                kp[ci][e] = ks_ * (1.f + (asg[ci][e] - 1.f) * kac[e]);
                prk += rs[ci][e] * kp[ci][e] * rkc[e];
                cl[ci][e] = row16_incl_scan(lwv[ci][e]);
                if (r16 == 15) ((LAS float*)(lds + CUMB_OFF))[tb * 64 + chl + e] = cl[ci][e];
            }
            u32x2 gw; gw.x = pkh(gl[0], gl[1]); gw.y = pkh(gl[2], gl[3]); *(u32x2*)(RWG + m * RW + ch) = gw;
        }
        pn += __shfl_xor(pn, 16); pn += __shfl_xor(pn, 32); prk += __shfl_xor(prk, 16); prk += __shfl_xor(prk, 32);
        if (g == 0) { ((LAS float*)(lds + NRM_OFF))[t * 2 + cth] = pn; BON[((size_t)u * 64 + t) * 2 + cth] = prk; }
        lds_barrier();
        {
            const float nrm = sqrtf(((LAS float*)(lds + NRM_OFF))[t * 2] + ((LAS float*)(lds + NRM_OFF))[t * 2 + 1]); const float inrm = __builtin_amdgcn_rcpf(fmaxf(nrm, 1e-12f));
#pragma unroll
            for (int ci = 0; ci < 2; ++ci) {
                const int chl = 16 * (2 * cth + ci) + 4 * g;
                float Ab[4], Rb[4], Bb[4], Kb[4], Bp[4], Kp[4];
                const LAS float* cbp = (const LAS float*)(lds + CUMB_OFF) + chl;
                const f32x4 cb0 = *(const LAS f32x4*)(cbp), cb1 = *(const LAS f32x4*)(cbp + 64), cb2 = *(const LAS f32x4*)(cbp + 128), cb3 = *(const LAS f32x4*)(cbp + 192);
#pragma unroll
                for (int e = 0; e < 4; ++e) {
                    const float b0 = cb0[e], b1 = cb1[e], b2 = cb2[e], b3 = cb3[e];
                    const float pre = (tb > 0 ? b0 : 0.f) + (tb > 1 ? b1 : 0.f) + (tb > 2 ? b2 : 0.f);
                    const float cum = cl[ci][e] + pre, cumC = (b0 + b1) + (b2 + b3);
                    const float kkn = kkv[ci][e] * inrm, av = -kkn, bv = kkn * asg[ci][e];
                    const float eg = __expf(cum), egi = __expf(-cum), egc = __expf(cumC - cum);
                    Ab[e] = av * __expf(cum - lwv[ci][e]); Rb[e] = rs[ci][e] * eg; Bb[e] = bv * egi; Kb[e] = kp[ci][e] * egi; Bp[e] = bv * egc; Kp[e] = kp[ci][e] * egc;
                }
                const int ro = t * XP + chl * 2;
                u32x2 w;
                w.x = pkb(Ab[0], Ab[1]); w.y = pkb(Ab[2], Ab[3]); *(LAS u32x2*)(lds + AB_OFF + ro) = w;
                w.x = pkb(Rb[0], Rb[1]); w.y = pkb(Rb[2], Rb[3]); *(LAS u32x2*)(lds + RB_OFF + ro) = w;
                w.x = pkb(Bb[0], Bb[1]); w.y = pkb(Bb[2], Bb[3]); *(LAS u32x2*)(lds + BB_OFF + ro) = w;
                w.x = pkb(Kb[0], Kb[1]); w.y = pkb(Kb[2], Kb[3]); *(LAS u32x2*)(lds + KB_OFF + ro) = w;
                w.x = pkh(Ab[0], Ab[1]); w.y = pkh(Ab[2], Ab[3]); *(LAS u32x2*)(lds + AH_OFF + ro) = w;
                w.x = pkh(Rb[0], Rb[1]); w.y = pkh(Rb[2], Rb[3]); *(LAS u32x2*)(lds + RH_OFF + ro) = w;
                w.x = pkh(vs[ci][0], vs[ci][1]); w.y = pkh(vs[ci][2], vs[ci][3]); *(LAS u32x2*)(lds + VH_OFF + ro) = w;
                w.x = pkh(Bp[0], Bp[1]); w.y = pkh(Bp[2], Bp[3]); *(LAS u32x2*)(lds + BP_OFF + ro) = w;
                w.x = pkh(Kp[0], Kp[1]); w.y = pkh(Kp[2], Kp[3]); *(LAS u32x2*)(lds + KP_OFF + ro) = w;
            }
        }
        lds_barrier();
#pragma unroll 1
        for (int k = 0; k < 5; ++k) {
            const int idx = wave + 8 * k, prod = idx / 10, rem = idx - prod * 10;
            const int tb1 = rem >= 6 ? 3 : rem >= 3 ? 2 : rem >= 1 ? 1 : 0, ub = rem - (tb1 * (tb1 + 1)) / 2;
            LAS unsigned char* X = lds + ((prod < 2) ? AB_OFF : RB_OFF); LAS unsigned char* Y = lds + ((prod & 1) ? KB_OFF : BB_OFF);
            f32x4 acc = z4;
#pragma unroll
            for (int ks = 0; ks < 2; ++ks) acc = MFMA_B(rd_rowb(Y, XP, 16 * ub + r16, 32 * ks + 8 * g), rd_rowb(X, XP, 16 * tb1 + r16, 32 * ks + 8 * g), acc);
            const int tt = 16 * tb1 + r16, tau0 = 16 * ub + 4 * g; const int lim = (prod < 2) ? tt : tt + 1;
#pragma unroll
            for (int e = 0; e < 4; ++e) if (tau0 + e >= lim) acc[e] = 0.f;
            wr4h(lds + LAB_OFF + prod * 9216 + tt * XP + tau0 * 2, acc);
        }
#pragma unroll 1
        for (int k = 0; k < 3; ++k) {
            const int idx = wave + 8 * k, prod = idx / 6, rem = idx - prod * 6;
            const int tb1 = rem >= 5 ? 2 : rem >= 3 ? 1 : 0, ub = (rem >= 5) ? 3 : (rem >= 3) ? rem - 1 : rem + 1;
            wr4h(lds + LAB_OFF + prod * 9216 + (16 * tb1 + r16) * XP + (16 * ub + 4 * g) * 2, z4);
        }
        lds_barrier();
        if (wave == 0) {
            LAS unsigned char* L = lds + LAB_OFF; LAS unsigned char* TT = lds + TT_OFF;
            f32x4 TB[4][4]; f16x4 TAh[4];
            float idn[4];
#pragma unroll
            for (int e = 0; e < 4; ++e) idn[e] = (r16 == 4 * g + e) ? 1.f : 0.f;
#pragma unroll
            for (int i = 0; i < 4; ++i) {
                f16x4 XA = *(const LAS f16x4*)(L + (16 * i + r16) * XP + (16 * i + 4 * g) * 2);
                f16x4 XB = tr_read16(L + (16 * i + 4 * g + qq) * XP + (16 * i + 4 * pp) * 2);
                f32x4 TAf, TBf;
#pragma unroll
                for (int e = 0; e < 4; ++e) { TAf[e] = idn[e] + (float)XA[e]; TBf[e] = idn[e] + (float)XB[e]; }
#pragma unroll
                for (int lv = 0; lv < 3; ++lv) {
                    const f32x4 X2B = MFMA_H16(XA, XB, z4), X2A = MFMA_H16(XB, XA, z4);
                    XA = cvt4h(X2A); XB = cvt4h(X2B);
                    const f16x4 ta = cvt4h(TAf);
                    TBf = MFMA_H16(ta, XB, TBf); TAf = MFMA_H16(XB, ta, TAf);
                }
                TB[i][i] = TBf; TAh[i] = cvt4h(TAf);
            }
#pragma unroll
            for (int d = 1; d < 4; ++d)
#pragma unroll
                for (int j = 0; j + d < 4; ++j) { const int i = j + d;
                    f32x4 M = z4;
#pragma unroll
                    for (int kq2 = j; kq2 < i; ++kq2) M = MFMA_H16(*(const LAS f16x4*)(L + (16 * i + r16) * XP + (16 * kq2 + 4 * g) * 2), cvt4h(TB[kq2][j]), M);
                    TB[i][j] = MFMA_H16(TAh[i], cvt4h(M), z4);
                }
#pragma unroll
            for (int i = 0; i < 4; ++i)
#pragma unroll
                for (int j = 0; j < 4; ++j) wr4h(TT + (16 * j + r16) * XP + (16 * i + 4 * g) * 2, (j <= i) ? TB[i][j] : z4);
        } else {
#pragma unroll 1
            for (int idx = wave - 1; idx < 16; idx += 7) { const int tb1 = idx >> 2, ib = idx & 3;
                f32x4 acc = z4;
#pragma unroll
                for (int ks = 0; ks < 2; ++ks) acc = MFMA_H(rd_row(lds + LAK_OFF, XP, 16 * tb1 + r16, 32 * ks + 8 * g), rd_tr(lds + VH_OFF, 32 * ks, 16 * ib, g, qq, pp), acc);
                wr4h(lds + M1T_OFF + (16 * ib + r16) * XP + (16 * tb1 + 4 * g) * 2, acc);
            }
        }
        lds_barrier();
#pragma unroll
        for (int k = 0; k < 4; ++k) {
            const int which = k >> 1, tb1 = 2 * (k & 1) + (wave >> 2), nb = wave & 3;
            f32x4 acc = z4;
#pragma unroll
            for (int ks = 0; ks < 2; ++ks) {
                const f16x8 af = rd_tr(lds + TT_OFF, 32 * ks, 16 * tb1, g, qq, pp);
                const f16x8 bf = which ? rd_row(lds + M1T_OFF, XP, 16 * nb + r16, 32 * ks + 8 * g) : rd_tr(lds + AH_OFF, 32 * ks, 16 * nb, g, qq, pp);
                acc = MFMA_H(af, bf, acc);
            }
            wr4h(lds + (which ? U1T_OFF : A2T_OFF) + (16 * nb + r16) * XP + (16 * tb1 + 4 * g) * 2, acc);
        }
        lds_barrier();
        if (un < NUNIT) X_PREFETCH(un);
#pragma unroll
        for (int k = 0; k < 8; ++k) {
            const int kind = k >> 1, a4 = 2 * (k & 1) + (wave >> 2), b4 = wave & 3;
            f32x4 acc = z4;
            if (kind == 0) {
#pragma unroll
                for (int ks = 0; ks < 2; ++ks) acc = MFMA_H(rd_row(lds + A2T_OFF, XP, 16 * a4 + r16, 32 * ks + 8 * g), rd_tr(lds + BP_OFF, 32 * ks, 16 * b4, g, qq, pp), acc);
                if (a4 == b4) { const LAS float* cb = (const LAS float*)(lds + CUMB_OFF) + 16 * b4 + r16; const float gC = __expf((cb[0] + cb[64]) + (cb[128] + cb[192]));
#pragma unroll
                    for (int e = 0; e < 4; ++e) if (4 * g + e == r16) acc[e] += gC; }
                u32x2 w; w.x = pkh(acc[0], acc[1]); w.y = pkh(acc[2], acc[3]);
                *(u32x2*)(RWP + (size_t)u * 4096 + ((b4 * 2 + (a4 >> 1)) * 64 + lane_o) * 8 + (a4 & 1) * 4) = w;
            } else if (kind == 1) {
#pragma unroll
                for (int ks = 0; ks < 2; ++ks) { acc = MFMA_H(rd_tr(lds + BP_OFF, 32 * ks, 16 * a4, g, qq, pp), rd_row(lds + U1T_OFF, XP, 16 * b4 + r16, 32 * ks + 8 * g), acc);
                    acc = MFMA_H(rd_tr(lds + KP_OFF, 32 * ks, 16 * a4, g, qq, pp), rd_tr(lds + VH_OFF, 32 * ks, 16 * b4, g, qq, pp), acc); }
                u32x2 w; w.x = pkh(acc[0], acc[1]); w.y = pkh(acc[2], acc[3]);
                *(u32x2*)(RWQ + (size_t)u * 4096 + ((b4 * 4 + a4) * 64 + lane_o) * 4) = w;
            } else if (kind == 2) {
                { const f16x4 rh4 = *(const LAS f16x4*)(lds + RH_OFF + (16 * b4 + r16) * XP + (16 * a4 + 4 * g) * 2); acc = cvt4f(rh4); }
#pragma unroll
                for (int ks = 0; ks < 2; ++ks) acc = MFMA_H(rd_row(lds + A2T_OFF, XP, 16 * a4 + r16, 32 * ks + 8 * g), rd_row(lds + LRB_OFF, XP, 16 * b4 + r16, 32 * ks + 8 * g), acc);
                u32x2 w; w.x = pkh(acc[0], acc[1]); w.y = pkh(acc[2], acc[3]);
                *(u32x2*)(RWR2 + (size_t)u * 4096 + (16 * b4 + r16) * 64 + 16 * a4 + 4 * g) = w;
            } else {
#pragma unroll
                for (int ks = 0; ks < 2; ++ks) { acc = MFMA_H(rd_row(lds + U1T_OFF, XP, 16 * a4 + r16, 32 * ks + 8 * g), rd_row(lds + LRB_OFF, XP, 16 * b4 + r16, 32 * ks + 8 * g), acc);
                    acc = MFMA_H(rd_tr(lds + VH_OFF, 32 * ks, 16 * a4, g, qq, pp), rd_row(lds + LRK_OFF, XP, 16 * b4 + r16, 32 * ks + 8 * g), acc); }
                u32x2 w; w.x = pkh(acc[0], acc[1]); w.y = pkh(acc[2], acc[3]);
                *(u32x2*)(RWY1 + (size_t)u * 4096 + ((a4 * 4 + b4) * 64 + lane_o) * 4) = w;
            }
        }
    }
}

#undef X_UNIT
#undef X_PREFETCH
struct ChBuf { f16x8 p[4][2]; u32x2 q[4]; };
__device__ __forceinline__ void p7y_chain(const Args& a, int bx0, int G, int wave, int lane) {
    unsigned char* ws = a.ws;
    const f16* RWP = (const f16*)(ws + WS_RWP); const f16* RWQ = (const f16*)(ws + WS_RWQ); f16* RWS0 = (f16*)(ws + WS_RWS0);
    if (wave != 0) return;
#pragma unroll 1
    for (int bx = bx0; bx < 256; bx += G) {
    const int r16 = lane & 15, g = lane >> 4;
    const int b = bx & 7, rest = bx >> 3, h = rest >> 2, it = rest & 3;
    f32x4 S[4];
#pragma unroll
    for (int mt = 0; mt < 4; ++mt) S[mt] = (f32x4){0.f, 0.f, 0.f, 0.f};
    ChBuf B0, B1, B2, B3;
#define CH_LOAD(BUF, c_) do { const size_t uu = ((size_t)(b * 64 + (c_)) * 8 + h); \
        _Pragma("unroll") for (int mo = 0; mo < 4; ++mo) { BUF.q[mo] = *(const u32x2*)(RWQ + uu * 4096 + ((it * 4 + mo) * 64 + lane) * 4); \
            _Pragma("unroll") for (int ks = 0; ks < 2; ++ks) BUF.p[mo][ks] = *(const f16x8*)(RWP + uu * 4096 + ((mo * 2 + ks) * 64 + lane) * 8); } } while (0)
#define CH_STEP(BUF, c_) do { const size_t uu = ((size_t)(b * 64 + (c_)) * 8 + h); f16x8 bfr[2]; \
        _Pragma("unroll") for (int mt = 0; mt < 4; ++mt) { u32x2 w; w.x = pkh(S[mt][0], S[mt][1]); w.y = pkh(S[mt][2], S[mt][3]); \
            *(u32x2*)(RWS0 + uu * 4096 + (16 * it + r16) * 64 + 16 * mt + 4 * g) = w; const f16x4 hv = __builtin_bit_cast(f16x4, w); \
            bfr[mt >> 1][(mt & 1) * 4 + 0] = hv[0]; bfr[mt >> 1][(mt & 1) * 4 + 1] = hv[1]; bfr[mt >> 1][(mt & 1) * 4 + 2] = hv[2]; bfr[mt >> 1][(mt & 1) * 4 + 3] = hv[3]; } \
        _Pragma("unroll") for (int mo = 0; mo < 4; ++mo) { f32x4 n_ = cvt4f(__builtin_bit_cast(f16x4, BUF.q[mo])); \
            _Pragma("unroll") for (int ks = 0; ks < 2; ++ks) n_ = MFMA_H(BUF.p[mo][ks], bfr[ks], n_); S[mo] = n_; } \
        if ((c_) + 4 < 64) CH_LOAD(BUF, (c_) + 4); } while (0)
    CH_LOAD(B0, 0); CH_LOAD(B1, 1); CH_LOAD(B2, 2); CH_LOAD(B3, 3);
#pragma unroll 1
    for (int c = 0; c < 64; c += 4) { CH_STEP(B0, c); CH_STEP(B1, c + 1); CH_STEP(B2, c + 2); CH_STEP(B3, c + 3); }
    }
#undef CH_LOAD
#undef CH_STEP
}

__device__ __forceinline__ void p8z_out(const Args& a, int vcu, int G, int wave, int lane) {
    unsigned char* ws = a.ws;
    const f16* PROJ = (const f16*)(ws + WS_PROJ); const f16* RWG = (const f16*)(ws + WS_RWG);
    const f16* RWR2 = (const f16*)(ws + WS_RWR2); const f16* RWY1 = (const f16*)(ws + WS_RWY1); const f16* RWS0 = (const f16*)(ws + WS_RWS0);
    const float* BON = (const float*)(ws + WS_BON); f16* OATT = (f16*)(ws + WS_OATT);
    const int gw = vcu * NWAVES + wave, NGW = G * NWAVES;
    const bool bal = (G == 256); const int bxx = blockIdx.x;
    const int nit = bal ? 2 : (NUNIT + NGW - 1) / NGW;
#pragma unroll 1
    for (int itx = 0; itx < nit; ++itx) {
        int u;
        if (bal) { const int idx = (bxx >> 3) * 8 + wave + 256 * itx; u = (((bxx & 7) * 64 + (idx >> 3)) * 8 + (idx & 7)); } else { u = gw + itx * NGW; if (u >= NUNIT) break; }
        int lane_o = lane; asm volatile("" : "+v"(lane_o));
        const int r16 = lane_o & 15, g = lane_o >> 4;
        const int h = u & 7, c = (u >> 3) & 63, b = u >> 9;
        const size_t m0 = (size_t)(b << 12) + c * 64;
        f32x4 acc[4][4];
#pragma unroll
        for (int mt = 0; mt < 4; ++mt)
#pragma unroll
            for (int nt = 0; nt < 4; ++nt) acc[mt][nt] = cvt4f(*(const f16x4*)(RWY1 + (size_t)u * 4096 + ((mt * 4 + nt) * 64 + lane_o) * 4));
#pragma unroll
        for (int ks = 0; ks < 2; ++ks) {
            f16x8 sf[4], rf[4];
#pragma unroll
            for (int x = 0; x < 4; ++x) { sf[x] = *(const f16x8*)(RWS0 + (size_t)u * 4096 + (16 * x + r16) * 64 + 32 * ks + 8 * g); rf[x] = *(const f16x8*)(RWR2 + (size_t)u * 4096 + (16 * x + r16) * 64 + 32 * ks + 8 * g); }
#pragma unroll
            for (int mt = 0; mt < 4; ++mt)
#pragma unroll
                for (int nt = 0; nt < 4; ++nt) acc[mt][nt] = MFMA_H(sf[mt], rf[nt], acc[mt][nt]);
        }
#pragma unroll
        for (int nt = 0; nt < 4; ++nt) {
            const int t = 16 * nt + r16; const size_t m = m0 + t;
            float s = 0.f;
#pragma unroll
            for (int mt = 0; mt < 4; ++mt) s += (acc[mt][nt][0] + acc[mt][nt][1]) + (acc[mt][nt][2] + acc[mt][nt][3]);
            s += __shfl_xor(s, 16); s += __shfl_xor(s, 32);
            const float mean = s * (1.f / 64.f); float q = 0.f;
#pragma unroll
            for (int mt = 0; mt < 4; ++mt)
#pragma unroll
                for (int e = 0; e < 4; ++e) { const float d = acc[mt][nt][e] - mean; q += d * d; }
            q += __shfl_xor(q, 16); q += __shfl_xor(q, 32);
            const float rstd = rsqrtf(q * (1.f / 64.f) + GN_EPS);
            const f32x2 bo = *(const f32x2*)(BON + ((size_t)u * 64 + t) * 2); const float bonus = bo[0] + bo[1];
#pragma unroll
            for (int mt = 0; mt < 4; ++mt) {
                const int ch = h * 64 + 16 * mt + 4 * g;
                const f16x4 vc = *(const f16x4*)(PROJ + m * IN_PAD + C_V + ch);
                f16x4 vp = {0, 0, 0, 0}; if ((c * 64 + t) != 0) vp = *(const f16x4*)(PROJ + (m - 1) * IN_PAD + C_V + ch);
                const f32x4 muv = *(const f32x4*)(a.in[17] + 1024 + ch), gn = *(const f32x4*)(a.in[26] + ch), bs = *(const f32x4*)(a.in[27] + ch);
                const f16x4 gg = *(const f16x4*)(RWG + m * RW + ch);
                float o[4];
#pragma unroll
                for (int e = 0; e < 4; ++e) { const float vsv = (float)vc[e] + muv[e] * ((float)vp[e] - (float)vc[e]);
                    o[e] = ((acc[mt][nt][e] - mean) * rstd * gn[e] + bs[e] + bonus * vsv) * (float)gg[e]; }
                u32x2 w; w.x = pkh(o[0], o[1]); w.y = pkh(o[2], o[3]);
                *(u32x2*)(OATT + m * KOUT + 1024 + ch) = w;
            }
        }
    }
}

__device__ __forceinline__ f16* x1_row(unsigned char* ws, int m) { return (f16*)(ws + ((m < 16384) ? WS_RWG : (WS_RWS0 - (size_t)16384 * 2048)) + (size_t)m * 2048); }
__device__ __forceinline__ void p10_mid(const Args& a, int vcu, int G, int wave, int lane) {
    unsigned char* ws = a.ws;
    const f16* MIX = (const f16*)(ws + WS_MIX); const float* mod = (const float*)(ws + WS_MOD); f16* HF = (f16*)(ws + WS_H);
    const int gw = vcu * NWAVES + wave, NGW = G * NWAVES;
    float g6[16], g7[16];
#pragma unroll
    for (int j = 0; j < 2; ++j) { const int c = 8 * lane + 512 * j;
        const f32x4 p0 = *(const f32x4*)(a.in[6] + c), p1 = *(const f32x4*)(a.in[6] + c + 4), q0 = *(const f32x4*)(a.in[7] + c), q1 = *(const f32x4*)(a.in[7] + c + 4);
#pragma unroll
        for (int e = 0; e < 4; ++e) { g6[8 * j + e] = p0[e]; g6[8 * j + 4 + e] = p1[e]; g7[8 * j + e] = q0[e]; g7[8 * j + 4 + e] = q1[e]; } }
    for (int m = gw; m < MTOK; m += NGW) {
        const int b = m >> 12; const float* md = mod + b * 6144;
        float mx[16], xv[16]; float s = 0.f;
#pragma unroll
        for (int j = 0; j < 2; ++j) { const int c = 8 * lane + 512 * j; const f16x8 v = *(const f16x8*)(MIX + (size_t)m * D + c);
#pragma unroll
            for (int e = 0; e < 8; ++e) { mx[8 * j + e] = (float)v[e]; s += mx[8 * j + e] * mx[8 * j + e]; }
            const f32x4 x0 = *(const f32x4*)(a.in[0] + (size_t)m * D + c), x1 = *(const f32x4*)(a.in[0] + (size_t)m * D + c + 4);
#pragma unroll
            for (int e = 0; e < 4; ++e) { xv[8 * j + e] = x0[e]; xv[8 * j + 4 + e] = x1[e]; } }
        const float r = rsqrtf(wave_sum(s) * (1.f / D) + NORM_EPS);
        float s1 = 0.f;
        f16* x1r = x1_row(ws, m);
#pragma unroll
        for (int j = 0; j < 2; ++j) { const int c = 8 * lane + 512 * j;
            const f32x4 gm0 = *(const f32x4*)(md + 2048 + c), gm1 = *(const f32x4*)(md + 2048 + c + 4);
#pragma unroll
            for (int e = 0; e < 8; ++e) { const float gm = e < 4 ? gm0[e & 3] : gm1[e & 3]; const float x1 = xv[8 * j + e] + gm * (mx[8 * j + e] * r * g6[8 * j + e]); xv[8 * j + e] = x1; s1 += x1 * x1; }
            u32x4 w; w.x = pkh(xv[8 * j], xv[8 * j + 1]); w.y = pkh(xv[8 * j + 2], xv[8 * j + 3]); w.z = pkh(xv[8 * j + 4], xv[8 * j + 5]); w.w = pkh(xv[8 * j + 6], xv[8 * j + 7]);
            *(u32x4*)(x1r + c) = w; }
        const float r1 = rsqrtf(wave_sum(s1) * (1.f / D) + NORM_EPS);
#pragma unroll
        for (int j = 0; j < 2; ++j) { const int c = 8 * lane + 512 * j; float y[8];
            const f32x4 sc0 = *(const f32x4*)(md + 4096 + c), sc1 = *(const f32x4*)(md + 4096 + c + 4), sh0 = *(const f32x4*)(md + 3072 + c), sh1 = *(const f32x4*)(md + 3072 + c + 4);
#pragma unroll
            for (int e = 0; e < 8; ++e) { const float sc = e < 4 ? sc0[e & 3] : sc1[e & 3], sh = e < 4 ? sh0[e & 3] : sh1[e & 3]; y[e] = xv[8 * j + e] * r1 * g7[8 * j + e] * (1.f + sc) + sh; }
            u32x4 w; w.x = pkh(y[0], y[1]); w.y = pkh(y[2], y[3]); w.z = pkh(y[4], y[5]); w.w = pkh(y[6], y[7]);
            *(u32x4*)(HF + (size_t)m * D + c) = w; }
    }
}
__device__ __forceinline__ void p13_final(const Args& a, int vcu, int G, int wave, int lane) {
    unsigned char* ws = a.ws;
    const f16* F = (const f16*)(ws + WS_F); const float* mod = (const float*)(ws + WS_MOD);
    const int gw = vcu * NWAVES + wave, NGW = G * NWAVES;
    float g8[16];
#pragma unroll
    for (int j = 0; j < 2; ++j) { const int c = 8 * lane + 512 * j; const f32x4 p0 = *(const f32x4*)(a.in[8] + c), p1 = *(const f32x4*)(a.in[8] + c + 4);
#pragma unroll
        for (int e = 0; e < 4; ++e) { g8[8 * j + e] = p0[e]; g8[8 * j + 4 + e] = p1[e]; } }
    for (int m = gw; m < MTOK; m += NGW) {
        const int b = m >> 12; const float* md = mod + b * 6144;
        float fv[16]; float s = 0.f;
        f16x8 xh[2];
        const f16* x1r = x1_row(ws, m);
#pragma unroll
        for (int j = 0; j < 2; ++j) { const int c = 8 * lane + 512 * j; const f16x8 v = *(const f16x8*)(F + (size_t)m * D + c); xh[j] = *(const f16x8*)(x1r + c);
#pragma unroll
            for (int e = 0; e < 8; ++e) { fv[8 * j + e] = (float)v[e]; s += fv[8 * j + e] * fv[8 * j + e]; } }
        const float r = rsqrtf(wave_sum(s) * (1.f / D) + NORM_EPS);
#pragma unroll
        for (int j = 0; j < 2; ++j) { const int c = 8 * lane + 512 * j;
            const f32x4 gf0 = *(const f32x4*)(md + 5120 + c), gf1 = *(const f32x4*)(md + 5120 + c + 4);
            f32x4 o0, o1;
#pragma unroll
            for (int e = 0; e < 4; ++e) { o0[e] = (float)xh[j][e] + gf0[e] * (fv[8 * j + e] * r * g8[8 * j + e]); o1[e] = (float)xh[j][4 + e] + gf1[e] * (fv[8 * j + 4 + e] * r * g8[8 * j + 4 + e]); }
            *(f32x4*)(a.out + (size_t)m * D + c) = o0; *(f32x4*)(a.out + (size_t)m * D + c + 4) = o1; }
    }
}

constexpr int NPHASE = 14;
__global__ void __launch_bounds__(NWAVES * 64, 2) fwd(Args args) {
    extern __shared__ __attribute__((aligned(16))) unsigned char lds_raw[];
    LAS unsigned char* lds = (LAS unsigned char*)lds_raw;
    const int tid = threadIdx.x, lane = tid & 63, wave = __builtin_amdgcn_readfirstlane(tid >> 6);
    const int G = gridDim.x; const int bx = blockIdx.x; const int vcu = (G % 8 == 0) ? (bx % 8) * (G / 8) + bx / 8 : bx;
    volatile LAS unsigned* MISC = (volatile LAS unsigned*)(lds + MISC_OFF);
    if (tid < 16) MISC[tid] = 0u;
    __syncthreads();
    const int lo = args.ph_lo, hi = args.ph_hi;
    unsigned* barw = (unsigned*)(args.ws + WS_CTL) + CW_BAR;
    XcdBarrier bar; bar.bar = barw; bar.x = 0; bar.st = nullptr;
    if (hi - lo > 1) bar = xcd_barrier_post(barw, MISC);
#ifndef PHMASK
#define PHMASK 0x3FFF
#endif
#ifndef REPMASK
#define REPMASK 0
#endif
#define IN(k) (((PHMASK >> (k)) & 1) && lo <= (k) && (k) < hi)
#define REP(k) for (int rep_ = 0; rep_ < (((REPMASK >> (k)) & 1) ? 2 : 1); ++rep_)
#ifndef BARREP
#define BARREP 1
#endif
#define SEAM(k) do { if (IN(k) && IN((k) + 1)) for (int br_ = 0; br_ < BARREP; ++br_) xcd_barrier(bar); } while (0)
    unsigned char* ws = args.ws;
    if (IN(0)) REP(0) { if (rep_) __syncthreads(); p0_prologue(args, lds, vcu, G, wave, lane); } SEAM(0);
    if (IN(1)) REP(1) { if (rep_) __syncthreads(); p1_modnorm(args, vcu, G, wave, lane); } SEAM(1);
    if (IN(2)) REP(2) { if (rep_) __syncthreads(); pg8::Gemm g{(const f16*)(ws + WS_H), (const f16*)(ws + WS_WIN), MTOK, IN_PAD, D}; pg8::StaticOrder S; S.init(MTOK, IN_PAD, G, bx);
        pg8::EpiF16 E{(f16*)(ws + WS_PROJ), IN_PAD}; pg8::gemm_phase<pg8::EpiF16, pg8::StaticOrder, true, true>(lds, g, S, E); } SEAM(2);
#ifdef OLD_BASELINE
    if (IN(5)) REP(5) { if (rep_) __syncthreads(); p5_indexer(args, lds, vcu, G, wave, lane); } SEAM(5);
    if (IN(6)) REP(6) { if (rep_) __syncthreads(); p6_attention(args, lds, vcu, G, wave, lane); p3_rwkv_prep(args, lds, vcu, G, tid); } SEAM(6);
    if (IN(7)) REP(7) { if (rep_) __syncthreads(); p7_scan(args, lds, vcu, G, wave, lane); } SEAM(7);
    if (IN(8)) REP(8) { if (rep_) __syncthreads(); p8_rwkv_post(args, vcu, G, wave, lane); } SEAM(8);
#else
#define SEAMX() do { if (hi - lo > 1) for (int br_ = 0; br_ < BARREP; ++br_) xcd_barrier(bar); } while (0)
    if (IN(3)) REP(3) { if (rep_) __syncthreads(); p3_rows(args, vcu, G, wave, lane); }
    if (IN(6)) REP(6) { __syncthreads(); p7x_chunks(args, lds, vcu, G, tid, wave, lane); } SEAMX();
    if (IN(4)) REP(4) { if (rep_) __syncthreads(); pg8::Gemm g{(const f16*)(ws + WS_CQ), (const f16*)(ws + WS_WCQ), MTOK, NQI, QL}; pg8::StaticOrder S; S.init(MTOK, NQI, G, bx);
        pg8::EpiF16 E{(f16*)args.out, NQI}; pg8::gemm_phase<pg8::EpiF16, pg8::StaticOrder, true, true>(lds, g, S, E); }
    if (IN(7)) REP(7) { __syncthreads(); p7y_chain(args, bx, G, wave, lane); } SEAMX();
    if (IN(5)) REP(5) { if (rep_) __syncthreads(); p5_dsa(args, lds, G, bx, tid, wave, lane); }
    if (IN(8)) REP(8) { __syncthreads(); p8z_out(args, vcu, G, wave, lane); } SEAMX();
#endif
    if (IN(9)) REP(9) { if (rep_) __syncthreads(); pg8::Gemm g{(const f16*)(ws + WS_OATT), (const f16*)(ws + WS_WOUT), MTOK, D, KOUT}; pg8::StaticOrder S; S.init(MTOK, D, G, bx);
        pg8::EpiF16 E{(f16*)(ws + WS_MIX), D}; pg8::gemm_phase<pg8::EpiF16, pg8::StaticOrder, true, true>(lds, g, S, E); } SEAM(9);
    if (IN(10)) REP(10) { if (rep_) __syncthreads(); p10_mid(args, vcu, G, wave, lane); } SEAM(10);
    if (IN(11)) REP(11) { if (rep_) __syncthreads(); pg8::Gemm g{(const f16*)(ws + WS_H), (const f16*)(ws + WS_WGU), MTOK, 2 * DFF, D}; pg8::StaticOrder S; S.init(MTOK, 2 * DFF, G, bx);
        pg8::EpiSwiGLU E{(f16*)(ws + WS_ACT), DFF}; pg8::gemm_phase<pg8::EpiSwiGLU, pg8::StaticOrder, true, true>(lds, g, S, E); } SEAM(11);
    if (IN(12)) REP(12) { if (rep_) __syncthreads(); pg8::Gemm g{(const f16*)(ws + WS_ACT), (const f16*)(ws + WS_WDN), MTOK, D, DFF}; pg8::StaticOrder S; S.init(MTOK, D, G, bx);
        pg8::EpiF16 E{(f16*)(ws + WS_F), D}; pg8::gemm_phase<pg8::EpiF16, pg8::StaticOrder, true, true>(lds, g, S, E); } SEAM(12);
    if (IN(13)) REP(13) { if (rep_) __syncthreads(); p13_final(args, vcu, G, wave, lane); }
#undef IN
#undef SEAM
}

#ifndef N_LAUNCH_MODE
#define N_LAUNCH_MODE 1
#endif
extern "C" void kernel_launch(void* const* d_in, const int* in_sizes, int n_in, void* d_out, int out_size, void* d_ws, size_t ws_size, hipStream_t stream) {
    static int grid = 0;
    if (grid == 0) {
        int dev = 0, cus = 0, per_cu = 0;
        if (n_in != 32 || ws_size < WS_END) { fprintf(stderr, "kernel_launch: unexpected n_in %d or ws_size %zu (< %zu)\n", n_in, ws_size, (size_t)WS_END); }
        if (hipGetDevice(&dev) != hipSuccess || hipDeviceGetAttribute(&cus, hipDeviceAttributeMultiprocessorCount, dev) != hipSuccess) { grid = -1; return; }
        if (hipFuncSetAttribute((const void*)fwd, hipFuncAttributeMaxDynamicSharedMemorySize, LDS_BYTES) != hipSuccess) { fprintf(stderr, "kernel_launch: hipFuncSetAttribute failed\n"); grid = -1; return; }
        if (hipOccupancyMaxActiveBlocksPerMultiprocessor(&per_cu, (const void*)fwd, NWAVES * 64, LDS_BYTES) != hipSuccess || per_cu < 1) fprintf(stderr, "kernel_launch: occupancy query says %d\n", per_cu);
        (void)hipGetLastError();
        grid = cus;
    }
    if (grid < 0) return;
    (void)hipMemsetAsync((char*)d_ws + WS_CTL, 0, CTL_ZERO_BYTES, stream);
    Args a{};
    for (int i = 0; i < 32; ++i) a.in[i] = (const float*)d_in[i];
    a.out = (float*)d_out; a.ws = (unsigned char*)d_ws;
    if (N_LAUNCH_MODE == 1) { a.ph_lo = 0; a.ph_hi = NPHASE; hipLaunchKernelGGL(fwd, dim3(grid), dim3(NWAVES * 64), LDS_BYTES, stream, a); }
    else for (int p = 0; p < NPHASE; ++p) { a.ph_lo = p; a.ph_hi = p + 1; hipLaunchKernelGGL(fwd, dim3(grid), dim3(NWAVES * 64), LDS_BYTES, stream, a); }
}
```

```cpp
#include <hip/hip_runtime.h>
#include <cstdio>
#include <cstdint>

#define LAS __attribute__((address_space(3)))
#define GAS __attribute__((address_space(1)))
typedef _Float16 f16;
typedef _Float16 f16x8 __attribute__((ext_vector_type(8)));
typedef _Float16 f16x4 __attribute__((ext_vector_type(4)));
typedef _Float16 f16x2 __attribute__((ext_vector_type(2)));
typedef float f32x4 __attribute__((ext_vector_type(4)));
typedef float f32x2 __attribute__((ext_vector_type(2)));
typedef unsigned u32x4 __attribute__((ext_vector_type(4)));
typedef unsigned u32x2 __attribute__((ext_vector_type(2)));

__device__ __forceinline__ unsigned pkh(float a, float b) { f16x2 v = {(f16)a, (f16)b}; return __builtin_bit_cast(unsigned, v); }
__device__ __forceinline__ float h2f(f16 h) { return (float)h; }

namespace pg8 {
constexpr int BM = 256, BK = 64, HALF = 128, HTB = HALF * BK * 2, STAGE_BYTES = 8 * HTB, NXCD = 8, WGM = 8;
__host__ __device__ __forceinline__ int lds_byte(int r, int c) { const int st = (r >> 4) * 2 + (c >> 5), rr = r & 15, cc = c & 31, ob = rr * 64 + cc * 2; return st * 1024 + (ob ^ (((ob >> 9) & 1) << 5)); }
__host__ __device__ __forceinline__ void stage_rc(int b, int& R, int& C) { const int st = b / 1024, sb = b % 1024, swz = sb ^ (((sb >> 9) & 1) << 5); R = (st >> 1) * 16 + swz / 64; C = (st & 1) * 32 + (swz % 64) / 2; }
__host__ __device__ __forceinline__ int perm32(int rho) { const int n = rho >> 4, i = rho & 15; return 8 * (i >> 2) + 4 * n + (i & 3); }

struct Unit { int pm, pn; };
struct Gemm { const f16* A; const f16* Bt; int M, N, K; };

struct StaticOrder {
    int nM, nN, nwg, G, c;
    __host__ __device__ void init(int M, int N, int G_, int c_) { nM = M / BM; nN = N / BM; nwg = nM * nN; G = G_; c = c_; }
    __host__ __device__ bool next(int i, Unit& u) const {
        const long L = (long)i * G + c; if (L >= nwg) return false;
        int wgid = (int)L; { const int q = nwg / NXCD, r = nwg % NXCD, xcd = wgid % NXCD, off = wgid / NXCD; wgid = (xcd < r ? xcd * (q + 1) : r * (q + 1) + (xcd - r) * q) + off; }
        const int nig = WGM * nN, gid = wgid / nig, fm = gid * WGM, gsz = (nM - fm) < WGM ? (nM - fm) : WGM;
        u.pm = fm + ((wgid % nig) % gsz); u.pn = (wgid % nig) / gsz; return true;
    }
    __device__ __forceinline__ void a_ready(const Unit&) const {}
    __device__ __forceinline__ void done(const Unit&) const {}
};

struct EpiF16 {
    static constexpr bool PERM = true, AFTER_DRAIN = false;
    f16* O; int ldc;
    __device__ __forceinline__ void operator()(const f32x4 (&acc)[2][2][4][2], const Unit& u, int wr, int wc, int fr, int fq) const {
        const int row0 = u.pm * BM + wr * 64 + fr; const int col0 = u.pn * BM + wc * 32 + 8 * fq;
#pragma unroll
        for (int ai = 0; ai < 2; ++ai)
#pragma unroll
            for (int m = 0; m < 4; ++m) { f16* rowp = O + (size_t)(row0 + ai * HALF + m * 16) * ldc + col0;
#pragma unroll
                for (int bj = 0; bj < 2; ++bj) { const f32x4 v0 = acc[ai][bj][m][0], v1 = acc[ai][bj][m][1];
                    u32x4 w; w.x = pkh(v0[0], v0[1]); w.y = pkh(v0[2], v0[3]); w.z = pkh(v1[0], v1[1]); w.w = pkh(v1[2], v1[3]);
                    *(u32x4*)(rowp + bj * HALF) = w; } }
    }
};
struct EpiSwiGLU {
    static constexpr bool PERM = true, AFTER_DRAIN = false;
    f16* O; int ldc;
    __device__ __forceinline__ void operator()(const f32x4 (&acc)[2][2][4][2], const Unit& u, int wr, int wc, int fr, int fq) const {
        const int row0 = u.pm * BM + wr * 64 + fr; const int col0 = u.pn * HALF + wc * 32 + 8 * fq;
#pragma unroll
        for (int ai = 0; ai < 2; ++ai)
#pragma unroll
            for (int m = 0; m < 4; ++m) { f16* rowp = O + (size_t)(row0 + ai * HALF + m * 16) * ldc + col0;
                float o[8];
#pragma unroll
                for (int n = 0; n < 2; ++n)
#pragma unroll
                    for (int j = 0; j < 4; ++j) { const float g = acc[ai][0][m][n][j], up = acc[ai][1][m][n][j]; o[n * 4 + j] = g * __builtin_amdgcn_rcpf(1.0f + __expf(-g)) * up; }
                u32x4 w; w.x = pkh(o[0], o[1]); w.y = pkh(o[2], o[3]); w.z = pkh(o[4], o[5]); w.w = pkh(o[6], o[7]);
                *(u32x4*)rowp = w; }
    }
};

template <class Epi, class Sched, bool ALIGN_EPI = false, bool SP2 = false>
__device__ __forceinline__ void gemm_phase(LAS unsigned char* lds, const Gemm g, const Sched& S, const Epi& E) {
    const int tid = threadIdx.x, wid = __builtin_amdgcn_readfirstlane(tid >> 6), lane = tid & 63, wr = wid >> 2, wc = wid & 3, fr = lane & 15, fq = lane >> 4;
    const int K = g.K, nt = K / BK;
    unsigned voffA[2], voffB[2];
#pragma unroll
    for (int i = 0; i < 2; ++i) { int R, C; stage_rc(tid * 16 + i * 8192, R, C); const int Rb = Epi::PERM ? ((R & ~31) + perm32(R & 31)) : R;
        voffA[i] = (unsigned)(R * K + C) * 2u; voffB[i] = (unsigned)(Rb * K + C) * 2u; }
    const size_t kstep = (size_t)(BK * 2);
    const size_t hstep = (size_t)HALF * K * 2;
    const size_t tstep = 2 * hstep;
    const unsigned ldsw = (unsigned)wid * 1024u;
    const int aoff = lds_byte(wr * 64 + fr, fq * 8), boff = lds_byte(wc * 32 + fr, fq * 8);
#define PG8_SA(b, h) (((b) * 2 + (h)) * HTB)
#define PG8_SB(b, h) ((4 + (b) * 2 + (h)) * HTB)
#define PG8_STAGE(bufoff, gbase, voff) do { _Pragma("unroll") for (int _i = 0; _i < 2; ++_i) \
        __builtin_amdgcn_global_load_lds((const unsigned*)((const char*)(gbase) + (voff)[_i]), (LAS unsigned*)(lds + (bufoff) + ldsw + _i * 8192), 16, 0, 0); } while (0)
#define PG8_LDA(dst, b, h) do { _Pragma("unroll") for (int m = 0; m < 4; ++m) _Pragma("unroll") for (int k = 0; k < 2; ++k) dst[m][k] = *(const LAS f16x8*)(lds + PG8_SA(b, h) + aoff + m * 2048 + k * 1024); } while (0)
#define PG8_LDB(dst, b, h) do { _Pragma("unroll") for (int n = 0; n < 2; ++n) _Pragma("unroll") for (int k = 0; k < 2; ++k) dst[n][k] = *(const LAS f16x8*)(lds + PG8_SB(b, h) + boff + n * 2048 + k * 1024); } while (0)
#define PG8_MMA(ai, bj, At, Bt) do { __builtin_amdgcn_s_setprio(1); _Pragma("unroll") for (int m = 0; m < 4; ++m) _Pragma("unroll") for (int n = 0; n < 2; ++n) _Pragma("unroll") for (int k = 0; k < 2; ++k) \
        acc[ai][bj][m][n] = __builtin_amdgcn_mfma_f32_16x16x32_f16(Bt[n][k], At[m][k], acc[ai][bj][m][n], 0, 0, 0); __builtin_amdgcn_s_setprio(0); } while (0)
#define PG8_WAIT_V(n) asm volatile("s_waitcnt vmcnt(" #n ")" ::: "memory")
#define PG8_WAIT_L(n) asm volatile("s_waitcnt lgkmcnt(" #n ")" ::: "memory")
#define PG8_BAR __builtin_amdgcn_s_barrier()
#define PG8_SCHED __builtin_amdgcn_sched_barrier(0)
    Unit cur, nxt; int ui = 0;
    if (!S.next(0, cur)) return;
    f32x4 acc[2][2][4][2];
#pragma unroll
    for (int a = 0; a < 2; ++a)
#pragma unroll
        for (int b = 0; b < 2; ++b)
#pragma unroll
            for (int m = 0; m < 4; ++m)
#pragma unroll
                for (int n = 0; n < 2; ++n) acc[a][b][m][n] = (f32x4){0.f, 0.f, 0.f, 0.f};
    f16x8 At[4][2], B0[2][2], B1[2][2];
    const char* cA = (const char*)g.A + (size_t)cur.pm * tstep; const char* cB = (const char*)g.Bt + (size_t)cur.pn * tstep;
    S.a_ready(cur);
    if constexpr (SP2) {
        PG8_STAGE(PG8_SB(0, 0), cB, voffB); PG8_STAGE(PG8_SB(0, 1), cB + hstep, voffB); PG8_STAGE(PG8_SA(0, 0), cA, voffA); PG8_STAGE(PG8_SA(0, 1), cA + hstep, voffA);
        if (wr == 1) PG8_BAR;
        PG8_WAIT_V(2); PG8_BAR;
        PG8_STAGE(PG8_SB(1, 0), cB + kstep, voffB); PG8_STAGE(PG8_SA(1, 0), cA + kstep, voffA); PG8_STAGE(PG8_SB(1, 1), cB + hstep + kstep, voffB);
        PG8_WAIT_V(6); PG8_BAR;
    } else {
        PG8_STAGE(PG8_SB(0, 0), cB, voffB); PG8_STAGE(PG8_SA(0, 0), cA, voffA); PG8_STAGE(PG8_SB(0, 1), cB + hstep, voffB); PG8_STAGE(PG8_SA(0, 1), cA + hstep, voffA);
        if (wr == 1) PG8_BAR;
        PG8_WAIT_V(4); PG8_BAR;
        PG8_STAGE(PG8_SB(1, 0), cB + kstep, voffB); PG8_STAGE(PG8_SA(1, 0), cA + kstep, voffA); PG8_STAGE(PG8_SB(1, 1), cB + hstep + kstep, voffB);
        PG8_WAIT_V(6); PG8_BAR;
    }
    for (;;) {
        const bool has_next = S.next(ui + 1, nxt);
        const char* nA = has_next ? (const char*)g.A + (size_t)nxt.pm * tstep : cA; const char* nB = has_next ? (const char*)g.Bt + (size_t)nxt.pn * tstep : cB;
        for (int t = 0; t < nt; t += 2) {
            const bool last = (t == nt - 2);
            const char* a1 = cA + (size_t)(t + 1) * kstep;
            const char* a2 = last ? nA : cA + (size_t)(t + 2) * kstep; const char* b2 = last ? nB : cB + (size_t)(t + 2) * kstep;
            const char* a3 = a2 + kstep; const char* b3 = b2 + kstep;
            if (last && has_next) S.a_ready(nxt);
            if constexpr (SP2) {
            PG8_LDB(B0, 0, 0); PG8_LDB(B1, 0, 1); PG8_SCHED; PG8_LDA(At, 0, 0); PG8_STAGE(PG8_SA(1, 1), a1 + hstep, voffA);
            PG8_WAIT_V(8); PG8_WAIT_L(0); PG8_BAR; PG8_MMA(0, 0, At, B0); PG8_MMA(0, 1, At, B1); PG8_BAR; PG8_SCHED;
            PG8_LDA(At, 0, 1); PG8_STAGE(PG8_SB(0, 0), b2, voffB); PG8_STAGE(PG8_SB(0, 1), b2 + hstep, voffB); PG8_STAGE(PG8_SA(0, 0), a2, voffA);
            PG8_WAIT_V(8); PG8_WAIT_L(0); PG8_BAR; PG8_MMA(1, 0, At, B0); PG8_MMA(1, 1, At, B1); PG8_BAR; PG8_SCHED;
            PG8_LDB(B0, 1, 0); PG8_LDB(B1, 1, 1); PG8_SCHED; PG8_LDA(At, 1, 0); PG8_STAGE(PG8_SA(0, 1), a2 + hstep, voffA);
            PG8_WAIT_V(8); PG8_WAIT_L(0); PG8_BAR; PG8_MMA(0, 0, At, B0); PG8_MMA(0, 1, At, B1); PG8_BAR; PG8_SCHED;
            PG8_LDA(At, 1, 1); PG8_STAGE(PG8_SB(1, 0), b3, voffB); PG8_STAGE(PG8_SB(1, 1), b3 + hstep, voffB); PG8_STAGE(PG8_SA(1, 0), a3, voffA);
            PG8_WAIT_V(8); PG8_WAIT_L(0); PG8_BAR; PG8_MMA(1, 0, At, B0); PG8_MMA(1, 1, At, B1); PG8_BAR; PG8_SCHED;
            } else {
            PG8_LDB(B0, 0, 0); PG8_SCHED; PG8_LDA(At, 0, 0); PG8_STAGE(PG8_SA(1, 1), a1 + hstep, voffA);
            PG8_WAIT_L(8); PG8_BAR; PG8_WAIT_L(0); PG8_MMA(0, 0, At, B0); PG8_BAR; PG8_SCHED;
            PG8_LDB(B1, 0, 1); PG8_STAGE(PG8_SB(0, 0), b2, voffB);
            PG8_BAR; PG8_WAIT_L(0); PG8_MMA(0, 1, At, B1); PG8_BAR;
            PG8_LDA(At, 0, 1); PG8_STAGE(PG8_SA(0, 0), a2, voffA);
            PG8_BAR; PG8_WAIT_L(0); PG8_MMA(1, 0, At, B0); PG8_BAR; PG8_SCHED;
            PG8_STAGE(PG8_SB(0, 1), b2 + hstep, voffB);
            PG8_WAIT_V(6); PG8_BAR; PG8_MMA(1, 1, At, B1); PG8_BAR;
            PG8_LDB(B0, 1, 0); PG8_SCHED; PG8_LDA(At, 1, 0); PG8_STAGE(PG8_SA(0, 1), a2 + hstep, voffA);
            PG8_WAIT_L(8); PG8_BAR; PG8_WAIT_L(0); PG8_MMA(0, 0, At, B0); PG8_BAR; PG8_SCHED;
            PG8_LDB(B1, 1, 1); PG8_STAGE(PG8_SB(1, 0), b3, voffB);
            PG8_BAR; PG8_WAIT_L(0); PG8_MMA(0, 1, At, B1); PG8_BAR;
            PG8_LDA(At, 1, 1); PG8_STAGE(PG8_SA(1, 0), a3, voffA);
            PG8_BAR; PG8_WAIT_L(0); PG8_MMA(1, 0, At, B0); PG8_BAR; PG8_SCHED;
            PG8_STAGE(PG8_SB(1, 1), b3 + hstep, voffB);
            PG8_WAIT_V(6); PG8_BAR; PG8_MMA(1, 1, At, B1); PG8_BAR;
            }
        }
        if constexpr (ALIGN_EPI) { if (wr == 0) PG8_BAR; }
        if constexpr (!Epi::AFTER_DRAIN) { E(acc, cur, wr, wc, fr, fq); S.done(cur); }
        if (!has_next) break;
#pragma unroll
        for (int a = 0; a < 2; ++a)
#pragma unroll
            for (int b = 0; b < 2; ++b)
#pragma unroll
                for (int m = 0; m < 4; ++m)
#pragma unroll
                    for (int n = 0; n < 2; ++n) acc[a][b][m][n] = (f32x4){0.f, 0.f, 0.f, 0.f};
        cur = nxt; cA = nA; cB = nB; ++ui;
        if constexpr (ALIGN_EPI) { if (wr == 1) PG8_BAR; }
    }
    PG8_WAIT_V(0);
    if constexpr (!ALIGN_EPI) { if (wr == 0) PG8_BAR; }
    PG8_BAR;
#undef PG8_SA
#undef PG8_SB
#undef PG8_STAGE
#undef PG8_LDA
#undef PG8_LDB
#undef PG8_MMA
#undef PG8_WAIT_V
#undef PG8_WAIT_L
#undef PG8_BAR
#undef PG8_SCHED
}
}

#define XB_TMO      128
#define XB_XCNT(j)  (256  + 64 * (j))
#define XB_XSUB(j)  (1280 + 64 * (j))
#define XB_XGEN(j)  (2304 + 64 * (j))
#define XB_TOP      3328
#define XB_TOPGEN   3392
#define XCD_BAR_WORDS 3456
#define XB_SPIN_CAP (1u << 18)
__device__ __forceinline__ unsigned xb_ld(unsigned* p)              { return __hip_atomic_load(p, __ATOMIC_RELAXED, __HIP_MEMORY_SCOPE_AGENT); }
__device__ __forceinline__ unsigned xb_add(unsigned* p, unsigned v) { return __hip_atomic_fetch_add(p, v, __ATOMIC_RELAXED, __HIP_MEMORY_SCOPE_AGENT); }
__device__ __forceinline__ unsigned xb_xcc_id() { return (unsigned)__builtin_amdgcn_s_getreg((3 << 11) | 20) & 0xFu; }
#define XB_SPIN(cond, bar) do { unsigned _sp = 0; while (cond) { __builtin_amdgcn_s_sleep(1); \
    if ((++_sp & 255u) == 0u) { if (xb_ld(&(bar)[XB_TMO])) break; if (_sp > XB_SPIN_CAP) { atomicAdd(&(bar)[XB_TMO], 1u); break; } } } } while (0)
struct XcdBarrier { unsigned* bar; unsigned x; volatile LAS unsigned* st; };
__device__ __forceinline__ XcdBarrier xcd_barrier_post(unsigned* bar, volatile LAS unsigned* st) {
    XcdBarrier b; b.bar = bar; b.x = xb_xcc_id(); b.st = st;
    if (threadIdx.x == 0) (void)xb_add(&bar[XB_XCNT(b.x)], 1u);
    return b;
}
__device__ __forceinline__ void xcd_barrier_complete(unsigned* bar, unsigned x, unsigned& nloc, unsigned& nx) {
    const unsigned G = gridDim.x * gridDim.y * gridDim.z;
    unsigned sum, cnt, mine, sp = 0u;
    for (;;) {
        sum = 0u; cnt = 0u; mine = 0u;
#pragma unroll
        for (unsigned j = 0; j < 16; ++j) { const unsigned c = xb_ld(&bar[XB_XCNT(j)]); sum += c; cnt += (c > 0u) ? 1u : 0u; mine = (j == x) ? c : mine; }
        if (sum == G) break;
        __builtin_amdgcn_s_sleep(1);
        if ((++sp & 255u) == 0u) { if (xb_ld(&bar[XB_TMO])) break; if (sp > XB_SPIN_CAP) { atomicAdd(&bar[XB_TMO], 1u); break; } }
    }
    nloc = mine > 0u ? mine : 1u; nx = cnt > 0u ? cnt : 1u;
}
__device__ __forceinline__ void xcd_barrier(const XcdBarrier& b) {
    asm volatile("s_waitcnt vmcnt(0)" ::: "memory");
    __syncthreads();
    if (threadIdx.x == 0) {
        unsigned* bar = b.bar;
        __builtin_amdgcn_s_waitcnt(0);
        unsigned nloc = b.st[0], nx = b.st[1];
        if (nloc == 0u) { xcd_barrier_complete(bar, b.x, nloc, nx); b.st[0] = nloc; b.st[1] = nx; }
        const unsigned old = xb_add(&bar[XB_XSUB(b.x)], 1u);
        const unsigned gen = old / nloc;
        if (old + 1u == (gen + 1u) * nloc) {
            __builtin_amdgcn_fence(__ATOMIC_RELEASE, "agent");
            asm volatile("s_waitcnt vmcnt(0)" ::: "memory");
            const unsigned og = xb_add(&bar[XB_TOP], 1u);
            const unsigned tg = og / nx;
            if (og + 1u == (tg + 1u) * nx) xb_add(&bar[XB_TOPGEN], 1u);
            else XB_SPIN(xb_ld(&bar[XB_TOPGEN]) == tg, bar);
            __builtin_amdgcn_fence(__ATOMIC_ACQUIRE, "agent");
            xb_add(&bar[XB_XGEN(b.x)], 1u);
            asm volatile("s_waitcnt vmcnt(0)" ::: "memory");
        } else {
            XB_SPIN(xb_ld(&bar[XB_XGEN(b.x)]) == gen, bar);
            __builtin_amdgcn_fence(__ATOMIC_ACQUIRE, "agent");
            asm volatile("s_waitcnt vmcnt(0)" ::: "memory");
        }
    }
    __syncthreads();
}

constexpr int BATCH = 8, SEQ = 4096, D = 1024, MTOK = BATCH * SEQ;
constexpr int QL = 256, KVL = 128, IDXD = 64, IDXH = 8, HATT = 8, TOPK = 256;
constexpr int RW = 512, HRW = 8, NRW = 64;
constexpr int IN_COLS = 2280, IN_PAD = 2304;
constexpr int C_CQ = 0, C_CKV = 256, C_IK = 384, C_IW = 448, C_R = 456, C_K = 968, C_V = 1480, C_WD = 1992, C_AD = 2056, C_GD = 2120;
constexpr int DFF = 2816;
constexpr int NQI = 1536;
constexpr int KOUT = 1536;
constexpr float NORM_EPS = 1e-6f, GN_EPS = 64e-5f;

constexpr size_t MiB = 1u << 20;
constexpr size_t WS_CTL = 0, CTL_ZERO_BYTES = 64 * 1024;
constexpr size_t WS_MOD = 1 * MiB;
constexpr size_t WS_WIN = 2 * MiB;
constexpr size_t WS_WCQ = 7 * MiB;
constexpr size_t WS_WOUT = 8 * MiB;
constexpr size_t WS_WGU = 11 * MiB;
constexpr size_t WS_WDN = 22 * MiB;
constexpr size_t WS_H = 32 * MiB;
constexpr size_t WS_RWW = 32 * MiB, WS_RWA = 64 * MiB;
constexpr size_t WS_PROJ = 96 * MiB;
constexpr size_t WS_CQ = 240 * MiB;
constexpr size_t WS_SEL = 240 * MiB;
constexpr size_t WS_OATT = 256 * MiB;
constexpr size_t WS_CKV = 352 * MiB;
constexpr size_t WS_IK16 = 360 * MiB;
constexpr size_t WS_IK32 = 364 * MiB;
constexpr size_t WS_IW = 372 * MiB;
constexpr size_t WS_RWG = 376 * MiB;
constexpr size_t WS_YRAW = 408 * MiB;
constexpr size_t WS_MIX = 408 * MiB;
constexpr size_t WS_ACT = 96 * MiB;
constexpr size_t WS_F = 288 * MiB;
constexpr size_t WS_CKV8 = 368 * MiB;
constexpr size_t WS_END = 504 * MiB;

constexpr int CW_BAR = 1024;
constexpr int NWAVES = 8;
constexpr int RING_BYTES = 131072, AUX_OFF = RING_BYTES  , MISC_OFF = 155648, LDS_BYTES = 155904;

struct Args { const float* in[32]; float* out; unsigned char* ws; int ph_lo, ph_hi; };

__device__ __forceinline__ float wave_sum(float v) {
#pragma unroll
    for (int o = 1; o < 64; o <<= 1) v += __shfl_xor(v, o);
    return v;
}
__device__ __forceinline__ void lds_barrier() { asm volatile("s_waitcnt lgkmcnt(0)\n\ts_barrier" ::: "memory"); }
__device__ __forceinline__ float sigmoidf_(float x) { return __builtin_amdgcn_rcpf(1.0f + __expf(-x)); }

__device__ __forceinline__ void p0_transpose_item(const float* W, int K, int N, int Npad, f16* WT, int ldk, int koff, int row_off, int mode, LAS float* scr, int item, int lane) {
    const int nblk = Npad / 32, kb = item / nblk, nb = item % nblk, k0 = 64 * kb, n0 = 32 * nb;
    const int rr = lane >> 3, c4 = 4 * (lane & 7);
    f32x4 v[8];
#pragma unroll
    for (int i = 0; i < 8; ++i) { const int kk = 8 * i + rr; v[i] = (n0 + c4 < N && k0 + kk < K) ? *(const f32x4*)(W + (size_t)(k0 + kk) * N + n0 + c4) : (f32x4){0.f, 0.f, 0.f, 0.f}; }
#pragma unroll
    for (int i = 0; i < 8; ++i) { const int kk = 8 * i + rr; LAS float* d = scr + kk * 33 + c4; d[0] = v[i][0]; d[1] = v[i][1]; d[2] = v[i][2]; d[3] = v[i][3]; }
    asm volatile("s_waitcnt lgkmcnt(0)" ::: "memory");
    const int c = lane & 7;
#pragma unroll
    for (int j = 0; j < 4; ++j) { const int nl = (lane >> 3) + 8 * j; const LAS float* s = scr + (8 * c) * 33 + nl;
        u32x4 o; o.x = pkh(s[0 * 33], s[1 * 33]); o.y = pkh(s[2 * 33], s[3 * 33]); o.z = pkh(s[4 * 33], s[5 * 33]); o.w = pkh(s[6 * 33], s[7 * 33]);
        const int n = n0 + nl; int row;
        if (mode == 0) row = row_off + n; else row = (n >> 7) * 256 + (mode == 2 ? 128 : 0) + (n & 127);
        *(u32x4*)(WT + (size_t)row * ldk + koff + k0 + 8 * c) = o; }
    asm volatile("s_waitcnt lgkmcnt(0)" ::: "memory");
}

__device__ __forceinline__ void p0_prologue(const Args& a, LAS unsigned char* lds, int vcu, int G, int wave, int lane) {
    unsigned char* ws = a.ws;
    LAS float* scr = (LAS float*)(lds + wave * 16384);
    const int gw = vcu * NWAVES + wave, NGW = G * NWAVES;
    f16* Win = (f16*)(ws + WS_WIN); f16* Wcq = (f16*)(ws + WS_WCQ); f16* Wout = (f16*)(ws + WS_WOUT); f16* Wgu = (f16*)(ws + WS_WGU); f16* Wdn = (f16*)(ws + WS_WDN);
    constexpr int I_IN = (D / 64) * (IN_PAD / 32), I_IDX = (QL / 64) * (512 / 32), I_OR = (512 / 64) * (D / 32), I_G = (D / 64) * (DFF / 32), I_D = (DFF / 64) * (D / 32);
    constexpr int I_FQ = 4 * 64, I_FO = 16 * 64, I_MOD = 8 * 96, I_LD = 16, I_LG = 48;
    constexpr int NITEMS = I_IN + I_IDX + I_OR + 2 * I_G + I_D + I_FQ + I_FO + 2 * I_LD + I_LG;
    const bool split = (G == 256);
    const int gw2 = split ? (vcu - 96) * NWAVES + wave : gw, NGW2 = split ? (G - 96) * NWAVES : NGW;
    for (int it = gw2; it < NITEMS && gw2 >= 0; it += NGW2) {
        int r = it;
        if (r < I_IN) { p0_transpose_item(a.in[9], D, IN_COLS, IN_PAD, Win, D, 0, 0, 0, scr, r, lane); continue; } r -= I_IN;
        if (r < I_IDX) { p0_transpose_item(a.in[12], QL, 512, 512, Wcq, QL, 0, 1024, 0, scr, r, lane); continue; } r -= I_IDX;
        if (r < I_OR) { p0_transpose_item(a.in[28] + (size_t)512 * D, 512, D, D, Wout, KOUT, 1024, 0, 0, scr, r, lane); continue; } r -= I_OR;
        if (r < I_G) { p0_transpose_item(a.in[29], D, DFF, DFF, Wgu, D, 0, 0, 1, scr, r, lane); continue; } r -= I_G;
        if (r < I_G) { p0_transpose_item(a.in[30], D, DFF, DFF, Wgu, D, 0, 0, 2, scr, r, lane); continue; } r -= I_G;
        if (r < I_D) { p0_transpose_item(a.in[31], DFF, D, D, Wdn, DFF, 0, 0, 0, scr, r, lane); continue; } r -= I_D;
        if (r < I_FQ) {
            const int rb = r & 3, nb = r >> 2, rr = rb * 64 + lane, n0 = nb * 16, h = n0 >> 7;
            const float* uq = a.in[11] + (size_t)rr * 512 + h * 64; const float* uk = a.in[15] + (size_t)n0 * 64;
            float q[64];
#pragma unroll
            for (int d4 = 0; d4 < 16; ++d4) { const f32x4 v = *(const f32x4*)(uq + 4 * d4); q[4 * d4] = v[0]; q[4 * d4 + 1] = v[1]; q[4 * d4 + 2] = v[2]; q[4 * d4 + 3] = v[3]; }
#pragma unroll 4
            for (int i = 0; i < 16; ++i) { float s = 0.f;
#pragma unroll
                for (int d = 0; d < 64; ++d) s += q[d] * uk[i * 64 + d];
                Wcq[(size_t)(n0 + i) * QL + rr] = (f16)(0.125f * s); }
            continue; } r -= I_FQ;
        if (r < I_FO) {
            const int kb = r & 15, nb = r >> 4, k = kb * 64 + lane, h = kb >> 1, n0 = nb * 16;
            const float* uvp = a.in[16] + (size_t)k * 64; const float* wo = a.in[28] + (size_t)(h * 64) * D + n0;
            float uv[64];
#pragma unroll
            for (int d4 = 0; d4 < 16; ++d4) { const f32x4 v = *(const f32x4*)(uvp + 4 * d4); uv[4 * d4] = v[0]; uv[4 * d4 + 1] = v[1]; uv[4 * d4 + 2] = v[2]; uv[4 * d4 + 3] = v[3]; }
            float acc[16];
#pragma unroll
            for (int i = 0; i < 16; ++i) acc[i] = 0.f;
#pragma unroll
            for (int d = 0; d < 64; ++d) {
#pragma unroll
                for (int i = 0; i < 16; ++i) acc[i] += uv[d] * wo[(size_t)d * D + i]; }
#pragma unroll
            for (int i = 0; i < 16; ++i) Wout[(size_t)(n0 + i) * KOUT + k] = (f16)acc[i];
            continue; } r -= I_FO;
        if (r < I_LD) { p0_transpose_item(a.in[19], 64, 512, 512, (f16*)(ws + (28u << 20)), 64, 0, 0, 0, scr, r, lane); continue; } r -= I_LD;
        if (r < I_LD) { p0_transpose_item(a.in[21], 64, 512, 512, (f16*)(ws + (28u << 20) + 65536), 64, 0, 0, 0, scr, r, lane); continue; } r -= I_LD;
        { p0_transpose_item(a.in[22], 160, 512, 512, (f16*)(ws + (28u << 20) + 131072), 192, 0, 0, 0, scr, r, lane); }
    }
    if (vcu < 96) {
        __syncthreads();
        const int tid = wave * 64 + lane;
        for (int e = tid; e < 8 * D; e += 512) { const float cc = a.in[1][e]; *(LAS float*)(lds + (e >> 10) * 16384 + 10496 + (e & 1023) * 4) = cc * sigmoidf_(cc); }
        for (int cb = vcu; cb < 96; cb += G) {
            __syncthreads();
            const int j = cb * 64 + lane; const float* aw = a.in[3] + j;
            float acc[8];
#pragma unroll
            for (int b = 0; b < 8; ++b) acc[b] = 0.f;
            const int kbeg = wave * 128;
#pragma unroll 1
            for (int k0 = 0; k0 < 128; k0 += 16) {
                float wv[16];
#pragma unroll
                for (int i = 0; i < 16; ++i) wv[i] = aw[(size_t)(kbeg + k0 + i) * 6144];
#pragma unroll
                for (int b = 0; b < 8; ++b) {
#pragma unroll
                    for (int i4 = 0; i4 < 4; ++i4) { const f32x4 sv = *(const LAS f32x4*)(lds + b * 16384 + 10496 + (kbeg + k0 + 4 * i4) * 4);
                        acc[b] += sv[0] * wv[4 * i4] + sv[1] * wv[4 * i4 + 1] + sv[2] * wv[4 * i4 + 2] + sv[3] * wv[4 * i4 + 3]; } }
            }
#pragma unroll
            for (int b = 0; b < 8; ++b) *(LAS float*)(lds + wave * 16384 + 8448 + (b * 64 + lane) * 4) = acc[b];
            __syncthreads();
            float sum = 0.f;
#pragma unroll
            for (int w = 0; w < 8; ++w) sum += *(const LAS float*)(lds + w * 16384 + 8448 + (wave * 64 + lane) * 4);
            ((float*)(ws + WS_MOD))[wave * 6144 + j] = sum + a.in[4][j];
        }
    }
}

__device__ __forceinline__ void p1_modnorm(const Args& a, int vcu, int G, int wave, int lane) {
    const int gw = vcu * NWAVES + wave, NGW = G * NWAVES;
    const float* mod = (const float*)(a.ws + WS_MOD); f16* H = (f16*)(a.ws + WS_H);
    for (int m = gw; m < MTOK; m += NGW) {
        const int b = m >> 12;
        const f32x4* xr = (const f32x4*)(a.in[0] + (size_t)m * D) + lane;
        f32x4 v[4]; float s = 0.f;
#pragma unroll
        for (int j = 0; j < 4; ++j) { v[j] = xr[64 * j]; s += (v[j][0] * v[j][0] + v[j][1] * v[j][1]) + (v[j][2] * v[j][2] + v[j][3] * v[j][3]); }
        const float r = rsqrtf(wave_sum(s) * (1.f / D) + NORM_EPS);
        u32x2* o = (u32x2*)(H + (size_t)m * D) + lane;
#pragma unroll
        for (int j = 0; j < 4; ++j) { const int c = 4 * lane + 256 * j;
            const f32x4 g = *(const f32x4*)(a.in[5] + c), sh = *(const f32x4*)(mod + b * 6144 + c), sc = *(const f32x4*)(mod + b * 6144 + 1024 + c);
            f32x4 y;
#pragma unroll
            for (int e = 0; e < 4; ++e) y[e] = v[j][e] * r * g[e] * (1.f + sc[e]) + sh[e];
            u32x2 w; w.x = pkh(y[0], y[1]); w.y = pkh(y[2], y[3]); o[64 * j] = w; }
    }
}

__device__ __forceinline__ void p3_rows(const Args& a, int vcu, int G, int wave, int lane) {
    const int gw = vcu * NWAVES + wave, NGW = G * NWAVES;
    unsigned char* ws = a.ws;
    const f16* PROJ = (const f16*)(ws + WS_PROJ);
    f16* CQ = (f16*)(ws + WS_CQ); f16* CKV = (f16*)(ws + WS_CKV); f16* IK16 = (f16*)(ws + WS_IK16); float* IW = (float*)(ws + WS_IW);
    for (int m = gw; m < MTOK; m += NGW) {
        const f16* pr = PROJ + (size_t)m * IN_PAD;
        const f16x4 q = *(const f16x4*)(pr + C_CQ + 4 * lane);
        const f16x2 kv = *(const f16x2*)(pr + C_CKV + 2 * lane);
        const float ik = (float)pr[C_IK + lane];
        float q0 = (float)q[0], q1 = (float)q[1], q2 = (float)q[2], q3 = (float)q[3], k0 = (float)kv[0], k1 = (float)kv[1];
        const float rq = rsqrtf(wave_sum(q0 * q0 + q1 * q1 + q2 * q2 + q3 * q3) * (1.f / QL) + NORM_EPS);
        const float rk = rsqrtf(wave_sum(k0 * k0 + k1 * k1) * (1.f / KVL) + NORM_EPS);
        const float ri = rsqrtf(wave_sum(ik * ik) * (1.f / IDXD) + NORM_EPS);
        const f32x4 gq = *(const f32x4*)(a.in[10] + 4 * lane); const f32x2 gk = *(const f32x2*)(a.in[13] + 2 * lane); const float gi = a.in[14][lane];
        u32x2 w; w.x = pkh(q0 * rq * gq[0], q1 * rq * gq[1]); w.y = pkh(q2 * rq * gq[2], q3 * rq * gq[3]);
        *(u32x2*)(CQ + (size_t)m * QL + 4 * lane) = w;
        ((unsigned short*)(ws + WS_CKV8))[(size_t)m * 64 + lane] = (unsigned short)__builtin_amdgcn_cvt_pk_fp8_f32(k0 * rk * gk[0], k1 * rk * gk[1], 0, false);
        const float ikn = ik * ri * gi;
        IK16[(size_t)m * IDXD + lane] = (f16)ikn;
        if (lane < 8) IW[(size_t)m * 8 + lane] = (float)pr[C_IW + lane] * 0.04419417382415922f;
    }
}
__device__ __forceinline__ void p3_rwkv_prep(const Args& a, LAS unsigned char* lds, int vcu, int G, int tid) {
    unsigned char* ws = a.ws;
    const f16* PROJ = (const f16*)(ws + WS_PROJ);
    f16* RWW = (f16*)(ws + WS_RWW); f16* RWA = (f16*)(ws + WS_RWA); f16* RWG = (f16*)(ws + WS_RWG);
    LAS float* xs = (LAS float*)lds;
    const float* mu = a.in[17];
    const int ch = tid;
    const float w0 = a.in[18][ch], a0 = a.in[20][ch];
    for (int u = vcu; u < MTOK / 16; u += G) {
        const int m0 = u * 16;
        __syncthreads();
        for (int e = tid; e < 16 * 288; e += 512) {
            const int t = e / 288, col = e % 288, m = m0 + t;
            const float cur = (float)PROJ[(size_t)m * IN_PAD + C_WD + col];
            const float prev = ((m & (SEQ - 1)) != 0) ? (float)PROJ[(size_t)(m - 1) * IN_PAD + C_WD + col] : 0.f;
            float v = cur + mu[1536 + col] * (prev - cur);
            if (col < 64) v = tanhf(v); else if (col >= 128) v = sigmoidf_(v);
            xs[t * 288 + col] = v;
        }
        __syncthreads();
        float dl[16], al[16], gl[16];
#pragma unroll
        for (int t = 0; t < 16; ++t) { dl[t] = 0.f; al[t] = 0.f; gl[t] = 0.f; }
        for (int kk = 0; kk < 64; ++kk) {
            const float wd = a.in[19][kk * 512 + ch], wa = a.in[21][kk * 512 + ch];
#pragma unroll
            for (int t = 0; t < 16; ++t) { dl[t] += xs[t * 288 + kk] * wd; al[t] += xs[t * 288 + 64 + kk] * wa; }
        }
        for (int kk = 0; kk < 160; ++kk) {
            const float wg = a.in[22][kk * 512 + ch];
#pragma unroll
            for (int t = 0; t < 16; ++t) gl[t] += xs[t * 288 + 128 + kk] * wg;
        }
#pragma unroll
        for (int t = 0; t < 16; ++t) {
            const float z = -(w0 + dl[t]);
            const float sp = z > 20.f ? z : log1pf(__expf(z));
            const float wlog = -sp - 0.5f;
            const float lw = -__expf(wlog);
            const float av = sigmoidf_(a0 + al[t]);
            const size_t o = (size_t)(m0 + t) * RW + ch;
            RWW[o] = (f16)lw; RWA[o] = (f16)av; RWG[o] = (f16)gl[t];
        }
    }
}

__device__ __forceinline__ unsigned f2key(float f) { const unsigned u = __builtin_bit_cast(unsigned, f); return (u & 0x80000000u) ? ~u : (u | 0x80000000u); }
__device__ __forceinline__ void p5_indexer(const Args& a, LAS unsigned char* lds, int vcu, int G, int wave, int lane) {
    unsigned char* ws = a.ws;
    const f16* QI = (const f16*)a.out;
    const float* IK32 = (const float*)(ws + WS_IK32); const float* IW = (const float*)(ws + WS_IW);
    unsigned short* SEL = (unsigned short*)(ws + WS_SEL);
    LAS float* sc = (LAS float*)(lds + wave * 16384);
    LAS float* iq = (LAS float*)(lds + AUX_OFF + wave * 2048);
    const int gw = vcu * NWAVES + wave, NGW = G * NWAVES;
    for (int q = gw; q < MTOK; q += NGW) {
        const int b = q >> 12, t = q & (SEQ - 1);
        unsigned short* sel = SEL + (size_t)q * TOPK;
        if (t < TOPK) {
#pragma unroll
            for (int j = 0; j < 4; ++j) { const int s = lane + 64 * j; sel[s] = (s <= t) ? (unsigned short)s : (unsigned short)0xFFFF; }
            continue;
        }
        { const f16x8 v = *(const f16x8*)(QI + (size_t)q * NQI + 1024 + 8 * lane);
#pragma unroll
          for (int e = 0; e < 8; ++e) iq[8 * lane + e] = (float)v[e]; }
        float wq[8];
#pragma unroll
        for (int h = 0; h < 8; ++h) wq[h] = IW[(size_t)q * 8 + h];
        asm volatile("s_waitcnt lgkmcnt(0)" ::: "memory");
        const int nj = (t >> 6) + 1;
        for (int j = 0; j < nj; ++j) {
            const int s = j * 64 + lane;
            const float* kr = IK32 + ((size_t)(b << 12) + (s <= t ? s : t)) * IDXD;
            float kx[64];
#pragma unroll
            for (int d4 = 0; d4 < 16; ++d4) { const f32x4 v = *(const f32x4*)(kr + 4 * d4); kx[4 * d4] = v[0]; kx[4 * d4 + 1] = v[1]; kx[4 * d4 + 2] = v[2]; kx[4 * d4 + 3] = v[3]; }
            float score = 0.f;
#pragma unroll
            for (int h = 0; h < 8; ++h) { float d0 = 0.f;
#pragma unroll
                for (int d4 = 0; d4 < 16; ++d4) { const f32x4 qv = *(const LAS f32x4*)(iq + h * 64 + 4 * d4); d0 += qv[0] * kx[4 * d4]; d0 += qv[1] * kx[4 * d4 + 1]; d0 += qv[2] * kx[4 * d4 + 2]; d0 += qv[3] * kx[4 * d4 + 3]; }
                score += wq[h] * fmaxf(d0, 0.f); }
            sc[s] = (s <= t) ? score : -INFINITY;
        }
        asm volatile("s_waitcnt lgkmcnt(0)" ::: "memory");
        const int nvalid = nj * 64;
        unsigned key[64];
#pragma unroll
        for (int j = 0; j < 64; ++j) { const int s = lane * 64 + j; key[j] = (s < nvalid) ? f2key(sc[s]) : 0u; }
        unsigned prefix = 0u;
        for (int bit = 31; bit >= 0; --bit) {
            const unsigned cand = prefix | (1u << bit);
            int c = 0;
#pragma unroll
            for (int j = 0; j < 64; ++j) c += (key[j] >= cand) ? 1 : 0;
#pragma unroll
            for (int o = 1; o < 64; o <<= 1) c += __shfl_xor(c, o);
            if (c >= TOPK) prefix = cand;
        }
        int cgt = 0, ceq = 0;
#pragma unroll
        for (int j = 0; j < 64; ++j) { cgt += (key[j] > prefix) ? 1 : 0; ceq += (key[j] == prefix) ? 1 : 0; }
        int sgt = cgt, seq = ceq;
#pragma unroll
        for (int o = 1; o < 64; o <<= 1) { const int x = __shfl_up(sgt, o), y = __shfl_up(seq, o); if (lane >= o) { sgt += x; seq += y; } }
        const int tot_gt = __shfl(sgt, 63);
        int pos_gt = sgt - cgt, rank_eq = seq - ceq;
        const int need = TOPK - tot_gt;
#pragma unroll
        for (int j = 0; j < 64; ++j) {
            const int s = lane * 64 + j;
            if (key[j] > prefix) { sel[pos_gt] = (unsigned short)s; ++pos_gt; }
            else if (key[j] == prefix) { if (rank_eq < need) sel[tot_gt + rank_eq] = (unsigned short)s; ++rank_eq; }
        }
    }
}

__device__ __forceinline__ int t5_bucket(int rel) {
    if (rel < 16) return rel;
    const int l = 16 + (int)(logf((float)rel * (1.f / 16.f)) / 2.0794415416798357f * 16.f);
    return l < 31 ? l : 31;
}
__device__ __forceinline__ void p6_attention(const Args& a, LAS unsigned char* lds, int vcu, int G, int wave, int lane) {
    unsigned char* ws = a.ws;
    const f16* QI = (const f16*)a.out; const f16* CKV = (const f16*)(ws + WS_CKV);
    const unsigned short* SEL = (const unsigned short*)(ws + WS_SEL);
    f16* OATT = (f16*)(ws + WS_OATT);
    const float* rel_bias = a.in[2];
    LAS float* qa = (LAS float*)(lds + wave * 16384);
    LAS float* pp = (LAS float*)(lds + wave * 16384 + 4096);
    LAS int* sidx = (LAS int*)(lds + wave * 16384 + 12288);
    const int gw = vcu * NWAVES + wave, NGW = G * NWAVES;
    for (int q = gw; q < MTOK; q += NGW) {
        const int b = q >> 12, t = q & (SEQ - 1);
#pragma unroll
        for (int i = 0; i < 2; ++i) { const f16x8 v = *(const f16x8*)(QI + (size_t)q * NQI + 512 * i + 8 * lane);
#pragma unroll
            for (int e = 0; e < 8; ++e) qa[512 * i + 8 * lane + e] = (float)v[e]; }
        asm volatile("s_waitcnt lgkmcnt(0)" ::: "memory");
        float lg[4][8];
        int srow[4]; bool okv[4];
#pragma unroll
        for (int i = 0; i < 4; ++i) {
            const int sraw = SEL[(size_t)q * TOPK + lane + 64 * i];
            okv[i] = sraw != 0xFFFF && sraw <= t;
            srow[i] = okv[i] ? sraw : 0;
            sidx[lane + 64 * i] = okv[i] ? sraw : -1;
#pragma unroll
            for (int h = 0; h < 8; ++h) lg[i][h] = 0.f;
        }
#pragma unroll 1
        for (int c8 = 0; c8 < 16; ++c8) {
            f16x8 kv[4];
#pragma unroll
            for (int i = 0; i < 4; ++i) kv[i] = *(const f16x8*)(CKV + ((size_t)(b << 12) + srow[i]) * KVL + 8 * c8);
#pragma unroll
            for (int h = 0; h < 8; ++h) {
                const f32x4 q0 = *(const LAS f32x4*)(qa + h * 128 + 8 * c8), q1 = *(const LAS f32x4*)(qa + h * 128 + 8 * c8 + 4);
#pragma unroll
                for (int i = 0; i < 4; ++i)
                    lg[i][h] += q0[0] * (float)kv[i][0] + q0[1] * (float)kv[i][1] + q0[2] * (float)kv[i][2] + q0[3] * (float)kv[i][3] + q1[0] * (float)kv[i][4] + q1[1] * (float)kv[i][5] + q1[2] * (float)kv[i][6] + q1[3] * (float)kv[i][7];
            }
        }
#pragma unroll
        for (int i = 0; i < 4; ++i) {
            const int bk = t5_bucket(t - srow[i]);
#pragma unroll
            for (int h = 0; h < 8; ++h) lg[i][h] = okv[i] ? lg[i][h] + rel_bias[bk * 8 + h] : -INFINITY;
        }
#pragma unroll
        for (int h = 0; h < 8; ++h) {
            float mx = fmaxf(fmaxf(lg[0][h], lg[1][h]), fmaxf(lg[2][h], lg[3][h]));
#pragma unroll
            for (int o = 1; o < 64; o <<= 1) mx = fmaxf(mx, __shfl_xor(mx, o));
            float e[4], s = 0.f;
#pragma unroll
            for (int i = 0; i < 4; ++i) { e[i] = __expf(lg[i][h] - mx); s += e[i]; }
            s = wave_sum(s);
            const float inv = 1.f / s;
#pragma unroll
            for (int i = 0; i < 4; ++i) pp[h * 256 + lane + 64 * i] = e[i] * inv;
        }
        asm volatile("s_waitcnt lgkmcnt(0)" ::: "memory");
        float o0[8], o1[8];
#pragma unroll
        for (int h = 0; h < 8; ++h) { o0[h] = 0.f; o1[h] = 0.f; }
        for (int kk = 0; kk < TOPK; ++kk) {
            const int s = sidx[kk];
            if (s < 0) continue;
            const f16x2 kv = *(const f16x2*)(CKV + ((size_t)(b << 12) + s) * KVL + 2 * lane);
            const float v0 = (float)kv[0], v1 = (float)kv[1];
#pragma unroll
            for (int h = 0; h < 8; ++h) { const float p = pp[h * 256 + kk]; o0[h] += p * v0; o1[h] += p * v1; }
        }
#pragma unroll
        for (int h = 0; h < 8; ++h) *(unsigned*)(OATT + (size_t)q * KOUT + h * 128 + 2 * lane) = pkh(o0[h], o1[h]);
        asm volatile("s_waitcnt lgkmcnt(0)" ::: "memory");
    }
}

constexpr int SC_PITCH = 8224, DSA_SEL_OFF = 16 * SC_PITCH, DSA_BL_OFF = DSA_SEL_OFF + 8192, DSA_HIST_OFF = 143936;
static_assert(DSA_BL_OFF + 129 * 8 * 4 <= DSA_HIST_OFF && DSA_HIST_OFF + 8 * 1280 <= MISC_OFF, "DSA LDS map");
typedef short v4i16_t __attribute__((ext_vector_type(4)));
__device__ __forceinline__ unsigned kv_off(unsigned row, unsigned ch) { return 256u * row + 16u * (ch ^ (((row & 3u) << 2) | ((row >> 2) & 3u))); }
__device__ __forceinline__ f16x4 tr_read16(LAS unsigned char* p) { return __builtin_bit_cast(f16x4, __builtin_amdgcn_ds_read_tr16_b64_v4i16((LAS v4i16_t*)p)); }
template <int CTRL, int RMASK> __device__ __forceinline__ int dpp_i(int x) { return __builtin_amdgcn_update_dpp(0, x, CTRL, RMASK, 0xF, false); }
template <int CTRL> __device__ __forceinline__ int dpp_iz(int x) { return __builtin_amdgcn_update_dpp(0, x, CTRL, 0xF, 0xF, true); }
__device__ __forceinline__ int wave_incl_scan_i(int x) { x += dpp_iz<0x111>(x); x += dpp_iz<0x112>(x); x += dpp_iz<0x114>(x); x += dpp_iz<0x118>(x);
    x += dpp_i<0x142, 0xA>(x); x += dpp_i<0x143, 0xC>(x); return x; }
__device__ __forceinline__ void p5_dsa(const Args& a, LAS unsigned char* lds, int G, int bx, int tid, int wave, int lane) {
    unsigned char* ws = a.ws;
    const f16* QI = (const f16*)a.out; const f16* IK16 = (const f16*)(ws + WS_IK16); const float* IW = (const float*)(ws + WS_IW);
    const f16* CKV = (const f16*)(ws + WS_CKV); f16* OATT = (f16*)(ws + WS_OATT);
    LAS unsigned short* SELL = (LAS unsigned short*)(lds + DSA_SEL_OFF);
    LAS float* BL = (LAS float*)(lds + DSA_BL_OFF);
    for (int e = tid; e < 129 * 8; e += 512) { const int rel = e >> 3, h = e & 7; BL[e] = a.in[2][t5_bucket(rel) * 8 + h]; }
    const int nunits = BATCH * (SEQ / 16);
    const bool balanced = (G == 256);
    const int niter = balanced ? 8 : (nunits + G - 1) / G;
#pragma unroll 1
    for (int it = 0; it < niter; ++it) {
        int b, tile;
        if (balanced) { b = bx & 7; const int r = bx >> 3, base = 64 * (it >> 1); tile = (it & 1) ? base + 63 - r : base + r; }
        else { const int u = it * G + bx; if (u >= nunits) break; b = u >> 8; tile = u & 255; }
        int lane_o = lane; asm volatile("" : "+v"(lane_o));
        const int r16 = lane_o & 15, g = lane_o >> 4;
        const int t0 = tile * 16;
        const size_t qb = (size_t)(b << 12);
        const int jn = ((t0 + 15) >> 7) + 1;
        lds_barrier();
#ifndef DSAREP
#define DSAREP 0
#endif
#ifndef DSA_NO_A
        for (int ra_ = 0; ra_ < ((DSAREP & 1) ? 2 : 1); ++ra_)
        if (t0 + 15 >= TOPK) {
            f16x8 afr[8][2]; f32x4 wv[4][2];
#pragma unroll
            for (int mt = 0; mt < 8; ++mt) { const int tg = mt >> 1, hf = mt & 1, t = t0 + 4 * tg + (r16 >> 2), h = 4 * hf + (r16 & 3);
#pragma unroll
                for (int ks = 0; ks < 2; ++ks) afr[mt][ks] = *(const f16x8*)(QI + (qb + t) * NQI + 1024 + h * 64 + 32 * ks + 8 * g); }
#pragma unroll
            for (int tg = 0; tg < 4; ++tg)
#pragma unroll
                for (int hf = 0; hf < 2; ++hf) wv[tg][hf] = *(const f32x4*)(IW + (qb + t0 + 4 * tg + g) * 8 + 4 * hf) * 65536.0f;
            const f32x2 cscale = {1.52587890625e-05f, 1.52587890625e-05f};
            f16x8 bn0[2], bn1[2], bn2[2];
            const f16* ikp = IK16 + (qb + 16 * wave + r16) * IDXD + 8 * g;
#pragma unroll
            for (int ks = 0; ks < 2; ++ks) { bn0[ks] = *(const f16x8*)(ikp + 32 * ks); bn1[ks] = bn0[ks]; bn2[ks] = bn0[ks];
                if (jn > 1) bn1[ks] = *(const f16x8*)(ikp + 128 * IDXD + 32 * ks);
                if (jn > 2) bn2[ks] = *(const f16x8*)(ikp + 256 * IDXD + 32 * ks); }
            for (int j = 0; j < jn; ++j) {
                const int s = 128 * j + 16 * wave + r16;
                f16x8 bfr[2]; bfr[0] = bn0[0]; bfr[1] = bn0[1];
                bn0[0] = bn1[0]; bn0[1] = bn1[1]; bn1[0] = bn2[0]; bn1[1] = bn2[1];
                if (j + 3 < jn) {
#pragma unroll
                    for (int ks = 0; ks < 2; ++ks) bn2[ks] = *(const f16x8*)(ikp + (size_t)(128 * (j + 3)) * IDXD + 32 * ks); }
                f32x4 acc[8];
#pragma unroll
                for (int mt = 0; mt < 8; ++mt) { acc[mt] = __builtin_amdgcn_mfma_f32_16x16x32_f16(afr[mt][0], bfr[0], (f32x4){0.f, 0.f, 0.f, 0.f}, 0, 0, 0);
                    acc[mt] = __builtin_amdgcn_mfma_f32_16x16x32_f16(afr[mt][1], bfr[1], acc[mt], 0, 0, 0); }
                asm volatile("s_nop 15\n\ts_nop 7" :: "v"(acc[0]), "v"(acc[1]), "v"(acc[2]), "v"(acc[3]), "v"(acc[4]), "v"(acc[5]), "v"(acc[6]), "v"(acc[7]));
                float scv[4];
#pragma unroll
                for (int tg = 0; tg < 4; ++tg) { f32x2 s2 = {0.f, 0.f};
#pragma unroll
                    for (int hf = 0; hf < 2; ++hf)
#pragma unroll
                        for (int p = 0; p < 2; ++p) { const f32x2 av = {acc[2 * tg + hf][2 * p], acc[2 * tg + hf][2 * p + 1]}; f32x2 r;
                            asm volatile("v_pk_mul_f32 %0, %1, %2 clamp" : "=v"(r) : "v"(av), "v"(cscale));
                            const f32x2 wp = {wv[tg][hf][2 * p], wv[tg][hf][2 * p + 1]}; s2 = r * wp + s2; }
                    scv[tg] = s2[0] + s2[1]; }
                if (j == jn - 1) {
#pragma unroll
                    for (int tg = 0; tg < 4; ++tg) if (s > t0 + 4 * tg + g) scv[tg] = -INFINITY; }
#pragma unroll
                for (int pr = 0; pr < 2; ++pr) {
                    const unsigned x = pkh(scv[2 * pr], scv[2 * pr + 1]);
                    const unsigned k2 = x ^ ((((x >> 15) & 0x00010001u) * 0x7FFFu) | 0x80008000u);
                    *(LAS unsigned short*)(lds + (4 * (2 * pr) + g) * SC_PITCH + s * 2) = (unsigned short)(k2 & 0xFFFFu);
                    *(LAS unsigned short*)(lds + (4 * (2 * pr + 1) + g) * SC_PITCH + s * 2) = (unsigned short)(k2 >> 16); }
            }
        }
#endif
        __builtin_amdgcn_sched_barrier(0); lds_barrier(); __builtin_amdgcn_sched_barrier(0);
#ifndef DSA_NO_C
#pragma unroll 1
        for (int rr = 0; rr < ((DSAREP & 2) ? 4 : 2); ++rr) {
            const int rl = 2 * wave + (rr & 1), t = t0 + rl;
            LAS unsigned short* sel = SELL + rl * 256;
            if (t < TOPK) {
#pragma unroll
                for (int k = 0; k < 4; ++k) { const int jx = lane_o + 64 * k; sel[jx] = (jx <= t) ? (unsigned short)jx : (unsigned short)0xFFFF; }
                continue;
            }
            const LAS unsigned* srow = (const LAS unsigned*)(lds + rl * SC_PITCH) + lane_o;
#define DSA_KEY(jj_) (srow[(jj_) * 64])
            LAS unsigned* hist = (LAS unsigned*)(lds + DSA_HIST_OFF + wave * 1280);
            unsigned prefix = 0u; int kneed = TOPK;
#pragma unroll 1
            for (int pass = 0; pass < 2; ++pass) {
                *(LAS u32x4*)(hist + 4 * lane_o) = (u32x4){0u, 0u, 0u, 0u};
                asm volatile("s_waitcnt lgkmcnt(0)" ::: "memory");
                if (pass == 0) {
#pragma unroll 4
                    for (int jj = 0; jj < jn; ++jj) { const unsigned k = DSA_KEY(jj);
                        __hip_atomic_fetch_add(hist + (k >> 24), 1u, __ATOMIC_RELAXED, __HIP_MEMORY_SCOPE_WORKGROUP);
                        __hip_atomic_fetch_add(hist + ((k >> 8) & 0xFFu), 1u, __ATOMIC_RELAXED, __HIP_MEMORY_SCOPE_WORKGROUP);
                        if (DSAREP & 8) { __hip_atomic_fetch_add(hist + (k >> 24), 1u, __ATOMIC_RELAXED, __HIP_MEMORY_SCOPE_WORKGROUP); __hip_atomic_fetch_add(hist + ((k >> 8) & 0xFFu), 1u, __ATOMIC_RELAXED, __HIP_MEMORY_SCOPE_WORKGROUP);
                            __hip_atomic_fetch_add(hist + (k >> 24), 0xFFFFFFFFu, __ATOMIC_RELAXED, __HIP_MEMORY_SCOPE_WORKGROUP); __hip_atomic_fetch_add(hist + ((k >> 8) & 0xFFu), 0xFFFFFFFFu, __ATOMIC_RELAXED, __HIP_MEMORY_SCOPE_WORKGROUP); } }
                } else {
#pragma unroll 4
                    for (int jj = 0; jj < jn; ++jj) { const unsigned k = DSA_KEY(jj);
                        const unsigned dump = 256u + (unsigned)lane_o;
                        __hip_atomic_fetch_add(hist + (((k >> 24) == prefix) ? ((k >> 16) & 0xFFu) : dump), 1u, __ATOMIC_RELAXED, __HIP_MEMORY_SCOPE_WORKGROUP);
                        __hip_atomic_fetch_add(hist + ((((k >> 8) & 0xFFu) == prefix) ? (k & 0xFFu) : dump), 1u, __ATOMIC_RELAXED, __HIP_MEMORY_SCOPE_WORKGROUP); }
                }
                asm volatile("s_waitcnt lgkmcnt(0)" ::: "memory");
                const u32x4 hv = *(const LAS u32x4*)(hist + 4 * lane_o);
                const int sl = (int)(hv.x + hv.y + hv.z + hv.w);
                const int pre = wave_incl_scan_i(sl);
                const int tot = __builtin_amdgcn_readlane(pre, 63);
                const int S = tot - pre + sl;
                const int excl = S - sl;
                const unsigned long long bm = __ballot(excl < kneed && S >= kneed);
                const int L = bm ? (int)__builtin_ctzll(bm) : 0;
                const int ex = __builtin_amdgcn_readlane(excl, L); const int h1 = __builtin_amdgcn_readlane((int)hv.y, L), h2 = __builtin_amdgcn_readlane((int)hv.z, L), h3 = __builtin_amdgcn_readlane((int)hv.w, L);
                int cabove = ex, bin;
                if (cabove + h3 >= kneed) bin = 3; else { cabove += h3;
                    if (cabove + h2 >= kneed) bin = 2; else { cabove += h2;
                        if (cabove + h1 >= kneed) bin = 1; else { cabove += h1; bin = 0; } } }
                prefix = (prefix << 8) | (unsigned)(4 * L + bin); kneed -= cabove;
            }
            const unsigned lo = prefix << 16, hi = (prefix + 1u) << 16;
            const int tot_gt = TOPK - kneed, need = kneed;
            LAS unsigned short* dumpp = (LAS unsigned short*)(hist + 256) + lane_o;
            for (int er_ = 0; er_ < ((DSAREP & 16) ? 2 : 1); ++er_) {
            int base = 0, tbase = 0;
#pragma unroll 2
            for (int jj = 0; jj < jn; ++jj) { const unsigned k = DSA_KEY(jj);
                const int s0 = 2 * (jj * 64 + lane_o); const unsigned kb = k << 16;
                const bool g0 = kb >= hi, g1 = k >= hi;
                const unsigned long long m0 = __ballot(g0), m1 = __ballot(g1);
                const int p0 = base + (int)__builtin_amdgcn_mbcnt_hi((unsigned)(m0 >> 32), __builtin_amdgcn_mbcnt_lo((unsigned)m0, 0u)); base += __popcll(m0);
                const int p1 = base + (int)__builtin_amdgcn_mbcnt_hi((unsigned)(m1 >> 32), __builtin_amdgcn_mbcnt_lo((unsigned)m1, 0u)); base += __popcll(m1);
                *(g0 ? sel + p0 : dumpp) = (unsigned short)s0;
                *(g1 ? sel + p1 : dumpp) = (unsigned short)(s0 + 1);
                const bool e0 = (kb >= lo) && !g0, e1 = (k >= lo) && !g1;
                const unsigned long long t0m = __ballot(e0), t1m = __ballot(e1);
                if (t0m | t1m) {
                    const int r0 = tbase + (int)__builtin_amdgcn_mbcnt_hi((unsigned)(t0m >> 32), __builtin_amdgcn_mbcnt_lo((unsigned)t0m, 0u)); tbase += __popcll(t0m);
                    const int r1 = tbase + (int)__builtin_amdgcn_mbcnt_hi((unsigned)(t1m >> 32), __builtin_amdgcn_mbcnt_lo((unsigned)t1m, 0u)); tbase += __popcll(t1m);
                    if (e0 && r0 < need) sel[tot_gt + r0] = (unsigned short)s0;
                    if (e1 && r1 < need) sel[tot_gt + r1] = (unsigned short)(s0 + 1);
                }
            }
            }
#undef DSA_KEY
        }
#endif
        __builtin_amdgcn_sched_barrier(0); lds_barrier(); __builtin_amdgcn_sched_barrier(0);
#ifndef DSA_NO_D
        LAS unsigned char* kvb = lds + wave * 16384;
        const unsigned char* CKV8 = ws + WS_CKV8;
#pragma unroll 1
        for (int rr = 0; rr < ((DSAREP & 4) ? 4 : 2); ++rr) {
            const int rl = 2 * wave + (rr & 1), t = t0 + rl; const size_t q = qb + t;
            const LAS unsigned short* sel = SELL + rl * 256;
            long qf8[4];
#pragma unroll
            for (int ks = 0; ks < 4; ++ks) { const f16x8 v = *(const f16x8*)(QI + q * NQI + (r16 & 7) * 128 + 32 * ks + 8 * g); const float zs = (r16 >= 8) ? 0.f : 64.f;
                int lo32 = __builtin_amdgcn_cvt_pk_fp8_f32((float)v[0] * zs, (float)v[1] * zs, 0, false); lo32 = __builtin_amdgcn_cvt_pk_fp8_f32((float)v[2] * zs, (float)v[3] * zs, lo32, true);
                int hi32 = __builtin_amdgcn_cvt_pk_fp8_f32((float)v[4] * zs, (float)v[5] * zs, 0, false); hi32 = __builtin_amdgcn_cvt_pk_fp8_f32((float)v[6] * zs, (float)v[7] * zs, hi32, true);
                qf8[ks] = (long)(((unsigned long long)(unsigned)hi32 << 32) | (unsigned)lo32); }
            const LAS float* BLh = BL + (r16 & 7);
            float m_run = -1e30f, l_run = 0.f;
            f32x4 oE[4], oO[4];
#pragma unroll
            for (int cb = 0; cb < 4; ++cb) { oE[cb] = (f32x4){0.f, 0.f, 0.f, 0.f}; oO[cb] = (f32x4){0.f, 0.f, 0.f, 0.f}; }
            const int nch = (t < TOPK) ? (t >> 5) + 1 : 8;
#define DSA_DMA(ch_, buf_) do { unsigned so_[4]; _Pragma("unroll") for (int i = 0; i < 4; ++i) { const int R = 8 * i + (lane_o >> 3); \
                const unsigned ix = sel[32 * (ch_) + R]; const unsigned srow = (ix == 0xFFFFu) ? 0u : ix; so_[i] = srow * 128u + 16u * (((unsigned)lane_o & 7u) ^ ((unsigned)R & 7u)); } \
            _Pragma("unroll") for (int i = 0; i < 4; ++i) __builtin_amdgcn_global_load_lds((const unsigned*)(ckvb + so_[i]), (LAS unsigned*)(kvb + (buf_) * 4096 + i * 1024), 16, 0, 0); } while (0)
            const unsigned char* ckvb = CKV8 + qb * 128;
            asm volatile("s_waitcnt vmcnt(0)" ::: "memory");
            DSA_DMA(0, 0);
            const int qq = (lane_o & 15) >> 2, pp = lane_o & 3;
            unsigned offA[2][4], offT[4][2];
#pragma unroll
            for (int mt = 0; mt < 2; ++mt) { const int row = 16 * mt + r16;
#pragma unroll
                for (int ks = 0; ks < 4; ++ks) offA[mt][ks] = row * 128 + 16 * ((2 * ks + (g >> 1)) ^ (row & 7)) + 8 * (g & 1); }
#pragma unroll
            for (int cb = 0; cb < 4; ++cb) { const int r1 = 4 * g + qq, r2 = 16 + 4 * g + qq;
                offT[cb][0] = r1 * 128 + 16 * ((2 * cb + (pp >> 1)) ^ (r1 & 7)) + 8 * (pp & 1); offT[cb][1] = r2 * 128 + 16 * ((2 * cb + (pp >> 1)) ^ (r2 & 7)) + 8 * (pp & 1); }
#pragma unroll 1
            for (int ch = 0; ch < nch; ++ch) {
                asm volatile("s_waitcnt vmcnt(0)" ::: "memory");
                long af[2][4]; u32x2 td[4][2];
#pragma unroll
                for (int mt = 0; mt < 2; ++mt)
#pragma unroll
                    for (int ks = 0; ks < 4; ++ks) af[mt][ks] = *(const LAS long*)(kvb + offA[mt][ks]);
#pragma unroll
                for (int cb = 0; cb < 4; ++cb) { td[cb][0] = __builtin_bit_cast(u32x2, tr_read16(kvb + offT[cb][0])); td[cb][1] = __builtin_bit_cast(u32x2, tr_read16(kvb + offT[cb][1])); }
                u32x2 pk2[2]; float bvv[2][4]; bool inv4[2][4];
#pragma unroll
                for (int mt = 0; mt < 2; ++mt) { pk2[mt] = *(const LAS u32x2*)(sel + 32 * ch + 16 * mt + 4 * g);
#pragma unroll
                    for (int e = 0; e < 4; ++e) { const unsigned ix = ((e & 2) ? pk2[mt].y : pk2[mt].x) >> ((e & 1) * 16) & 0xFFFFu;
                        const int rel = t - (int)ix; const int rc = min(max(rel, 0), 128);
                        inv4[mt][e] = (ix == 0xFFFFu); bvv[mt][e] = BLh[rc * 8]; } }
                asm volatile("s_waitcnt lgkmcnt(0)" : "+v"(bvv[0][0]), "+v"(bvv[0][1]), "+v"(bvv[0][2]), "+v"(bvv[0][3]), "+v"(bvv[1][0]), "+v"(bvv[1][1]), "+v"(bvv[1][2]), "+v"(bvv[1][3]) :: "memory");
                if (ch + 1 < nch) DSA_DMA(ch + 1, 0);
                f32x4 lg[2];
#pragma unroll
                for (int mt = 0; mt < 2; ++mt) { lg[mt] = (f32x4){0.f, 0.f, 0.f, 0.f};
#pragma unroll
                    for (int ks = 0; ks < 4; ++ks) lg[mt] = __builtin_amdgcn_mfma_f32_16x16x32_fp8_fp8(af[mt][ks], qf8[ks], lg[mt], 0, 0, 0); }
                float cmax = -INFINITY;
#pragma unroll
                for (int mt = 0; mt < 2; ++mt)
#pragma unroll
                    for (int e = 0; e < 4; ++e) { const float v = inv4[mt][e] ? -INFINITY : lg[mt][e] * 0.015625f + bvv[mt][e]; lg[mt][e] = v; cmax = fmaxf(cmax, v); }
                cmax = fmaxf(cmax, __shfl_xor(cmax, 16)); cmax = fmaxf(cmax, __shfl_xor(cmax, 32));
                const float m_new = fmaxf(m_run, cmax); const float alpha = __expf(m_run - m_new); m_run = m_new;
                float ps = 0.f, pv[8];
#pragma unroll
                for (int mt = 0; mt < 2; ++mt)
#pragma unroll
                    for (int e = 0; e < 4; ++e) { const float p = __expf(lg[mt][e] - m_new); ps += p; pv[mt * 4 + e] = p; }
                int plo = __builtin_amdgcn_cvt_pk_fp8_f32(pv[0], pv[1], 0, false); plo = __builtin_amdgcn_cvt_pk_fp8_f32(pv[2], pv[3], plo, true);
                int phi = __builtin_amdgcn_cvt_pk_fp8_f32(pv[4], pv[5], 0, false); phi = __builtin_amdgcn_cvt_pk_fp8_f32(pv[6], pv[7], phi, true);
                const long pf8 = (long)(((unsigned long long)(unsigned)phi << 32) | (unsigned)plo);
                l_run = l_run * alpha + ps;
#pragma unroll
                for (int cb = 0; cb < 4; ++cb) { oE[cb] *= alpha; oO[cb] *= alpha; }
#pragma unroll
                for (int cb = 0; cb < 4; ++cb) {
                    const u32x2 d1 = td[cb][0], d2 = td[cb][1];
                    const unsigned xe0 = __builtin_amdgcn_perm(d1.y, d1.x, 0x06040200u), xo0 = __builtin_amdgcn_perm(d1.y, d1.x, 0x07050301u);
                    const unsigned xe1 = __builtin_amdgcn_perm(d2.y, d2.x, 0x06040200u), xo1 = __builtin_amdgcn_perm(d2.y, d2.x, 0x07050301u);
                    oE[cb] = __builtin_amdgcn_mfma_f32_16x16x32_fp8_fp8((long)(((unsigned long long)xe1 << 32) | xe0), pf8, oE[cb], 0, 0, 0);
                    oO[cb] = __builtin_amdgcn_mfma_f32_16x16x32_fp8_fp8((long)(((unsigned long long)xo1 << 32) | xo0), pf8, oO[cb], 0, 0, 0);
                }
            }
#undef DSA_DMA
            l_run += __shfl_xor(l_run, 16); l_run += __shfl_xor(l_run, 32);
            const float inv = 1.f / l_run;
            if (r16 < 8) {
#pragma unroll
                for (int cb = 0; cb < 4; ++cb) { u32x4 w; w.x = pkh(oE[cb][0] * inv, oO[cb][0] * inv); w.y = pkh(oE[cb][1] * inv, oO[cb][1] * inv); w.z = pkh(oE[cb][2] * inv, oO[cb][2] * inv); w.w = pkh(oE[cb][3] * inv, oO[cb][3] * inv);
                    *(u32x4*)(OATT + q * KOUT + r16 * 128 + 32 * cb + 8 * g) = w; }
            }
        }
#endif
    }
}

template <int CTRL> __device__ __forceinline__ float dpp_f(float x) { return __builtin_bit_cast(float, __builtin_amdgcn_update_dpp(0, __builtin_bit_cast(int, x), CTRL, 0xF, 0xF, false)); }
__device__ __forceinline__ float row16_sum(float x) { x += dpp_f<0x128>(x); x += dpp_f<0x124>(x); x += dpp_f<0x122>(x); x += dpp_f<0x121>(x); return x; }
constexpr int SCAN_TB = 32;
__device__ __forceinline__ void p7_scan(const Args& a, LAS unsigned char* lds, int vcu, int G, int wave, int lane) {
    unsigned char* ws = a.ws;
    const f16* PROJ = (const f16*)(ws + WS_PROJ); const f16* RWW = (const f16*)(ws + WS_RWW); const f16* RWA = (const f16*)(ws + WS_RWA);
    float* YRAW = (float*)(ws + WS_YRAW);
    for (int u = vcu; u < BATCH * HRW * 2; u += G) {
        const int half = u & 1, h = (u >> 1) & 7, b = u >> 4;
        const int ch = h * 64 + lane;
        const float mu_r = a.in[17][ch], mu_k = a.in[17][512 + ch], mu_v = a.in[17][1024 + ch], kkc = a.in[23][ch], kac = a.in[24][ch];
        const int rr = lane >> 4, qd = lane & 15, irow = half * 32 + wave * 4 + rr;
        float S0 = 0.f, S1 = 0.f, S2 = 0.f, S3 = 0.f;
#define SCAN_LOAD(blk_) do { _Pragma("unroll") for (int tt = 0; tt < 4; ++tt) { const int t = (blk_) * SCAN_TB + wave * 4 + tt; const size_t m = (size_t)(b << 12) + t; \
            const f16* pr = PROJ + m * IN_PAD + h * 64 + lane; \
            st_r[tt] = (float)pr[C_R]; st_k[tt] = (float)pr[C_K]; st_v[tt] = (float)pr[C_V]; \
            if (t > 0) { st_rp[tt] = (float)pr[C_R - IN_PAD]; st_kp[tt] = (float)pr[C_K - IN_PAD]; st_vp[tt] = (float)pr[C_V - IN_PAD]; } else { st_rp[tt] = 0.f; st_kp[tt] = 0.f; st_vp[tt] = 0.f; } \
            st_lw[tt] = (float)RWW[m * RW + ch]; st_av[tt] = (float)RWA[m * RW + ch]; } } while (0)
#define SCAN_WRITE(buf_) do { LAS float* base_ = (LAS float*)(lds + (buf_) * 49152); _Pragma("unroll") for (int tt = 0; tt < 4; ++tt) { const int tl = wave * 4 + tt; \
            const float rs = st_r[tt] + mu_r * (st_rp[tt] - st_r[tt]), ks = st_k[tt] + mu_k * (st_kp[tt] - st_k[tt]), vs = st_v[tt] + mu_v * (st_vp[tt] - st_v[tt]); \
            const float kkv = ks * kkc; const float nrm = sqrtf(wave_sum(kkv * kkv)); const float kkn = kkv / fmaxf(nrm, 1e-12f); \
            const float av = st_av[tt]; const float km = ks * (1.f + (av - 1.f) * kac); \
            base_[0 * 2048 + tl * 64 + lane] = rs; base_[1 * 2048 + tl * 64 + lane] = __expf(st_lw[tt]); base_[2 * 2048 + tl * 64 + lane] = km; \
            base_[3 * 2048 + tl * 64 + lane] = vs; base_[4 * 2048 + tl * 64 + lane] = -kkn; base_[5 * 2048 + tl * 64 + lane] = kkn * av; } } while (0)
        float st_r[4], st_k[4], st_v[4], st_rp[4], st_kp[4], st_vp[4], st_lw[4], st_av[4];
        __syncthreads();
        SCAN_LOAD(0); SCAN_WRITE(0);
        constexpr int NBLK = SEQ / SCAN_TB;
        for (int blk = 0; blk < NBLK; ++blk) {
            __syncthreads();
            if (blk + 1 < NBLK) SCAN_LOAD(blk + 1);
            const LAS float* base = (const LAS float*)(lds + (blk & 1) * 49152);
            for (int tl = 0; tl < SCAN_TB; ++tl) {
                const f32x4 r4 = *(const LAS f32x4*)(base + 0 * 2048 + tl * 64 + 4 * qd), w4 = *(const LAS f32x4*)(base + 1 * 2048 + tl * 64 + 4 * qd), k4 = *(const LAS f32x4*)(base + 2 * 2048 + tl * 64 + 4 * qd);
                const f32x4 a4 = *(const LAS f32x4*)(base + 4 * 2048 + tl * 64 + 4 * qd), b4 = *(const LAS f32x4*)(base + 5 * 2048 + tl * 64 + 4 * qd);
                const float vi = base[3 * 2048 + tl * 64 + irow];
                float sa = S0 * a4[0] + S1 * a4[1] + S2 * a4[2] + S3 * a4[3];
                sa = row16_sum(sa);
                S0 = S0 * w4[0] + sa * b4[0] + vi * k4[0]; S1 = S1 * w4[1] + sa * b4[1] + vi * k4[1]; S2 = S2 * w4[2] + sa * b4[2] + vi * k4[2]; S3 = S3 * w4[3] + sa * b4[3] + vi * k4[3];
                float y = S0 * r4[0] + S1 * r4[1] + S2 * r4[2] + S3 * r4[3];
                y = row16_sum(y);
                if (qd == 0) YRAW[((size_t)(b << 12) + blk * SCAN_TB + tl) * RW + h * 64 + irow] = y;
            }
            if (blk + 1 < NBLK) SCAN_WRITE((blk + 1) & 1);
        }
        __syncthreads();
    }
}

__device__ __forceinline__ void p8_rwkv_post(const Args& a, int vcu, int G, int wave, int lane) {
    unsigned char* ws = a.ws;
    const f16* PROJ = (const f16*)(ws + WS_PROJ); const f16* RWA = (const f16*)(ws + WS_RWA); const f16* RWG = (const f16*)(ws + WS_RWG);
    const float* YRAW = (const float*)(ws + WS_YRAW); f16* OATT = (f16*)(ws + WS_OATT);
    const int gw = vcu * NWAVES + wave, NGW = G * NWAVES;
    for (int it = gw; it < MTOK * HRW; it += NGW) {
        const int m = it >> 3, h = it & 7, ch = h * 64 + lane, t = m & (SEQ - 1);
        const f16* pr = PROJ + (size_t)m * IN_PAD + ch;
        float r = (float)pr[C_R], k = (float)pr[C_K], v = (float)pr[C_V], rp = 0.f, kp = 0.f, vp = 0.f;
        if (t > 0) { rp = (float)pr[C_R - IN_PAD]; kp = (float)pr[C_K - IN_PAD]; vp = (float)pr[C_V - IN_PAD]; }
        const float rs = r + a.in[17][ch] * (rp - r), ks = k + a.in[17][512 + ch] * (kp - k), vs = v + a.in[17][1024 + ch] * (vp - v);
        const float av = (float)RWA[(size_t)m * RW + ch];
        const float km = ks * (1.f + (av - 1.f) * a.in[24][ch]);
        const float y = YRAW[(size_t)m * RW + ch];
        const float mean = wave_sum(y) * (1.f / 64.f); const float dy = y - mean;
        const float var = wave_sum(dy * dy) * (1.f / 64.f);
        const float yn = dy * rsqrtf(var + GN_EPS) * a.in[26][ch] + a.in[27][ch];
        const float bonus = wave_sum(rs * km * a.in[25][ch]) * vs;
        OATT[(size_t)m * KOUT + 1024 + ch] = (f16)((yn + bonus) * (float)RWG[(size_t)m * RW + ch]);
    }
}

typedef short bf16x8 __attribute__((ext_vector_type(8)));
typedef _Float16 f16x4v __attribute__((ext_vector_type(4)));
__device__ __forceinline__ unsigned f2bf(float f) { unsigned u = __builtin_bit_cast(unsigned, f); return (u + 0x7fffu + ((u >> 16) & 1u)) >> 16; }
__device__ __forceinline__ unsigned pkb(float lo, float hi) { unsigned r; asm("v_cvt_pk_bf16_f32 %0, %1, %2" : "=v"(r) : "v"(lo), "v"(hi)); return r; }
constexpr int XP = 144;
constexpr int XD_OFF = 0, XA_OFF = 9216, XG_OFF = 18432, XG_P = 336;
constexpr int LAB_OFF = 0, LAK_OFF = 9216, LRB_OFF = 18432, LRK_OFF = 27648;
constexpr int AB_OFF = 39936, RB_OFF = AB_OFF + 9216, BB_OFF = RB_OFF + 9216, KB_OFF = BB_OFF + 9216;
constexpr int TT_OFF = 39936, M1T_OFF = TT_OFF + 9216, A2T_OFF = M1T_OFF + 9216, U1T_OFF = A2T_OFF + 9216;
constexpr int AH_OFF = 76800, VH_OFF = AH_OFF + 9216, BP_OFF = VH_OFF + 9216, KP_OFF = BP_OFF + 9216, RH_OFF = KP_OFF + 9216;
constexpr int NRM_OFF = 122880, CUMB_OFF = NRM_OFF + 512, XCONST_OFF = CUMB_OFF + 1024;
constexpr size_t WS_WDT = 28 * MiB, WS_WAT = WS_WDT + 65536, WS_WGT = WS_WAT + 65536;
constexpr size_t WS_RWP = 32 * MiB, WS_RWQ = 64 * MiB, WS_RWR2 = 408 * MiB, WS_RWY1 = 440 * MiB, WS_RWS0 = 472 * MiB, WS_BON = 364 * MiB;
constexpr int NUNIT = BATCH * 64 * HRW;

__device__ __forceinline__ f16x8 rd_row(LAS unsigned char* base, int pitch, int row, int col) { return *(const LAS f16x8*)(base + row * pitch + col * 2); }
__device__ __forceinline__ bf16x8 rd_rowb(LAS unsigned char* base, int pitch, int row, int col) { return *(const LAS bf16x8*)(base + row * pitch + col * 2); }
__device__ __forceinline__ f16x8 rd_tr(LAS unsigned char* base, int k0, int c0, int g, int qq, int pp) {
    const f16x4 v0 = tr_read16(base + (k0 + 8 * g + qq) * XP + (c0 + 4 * pp) * 2), v1 = tr_read16(base + (k0 + 8 * g + 4 + qq) * XP + (c0 + 4 * pp) * 2);
    return (f16x8){v0[0], v0[1], v0[2], v0[3], v1[0], v1[1], v1[2], v1[3]};
}
__device__ __forceinline__ void wr4h(LAS unsigned char* p, const f32x4& v) { u32x2 w; w.x = pkh(v[0], v[1]); w.y = pkh(v[2], v[3]); *(LAS u32x2*)p = w; }
__device__ __forceinline__ float dpp_shr_f(float x, int) { return x; }
template <int CTRL> __device__ __forceinline__ float dpp_z(float x) { return __builtin_bit_cast(float, __builtin_amdgcn_update_dpp(0, __builtin_bit_cast(int, x), CTRL, 0xF, 0xF, true)); }
__device__ __forceinline__ float row16_incl_scan(float x) { x += dpp_z<0x111>(x); x += dpp_z<0x112>(x); x += dpp_z<0x114>(x); x += dpp_z<0x118>(x); return x; }
#define MFMA_H(a, b, c) __builtin_amdgcn_mfma_f32_16x16x32_f16((a), (b), (c), 0, 0, 0)
#define MFMA_B(a, b, c) __builtin_amdgcn_mfma_f32_16x16x32_bf16((a), (b), (c), 0, 0, 0)
#define MFMA_H16(a, b, c) __builtin_amdgcn_mfma_f32_16x16x16f16((a), (b), (c), 0, 0, 0)
__device__ __forceinline__ f16x4 cvt4h(const f32x4& v) { return (f16x4){(f16)v[0], (f16)v[1], (f16)v[2], (f16)v[3]}; }
__device__ __forceinline__ f32x4 cvt4f(const f16x4& v) { return (f32x4){(float)v[0], (float)v[1], (float)v[2], (float)v[3]}; }

__device__ __forceinline__ void p7x_chunks(const Args& a, LAS unsigned char* lds, int vcu, int G, int tid, int wave, int lane) {
    unsigned char* ws = a.ws;
    const f16* PROJ = (const f16*)(ws + WS_PROJ);
    const f16* WDT = (const f16*)(ws + WS_WDT); const f16* WAT = (const f16*)(ws + WS_WAT); const f16* WGT = (const f16*)(ws + WS_WGT);
    f16* RWG = (f16*)(ws + WS_RWG); f16* RWP = (f16*)(ws + WS_RWP); f16* RWQ = (f16*)(ws + WS_RWQ); f16* RWR2 = (f16*)(ws + WS_RWR2); f16* RWY1 = (f16*)(ws + WS_RWY1);
    float* BON = (float*)(ws + WS_BON);
    const float* mu = a.in[17];
    const f32x4 z4 = {0.f, 0.f, 0.f, 0.f};
    const bool bal = (G == 256); const int bxx = blockIdx.x;
    const int nit = bal ? 16 : (NUNIT + G - 1) / G;
#define X_UNIT(itx_) (bal ? ((((bxx & 7) * 64 + (((bxx >> 3) + 32 * (itx_)) >> 3)) * 8 + (((bxx >> 3) + 32 * (itx_)) & 7))) : (vcu + (itx_) * G))
    f16x4 rv0[9], rv1c, rv1p, prc[2], pkc[2], pvc[2], prp[2], pkp[2], pvp[2];
    f16x8 wfd[2][2], wfa[2][2], wfg[2][5];
    int h_tab = -1;
#define X_PREFETCH(u_) do { int lp = lane; asm volatile("" : "+v"(lp)); const int h_ = (u_) & 7, c_ = ((u_) >> 3) & 63, b_ = (u_) >> 9; const size_t m0_ = (size_t)(b_ << 12) + c_ * 64; \
        _Pragma("unroll") for (int i = 0; i < 9; ++i) { const int t_ = 8 * wave + i - 1; const bool ok_ = (t_ >= 0 || c_ > 0); const f16* rowp = PROJ + (m0_ + t_) * IN_PAD + C_WD; \
            rv0[i] = (f16x4){0, 0, 0, 0}; if (ok_) rv0[i] = *(const f16x4*)(rowp + 4 * lp); } \
        { const int t1_ = 8 * wave + (lp >> 3); const f16* rp1 = PROJ + (m0_ + t1_) * IN_PAD + C_WD + 256 + 4 * (lp & 7); rv1c = *(const f16x4*)rp1; rv1p = (f16x4){0, 0, 0, 0}; if (t1_ > 0 || c_ > 0) rv1p = *(const f16x4*)(rp1 - IN_PAD); } \
        _Pragma("unroll") for (int ci = 0; ci < 2; ++ci) { const int chr_ = h_ * 64 + 16 * (2 * (wave >> 2) + ci) + (lp & 15); \
            _Pragma("unroll") for (int ks = 0; ks < 2; ++ks) { wfd[ci][ks] = *(const f16x8*)(WDT + (size_t)chr_ * 64 + 32 * ks + 8 * (lp >> 4)); wfa[ci][ks] = *(const f16x8*)(WAT + (size_t)chr_ * 64 + 32 * ks + 8 * (lp >> 4)); } \
            _Pragma("unroll") for (int ks = 0; ks < 5; ++ks) wfg[ci][ks] = *(const f16x8*)(WGT + (size_t)chr_ * 192 + 32 * ks + 8 * (lp >> 4)); } \
        const int t2_ = 16 * (wave & 3) + (lp & 15); const size_t m_ = m0_ + t2_; \
        _Pragma("unroll") for (int ci = 0; ci < 2; ++ci) { const int ch_ = h_ * 64 + 16 * (2 * (wave >> 2) + ci) + 4 * (lp >> 4); \
            prc[ci] = *(const f16x4*)(PROJ + m_ * IN_PAD + C_R + ch_); pkc[ci] = *(const f16x4*)(PROJ + m_ * IN_PAD + C_K + ch_); pvc[ci] = *(const f16x4*)(PROJ + m_ * IN_PAD + C_V + ch_); \
            prp[ci] = (f16x4){0, 0, 0, 0}; pkp[ci] = (f16x4){0, 0, 0, 0}; pvp[ci] = (f16x4){0, 0, 0, 0}; \
            if ((c_ * 64 + t2_) != 0) { prp[ci] = *(const f16x4*)(PROJ + (m_ - 1) * IN_PAD + C_R + ch_); pkp[ci] = *(const f16x4*)(PROJ + (m_ - 1) * IN_PAD + C_K + ch_); pvp[ci] = *(const f16x4*)(PROJ + (m_ - 1) * IN_PAD + C_V + ch_); } } } while (0)
    { const int u0 = X_UNIT(0); if (u0 < NUNIT) X_PREFETCH(u0); }
#pragma unroll 1
    for (int itx = 0; itx < nit; ++itx) {
        const int u = X_UNIT(itx); if (u >= NUNIT) break;
        const int un = (itx + 1 < nit) ? X_UNIT(itx + 1) : NUNIT;
        int lane_o = lane; asm volatile("" : "+v"(lane_o));
        const int r16 = lane_o & 15, g = lane_o >> 4, qq = r16 >> 2, pp = lane_o & 3;
        const int h = u & 7, c = (u >> 3) & 63, b = u >> 9;
        const size_t m0 = (size_t)(b << 12) + c * 64;
        lds_barrier();
        if (h != h_tab) { h_tab = h;
            if (tid < 64) { const int ch = h * 64 + tid; LAS float* ct = (LAS float*)(lds + XCONST_OFF) + tid;
                ct[0] = mu[ch]; ct[64] = mu[512 + ch]; ct[128] = mu[1024 + ch]; ct[192] = a.in[18][ch]; ct[256] = a.in[20][ch]; ct[320] = a.in[23][ch]; ct[384] = a.in[24][ch]; ct[448] = a.in[25][ch]; } }
        {
            const f32x4 mu0 = *(const f32x4*)(mu + 1536 + 4 * lane_o); const f32x4 mu1 = *(const f32x4*)(mu + 1536 + 256 + 4 * (lane_o & 7));
            const float kf = lane_o < 16 ? 2.f : 1.f; const bool is_t = lane_o < 16, is_id = (lane_o >= 16 && lane_o < 32);
            LAS unsigned char* d0 = is_t ? lds + XD_OFF + 8 * lane_o : is_id ? lds + XA_OFF + 8 * (lane_o - 16) : lds + XG_OFF + 8 * (lane_o - 32);
            const int p0 = (lane_o < 32) ? XP : XG_P;
#pragma unroll
            for (int i = 0; i < 8; ++i) { const int t = 8 * wave + i; float o[4];
#pragma unroll
                for (int e = 0; e < 4; ++e) { const float cu = (float)rv0[i + 1][e], pv = (float)rv0[i][e]; const float x = cu + mu0[e] * (pv - cu);
                    const float sg = __builtin_amdgcn_rcpf(1.f + __expf(-kf * x)); o[e] = is_t ? 2.f * sg - 1.f : is_id ? x : sg; }
                u32x2 w; w.x = pkh(o[0], o[1]); w.y = pkh(o[2], o[3]); *(LAS u32x2*)(d0 + t * p0) = w; }
            {
                float o1[4];
#pragma unroll
                for (int e = 0; e < 4; ++e) { const float cu1 = (float)rv1c[e], pv1 = (float)rv1p[e]; const float x1 = cu1 + mu1[e] * (pv1 - cu1); o1[e] = __builtin_amdgcn_rcpf(1.f + __expf(-x1)); }
                u32x2 w1; w1.x = pkh(o1[0], o1[1]); w1.y = pkh(o1[2], o1[3]); *(LAS u32x2*)(lds + XG_OFF + (8 * wave + (lane_o >> 3)) * XG_P + (128 + 4 * (lane_o & 7)) * 2) = w1; }
        }
        lds_barrier();
        const int tb = wave & 3, cth = wave >> 2;
        const int t = 16 * tb + r16; const size_t m = m0 + t;
        f32x4 dA[2], aA[2], gA[2];
#pragma unroll
        for (int ci = 0; ci < 2; ++ci) {
            dA[ci] = z4; aA[ci] = z4; gA[ci] = z4;
#pragma unroll
            for (int ks = 0; ks < 2; ++ks) {
                dA[ci] = MFMA_H(wfd[ci][ks], rd_row(lds + XD_OFF, XP, t, 32 * ks + 8 * g), dA[ci]);
                aA[ci] = MFMA_H(wfa[ci][ks], rd_row(lds + XA_OFF, XP, t, 32 * ks + 8 * g), aA[ci]); }
#pragma unroll
            for (int ks = 0; ks < 5; ++ks) gA[ci] = MFMA_H(wfg[ci][ks], rd_row(lds + XG_OFF, XG_P, t, 32 * ks + 8 * g), gA[ci]);
        }
        float lwv[2][4], asg[2][4], rs[2][4], kp[2][4], vs[2][4], kkv[2][4], cl[2][4];
        float pn = 0.f, prk = 0.f;
#pragma unroll
        for (int ci = 0; ci < 2; ++ci) {
            const int chl = 16 * (2 * cth + ci) + 4 * g, ch = h * 64 + chl;
            const f16x4 rc = prc[ci], kc = pkc[ci], vc = pvc[ci], rp = prp[ci], kq = pkp[ci], vp = pvp[ci];
            const LAS float* ct = (const LAS float*)(lds + XCONST_OFF) + chl;
            const f32x4 mur = *(const LAS f32x4*)(ct), muk = *(const LAS f32x4*)(ct + 64), muv = *(const LAS f32x4*)(ct + 128);
            const f32x4 w0 = *(const LAS f32x4*)(ct + 192), a0 = *(const LAS f32x4*)(ct + 256), kkc = *(const LAS f32x4*)(ct + 320), kac = *(const LAS f32x4*)(ct + 384), rkc = *(const LAS f32x4*)(ct + 448);
            float gl[4];
#pragma unroll
            for (int e = 0; e < 4; ++e) {
                const float z = -(w0[e] + dA[ci][e]); const float sp = fmaxf(z, 0.f) + __logf(1.f + __expf(-fabsf(z)));
                lwv[ci][e] = -__expf(-sp - 0.5f);
                asg[ci][e] = sigmoidf_(a0[e] + aA[ci][e]); gl[e] = gA[ci][e];
                rs[ci][e] = (float)rc[e] + mur[e] * ((float)rp[e] - (float)rc[e]);
                const float ks_ = (float)kc[e] + muk[e] * ((float)kq[e] - (float)kc[e]);
                vs[ci][e] = (float)vc[e] + muv[e] * ((float)vp[e] - (float)vc[e]);
                kkv[ci][e] = ks_ * kkc[e]; pn += kkv[ci][e] * kkv[ci][e];
                kp[ci][e] = ks_ * (1.f + (asg[ci][e] - 1.f) * kac[e]);
                prk += rs[ci][e] * kp[ci][e] * rkc[e];
                cl[ci][e] = row16_incl_scan(lwv[ci][e]);
                if (r16 == 15) ((LAS float*)(lds + CUMB_OFF))[tb * 64 + chl + e] = cl[ci][e];
            }
            u32x2 gw; gw.x = pkh(gl[0], gl[1]); gw.y = pkh(gl[2], gl[3]); *(u32x2*)(RWG + m * RW + ch) = gw;
        }
        pn += __shfl_xor(pn, 16); pn += __shfl_xor(pn, 32); prk += __shfl_xor(prk, 16); prk += __shfl_xor(prk, 32);
        if (g == 0) { ((LAS float*)(lds + NRM_OFF))[t * 2 + cth] = pn; BON[((size_t)u * 64 + t) * 2 + cth] = prk; }
        lds_barrier();
        {
            const float nrm = sqrtf(((LAS float*)(lds + NRM_OFF))[t * 2] + ((LAS float*)(lds + NRM_OFF))[t * 2 + 1]); const float inrm = __builtin_amdgcn_rcpf(fmaxf(nrm, 1e-12f));
#pragma unroll
            for (int ci = 0; ci < 2; ++ci) {
                const int chl = 16 * (2 * cth + ci) + 4 * g;
                float Ab[4], Rb[4], Bb[4], Kb[4], Bp[4], Kp[4];
                const LAS float* cbp = (const LAS float*)(lds + CUMB_OFF) + chl;
                const f32x4 cb0 = *(const LAS f32x4*)(cbp), cb1 = *(const LAS f32x4*)(cbp + 64), cb2 = *(const LAS f32x4*)(cbp + 128), cb3 = *(const LAS f32x4*)(cbp + 192);
#pragma unroll
                for (int e = 0; e < 4; ++e) {
                    const float b0 = cb0[e], b1 = cb1[e], b2 = cb2[e], b3 = cb3[e];
                    const float pre = (tb > 0 ? b0 : 0.f) + (tb > 1 ? b1 : 0.f) + (tb > 2 ? b2 : 0.f);
                    const float cum = cl[ci][e] + pre, cumC = (b0 + b1) + (b2 + b3);
                    const float kkn = kkv[ci][e] * inrm, av = -kkn, bv = kkn * asg[ci][e];
                    const float eg = __expf(cum), egi = __expf(-cum), egc = __expf(cumC - cum);
                    Ab[e] = av * __expf(cum - lwv[ci][e]); Rb[e] = rs[ci][e] * eg; Bb[e] = bv * egi; Kb[e] = kp[ci][e] * egi; Bp[e] = bv * egc; Kp[e] = kp[ci][e] * egc;
                }
                const int ro = t * XP + chl * 2;
                u32x2 w;
                w.x = pkb(Ab[0], Ab[1]); w.y = pkb(Ab[2], Ab[3]); *(LAS u32x2*)(lds + AB_OFF + ro) = w;
                w.x = pkb(Rb[0], Rb[1]); w.y = pkb(Rb[2], Rb[3]); *(LAS u32x2*)(lds + RB_OFF + ro) = w;
                w.x = pkb(Bb[0], Bb[1]); w.y = pkb(Bb[2], Bb[3]); *(LAS u32x2*)(lds + BB_OFF + ro) = w;
                w.x = pkb(Kb[0], Kb[1]); w.y = pkb(Kb[2], Kb[3]); *(LAS u32x2*)(lds + KB_OFF + ro) = w;
                w.x = pkh(Ab[0], Ab[1]); w.y = pkh(Ab[2], Ab[3]); *(LAS u32x2*)(lds + AH_OFF + ro) = w;
                w.x = pkh(Rb[0], Rb[1]); w.y = pkh(Rb[2], Rb[3]); *(LAS u32x2*)(lds + RH_OFF + ro) = w;
                w.x = pkh(vs[ci][0], vs[ci][1]); w.y = pkh(vs[ci][2], vs[ci][3]); *(LAS u32x2*)(lds + VH_OFF + ro) = w;
                w.x = pkh(Bp[0], Bp[1]); w.y = pkh(Bp[2], Bp[3]); *(LAS u32x2*)(lds + BP_OFF + ro) = w;
                w.x = pkh(Kp[0], Kp[1]); w.y = pkh(Kp[2], Kp[3]); *(LAS u32x2*)(lds + KP_OFF + ro) = w;
            }
        }
        lds_barrier();
#pragma unroll 1
        for (int k = 0; k < 5; ++k) {
            const int idx = wave + 8 * k, prod = idx / 10, rem = idx - prod * 10;
            const int tb1 = rem >= 6 ? 3 : rem >= 3 ? 2 : rem >= 1 ? 1 : 0, ub = rem - (tb1 * (tb1 + 1)) / 2;
            LAS unsigned char* X = lds + ((prod < 2) ? AB_OFF : RB_OFF); LAS unsigned char* Y = lds + ((prod & 1) ? KB_OFF : BB_OFF);
            f32x4 acc = z4;
#pragma unroll
            for (int ks = 0; ks < 2; ++ks) acc = MFMA_B(rd_rowb(Y, XP, 16 * ub + r16, 32 * ks + 8 * g), rd_rowb(X, XP, 16 * tb1 + r16, 32 * ks + 8 * g), acc);
            const int tt = 16 * tb1 + r16, tau0 = 16 * ub + 4 * g; const int lim = (prod < 2) ? tt : tt + 1;
#pragma unroll
            for (int e = 0; e < 4; ++e) if (tau0 + e >= lim) acc[e] = 0.f;
            wr4h(lds + LAB_OFF + prod * 9216 + tt * XP + tau0 * 2, acc);
        }
#pragma unroll 1
        for (int k = 0; k < 3; ++k) {
            const int idx = wave + 8 * k, prod = idx / 6, rem = idx - prod * 6;
            const int tb1 = rem >= 5 ? 2 : rem >= 3 ? 1 : 0, ub = (rem >= 5) ? 3 : (rem >= 3) ? rem - 1 : rem + 1;
            wr4h(lds + LAB_OFF + prod * 9216 + (16 * tb1 + r16) * XP + (16 * ub + 4 * g) * 2, z4);
        }
        lds_barrier();
        if (wave == 0) {
            LAS unsigned char* L = lds + LAB_OFF; LAS unsigned char* TT = lds + TT_OFF;
            f32x4 TB[4][4]; f16x4 TAh[4];
            float idn[4];
#pragma unroll
            for (int e = 0; e < 4; ++e) idn[e] = (r16 == 4 * g + e) ? 1.f : 0.f;
#pragma unroll
            for (int i = 0; i < 4; ++i) {
                f16x4 XA = *(const LAS f16x4*)(L + (16 * i + r16) * XP + (16 * i + 4 * g) * 2);
                f16x4 XB = tr_read16(L + (16 * i + 4 * g + qq) * XP + (16 * i + 4 * pp) * 2);
                f32x4 TAf, TBf;
#pragma unroll
                for (int e = 0; e < 4; ++e) { TAf[e] = idn[e] + (float)XA[e]; TBf[e] = idn[e] + (float)XB[e]; }
#pragma unroll
                for (int lv = 0; lv < 3; ++lv) {
                    const f32x4 X2B = MFMA_H16(XA, XB, z4), X2A = MFMA_H16(XB, XA, z4);
                    XA = cvt4h(X2A); XB = cvt4h(X2B);
                    const f16x4 ta = cvt4h(TAf);
                    TBf = MFMA_H16(ta, XB, TBf); TAf = MFMA_H16(XB, ta, TAf);
                }
                TB[i][i] = TBf; TAh[i] = cvt4h(TAf);
            }
#pragma unroll
            for (int d = 1; d < 4; ++d)
#pragma unroll
                for (int j = 0; j + d < 4; ++j) { const int i = j + d;
                    f32x4 M = z4;
#pragma unroll
                    for (int kq2 = j; kq2 < i; ++kq2) M = MFMA_H16(*(const LAS f16x4*)(L + (16 * i + r16) * XP + (16 * kq2 + 4 * g) * 2), cvt4h(TB[kq2][j]), M);
                    TB[i][j] = MFMA_H16(TAh[i], cvt4h(M), z4);
                }
#pragma unroll
            for (int i = 0; i < 4; ++i)
#pragma unroll
                for (int j = 0; j < 4; ++j) wr4h(TT + (16 * j + r16) * XP + (16 * i + 4 * g) * 2, (j <= i) ? TB[i][j] : z4);
        } else {
#pragma unroll 1
            for (int idx = wave - 1; idx < 16; idx += 7) { const int tb1 = idx >> 2, ib = idx & 3;
                f32x4 acc = z4;
#pragma unroll
                for (int ks = 0; ks < 2; ++ks) acc = MFMA_H(rd_row(lds + LAK_OFF, XP, 16 * tb1 + r16, 32 * ks + 8 * g), rd_tr(lds + VH_OFF, 32 * ks, 16 * ib, g, qq, pp), acc);
                wr4h(lds + M1T_OFF + (16 * ib + r16) * XP + (16 * tb1 + 4 * g) * 2, acc);
            }
        }
        lds_barrier();
#pragma unroll
        for (int k = 0; k < 4; ++k) {
            const int which = k >> 1, tb1 = 2 * (k & 1) + (wave >> 2), nb = wave & 3;
            f32x4 acc = z4;
#pragma unroll
            for (int ks = 0; ks < 2; ++ks) {
                const f16x8 af = rd_tr(lds + TT_OFF, 32 * ks, 16 * tb1, g, qq, pp);
                const f16x8 bf = which ? rd_row(lds + M1T_OFF, XP, 16 * nb + r16, 32 * ks + 8 * g) : rd_tr(lds + AH_OFF, 32 * ks, 16 * nb, g, qq, pp);
                acc = MFMA_H(af, bf, acc);
            }
            wr4h(lds + (which ? U1T_OFF : A2T_OFF) + (16 * nb + r16) * XP + (16 * tb1 + 4 * g) * 2, acc);
        }
        lds_barrier();
        if (un < NUNIT) X_PREFETCH(un);
#pragma unroll
        for (int k = 0; k < 8; ++k) {
            const int kind = k >> 1, a4 = 2 * (k & 1) + (wave >> 2), b4 = wave & 3;
            f32x4 acc = z4;
            if (kind == 0) {
#pragma unroll
                for (int ks = 0; ks < 2; ++ks) acc = MFMA_H(rd_row(lds + A2T_OFF, XP, 16 * a4 + r16, 32 * ks + 8 * g), rd_tr(lds + BP_OFF, 32 * ks, 16 * b4, g, qq, pp), acc);
                if (a4 == b4) { const LAS float* cb = (const LAS float*)(lds + CUMB_OFF) + 16 * b4 + r16; const float gC = __expf((cb[0] + cb[64]) + (cb[128] + cb[192]));
#pragma unroll
                    for (int e = 0; e < 4; ++e) if (4 * g + e == r16) acc[e] += gC; }
                u32x2 w; w.x = pkh(acc[0], acc[1]); w.y = pkh(acc[2], acc[3]);
                *(u32x2*)(RWP + (size_t)u * 4096 + ((b4 * 2 + (a4 >> 1)) * 64 + lane_o) * 8 + (a4 & 1) * 4) = w;
            } else if (kind == 1) {
#pragma unroll
                for (int ks = 0; ks < 2; ++ks) { acc = MFMA_H(rd_tr(lds + BP_OFF, 32 * ks, 16 * a4, g, qq, pp), rd_row(lds + U1T_OFF, XP, 16 * b4 + r16, 32 * ks + 8 * g), acc);
                    acc = MFMA_H(rd_tr(lds + KP_OFF, 32 * ks, 16 * a4, g, qq, pp), rd_tr(lds + VH_OFF, 32 * ks, 16 * b4, g, qq, pp), acc); }
                u32x2 w; w.x = pkh(acc[0], acc[1]); w.y = pkh(acc[2], acc[3]);
                *(u32x2*)(RWQ + (size_t)u * 4096 + ((b4 * 4 + a4) * 64 + lane_o) * 4) = w;
            } else if (kind == 2) {
                { const f16x4 rh4 = *(const LAS f16x4*)(lds + RH_OFF + (16 * b4 + r16) * XP + (16 * a4 + 4 * g) * 2); acc = cvt4f(rh4); }
#pragma unroll
                for (int ks = 0; ks < 2; ++ks) acc = MFMA_H(rd_row(lds + A2T_OFF, XP, 16 * a4 + r16, 32 * ks + 8 * g), rd_row(lds + LRB_OFF, XP, 16 * b4 + r16, 32 * ks + 8 * g), acc);
                u32x2 w; w.x = pkh(acc[0], acc[1]); w.y = pkh(acc[2], acc[3]);
                *(u32x2*)(RWR2 + (size_t)u * 4096 + (16 * b4 + r16) * 64 + 16 * a4 + 4 * g) = w;
            } else {
#pragma unroll
                for (int ks = 0; ks < 2; ++ks) { acc = MFMA_H(rd_row(lds + U1T_OFF, XP, 16 * a4 + r16, 32 * ks + 8 * g), rd_row(lds + LRB_OFF, XP, 16 * b4 + r16, 32 * ks + 8 * g), acc);
                    acc = MFMA_H(rd_tr(lds + VH_OFF, 32 * ks, 16 * a4, g, qq, pp), rd_row(lds + LRK_OFF, XP, 16 * b4 + r16, 32 * ks + 8 * g), acc); }
                u32x2 w; w.x = pkh(acc[0], acc[1]); w.y = pkh(acc[2], acc[3]);
                *(u32x2*)(RWY1 + (size_t)u * 4096 + ((a4 * 4 + b4) * 64 + lane_o) * 4) = w;
            }
        }
    }
}

#undef X_UNIT
#undef X_PREFETCH
struct ChBuf { f16x8 p[4][2]; u32x2 q[4]; };
__device__ __forceinline__ void p7y_chain(const Args& a, int bx0, int G, int wave, int lane) {
    unsigned char* ws = a.ws;
    const f16* RWP = (const f16*)(ws + WS_RWP); const f16* RWQ = (const f16*)(ws + WS_RWQ); f16* RWS0 = (f16*)(ws + WS_RWS0);
    if (wave != 0) return;
#pragma unroll 1
    for (int bx = bx0; bx < 256; bx += G) {
    const int r16 = lane & 15, g = lane >> 4;
    const int b = bx & 7, rest = bx >> 3, h = rest >> 2, it = rest & 3;
    f32x4 S[4];
#pragma unroll
    for (int mt = 0; mt < 4; ++mt) S[mt] = (f32x4){0.f, 0.f, 0.f, 0.f};
    ChBuf B0, B1, B2, B3;
#define CH_LOAD(BUF, c_) do { const size_t uu = ((size_t)(b * 64 + (c_)) * 8 + h); \
        _Pragma("unroll") for (int mo = 0; mo < 4; ++mo) { BUF.q[mo] = *(const u32x2*)(RWQ + uu * 4096 + ((it * 4 + mo) * 64 + lane) * 4); \
            _Pragma("unroll") for (int ks = 0; ks < 2; ++ks) BUF.p[mo][ks] = *(const f16x8*)(RWP + uu * 4096 + ((mo * 2 + ks) * 64 + lane) * 8); } } while (0)
#define CH_STEP(BUF, c_) do { const size_t uu = ((size_t)(b * 64 + (c_)) * 8 + h); f16x8 bfr[2]; \
        _Pragma("unroll") for (int mt = 0; mt < 4; ++mt) { u32x2 w; w.x = pkh(S[mt][0], S[mt][1]); w.y = pkh(S[mt][2], S[mt][3]); \
            *(u32x2*)(RWS0 + uu * 4096 + (16 * it + r16) * 64 + 16 * mt + 4 * g) = w; const f16x4 hv = __builtin_bit_cast(f16x4, w); \
            bfr[mt >> 1][(mt & 1) * 4 + 0] = hv[0]; bfr[mt >> 1][(mt & 1) * 4 + 1] = hv[1]; bfr[mt >> 1][(mt & 1) * 4 + 2] = hv[2]; bfr[mt >> 1][(mt & 1) * 4 + 3] = hv[3]; } \
        _Pragma("unroll") for (int mo = 0; mo < 4; ++mo) { f32x4 n_ = cvt4f(__builtin_bit_cast(f16x4, BUF.q[mo])); \
            _Pragma("unroll") for (int ks = 0; ks < 2; ++ks) n_ = MFMA_H(BUF.p[mo][ks], bfr[ks], n_); S[mo] = n_; } \
        if ((c_) + 4 < 64) CH_LOAD(BUF, (c_) + 4); } while (0)
    CH_LOAD(B0, 0); CH_LOAD(B1, 1); CH_LOAD(B2, 2); CH_LOAD(B3, 3);
#pragma unroll 1
    for (int c = 0; c < 64; c += 4) { CH_STEP(B0, c); CH_STEP(B1, c + 1); CH_STEP(B2, c + 2); CH_STEP(B3, c + 3); }
    }
#undef CH_LOAD
#undef CH_STEP
}

__device__ __forceinline__ void p8z_out(const Args& a, int vcu, int G, int wave, int lane) {
    unsigned char* ws = a.ws;
    const f16* PROJ = (const f16*)(ws + WS_PROJ); const f16* RWG = (const f16*)(ws + WS_RWG);
    const f16* RWR2 = (const f16*)(ws + WS_RWR2); const f16* RWY1 = (const f16*)(ws + WS_RWY1); const f16* RWS0 = (const f16*)(ws + WS_RWS0);
    const float* BON = (const float*)(ws + WS_BON); f16* OATT = (f16*)(ws + WS_OATT);
    const int gw = vcu * NWAVES + wave, NGW = G * NWAVES;
    const bool bal = (G == 256); const int bxx = blockIdx.x;
    const int nit = bal ? 2 : (NUNIT + NGW - 1) / NGW;
#pragma unroll 1
    for (int itx = 0; itx < nit; ++itx) {
        int u;
        if (bal) { const int idx = (bxx >> 3) * 8 + wave + 256 * itx; u = (((bxx & 7) * 64 + (idx >> 3)) * 8 + (idx & 7)); } else { u = gw + itx * NGW; if (u >= NUNIT) break; }
        int lane_o = lane; asm volatile("" : "+v"(lane_o));
        const int r16 = lane_o & 15, g = lane_o >> 4;
        const int h = u & 7, c = (u >> 3) & 63, b = u >> 9;
        const size_t m0 = (size_t)(b << 12) + c * 64;
        f32x4 acc[4][4];
#pragma unroll
        for (int mt = 0; mt < 4; ++mt)
#pragma unroll
            for (int nt = 0; nt < 4; ++nt) acc[mt][nt] = cvt4f(*(const f16x4*)(RWY1 + (size_t)u * 4096 + ((mt * 4 + nt) * 64 + lane_o) * 4));
#pragma unroll
        for (int ks = 0; ks < 2; ++ks) {
            f16x8 sf[4], rf[4];
#pragma unroll
            for (int x = 0; x < 4; ++x) { sf[x] = *(const f16x8*)(RWS0 + (size_t)u * 4096 + (16 * x + r16) * 64 + 32 * ks + 8 * g); rf[x] = *(const f16x8*)(RWR2 + (size_t)u * 4096 + (16 * x + r16) * 64 + 32 * ks + 8 * g); }
#pragma unroll
            for (int mt = 0; mt < 4; ++mt)
#pragma unroll
                for (int nt = 0; nt < 4; ++nt) acc[mt][nt] = MFMA_H(sf[mt], rf[nt], acc[mt][nt]);
        }
#pragma unroll
        for (int nt = 0; nt < 4; ++nt) {
            const int t = 16 * nt + r16; const size_t m = m0 + t;
            float s = 0.f;
#pragma unroll
            for (int mt = 0; mt < 4; ++mt) s += (acc[mt][nt][0] + acc[mt][nt][1]) + (acc[mt][nt][2] + acc[mt][nt][3]);
            s += __shfl_xor(s, 16); s += __shfl_xor(s, 32);
            const float mean = s * (1.f / 64.f); float q = 0.f;
#pragma unroll
            for (int mt = 0; mt < 4; ++mt)
#pragma unroll
                for (int e = 0; e < 4; ++e) { const float d = acc[mt][nt][e] - mean; q += d * d; }
            q += __shfl_xor(q, 16); q += __shfl_xor(q, 32);
            const float rstd = rsqrtf(q * (1.f / 64.f) + GN_EPS);
            const f32x2 bo = *(const f32x2*)(BON + ((size_t)u * 64 + t) * 2); const float bonus = bo[0] + bo[1];
#pragma unroll
            for (int mt = 0; mt < 4; ++mt) {
                const int ch = h * 64 + 16 * mt + 4 * g;
                const f16x4 vc = *(const f16x4*)(PROJ + m * IN_PAD + C_V + ch);
                f16x4 vp = {0, 0, 0, 0}; if ((c * 64 + t) != 0) vp = *(const f16x4*)(PROJ + (m - 1) * IN_PAD + C_V + ch);
                const f32x4 muv = *(const f32x4*)(a.in[17] + 1024 + ch), gn = *(const f32x4*)(a.in[26] + ch), bs = *(const f32x4*)(a.in[27] + ch);
                const f16x4 gg = *(const f16x4*)(RWG + m * RW + ch);
                float o[4];
#pragma unroll
                for (int e = 0; e < 4; ++e) { const float vsv = (float)vc[e] + muv[e] * ((float)vp[e] - (float)vc[e]);
                    o[e] = ((acc[mt][nt][e] - mean) * rstd * gn[e] + bs[e] + bonus * vsv) * (float)gg[e]; }
                u32x2 w; w.x = pkh(o[0], o[1]); w.y = pkh(o[2], o[3]);
                *(u32x2*)(OATT + m * KOUT + 1024 + ch) = w;
            }
        }
    }
}

__device__ __forceinline__ f16* x1_row(unsigned char* ws, int m) { return (f16*)(ws + ((m < 16384) ? WS_RWG : (WS_RWS0 - (size_t)16384 * 2048)) + (size_t)m * 2048); }
__device__ __forceinline__ void p10_mid(const Args& a, int vcu, int G, int wave, int lane) {
    unsigned char* ws = a.ws;
    const f16* MIX = (const f16*)(ws + WS_MIX); const float* mod = (const float*)(ws + WS_MOD); f16* HF = (f16*)(ws + WS_H);
    const int gw = vcu * NWAVES + wave, NGW = G * NWAVES;
    float g6[16], g7[16];
#pragma unroll
    for (int j = 0; j < 2; ++j) { const int c = 8 * lane + 512 * j;
        const f32x4 p0 = *(const f32x4*)(a.in[6] + c), p1 = *(const f32x4*)(a.in[6] + c + 4), q0 = *(const f32x4*)(a.in[7] + c), q1 = *(const f32x4*)(a.in[7] + c + 4);
#pragma unroll
        for (int e = 0; e < 4; ++e) { g6[8 * j + e] = p0[e]; g6[8 * j + 4 + e] = p1[e]; g7[8 * j + e] = q0[e]; g7[8 * j + 4 + e] = q1[e]; } }
    for (int m = gw; m < MTOK; m += NGW) {
        const int b = m >> 12; const float* md = mod + b * 6144;
        float mx[16], xv[16]; float s = 0.f;
#pragma unroll
        for (int j = 0; j < 2; ++j) { const int c = 8 * lane + 512 * j; const f16x8 v = *(const f16x8*)(MIX + (size_t)m * D + c);
#pragma unroll
            for (int e = 0; e < 8; ++e) { mx[8 * j + e] = (float)v[e]; s += mx[8 * j + e] * mx[8 * j + e]; }
            const f32x4 x0 = *(const f32x4*)(a.in[0] + (size_t)m * D + c), x1 = *(const f32x4*)(a.in[0] + (size_t)m * D + c + 4);
#pragma unroll
            for (int e = 0; e < 4; ++e) { xv[8 * j + e] = x0[e]; xv[8 * j + 4 + e] = x1[e]; } }
        const float r = rsqrtf(wave_sum(s) * (1.f / D) + NORM_EPS);
        float s1 = 0.f;
        f16* x1r = x1_row(ws, m);
#pragma unroll
        for (int j = 0; j < 2; ++j) { const int c = 8 * lane + 512 * j;
            const f32x4 gm0 = *(const f32x4*)(md + 2048 + c), gm1 = *(const f32x4*)(md + 2048 + c + 4);
#pragma unroll
            for (int e = 0; e < 8; ++e) { const float gm = e < 4 ? gm0[e & 3] : gm1[e & 3]; const float x1 = xv[8 * j + e] + gm * (mx[8 * j + e] * r * g6[8 * j + e]); xv[8 * j + e] = x1; s1 += x1 * x1; }
            u32x4 w; w.x = pkh(xv[8 * j], xv[8 * j + 1]); w.y = pkh(xv[8 * j + 2], xv[8 * j + 3]); w.z = pkh(xv[8 * j + 4], xv[8 * j + 5]); w.w = pkh(xv[8 * j + 6], xv[8 * j + 7]);
            *(u32x4*)(x1r + c) = w; }
        const float r1 = rsqrtf(wave_sum(s1) * (1.f / D) + NORM_EPS);
#pragma unroll
        for (int j = 0; j < 2; ++j) { const int c = 8 * lane + 512 * j; float y[8];
            const f32x4 sc0 = *(const f32x4*)(md + 4096 + c), sc1 = *(const f32x4*)(md + 4096 + c + 4), sh0 = *(const f32x4*)(md + 3072 + c), sh1 = *(const f32x4*)(md + 3072 + c + 4);
#pragma unroll
            for (int e = 0; e < 8; ++e) { const float sc = e < 4 ? sc0[e & 3] : sc1[e & 3], sh = e < 4 ? sh0[e & 3] : sh1[e & 3]; y[e] = xv[8 * j + e] * r1 * g7[8 * j + e] * (1.f + sc) + sh; }
            u32x4 w; w.x = pkh(y[0], y[1]); w.y = pkh(y[2], y[3]); w.z = pkh(y[4], y[5]); w.w = pkh(y[6], y[7]);
            *(u32x4*)(HF + (size_t)m * D + c) = w; }
    }
}
__device__ __forceinline__ void p13_final(const Args& a, int vcu, int G, int wave, int lane) {
    unsigned char* ws = a.ws;
    const f16* F = (const f16*)(ws + WS_F); const float* mod = (const float*)(ws + WS_MOD);
    const int gw = vcu * NWAVES + wave, NGW = G * NWAVES;
    float g8[16];
#pragma unroll
    for (int j = 0; j < 2; ++j) { const int c = 8 * lane + 512 * j; const f32x4 p0 = *(const f32x4*)(a.in[8] + c), p1 = *(const f32x4*)(a.in[8] + c + 4);
#pragma unroll
        for (int e = 0; e < 4; ++e) { g8[8 * j + e] = p0[e]; g8[8 * j + 4 + e] = p1[e]; } }
    for (int m = gw; m < MTOK; m += NGW) {
        const int b = m >> 12; const float* md = mod + b * 6144;
        float fv[16]; float s = 0.f;
        f16x8 xh[2];
        const f16* x1r = x1_row(ws, m);
#pragma unroll
        for (int j = 0; j < 2; ++j) { const int c = 8 * lane + 512 * j; const f16x8 v = *(const f16x8*)(F + (size_t)m * D + c); xh[j] = *(const f16x8*)(x1r + c);
#pragma unroll
            for (int e = 0; e < 8; ++e) { fv[8 * j + e] = (float)v[e]; s += fv[8 * j + e] * fv[8 * j + e]; } }
        const float r = rsqrtf(wave_sum(s) * (1.f / D) + NORM_EPS);
#pragma unroll
        for (int j = 0; j < 2; ++j) { const int c = 8 * lane + 512 * j;
            const f32x4 gf0 = *(const f32x4*)(md + 5120 + c), gf1 = *(const f32x4*)(md + 5120 + c + 4);
            f32x4 o0, o1;
#pragma unroll
            for (int e = 0; e < 4; ++e) { o0[e] = (float)xh[j][e] + gf0[e] * (fv[8 * j + e] * r * g8[8 * j + e]); o1[e] = (float)xh[j][4 + e] + gf1[e] * (fv[8 * j + 4 + e] * r * g8[8 * j + 4 + e]); }
            *(f32x4*)(a.out + (size_t)m * D + c) = o0; *(f32x4*)(a.out + (size_t)m * D + c + 4) = o1; }
    }
}

constexpr int NPHASE = 14;
__global__ void __launch_bounds__(NWAVES * 64, 2) fwd(Args args) {
    extern __shared__ __attribute__((aligned(16))) unsigned char lds_raw[];
    LAS unsigned char* lds = (LAS unsigned char*)lds_raw;
    const int tid = threadIdx.x, lane = tid & 63, wave = __builtin_amdgcn_readfirstlane(tid >> 6);
    const int G = gridDim.x; const int bx = blockIdx.x; const int vcu = (G % 8 == 0) ? (bx % 8) * (G / 8) + bx / 8 : bx;
    volatile LAS unsigned* MISC = (volatile LAS unsigned*)(lds + MISC_OFF);
    if (tid < 16) MISC[tid] = 0u;
    __syncthreads();
    const int lo = args.ph_lo, hi = args.ph_hi;
    unsigned* barw = (unsigned*)(args.ws + WS_CTL) + CW_BAR;
    XcdBarrier bar; bar.bar = barw; bar.x = 0; bar.st = nullptr;
    if (hi - lo > 1) bar = xcd_barrier_post(barw, MISC);
#ifndef PHMASK
#define PHMASK 0x3FFF
#endif
#ifndef REPMASK
#define REPMASK 0
#endif
#define IN(k) (((PHMASK >> (k)) & 1) && lo <= (k) && (k) < hi)
#define REP(k) for (int rep_ = 0; rep_ < (((REPMASK >> (k)) & 1) ? 2 : 1); ++rep_)
#ifndef BARREP
#define BARREP 1
#endif
#define SEAM(k) do { if (IN(k) && IN((k) + 1)) for (int br_ = 0; br_ < BARREP; ++br_) xcd_barrier(bar); } while (0)
    unsigned char* ws = args.ws;
    if (IN(0)) REP(0) { if (rep_) __syncthreads(); p0_prologue(args, lds, vcu, G, wave, lane); } SEAM(0);
    if (IN(1)) REP(1) { if (rep_) __syncthreads(); p1_modnorm(args, vcu, G, wave, lane); } SEAM(1);
    if (IN(2)) REP(2) { if (rep_) __syncthreads(); pg8::Gemm g{(const f16*)(ws + WS_H), (const f16*)(ws + WS_WIN), MTOK, IN_PAD, D}; pg8::StaticOrder S; S.init(MTOK, IN_PAD, G, bx);
        pg8::EpiF16 E{(f16*)(ws + WS_PROJ), IN_PAD}; pg8::gemm_phase<pg8::EpiF16, pg8::StaticOrder, true, true>(lds, g, S, E); } SEAM(2);
#ifdef OLD_BASELINE
    if (IN(5)) REP(5) { if (rep_) __syncthreads(); p5_indexer(args, lds, vcu, G, wave, lane); } SEAM(5);
    if (IN(6)) REP(6) { if (rep_) __syncthreads(); p6_attention(args, lds, vcu, G, wave, lane); p3_rwkv_prep(args, lds, vcu, G, tid); } SEAM(6);
    if (IN(7)) REP(7) { if (rep_) __syncthreads(); p7_scan(args, lds, vcu, G, wave, lane); } SEAM(7);
    if (IN(8)) REP(8) { if (rep_) __syncthreads(); p8_rwkv_post(args, vcu, G, wave, lane); } SEAM(8);
#else
#define SEAMX() do { if (hi - lo > 1) for (int br_ = 0; br_ < BARREP; ++br_) xcd_barrier(bar); } while (0)
    if (IN(3)) REP(3) { if (rep_) __syncthreads(); p3_rows(args, vcu, G, wave, lane); }
    if (IN(6)) REP(6) { __syncthreads(); p7x_chunks(args, lds, vcu, G, tid, wave, lane); } SEAMX();
    if (IN(4)) REP(4) { if (rep_) __syncthreads(); pg8::Gemm g{(const f16*)(ws + WS_CQ), (const f16*)(ws + WS_WCQ), MTOK, NQI, QL}; pg8::StaticOrder S; S.init(MTOK, NQI, G, bx);
        pg8::EpiF16 E{(f16*)args.out, NQI}; pg8::gemm_phase<pg8::EpiF16, pg8::StaticOrder, true, true>(lds, g, S, E); }
    if (IN(7)) REP(7) { __syncthreads(); p7y_chain(args, bx, G, wave, lane); } SEAMX();
    if (IN(5)) REP(5) { if (rep_) __syncthreads(); p5_dsa(args, lds, G, bx, tid, wave, lane); }
    if (IN(8)) REP(8) { __syncthreads(); p8z_out(args, vcu, G, wave, lane); } SEAMX();
#endif
    if (IN(9)) REP(9) { if (rep_) __syncthreads(); pg8::Gemm g{(const f16*)(ws + WS_OATT), (const f16*)(ws + WS_WOUT), MTOK, D, KOUT}; pg8::StaticOrder S; S.init(MTOK, D, G, bx);
        pg8::EpiF16 E{(f16*)(ws + WS_MIX), D}; pg8::gemm_phase<pg8::EpiF16, pg8::StaticOrder, true, true>(lds, g, S, E); } SEAM(9);
    if (IN(10)) REP(10) { if (rep_) __syncthreads(); p10_mid(args, vcu, G, wave, lane); } SEAM(10);
    if (IN(11)) REP(11) { if (rep_) __syncthreads(); pg8::Gemm g{(const f16*)(ws + WS_H), (const f16*)(ws + WS_WGU), MTOK, 2 * DFF, D}; pg8::StaticOrder S; S.init(MTOK, 2 * DFF, G, bx);
        pg8::EpiSwiGLU E{(f16*)(ws + WS_ACT), DFF}; pg8::gemm_phase<pg8::EpiSwiGLU, pg8::StaticOrder, true, true>(lds, g, S, E); } SEAM(11);
    if (IN(12)) REP(12) { if (rep_) __syncthreads(); pg8::Gemm g{(const f16*)(ws + WS_ACT), (const f16*)(ws + WS_WDN), MTOK, D, DFF}; pg8::StaticOrder S; S.init(MTOK, D, G, bx);
        pg8::EpiF16 E{(f16*)(ws + WS_F), D}; pg8::gemm_phase<pg8::EpiF16, pg8::StaticOrder, true, true>(lds, g, S, E); } SEAM(12);
    if (IN(13)) REP(13) { if (rep_) __syncthreads(); p13_final(args, vcu, G, wave, lane); }
#undef IN
#undef SEAM
}

#ifndef N_LAUNCH_MODE
#define N_LAUNCH_MODE 1
#endif
extern "C" void kernel_launch(void* const* d_in, const int* in_sizes, int n_in, void* d_out, int out_size, void* d_ws, size_t ws_size, hipStream_t stream) {
    static int grid = 0;
    if (grid == 0) {
        int dev = 0, cus = 0, per_cu = 0;
        if (n_in != 32 || ws_size < WS_END) { fprintf(stderr, "kernel_launch: unexpected n_in %d or ws_size %zu (< %zu)\n", n_in, ws_size, (size_t)WS_END); }
        if (hipGetDevice(&dev) != hipSuccess || hipDeviceGetAttribute(&cus, hipDeviceAttributeMultiprocessorCount, dev) != hipSuccess) { grid = -1; return; }
        if (hipFuncSetAttribute((const void*)fwd, hipFuncAttributeMaxDynamicSharedMemorySize, LDS_BYTES) != hipSuccess) { fprintf(stderr, "kernel_launch: hipFuncSetAttribute failed\n"); grid = -1; return; }
        if (hipOccupancyMaxActiveBlocksPerMultiprocessor(&per_cu, (const void*)fwd, NWAVES * 64, LDS_BYTES) != hipSuccess || per_cu < 1) fprintf(stderr, "kernel_launch: occupancy query says %d\n", per_cu);
        (void)hipGetLastError();
        grid = cus;
    }
    if (grid < 0) return;
    (void)hipMemsetAsync((char*)d_ws + WS_CTL, 0, CTL_ZERO_BYTES, stream);
    Args a{};
    for (int i = 0; i < 32; ++i) a.in[i] = (const float*)d_in[i];
    a.out = (float*)d_out; a.ws = (unsigned char*)d_ws;
    if (N_LAUNCH_MODE == 1) { a.ph_lo = 0; a.ph_hi = NPHASE; hipLaunchKernelGGL(fwd, dim3(grid), dim3(NWAVES * 64), LDS_BYTES, stream, a); }
    else for (int p = 0; p < NPHASE; ++p) { a.ph_lo = p; a.ph_hi = p + 1; hipLaunchKernelGGL(fwd, dim3(grid), dim3(NWAVES * 64), LDS_BYTES, stream, a); }
}
```

```cpp
#include <hip/hip_runtime.h>
#include <cstdio>
#include <cstdint>

#define LAS __attribute__((address_space(3)))
#define GAS __attribute__((address_space(1)))
typedef _Float16 f16;
typedef _Float16 f16x8 __attribute__((ext_vector_type(8)));
typedef _Float16 f16x4 __attribute__((ext_vector_type(4)));
typedef _Float16 f16x2 __attribute__((ext_vector_type(2)));
typedef float f32x4 __attribute__((ext_vector_type(4)));
typedef float f32x2 __attribute__((ext_vector_type(2)));
typedef unsigned u32x4 __attribute__((ext_vector_type(4)));
typedef unsigned u32x2 __attribute__((ext_vector_type(2)));

__device__ __forceinline__ unsigned pkh(float a, float b) { f16x2 v = {(f16)a, (f16)b}; return __builtin_bit_cast(unsigned, v); }
__device__ __forceinline__ float h2f(f16 h) { return (float)h; }

namespace pg8 {
constexpr int BM = 256, BK = 64, HALF = 128, HTB = HALF * BK * 2, STAGE_BYTES = 8 * HTB, NXCD = 8, WGM = 8;
__host__ __device__ __forceinline__ int lds_byte(int r, int c) { const int st = (r >> 4) * 2 + (c >> 5), rr = r & 15, cc = c & 31, ob = rr * 64 + cc * 2; return st * 1024 + (ob ^ (((ob >> 9) & 1) << 5)); }
__host__ __device__ __forceinline__ void stage_rc(int b, int& R, int& C) { const int st = b / 1024, sb = b % 1024, swz = sb ^ (((sb >> 9) & 1) << 5); R = (st >> 1) * 16 + swz / 64; C = (st & 1) * 32 + (swz % 64) / 2; }
__host__ __device__ __forceinline__ int perm32(int rho) { const int n = rho >> 4, i = rho & 15; return 8 * (i >> 2) + 4 * n + (i & 3); }

struct Unit { int pm, pn; };
struct Gemm { const f16* A; const f16* Bt; int M, N, K; };

struct StaticOrder {
    int nM, nN, nwg, G, c;
    __host__ __device__ void init(int M, int N, int G_, int c_) { nM = M / BM; nN = N / BM; nwg = nM * nN; G = G_; c = c_; }
    __host__ __device__ bool next(int i, Unit& u) const {
        const long L = (long)i * G + c; if (L >= nwg) return false;
        int wgid = (int)L; { const int q = nwg / NXCD, r = nwg % NXCD, xcd = wgid % NXCD, off = wgid / NXCD; wgid = (xcd < r ? xcd * (q + 1) : r * (q + 1) + (xcd - r) * q) + off; }
        const int nig = WGM * nN, gid = wgid / nig, fm = gid * WGM, gsz = (nM - fm) < WGM ? (nM - fm) : WGM;
        u.pm = fm + ((wgid % nig) % gsz); u.pn = (wgid % nig) / gsz; return true;
    }
    __device__ __forceinline__ void a_ready(const Unit&) const {}
    __device__ __forceinline__ void done(const Unit&) const {}
};

struct EpiF16 {
    static constexpr bool PERM = true, AFTER_DRAIN = false;
    f16* O; int ldc;
    __device__ __forceinline__ void operator()(const f32x4 (&acc)[2][2][4][2], const Unit& u, int wr, int wc, int fr, int fq) const {
        const int row0 = u.pm * BM + wr * 64 + fr; const int col0 = u.pn * BM + wc * 32 + 8 * fq;
#pragma unroll
        for (int ai = 0; ai < 2; ++ai)
#pragma unroll
            for (int m = 0; m < 4; ++m) { f16* rowp = O + (size_t)(row0 + ai * HALF + m * 16) * ldc + col0;
#pragma unroll
                for (int bj = 0; bj < 2; ++bj) { const f32x4 v0 = acc[ai][bj][m][0], v1 = acc[ai][bj][m][1];
                    u32x4 w; w.x = pkh(v0[0], v0[1]); w.y = pkh(v0[2], v0[3]); w.z = pkh(v1[0], v1[1]); w.w = pkh(v1[2], v1[3]);
                    *(u32x4*)(rowp + bj * HALF) = w; } }
    }
};
struct EpiSwiGLU {
    static constexpr bool PERM = true, AFTER_DRAIN = false;
    f16* O; int ldc;
    __device__ __forceinline__ void operator()(const f32x4 (&acc)[2][2][4][2], const Unit& u, int wr, int wc, int fr, int fq) const {
        const int row0 = u.pm * BM + wr * 64 + fr; const int col0 = u.pn * HALF + wc * 32 + 8 * fq;
#pragma unroll
        for (int ai = 0; ai < 2; ++ai)
#pragma unroll
            for (int m = 0; m < 4; ++m) { f16* rowp = O + (size_t)(row0 + ai * HALF + m * 16) * ldc + col0;
                float o[8];
#pragma unroll
                for (int n = 0; n < 2; ++n)
#pragma unroll
                    for (int j = 0; j < 4; ++j) { const float g = acc[ai][0][m][n][j], up = acc[ai][1][m][n][j]; o[n * 4 + j] = g * __builtin_amdgcn_rcpf(1.0f + __expf(-g)) * up; }
                u32x4 w; w.x = pkh(o[0], o[1]); w.y = pkh(o[2], o[3]); w.z = pkh(o[4], o[5]); w.w = pkh(o[6], o[7]);
                *(u32x4*)rowp = w; }
    }
};

template <class Epi, class Sched, bool ALIGN_EPI = false, bool SP2 = false>
__device__ __forceinline__ void gemm_phase(LAS unsigned char* lds, const Gemm g, const Sched& S, const Epi& E) {
    const int tid = threadIdx.x, wid = __builtin_amdgcn_readfirstlane(tid >> 6), lane = tid & 63, wr = wid >> 2, wc = wid & 3, fr = lane & 15, fq = lane >> 4;
    const int K = g.K, nt = K / BK;
    unsigned voffA[2], voffB[2];
#pragma unroll
    for (int i = 0; i < 2; ++i) { int R, C; stage_rc(tid * 16 + i * 8192, R, C); const int Rb = Epi::PERM ? ((R & ~31) + perm32(R & 31)) : R;
        voffA[i] = (unsigned)(R * K + C) * 2u; voffB[i] = (unsigned)(Rb * K + C) * 2u; }
    const size_t kstep = (size_t)(BK * 2);
    const size_t hstep = (size_t)HALF * K * 2;
    const size_t tstep = 2 * hstep;
    const unsigned ldsw = (unsigned)wid * 1024u;
    const int aoff = lds_byte(wr * 64 + fr, fq * 8), boff = lds_byte(wc * 32 + fr, fq * 8);
#define PG8_SA(b, h) (((b) * 2 + (h)) * HTB)
#define PG8_SB(b, h) ((4 + (b) * 2 + (h)) * HTB)
#define PG8_STAGE(bufoff, gbase, voff) do { _Pragma("unroll") for (int _i = 0; _i < 2; ++_i) \
        __builtin_amdgcn_global_load_lds((const unsigned*)((const char*)(gbase) + (voff)[_i]), (LAS unsigned*)(lds + (bufoff) + ldsw + _i * 8192), 16, 0, 0); } while (0)
#define PG8_LDA(dst, b, h) do { _Pragma("unroll") for (int m = 0; m < 4; ++m) _Pragma("unroll") for (int k = 0; k < 2; ++k) dst[m][k] = *(const LAS f16x8*)(lds + PG8_SA(b, h) + aoff + m * 2048 + k * 1024); } while (0)
#define PG8_LDB(dst, b, h) do { _Pragma("unroll") for (int n = 0; n < 2; ++n) _Pragma("unroll") for (int k = 0; k < 2; ++k) dst[n][k] = *(const LAS f16x8*)(lds + PG8_SB(b, h) + boff + n * 2048 + k * 1024); } while (0)
#define PG8_MMA(ai, bj, At, Bt) do { __builtin_amdgcn_s_setprio(1); _Pragma("unroll") for (int m = 0; m < 4; ++m) _Pragma("unroll") for (int n = 0; n < 2; ++n) _Pragma("unroll") for (int k = 0; k < 2; ++k) \
        acc[ai][bj][m][n] = __builtin_amdgcn_mfma_f32_16x16x32_f16(Bt[n][k], At[m][k], acc[ai][bj][m][n], 0, 0, 0); __builtin_amdgcn_s_setprio(0); } while (0)
#define PG8_WAIT_V(n) asm volatile("s_waitcnt vmcnt(" #n ")" ::: "memory")
#define PG8_WAIT_L(n) asm volatile("s_waitcnt lgkmcnt(" #n ")" ::: "memory")
#define PG8_BAR __builtin_amdgcn_s_barrier()
#define PG8_SCHED __builtin_amdgcn_sched_barrier(0)
    Unit cur, nxt; int ui = 0;
    if (!S.next(0, cur)) return;
    f32x4 acc[2][2][4][2];
#pragma unroll
    for (int a = 0; a < 2; ++a)
#pragma unroll
        for (int b = 0; b < 2; ++b)
#pragma unroll
            for (int m = 0; m < 4; ++m)
#pragma unroll
                for (int n = 0; n < 2; ++n) acc[a][b][m][n] = (f32x4){0.f, 0.f, 0.f, 0.f};
    f16x8 At[4][2], B0[2][2], B1[2][2];
    const char* cA = (const char*)g.A + (size_t)cur.pm * tstep; const char* cB = (const char*)g.Bt + (size_t)cur.pn * tstep;
    S.a_ready(cur);
    if constexpr (SP2) {
        PG8_STAGE(PG8_SB(0, 0), cB, voffB); PG8_STAGE(PG8_SB(0, 1), cB + hstep, voffB); PG8_STAGE(PG8_SA(0, 0), cA, voffA); PG8_STAGE(PG8_SA(0, 1), cA + hstep, voffA);
        if (wr == 1) PG8_BAR;
        PG8_WAIT_V(2); PG8_BAR;
        PG8_STAGE(PG8_SB(1, 0), cB + kstep, voffB); PG8_STAGE(PG8_SA(1, 0), cA + kstep, voffA); PG8_STAGE(PG8_SB(1, 1), cB + hstep + kstep, voffB);
        PG8_WAIT_V(6); PG8_BAR;
    } else {
        PG8_STAGE(PG8_SB(0, 0), cB, voffB); PG8_STAGE(PG8_SA(0, 0), cA, voffA); PG8_STAGE(PG8_SB(0, 1), cB + hstep, voffB); PG8_STAGE(PG8_SA(0, 1), cA + hstep, voffA);
        if (wr == 1) PG8_BAR;
        PG8_WAIT_V(4); PG8_BAR;
        PG8_STAGE(PG8_SB(1, 0), cB + kstep, voffB); PG8_STAGE(PG8_SA(1, 0), cA + kstep, voffA); PG8_STAGE(PG8_SB(1, 1), cB + hstep + kstep, voffB);
        PG8_WAIT_V(6); PG8_BAR;
    }
    for (;;) {
        const bool has_next = S.next(ui + 1, nxt);
        const char* nA = has_next ? (const char*)g.A + (size_t)nxt.pm * tstep : cA; const char* nB = has_next ? (const char*)g.Bt + (size_t)nxt.pn * tstep : cB;
        for (int t = 0; t < nt; t += 2) {
            const bool last = (t == nt - 2);
            const char* a1 = cA + (size_t)(t + 1) * kstep;
            const char* a2 = last ? nA : cA + (size_t)(t + 2) * kstep; const char* b2 = last ? nB : cB + (size_t)(t + 2) * kstep;
            const char* a3 = a2 + kstep; const char* b3 = b2 + kstep;
            if (last && has_next) S.a_ready(nxt);
            if constexpr (SP2) {
            PG8_LDB(B0, 0, 0); PG8_LDB(B1, 0, 1); PG8_SCHED; PG8_LDA(At, 0, 0); PG8_STAGE(PG8_SA(1, 1), a1 + hstep, voffA);
            PG8_WAIT_V(8); PG8_WAIT_L(0); PG8_BAR; PG8_MMA(0, 0, At, B0); PG8_MMA(0, 1, At, B1); PG8_BAR; PG8_SCHED;
            PG8_LDA(At, 0, 1); PG8_STAGE(PG8_SB(0, 0), b2, voffB); PG8_STAGE(PG8_SB(0, 1), b2 + hstep, voffB); PG8_STAGE(PG8_SA(0, 0), a2, voffA);
            PG8_WAIT_V(8); PG8_WAIT_L(0); PG8_BAR; PG8_MMA(1, 0, At, B0); PG8_MMA(1, 1, At, B1); PG8_BAR; PG8_SCHED;
            PG8_LDB(B0, 1, 0); PG8_LDB(B1, 1, 1); PG8_SCHED; PG8_LDA(At, 1, 0); PG8_STAGE(PG8_SA(0, 1), a2 + hstep, voffA);
            PG8_WAIT_V(8); PG8_WAIT_L(0); PG8_BAR; PG8_MMA(0, 0, At, B0); PG8_MMA(0, 1, At, B1); PG8_BAR; PG8_SCHED;
            PG8_LDA(At, 1, 1); PG8_STAGE(PG8_SB(1, 0), b3, voffB); PG8_STAGE(PG8_SB(1, 1), b3 + hstep, voffB); PG8_STAGE(PG8_SA(1, 0), a3, voffA);
            PG8_WAIT_V(8); PG8_WAIT_L(0); PG8_BAR; PG8_MMA(1, 0, At, B0); PG8_MMA(1, 1, At, B1); PG8_BAR; PG8_SCHED;
            } else {
            PG8_LDB(B0, 0, 0); PG8_SCHED; PG8_LDA(At, 0, 0); PG8_STAGE(PG8_SA(1, 1), a1 + hstep, voffA);
            PG8_WAIT_L(8); PG8_BAR; PG8_WAIT_L(0); PG8_MMA(0, 0, At, B0); PG8_BAR; PG8_SCHED;
            PG8_LDB(B1, 0, 1); PG8_STAGE(PG8_SB(0, 0), b2, voffB);
            PG8_BAR; PG8_WAIT_L(0); PG8_MMA(0, 1, At, B1); PG8_BAR;
            PG8_LDA(At, 0, 1); PG8_STAGE(PG8_SA(0, 0), a2, voffA);
            PG8_BAR; PG8_WAIT_L(0); PG8_MMA(1, 0, At, B0); PG8_BAR; PG8_SCHED;
            PG8_STAGE(PG8_SB(0, 1), b2 + hstep, voffB);
            PG8_WAIT_V(6); PG8_BAR; PG8_MMA(1, 1, At, B1); PG8_BAR;
            PG8_LDB(B0, 1, 0); PG8_SCHED; PG8_LDA(At, 1, 0); PG8_STAGE(PG8_SA(0, 1), a2 + hstep, voffA);
            PG8_WAIT_L(8); PG8_BAR; PG8_WAIT_L(0); PG8_MMA(0, 0, At, B0); PG8_BAR; PG8_SCHED;
            PG8_LDB(B1, 1, 1); PG8_STAGE(PG8_SB(1, 0), b3, voffB);
            PG8_BAR; PG8_WAIT_L(0); PG8_MMA(0, 1, At, B1); PG8_BAR;
            PG8_LDA(At, 1, 1); PG8_STAGE(PG8_SA(1, 0), a3, voffA);
            PG8_BAR; PG8_WAIT_L(0); PG8_MMA(1, 0, At, B0); PG8_BAR; PG8_SCHED;
            PG8_STAGE(PG8_SB(1, 1), b3 + hstep, voffB);
            PG8_WAIT_V(6); PG8_BAR; PG8_MMA(1, 1, At, B1); PG8_BAR;
            }
        }
        if constexpr (ALIGN_EPI) { if (wr == 0) PG8_BAR; }
        if constexpr (!Epi::AFTER_DRAIN) { E(acc, cur, wr, wc, fr, fq); S.done(cur); }
        if (!has_next) break;
#pragma unroll
        for (int a = 0; a < 2; ++a)
#pragma unroll
            for (int b = 0; b < 2; ++b)
#pragma unroll
                for (int m = 0; m < 4; ++m)
#pragma unroll
                    for (int n = 0; n < 2; ++n) acc[a][b][m][n] = (f32x4){0.f, 0.f, 0.f, 0.f};
        cur = nxt; cA = nA; cB = nB; ++ui;
        if constexpr (ALIGN_EPI) { if (wr == 1) PG8_BAR; }
    }
    PG8_WAIT_V(0);
    if constexpr (!ALIGN_EPI) { if (wr == 0) PG8_BAR; }
    PG8_BAR;
#undef PG8_SA
#undef PG8_SB
#undef PG8_STAGE
#undef PG8_LDA
#undef PG8_LDB
#undef PG8_MMA
#undef PG8_WAIT_V
#undef PG8_WAIT_L
#undef PG8_BAR
#undef PG8_SCHED
}
}

#define XB_TMO      128
#define XB_XCNT(j)  (256  + 64 * (j))
#define XB_XSUB(j)  (1280 + 64 * (j))
#define XB_XGEN(j)  (2304 + 64 * (j))
#define XB_TOP      3328
#define XB_TOPGEN   3392
#define XCD_BAR_WORDS 3456
#define XB_SPIN_CAP (1u << 18)
__device__ __forceinline__ unsigned xb_ld(unsigned* p)              { return __hip_atomic_load(p, __ATOMIC_RELAXED, __HIP_MEMORY_SCOPE_AGENT); }
__device__ __forceinline__ unsigned xb_add(unsigned* p, unsigned v) { return __hip_atomic_fetch_add(p, v, __ATOMIC_RELAXED, __HIP_MEMORY_SCOPE_AGENT); }
__device__ __forceinline__ unsigned xb_xcc_id() { return (unsigned)__builtin_amdgcn_s_getreg((3 << 11) | 20) & 0xFu; }
#define XB_SPIN(cond, bar) do { unsigned _sp = 0; while (cond) { __builtin_amdgcn_s_sleep(1); \
    if ((++_sp & 255u) == 0u) { if (xb_ld(&(bar)[XB_TMO])) break; if (_sp > XB_SPIN_CAP) { atomicAdd(&(bar)[XB_TMO], 1u); break; } } } } while (0)
struct XcdBarrier { unsigned* bar; unsigned x; volatile LAS unsigned* st; };
__device__ __forceinline__ XcdBarrier xcd_barrier_post(unsigned* bar, volatile LAS unsigned* st) {
    XcdBarrier b; b.bar = bar; b.x = xb_xcc_id(); b.st = st;
    if (threadIdx.x == 0) (void)xb_add(&bar[XB_XCNT(b.x)], 1u);
    return b;
}
__device__ __forceinline__ void xcd_barrier_complete(unsigned* bar, unsigned x, unsigned& nloc, unsigned& nx) {
    const unsigned G = gridDim.x * gridDim.y * gridDim.z;
    unsigned sum, cnt, mine, sp = 0u;
    for (;;) {
        sum = 0u; cnt = 0u; mine = 0u;
#pragma unroll
        for (unsigned j = 0; j < 16; ++j) { const unsigned c = xb_ld(&bar[XB_XCNT(j)]); sum += c; cnt += (c > 0u) ? 1u : 0u; mine = (j == x) ? c : mine; }
        if (sum == G) break;
        __builtin_amdgcn_s_sleep(1);
        if ((++sp & 255u) == 0u) { if (xb_ld(&bar[XB_TMO])) break; if (sp > XB_SPIN_CAP) { atomicAdd(&bar[XB_TMO], 1u); break; } }
    }
    nloc = mine > 0u ? mine : 1u; nx = cnt > 0u ? cnt : 1u;
}
__device__ __forceinline__ void xcd_barrier(const XcdBarrier& b) {
    asm volatile("s_waitcnt vmcnt(0)" ::: "memory");
    __syncthreads();
    if (threadIdx.x == 0) {
        unsigned* bar = b.bar;
        __builtin_amdgcn_s_waitcnt(0);
        unsigned nloc = b.st[0], nx = b.st[1];
        if (nloc == 0u) { xcd_barrier_complete(bar, b.x, nloc, nx); b.st[0] = nloc; b.st[1] = nx; }
        const unsigned old = xb_add(&bar[XB_XSUB(b.x)], 1u);
        const unsigned gen = old / nloc;
        if (old + 1u == (gen + 1u) * nloc) {
            __builtin_amdgcn_fence(__ATOMIC_RELEASE, "agent");
            asm volatile("s_waitcnt vmcnt(0)" ::: "memory");
            const unsigned og = xb_add(&bar[XB_TOP], 1u);
            const unsigned tg = og / nx;
            if (og + 1u == (tg + 1u) * nx) xb_add(&bar[XB_TOPGEN], 1u);
            else XB_SPIN(xb_ld(&bar[XB_TOPGEN]) == tg, bar);
            __builtin_amdgcn_fence(__ATOMIC_ACQUIRE, "agent");
            xb_add(&bar[XB_XGEN(b.x)], 1u);
            asm volatile("s_waitcnt vmcnt(0)" ::: "memory");
        } else {
            XB_SPIN(xb_ld(&bar[XB_XGEN(b.x)]) == gen, bar);
            __builtin_amdgcn_fence(__ATOMIC_ACQUIRE, "agent");
            asm volatile("s_waitcnt vmcnt(0)" ::: "memory");
        }
    }
    __syncthreads();
}

constexpr int BATCH = 8, SEQ = 4096, D = 1024, MTOK = BATCH * SEQ;
constexpr int QL = 256, KVL = 128, IDXD = 64, IDXH = 8, HATT = 8, TOPK = 256;
constexpr int RW = 512, HRW = 8, NRW = 64;
constexpr int IN_COLS = 2280, IN_PAD = 2304;
constexpr int C_CQ = 0, C_CKV = 256, C_IK = 384, C_IW = 448, C_R = 456, C_K = 968, C_V = 1480, C_WD = 1992, C_AD = 2056, C_GD = 2120;
constexpr int DFF = 2816;
constexpr int NQI = 1536;
constexpr int KOUT = 1536;
constexpr float NORM_EPS = 1e-6f, GN_EPS = 64e-5f;

constexpr size_t MiB = 1u << 20;
constexpr size_t WS_CTL = 0, CTL_ZERO_BYTES = 64 * 1024;
constexpr size_t WS_MOD = 1 * MiB;
constexpr size_t WS_WIN = 2 * MiB;
constexpr size_t WS_WCQ = 7 * MiB;
constexpr size_t WS_WOUT = 8 * MiB;
constexpr size_t WS_WGU = 11 * MiB;
constexpr size_t WS_WDN = 22 * MiB;
constexpr size_t WS_H = 32 * MiB;
constexpr size_t WS_RWW = 32 * MiB, WS_RWA = 64 * MiB;
constexpr size_t WS_PROJ = 96 * MiB;
constexpr size_t WS_CQ = 240 * MiB;
constexpr size_t WS_SEL = 240 * MiB;
constexpr size_t WS_OATT = 256 * MiB;
constexpr size_t WS_CKV = 352 * MiB;
constexpr size_t WS_IK16 = 360 * MiB;
constexpr size_t WS_IK32 = 364 * MiB;
constexpr size_t WS_IW = 372 * MiB;
constexpr size_t WS_RWG = 376 * MiB;
constexpr size_t WS_YRAW = 408 * MiB;
constexpr size_t WS_MIX = 408 * MiB;
constexpr size_t WS_ACT = 96 * MiB;
constexpr size_t WS_F = 288 * MiB;
constexpr size_t WS_CKV8 = 368 * MiB;
constexpr size_t WS_END = 504 * MiB;

constexpr int CW_BAR = 1024;
constexpr int NWAVES = 8;
constexpr int RING_BYTES = 131072, AUX_OFF = RING_BYTES  , MISC_OFF = 155648, LDS_BYTES = 155904;

struct Args { const float* in[32]; float* out; unsigned char* ws; int ph_lo, ph_hi; };

__device__ __forceinline__ float wave_sum(float v) {
#pragma unroll
    for (int o = 1; o < 64; o <<= 1) v += __shfl_xor(v, o);
    return v;
}
__device__ __forceinline__ void lds_barrier() { asm volatile("s_waitcnt lgkmcnt(0)\n\ts_barrier" ::: "memory"); }
__device__ __forceinline__ float sigmoidf_(float x) { return __builtin_amdgcn_rcpf(1.0f + __expf(-x)); }

__device__ __forceinline__ void p0_transpose_item(const float* W, int K, int N, int Npad, f16* WT, int ldk, int koff, int row_off, int mode, LAS float* scr, int item, int lane) {
    const int nblk = Npad / 32, kb = item / nblk, nb = item % nblk, k0 = 64 * kb, n0 = 32 * nb;
    const int rr = lane >> 3, c4 = 4 * (lane & 7);
    f32x4 v[8];
#pragma unroll
    for (int i = 0; i < 8; ++i) { const int kk = 8 * i + rr; v[i] = (n0 + c4 < N && k0 + kk < K) ? *(const f32x4*)(W + (size_t)(k0 + kk) * N + n0 + c4) : (f32x4){0.f, 0.f, 0.f, 0.f}; }
#pragma unroll
    for (int i = 0; i < 8; ++i) { const int kk = 8 * i + rr; LAS float* d = scr + kk * 33 + c4; d[0] = v[i][0]; d[1] = v[i][1]; d[2] = v[i][2]; d[3] = v[i][3]; }
    asm volatile("s_waitcnt lgkmcnt(0)" ::: "memory");
    const int c = lane & 7;
#pragma unroll
    for (int j = 0; j < 4; ++j) { const int nl = (lane >> 3) + 8 * j; const LAS float* s = scr + (8 * c) * 33 + nl;
        u32x4 o; o.x = pkh(s[0 * 33], s[1 * 33]); o.y = pkh(s[2 * 33], s[3 * 33]); o.z = pkh(s[4 * 33], s[5 * 33]); o.w = pkh(s[6 * 33], s[7 * 33]);
        const int n = n0 + nl; int row;
        if (mode == 0) row = row_off + n; else row = (n >> 7) * 256 + (mode == 2 ? 128 : 0) + (n & 127);
        *(u32x4*)(WT + (size_t)row * ldk + koff + k0 + 8 * c) = o; }
    asm volatile("s_waitcnt lgkmcnt(0)" ::: "memory");
}

__device__ __forceinline__ void p0_prologue(const Args& a, LAS unsigned char* lds, int vcu, int G, int wave, int lane) {
    unsigned char* ws = a.ws;
    LAS float* scr = (LAS float*)(lds + wave * 16384);
    const int gw = vcu * NWAVES + wave, NGW = G * NWAVES;
    f16* Win = (f16*)(ws + WS_WIN); f16* Wcq = (f16*)(ws + WS_WCQ); f16* Wout = (f16*)(ws + WS_WOUT); f16* Wgu = (f16*)(ws + WS_WGU); f16* Wdn = (f16*)(ws + WS_WDN);
    constexpr int I_IN = (D / 64) * (IN_PAD / 32), I_IDX = (QL / 64) * (512 / 32), I_OR = (512 / 64) * (D / 32), I_G = (D / 64) * (DFF / 32), I_D = (DFF / 64) * (D / 32);
    constexpr int I_FQ = 4 * 64, I_FO = 16 * 64, I_MOD = 8 * 96, I_LD = 16, I_LG = 48;
    constexpr int NITEMS = I_IN + I_IDX + I_OR + 2 * I_G + I_D + I_FQ + I_FO + 2 * I_LD + I_LG;
    const bool split = (G == 256);
    const int gw2 = split ? (vcu - 96) * NWAVES + wave : gw, NGW2 = split ? (G - 96) * NWAVES : NGW;
    for (int it = gw2; it < NITEMS && gw2 >= 0; it += NGW2) {
        int r = it;
        if (r < I_IN) { p0_transpose_item(a.in[9], D, IN_COLS, IN_PAD, Win, D, 0, 0, 0, scr, r, lane); continue; } r -= I_IN;
        if (r < I_IDX) { p0_transpose_item(a.in[12], QL, 512, 512, Wcq, QL, 0, 1024, 0, scr, r, lane); continue; } r -= I_IDX;
        if (r < I_OR) { p0_transpose_item(a.in[28] + (size_t)512 * D, 512, D, D, Wout, KOUT, 1024, 0, 0, scr, r, lane); continue; } r -= I_OR;
        if (r < I_G) { p0_transpose_item(a.in[29], D, DFF, DFF, Wgu, D, 0, 0, 1, scr, r, lane); continue; } r -= I_G;
        if (r < I_G) { p0_transpose_item(a.in[30], D, DFF, DFF, Wgu, D, 0, 0, 2, scr, r, lane); continue; } r -= I_G;
        if (r < I_D) { p0_transpose_item(a.in[31], DFF, D, D, Wdn, DFF, 0, 0, 0, scr, r, lane); continue; } r -= I_D;
        if (r < I_FQ) {
            const int rb = r & 3, nb = r >> 2, rr = rb * 64 + lane, n0 = nb * 16, h = n0 >> 7;
            const float* uq = a.in[11] + (size_t)rr * 512 + h * 64; const float* uk = a.in[15] + (size_t)n0 * 64;
            float q[64];
#pragma unroll
            for (int d4 = 0; d4 < 16; ++d4) { const f32x4 v = *(const f32x4*)(uq + 4 * d4); q[4 * d4] = v[0]; q[4 * d4 + 1] = v[1]; q[4 * d4 + 2] = v[2]; q[4 * d4 + 3] = v[3]; }
#pragma unroll 4
            for (int i = 0; i < 16; ++i) { float s = 0.f;
#pragma unroll
                for (int d = 0; d < 64; ++d) s += q[d] * uk[i * 64 + d];
                Wcq[(size_t)(n0 + i) * QL + rr] = (f16)(0.125f * s); }
            continue; } r -= I_FQ;
        if (r < I_FO) {
            const int kb = r & 15, nb = r >> 4, k = kb * 64 + lane, h = kb >> 1, n0 = nb * 16;
            const float* uvp = a.in[16] + (size_t)k * 64; const float* wo = a.in[28] + (size_t)(h * 64) * D + n0;
            float uv[64];
#pragma unroll
            for (int d4 = 0; d4 < 16; ++d4) { const f32x4 v = *(const f32x4*)(uvp + 4 * d4); uv[4 * d4] = v[0]; uv[4 * d4 + 1] = v[1]; uv[4 * d4 + 2] = v[2]; uv[4 * d4 + 3] = v[3]; }
            float acc[16];
#pragma unroll
            for (int i = 0; i < 16; ++i) acc[i] = 0.f;
#pragma unroll
            for (int d = 0; d < 64; ++d) {
#pragma unroll
                for (int i = 0; i < 16; ++i) acc[i] += uv[d] * wo[(size_t)d * D + i]; }
#pragma unroll
            for (int i = 0; i < 16; ++i) Wout[(size_t)(n0 + i) * KOUT + k] = (f16)acc[i];
            continue; } r -= I_FO;
        if (r < I_LD) { p0_transpose_item(a.in[19], 64, 512, 512, (f16*)(ws + (28u << 20)), 64, 0, 0, 0, scr, r, lane); continue; } r -= I_LD;
        if (r < I_LD) { p0_transpose_item(a.in[21], 64, 512, 512, (f16*)(ws + (28u << 20) + 65536), 64, 0, 0, 0, scr, r, lane); continue; } r -= I_LD;
        { p0_transpose_item(a.in[22], 160, 512, 512, (f16*)(ws + (28u << 20) + 131072), 192, 0, 0, 0, scr, r, lane); }
    }
    if (vcu < 96) {
        __syncthreads();
        const int tid = wave * 64 + lane;
        for (int e = tid; e < 8 * D; e += 512) { const float cc = a.in[1][e]; *(LAS float*)(lds + (e >> 10) * 16384 + 10496 + (e & 1023) * 4) = cc * sigmoidf_(cc); }
        for (int cb = vcu; cb < 96; cb += G) {
            __syncthreads();
            const int j = cb * 64 + lane; const float* aw = a.in[3] + j;
            float acc[8];
#pragma unroll
            for (int b = 0; b < 8; ++b) acc[b] = 0.f;
            const int kbeg = wave * 128;
#pragma unroll 1
            for (int k0 = 0; k0 < 128; k0 += 16) {
                float wv[16];
#pragma unroll
                for (int i = 0; i < 16; ++i) wv[i] = aw[(size_t)(kbeg + k0 + i) * 6144];
#pragma unroll
                for (int b = 0; b < 8; ++b) {
#pragma unroll
                    for (int i4 = 0; i4 < 4; ++i4) { const f32x4 sv = *(const LAS f32x4*)(lds + b * 16384 + 10496 + (kbeg + k0 + 4 * i4) * 4);
                        acc[b] += sv[0] * wv[4 * i4] + sv[1] * wv[4 * i4 + 1] + sv[2] * wv[4 * i4 + 2] + sv[3] * wv[4 * i4 + 3]; } }
            }
#pragma unroll
            for (int b = 0; b < 8; ++b) *(LAS float*)(lds + wave * 16384 + 8448 + (b * 64 + lane) * 4) = acc[b];
            __syncthreads();
            float sum = 0.f;
#pragma unroll
            for (int w = 0; w < 8; ++w) sum += *(const LAS float*)(lds + w * 16384 + 8448 + (wave * 64 + lane) * 4);
            ((float*)(ws + WS_MOD))[wave * 6144 + j] = sum + a.in[4][j];
        }
    }
}

__device__ __forceinline__ void p1_modnorm(const Args& a, int vcu, int G, int wave, int lane) {
    const int gw = vcu * NWAVES + wave, NGW = G * NWAVES;
    const float* mod = (const float*)(a.ws + WS_MOD); f16* H = (f16*)(a.ws + WS_H);
    for (int m = gw; m < MTOK; m += NGW) {
        const int b = m >> 12;
        const f32x4* xr = (const f32x4*)(a.in[0] + (size_t)m * D) + lane;
        f32x4 v[4]; float s = 0.f;
#pragma unroll
        for (int j = 0; j < 4; ++j) { v[j] = xr[64 * j]; s += (v[j][0] * v[j][0] + v[j][1] * v[j][1]) + (v[j][2] * v[j][2] + v[j][3] * v[j][3]); }
        const float r = rsqrtf(wave_sum(s) * (1.f / D) + NORM_EPS);
        u32x2* o = (u32x2*)(H + (size_t)m * D) + lane;
#pragma unroll
        for (int j = 0; j < 4; ++j) { const int c = 4 * lane + 256 * j;
            const f32x4 g = *(const f32x4*)(a.in[5] + c), sh = *(const f32x4*)(mod + b * 6144 + c), sc = *(const f32x4*)(mod + b * 6144 + 1024 + c);
            f32x4 y;
#pragma unroll
            for (int e = 0; e < 4; ++e) y[e] = v[j][e] * r * g[e] * (1.f + sc[e]) + sh[e];
            u32x2 w; w.x = pkh(y[0], y[1]); w.y = pkh(y[2], y[3]); o[64 * j] = w; }
    }
}

__device__ __forceinline__ void p3_rows(const Args& a, int vcu, int G, int wave, int lane) {
    const int gw = vcu * NWAVES + wave, NGW = G * NWAVES;
    unsigned char* ws = a.ws;
    const f16* PROJ = (const f16*)(ws + WS_PROJ);
    f16* CQ = (f16*)(ws + WS_CQ); f16* CKV = (f16*)(ws + WS_CKV); f16* IK16 = (f16*)(ws + WS_IK16); float* IW = (float*)(ws + WS_IW);
    for (int m = gw; m < MTOK; m += NGW) {
        const f16* pr = PROJ + (size_t)m * IN_PAD;
        const f16x4 q = *(const f16x4*)(pr + C_CQ + 4 * lane);
        const f16x2 kv = *(const f16x2*)(pr + C_CKV + 2 * lane);
        const float ik = (float)pr[C_IK + lane];
        float q0 = (float)q[0], q1 = (float)q[1], q2 = (float)q[2], q3 = (float)q[3], k0 = (float)kv[0], k1 = (float)kv[1];
        const float rq = rsqrtf(wave_sum(q0 * q0 + q1 * q1 + q2 * q2 + q3 * q3) * (1.f / QL) + NORM_EPS);
        const float rk = rsqrtf(wave_sum(k0 * k0 + k1 * k1) * (1.f / KVL) + NORM_EPS);
        const float ri = rsqrtf(wave_sum(ik * ik) * (1.f / IDXD) + NORM_EPS);
        const f32x4 gq = *(const f32x4*)(a.in[10] + 4 * lane); const f32x2 gk = *(const f32x2*)(a.in[13] + 2 * lane); const float gi = a.in[14][lane];
        u32x2 w; w.x = pkh(q0 * rq * gq[0], q1 * rq * gq[1]); w.y = pkh(q2 * rq * gq[2], q3 * rq * gq[3]);
        *(u32x2*)(CQ + (size_t)m * QL + 4 * lane) = w;
        ((unsigned short*)(ws + WS_CKV8))[(size_t)m * 64 + lane] = (unsigned short)__builtin_amdgcn_cvt_pk_fp8_f32(k0 * rk * gk[0], k1 * rk * gk[1], 0, false);
        const float ikn = ik * ri * gi;
        IK16[(size_t)m * IDXD + lane] = (f16)ikn;
        if (lane < 8) IW[(size_t)m * 8 + lane] = (float)pr[C_IW + lane] * 0.04419417382415922f;
    }
}
__device__ __forceinline__ void p3_rwkv_prep(const Args& a, LAS unsigned char* lds, int vcu, int G, int tid) {
    unsigned char* ws = a.ws;
    const f16* PROJ = (const f16*)(ws + WS_PROJ);
    f16* RWW = (f16*)(ws + WS_RWW); f16* RWA = (f16*)(ws + WS_RWA); f16* RWG = (f16*)(ws + WS_RWG);
    LAS float* xs = (LAS float*)lds;
    const float* mu = a.in[17];
    const int ch = tid;
    const float w0 = a.in[18][ch], a0 = a.in[20][ch];
    for (int u = vcu; u < MTOK / 16; u += G) {
        const int m0 = u * 16;
        __syncthreads();
        for (int e = tid; e < 16 * 288; e += 512) {
            const int t = e / 288, col = e % 288, m = m0 + t;
            const float cur = (float)PROJ[(size_t)m * IN_PAD + C_WD + col];
            const float prev = ((m & (SEQ - 1)) != 0) ? (float)PROJ[(size_t)(m - 1) * IN_PAD + C_WD + col] : 0.f;
            float v = cur + mu[1536 + col] * (prev - cur);
            if (col < 64) v = tanhf(v); else if (col >= 128) v = sigmoidf_(v);
            xs[t * 288 + col] = v;
        }
        __syncthreads();
        float dl[16], al[16], gl[16];
#pragma unroll
        for (int t = 0; t < 16; ++t) { dl[t] = 0.f; al[t] = 0.f; gl[t] = 0.f; }
        for (int kk = 0; kk < 64; ++kk) {
            const float wd = a.in[19][kk * 512 + ch], wa = a.in[21][kk * 512 + ch];
#pragma unroll
            for (int t = 0; t < 16; ++t) { dl[t] += xs[t * 288 + kk] * wd; al[t] += xs[t * 288 + 64 + kk] * wa; }
        }
        for (int kk = 0; kk < 160; ++kk) {
            const float wg = a.in[22][kk * 512 + ch];
#pragma unroll
            for (int t = 0; t < 16; ++t) gl[t] += xs[t * 288 + 128 + kk] * wg;
        }
#pragma unroll
        for (int t = 0; t < 16; ++t) {
            const float z = -(w0 + dl[t]);
            const float sp = z > 20.f ? z : log1pf(__expf(z));
            const float wlog = -sp - 0.5f;
            const float lw = -__expf(wlog);
            const float av = sigmoidf_(a0 + al[t]);
            const size_t o = (size_t)(m0 + t) * RW + ch;
            RWW[o] = (f16)lw; RWA[o] = (f16)av; RWG[o] = (f16)gl[t];
        }
    }
}

__device__ __forceinline__ unsigned f2key(float f) { const unsigned u = __builtin_bit_cast(unsigned, f); return (u & 0x80000000u) ? ~u : (u | 0x80000000u); }
__device__ __forceinline__ void p5_indexer(const Args& a, LAS unsigned char* lds, int vcu, int G, int wave, int lane) {
    unsigned char* ws = a.ws;
    const f16* QI = (const f16*)a.out;
    const float* IK32 = (const float*)(ws + WS_IK32); const float* IW = (const float*)(ws + WS_IW);
    unsigned short* SEL = (unsigned short*)(ws + WS_SEL);
    LAS float* sc = (LAS float*)(lds + wave * 16384);
    LAS float* iq = (LAS float*)(lds + AUX_OFF + wave * 2048);
    const int gw = vcu * NWAVES + wave, NGW = G * NWAVES;
    for (int q = gw; q < MTOK; q += NGW) {
        const int b = q >> 12, t = q & (SEQ - 1);
        unsigned short* sel = SEL + (size_t)q * TOPK;
        if (t < TOPK) {
#pragma unroll
            for (int j = 0; j < 4; ++j) { const int s = lane + 64 * j; sel[s] = (s <= t) ? (unsigned short)s : (unsigned short)0xFFFF; }
            continue;
        }
        { const f16x8 v = *(const f16x8*)(QI + (size_t)q * NQI + 1024 + 8 * lane);
#pragma unroll
          for (int e = 0; e < 8; ++e) iq[8 * lane + e] = (float)v[e]; }
        float wq[8];
#pragma unroll
        for (int h = 0; h < 8; ++h) wq[h] = IW[(size_t)q * 8 + h];
        asm volatile("s_waitcnt lgkmcnt(0)" ::: "memory");
        const int nj = (t >> 6) + 1;
        for (int j = 0; j < nj; ++j) {
            const int s = j * 64 + lane;
            const float* kr = IK32 + ((size_t)(b << 12) + (s <= t ? s : t)) * IDXD;
            float kx[64];
#pragma unroll
            for (int d4 = 0; d4 < 16; ++d4) { const f32x4 v = *(const f32x4*)(kr + 4 * d4); kx[4 * d4] = v[0]; kx[4 * d4 + 1] = v[1]; kx[4 * d4 + 2] = v[2]; kx[4 * d4 + 3] = v[3]; }
            float score = 0.f;
#pragma unroll
            for (int h = 0; h < 8; ++h) { float d0 = 0.f;
#pragma unroll
                for (int d4 = 0; d4 < 16; ++d4) { const f32x4 qv = *(const LAS f32x4*)(iq + h * 64 + 4 * d4); d0 += qv[0] * kx[4 * d4]; d0 += qv[1] * kx[4 * d4 + 1]; d0 += qv[2] * kx[4 * d4 + 2]; d0 += qv[3] * kx[4 * d4 + 3]; }
                score += wq[h] * fmaxf(d0, 0.f); }
            sc[s] = (s <= t) ? score : -INFINITY;
        }
        asm volatile("s_waitcnt lgkmcnt(0)" ::: "memory");
        const int nvalid = nj * 64;
        unsigned key[64];
#pragma unroll
        for (int j = 0; j < 64; ++j) { const int s = lane * 64 + j; key[j] = (s < nvalid) ? f2key(sc[s]) : 0u; }
        unsigned prefix = 0u;
        for (int bit = 31; bit >= 0; --bit) {
            const unsigned cand = prefix | (1u << bit);
            int c = 0;
#pragma unroll
            for (int j = 0; j < 64; ++j) c += (key[j] >= cand) ? 1 : 0;
#pragma unroll
            for (int o = 1; o < 64; o <<= 1) c += __shfl_xor(c, o);
            if (c >= TOPK) prefix = cand;
        }
        int cgt = 0, ceq = 0;
#pragma unroll
        for (int j = 0; j < 64; ++j) { cgt += (key[j] > prefix) ? 1 : 0; ceq += (key[j] == prefix) ? 1 : 0; }
        int sgt = cgt, seq = ceq;
#pragma unroll
        for (int o = 1; o < 64; o <<= 1) { const int x = __shfl_up(sgt, o), y = __shfl_up(seq, o); if (lane >= o) { sgt += x; seq += y; } }
        const int tot_gt = __shfl(sgt, 63);
        int pos_gt = sgt - cgt, rank_eq = seq - ceq;
        const int need = TOPK - tot_gt;
#pragma unroll
        for (int j = 0; j < 64; ++j) {
            const int s = lane * 64 + j;
            if (key[j] > prefix) { sel[pos_gt] = (unsigned short)s; ++pos_gt; }
            else if (key[j] == prefix) { if (rank_eq < need) sel[tot_gt + rank_eq] = (unsigned short)s; ++rank_eq; }
        }
    }
}

__device__ __forceinline__ int t5_bucket(int rel) {
    if (rel < 16) return rel;
    const int l = 16 + (int)(logf((float)rel * (1.f / 16.f)) / 2.0794415416798357f * 16.f);
    return l < 31 ? l : 31;
}
__device__ __forceinline__ void p6_attention(const Args& a, LAS unsigned char* lds, int vcu, int G, int wave, int lane) {
    unsigned char* ws = a.ws;
    const f16* QI = (const f16*)a.out; const f16* CKV = (const f16*)(ws + WS_CKV);
    const unsigned short* SEL = (const unsigned short*)(ws + WS_SEL);
    f16* OATT = (f16*)(ws + WS_OATT);
    const float* rel_bias = a.in[2];
    LAS float* qa = (LAS float*)(lds + wave * 16384);
    LAS float* pp = (LAS float*)(lds + wave * 16384 + 4096);
    LAS int* sidx = (LAS int*)(lds + wave * 16384 + 12288);
    const int gw = vcu * NWAVES + wave, NGW = G * NWAVES;
    for (int q = gw; q < MTOK; q += NGW) {
        const int b = q >> 12, t = q & (SEQ - 1);
#pragma unroll
        for (int i = 0; i < 2; ++i) { const f16x8 v = *(const f16x8*)(QI + (size_t)q * NQI + 512 * i + 8 * lane);
#pragma unroll
            for (int e = 0; e < 8; ++e) qa[512 * i + 8 * lane + e] = (float)v[e]; }
        asm volatile("s_waitcnt lgkmcnt(0)" ::: "memory");
        float lg[4][8];
        int srow[4]; bool okv[4];
#pragma unroll
        for (int i = 0; i < 4; ++i) {
            const int sraw = SEL[(size_t)q * TOPK + lane + 64 * i];
            okv[i] = sraw != 0xFFFF && sraw <= t;
            srow[i] = okv[i] ? sraw : 0;
            sidx[lane + 64 * i] = okv[i] ? sraw : -1;
#pragma unroll
            for (int h = 0; h < 8; ++h) lg[i][h] = 0.f;
        }
#pragma unroll 1
        for (int c8 = 0; c8 < 16; ++c8) {
            f16x8 kv[4];
#pragma unroll
            for (int i = 0; i < 4; ++i) kv[i] = *(const f16x8*)(CKV + ((size_t)(b << 12) + srow[i]) * KVL + 8 * c8);
#pragma unroll
            for (int h = 0; h < 8; ++h) {
                const f32x4 q0 = *(const LAS f32x4*)(qa + h * 128 + 8 * c8), q1 = *(const LAS f32x4*)(qa + h * 128 + 8 * c8 + 4);
#pragma unroll
                for (int i = 0; i < 4; ++i)
                    lg[i][h] += q0[0] * (float)kv[i][0] + q0[1] * (float)kv[i][1] + q0[2] * (float)kv[i][2] + q0[3] * (float)kv[i][3] + q1[0] * (float)kv[i][4] + q1[1] * (float)kv[i][5] + q1[2] * (float)kv[i][6] + q1[3] * (float)kv[i][7];
            }
        }
#pragma unroll
        for (int i = 0; i < 4; ++i) {
            const int bk = t5_bucket(t - srow[i]);
#pragma unroll
            for (int h = 0; h < 8; ++h) lg[i][h] = okv[i] ? lg[i][h] + rel_bias[bk * 8 + h] : -INFINITY;
        }
#pragma unroll
        for (int h = 0; h < 8; ++h) {
            float mx = fmaxf(fmaxf(lg[0][h], lg[1][h]), fmaxf(lg[2][h], lg[3][h]));
#pragma unroll
            for (int o = 1; o < 64; o <<= 1) mx = fmaxf(mx, __shfl_xor(mx, o));
            float e[4], s = 0.f;
#pragma unroll
            for (int i = 0; i < 4; ++i) { e[i] = __expf(lg[i][h] - mx); s += e[i]; }
            s = wave_sum(s);
            const float inv = 1.f / s;
#pragma unroll
            for (int i = 0; i < 4; ++i) pp[h * 256 + lane + 64 * i] = e[i] * inv;
        }
        asm volatile("s_waitcnt lgkmcnt(0)" ::: "memory");
        float o0[8], o1[8];
#pragma unroll
        for (int h = 0; h < 8; ++h) { o0[h] = 0.f; o1[h] = 0.f; }
        for (int kk = 0; kk < TOPK; ++kk) {
            const int s = sidx[kk];
            if (s < 0) continue;
            const f16x2 kv = *(const f16x2*)(CKV + ((size_t)(b << 12) + s) * KVL + 2 * lane);
            const float v0 = (float)kv[0], v1 = (float)kv[1];
#pragma unroll
            for (int h = 0; h < 8; ++h) { const float p = pp[h * 256 + kk]; o0[h] += p * v0; o1[h] += p * v1; }
        }
#pragma unroll
        for (int h = 0; h < 8; ++h) *(unsigned*)(OATT + (size_t)q * KOUT + h * 128 + 2 * lane) = pkh(o0[h], o1[h]);
        asm volatile("s_waitcnt lgkmcnt(0)" ::: "memory");
    }
}

constexpr int SC_PITCH = 8224, DSA_SEL_OFF = 16 * SC_PITCH, DSA_BL_OFF = DSA_SEL_OFF + 8192, DSA_HIST_OFF = 143936;
static_assert(DSA_BL_OFF + 129 * 8 * 4 <= DSA_HIST_OFF && DSA_HIST_OFF + 8 * 1280 <= MISC_OFF, "DSA LDS map");
typedef short v4i16_t __attribute__((ext_vector_type(4)));
__device__ __forceinline__ unsigned kv_off(unsigned row, unsigned ch) { return 256u * row + 16u * (ch ^ (((row & 3u) << 2) | ((row >> 2) & 3u))); }
__device__ __forceinline__ f16x4 tr_read16(LAS unsigned char* p) { return __builtin_bit_cast(f16x4, __builtin_amdgcn_ds_read_tr16_b64_v4i16((LAS v4i16_t*)p)); }
template <int CTRL, int RMASK> __device__ __forceinline__ int dpp_i(int x) { return __builtin_amdgcn_update_dpp(0, x, CTRL, RMASK, 0xF, false); }
template <int CTRL> __device__ __forceinline__ int dpp_iz(int x) { return __builtin_amdgcn_update_dpp(0, x, CTRL, 0xF, 0xF, true); }
__device__ __forceinline__ int wave_incl_scan_i(int x) { x += dpp_iz<0x111>(x); x += dpp_iz<0x112>(x); x += dpp_iz<0x114>(x); x += dpp_iz<0x118>(x);
    x += dpp_i<0x142, 0xA>(x); x += dpp_i<0x143, 0xC>(x); return x; }
__device__ __forceinline__ void p5_dsa(const Args& a, LAS unsigned char* lds, int G, int bx, int tid, int wave, int lane) {
    unsigned char* ws = a.ws;
    const f16* QI = (const f16*)a.out; const f16* IK16 = (const f16*)(ws + WS_IK16); const float* IW = (const float*)(ws + WS_IW);
    const f16* CKV = (const f16*)(ws + WS_CKV); f16* OATT = (f16*)(ws + WS_OATT);
    LAS unsigned short* SELL = (LAS unsigned short*)(lds + DSA_SEL_OFF);
    LAS float* BL = (LAS float*)(lds + DSA_BL_OFF);
    for (int e = tid; e < 129 * 8; e += 512) { const int rel = e >> 3, h = e & 7; BL[e] = a.in[2][t5_bucket(rel) * 8 + h]; }
    const int nunits = BATCH * (SEQ / 16);
    const bool balanced = (G == 256);
    const int niter = balanced ? 8 : (nunits + G - 1) / G;
#pragma unroll 1
    for (int it = 0; it < niter; ++it) {
        int b, tile;
        if (balanced) { b = bx & 7; const int r = bx >> 3, base = 64 * (it >> 1); tile = (it & 1) ? base + 63 - r : base + r; }
        else { const int u = it * G + bx; if (u >= nunits) break; b = u >> 8; tile = u & 255; }
        int lane_o = lane; asm volatile("" : "+v"(lane_o));
        const int r16 = lane_o & 15, g = lane_o >> 4;
        const int t0 = tile * 16;
        const size_t qb = (size_t)(b << 12);
        const int jn = ((t0 + 15) >> 7) + 1;
        lds_barrier();
#ifndef DSAREP
#define DSAREP 0
#endif
#ifndef DSA_NO_A
        for (int ra_ = 0; ra_ < ((DSAREP & 1) ? 2 : 1); ++ra_)
        if (t0 + 15 >= TOPK) {
            f16x8 afr[8][2]; f32x4 wv[4][2];
#pragma unroll
            for (int mt = 0; mt < 8; ++mt) { const int tg = mt >> 1, hf = mt & 1, t = t0 + 4 * tg + (r16 >> 2), h = 4 * hf + (r16 & 3);
#pragma unroll
                for (int ks = 0; ks < 2; ++ks) afr[mt][ks] = *(const f16x8*)(QI + (qb + t) * NQI + 1024 + h * 64 + 32 * ks + 8 * g); }
#pragma unroll
            for (int tg = 0; tg < 4; ++tg)
#pragma unroll
                for (int hf = 0; hf < 2; ++hf) wv[tg][hf] = *(const f32x4*)(IW + (qb + t0 + 4 * tg + g) * 8 + 4 * hf) * 65536.0f;
            const f32x2 cscale = {1.52587890625e-05f, 1.52587890625e-05f};
            f16x8 bn0[2], bn1[2], bn2[2];
            const f16* ikp = IK16 + (qb + 16 * wave + r16) * IDXD + 8 * g;
#define A_LOAD(BN, j_) do { const f16* p_ = ikp + (size_t)(128 * (j_)) * IDXD; asm volatile("global_load_dwordx4 %0, %2, off\n\tglobal_load_dwordx4 %1, %2, off offset:64" : "=&v"(BN[0]), "=&v"(BN[1]) : "v"(p_) : "memory"); } while (0)
#define A_WAIT(BN) asm volatile("s_waitcnt vmcnt(4)" : "+v"(BN[0]), "+v"(BN[1]) :: "memory")
#define A_STEP(BN, j_) do { const int j = (j_); const int s = 128 * j + 16 * wave + r16; A_WAIT(BN); f16x8 bfr[2]; bfr[0] = BN[0]; bfr[1] = BN[1]; \
                f32x4 acc[8]; \
_Pragma("unroll") \
                for (int mt = 0; mt < 8; ++mt) { acc[mt] = __builtin_amdgcn_mfma_f32_16x16x32_f16(afr[mt][0], bfr[0], (f32x4){0.f, 0.f, 0.f, 0.f}, 0, 0, 0); \
                    acc[mt] = __builtin_amdgcn_mfma_f32_16x16x32_f16(afr[mt][1], bfr[1], acc[mt], 0, 0, 0); } \
                asm volatile("s_nop 15\n\ts_nop 7" :: "v"(acc[0]), "v"(acc[1]), "v"(acc[2]), "v"(acc[3]), "v"(acc[4]), "v"(acc[5]), "v"(acc[6]), "v"(acc[7])); \
                float scv[4]; \
_Pragma("unroll") \
                for (int tg = 0; tg < 4; ++tg) { f32x2 s2 = {0.f, 0.f}; \
_Pragma("unroll") \
                    for (int hf = 0; hf < 2; ++hf) \
_Pragma("unroll") \
                        for (int p = 0; p < 2; ++p) { const f32x2 av = {acc[2 * tg + hf][2 * p], acc[2 * tg + hf][2 * p + 1]}; f32x2 r; \
                            asm volatile("v_pk_mul_f32 %0, %1, %2 clamp" : "=v"(r) : "v"(av), "v"(cscale)); \
                            const f32x2 wp = {wv[tg][hf][2 * p], wv[tg][hf][2 * p + 1]}; s2 = r * wp + s2; } \
                    scv[tg] = s2[0] + s2[1]; } \
                if (j == jn - 1) { \
_Pragma("unroll") \
                    for (int tg = 0; tg < 4; ++tg) if (s > t0 + 4 * tg + g) scv[tg] = -INFINITY; } \
_Pragma("unroll") \
                for (int pr = 0; pr < 2; ++pr) { \
                    const unsigned x = pkh(scv[2 * pr], scv[2 * pr + 1]); \
                    const unsigned k2 = x ^ ((((x >> 15) & 0x00010001u) * 0x7FFFu) | 0x80008000u); \
                    *(LAS unsigned short*)(lds + (4 * (2 * pr) + g) * SC_PITCH + s * 2) = (unsigned short)(k2 & 0xFFFFu); \
                    *(LAS unsigned short*)(lds + (4 * (2 * pr + 1) + g) * SC_PITCH + s * 2) = (unsigned short)(k2 >> 16); } \
                A_LOAD(BN, (j + 3 < jn) ? j + 3 : jn - 1); } while (0)
            A_LOAD(bn0, 0); A_LOAD(bn1, (jn > 1) ? 1 : 0); A_LOAD(bn2, (jn > 2) ? 2 : jn - 1);
#pragma unroll 1
            for (int j3 = 0; j3 < jn; j3 += 3) { A_STEP(bn0, j3); if (j3 + 1 < jn) A_STEP(bn1, j3 + 1); if (j3 + 2 < jn) A_STEP(bn2, j3 + 2); }
            asm volatile("s_waitcnt vmcnt(0)" : "+v"(bn0[0]), "+v"(bn0[1]), "+v"(bn1[0]), "+v"(bn1[1]), "+v"(bn2[0]), "+v"(bn2[1]) :: "memory");
#undef A_LOAD
#undef A_WAIT
#undef A_STEP
        }
#endif
        __builtin_amdgcn_sched_barrier(0); lds_barrier(); __builtin_amdgcn_sched_barrier(0);
#ifndef DSA_NO_C
#pragma unroll 1
        for (int rr = 0; rr < ((DSAREP & 2) ? 4 : 2); ++rr) {
            const int rl = 2 * wave + (rr & 1), t = t0 + rl;
            LAS unsigned short* sel = SELL + rl * 256;
            if (t < TOPK) {
#pragma unroll
                for (int k = 0; k < 4; ++k) { const int jx = lane_o + 64 * k; sel[jx] = (jx <= t) ? (unsigned short)jx : (unsigned short)0xFFFF; }
                continue;
            }
            const LAS unsigned* srow = (const LAS unsigned*)(lds + rl * SC_PITCH) + lane_o;
#define DSA_KEY(jj_) (srow[(jj_) * 64])
            LAS unsigned* hist = (LAS unsigned*)(lds + DSA_HIST_OFF + wave * 1280);
            unsigned prefix = 0u; int kneed = TOPK;
#pragma unroll 1
            for (int pass = 0; pass < 2; ++pass) {
                *(LAS u32x4*)(hist + 4 * lane_o) = (u32x4){0u, 0u, 0u, 0u};
                asm volatile("s_waitcnt lgkmcnt(0)" ::: "memory");
                if (pass == 0) {
#pragma unroll 4
                    for (int jj = 0; jj < jn; ++jj) { const unsigned k = DSA_KEY(jj);
                        __hip_atomic_fetch_add(hist + (k >> 24), 1u, __ATOMIC_RELAXED, __HIP_MEMORY_SCOPE_WORKGROUP);
                        __hip_atomic_fetch_add(hist + ((k >> 8) & 0xFFu), 1u, __ATOMIC_RELAXED, __HIP_MEMORY_SCOPE_WORKGROUP);
                        if (DSAREP & 8) { __hip_atomic_fetch_add(hist + (k >> 24), 1u, __ATOMIC_RELAXED, __HIP_MEMORY_SCOPE_WORKGROUP); __hip_atomic_fetch_add(hist + ((k >> 8) & 0xFFu), 1u, __ATOMIC_RELAXED, __HIP_MEMORY_SCOPE_WORKGROUP);
                            __hip_atomic_fetch_add(hist + (k >> 24), 0xFFFFFFFFu, __ATOMIC_RELAXED, __HIP_MEMORY_SCOPE_WORKGROUP); __hip_atomic_fetch_add(hist + ((k >> 8) & 0xFFu), 0xFFFFFFFFu, __ATOMIC_RELAXED, __HIP_MEMORY_SCOPE_WORKGROUP); } }
                } else {
#pragma unroll 4
                    for (int jj = 0; jj < jn; ++jj) { const unsigned k = DSA_KEY(jj);
                        const unsigned dump = 256u + (unsigned)lane_o;
                        __hip_atomic_fetch_add(hist + (((k >> 24) == prefix) ? ((k >> 16) & 0xFFu) : dump), 1u, __ATOMIC_RELAXED, __HIP_MEMORY_SCOPE_WORKGROUP);
                        __hip_atomic_fetch_add(hist + ((((k >> 8) & 0xFFu) == prefix) ? (k & 0xFFu) : dump), 1u, __ATOMIC_RELAXED, __HIP_MEMORY_SCOPE_WORKGROUP); }
                }
                asm volatile("s_waitcnt lgkmcnt(0)" ::: "memory");
                const u32x4 hv = *(const LAS u32x4*)(hist + 4 * lane_o);
                const int sl = (int)(hv.x + hv.y + hv.z + hv.w);
                const int pre = wave_incl_scan_i(sl);
                const int tot = __builtin_amdgcn_readlane(pre, 63);
                const int S = tot - pre + sl;
                const int excl = S - sl;
                const unsigned long long bm = __ballot(excl < kneed && S >= kneed);
                const int L = bm ? (int)__builtin_ctzll(bm) : 0;
                const int ex = __builtin_amdgcn_readlane(excl, L); const int h1 = __builtin_amdgcn_readlane((int)hv.y, L), h2 = __builtin_amdgcn_readlane((int)hv.z, L), h3 = __builtin_amdgcn_readlane((int)hv.w, L);
                int cabove = ex, bin;
                if (cabove + h3 >= kneed) bin = 3; else { cabove += h3;
                    if (cabove + h2 >= kneed) bin = 2; else { cabove += h2;
                        if (cabove + h1 >= kneed) bin = 1; else { cabove += h1; bin = 0; } } }
                prefix = (prefix << 8) | (unsigned)(4 * L + bin); kneed -= cabove;
            }
            const unsigned lo = prefix << 16, hi = (prefix + 1u) << 16;
            const int tot_gt = TOPK - kneed, need = kneed;
            LAS unsigned short* dumpp = (LAS unsigned short*)(hist + 256) + lane_o;
            for (int er_ = 0; er_ < ((DSAREP & 16) ? 2 : 1); ++er_) {
            int base = 0, tbase = 0;
#pragma unroll 2
            for (int jj = 0; jj < jn; ++jj) { const unsigned k = DSA_KEY(jj);
                const int s0 = 2 * (jj * 64 + lane_o); const unsigned kb = k << 16;
                const bool g0 = kb >= hi, g1 = k >= hi;
                const unsigned long long m0 = __ballot(g0), m1 = __ballot(g1);
                const int p0 = base + (int)__builtin_amdgcn_mbcnt_hi((unsigned)(m0 >> 32), __builtin_amdgcn_mbcnt_lo((unsigned)m0, 0u)); base += __popcll(m0);
                const int p1 = base + (int)__builtin_amdgcn_mbcnt_hi((unsigned)(m1 >> 32), __builtin_amdgcn_mbcnt_lo((unsigned)m1, 0u)); base += __popcll(m1);
                *(g0 ? sel + p0 : dumpp) = (unsigned short)s0;
                *(g1 ? sel + p1 : dumpp) = (unsigned short)(s0 + 1);
                const bool e0 = (kb >= lo) && !g0, e1 = (k >= lo) && !g1;
                const unsigned long long t0m = __ballot(e0), t1m = __ballot(e1);
                if (t0m | t1m) {
                    const int r0 = tbase + (int)__builtin_amdgcn_mbcnt_hi((unsigned)(t0m >> 32), __builtin_amdgcn_mbcnt_lo((unsigned)t0m, 0u)); tbase += __popcll(t0m);
                    const int r1 = tbase + (int)__builtin_amdgcn_mbcnt_hi((unsigned)(t1m >> 32), __builtin_amdgcn_mbcnt_lo((unsigned)t1m, 0u)); tbase += __popcll(t1m);
                    if (e0 && r0 < need) sel[tot_gt + r0] = (unsigned short)s0;
                    if (e1 && r1 < need) sel[tot_gt + r1] = (unsigned short)(s0 + 1);
                }
            }
            }
#undef DSA_KEY
        }
#endif
        __builtin_amdgcn_sched_barrier(0); lds_barrier(); __builtin_amdgcn_sched_barrier(0);
#ifndef DSA_NO_D
        LAS unsigned char* kvb = lds + wave * 16384;
        const unsigned char* CKV8 = ws + WS_CKV8;
#pragma unroll 1
        for (int rr = 0; rr < ((DSAREP & 4) ? 4 : 2); ++rr) {
            const int rl = 2 * wave + (rr & 1), t = t0 + rl; const size_t q = qb + t;
            const LAS unsigned short* sel = SELL + rl * 256;
            long qf8[4];
#pragma unroll
            for (int ks = 0; ks < 4; ++ks) { const f16x8 v = *(const f16x8*)(QI + q * NQI + (r16 & 7) * 128 + 32 * ks + 8 * g); const float zs = (r16 >= 8) ? 0.f : 64.f;
                int lo32 = __builtin_amdgcn_cvt_pk_fp8_f32((float)v[0] * zs, (float)v[1] * zs, 0, false); lo32 = __builtin_amdgcn_cvt_pk_fp8_f32((float)v[2] * zs, (float)v[3] * zs, lo32, true);
                int hi32 = __builtin_amdgcn_cvt_pk_fp8_f32((float)v[4] * zs, (float)v[5] * zs, 0, false); hi32 = __builtin_amdgcn_cvt_pk_fp8_f32((float)v[6] * zs, (float)v[7] * zs, hi32, true);
                qf8[ks] = (long)(((unsigned long long)(unsigned)hi32 << 32) | (unsigned)lo32); }
            const LAS float* BLh = BL + (r16 & 7);
            float m_run = -1e30f, l_run = 0.f;
            f32x4 oE[4], oO[4];
#pragma unroll
            for (int cb = 0; cb < 4; ++cb) { oE[cb] = (f32x4){0.f, 0.f, 0.f, 0.f}; oO[cb] = (f32x4){0.f, 0.f, 0.f, 0.f}; }
            const int nch = (t < TOPK) ? (t >> 6) + 1 : 4;
#define DSA_DMA(ch_) do { unsigned so_[8]; _Pragma("unroll") for (int i = 0; i < 8; ++i) { const int R = 8 * i + (lane_o >> 3); \
                const unsigned ix = sel[64 * (ch_) + R]; const unsigned srow = (ix == 0xFFFFu) ? 0u : ix; so_[i] = srow * 128u + 16u * (((unsigned)lane_o & 7u) ^ ((unsigned)R & 7u)); } \
            _Pragma("unroll") for (int i = 0; i < 8; ++i) __builtin_amdgcn_global_load_lds((const unsigned*)(ckvb + so_[i]), (LAS unsigned*)(kvb + i * 1024), 16, 0, 0); } while (0)
            const unsigned char* ckvb = CKV8 + qb * 128;
            asm volatile("s_waitcnt vmcnt(0)" ::: "memory");
            DSA_DMA(0);
            const int qq = (lane_o & 15) >> 2, pp = lane_o & 3;
            unsigned offA[4][4], offT[4][2][2];
#pragma unroll
            for (int mt = 0; mt < 4; ++mt) { const int row = 16 * mt + r16;
#pragma unroll
                for (int ks = 0; ks < 4; ++ks) offA[mt][ks] = row * 128 + 16 * ((2 * ks + (g >> 1)) ^ (row & 7)) + 8 * (g & 1); }
#pragma unroll
            for (int cb = 0; cb < 4; ++cb)
#pragma unroll
                for (int k2 = 0; k2 < 2; ++k2) { const int r1 = 32 * k2 + 4 * g + qq, r2 = r1 + 16;
                    offT[cb][k2][0] = r1 * 128 + 16 * ((2 * cb + (pp >> 1)) ^ (r1 & 7)) + 8 * (pp & 1); offT[cb][k2][1] = r2 * 128 + 16 * ((2 * cb + (pp >> 1)) ^ (r2 & 7)) + 8 * (pp & 1); }
#pragma unroll 1
            for (int ch = 0; ch < nch; ++ch) {
                asm volatile("s_waitcnt vmcnt(0)" ::: "memory");
                long af[4][4]; u32x2 td[4][2][2];
#pragma unroll
                for (int mt = 0; mt < 4; ++mt)
#pragma unroll
                    for (int ks = 0; ks < 4; ++ks) af[mt][ks] = *(const LAS long*)(kvb + offA[mt][ks]);
#pragma unroll
                for (int cb = 0; cb < 4; ++cb)
#pragma unroll
                    for (int k2 = 0; k2 < 2; ++k2) { td[cb][k2][0] = __builtin_bit_cast(u32x2, tr_read16(kvb + offT[cb][k2][0])); td[cb][k2][1] = __builtin_bit_cast(u32x2, tr_read16(kvb + offT[cb][k2][1])); }
                float bvv[4][4]; bool inv4[4][4];
#pragma unroll
                for (int mt = 0; mt < 4; ++mt) { const u32x2 pk2 = *(const LAS u32x2*)(sel + 64 * ch + 16 * mt + 4 * g);
#pragma unroll
                    for (int e = 0; e < 4; ++e) { const unsigned ix = ((e & 2) ? pk2.y : pk2.x) >> ((e & 1) * 16) & 0xFFFFu;
                        const int rel = t - (int)ix; const int rc = min(max(rel, 0), 128);
                        inv4[mt][e] = (ix == 0xFFFFu); bvv[mt][e] = BLh[rc * 8]; } }
                asm volatile("s_waitcnt lgkmcnt(0)" : "+v"(bvv[0][0]), "+v"(bvv[0][1]), "+v"(bvv[0][2]), "+v"(bvv[0][3]), "+v"(bvv[1][0]), "+v"(bvv[1][1]), "+v"(bvv[1][2]), "+v"(bvv[1][3]),
                             "+v"(bvv[2][0]), "+v"(bvv[2][1]), "+v"(bvv[2][2]), "+v"(bvv[2][3]), "+v"(bvv[3][0]), "+v"(bvv[3][1]), "+v"(bvv[3][2]), "+v"(bvv[3][3]) :: "memory");
                if (ch + 1 < nch) DSA_DMA(ch + 1);
                f32x4 lg[4];
#pragma unroll
                for (int mt = 0; mt < 4; ++mt) { lg[mt] = (f32x4){0.f, 0.f, 0.f, 0.f};
#pragma unroll
                    for (int ks = 0; ks < 4; ++ks) lg[mt] = __builtin_amdgcn_mfma_f32_16x16x32_fp8_fp8(af[mt][ks], qf8[ks], lg[mt], 0, 0, 0); }
                float cmax = -INFINITY;
#pragma unroll
                for (int mt = 0; mt < 4; ++mt)
#pragma unroll
                    for (int e = 0; e < 4; ++e) { const float v = inv4[mt][e] ? -INFINITY : lg[mt][e] * 0.015625f + bvv[mt][e]; lg[mt][e] = v; cmax = fmaxf(cmax, v); }
                cmax = fmaxf(cmax, __shfl_xor(cmax, 16)); cmax = fmaxf(cmax, __shfl_xor(cmax, 32));
                const float m_new = fmaxf(m_run, cmax); const float alpha = __expf(m_run - m_new); m_run = m_new;
                float ps = 0.f; long pf8[2];
#pragma unroll
                for (int k2 = 0; k2 < 2; ++k2) { float pv[8];
#pragma unroll
                    for (int mt = 0; mt < 2; ++mt)
#pragma unroll
                        for (int e = 0; e < 4; ++e) { const float p = __expf(lg[2 * k2 + mt][e] - m_new); ps += p; pv[mt * 4 + e] = p; }
                    int plo = __builtin_amdgcn_cvt_pk_fp8_f32(pv[0], pv[1], 0, false); plo = __builtin_amdgcn_cvt_pk_fp8_f32(pv[2], pv[3], plo, true);
                    int phi = __builtin_amdgcn_cvt_pk_fp8_f32(pv[4], pv[5], 0, false); phi = __builtin_amdgcn_cvt_pk_fp8_f32(pv[6], pv[7], phi, true);
                    pf8[k2] = (long)(((unsigned long long)(unsigned)phi << 32) | (unsigned)plo); }
                l_run = l_run * alpha + ps;
#pragma unroll
                for (int cb = 0; cb < 4; ++cb) { oE[cb] *= alpha; oO[cb] *= alpha; }
#pragma unroll
                for (int cb = 0; cb < 4; ++cb)
#pragma unroll
                    for (int k2 = 0; k2 < 2; ++k2) {
                        const u32x2 d1 = td[cb][k2][0], d2 = td[cb][k2][1];
                        const unsigned xe0 = __builtin_amdgcn_perm(d1.y, d1.x, 0x06040200u), xo0 = __builtin_amdgcn_perm(d1.y, d1.x, 0x07050301u);
                        const unsigned xe1 = __builtin_amdgcn_perm(d2.y, d2.x, 0x06040200u), xo1 = __builtin_amdgcn_perm(d2.y, d2.x, 0x07050301u);
                        oE[cb] = __builtin_amdgcn_mfma_f32_16x16x32_fp8_fp8((long)(((unsigned long long)xe1 << 32) | xe0), pf8[k2], oE[cb], 0, 0, 0);
                        oO[cb] = __builtin_amdgcn_mfma_f32_16x16x32_fp8_fp8((long)(((unsigned long long)xo1 << 32) | xo0), pf8[k2], oO[cb], 0, 0, 0);
                    }
            }
#undef DSA_DMA
            l_run += __shfl_xor(l_run, 16); l_run += __shfl_xor(l_run, 32);
            const float inv = 1.f / l_run;
            if (r16 < 8) {
#pragma unroll
                for (int cb = 0; cb < 4; ++cb) { u32x4 w; w.x = pkh(oE[cb][0] * inv, oO[cb][0] * inv); w.y = pkh(oE[cb][1] * inv, oO[cb][1] * inv); w.z = pkh(oE[cb][2] * inv, oO[cb][2] * inv); w.w = pkh(oE[cb][3] * inv, oO[cb][3] * inv);
                    *(u32x4*)(OATT + q * KOUT + r16 * 128 + 32 * cb + 8 * g) = w; }
            }
        }
#endif
    }
}

template <int CTRL> __device__ __forceinline__ float dpp_f(float x) { return __builtin_bit_cast(float, __builtin_amdgcn_update_dpp(0, __builtin_bit_cast(int, x), CTRL, 0xF, 0xF, false)); }
__device__ __forceinline__ float row16_sum(float x) { x += dpp_f<0x128>(x); x += dpp_f<0x124>(x); x += dpp_f<0x122>(x); x += dpp_f<0x121>(x); return x; }
constexpr int SCAN_TB = 32;
__device__ __forceinline__ void p7_scan(const Args& a, LAS unsigned char* lds, int vcu, int G, int wave, int lane) {
    unsigned char* ws = a.ws;
    const f16* PROJ = (const f16*)(ws + WS_PROJ); const f16* RWW = (const f16*)(ws + WS_RWW); const f16* RWA = (const f16*)(ws + WS_RWA);
    float* YRAW = (float*)(ws + WS_YRAW);
    for (int u = vcu; u < BATCH * HRW * 2; u += G) {
        const int half = u & 1, h = (u >> 1) & 7, b = u >> 4;
        const int ch = h * 64 + lane;
        const float mu_r = a.in[17][ch], mu_k = a.in[17][512 + ch], mu_v = a.in[17][1024 + ch], kkc = a.in[23][ch], kac = a.in[24][ch];
        const int rr = lane >> 4, qd = lane & 15, irow = half * 32 + wave * 4 + rr;
        float S0 = 0.f, S1 = 0.f, S2 = 0.f, S3 = 0.f;
#define SCAN_LOAD(blk_) do { _Pragma("unroll") for (int tt = 0; tt < 4; ++tt) { const int t = (blk_) * SCAN_TB + wave * 4 + tt; const size_t m = (size_t)(b << 12) + t; \
            const f16* pr = PROJ + m * IN_PAD + h * 64 + lane; \
            st_r[tt] = (float)pr[C_R]; st_k[tt] = (float)pr[C_K]; st_v[tt] = (float)pr[C_V]; \
            if (t > 0) { st_rp[tt] = (float)pr[C_R - IN_PAD]; st_kp[tt] = (float)pr[C_K - IN_PAD]; st_vp[tt] = (float)pr[C_V - IN_PAD]; } else { st_rp[tt] = 0.f; st_kp[tt] = 0.f; st_vp[tt] = 0.f; } \
            st_lw[tt] = (float)RWW[m * RW + ch]; st_av[tt] = (float)RWA[m * RW + ch]; } } while (0)
#define SCAN_WRITE(buf_) do { LAS float* base_ = (LAS float*)(lds + (buf_) * 49152); _Pragma("unroll") for (int tt = 0; tt < 4; ++tt) { const int tl = wave * 4 + tt; \
            const float rs = st_r[tt] + mu_r * (st_rp[tt] - st_r[tt]), ks = st_k[tt] + mu_k * (st_kp[tt] - st_k[tt]), vs = st_v[tt] + mu_v * (st_vp[tt] - st_v[tt]); \
            const float kkv = ks * kkc; const float nrm = sqrtf(wave_sum(kkv * kkv)); const float kkn = kkv / fmaxf(nrm, 1e-12f); \
            const float av = st_av[tt]; const float km = ks * (1.f + (av - 1.f) * kac); \
            base_[0 * 2048 + tl * 64 + lane] = rs; base_[1 * 2048 + tl * 64 + lane] = __expf(st_lw[tt]); base_[2 * 2048 + tl * 64 + lane] = km; \
            base_[3 * 2048 + tl * 64 + lane] = vs; base_[4 * 2048 + tl * 64 + lane] = -kkn; base_[5 * 2048 + tl * 64 + lane] = kkn * av; } } while (0)
        float st_r[4], st_k[4], st_v[4], st_rp[4], st_kp[4], st_vp[4], st_lw[4], st_av[4];
        __syncthreads();
        SCAN_LOAD(0); SCAN_WRITE(0);
        constexpr int NBLK = SEQ / SCAN_TB;
        for (int blk = 0; blk < NBLK; ++blk) {
            __syncthreads();
            if (blk + 1 < NBLK) SCAN_LOAD(blk + 1);
            const LAS float* base = (const LAS float*)(lds + (blk & 1) * 49152);
            for (int tl = 0; tl < SCAN_TB; ++tl) {
                const f32x4 r4 = *(const LAS f32x4*)(base + 0 * 2048 + tl * 64 + 4 * qd), w4 = *(const LAS f32x4*)(base + 1 * 2048 + tl * 64 + 4 * qd), k4 = *(const LAS f32x4*)(base + 2 * 2048 + tl * 64 + 4 * qd);
                const f32x4 a4 = *(const LAS f32x4*)(base + 4 * 2048 + tl * 64 + 4 * qd), b4 = *(const LAS f32x4*)(base + 5 * 2048 + tl * 64 + 4 * qd);
                const float vi = base[3 * 2048 + tl * 64 + irow];
                float sa = S0 * a4[0] + S1 * a4[1] + S2 * a4[2] + S3 * a4[3];
                sa = row16_sum(sa);
                S0 = S0 * w4[0] + sa * b4[0] + vi * k4[0]; S1 = S1 * w4[1] + sa * b4[1] + vi * k4[1]; S2 = S2 * w4[2] + sa * b4[2] + vi * k4[2]; S3 = S3 * w4[3] + sa * b4[3] + vi * k4[3];
                float y = S0 * r4[0] + S1 * r4[1] + S2 * r4[2] + S3 * r4[3];
                y = row16_sum(y);
                if (qd == 0) YRAW[((size_t)(b << 12) + blk * SCAN_TB + tl) * RW + h * 64 + irow] = y;
            }
            if (blk + 1 < NBLK) SCAN_WRITE((blk + 1) & 1);
        }
        __syncthreads();
    }
}

__device__ __forceinline__ void p8_rwkv_post(const Args& a, int vcu, int G, int wave, int lane) {
    unsigned char* ws = a.ws;
    const f16* PROJ = (const f16*)(ws + WS_PROJ); const f16* RWA = (const f16*)(ws + WS_RWA); const f16* RWG = (const f16*)(ws + WS_RWG);
    const float* YRAW = (const float*)(ws + WS_YRAW); f16* OATT = (f16*)(ws + WS_OATT);
    const int gw = vcu * NWAVES + wave, NGW = G * NWAVES;
    for (int it = gw; it < MTOK * HRW; it += NGW) {
        const int m = it >> 3, h = it & 7, ch = h * 64 + lane, t = m & (SEQ - 1);
        const f16* pr = PROJ + (size_t)m * IN_PAD + ch;
        float r = (float)pr[C_R], k = (float)pr[C_K], v = (float)pr[C_V], rp = 0.f, kp = 0.f, vp = 0.f;
        if (t > 0) { rp = (float)pr[C_R - IN_PAD]; kp = (float)pr[C_K - IN_PAD]; vp = (float)pr[C_V - IN_PAD]; }
        const float rs = r + a.in[17][ch] * (rp - r), ks = k + a.in[17][512 + ch] * (kp - k), vs = v + a.in[17][1024 + ch] * (vp - v);
        const float av = (float)RWA[(size_t)m * RW + ch];
        const float km = ks * (1.f + (av - 1.f) * a.in[24][ch]);
        const float y = YRAW[(size_t)m * RW + ch];
        const float mean = wave_sum(y) * (1.f / 64.f); const float dy = y - mean;
        const float var = wave_sum(dy * dy) * (1.f / 64.f);
        const float yn = dy * rsqrtf(var + GN_EPS) * a.in[26][ch] + a.in[27][ch];
        const float bonus = wave_sum(rs * km * a.in[25][ch]) * vs;
        OATT[(size_t)m * KOUT + 1024 + ch] = (f16)((yn + bonus) * (float)RWG[(size_t)m * RW + ch]);
    }
}

typedef short bf16x8 __attribute__((ext_vector_type(8)));
typedef _Float16 f16x4v __attribute__((ext_vector_type(4)));
__device__ __forceinline__ unsigned f2bf(float f) { unsigned u = __builtin_bit_cast(unsigned, f); return (u + 0x7fffu + ((u >> 16) & 1u)) >> 16; }
__device__ __forceinline__ unsigned pkb(float lo, float hi) { unsigned r; asm("v_cvt_pk_bf16_f32 %0, %1, %2" : "=v"(r) : "v"(lo), "v"(hi)); return r; }
constexpr int XP = 144;
constexpr int XD_OFF = 0, XA_OFF = 9216, XG_OFF = 18432, XG_P = 336;
constexpr int LAB_OFF = 0, LAK_OFF = 9216, LRB_OFF = 18432, LRK_OFF = 27648;
constexpr int AB_OFF = 39936, RB_OFF = AB_OFF + 9216, BB_OFF = RB_OFF + 9216, KB_OFF = BB_OFF + 9216;
constexpr int TT_OFF = 39936, M1T_OFF = TT_OFF + 9216, A2T_OFF = M1T_OFF + 9216, U1T_OFF = A2T_OFF + 9216;
constexpr int AH_OFF = 76800, VH_OFF = AH_OFF + 9216, BP_OFF = VH_OFF + 9216, KP_OFF = BP_OFF + 9216, RH_OFF = KP_OFF + 9216;
constexpr int NRM_OFF = 122880, CUMB_OFF = NRM_OFF + 512, XCONST_OFF = CUMB_OFF + 1024;
constexpr size_t WS_WDT = 28 * MiB, WS_WAT = WS_WDT + 65536, WS_WGT = WS_WAT + 65536;
constexpr size_t WS_RWP = 32 * MiB, WS_RWQ = 64 * MiB, WS_RWR2 = 408 * MiB, WS_RWY1 = 440 * MiB, WS_RWS0 = 472 * MiB, WS_BON = 364 * MiB;
constexpr int NUNIT = BATCH * 64 * HRW;

__device__ __forceinline__ f16x8 rd_row(LAS unsigned char* base, int pitch, int row, int col) { return *(const LAS f16x8*)(base + row * pitch + col * 2); }
__device__ __forceinline__ bf16x8 rd_rowb(LAS unsigned char* base, int pitch, int row, int col) { return *(const LAS bf16x8*)(base + row * pitch + col * 2); }
__device__ __forceinline__ f16x8 rd_tr(LAS unsigned char* base, int k0, int c0, int g, int qq, int pp) {
    const f16x4 v0 = tr_read16(base + (k0 + 8 * g + qq) * XP + (c0 + 4 * pp) * 2), v1 = tr_read16(base + (k0 + 8 * g + 4 + qq) * XP + (c0 + 4 * pp) * 2);
    return (f16x8){v0[0], v0[1], v0[2], v0[3], v1[0], v1[1], v1[2], v1[3]};
}
__device__ __forceinline__ void wr4h(LAS unsigned char* p, const f32x4& v) { u32x2 w; w.x = pkh(v[0], v[1]); w.y = pkh(v[2], v[3]); *(LAS u32x2*)p = w; }
__device__ __forceinline__ float dpp_shr_f(float x, int) { return x; }
template <int CTRL> __device__ __forceinline__ float dpp_z(float x) { return __builtin_bit_cast(float, __builtin_amdgcn_update_dpp(0, __builtin_bit_cast(int, x), CTRL, 0xF, 0xF, true)); }
__device__ __forceinline__ float row16_incl_scan(float x) { x += dpp_z<0x111>(x); x += dpp_z<0x112>(x); x += dpp_z<0x114>(x); x += dpp_z<0x118>(x); return x; }
#define MFMA_H(a, b, c) __builtin_amdgcn_mfma_f32_16x16x32_f16((a), (b), (c), 0, 0, 0)
#define MFMA_B(a, b, c) __builtin_amdgcn_mfma_f32_16x16x32_bf16((a), (b), (c), 0, 0, 0)
#define MFMA_H16(a, b, c) __builtin_amdgcn_mfma_f32_16x16x16f16((a), (b), (c), 0, 0, 0)
__device__ __forceinline__ f16x4 cvt4h(const f32x4& v) { return (f16x4){(f16)v[0], (f16)v[1], (f16)v[2], (f16)v[3]}; }
__device__ __forceinline__ f32x4 cvt4f(const f16x4& v) { return (f32x4){(float)v[0], (float)v[1], (float)v[2], (float)v[3]}; }

__device__ __forceinline__ void p7x_chunks(const Args& a, LAS unsigned char* lds, int vcu, int G, int tid, int wave, int lane) {
    unsigned char* ws = a.ws;
    const f16* PROJ = (const f16*)(ws + WS_PROJ);
    const f16* WDT = (const f16*)(ws + WS_WDT); const f16* WAT = (const f16*)(ws + WS_WAT); const f16* WGT = (const f16*)(ws + WS_WGT);
    f16* RWG = (f16*)(ws + WS_RWG); f16* RWP = (f16*)(ws + WS_RWP); f16* RWQ = (f16*)(ws + WS_RWQ); f16* RWR2 = (f16*)(ws + WS_RWR2); f16* RWY1 = (f16*)(ws + WS_RWY1);
    float* BON = (float*)(ws + WS_BON);
    const float* mu = a.in[17];
    const f32x4 z4 = {0.f, 0.f, 0.f, 0.f};
    const bool bal = (G == 256); const int bxx = blockIdx.x;
    const int nit = bal ? 16 : (NUNIT + G - 1) / G;
#define X_UNIT(itx_) (bal ? ((((bxx & 7) * 64 + (((bxx >> 3) + 32 * (itx_)) >> 3)) * 8 + (((bxx >> 3) + 32 * (itx_)) & 7))) : (vcu + (itx_) * G))
    f16x4 rv0[9], rv1c, rv1p, prc[2], pkc[2], pvc[2], prp[2], pkp[2], pvp[2];
    f16x8 wfd[2][2], wfa[2][2], wfg[2][5];
    int h_tab = -1;
#define X_PREFETCH(u_) do { int lp = lane; asm volatile("" : "+v"(lp)); const int h_ = (u_) & 7, c_ = ((u_) >> 3) & 63, b_ = (u_) >> 9; const size_t m0_ = (size_t)(b_ << 12) + c_ * 64; \
        _Pragma("unroll") for (int i = 0; i < 9; ++i) { const int t_ = 8 * wave + i - 1; const bool ok_ = (t_ >= 0 || c_ > 0); const f16* rowp = PROJ + (m0_ + t_) * IN_PAD + C_WD; \
            rv0[i] = (f16x4){0, 0, 0, 0}; if (ok_) rv0[i] = *(const f16x4*)(rowp + 4 * lp); } \
        { const int t1_ = 8 * wave + (lp >> 3); const f16* rp1 = PROJ + (m0_ + t1_) * IN_PAD + C_WD + 256 + 4 * (lp & 7); rv1c = *(const f16x4*)rp1; rv1p = (f16x4){0, 0, 0, 0}; if (t1_ > 0 || c_ > 0) rv1p = *(const f16x4*)(rp1 - IN_PAD); } \
        _Pragma("unroll") for (int ci = 0; ci < 2; ++ci) { const int chr_ = h_ * 64 + 16 * (2 * (wave >> 2) + ci) + (lp & 15); \
            _Pragma("unroll") for (int ks = 0; ks < 2; ++ks) { wfd[ci][ks] = *(const f16x8*)(WDT + (size_t)chr_ * 64 + 32 * ks + 8 * (lp >> 4)); wfa[ci][ks] = *(const f16x8*)(WAT + (size_t)chr_ * 64 + 32 * ks + 8 * (lp >> 4)); } \
            _Pragma("unroll") for (int ks = 0; ks < 5; ++ks) wfg[ci][ks] = *(const f16x8*)(WGT + (size_t)chr_ * 192 + 32 * ks + 8 * (lp >> 4)); } \
        const int t2_ = 16 * (wave & 3) + (lp & 15); const size_t m_ = m0_ + t2_; \
        _Pragma("unroll") for (int ci = 0; ci < 2; ++ci) { const int ch_ = h_ * 64 + 16 * (2 * (wave >> 2) + ci) + 4 * (lp >> 4); \
            prc[ci] = *(const f16x4*)(PROJ + m_ * IN_PAD + C_R + ch_); pkc[ci] = *(const f16x4*)(PROJ + m_ * IN_PAD + C_K + ch_); pvc[ci] = *(const f16x4*)(PROJ + m_ * IN_PAD + C_V + ch_); \
            prp[ci] = (f16x4){0, 0, 0, 0}; pkp[ci] = (f16x4){0, 0, 0, 0}; pvp[ci] = (f16x4){0, 0, 0, 0}; \
            if ((c_ * 64 + t2_) != 0) { prp[ci] = *(const f16x4*)(PROJ + (m_ - 1) * IN_PAD + C_R + ch_); pkp[ci] = *(const f16x4*)(PROJ + (m_ - 1) * IN_PAD + C_K + ch_); pvp[ci] = *(const f16x4*)(PROJ + (m_ - 1) * IN_PAD + C_V + ch_); } } } while (0)
    { const int u0 = X_UNIT(0); if (u0 < NUNIT) X_PREFETCH(u0); }
#pragma unroll 1
    for (int itx = 0; itx < nit; ++itx) {
        const int u = X_UNIT(itx); if (u >= NUNIT) break;
        const int un = (itx + 1 < nit) ? X_UNIT(itx + 1) : NUNIT;
        int lane_o = lane; asm volatile("" : "+v"(lane_o));
        const int r16 = lane_o & 15, g = lane_o >> 4, qq = r16 >> 2, pp = lane_o & 3;
        const int h = u & 7, c = (u >> 3) & 63, b = u >> 9;
        const size_t m0 = (size_t)(b << 12) + c * 64;
        lds_barrier();
        if (h != h_tab) { h_tab = h;
            if (tid < 64) { const int ch = h * 64 + tid; LAS float* ct = (LAS float*)(lds + XCONST_OFF) + tid;
                ct[0] = mu[ch]; ct[64] = mu[512 + ch]; ct[128] = mu[1024 + ch]; ct[192] = a.in[18][ch]; ct[256] = a.in[20][ch]; ct[320] = a.in[23][ch]; ct[384] = a.in[24][ch]; ct[448] = a.in[25][ch]; } }
        {
            const f32x4 mu0 = *(const f32x4*)(mu + 1536 + 4 * lane_o); const f32x4 mu1 = *(const f32x4*)(mu + 1536 + 256 + 4 * (lane_o & 7));
            const float kf = lane_o < 16 ? 2.f : 1.f; const bool is_t = lane_o < 16, is_id = (lane_o >= 16 && lane_o < 32);
            LAS unsigned char* d0 = is_t ? lds + XD_OFF + 8 * lane_o : is_id ? lds + XA_OFF + 8 * (lane_o - 16) : lds + XG_OFF + 8 * (lane_o - 32);
            const int p0 = (lane_o < 32) ? XP : XG_P;
#pragma unroll
            for (int i = 0; i < 8; ++i) { const int t = 8 * wave + i; float o[4];
#pragma unroll
                for (int e = 0; e < 4; ++e) { const float cu = (float)rv0[i + 1][e], pv = (float)rv0[i][e]; const float x = cu + mu0[e] * (pv - cu);
                    const float sg = __builtin_amdgcn_rcpf(1.f + __expf(-kf * x)); o[e] = is_t ? 2.f * sg - 1.f : is_id ? x : sg; }
                u32x2 w; w.x = pkh(o[0], o[1]); w.y = pkh(o[2], o[3]); *(LAS u32x2*)(d0 + t * p0) = w; }
            {
                float o1[4];
#pragma unroll
                for (int e = 0; e < 4; ++e) { const float cu1 = (float)rv1c[e], pv1 = (float)rv1p[e]; const float x1 = cu1 + mu1[e] * (pv1 - cu1); o1[e] = __builtin_amdgcn_rcpf(1.f + __expf(-x1)); }
                u32x2 w1; w1.x = pkh(o1[0], o1[1]); w1.y = pkh(o1[2], o1[3]); *(LAS u32x2*)(lds + XG_OFF + (8 * wave + (lane_o >> 3)) * XG_P + (128 + 4 * (lane_o & 7)) * 2) = w1; }
        }
        lds_barrier();
        const int tb = wave & 3, cth = wave >> 2;
        const int t = 16 * tb + r16; const size_t m = m0 + t;
        f32x4 dA[2], aA[2], gA[2];
#pragma unroll
        for (int ci = 0; ci < 2; ++ci) {
            dA[ci] = z4; aA[ci] = z4; gA[ci] = z4;
#pragma unroll
            for (int ks = 0; ks < 2; ++ks) {
                dA[ci] = MFMA_H(wfd[ci][ks], rd_row(lds + XD_OFF, XP, t, 32 * ks + 8 * g), dA[ci]);
                aA[ci] = MFMA_H(wfa[ci][ks], rd_row(lds + XA_OFF, XP, t, 32 * ks + 8 * g), aA[ci]); }
#pragma unroll
            for (int ks = 0; ks < 5; ++ks) gA[ci] = MFMA_H(wfg[ci][ks], rd_row(lds + XG_OFF, XG_P, t, 32 * ks + 8 * g), gA[ci]);
        }
        float lwv[2][4], asg[2][4], rs[2][4], kp[2][4], vs[2][4], kkv[2][4], cl[2][4];
        float pn = 0.f, prk = 0.f;
#pragma unroll
        for (int ci = 0; ci < 2; ++ci) {
            const int chl = 16 * (2 * cth + ci) + 4 * g, ch = h * 64 + chl;
            const f16x4 rc = prc[ci], kc = pkc[ci], vc = pvc[ci], rp = prp[ci], kq = pkp[ci], vp = pvp[ci];
            const LAS float* ct = (const LAS float*)(lds + XCONST_OFF) + chl;
            const f32x4 mur = *(const LAS f32x4*)(ct), muk = *(const LAS f32x4*)(ct + 64), muv = *(const LAS f32x4*)(ct + 128);
            const f32x4 w0 = *(const LAS f32x4*)(ct + 192), a0 = *(const LAS f32x4*)(ct + 256), kkc = *(const LAS f32x4*)(ct + 320), kac = *(const LAS f32x4*)(ct + 384), rkc = *(const LAS f32x4*)(ct + 448);
            float gl[4];
#pragma unroll
            for (int e = 0; e < 4; ++e) {
                const float z = -(w0[e] + dA[ci][e]); const float sp = fmaxf(z, 0.f) + __logf(1.f + __expf(-fabsf(z)));
                lwv[ci][e] = -__expf(-sp - 0.5f);
                asg[ci][e] = sigmoidf_(a0[e] + aA[ci][e]); gl[e] = gA[ci][e];
                rs[ci][e] = (float)rc[e] + mur[e] * ((float)rp[e] - (float)rc[e]);
                const float ks_ = (float)kc[e] + muk[e] * ((float)kq[e] - (float)kc[e]);
                vs[ci][e] = (float)vc[e] + muv[e] * ((float)vp[e] - (float)vc[e]);
                kkv[ci][e] = ks_ * kkc[e]; pn += kkv[ci][e] * kkv[ci][e];
                kp[ci][e] = ks_ * (1.f + (asg[ci][e] - 1.f) * kac[e]);
                prk += rs[ci][e] * kp[ci][e] * rkc[e];
                cl[ci][e] = row16_incl_scan(lwv[ci][e]);
                if (r16 == 15) ((LAS float*)(lds + CUMB_OFF))[tb * 64 + chl + e] = cl[ci][e];
            }
            u32x2 gw; gw.x = pkh(gl[0], gl[1]); gw.y = pkh(gl[2], gl[3]); *(u32x2*)(RWG + m * RW + ch) = gw;
        }
        pn += __shfl_xor(pn, 16); pn += __shfl_xor(pn, 32); prk += __shfl_xor(prk, 16); prk += __shfl_xor(prk, 32);
        if (g == 0) { ((LAS float*)(lds + NRM_OFF))[t * 2 + cth] = pn; BON[((size_t)u * 64 + t) * 2 + cth] = prk; }
        lds_barrier();
        {
            const float nrm = sqrtf(((LAS float*)(lds + NRM_OFF))[t * 2] + ((LAS float*)(lds + NRM_OFF))[t * 2 + 1]); const float inrm = __builtin_amdgcn_rcpf(fmaxf(nrm, 1e-12f));
#pragma unroll
            for (int ci = 0; ci < 2; ++ci) {
                const int chl = 16 * (2 * cth + ci) + 4 * g;
                float Ab[4], Rb[4], Bb[4], Kb[4], Bp[4], Kp[4];
                const LAS float* cbp = (const LAS float*)(lds + CUMB_OFF) + chl;
                const f32x4 cb0 = *(const LAS f32x4*)(cbp), cb1 = *(const LAS f32x4*)(cbp + 64), cb2 = *(const LAS f32x4*)(cbp + 128), cb3 = *(const LAS f32x4*)(cbp + 192);
#pragma unroll
                for (int e = 0; e < 4; ++e) {
                    const float b0 = cb0[e], b1 = cb1[e], b2 = cb2[e], b3 = cb3[e];
                    const float pre = (tb > 0 ? b0 : 0.f) + (tb > 1 ? b1 : 0.f) + (tb > 2 ? b2 : 0.f);
                    const float cum = cl[ci][e] + pre, cumC = (b0 + b1) + (b2 + b3);
                    const float kkn = kkv[ci][e] * inrm, av = -kkn, bv = kkn * asg[ci][e];
                    const float eg = __expf(cum), egi = __expf(-cum), egc = __expf(cumC - cum);
                    Ab[e] = av * __expf(cum - lwv[ci][e]); Rb[e] = rs[ci][e] * eg; Bb[e] = bv * egi; Kb[e] = kp[ci][e] * egi; Bp[e] = bv * egc; Kp[e] = kp[ci][e] * egc;
                }
                const int ro = t * XP + chl * 2;
                u32x2 w;
                w.x = pkb(Ab[0], Ab[1]); w.y = pkb(Ab[2], Ab[3]); *(LAS u32x2*)(lds + AB_OFF + ro) = w;
                w.x = pkb(Rb[0], Rb[1]); w.y = pkb(Rb[2], Rb[3]); *(LAS u32x2*)(lds + RB_OFF + ro) = w;
                w.x = pkb(Bb[0], Bb[1]); w.y = pkb(Bb[2], Bb[3]); *(LAS u32x2*)(lds + BB_OFF + ro) = w;
                w.x = pkb(Kb[0], Kb[1]); w.y = pkb(Kb[2], Kb[3]); *(LAS u32x2*)(lds + KB_OFF + ro) = w;
                w.x = pkh(Ab[0], Ab[1]); w.y = pkh(Ab[2], Ab[3]); *(LAS u32x2*)(lds + AH_OFF + ro) = w;
                w.x = pkh(Rb[0], Rb[1]); w.y = pkh(Rb[2], Rb[3]); *(LAS u32x2*)(lds + RH_OFF + ro) = w;
                w.x = pkh(vs[ci][0], vs[ci][1]); w.y = pkh(vs[ci][2], vs[ci][3]); *(LAS u32x2*)(lds + VH_OFF + ro) = w;
                w.x = pkh(Bp[0], Bp[1]); w.y = pkh(Bp[2], Bp[3]); *(LAS u32x2*)(lds + BP_OFF + ro) = w;
                w.x = pkh(Kp[0], Kp[1]); w.y = pkh(Kp[2], Kp[3]); *(LAS u32x2*)(lds + KP_OFF + ro) = w;
            }
        }
        lds_barrier();
#pragma unroll 1
        for (int k = 0; k < 5; ++k) {
            const int idx = wave + 8 * k, prod = idx / 10, rem = idx - prod * 10;
            const int tb1 = rem >= 6 ? 3 : rem >= 3 ? 2 : rem >= 1 ? 1 : 0, ub = rem - (tb1 * (tb1 + 1)) / 2;
            LAS unsigned char* X = lds + ((prod < 2) ? AB_OFF : RB_OFF); LAS unsigned char* Y = lds + ((prod & 1) ? KB_OFF : BB_OFF);
            f32x4 acc = z4;
#pragma unroll
            for (int ks = 0; ks < 2; ++ks) acc = MFMA_B(rd_rowb(Y, XP, 16 * ub + r16, 32 * ks + 8 * g), rd_rowb(X, XP, 16 * tb1 + r16, 32 * ks + 8 * g), acc);
            const int tt = 16 * tb1 + r16, tau0 = 16 * ub + 4 * g; const int lim = (prod < 2) ? tt : tt + 1;
#pragma unroll
            for (int e = 0; e < 4; ++e) if (tau0 + e >= lim) acc[e] = 0.f;
            wr4h(lds + LAB_OFF + prod * 9216 + tt * XP + tau0 * 2, acc);
        }
#pragma unroll 1
        for (int k = 0; k < 3; ++k) {
            const int idx = wave + 8 * k, prod = idx / 6, rem = idx - prod * 6;
            const int tb1 = rem >= 5 ? 2 : rem >= 3 ? 1 : 0, ub = (rem >= 5) ? 3 : (rem >= 3) ? rem - 1 : rem + 1;
            wr4h(lds + LAB_OFF + prod * 9216 + (16 * tb1 + r16) * XP + (16 * ub + 4 * g) * 2, z4);
        }
        lds_barrier();
        if (wave == 0) {
            LAS unsigned char* L = lds + LAB_OFF; LAS unsigned char* TT = lds + TT_OFF;
            f32x4 TB[4][4]; f16x4 TAh[4];
            float idn[4];
#pragma unroll
            for (int e = 0; e < 4; ++e) idn[e] = (r16 == 4 * g + e) ? 1.f : 0.f;
#pragma unroll
            for (int i = 0; i < 4; ++i) {
                f16x4 XA = *(const LAS f16x4*)(L + (16 * i + r16) * XP + (16 * i + 4 * g) * 2);
                f16x4 XB = tr_read16(L + (16 * i + 4 * g + qq) * XP + (16 * i + 4 * pp) * 2);
                f32x4 TAf, TBf;
#pragma unroll
                for (int e = 0; e < 4; ++e) { TAf[e] = idn[e] + (float)XA[e]; TBf[e] = idn[e] + (float)XB[e]; }
#pragma unroll
                for (int lv = 0; lv < 3; ++lv) {
                    const f32x4 X2B = MFMA_H16(XA, XB, z4), X2A = MFMA_H16(XB, XA, z4);
                    XA = cvt4h(X2A); XB = cvt4h(X2B);
                    const f16x4 ta = cvt4h(TAf);
                    TBf = MFMA_H16(ta, XB, TBf); TAf = MFMA_H16(XB, ta, TAf);
                }
                TB[i][i] = TBf; TAh[i] = cvt4h(TAf);
            }
#pragma unroll
            for (int d = 1; d < 4; ++d)
#pragma unroll
                for (int j = 0; j + d < 4; ++j) { const int i = j + d;
                    f32x4 M = z4;
#pragma unroll
                    for (int kq2 = j; kq2 < i; ++kq2) M = MFMA_H16(*(const LAS f16x4*)(L + (16 * i + r16) * XP + (16 * kq2 + 4 * g) * 2), cvt4h(TB[kq2][j]), M);
                    TB[i][j] = MFMA_H16(TAh[i], cvt4h(M), z4);
                }
#pragma unroll
            for (int i = 0; i < 4; ++i)
#pragma unroll
                for (int j = 0; j < 4; ++j) wr4h(TT + (16 * j + r16) * XP + (16 * i + 4 * g) * 2, (j <= i) ? TB[i][j] : z4);
        } else {
#pragma unroll 1
            for (int idx = wave - 1; idx < 16; idx += 7) { const int tb1 = idx >> 2, ib = idx & 3;
                f32x4 acc = z4;
#pragma unroll
                for (int ks = 0; ks < 2; ++ks) acc = MFMA_H(rd_row(lds + LAK_OFF, XP, 16 * tb1 + r16, 32 * ks + 8 * g), rd_tr(lds + VH_OFF, 32 * ks, 16 * ib, g, qq, pp), acc);
                wr4h(lds + M1T_OFF + (16 * ib + r16) * XP + (16 * tb1 + 4 * g) * 2, acc);
            }
        }
        lds_barrier();
#pragma unroll
        for (int k = 0; k < 4; ++k) {
            const int which = k >> 1, tb1 = 2 * (k & 1) + (wave >> 2), nb = wave & 3;
            f32x4 acc = z4;
#pragma unroll
            for (int ks = 0; ks < 2; ++ks) {
                const f16x8 af = rd_tr(lds + TT_OFF, 32 * ks, 16 * tb1, g, qq, pp);
                const f16x8 bf = which ? rd_row(lds + M1T_OFF, XP, 16 * nb + r16, 32 * ks + 8 * g) : rd_tr(lds + AH_OFF, 32 * ks, 16 * nb, g, qq, pp);
                acc = MFMA_H(af, bf, acc);
            }
            wr4h(lds + (which ? U1T_OFF : A2T_OFF) + (16 * nb + r16) * XP + (16 * tb1 + 4 * g) * 2, acc);
        }
        lds_barrier();
        if (un < NUNIT) X_PREFETCH(un);
#pragma unroll
        for (int k = 0; k < 8; ++k) {
            const int kind = k >> 1, a4 = 2 * (k & 1) + (wave >> 2), b4 = wave & 3;
            f32x4 acc = z4;
            if (kind == 0) {
#pragma unroll
                for (int ks = 0; ks < 2; ++ks) acc = MFMA_H(rd_row(lds + A2T_OFF, XP, 16 * a4 + r16, 32 * ks + 8 * g), rd_tr(lds + BP_OFF, 32 * ks, 16 * b4, g, qq, pp), acc);
                if (a4 == b4) { const LAS float* cb = (const LAS float*)(lds + CUMB_OFF) + 16 * b4 + r16; const float gC = __expf((cb[0] + cb[64]) + (cb[128] + cb[192]));
#pragma unroll
                    for (int e = 0; e < 4; ++e) if (4 * g + e == r16) acc[e] += gC; }
                u32x2 w; w.x = pkh(acc[0], acc[1]); w.y = pkh(acc[2], acc[3]);
                *(u32x2*)(RWP + (size_t)u * 4096 + ((b4 * 2 + (a4 >> 1)) * 64 + lane_o) * 8 + (a4 & 1) * 4) = w;
            } else if (kind == 1) {
#pragma unroll
                for (int ks = 0; ks < 2; ++ks) { acc = MFMA_H(rd_tr(lds + BP_OFF, 32 * ks, 16 * a4, g, qq, pp), rd_row(lds + U1T_OFF, XP, 16 * b4 + r16, 32 * ks + 8 * g), acc);
                    acc = MFMA_H(rd_tr(lds + KP_OFF, 32 * ks, 16 * a4, g, qq, pp), rd_tr(lds + VH_OFF, 32 * ks, 16 * b4, g, qq, pp), acc); }
                u32x2 w; w.x = pkh(acc[0], acc[1]); w.y = pkh(acc[2], acc[3]);
                *(u32x2*)(RWQ + (size_t)u * 4096 + ((b4 * 4 + a4) * 64 + lane_o) * 4) = w;
            } else if (kind == 2) {
                { const f16x4 rh4 = *(const LAS f16x4*)(lds + RH_OFF + (16 * b4 + r16) * XP + (16 * a4 + 4 * g) * 2); acc = cvt4f(rh4); }
#pragma unroll
                for (int ks = 0; ks < 2; ++ks) acc = MFMA_H(rd_row(lds + A2T_OFF, XP, 16 * a4 + r16, 32 * ks + 8 * g), rd_row(lds + LRB_OFF, XP, 16 * b4 + r16, 32 * ks + 8 * g), acc);
                u32x2 w; w.x = pkh(acc[0], acc[1]); w.y = pkh(acc[2], acc[3]);
                *(u32x2*)(RWR2 + (size_t)u * 4096 + (16 * b4 + r16) * 64 + 16 * a4 + 4 * g) = w;
            } else {
#pragma unroll
                for (int ks = 0; ks < 2; ++ks) { acc = MFMA_H(rd_row(lds + U1T_OFF, XP, 16 * a4 + r16, 32 * ks + 8 * g), rd_row(lds + LRB_OFF, XP, 16 * b4 + r16, 32 * ks + 8 * g), acc);
                    acc = MFMA_H(rd_tr(lds + VH_OFF, 32 * ks, 16 * a4, g, qq, pp), rd_row(lds + LRK_OFF, XP, 16 * b4 + r16, 32 * ks + 8 * g), acc); }
                u32x2 w; w.x = pkh(acc[0], acc[1]); w.y = pkh(acc[2], acc[3]);
                *(u32x2*)(RWY1 + (size_t)u * 4096 + ((a4 * 4 + b4) * 64 + lane_o) * 4) = w;
            }
        }
    }
}

#undef X_UNIT
#undef X_PREFETCH
struct ChBuf { f16x8 p[4][2]; u32x2 q[4]; };
__device__ __forceinline__ void p7y_chain(const Args& a, int bx0, int G, int wave, int lane) {
    unsigned char* ws = a.ws;
    const f16* RWP = (const f16*)(ws + WS_RWP); const f16* RWQ = (const f16*)(ws + WS_RWQ); f16* RWS0 = (f16*)(ws + WS_RWS0);
    if (wave != 0) return;
#pragma unroll 1
    for (int bx = bx0; bx < 256; bx += G) {
    const int r16 = lane & 15, g = lane >> 4;
    const int b = bx & 7, rest = bx >> 3, h = rest >> 2, it = rest & 3;
    f32x4 S[4];
#pragma unroll
    for (int mt = 0; mt < 4; ++mt) S[mt] = (f32x4){0.f, 0.f, 0.f, 0.f};
    ChBuf B0, B1, B2, B3;
#define CH_LOAD(BUF, c_) do { const size_t uu = ((size_t)(b * 64 + (c_)) * 8 + h); \
        _Pragma("unroll") for (int mo = 0; mo < 4; ++mo) { BUF.q[mo] = *(const u32x2*)(RWQ + uu * 4096 + ((it * 4 + mo) * 64 + lane) * 4); \
            _Pragma("unroll") for (int ks = 0; ks < 2; ++ks) BUF.p[mo][ks] = *(const f16x8*)(RWP + uu * 4096 + ((mo * 2 + ks) * 64 + lane) * 8); } } while (0)
#define CH_STEP(BUF, c_) do { const size_t uu = ((size_t)(b * 64 + (c_)) * 8 + h); f16x8 bfr[2]; \
        _Pragma("unroll") for (int mt = 0; mt < 4; ++mt) { u32x2 w; w.x = pkh(S[mt][0], S[mt][1]); w.y = pkh(S[mt][2], S[mt][3]); \
            *(u32x2*)(RWS0 + uu * 4096 + (16 * it + r16) * 64 + 16 * mt + 4 * g) = w; const f16x4 hv = __builtin_bit_cast(f16x4, w); \
            bfr[mt >> 1][(mt & 1) * 4 + 0] = hv[0]; bfr[mt >> 1][(mt & 1) * 4 + 1] = hv[1]; bfr[mt >> 1][(mt & 1) * 4 + 2] = hv[2]; bfr[mt >> 1][(mt & 1) * 4 + 3] = hv[3]; } \
        _Pragma("unroll") for (int mo = 0; mo < 4; ++mo) { f32x4 n_ = cvt4f(__builtin_bit_cast(f16x4, BUF.q[mo])); \
            _Pragma("unroll") for (int ks = 0; ks < 2; ++ks) n_ = MFMA_H(BUF.p[mo][ks], bfr[ks], n_); S[mo] = n_; } \
        if ((c_) + 4 < 64) CH_LOAD(BUF, (c_) + 4); } while (0)
    CH_LOAD(B0, 0); CH_LOAD(B1, 1); CH_LOAD(B2, 2); CH_LOAD(B3, 3);
#pragma unroll 1
    for (int c = 0; c < 64; c += 4) { CH_STEP(B0, c); CH_STEP(B1, c + 1); CH_STEP(B2, c + 2); CH_STEP(B3, c + 3); }
    }
#undef CH_LOAD
#undef CH_STEP
}

__device__ __forceinline__ void p8z_out(const Args& a, int vcu, int G, int wave, int lane) {
    unsigned char* ws = a.ws;
    const f16* PROJ = (const f16*)(ws + WS_PROJ); const f16* RWG = (const f16*)(ws + WS_RWG);
    const f16* RWR2 = (const f16*)(ws + WS_RWR2); const f16* RWY1 = (const f16*)(ws + WS_RWY1); const f16* RWS0 = (const f16*)(ws + WS_RWS0);
    const float* BON = (const float*)(ws + WS_BON); f16* OATT = (f16*)(ws + WS_OATT);
    const int gw = vcu * NWAVES + wave, NGW = G * NWAVES;
    const bool bal = (G == 256); const int bxx = blockIdx.x;
    const int nit = bal ? 2 : (NUNIT + NGW - 1) / NGW;
#pragma unroll 1
    for (int itx = 0; itx < nit; ++itx) {
        int u;
        if (bal) { const int idx = (bxx >> 3) * 8 + wave + 256 * itx; u = (((bxx & 7) * 64 + (idx >> 3)) * 8 + (idx & 7)); } else { u = gw + itx * NGW; if (u >= NUNIT) break; }
        int lane_o = lane; asm volatile("" : "+v"(lane_o));
        const int r16 = lane_o & 15, g = lane_o >> 4;
        const int h = u & 7, c = (u >> 3) & 63, b = u >> 9;
        const size_t m0 = (size_t)(b << 12) + c * 64;
        f32x4 acc[4][4];
#pragma unroll
        for (int mt = 0; mt < 4; ++mt)
#pragma unroll
            for (int nt = 0; nt < 4; ++nt) acc[mt][nt] = cvt4f(*(const f16x4*)(RWY1 + (size_t)u * 4096 + ((mt * 4 + nt) * 64 + lane_o) * 4));
#pragma unroll
        for (int ks = 0; ks < 2; ++ks) {
            f16x8 sf[4], rf[4];
#pragma unroll
            for (int x = 0; x < 4; ++x) { sf[x] = *(const f16x8*)(RWS0 + (size_t)u * 4096 + (16 * x + r16) * 64 + 32 * ks + 8 * g); rf[x] = *(const f16x8*)(RWR2 + (size_t)u * 4096 + (16 * x + r16) * 64 + 32 * ks + 8 * g); }
#pragma unroll
            for (int mt = 0; mt < 4; ++mt)
#pragma unroll
                for (int nt = 0; nt < 4; ++nt) acc[mt][nt] = MFMA_H(sf[mt], rf[nt], acc[mt][nt]);
        }
#pragma unroll
        for (int nt = 0; nt < 4; ++nt) {
            const int t = 16 * nt + r16; const size_t m = m0 + t;
            float s = 0.f;
#pragma unroll
            for (int mt = 0; mt < 4; ++mt) s += (acc[mt][nt][0] + acc[mt][nt][1]) + (acc[mt][nt][2] + acc[mt][nt][3]);
            s += __shfl_xor(s, 16); s += __shfl_xor(s, 32);
            const float mean = s * (1.f / 64.f); float q = 0.f;
#pragma unroll
            for (int mt = 0; mt < 4; ++mt)
#pragma unroll
                for (int e = 0; e < 4; ++e) { const float d = acc[mt][nt][e] - mean; q += d * d; }
            q += __shfl_xor(q, 16); q += __shfl_xor(q, 32);
            const float rstd = rsqrtf(q * (1.f / 64.f) + GN_EPS);
            const f32x2 bo = *(const f32x2*)(BON + ((size_t)u * 64 + t) * 2); const float bonus = bo[0] + bo[1];
#pragma unroll
            for (int mt = 0; mt < 4; ++mt) {
                const int ch = h * 64 + 16 * mt + 4 * g;
                const f16x4 vc = *(const f16x4*)(PROJ + m * IN_PAD + C_V + ch);
                f16x4 vp = {0, 0, 0, 0}; if ((c * 64 + t) != 0) vp = *(const f16x4*)(PROJ + (m - 1) * IN_PAD + C_V + ch);
                const f32x4 muv = *(const f32x4*)(a.in[17] + 1024 + ch), gn = *(const f32x4*)(a.in[26] + ch), bs = *(const f32x4*)(a.in[27] + ch);
                const f16x4 gg = *(const f16x4*)(RWG + m * RW + ch);
                float o[4];
#pragma unroll
                for (int e = 0; e < 4; ++e) { const float vsv = (float)vc[e] + muv[e] * ((float)vp[e] - (float)vc[e]);
                    o[e] = ((acc[mt][nt][e] - mean) * rstd * gn[e] + bs[e] + bonus * vsv) * (float)gg[e]; }
                u32x2 w; w.x = pkh(o[0], o[1]); w.y = pkh(o[2], o[3]);
                *(u32x2*)(OATT + m * KOUT + 1024 + ch) = w;
            }
        }
    }
}

__device__ __forceinline__ f16* x1_row(unsigned char* ws, int m) { return (f16*)(ws + ((m < 16384) ? WS_RWG : (WS_RWS0 - (size_t)16384 * 2048)) + (size_t)m * 2048); }
__device__ __forceinline__ void p10_mid(const Args& a, int vcu, int G, int wave, int lane) {
    unsigned char* ws = a.ws;
    const f16* MIX = (const f16*)(ws + WS_MIX); const float* mod = (const float*)(ws + WS_MOD); f16* HF = (f16*)(ws + WS_H);
    const int gw = vcu * NWAVES + wave, NGW = G * NWAVES;
    float g6[16], g7[16];
#pragma unroll
    for (int j = 0; j < 2; ++j) { const int c = 8 * lane + 512 * j;
        const f32x4 p0 = *(const f32x4*)(a.in[6] + c), p1 = *(const f32x4*)(a.in[6] + c + 4), q0 = *(const f32x4*)(a.in[7] + c), q1 = *(const f32x4*)(a.in[7] + c + 4);
#pragma unroll
        for (int e = 0; e < 4; ++e) { g6[8 * j + e] = p0[e]; g6[8 * j + 4 + e] = p1[e]; g7[8 * j + e] = q0[e]; g7[8 * j + 4 + e] = q1[e]; } }
    for (int m = gw; m < MTOK; m += NGW) {
        const int b = m >> 12; const float* md = mod + b * 6144;
        float mx[16], xv[16]; float s = 0.f;
#pragma unroll
        for (int j = 0; j < 2; ++j) { const int c = 8 * lane + 512 * j; const f16x8 v = *(const f16x8*)(MIX + (size_t)m * D + c);
#pragma unroll
            for (int e = 0; e < 8; ++e) { mx[8 * j + e] = (float)v[e]; s += mx[8 * j + e] * mx[8 * j + e]; }
            const f32x4 x0 = *(const f32x4*)(a.in[0] + (size_t)m * D + c), x1 = *(const f32x4*)(a.in[0] + (size_t)m * D + c + 4);
#pragma unroll
            for (int e = 0; e < 4; ++e) { xv[8 * j + e] = x0[e]; xv[8 * j + 4 + e] = x1[e]; } }
        const float r = rsqrtf(wave_sum(s) * (1.f / D) + NORM_EPS);
        float s1 = 0.f;
        f16* x1r = x1_row(ws, m);
#pragma unroll
        for (int j = 0; j < 2; ++j) { const int c = 8 * lane + 512 * j;
            const f32x4 gm0 = *(const f32x4*)(md + 2048 + c), gm1 = *(const f32x4*)(md + 2048 + c + 4);
#pragma unroll
            for (int e = 0; e < 8; ++e) { const float gm = e < 4 ? gm0[e & 3] : gm1[e & 3]; const float x1 = xv[8 * j + e] + gm * (mx[8 * j + e] * r * g6[8 * j + e]); xv[8 * j + e] = x1; s1 += x1 * x1; }
            u32x4 w; w.x = pkh(xv[8 * j], xv[8 * j + 1]); w.y = pkh(xv[8 * j + 2], xv[8 * j + 3]); w.z = pkh(xv[8 * j + 4], xv[8 * j + 5]); w.w = pkh(xv[8 * j + 6], xv[8 * j + 7]);
            *(u32x4*)(x1r + c) = w; }
        const float r1 = rsqrtf(wave_sum(s1) * (1.f / D) + NORM_EPS);
#pragma unroll
        for (int j = 0; j < 2; ++j) { const int c = 8 * lane + 512 * j; float y[8];
            const f32x4 sc0 = *(const f32x4*)(md + 4096 + c), sc1 = *(const f32x4*)(md + 4096 + c + 4), sh0 = *(const f32x4*)(md + 3072 + c), sh1 = *(const f32x4*)(md + 3072 + c + 4);
#pragma unroll
            for (int e = 0; e < 8; ++e) { const float sc = e < 4 ? sc0[e & 3] : sc1[e & 3], sh = e < 4 ? sh0[e & 3] : sh1[e & 3]; y[e] = xv[8 * j + e] * r1 * g7[8 * j + e] * (1.f + sc) + sh; }
            u32x4 w; w.x = pkh(y[0], y[1]); w.y = pkh(y[2], y[3]); w.z = pkh(y[4], y[5]); w.w = pkh(y[6], y[7]);
            *(u32x4*)(HF + (size_t)m * D + c) = w; }
    }
}
__device__ __forceinline__ void p13_final(const Args& a, int vcu, int G, int wave, int lane) {
    unsigned char* ws = a.ws;
    const f16* F = (const f16*)(ws + WS_F); const float* mod = (const float*)(ws + WS_MOD);
    const int gw = vcu * NWAVES + wave, NGW = G * NWAVES;
    float g8[16];
#pragma unroll
    for (int j = 0; j < 2; ++j) { const int c = 8 * lane + 512 * j; const f32x4 p0 = *(const f32x4*)(a.in[8] + c), p1 = *(const f32x4*)(a.in[8] + c + 4);
#pragma unroll
        for (int e = 0; e < 4; ++e) { g8[8 * j + e] = p0[e]; g8[8 * j + 4 + e] = p1[e]; } }
    for (int m = gw; m < MTOK; m += NGW) {
        const int b = m >> 12; const float* md = mod + b * 6144;
        float fv[16]; float s = 0.f;
        f16x8 xh[2];
        const f16* x1r = x1_row(ws, m);
#pragma unroll
        for (int j = 0; j < 2; ++j) { const int c = 8 * lane + 512 * j; const f16x8 v = *(const f16x8*)(F + (size_t)m * D + c); xh[j] = *(const f16x8*)(x1r + c);
#pragma unroll
            for (int e = 0; e < 8; ++e) { fv[8 * j + e] = (float)v[e]; s += fv[8 * j + e] * fv[8 * j + e]; } }
        const float r = rsqrtf(wave_sum(s) * (1.f / D) + NORM_EPS);
#pragma unroll
        for (int j = 0; j < 2; ++j) { const int c = 8 * lane + 512 * j;
            const f32x4 gf0 = *(const f32x4*)(md + 5120 + c), gf1 = *(const f32x4*)(md + 5120 + c + 4);
            f32x4 o0, o1;
#pragma unroll
            for (int e = 0; e < 4; ++e) { o0[e] = (float)xh[j][e] + gf0[e] * (fv[8 * j + e] * r * g8[8 * j + e]); o1[e] = (float)xh[j][4 + e] + gf1[e] * (fv[8 * j + 4 + e] * r * g8[8 * j + 4 + e]); }
            *(f32x4*)(a.out + (size_t)m * D + c) = o0; *(f32x4*)(a.out + (size_t)m * D + c + 4) = o1; }
    }
}

constexpr int NPHASE = 14;
__global__ void __launch_bounds__(NWAVES * 64, 2) fwd(Args args) {
    extern __shared__ __attribute__((aligned(16))) unsigned char lds_raw[];
    LAS unsigned char* lds = (LAS unsigned char*)lds_raw;
    const int tid = threadIdx.x, lane = tid & 63, wave = __builtin_amdgcn_readfirstlane(tid >> 6);
    const int G = gridDim.x; const int bx = blockIdx.x; const int vcu = (G % 8 == 0) ? (bx % 8) * (G / 8) + bx / 8 : bx;
    volatile LAS unsigned* MISC = (volatile LAS unsigned*)(lds + MISC_OFF);
    if (tid < 16) MISC[tid] = 0u;
    __syncthreads();
    const int lo = args.ph_lo, hi = args.ph_hi;
    unsigned* barw = (unsigned*)(args.ws + WS_CTL) + CW_BAR;
    XcdBarrier bar; bar.bar = barw; bar.x = 0; bar.st = nullptr;
    if (hi - lo > 1) bar = xcd_barrier_post(barw, MISC);
#ifndef PHMASK
#define PHMASK 0x3FFF
#endif
#ifndef REPMASK
#define REPMASK 0
#endif
#define IN(k) (((PHMASK >> (k)) & 1) && lo <= (k) && (k) < hi)
#define REP(k) for (int rep_ = 0; rep_ < (((REPMASK >> (k)) & 1) ? 2 : 1); ++rep_)
#ifndef BARREP
#define BARREP 1
#endif
#define SEAM(k) do { if (IN(k) && IN((k) + 1)) for (int br_ = 0; br_ < BARREP; ++br_) xcd_barrier(bar); } while (0)
    unsigned char* ws = args.ws;
    if (IN(0)) REP(0) { if (rep_) __syncthreads(); p0_prologue(args, lds, vcu, G, wave, lane); } SEAM(0);
    if (IN(1)) REP(1) { if (rep_) __syncthreads(); p1_modnorm(args, vcu, G, wave, lane); } SEAM(1);
    if (IN(2)) REP(2) { if (rep_) __syncthreads(); pg8::Gemm g{(const f16*)(ws + WS_H), (const f16*)(ws + WS_WIN), MTOK, IN_PAD, D}; pg8::StaticOrder S; S.init(MTOK, IN_PAD, G, bx);
        pg8::EpiF16 E{(f16*)(ws + WS_PROJ), IN_PAD}; pg8::gemm_phase<pg8::EpiF16, pg8::StaticOrder, true, true>(lds, g, S, E); } SEAM(2);
#ifdef OLD_BASELINE
    if (IN(5)) REP(5) { if (rep_) __syncthreads(); p5_indexer(args, lds, vcu, G, wave, lane); } SEAM(5);
    if (IN(6)) REP(6) { if (rep_) __syncthreads(); p6_attention(args, lds, vcu, G, wave, lane); p3_rwkv_prep(args, lds, vcu, G, tid); } SEAM(6);
    if (IN(7)) REP(7) { if (rep_) __syncthreads(); p7_scan(args, lds, vcu, G, wave, lane); } SEAM(7);
    if (IN(8)) REP(8) { if (rep_) __syncthreads(); p8_rwkv_post(args, vcu, G, wave, lane); } SEAM(8);
#else
#define SEAMX() do { if (hi - lo > 1) for (int br_ = 0; br_ < BARREP; ++br_) xcd_barrier(bar); } while (0)
    if (IN(3)) REP(3) { if (rep_) __syncthreads(); p3_rows(args, vcu, G, wave, lane); }
    if (IN(6)) REP(6) { __syncthreads(); p7x_chunks(args, lds, vcu, G, tid, wave, lane); } SEAMX();
    if (IN(4)) REP(4) { if (rep_) __syncthreads(); pg8::Gemm g{(const f16*)(ws + WS_CQ), (const f16*)(ws + WS_WCQ), MTOK, NQI, QL}; pg8::StaticOrder S; S.init(MTOK, NQI, G, bx);
        pg8::EpiF16 E{(f16*)args.out, NQI}; pg8::gemm_phase<pg8::EpiF16, pg8::StaticOrder, true, true>(lds, g, S, E); }
    if (IN(7)) REP(7) { __syncthreads(); p7y_chain(args, bx, G, wave, lane); } SEAMX();
    if (IN(5)) REP(5) { if (rep_) __syncthreads(); p5_dsa(args, lds, G, bx, tid, wave, lane); }
    if (IN(8)) REP(8) { __syncthreads(); p8z_out(args, vcu, G, wave, lane); } SEAMX();
#endif
    if (IN(9)) REP(9) { if (rep_) __syncthreads(); pg8::Gemm g{(const f16*)(ws + WS_OATT), (const f16*)(ws + WS_WOUT), MTOK, D, KOUT}; pg8::StaticOrder S; S.init(MTOK, D, G, bx);
        pg8::EpiF16 E{(f16*)(ws + WS_MIX), D}; pg8::gemm_phase<pg8::EpiF16, pg8::StaticOrder, true, true>(lds, g, S, E); } SEAM(9);
    if (IN(10)) REP(10) { if (rep_) __syncthreads(); p10_mid(args, vcu, G, wave, lane); } SEAM(10);
    if (IN(11)) REP(11) { if (rep_) __syncthreads(); pg8::Gemm g{(const f16*)(ws + WS_H), (const f16*)(ws + WS_WGU), MTOK, 2 * DFF, D}; pg8::StaticOrder S; S.init(MTOK, 2 * DFF, G, bx);
        pg8::EpiSwiGLU E{(f16*)(ws + WS_ACT), DFF}; pg8::gemm_phase<pg8::EpiSwiGLU, pg8::StaticOrder, true, true>(lds, g, S, E); } SEAM(11);
    if (IN(12)) REP(12) { if (rep_) __syncthreads(); pg8::Gemm g{(const f16*)(ws + WS_ACT), (const f16*)(ws + WS_WDN), MTOK, D, DFF}; pg8::StaticOrder S; S.init(MTOK, D, G, bx);
        pg8::EpiF16 E{(f16*)(ws + WS_F), D}; pg8::gemm_phase<pg8::EpiF16, pg8::StaticOrder, true, true>(lds, g, S, E); } SEAM(12);
    if (IN(13)) REP(13) { if (rep_) __syncthreads(); p13_final(args, vcu, G, wave, lane); }
#undef IN
#undef SEAM
}

#ifndef N_LAUNCH_MODE
#define N_LAUNCH_MODE 1
#endif
extern "C" void kernel_launch(void* const* d_in, const int* in_sizes, int n_in, void* d_out, int out_size, void* d_ws, size_t ws_size, hipStream_t stream) {
    static int grid = 0;
    if (grid == 0) {
        int dev = 0, cus = 0, per_cu = 0;
        if (n_in != 32 || ws_size < WS_END) { fprintf(stderr, "kernel_launch: unexpected n_in %d or ws_size %zu (< %zu)\n", n_in, ws_size, (size_t)WS_END); }
        if (hipGetDevice(&dev) != hipSuccess || hipDeviceGetAttribute(&cus, hipDeviceAttributeMultiprocessorCount, dev) != hipSuccess) { grid = -1; return; }
        if (hipFuncSetAttribute((const void*)fwd, hipFuncAttributeMaxDynamicSharedMemorySize, LDS_BYTES) != hipSuccess) { fprintf(stderr, "kernel_launch: hipFuncSetAttribute failed\n"); grid = -1; return; }
        if (hipOccupancyMaxActiveBlocksPerMultiprocessor(&per_cu, (const void*)fwd, NWAVES * 64, LDS_BYTES) != hipSuccess || per_cu < 1) fprintf(stderr, "kernel_launch: occupancy query says %d\n", per_cu);
        (void)hipGetLastError();
        grid = cus;
    }
    if (grid < 0) return;
    (void)hipMemsetAsync((char*)d_ws + WS_CTL, 0, CTL_ZERO_BYTES, stream);
    Args a{};
    for (int i = 0; i < 32; ++i) a.in[i] = (const float*)d_in[i];
    a.out = (float*)d_out; a.ws = (unsigned char*)d_ws;
    if (N_LAUNCH_MODE == 1) { a.ph_lo = 0; a.ph_hi = NPHASE; hipLaunchKernelGGL(fwd, dim3(grid), dim3(NWAVES * 64), LDS_BYTES, stream, a); }
    else for (int p = 0; p < NPHASE; ++p) { a.ph_lo = p; a.ph_hi = p + 1; hipLaunchKernelGGL(fwd, dim3(grid), dim3(NWAVES * 64), LDS_BYTES, stream, a); }
}
```

```cpp
#include <hip/hip_runtime.h>
#include <cstdio>
#include <cstdint>

#define LAS __attribute__((address_space(3)))
#define GAS __attribute__((address_space(1)))
typedef _Float16 f16;
typedef _Float16 f16x8 __attribute__((ext_vector_type(8)));
typedef _Float16 f16x4 __attribute__((ext_vector_type(4)));
typedef _Float16 f16x2 __attribute__((ext_vector_type(2)));
typedef float f32x4 __attribute__((ext_vector_type(4)));
typedef float f32x2 __attribute__((ext_vector_type(2)));
typedef unsigned u32x4 __attribute__((ext_vector_type(4)));
typedef unsigned u32x2 __attribute__((ext_vector_type(2)));

__device__ __forceinline__ unsigned pkh(float a, float b) { f16x2 v = {(f16)a, (f16)b}; return __builtin_bit_cast(unsigned, v); }
__device__ __forceinline__ float h2f(f16 h) { return (float)h; }

namespace pg8 {
constexpr int BM = 256, BK = 64, HALF = 128, HTB = HALF * BK * 2, STAGE_BYTES = 8 * HTB, NXCD = 8, WGM = 8;
__host__ __device__ __forceinline__ int lds_byte(int r, int c) { const int st = (r >> 4) * 2 + (c >> 5), rr = r & 15, cc = c & 31, ob = rr * 64 + cc * 2; return st * 1024 + (ob ^ (((ob >> 9) & 1) << 5)); }
__host__ __device__ __forceinline__ void stage_rc(int b, int& R, int& C) { const int st = b / 1024, sb = b % 1024, swz = sb ^ (((sb >> 9) & 1) << 5); R = (st >> 1) * 16 + swz / 64; C = (st & 1) * 32 + (swz % 64) / 2; }
__host__ __device__ __forceinline__ int perm32(int rho) { const int n = rho >> 4, i = rho & 15; return 8 * (i >> 2) + 4 * n + (i & 3); }

struct Unit { int pm, pn; };
struct Gemm { const f16* A; const f16* Bt; int M, N, K; };

struct StaticOrder {
    int nM, nN, nwg, G, c;
    __host__ __device__ void init(int M, int N, int G_, int c_) { nM = M / BM; nN = N / BM; nwg = nM * nN; G = G_; c = c_; }
    __host__ __device__ bool next(int i, Unit& u) const {
        const long L = (long)i * G + c; if (L >= nwg) return false;
        int wgid = (int)L; { const int q = nwg / NXCD, r = nwg % NXCD, xcd = wgid % NXCD, off = wgid / NXCD; wgid = (xcd < r ? xcd * (q + 1) : r * (q + 1) + (xcd - r) * q) + off; }
        const int nig = WGM * nN, gid = wgid / nig, fm = gid * WGM, gsz = (nM - fm) < WGM ? (nM - fm) : WGM;
        u.pm = fm + ((wgid % nig) % gsz); u.pn = (wgid % nig) / gsz; return true;
    }
    __device__ __forceinline__ void a_ready(const Unit&) const {}
    __device__ __forceinline__ void done(const Unit&) const {}
};

struct EpiF16 {
    static constexpr bool PERM = true, AFTER_DRAIN = false;
    f16* O; int ldc;
    __device__ __forceinline__ void operator()(const f32x4 (&acc)[2][2][4][2], const Unit& u, int wr, int wc, int fr, int fq) const {
        const int row0 = u.pm * BM + wr * 64 + fr; const int col0 = u.pn * BM + wc * 32 + 8 * fq;
#pragma unroll
        for (int ai = 0; ai < 2; ++ai)
#pragma unroll
            for (int m = 0; m < 4; ++m) { f16* rowp = O + (size_t)(row0 + ai * HALF + m * 16) * ldc + col0;
#pragma unroll
                for (int bj = 0; bj < 2; ++bj) { const f32x4 v0 = acc[ai][bj][m][0], v1 = acc[ai][bj][m][1];
                    u32x4 w; w.x = pkh(v0[0], v0[1]); w.y = pkh(v0[2], v0[3]); w.z = pkh(v1[0], v1[1]); w.w = pkh(v1[2], v1[3]);
                    *(u32x4*)(rowp + bj * HALF) = w; } }
    }
};
struct EpiSwiGLU {
    static constexpr bool PERM = true, AFTER_DRAIN = false;
    f16* O; int ldc;
    __device__ __forceinline__ void operator()(const f32x4 (&acc)[2][2][4][2], const Unit& u, int wr, int wc, int fr, int fq) const {
        const int row0 = u.pm * BM + wr * 64 + fr; const int col0 = u.pn * HALF + wc * 32 + 8 * fq;
#pragma unroll
        for (int ai = 0; ai < 2; ++ai)
#pragma unroll
            for (int m = 0; m < 4; ++m) { f16* rowp = O + (size_t)(row0 + ai * HALF + m * 16) * ldc + col0;
                float o[8];
#pragma unroll
                for (int n = 0; n < 2; ++n)
#pragma unroll
                    for (int j = 0; j < 4; ++j) { const float g = acc[ai][0][m][n][j], up = acc[ai][1][m][n][j]; o[n * 4 + j] = g * __builtin_amdgcn_rcpf(1.0f + __expf(-g)) * up; }
                u32x4 w; w.x = pkh(o[0], o[1]); w.y = pkh(o[2], o[3]); w.z = pkh(o[4], o[5]); w.w = pkh(o[6], o[7]);
                *(u32x4*)rowp = w; }
    }
};

template <class Epi, class Sched, bool ALIGN_EPI = false, bool SP2 = false>
__device__ __forceinline__ void gemm_phase(LAS unsigned char* lds, const Gemm g, const Sched& S, const Epi& E) {
    const int tid = threadIdx.x, wid = __builtin_amdgcn_readfirstlane(tid >> 6), lane = tid & 63, wr = wid >> 2, wc = wid & 3, fr = lane & 15, fq = lane >> 4;
    const int K = g.K, nt = K / BK;
    unsigned voffA[2], voffB[2];
#pragma unroll
    for (int i = 0; i < 2; ++i) { int R, C; stage_rc(tid * 16 + i * 8192, R, C); const int Rb = Epi::PERM ? ((R & ~31) + perm32(R & 31)) : R;
        voffA[i] = (unsigned)(R * K + C) * 2u; voffB[i] = (unsigned)(Rb * K + C) * 2u; }
    const size_t kstep = (size_t)(BK * 2);
    const size_t hstep = (size_t)HALF * K * 2;
    const size_t tstep = 2 * hstep;
    const unsigned ldsw = (unsigned)wid * 1024u;
    const int aoff = lds_byte(wr * 64 + fr, fq * 8), boff = lds_byte(wc * 32 + fr, fq * 8);
#define PG8_SA(b, h) (((b) * 2 + (h)) * HTB)
#define PG8_SB(b, h) ((4 + (b) * 2 + (h)) * HTB)
#define PG8_STAGE(bufoff, gbase, voff) do { _Pragma("unroll") for (int _i = 0; _i < 2; ++_i) \
        __builtin_amdgcn_global_load_lds((const unsigned*)((const char*)(gbase) + (voff)[_i]), (LAS unsigned*)(lds + (bufoff) + ldsw + _i * 8192), 16, 0, 0); } while (0)
#define PG8_LDA(dst, b, h) do { _Pragma("unroll") for (int m = 0; m < 4; ++m) _Pragma("unroll") for (int k = 0; k < 2; ++k) dst[m][k] = *(const LAS f16x8*)(lds + PG8_SA(b, h) + aoff + m * 2048 + k * 1024); } while (0)
#define PG8_LDB(dst, b, h) do { _Pragma("unroll") for (int n = 0; n < 2; ++n) _Pragma("unroll") for (int k = 0; k < 2; ++k) dst[n][k] = *(const LAS f16x8*)(lds + PG8_SB(b, h) + boff + n * 2048 + k * 1024); } while (0)
#define PG8_MMA(ai, bj, At, Bt) do { __builtin_amdgcn_s_setprio(1); _Pragma("unroll") for (int m = 0; m < 4; ++m) _Pragma("unroll") for (int n = 0; n < 2; ++n) _Pragma("unroll") for (int k = 0; k < 2; ++k) \
        acc[ai][bj][m][n] = __builtin_amdgcn_mfma_f32_16x16x32_f16(Bt[n][k], At[m][k], acc[ai][bj][m][n], 0, 0, 0); __builtin_amdgcn_s_setprio(0); } while (0)
#define PG8_WAIT_V(n) asm volatile("s_waitcnt vmcnt(" #n ")" ::: "memory")
#define PG8_WAIT_L(n) asm volatile("s_waitcnt lgkmcnt(" #n ")" ::: "memory")
#define PG8_BAR __builtin_amdgcn_s_barrier()
#define PG8_SCHED __builtin_amdgcn_sched_barrier(0)
    Unit cur, nxt; int ui = 0;
    if (!S.next(0, cur)) return;
    f32x4 acc[2][2][4][2];
#pragma unroll
    for (int a = 0; a < 2; ++a)
#pragma unroll
        for (int b = 0; b < 2; ++b)
#pragma unroll
            for (int m = 0; m < 4; ++m)
#pragma unroll
                for (int n = 0; n < 2; ++n) acc[a][b][m][n] = (f32x4){0.f, 0.f, 0.f, 0.f};
    f16x8 At[4][2], B0[2][2], B1[2][2];
    const char* cA = (const char*)g.A + (size_t)cur.pm * tstep; const char* cB = (const char*)g.Bt + (size_t)cur.pn * tstep;
    S.a_ready(cur);
    if constexpr (SP2) {
        PG8_STAGE(PG8_SB(0, 0), cB, voffB); PG8_STAGE(PG8_SB(0, 1), cB + hstep, voffB); PG8_STAGE(PG8_SA(0, 0), cA, voffA); PG8_STAGE(PG8_SA(0, 1), cA + hstep, voffA);
        if (wr == 1) PG8_BAR;
        PG8_WAIT_V(2); PG8_BAR;
        PG8_STAGE(PG8_SB(1, 0), cB + kstep, voffB); PG8_STAGE(PG8_SA(1, 0), cA + kstep, voffA); PG8_STAGE(PG8_SB(1, 1), cB + hstep + kstep, voffB);
        PG8_WAIT_V(6); PG8_BAR;
    } else {
        PG8_STAGE(PG8_SB(0, 0), cB, voffB); PG8_STAGE(PG8_SA(0, 0), cA, voffA); PG8_STAGE(PG8_SB(0, 1), cB + hstep, voffB); PG8_STAGE(PG8_SA(0, 1), cA + hstep, voffA);
        if (wr == 1) PG8_BAR;
        PG8_WAIT_V(4); PG8_BAR;
        PG8_STAGE(PG8_SB(1, 0), cB + kstep, voffB); PG8_STAGE(PG8_SA(1, 0), cA + kstep, voffA); PG8_STAGE(PG8_SB(1, 1), cB + hstep + kstep, voffB);
        PG8_WAIT_V(6); PG8_BAR;
    }
    for (;;) {
        const bool has_next = S.next(ui + 1, nxt);
        const char* nA = has_next ? (const char*)g.A + (size_t)nxt.pm * tstep : cA; const char* nB = has_next ? (const char*)g.Bt + (size_t)nxt.pn * tstep : cB;
        for (int t = 0; t < nt; t += 2) {
            const bool last = (t == nt - 2);
            const char* a1 = cA + (size_t)(t + 1) * kstep;
            const char* a2 = last ? nA : cA + (size_t)(t + 2) * kstep; const char* b2 = last ? nB : cB + (size_t)(t + 2) * kstep;
            const char* a3 = a2 + kstep; const char* b3 = b2 + kstep;
            if (last && has_next) S.a_ready(nxt);
            if constexpr (SP2) {
            PG8_LDB(B0, 0, 0); PG8_LDB(B1, 0, 1); PG8_SCHED; PG8_LDA(At, 0, 0); PG8_STAGE(PG8_SA(1, 1), a1 + hstep, voffA);
            PG8_WAIT_V(8); PG8_WAIT_L(0); PG8_BAR; PG8_MMA(0, 0, At, B0); PG8_MMA(0, 1, At, B1); PG8_BAR; PG8_SCHED;
            PG8_LDA(At, 0, 1); PG8_STAGE(PG8_SB(0, 0), b2, voffB); PG8_STAGE(PG8_SB(0, 1), b2 + hstep, voffB); PG8_STAGE(PG8_SA(0, 0), a2, voffA);
            PG8_WAIT_V(8); PG8_WAIT_L(0); PG8_BAR; PG8_MMA(1, 0, At, B0); PG8_MMA(1, 1, At, B1); PG8_BAR; PG8_SCHED;
            PG8_LDB(B0, 1, 0); PG8_LDB(B1, 1, 1); PG8_SCHED; PG8_LDA(At, 1, 0); PG8_STAGE(PG8_SA(0, 1), a2 + hstep, voffA);
            PG8_WAIT_V(8); PG8_WAIT_L(0); PG8_BAR; PG8_MMA(0, 0, At, B0); PG8_MMA(0, 1, At, B1); PG8_BAR; PG8_SCHED;
            PG8_LDA(At, 1, 1); PG8_STAGE(PG8_SB(1, 0), b3, voffB); PG8_STAGE(PG8_SB(1, 1), b3 + hstep, voffB); PG8_STAGE(PG8_SA(1, 0), a3, voffA);
            PG8_WAIT_V(8); PG8_WAIT_L(0); PG8_BAR; PG8_MMA(1, 0, At, B0); PG8_MMA(1, 1, At, B1); PG8_BAR; PG8_SCHED;
            } else {
            PG8_LDB(B0, 0, 0); PG8_SCHED; PG8_LDA(At, 0, 0); PG8_STAGE(PG8_SA(1, 1), a1 + hstep, voffA);
            PG8_WAIT_L(8); PG8_BAR; PG8_WAIT_L(0); PG8_MMA(0, 0, At, B0); PG8_BAR; PG8_SCHED;
            PG8_LDB(B1, 0, 1); PG8_STAGE(PG8_SB(0, 0), b2, voffB);
            PG8_BAR; PG8_WAIT_L(0); PG8_MMA(0, 1, At, B1); PG8_BAR;
            PG8_LDA(At, 0, 1); PG8_STAGE(PG8_SA(0, 0), a2, voffA);
            PG8_BAR; PG8_WAIT_L(0); PG8_MMA(1, 0, At, B0); PG8_BAR; PG8_SCHED;
            PG8_STAGE(PG8_SB(0, 1), b2 + hstep, voffB);
            PG8_WAIT_V(6); PG8_BAR; PG8_MMA(1, 1, At, B1); PG8_BAR;
            PG8_LDB(B0, 1, 0); PG8_SCHED; PG8_LDA(At, 1, 0); PG8_STAGE(PG8_SA(0, 1), a2 + hstep, voffA);
            PG8_WAIT_L(8); PG8_BAR; PG8_WAIT_L(0); PG8_MMA(0, 0, At, B0); PG8_BAR; PG8_SCHED;
            PG8_LDB(B1, 1, 1); PG8_STAGE(PG8_SB(1, 0), b3, voffB);
            PG8_BAR; PG8_WAIT_L(0); PG8_MMA(0, 1, At, B1); PG8_BAR;
            PG8_LDA(At, 1, 1); PG8_STAGE(PG8_SA(1, 0), a3, voffA);
            PG8_BAR; PG8_WAIT_L(0); PG8_MMA(1, 0, At, B0); PG8_BAR; PG8_SCHED;
            PG8_STAGE(PG8_SB(1, 1), b3 + hstep, voffB);
            PG8_WAIT_V(6); PG8_BAR; PG8_MMA(1, 1, At, B1); PG8_BAR;
            }
        }
        if constexpr (ALIGN_EPI) { if (wr == 0) PG8_BAR; }
        if constexpr (!Epi::AFTER_DRAIN) { E(acc, cur, wr, wc, fr, fq); S.done(cur); }
        if (!has_next) break;
#pragma unroll
        for (int a = 0; a < 2; ++a)
#pragma unroll
            for (int b = 0; b < 2; ++b)
#pragma unroll
                for (int m = 0; m < 4; ++m)
#pragma unroll
                    for (int n = 0; n < 2; ++n) acc[a][b][m][n] = (f32x4){0.f, 0.f, 0.f, 0.f};
        cur = nxt; cA = nA; cB = nB; ++ui;
        if constexpr (ALIGN_EPI) { if (wr == 1) PG8_BAR; }
    }
    PG8_WAIT_V(0);
    if constexpr (!ALIGN_EPI) { if (wr == 0) PG8_BAR; }
    PG8_BAR;
#undef PG8_SA
#undef PG8_SB
#undef PG8_STAGE
#undef PG8_LDA
#undef PG8_LDB
#undef PG8_MMA
#undef PG8_WAIT_V
#undef PG8_WAIT_L
#undef PG8_BAR
#undef PG8_SCHED
}
}

#define XB_TMO      128
#define XB_XCNT(j)  (256  + 64 * (j))
#define XB_XSUB(j)  (1280 + 64 * (j))
#define XB_XGEN(j)  (2304 + 64 * (j))
#define XB_TOP      3328
#define XB_TOPGEN   3392
#define XCD_BAR_WORDS 3456
#define XB_SPIN_CAP (1u << 18)
__device__ __forceinline__ unsigned xb_ld(unsigned* p)              { return __hip_atomic_load(p, __ATOMIC_RELAXED, __HIP_MEMORY_SCOPE_AGENT); }
__device__ __forceinline__ unsigned xb_add(unsigned* p, unsigned v) { return __hip_atomic_fetch_add(p, v, __ATOMIC_RELAXED, __HIP_MEMORY_SCOPE_AGENT); }
__device__ __forceinline__ unsigned xb_xcc_id() { return (unsigned)__builtin_amdgcn_s_getreg((3 << 11) | 20) & 0xFu; }
#define XB_SPIN(cond, bar) do { unsigned _sp = 0; while (cond) { __builtin_amdgcn_s_sleep(1); \
    if ((++_sp & 255u) == 0u) { if (xb_ld(&(bar)[XB_TMO])) break; if (_sp > XB_SPIN_CAP) { atomicAdd(&(bar)[XB_TMO], 1u); break; } } } } while (0)
struct XcdBarrier { unsigned* bar; unsigned x; volatile LAS unsigned* st; };
__device__ __forceinline__ XcdBarrier xcd_barrier_post(unsigned* bar, volatile LAS unsigned* st) {
    XcdBarrier b; b.bar = bar; b.x = xb_xcc_id(); b.st = st;
    if (threadIdx.x == 0) (void)xb_add(&bar[XB_XCNT(b.x)], 1u);
    return b;
}
__device__ __forceinline__ void xcd_barrier_complete(unsigned* bar, unsigned x, unsigned& nloc, unsigned& nx) {
    const unsigned G = gridDim.x * gridDim.y * gridDim.z;
    unsigned sum, cnt, mine, sp = 0u;
    for (;;) {
        sum = 0u; cnt = 0u; mine = 0u;
#pragma unroll
        for (unsigned j = 0; j < 16; ++j) { const unsigned c = xb_ld(&bar[XB_XCNT(j)]); sum += c; cnt += (c > 0u) ? 1u : 0u; mine = (j == x) ? c : mine; }
        if (sum == G) break;
        __builtin_amdgcn_s_sleep(1);
        if ((++sp & 255u) == 0u) { if (xb_ld(&bar[XB_TMO])) break; if (sp > XB_SPIN_CAP) { atomicAdd(&bar[XB_TMO], 1u); break; } }
    }
    nloc = mine > 0u ? mine : 1u; nx = cnt > 0u ? cnt : 1u;
}
__device__ __forceinline__ void xcd_barrier(const XcdBarrier& b) {
    asm volatile("s_waitcnt vmcnt(0)" ::: "memory");
    __syncthreads();
    if (threadIdx.x == 0) {
        unsigned* bar = b.bar;
        __builtin_amdgcn_s_waitcnt(0);
        unsigned nloc = b.st[0], nx = b.st[1];
        if (nloc == 0u) { xcd_barrier_complete(bar, b.x, nloc, nx); b.st[0] = nloc; b.st[1] = nx; }
        const unsigned old = xb_add(&bar[XB_XSUB(b.x)], 1u);
        const unsigned gen = old / nloc;
        if (old + 1u == (gen + 1u) * nloc) {
            __builtin_amdgcn_fence(__ATOMIC_RELEASE, "agent");
            asm volatile("s_waitcnt vmcnt(0)" ::: "memory");
            const unsigned og = xb_add(&bar[XB_TOP], 1u);
            const unsigned tg = og / nx;
            if (og + 1u == (tg + 1u) * nx) xb_add(&bar[XB_TOPGEN], 1u);
            else XB_SPIN(xb_ld(&bar[XB_TOPGEN]) == tg, bar);
            __builtin_amdgcn_fence(__ATOMIC_ACQUIRE, "agent");
            xb_add(&bar[XB_XGEN(b.x)], 1u);
            asm volatile("s_waitcnt vmcnt(0)" ::: "memory");
        } else {
            XB_SPIN(xb_ld(&bar[XB_XGEN(b.x)]) == gen, bar);
            __builtin_amdgcn_fence(__ATOMIC_ACQUIRE, "agent");
            asm volatile("s_waitcnt vmcnt(0)" ::: "memory");
        }
    }
    __syncthreads();
}

constexpr int BATCH = 8, SEQ = 4096, D = 1024, MTOK = BATCH * SEQ;
constexpr int QL = 256, KVL = 128, IDXD = 64, IDXH = 8, HATT = 8, TOPK = 256;
constexpr int RW = 512, HRW = 8, NRW = 64;
constexpr int IN_COLS = 2280, IN_PAD = 2304;
constexpr int C_CQ = 0, C_CKV = 256, C_IK = 384, C_IW = 448, C_R = 456, C_K = 968, C_V = 1480, C_WD = 1992, C_AD = 2056, C_GD = 2120;
constexpr int DFF = 2816;
constexpr int NQI = 1536;
constexpr int KOUT = 1536;
constexpr float NORM_EPS = 1e-6f, GN_EPS = 64e-5f;

constexpr size_t MiB = 1u << 20;
constexpr size_t WS_CTL = 0, CTL_ZERO_BYTES = 64 * 1024;
constexpr size_t WS_MOD = 1 * MiB;
constexpr size_t WS_WIN = 2 * MiB;
constexpr size_t WS_WCQ = 7 * MiB;
constexpr size_t WS_WOUT = 8 * MiB;
constexpr size_t WS_WGU = 11 * MiB;
constexpr size_t WS_WDN = 22 * MiB;
constexpr size_t WS_H = 32 * MiB;
constexpr size_t WS_RWW = 32 * MiB, WS_RWA = 64 * MiB;
constexpr size_t WS_PROJ = 96 * MiB;
constexpr size_t WS_CQ = 240 * MiB;
constexpr size_t WS_SEL = 240 * MiB;
constexpr size_t WS_OATT = 256 * MiB;
constexpr size_t WS_CKV = 352 * MiB;
constexpr size_t WS_IK16 = 360 * MiB;
constexpr size_t WS_IK32 = 364 * MiB;
constexpr size_t WS_IW = 372 * MiB;
constexpr size_t WS_RWG = 376 * MiB;
constexpr size_t WS_YRAW = 408 * MiB;
constexpr size_t WS_MIX = 408 * MiB;
constexpr size_t WS_ACT = 96 * MiB;
constexpr size_t WS_F = 288 * MiB;
constexpr size_t WS_CKV8 = 368 * MiB;
constexpr size_t WS_END = 504 * MiB;

constexpr int CW_BAR = 1024;
constexpr int NWAVES = 8;
constexpr int RING_BYTES = 131072, AUX_OFF = RING_BYTES  , MISC_OFF = 163584, LDS_BYTES = 163648;

struct Args { const float* in[32]; float* out; unsigned char* ws; int ph_lo, ph_hi; };

__device__ __forceinline__ float wave_sum(float v) {
#pragma unroll
    for (int o = 1; o < 64; o <<= 1) v += __shfl_xor(v, o);
    return v;
}
__device__ __forceinline__ void lds_barrier() { asm volatile("s_waitcnt lgkmcnt(0)\n\ts_barrier" ::: "memory"); }
__device__ __forceinline__ float sigmoidf_(float x) { return __builtin_amdgcn_rcpf(1.0f + __expf(-x)); }

__device__ __forceinline__ void p0_transpose_item(const float* W, int K, int N, int Npad, f16* WT, int ldk, int koff, int row_off, int mode, LAS float* scr, int item, int lane) {
    const int nblk = Npad / 32, kb = item / nblk, nb = item % nblk, k0 = 64 * kb, n0 = 32 * nb;
    const int rr = lane >> 3, c4 = 4 * (lane & 7);
    f32x4 v[8];
#pragma unroll
    for (int i = 0; i < 8; ++i) { const int kk = 8 * i + rr; v[i] = (n0 + c4 < N && k0 + kk < K) ? *(const f32x4*)(W + (size_t)(k0 + kk) * N + n0 + c4) : (f32x4){0.f, 0.f, 0.f, 0.f}; }
#pragma unroll
    for (int i = 0; i < 8; ++i) { const int kk = 8 * i + rr; LAS float* d = scr + kk * 33 + c4; d[0] = v[i][0]; d[1] = v[i][1]; d[2] = v[i][2]; d[3] = v[i][3]; }
    asm volatile("s_waitcnt lgkmcnt(0)" ::: "memory");
    const int c = lane & 7;
#pragma unroll
    for (int j = 0; j < 4; ++j) { const int nl = (lane >> 3) + 8 * j; const LAS float* s = scr + (8 * c) * 33 + nl;
        u32x4 o; o.x = pkh(s[0 * 33], s[1 * 33]); o.y = pkh(s[2 * 33], s[3 * 33]); o.z = pkh(s[4 * 33], s[5 * 33]); o.w = pkh(s[6 * 33], s[7 * 33]);
        const int n = n0 + nl; int row;
        if (mode == 0) row = row_off + n; else row = (n >> 7) * 256 + (mode == 2 ? 128 : 0) + (n & 127);
        *(u32x4*)(WT + (size_t)row * ldk + koff + k0 + 8 * c) = o; }
    asm volatile("s_waitcnt lgkmcnt(0)" ::: "memory");
}

__device__ __forceinline__ void p0_prologue(const Args& a, LAS unsigned char* lds, int vcu, int G, int wave, int lane) {
    unsigned char* ws = a.ws;
    LAS float* scr = (LAS float*)(lds + wave * 16384);
    const int gw = vcu * NWAVES + wave, NGW = G * NWAVES;
    f16* Win = (f16*)(ws + WS_WIN); f16* Wcq = (f16*)(ws + WS_WCQ); f16* Wout = (f16*)(ws + WS_WOUT); f16* Wgu = (f16*)(ws + WS_WGU); f16* Wdn = (f16*)(ws + WS_WDN);
    constexpr int I_IN = (D / 64) * (IN_PAD / 32), I_IDX = (QL / 64) * (512 / 32), I_OR = (512 / 64) * (D / 32), I_G = (D / 64) * (DFF / 32), I_D = (DFF / 64) * (D / 32);
    constexpr int I_FQ = 4 * 64, I_FO = 16 * 64, I_MOD = 8 * 96, I_LD = 16, I_LG = 48;
    constexpr int NITEMS = I_IN + I_IDX + I_OR + 2 * I_G + I_D + I_FQ + I_FO + 2 * I_LD + I_LG;
    const bool split = (G == 256);
    const int gw2 = split ? (vcu - 96) * NWAVES + wave : gw, NGW2 = split ? (G - 96) * NWAVES : NGW;
    for (int it = gw2; it < NITEMS && gw2 >= 0; it += NGW2) {
        int r = it;
        if (r < I_IN) { p0_transpose_item(a.in[9], D, IN_COLS, IN_PAD, Win, D, 0, 0, 0, scr, r, lane); continue; } r -= I_IN;
        if (r < I_IDX) { p0_transpose_item(a.in[12], QL, 512, 512, Wcq, QL, 0, 1024, 0, scr, r, lane); continue; } r -= I_IDX;
        if (r < I_OR) { p0_transpose_item(a.in[28] + (size_t)512 * D, 512, D, D, Wout, KOUT, 1024, 0, 0, scr, r, lane); continue; } r -= I_OR;
        if (r < I_G) { p0_transpose_item(a.in[29], D, DFF, DFF, Wgu, D, 0, 0, 1, scr, r, lane); continue; } r -= I_G;
        if (r < I_G) { p0_transpose_item(a.in[30], D, DFF, DFF, Wgu, D, 0, 0, 2, scr, r, lane); continue; } r -= I_G;
        if (r < I_D) { p0_transpose_item(a.in[31], DFF, D, D, Wdn, DFF, 0, 0, 0, scr, r, lane); continue; } r -= I_D;
        if (r < I_FQ) {
            const int rb = r & 3, nb = r >> 2, rr = rb * 64 + lane, n0 = nb * 16, h = n0 >> 7;
            const float* uq = a.in[11] + (size_t)rr * 512 + h * 64; const float* uk = a.in[15] + (size_t)n0 * 64;
            float q[64];
#pragma unroll
            for (int d4 = 0; d4 < 16; ++d4) { const f32x4 v = *(const f32x4*)(uq + 4 * d4); q[4 * d4] = v[0]; q[4 * d4 + 1] = v[1]; q[4 * d4 + 2] = v[2]; q[4 * d4 + 3] = v[3]; }
#pragma unroll 4
            for (int i = 0; i < 16; ++i) { float s = 0.f;
#pragma unroll
                for (int d = 0; d < 64; ++d) s += q[d] * uk[i * 64 + d];
                Wcq[(size_t)(n0 + i) * QL + rr] = (f16)(0.125f * s); }
            continue; } r -= I_FQ;
        if (r < I_FO) {
            const int kb = r & 15, nb = r >> 4, k = kb * 64 + lane, h = kb >> 1, n0 = nb * 16;
            const float* uvp = a.in[16] + (size_t)k * 64; const float* wo = a.in[28] + (size_t)(h * 64) * D + n0;
            float uv[64];
#pragma unroll
            for (int d4 = 0; d4 < 16; ++d4) { const f32x4 v = *(const f32x4*)(uvp + 4 * d4); uv[4 * d4] = v[0]; uv[4 * d4 + 1] = v[1]; uv[4 * d4 + 2] = v[2]; uv[4 * d4 + 3] = v[3]; }
            float acc[16];
#pragma unroll
            for (int i = 0; i < 16; ++i) acc[i] = 0.f;
#pragma unroll
            for (int d = 0; d < 64; ++d) {
#pragma unroll
                for (int i = 0; i < 16; ++i) acc[i] += uv[d] * wo[(size_t)d * D + i]; }
#pragma unroll
            for (int i = 0; i < 16; ++i) Wout[(size_t)(n0 + i) * KOUT + k] = (f16)acc[i];
            continue; } r -= I_FO;
        if (r < I_LD) { p0_transpose_item(a.in[19], 64, 512, 512, (f16*)(ws + (28u << 20)), 64, 0, 0, 0, scr, r, lane); continue; } r -= I_LD;
        if (r < I_LD) { p0_transpose_item(a.in[21], 64, 512, 512, (f16*)(ws + (28u << 20) + 65536), 64, 0, 0, 0, scr, r, lane); continue; } r -= I_LD;
        { p0_transpose_item(a.in[22], 160, 512, 512, (f16*)(ws + (28u << 20) + 131072), 192, 0, 0, 0, scr, r, lane); }
    }
    if (vcu < 96) {
        __syncthreads();
        const int tid = wave * 64 + lane;
        for (int e = tid; e < 8 * D; e += 512) { const float cc = a.in[1][e]; *(LAS float*)(lds + (e >> 10) * 16384 + 10496 + (e & 1023) * 4) = cc * sigmoidf_(cc); }
        for (int cb = vcu; cb < 96; cb += G) {
            __syncthreads();
            const int j = cb * 64 + lane; const float* aw = a.in[3] + j;
            float acc[8];
#pragma unroll
            for (int b = 0; b < 8; ++b) acc[b] = 0.f;
            const int kbeg = wave * 128;
#pragma unroll 1
            for (int k0 = 0; k0 < 128; k0 += 16) {
                float wv[16];
#pragma unroll
                for (int i = 0; i < 16; ++i) wv[i] = aw[(size_t)(kbeg + k0 + i) * 6144];
#pragma unroll
                for (int b = 0; b < 8; ++b) {
#pragma unroll
                    for (int i4 = 0; i4 < 4; ++i4) { const f32x4 sv = *(const LAS f32x4*)(lds + b * 16384 + 10496 + (kbeg + k0 + 4 * i4) * 4);
                        acc[b] += sv[0] * wv[4 * i4] + sv[1] * wv[4 * i4 + 1] + sv[2] * wv[4 * i4 + 2] + sv[3] * wv[4 * i4 + 3]; } }
            }
#pragma unroll
            for (int b = 0; b < 8; ++b) *(LAS float*)(lds + wave * 16384 + 8448 + (b * 64 + lane) * 4) = acc[b];
            __syncthreads();
            float sum = 0.f;
#pragma unroll
            for (int w = 0; w < 8; ++w) sum += *(const LAS float*)(lds + w * 16384 + 8448 + (wave * 64 + lane) * 4);
            ((float*)(ws + WS_MOD))[wave * 6144 + j] = sum + a.in[4][j];
        }
    }
}

__device__ __forceinline__ void p1_modnorm(const Args& a, int vcu, int G, int wave, int lane) {
    const int gw = vcu * NWAVES + wave, NGW = G * NWAVES;
    const float* mod = (const float*)(a.ws + WS_MOD); f16* H = (f16*)(a.ws + WS_H);
    f32x4 gq[4];
#pragma unroll
    for (int j = 0; j < 4; ++j) gq[j] = *(const f32x4*)(a.in[5] + 4 * lane + 256 * j);
    f32x4 nv[4];
    if (gw < MTOK) {
#pragma unroll
        for (int j = 0; j < 4; ++j) nv[j] = ((const f32x4*)(a.in[0] + (size_t)gw * D) + lane)[64 * j]; }
    for (int m = gw; m < MTOK; m += NGW) {
        const int b = m >> 12;
        f32x4 v[4]; float s = 0.f;
#pragma unroll
        for (int j = 0; j < 4; ++j) { v[j] = nv[j]; s += (v[j][0] * v[j][0] + v[j][1] * v[j][1]) + (v[j][2] * v[j][2] + v[j][3] * v[j][3]); }
        const int mn = (m + NGW < MTOK) ? m + NGW : m;
#pragma unroll
        for (int j = 0; j < 4; ++j) nv[j] = ((const f32x4*)(a.in[0] + (size_t)mn * D) + lane)[64 * j];
        const float r = rsqrtf(wave_sum(s) * (1.f / D) + NORM_EPS);
        u32x2* o = (u32x2*)(H + (size_t)m * D) + lane;
#pragma unroll
        for (int j = 0; j < 4; ++j) { const int c = 4 * lane + 256 * j;
            const f32x4 sh = *(const f32x4*)(mod + b * 6144 + c), sc = *(const f32x4*)(mod + b * 6144 + 1024 + c);
            f32x4 y;
#pragma unroll
            for (int e = 0; e < 4; ++e) y[e] = v[j][e] * r * gq[j][e] * (1.f + sc[e]) + sh[e];
            u32x2 w; w.x = pkh(y[0], y[1]); w.y = pkh(y[2], y[3]); o[64 * j] = w; }
    }
}

__device__ __forceinline__ void p3_rows(const Args& a, int vcu, int G, int wave, int lane) {
    const int gw = vcu * NWAVES + wave, NGW = G * NWAVES;
    unsigned char* ws = a.ws;
    const f16* PROJ = (const f16*)(ws + WS_PROJ);
    f16* CQ = (f16*)(ws + WS_CQ); f16* CKV = (f16*)(ws + WS_CKV); f16* IK16 = (f16*)(ws + WS_IK16); float* IW = (float*)(ws + WS_IW);
    for (int m = gw; m < MTOK; m += NGW) {
        const f16* pr = PROJ + (size_t)m * IN_PAD;
        const f16x4 q = *(const f16x4*)(pr + C_CQ + 4 * lane);
        const f16x2 kv = *(const f16x2*)(pr + C_CKV + 2 * lane);
        const float ik = (float)pr[C_IK + lane];
        float q0 = (float)q[0], q1 = (float)q[1], q2 = (float)q[2], q3 = (float)q[3], k0 = (float)kv[0], k1 = (float)kv[1];
        const float rq = rsqrtf(wave_sum(q0 * q0 + q1 * q1 + q2 * q2 + q3 * q3) * (1.f / QL) + NORM_EPS);
        const float rk = rsqrtf(wave_sum(k0 * k0 + k1 * k1) * (1.f / KVL) + NORM_EPS);
        const float ri = rsqrtf(wave_sum(ik * ik) * (1.f / IDXD) + NORM_EPS);
        const f32x4 gq = *(const f32x4*)(a.in[10] + 4 * lane); const f32x2 gk = *(const f32x2*)(a.in[13] + 2 * lane); const float gi = a.in[14][lane];
        u32x2 w; w.x = pkh(q0 * rq * gq[0], q1 * rq * gq[1]); w.y = pkh(q2 * rq * gq[2], q3 * rq * gq[3]);
        *(u32x2*)(CQ + (size_t)m * QL + 4 * lane) = w;
        ((unsigned short*)(ws + WS_CKV8))[(size_t)m * 64 + lane] = (unsigned short)__builtin_amdgcn_cvt_pk_fp8_f32(k0 * rk * gk[0], k1 * rk * gk[1], 0, false);
        const float ikn = ik * ri * gi;
        IK16[(size_t)m * IDXD + lane] = (f16)ikn;
        if (lane < 8) IW[(size_t)m * 8 + lane] = (float)pr[C_IW + lane] * 0.04419417382415922f;
    }
}
__device__ __forceinline__ void p3_rwkv_prep(const Args& a, LAS unsigned char* lds, int vcu, int G, int tid) {
    unsigned char* ws = a.ws;
    const f16* PROJ = (const f16*)(ws + WS_PROJ);
    f16* RWW = (f16*)(ws + WS_RWW); f16* RWA = (f16*)(ws + WS_RWA); f16* RWG = (f16*)(ws + WS_RWG);
    LAS float* xs = (LAS float*)lds;
    const float* mu = a.in[17];
    const int ch = tid;
    const float w0 = a.in[18][ch], a0 = a.in[20][ch];
    for (int u = vcu; u < MTOK / 16; u += G) {
        const int m0 = u * 16;
        __syncthreads();
        for (int e = tid; e < 16 * 288; e += 512) {
            const int t = e / 288, col = e % 288, m = m0 + t;
            const float cur = (float)PROJ[(size_t)m * IN_PAD + C_WD + col];
            const float prev = ((m & (SEQ - 1)) != 0) ? (float)PROJ[(size_t)(m - 1) * IN_PAD + C_WD + col] : 0.f;
            float v = cur + mu[1536 + col] * (prev - cur);
            if (col < 64) v = tanhf(v); else if (col >= 128) v = sigmoidf_(v);
            xs[t * 288 + col] = v;
        }
        __syncthreads();
        float dl[16], al[16], gl[16];
#pragma unroll
        for (int t = 0; t < 16; ++t) { dl[t] = 0.f; al[t] = 0.f; gl[t] = 0.f; }
        for (int kk = 0; kk < 64; ++kk) {
            const float wd = a.in[19][kk * 512 + ch], wa = a.in[21][kk * 512 + ch];
#pragma unroll
            for (int t = 0; t < 16; ++t) { dl[t] += xs[t * 288 + kk] * wd; al[t] += xs[t * 288 + 64 + kk] * wa; }
        }
        for (int kk = 0; kk < 160; ++kk) {
            const float wg = a.in[22][kk * 512 + ch];
#pragma unroll
            for (int t = 0; t < 16; ++t) gl[t] += xs[t * 288 + 128 + kk] * wg;
        }
#pragma unroll
        for (int t = 0; t < 16; ++t) {
            const float z = -(w0 + dl[t]);
            const float sp = z > 20.f ? z : log1pf(__expf(z));
            const float wlog = -sp - 0.5f;
            const float lw = -__expf(wlog);
            const float av = sigmoidf_(a0 + al[t]);
            const size_t o = (size_t)(m0 + t) * RW + ch;
            RWW[o] = (f16)lw; RWA[o] = (f16)av; RWG[o] = (f16)gl[t];
        }
    }
}

__device__ __forceinline__ unsigned f2key(float f) { const unsigned u = __builtin_bit_cast(unsigned, f); return (u & 0x80000000u) ? ~u : (u | 0x80000000u); }
__device__ __forceinline__ void p5_indexer(const Args& a, LAS unsigned char* lds, int vcu, int G, int wave, int lane) {
    unsigned char* ws = a.ws;
    const f16* QI = (const f16*)a.out;
    const float* IK32 = (const float*)(ws + WS_IK32); const float* IW = (const float*)(ws + WS_IW);
    unsigned short* SEL = (unsigned short*)(ws + WS_SEL);
    LAS float* sc = (LAS float*)(lds + wave * 16384);
    LAS float* iq = (LAS float*)(lds + AUX_OFF + wave * 2048);
    const int gw = vcu * NWAVES + wave, NGW = G * NWAVES;
    for (int q = gw; q < MTOK; q += NGW) {
        const int b = q >> 12, t = q & (SEQ - 1);
        unsigned short* sel = SEL + (size_t)q * TOPK;
        if (t < TOPK) {
#pragma unroll
            for (int j = 0; j < 4; ++j) { const int s = lane + 64 * j; sel[s] = (s <= t) ? (unsigned short)s : (unsigned short)0xFFFF; }
            continue;
        }
        { const f16x8 v = *(const f16x8*)(QI + (size_t)q * NQI + 1024 + 8 * lane);
#pragma unroll
          for (int e = 0; e < 8; ++e) iq[8 * lane + e] = (float)v[e]; }
        float wq[8];
#pragma unroll
        for (int h = 0; h < 8; ++h) wq[h] = IW[(size_t)q * 8 + h];
        asm volatile("s_waitcnt lgkmcnt(0)" ::: "memory");
        const int nj = (t >> 6) + 1;
        for (int j = 0; j < nj; ++j) {
            const int s = j * 64 + lane;
            const float* kr = IK32 + ((size_t)(b << 12) + (s <= t ? s : t)) * IDXD;
            float kx[64];
#pragma unroll
            for (int d4 = 0; d4 < 16; ++d4) { const f32x4 v = *(const f32x4*)(kr + 4 * d4); kx[4 * d4] = v[0]; kx[4 * d4 + 1] = v[1]; kx[4 * d4 + 2] = v[2]; kx[4 * d4 + 3] = v[3]; }
            float score = 0.f;
#pragma unroll
            for (int h = 0; h < 8; ++h) { float d0 = 0.f;
#pragma unroll
                for (int d4 = 0; d4 < 16; ++d4) { const f32x4 qv = *(const LAS f32x4*)(iq + h * 64 + 4 * d4); d0 += qv[0] * kx[4 * d4]; d0 += qv[1] * kx[4 * d4 + 1]; d0 += qv[2] * kx[4 * d4 + 2]; d0 += qv[3] * kx[4 * d4 + 3]; }
                score += wq[h] * fmaxf(d0, 0.f); }
            sc[s] = (s <= t) ? score : -INFINITY;
        }
        asm volatile("s_waitcnt lgkmcnt(0)" ::: "memory");
        const int nvalid = nj * 64;
        unsigned key[64];
#pragma unroll
        for (int j = 0; j < 64; ++j) { const int s = lane * 64 + j; key[j] = (s < nvalid) ? f2key(sc[s]) : 0u; }
        unsigned prefix = 0u;
        for (int bit = 31; bit >= 0; --bit) {
            const unsigned cand = prefix | (1u << bit);
            int c = 0;
#pragma unroll
            for (int j = 0; j < 64; ++j) c += (key[j] >= cand) ? 1 : 0;
#pragma unroll
            for (int o = 1; o < 64; o <<= 1) c += __shfl_xor(c, o);
            if (c >= TOPK) prefix = cand;
        }
        int cgt = 0, ceq = 0;
#pragma unroll
        for (int j = 0; j < 64; ++j) { cgt += (key[j] > prefix) ? 1 : 0; ceq += (key[j] == prefix) ? 1 : 0; }
        int sgt = cgt, seq = ceq;
#pragma unroll
        for (int o = 1; o < 64; o <<= 1) { const int x = __shfl_up(sgt, o), y = __shfl_up(seq, o); if (lane >= o) { sgt += x; seq += y; } }
        const int tot_gt = __shfl(sgt, 63);
        int pos_gt = sgt - cgt, rank_eq = seq - ceq;
        const int need = TOPK - tot_gt;
#pragma unroll
        for (int j = 0; j < 64; ++j) {
            const int s = lane * 64 + j;
            if (key[j] > prefix) { sel[pos_gt] = (unsigned short)s; ++pos_gt; }
            else if (key[j] == prefix) { if (rank_eq < need) sel[tot_gt + rank_eq] = (unsigned short)s; ++rank_eq; }
        }
    }
}

__device__ __forceinline__ int t5_bucket(int rel) {
    if (rel < 16) return rel;
    const int l = 16 + (int)(logf((float)rel * (1.f / 16.f)) / 2.0794415416798357f * 16.f);
    return l < 31 ? l : 31;
}
__device__ __forceinline__ void p6_attention(const Args& a, LAS unsigned char* lds, int vcu, int G, int wave, int lane) {
    unsigned char* ws = a.ws;
    const f16* QI = (const f16*)a.out; const f16* CKV = (const f16*)(ws + WS_CKV);
    const unsigned short* SEL = (const unsigned short*)(ws + WS_SEL);
    f16* OATT = (f16*)(ws + WS_OATT);
    const float* rel_bias = a.in[2];
    LAS float* qa = (LAS float*)(lds + wave * 16384);
    LAS float* pp = (LAS float*)(lds + wave * 16384 + 4096);
    LAS int* sidx = (LAS int*)(lds + wave * 16384 + 12288);
    const int gw = vcu * NWAVES + wave, NGW = G * NWAVES;
    for (int q = gw; q < MTOK; q += NGW) {
        const int b = q >> 12, t = q & (SEQ - 1);
#pragma unroll
        for (int i = 0; i < 2; ++i) { const f16x8 v = *(const f16x8*)(QI + (size_t)q * NQI + 512 * i + 8 * lane);
#pragma unroll
            for (int e = 0; e < 8; ++e) qa[512 * i + 8 * lane + e] = (float)v[e]; }
        asm volatile("s_waitcnt lgkmcnt(0)" ::: "memory");
        float lg[4][8];
        int srow[4]; bool okv[4];
#pragma unroll
        for (int i = 0; i < 4; ++i) {
            const int sraw = SEL[(size_t)q * TOPK + lane + 64 * i];
            okv[i] = sraw != 0xFFFF && sraw <= t;
            srow[i] = okv[i] ? sraw : 0;
            sidx[lane + 64 * i] = okv[i] ? sraw : -1;
#pragma unroll
            for (int h = 0; h < 8; ++h) lg[i][h] = 0.f;
        }
#pragma unroll 1
        for (int c8 = 0; c8 < 16; ++c8) {
            f16x8 kv[4];
#pragma unroll
            for (int i = 0; i < 4; ++i) kv[i] = *(const f16x8*)(CKV + ((size_t)(b << 12) + srow[i]) * KVL + 8 * c8);
#pragma unroll
            for (int h = 0; h < 8; ++h) {
                const f32x4 q0 = *(const LAS f32x4*)(qa + h * 128 + 8 * c8), q1 = *(const LAS f32x4*)(qa + h * 128 + 8 * c8 + 4);
#pragma unroll
                for (int i = 0; i < 4; ++i)
                    lg[i][h] += q0[0] * (float)kv[i][0] + q0[1] * (float)kv[i][1] + q0[2] * (float)kv[i][2] + q0[3] * (float)kv[i][3] + q1[0] * (float)kv[i][4] + q1[1] * (float)kv[i][5] + q1[2] * (float)kv[i][6] + q1[3] * (float)kv[i][7];
            }
        }
#pragma unroll
        for (int i = 0; i < 4; ++i) {
            const int bk = t5_bucket(t - srow[i]);
#pragma unroll
            for (int h = 0; h < 8; ++h) lg[i][h] = okv[i] ? lg[i][h] + rel_bias[bk * 8 + h] : -INFINITY;
        }
#pragma unroll
        for (int h = 0; h < 8; ++h) {
            float mx = fmaxf(fmaxf(lg[0][h], lg[1][h]), fmaxf(lg[2][h], lg[3][h]));
#pragma unroll
            for (int o = 1; o < 64; o <<= 1) mx = fmaxf(mx, __shfl_xor(mx, o));
            float e[4], s = 0.f;
#pragma unroll
            for (int i = 0; i < 4; ++i) { e[i] = __expf(lg[i][h] - mx); s += e[i]; }
            s = wave_sum(s);
            const float inv = 1.f / s;
#pragma unroll
            for (int i = 0; i < 4; ++i) pp[h * 256 + lane + 64 * i] = e[i] * inv;
        }
        asm volatile("s_waitcnt lgkmcnt(0)" ::: "memory");
        float o0[8], o1[8];
#pragma unroll
        for (int h = 0; h < 8; ++h) { o0[h] = 0.f; o1[h] = 0.f; }
        for (int kk = 0; kk < TOPK; ++kk) {
            const int s = sidx[kk];
            if (s < 0) continue;
            const f16x2 kv = *(const f16x2*)(CKV + ((size_t)(b << 12) + s) * KVL + 2 * lane);
            const float v0 = (float)kv[0], v1 = (float)kv[1];
#pragma unroll
            for (int h = 0; h < 8; ++h) { const float p = pp[h * 256 + kk]; o0[h] += p * v0; o1[h] += p * v1; }
        }
#pragma unroll
        for (int h = 0; h < 8; ++h) *(unsigned*)(OATT + (size_t)q * KOUT + h * 128 + 2 * lane) = pkh(o0[h], o1[h]);
        asm volatile("s_waitcnt lgkmcnt(0)" ::: "memory");
    }
}

constexpr int SC_PITCH = 8224, DSA_SEL_OFF = 16 * SC_PITCH, DSA_BL_OFF = DSA_SEL_OFF + 8192, DSA_HIST_OFF = 143936;
static_assert(DSA_BL_OFF + 129 * 8 * 4 <= DSA_HIST_OFF && DSA_HIST_OFF + 8 * 1280 <= MISC_OFF, "DSA LDS map");
typedef short v4i16_t __attribute__((ext_vector_type(4)));
__device__ __forceinline__ unsigned kv_off(unsigned row, unsigned ch) { return 256u * row + 16u * (ch ^ (((row & 3u) << 2) | ((row >> 2) & 3u))); }
__device__ __forceinline__ f16x4 tr_read16(LAS unsigned char* p) { return __builtin_bit_cast(f16x4, __builtin_amdgcn_ds_read_tr16_b64_v4i16((LAS v4i16_t*)p)); }
template <int CTRL, int RMASK> __device__ __forceinline__ int dpp_i(int x) { return __builtin_amdgcn_update_dpp(0, x, CTRL, RMASK, 0xF, false); }
template <int CTRL> __device__ __forceinline__ int dpp_iz(int x) { return __builtin_amdgcn_update_dpp(0, x, CTRL, 0xF, 0xF, true); }
__device__ __forceinline__ int wave_incl_scan_i(int x) { x += dpp_iz<0x111>(x); x += dpp_iz<0x112>(x); x += dpp_iz<0x114>(x); x += dpp_iz<0x118>(x);
    x += dpp_i<0x142, 0xA>(x); x += dpp_i<0x143, 0xC>(x); return x; }
__device__ __forceinline__ void p5_dsa(const Args& a, LAS unsigned char* lds, int G, int bx, int tid, int wave, int lane) {
    unsigned char* ws = a.ws;
    const f16* QI = (const f16*)a.out; const f16* IK16 = (const f16*)(ws + WS_IK16); const float* IW = (const float*)(ws + WS_IW);
    const f16* CKV = (const f16*)(ws + WS_CKV); f16* OATT = (f16*)(ws + WS_OATT);
    LAS unsigned short* SELL = (LAS unsigned short*)(lds + DSA_SEL_OFF);
    LAS float* BL = (LAS float*)(lds + DSA_BL_OFF);
    for (int e = tid; e < 129 * 8; e += 512) { const int rel = e >> 3, h = e & 7; BL[e] = a.in[2][t5_bucket(rel) * 8 + h] * 1.4426950408889634f; }
    const int nunits = BATCH * (SEQ / 16);
    const bool balanced = (G == 256);
    const int niter = balanced ? 8 : (nunits + G - 1) / G;
#pragma unroll 1
    for (int it = 0; it < niter; ++it) {
        int b, tile;
        if (balanced) { b = bx & 7; const int r = bx >> 3, base = 64 * (it >> 1); tile = (it & 1) ? base + 63 - r : base + r; }
        else { const int u = it * G + bx; if (u >= nunits) break; b = u >> 8; tile = u & 255; }
        int lane_o = lane; asm volatile("" : "+v"(lane_o));
        const int r16 = lane_o & 15, g = lane_o >> 4;
        const int t0 = tile * 16;
        const size_t qb = (size_t)(b << 12);
        const int jn = ((t0 + 15) >> 7) + 1;
        lds_barrier();
#ifndef DSAREP
#define DSAREP 0
#endif
#ifndef DSA_NO_A
        for (int ra_ = 0; ra_ < ((DSAREP & 1) ? 2 : 1); ++ra_)
        if (t0 + 15 >= TOPK) {
            f16x8 afr[8][2]; f32x4 wv[4][2];
#pragma unroll
            for (int mt = 0; mt < 8; ++mt) { const int tg = mt >> 1, hf = mt & 1, t = t0 + 4 * tg + (r16 >> 2), h = 4 * hf + (r16 & 3);
#pragma unroll
                for (int ks = 0; ks < 2; ++ks) afr[mt][ks] = *(const f16x8*)(QI + (qb + t) * NQI + 1024 + h * 64 + 32 * ks + 8 * g); }
#pragma unroll
            for (int tg = 0; tg < 4; ++tg)
#pragma unroll
                for (int hf = 0; hf < 2; ++hf) wv[tg][hf] = *(const f32x4*)(IW + (qb + t0 + 4 * tg + g) * 8 + 4 * hf) * 65536.0f;
            const f32x2 cscale = {1.52587890625e-05f, 1.52587890625e-05f};
            f16x8 bn0[2], bn1[2], bn2[2];
            const f16* ikp = IK16 + (qb + 16 * wave + r16) * IDXD + 8 * g;
#define A_LOAD(BN, j_) do { const f16* p_ = ikp + (size_t)(128 * (j_)) * IDXD; asm volatile("global_load_dwordx4 %0, %2, off\n\tglobal_load_dwordx4 %1, %2, off offset:64" : "=&v"(BN[0]), "=&v"(BN[1]) : "v"(p_) : "memory"); } while (0)
#define A_WAIT(BN) asm volatile("s_waitcnt vmcnt(4)" : "+v"(BN[0]), "+v"(BN[1]) :: "memory")
#define A_STEP(BN, j_) do { const int j = (j_); const int s = 128 * j + 16 * wave + r16; A_WAIT(BN); f16x8 bfr[2]; bfr[0] = BN[0]; bfr[1] = BN[1]; \
                f32x4 acc[8]; \
_Pragma("unroll") \
                for (int mt = 0; mt < 8; ++mt) { acc[mt] = __builtin_amdgcn_mfma_f32_16x16x32_f16(afr[mt][0], bfr[0], (f32x4){0.f, 0.f, 0.f, 0.f}, 0, 0, 0); \
                    acc[mt] = __builtin_amdgcn_mfma_f32_16x16x32_f16(afr[mt][1], bfr[1], acc[mt], 0, 0, 0); } \
                asm volatile("s_nop 15\n\ts_nop 7" :: "v"(acc[0]), "v"(acc[1]), "v"(acc[2]), "v"(acc[3]), "v"(acc[4]), "v"(acc[5]), "v"(acc[6]), "v"(acc[7])); \
                float scv[4]; \
_Pragma("unroll") \
                for (int tg = 0; tg < 4; ++tg) { f32x2 s2 = {0.f, 0.f}; \
_Pragma("unroll") \
                    for (int hf = 0; hf < 2; ++hf) \
_Pragma("unroll") \
                        for (int p = 0; p < 2; ++p) { const f32x2 av = {acc[2 * tg + hf][2 * p], acc[2 * tg + hf][2 * p + 1]}; f32x2 r; \
                            asm volatile("v_pk_mul_f32 %0, %1, %2 clamp" : "=v"(r) : "v"(av), "v"(cscale)); \
                            const f32x2 wp = {wv[tg][hf][2 * p], wv[tg][hf][2 * p + 1]}; s2 = r * wp + s2; } \
                    scv[tg] = s2[0] + s2[1]; } \
                if (j == jn - 1) { \
_Pragma("unroll") \
                    for (int tg = 0; tg < 4; ++tg) if (s > t0 + 4 * tg + g) scv[tg] = -INFINITY; } \
_Pragma("unroll") \
                for (int pr = 0; pr < 2; ++pr) { \
                    const unsigned x = pkh(scv[2 * pr], scv[2 * pr + 1]); \
                    const unsigned k2 = x ^ ((((x >> 15) & 0x00010001u) * 0x7FFFu) | 0x80008000u); \
                    *(LAS unsigned short*)(lds + (4 * (2 * pr) + g) * SC_PITCH + s * 2) = (unsigned short)(k2 & 0xFFFFu); \
                    *(LAS unsigned short*)(lds + (4 * (2 * pr + 1) + g) * SC_PITCH + s * 2) = (unsigned short)(k2 >> 16); } \
                A_LOAD(BN, (j + 3 < jn) ? j + 3 : jn - 1); } while (0)
            A_LOAD(bn0, 0); A_LOAD(bn1, (jn > 1) ? 1 : 0); A_LOAD(bn2, (jn > 2) ? 2 : jn - 1);
#pragma unroll 1
            for (int j3 = 0; j3 < jn; j3 += 3) { A_STEP(bn0, j3); if (j3 + 1 < jn) A_STEP(bn1, j3 + 1); if (j3 + 2 < jn) A_STEP(bn2, j3 + 2); }
            asm volatile("s_waitcnt vmcnt(0)" : "+v"(bn0[0]), "+v"(bn0[1]), "+v"(bn1[0]), "+v"(bn1[1]), "+v"(bn2[0]), "+v"(bn2[1]) :: "memory");
#undef A_LOAD
#undef A_WAIT
#undef A_STEP
        }
#endif
        __builtin_amdgcn_sched_barrier(0); lds_barrier(); __builtin_amdgcn_sched_barrier(0);
#ifndef DSA_NO_C
#pragma unroll 1
        for (int rr = 0; rr < ((DSAREP & 2) ? 4 : 2); ++rr) {
            const int rl = 2 * wave + (rr & 1), t = t0 + rl;
            LAS unsigned short* sel = SELL + rl * 256;
            if (t < TOPK) {
#pragma unroll
                for (int k = 0; k < 4; ++k) { const int jx = lane_o + 64 * k; sel[jx] = (jx <= t) ? (unsigned short)jx : (unsigned short)0xFFFF; }
                continue;
            }
            const LAS unsigned* srow = (const LAS unsigned*)(lds + rl * SC_PITCH) + lane_o;
#define DSA_KEY(jj_) (srow[(jj_) * 64])
            LAS unsigned* hist = (LAS unsigned*)(lds + DSA_HIST_OFF + wave * 1280);
            unsigned prefix = 0u; int kneed = TOPK;
#pragma unroll 1
            for (int pass = 0; pass < 2; ++pass) {
                *(LAS u32x4*)(hist + 4 * lane_o) = (u32x4){0u, 0u, 0u, 0u};
                asm volatile("s_waitcnt lgkmcnt(0)" ::: "memory");
                if (pass == 0) {
#pragma unroll 4
                    for (int jj = 0; jj < jn; ++jj) { const unsigned k = DSA_KEY(jj);
                        __hip_atomic_fetch_add(hist + (k >> 24), 1u, __ATOMIC_RELAXED, __HIP_MEMORY_SCOPE_WORKGROUP);
                        __hip_atomic_fetch_add(hist + ((k >> 8) & 0xFFu), 1u, __ATOMIC_RELAXED, __HIP_MEMORY_SCOPE_WORKGROUP);
                        if (DSAREP & 8) { __hip_atomic_fetch_add(hist + (k >> 24), 1u, __ATOMIC_RELAXED, __HIP_MEMORY_SCOPE_WORKGROUP); __hip_atomic_fetch_add(hist + ((k >> 8) & 0xFFu), 1u, __ATOMIC_RELAXED, __HIP_MEMORY_SCOPE_WORKGROUP);
                            __hip_atomic_fetch_add(hist + (k >> 24), 0xFFFFFFFFu, __ATOMIC_RELAXED, __HIP_MEMORY_SCOPE_WORKGROUP); __hip_atomic_fetch_add(hist + ((k >> 8) & 0xFFu), 0xFFFFFFFFu, __ATOMIC_RELAXED, __HIP_MEMORY_SCOPE_WORKGROUP); } }
                } else {
#pragma unroll 4
                    for (int jj = 0; jj < jn; ++jj) { const unsigned k = DSA_KEY(jj);
                        const unsigned dump = 256u + (unsigned)lane_o;
                        __hip_atomic_fetch_add(hist + (((k >> 24) == prefix) ? ((k >> 16) & 0xFFu) : dump), 1u, __ATOMIC_RELAXED, __HIP_MEMORY_SCOPE_WORKGROUP);
                        __hip_atomic_fetch_add(hist + ((((k >> 8) & 0xFFu) == prefix) ? (k & 0xFFu) : dump), 1u, __ATOMIC_RELAXED, __HIP_MEMORY_SCOPE_WORKGROUP); }
                }
                asm volatile("s_waitcnt lgkmcnt(0)" ::: "memory");
                const u32x4 hv = *(const LAS u32x4*)(hist + 4 * lane_o);
                const int sl = (int)(hv.x + hv.y + hv.z + hv.w);
                const int pre = wave_incl_scan_i(sl);
                const int tot = __builtin_amdgcn_readlane(pre, 63);
                const int S = tot - pre + sl;
                const int excl = S - sl;
                const unsigned long long bm = __ballot(excl < kneed && S >= kneed);
                const int L = bm ? (int)__builtin_ctzll(bm) : 0;
                const int ex = __builtin_amdgcn_readlane(excl, L); const int h1 = __builtin_amdgcn_readlane((int)hv.y, L), h2 = __builtin_amdgcn_readlane((int)hv.z, L), h3 = __builtin_amdgcn_readlane((int)hv.w, L);
                int cabove = ex, bin;
                if (cabove + h3 >= kneed) bin = 3; else { cabove += h3;
                    if (cabove + h2 >= kneed) bin = 2; else { cabove += h2;
                        if (cabove + h1 >= kneed) bin = 1; else { cabove += h1; bin = 0; } } }
                prefix = (prefix << 8) | (unsigned)(4 * L + bin); kneed -= cabove;
            }
            const unsigned lo = prefix << 16, hi = (prefix + 1u) << 16;
            const int tot_gt = TOPK - kneed, need = kneed;
            LAS unsigned short* dumpp = (LAS unsigned short*)(hist + 256) + lane_o;
            for (int er_ = 0; er_ < ((DSAREP & 16) ? 2 : 1); ++er_) {
            int base = 0, tbase = 0;
#pragma unroll 2
            for (int jj = 0; jj < jn; ++jj) { const unsigned k = DSA_KEY(jj);
                const int s0 = 2 * (jj * 64 + lane_o); const unsigned kb = k << 16;
                const bool g0 = kb >= hi, g1 = k >= hi;
                const unsigned long long m0 = __ballot(g0), m1 = __ballot(g1);
                const int p0 = base + (int)__builtin_amdgcn_mbcnt_hi((unsigned)(m0 >> 32), __builtin_amdgcn_mbcnt_lo((unsigned)m0, 0u)); base += __popcll(m0);
                const int p1 = base + (int)__builtin_amdgcn_mbcnt_hi((unsigned)(m1 >> 32), __builtin_amdgcn_mbcnt_lo((unsigned)m1, 0u)); base += __popcll(m1);
                *(g0 ? sel + p0 : dumpp) = (unsigned short)s0;
                *(g1 ? sel + p1 : dumpp) = (unsigned short)(s0 + 1);
                const bool e0 = (kb >= lo) && !g0, e1 = (k >= lo) && !g1;
                const unsigned long long t0m = __ballot(e0), t1m = __ballot(e1);
                if (t0m | t1m) {
                    const int r0 = tbase + (int)__builtin_amdgcn_mbcnt_hi((unsigned)(t0m >> 32), __builtin_amdgcn_mbcnt_lo((unsigned)t0m, 0u)); tbase += __popcll(t0m);
                    const int r1 = tbase + (int)__builtin_amdgcn_mbcnt_hi((unsigned)(t1m >> 32), __builtin_amdgcn_mbcnt_lo((unsigned)t1m, 0u)); tbase += __popcll(t1m);
                    if (e0 && r0 < need) sel[tot_gt + r0] = (unsigned short)s0;
                    if (e1 && r1 < need) sel[tot_gt + r1] = (unsigned short)(s0 + 1);
                }
            }
            }
#undef DSA_KEY
        }
#endif
        __builtin_amdgcn_sched_barrier(0); lds_barrier(); __builtin_amdgcn_sched_barrier(0);
#ifndef DSA_NO_D
        LAS unsigned char* kvb = lds + wave * 16384;
        const unsigned char* CKV8 = ws + WS_CKV8;
#pragma unroll 1
        for (int rr = 0; rr < ((DSAREP & 4) ? 4 : 2); ++rr) {
            const int rl = 2 * wave + (rr & 1), t = t0 + rl; const size_t q = qb + t;
            const LAS unsigned short* sel = SELL + rl * 256;
            long qf8[4];
#pragma unroll
            for (int ks = 0; ks < 4; ++ks) { const f16x8 v = *(const f16x8*)(QI + q * NQI + (r16 & 7) * 128 + 32 * ks + 8 * g); const float zs = (r16 >= 8) ? 0.f : 64.f;
                int lo32 = __builtin_amdgcn_cvt_pk_fp8_f32((float)v[0] * zs, (float)v[1] * zs, 0, false); lo32 = __builtin_amdgcn_cvt_pk_fp8_f32((float)v[2] * zs, (float)v[3] * zs, lo32, true);
                int hi32 = __builtin_amdgcn_cvt_pk_fp8_f32((float)v[4] * zs, (float)v[5] * zs, 0, false); hi32 = __builtin_amdgcn_cvt_pk_fp8_f32((float)v[6] * zs, (float)v[7] * zs, hi32, true);
                qf8[ks] = (long)(((unsigned long long)(unsigned)hi32 << 32) | (unsigned)lo32); }
            const LAS float* BLh = BL + (r16 & 7);
            float m_run = -1e30f, l_run = 0.f;
            f32x4 oE[4], oO[4];
#pragma unroll
            for (int cb = 0; cb < 4; ++cb) { oE[cb] = (f32x4){0.f, 0.f, 0.f, 0.f}; oO[cb] = (f32x4){0.f, 0.f, 0.f, 0.f}; }
            const int nch = (t < TOPK) ? (t >> 6) + 1 : 4;
#define DSA_DMA(ch_) do { unsigned so_[8]; _Pragma("unroll") for (int i = 0; i < 8; ++i) { const int R = 8 * i + (lane_o >> 3); \
                const unsigned ix = sel[64 * (ch_) + R]; const unsigned srow = (ix == 0xFFFFu) ? 0u : ix; so_[i] = srow * 128u + 16u * (((unsigned)lane_o & 7u) ^ ((unsigned)R & 7u)); } \
            _Pragma("unroll") for (int i = 0; i < 8; ++i) __builtin_amdgcn_global_load_lds((const unsigned*)(ckvb + so_[i]), (LAS unsigned*)(kvb + i * 1024), 16, 0, 0); } while (0)
            const unsigned char* ckvb = CKV8 + qb * 128;
            asm volatile("s_waitcnt vmcnt(0)" ::: "memory");
            DSA_DMA(0);
            const int qq = (lane_o & 15) >> 2, pp = lane_o & 3;
            unsigned offA[4][4], offT[4][2][2];
#pragma unroll
            for (int mt = 0; mt < 4; ++mt) { const int row = 16 * mt + r16;
#pragma unroll
                for (int ks = 0; ks < 4; ++ks) offA[mt][ks] = row * 128 + 16 * ((2 * ks + (g >> 1)) ^ (row & 7)) + 8 * (g & 1); }
#pragma unroll
            for (int cb = 0; cb < 4; ++cb)
#pragma unroll
                for (int k2 = 0; k2 < 2; ++k2) { const int r1 = 32 * k2 + 4 * g + qq, r2 = r1 + 16;
                    offT[cb][k2][0] = r1 * 128 + 16 * ((2 * cb + (pp >> 1)) ^ (r1 & 7)) + 8 * (pp & 1); offT[cb][k2][1] = r2 * 128 + 16 * ((2 * cb + (pp >> 1)) ^ (r2 & 7)) + 8 * (pp & 1); }
#define DSA_CHUNK(CHK) do { \
                asm volatile("s_waitcnt vmcnt(0)" ::: "memory"); \
                long af[4][4]; u32x2 td[4][2][2]; \
                _Pragma("unroll") for (int mt = 0; mt < 4; ++mt) \
                    _Pragma("unroll") for (int ks = 0; ks < 4; ++ks) af[mt][ks] = *(const LAS long*)(kvb + offA[mt][ks]); \
                _Pragma("unroll") for (int cb = 0; cb < 4; ++cb) \
                    _Pragma("unroll") for (int k2 = 0; k2 < 2; ++k2) { td[cb][k2][0] = __builtin_bit_cast(u32x2, tr_read16(kvb + offT[cb][k2][0])); td[cb][k2][1] = __builtin_bit_cast(u32x2, tr_read16(kvb + offT[cb][k2][1])); } \
                float bvv[4][4]; bool inv4[4][4]; \
                _Pragma("unroll") for (int mt = 0; mt < 4; ++mt) { const u32x2 pk2 = *(const LAS u32x2*)(sel + 64 * ch + 16 * mt + 4 * g); \
                    _Pragma("unroll") for (int e = 0; e < 4; ++e) { const unsigned ix = ((e & 2) ? pk2.y : pk2.x) >> ((e & 1) * 16) & 0xFFFFu; \
                        const int rel = t - (int)ix; const int rc = (CHK) ? min(max(rel, 0), 128) : min(rel, 128); \
                        inv4[mt][e] = (CHK) && (ix == 0xFFFFu); bvv[mt][e] = BLh[rc * 8]; } } \
                asm volatile("s_waitcnt lgkmcnt(0)" : "+v"(bvv[0][0]), "+v"(bvv[0][1]), "+v"(bvv[0][2]), "+v"(bvv[0][3]), "+v"(bvv[1][0]), "+v"(bvv[1][1]), "+v"(bvv[1][2]), "+v"(bvv[1][3]), \
                             "+v"(bvv[2][0]), "+v"(bvv[2][1]), "+v"(bvv[2][2]), "+v"(bvv[2][3]), "+v"(bvv[3][0]), "+v"(bvv[3][1]), "+v"(bvv[3][2]), "+v"(bvv[3][3]) :: "memory"); \
                if (ch + 1 < nch) DSA_DMA(ch + 1); \
                f32x4 lg[4]; \
                _Pragma("unroll") for (int mt = 0; mt < 4; ++mt) { lg[mt] = (f32x4){0.f, 0.f, 0.f, 0.f}; \
                    _Pragma("unroll") for (int ks = 0; ks < 4; ++ks) lg[mt] = __builtin_amdgcn_mfma_f32_16x16x32_fp8_fp8(af[mt][ks], qf8[ks], lg[mt], 0, 0, 0); } \
                float cmax = -INFINITY; \
                _Pragma("unroll") for (int mt = 0; mt < 4; ++mt) \
                    _Pragma("unroll") for (int e = 0; e < 4; ++e) { const float v = inv4[mt][e] ? -INFINITY : lg[mt][e] * 0.02254211001388847f + bvv[mt][e]; lg[mt][e] = v; cmax = fmaxf(cmax, v); } \
                cmax = fmaxf(cmax, __shfl_xor(cmax, 16)); cmax = fmaxf(cmax, __shfl_xor(cmax, 32)); \
                const float m_new = fmaxf(m_run, cmax); const float alpha = __builtin_amdgcn_exp2f(m_run - m_new); m_run = m_new; \
                float ps = 0.f; long pf8[2]; \
                _Pragma("unroll") for (int k2 = 0; k2 < 2; ++k2) { float pv[8]; \
                    _Pragma("unroll") for (int mt = 0; mt < 2; ++mt) \
                        _Pragma("unroll") for (int e = 0; e < 4; ++e) { const float p = __builtin_amdgcn_exp2f(lg[2 * k2 + mt][e] - m_new); ps += p; pv[mt * 4 + e] = p; } \
                    int plo = __builtin_amdgcn_cvt_pk_fp8_f32(pv[0], pv[1], 0, false); plo = __builtin_amdgcn_cvt_pk_fp8_f32(pv[2], pv[3], plo, true); \
                    int phi = __builtin_amdgcn_cvt_pk_fp8_f32(pv[4], pv[5], 0, false); phi = __builtin_amdgcn_cvt_pk_fp8_f32(pv[6], pv[7], phi, true); \
                    pf8[k2] = (long)(((unsigned long long)(unsigned)phi << 32) | (unsigned)plo); } \
                l_run = l_run * alpha + ps; \
                if (__ballot(alpha != 1.f) != 0ull) { _Pragma("unroll") for (int cb = 0; cb < 4; ++cb) { oE[cb] *= alpha; oO[cb] *= alpha; } } \
                _Pragma("unroll") for (int cb = 0; cb < 4; ++cb) \
                    _Pragma("unroll") for (int k2 = 0; k2 < 2; ++k2) { \
                        const u32x2 d1 = td[cb][k2][0], d2 = td[cb][k2][1]; \
                        const unsigned xe0 = __builtin_amdgcn_perm(d1.y, d1.x, 0x06040200u), xo0 = __builtin_amdgcn_perm(d1.y, d1.x, 0x07050301u); \
                        const unsigned xe1 = __builtin_amdgcn_perm(d2.y, d2.x, 0x06040200u), xo1 = __builtin_amdgcn_perm(d2.y, d2.x, 0x07050301u); \
                        oE[cb] = __builtin_amdgcn_mfma_f32_16x16x32_fp8_fp8((long)(((unsigned long long)xe1 << 32) | xe0), pf8[k2], oE[cb], 0, 0, 0); \
                        oO[cb] = __builtin_amdgcn_mfma_f32_16x16x32_fp8_fp8((long)(((unsigned long long)xo1 << 32) | xo0), pf8[k2], oO[cb], 0, 0, 0); } } while (0)
            if (t < TOPK) {
#pragma unroll 1
                for (int ch = 0; ch < nch; ++ch) DSA_CHUNK(1);
            } else {
#pragma unroll 1
                for (int ch = 0; ch < nch; ++ch) DSA_CHUNK(0);
            }
#undef DSA_CHUNK
#undef DSA_DMA
            l_run += __shfl_xor(l_run, 16); l_run += __shfl_xor(l_run, 32);
            const float inv = 1.f / l_run;
            if (r16 < 8) {
#pragma unroll
                for (int cb = 0; cb < 4; ++cb) { u32x4 w; w.x = pkh(oE[cb][0] * inv, oO[cb][0] * inv); w.y = pkh(oE[cb][1] * inv, oO[cb][1] * inv); w.z = pkh(oE[cb][2] * inv, oO[cb][2] * inv); w.w = pkh(oE[cb][3] * inv, oO[cb][3] * inv);
                    *(u32x4*)(OATT + q * KOUT + r16 * 128 + 32 * cb + 8 * g) = w; }
            }
        }
#endif
    }
}

template <int CTRL> __device__ __forceinline__ float dpp_f(float x) { return __builtin_bit_cast(float, __builtin_amdgcn_update_dpp(0, __builtin_bit_cast(int, x), CTRL, 0xF, 0xF, false)); }
__device__ __forceinline__ float row16_sum(float x) { x += dpp_f<0x128>(x); x += dpp_f<0x124>(x); x += dpp_f<0x122>(x); x += dpp_f<0x121>(x); return x; }
constexpr int SCAN_TB = 32;
__device__ __forceinline__ void p7_scan(const Args& a, LAS unsigned char* lds, int vcu, int G, int wave, int lane) {
    unsigned char* ws = a.ws;
    const f16* PROJ = (const f16*)(ws + WS_PROJ); const f16* RWW = (const f16*)(ws + WS_RWW); const f16* RWA = (const f16*)(ws + WS_RWA);
    float* YRAW = (float*)(ws + WS_YRAW);
    for (int u = vcu; u < BATCH * HRW * 2; u += G) {
        const int half = u & 1, h = (u >> 1) & 7, b = u >> 4;
        const int ch = h * 64 + lane;
        const float mu_r = a.in[17][ch], mu_k = a.in[17][512 + ch], mu_v = a.in[17][1024 + ch], kkc = a.in[23][ch], kac = a.in[24][ch];
        const int rr = lane >> 4, qd = lane & 15, irow = half * 32 + wave * 4 + rr;
        float S0 = 0.f, S1 = 0.f, S2 = 0.f, S3 = 0.f;
#define SCAN_LOAD(blk_) do { _Pragma("unroll") for (int tt = 0; tt < 4; ++tt) { const int t = (blk_) * SCAN_TB + wave * 4 + tt; const size_t m = (size_t)(b << 12) + t; \
            const f16* pr = PROJ + m * IN_PAD + h * 64 + lane; \
            st_r[tt] = (float)pr[C_R]; st_k[tt] = (float)pr[C_K]; st_v[tt] = (float)pr[C_V]; \
            if (t > 0) { st_rp[tt] = (float)pr[C_R - IN_PAD]; st_kp[tt] = (float)pr[C_K - IN_PAD]; st_vp[tt] = (float)pr[C_V - IN_PAD]; } else { st_rp[tt] = 0.f; st_kp[tt] = 0.f; st_vp[tt] = 0.f; } \
            st_lw[tt] = (float)RWW[m * RW + ch]; st_av[tt] = (float)RWA[m * RW + ch]; } } while (0)
#define SCAN_WRITE(buf_) do { LAS float* base_ = (LAS float*)(lds + (buf_) * 49152); _Pragma("unroll") for (int tt = 0; tt < 4; ++tt) { const int tl = wave * 4 + tt; \
            const float rs = st_r[tt] + mu_r * (st_rp[tt] - st_r[tt]), ks = st_k[tt] + mu_k * (st_kp[tt] - st_k[tt]), vs = st_v[tt] + mu_v * (st_vp[tt] - st_v[tt]); \
            const float kkv = ks * kkc; const float nrm = sqrtf(wave_sum(kkv * kkv)); const float kkn = kkv / fmaxf(nrm, 1e-12f); \
            const float av = st_av[tt]; const float km = ks * (1.f + (av - 1.f) * kac); \
            base_[0 * 2048 + tl * 64 + lane] = rs; base_[1 * 2048 + tl * 64 + lane] = __expf(st_lw[tt]); base_[2 * 2048 + tl * 64 + lane] = km; \
            base_[3 * 2048 + tl * 64 + lane] = vs; base_[4 * 2048 + tl * 64 + lane] = -kkn; base_[5 * 2048 + tl * 64 + lane] = kkn * av; } } while (0)
        float st_r[4], st_k[4], st_v[4], st_rp[4], st_kp[4], st_vp[4], st_lw[4], st_av[4];
        __syncthreads();
        SCAN_LOAD(0); SCAN_WRITE(0);
        constexpr int NBLK = SEQ / SCAN_TB;
        for (int blk = 0; blk < NBLK; ++blk) {
            __syncthreads();
            if (blk + 1 < NBLK) SCAN_LOAD(blk + 1);
            const LAS float* base = (const LAS float*)(lds + (blk & 1) * 49152);
            for (int tl = 0; tl < SCAN_TB; ++tl) {
                const f32x4 r4 = *(const LAS f32x4*)(base + 0 * 2048 + tl * 64 + 4 * qd), w4 = *(const LAS f32x4*)(base + 1 * 2048 + tl * 64 + 4 * qd), k4 = *(const LAS f32x4*)(base + 2 * 2048 + tl * 64 + 4 * qd);
                const f32x4 a4 = *(const LAS f32x4*)(base + 4 * 2048 + tl * 64 + 4 * qd), b4 = *(const LAS f32x4*)(base + 5 * 2048 + tl * 64 + 4 * qd);
                const float vi = base[3 * 2048 + tl * 64 + irow];
                float sa = S0 * a4[0] + S1 * a4[1] + S2 * a4[2] + S3 * a4[3];
                sa = row16_sum(sa);
                S0 = S0 * w4[0] + sa * b4[0] + vi * k4[0]; S1 = S1 * w4[1] + sa * b4[1] + vi * k4[1]; S2 = S2 * w4[2] + sa * b4[2] + vi * k4[2]; S3 = S3 * w4[3] + sa * b4[3] + vi * k4[3];
                float y = S0 * r4[0] + S1 * r4[1] + S2 * r4[2] + S3 * r4[3];
                y = row16_sum(y);
                if (qd == 0) YRAW[((size_t)(b << 12) + blk * SCAN_TB + tl) * RW + h * 64 + irow] = y;
            }
            if (blk + 1 < NBLK) SCAN_WRITE((blk + 1) & 1);
        }
        __syncthreads();
    }
}

__device__ __forceinline__ void p8_rwkv_post(const Args& a, int vcu, int G, int wave, int lane) {
    unsigned char* ws = a.ws;
    const f16* PROJ = (const f16*)(ws + WS_PROJ); const f16* RWA = (const f16*)(ws + WS_RWA); const f16* RWG = (const f16*)(ws + WS_RWG);
    const float* YRAW = (const float*)(ws + WS_YRAW); f16* OATT = (f16*)(ws + WS_OATT);
    const int gw = vcu * NWAVES + wave, NGW = G * NWAVES;
    for (int it = gw; it < MTOK * HRW; it += NGW) {
        const int m = it >> 3, h = it & 7, ch = h * 64 + lane, t = m & (SEQ - 1);
        const f16* pr = PROJ + (size_t)m * IN_PAD + ch;
        float r = (float)pr[C_R], k = (float)pr[C_K], v = (float)pr[C_V], rp = 0.f, kp = 0.f, vp = 0.f;
        if (t > 0) { rp = (float)pr[C_R - IN_PAD]; kp = (float)pr[C_K - IN_PAD]; vp = (float)pr[C_V - IN_PAD]; }
        const float rs = r + a.in[17][ch] * (rp - r), ks = k + a.in[17][512 + ch] * (kp - k), vs = v + a.in[17][1024 + ch] * (vp - v);
        const float av = (float)RWA[(size_t)m * RW + ch];
        const float km = ks * (1.f + (av - 1.f) * a.in[24][ch]);
        const float y = YRAW[(size_t)m * RW + ch];
        const float mean = wave_sum(y) * (1.f / 64.f); const float dy = y - mean;
        const float var = wave_sum(dy * dy) * (1.f / 64.f);
        const float yn = dy * rsqrtf(var + GN_EPS) * a.in[26][ch] + a.in[27][ch];
        const float bonus = wave_sum(rs * km * a.in[25][ch]) * vs;
        OATT[(size_t)m * KOUT + 1024 + ch] = (f16)((yn + bonus) * (float)RWG[(size_t)m * RW + ch]);
    }
}

typedef short bf16x8 __attribute__((ext_vector_type(8)));
typedef _Float16 f16x4v __attribute__((ext_vector_type(4)));
__device__ __forceinline__ unsigned f2bf(float f) { unsigned u = __builtin_bit_cast(unsigned, f); return (u + 0x7fffu + ((u >> 16) & 1u)) >> 16; }
__device__ __forceinline__ unsigned pkb(float lo, float hi) { unsigned r; asm("v_cvt_pk_bf16_f32 %0, %1, %2" : "=v"(r) : "v"(lo), "v"(hi)); return r; }
constexpr int XP = 144;
constexpr int XD_OFF = 0, XA_OFF = 9216, XG_OFF = 18432, XG_P = 336;
constexpr int LAB_OFF = 126720, LAK_OFF = LAB_OFF + 9216, LRB_OFF = LAK_OFF + 9216, LRK_OFF = LRB_OFF + 9216;
static_assert(LRK_OFF + 9216 <= MISC_OFF, "X-phase LDS map");
constexpr int AB_OFF = 39936, RB_OFF = AB_OFF + 9216, BB_OFF = RB_OFF + 9216, KB_OFF = BB_OFF + 9216;
constexpr int TT_OFF = 39936, M1T_OFF = TT_OFF + 9216, A2T_OFF = M1T_OFF + 9216, U1T_OFF = A2T_OFF + 9216;
constexpr int AH_OFF = 76800, VH_OFF = AH_OFF + 9216, BP_OFF = VH_OFF + 9216, KP_OFF = BP_OFF + 9216, RH_OFF = KP_OFF + 9216;
constexpr int NRM_OFF = 122880, CUMB_OFF = NRM_OFF + 512, XCONST_OFF = CUMB_OFF + 1024;
constexpr size_t WS_WDT = 28 * MiB, WS_WAT = WS_WDT + 65536, WS_WGT = WS_WAT + 65536;
constexpr size_t WS_RWP = 32 * MiB, WS_RWQ = 64 * MiB, WS_RWR2 = 408 * MiB, WS_RWY1 = 440 * MiB, WS_RWS0 = 472 * MiB, WS_BON = 364 * MiB;
constexpr int NUNIT = BATCH * 64 * HRW;

__device__ __forceinline__ f16x8 rd_row(LAS unsigned char* base, int pitch, int row, int col) { return *(const LAS f16x8*)(base + row * pitch + col * 2); }
__device__ __forceinline__ bf16x8 rd_rowb(LAS unsigned char* base, int pitch, int row, int col) { return *(const LAS bf16x8*)(base + row * pitch + col * 2); }
__device__ __forceinline__ f16x8 rd_tr(LAS unsigned char* base, int k0, int c0, int g, int qq, int pp) {
    const f16x4 v0 = tr_read16(base + (k0 + 8 * g + qq) * XP + (c0 + 4 * pp) * 2), v1 = tr_read16(base + (k0 + 8 * g + 4 + qq) * XP + (c0 + 4 * pp) * 2);
    return (f16x8){v0[0], v0[1], v0[2], v0[3], v1[0], v1[1], v1[2], v1[3]};
}
__device__ __forceinline__ void wr4h(LAS unsigned char* p, const f32x4& v) { u32x2 w; w.x = pkh(v[0], v[1]); w.y = pkh(v[2], v[3]); *(LAS u32x2*)p = w; }
__device__ __forceinline__ float dpp_shr_f(float x, int) { return x; }
template <int CTRL> __device__ __forceinline__ float dpp_z(float x) { return __builtin_bit_cast(float, __builtin_amdgcn_update_dpp(0, __builtin_bit_cast(int, x), CTRL, 0xF, 0xF, true)); }
__device__ __forceinline__ float row16_incl_scan(float x) { x += dpp_z<0x111>(x); x += dpp_z<0x112>(x); x += dpp_z<0x114>(x); x += dpp_z<0x118>(x); return x; }
#define MFMA_H(a, b, c) __builtin_amdgcn_mfma_f32_16x16x32_f16((a), (b), (c), 0, 0, 0)
#define MFMA_B(a, b, c) __builtin_amdgcn_mfma_f32_16x16x32_bf16((a), (b), (c), 0, 0, 0)
#define MFMA_H16(a, b, c) __builtin_amdgcn_mfma_f32_16x16x16f16((a), (b), (c), 0, 0, 0)
__device__ __forceinline__ f16x4 cvt4h(const f32x4& v) { return (f16x4){(f16)v[0], (f16)v[1], (f16)v[2], (f16)v[3]}; }
__device__ __forceinline__ f32x4 cvt4f(const f16x4& v) { return (f32x4){(float)v[0], (float)v[1], (float)v[2], (float)v[3]}; }

__device__ __forceinline__ void p7x_chunks(const Args& a, LAS unsigned char* lds, int vcu, int G, int tid, int wave, int lane) {
    unsigned char* ws = a.ws;
    const f16* PROJ = (const f16*)(ws + WS_PROJ);
    const f16* WDT = (const f16*)(ws + WS_WDT); const f16* WAT = (const f16*)(ws + WS_WAT); const f16* WGT = (const f16*)(ws + WS_WGT);
    f16* RWG = (f16*)(ws + WS_RWG); f16* RWP = (f16*)(ws + WS_RWP); f16* RWQ = (f16*)(ws + WS_RWQ); f16* RWR2 = (f16*)(ws + WS_RWR2); f16* RWY1 = (f16*)(ws + WS_RWY1);
    float* BON = (float*)(ws + WS_BON);
    const float* mu = a.in[17];
    const f32x4 z4 = {0.f, 0.f, 0.f, 0.f};
    const bool bal = (G == 256); const int bxx = blockIdx.x;
    const int nit = bal ? 16 : (NUNIT + G - 1) / G;
#define X_UNIT(itx_) (bal ? ((((bxx & 7) * 64 + ((bxx >> 3) + 32 * ((itx_) >> 3))) * 8 + ((itx_) & 7))) : (vcu + (itx_) * G))
    f16x4 rv0[9], rv1c, rv1p, prc[2], pkc[2], pvc[2], prp[2], pkp[2], pvp[2];
    f16x8 wfd[2][2], wfa[2][2], wfg[2][5];
    int h_tab = -1;
#define X_PREFETCH(u_, rows_) do { int lp = lane; asm volatile("" : "+v"(lp)); const int h_ = (u_) & 7, c_ = ((u_) >> 3) & 63, b_ = (u_) >> 9; const size_t m0_ = (size_t)(b_ << 12) + c_ * 64; \
        if (rows_) { _Pragma("unroll") for (int i = 0; i < 9; ++i) { const int t_ = 8 * wave + i - 1; const bool ok_ = (t_ >= 0 || c_ > 0); const f16* rowp = PROJ + (m0_ + t_) * IN_PAD + C_WD; \
            rv0[i] = (f16x4){0, 0, 0, 0}; if (ok_) rv0[i] = *(const f16x4*)(rowp + 4 * lp); } \
        { const int t1_ = 8 * wave + (lp >> 3); const f16* rp1 = PROJ + (m0_ + t1_) * IN_PAD + C_WD + 256 + 4 * (lp & 7); rv1c = *(const f16x4*)rp1; rv1p = (f16x4){0, 0, 0, 0}; if (t1_ > 0 || c_ > 0) rv1p = *(const f16x4*)(rp1 - IN_PAD); } } \
        _Pragma("unroll") for (int ci = 0; ci < 2; ++ci) { const int chr_ = h_ * 64 + 16 * (2 * (wave >> 2) + ci) + (lp & 15); \
            _Pragma("unroll") for (int ks = 0; ks < 2; ++ks) { wfd[ci][ks] = *(const f16x8*)(WDT + (size_t)chr_ * 64 + 32 * ks + 8 * (lp >> 4)); wfa[ci][ks] = *(const f16x8*)(WAT + (size_t)chr_ * 64 + 32 * ks + 8 * (lp >> 4)); } \
            _Pragma("unroll") for (int ks = 0; ks < 5; ++ks) wfg[ci][ks] = *(const f16x8*)(WGT + (size_t)chr_ * 192 + 32 * ks + 8 * (lp >> 4)); } \
        const int t2_ = 16 * (wave & 3) + (lp & 15); const size_t m_ = m0_ + t2_; \
        _Pragma("unroll") for (int ci = 0; ci < 2; ++ci) { const int ch_ = h_ * 64 + 16 * (2 * (wave >> 2) + ci) + 4 * (lp >> 4); \
            prc[ci] = *(const f16x4*)(PROJ + m_ * IN_PAD + C_R + ch_); pkc[ci] = *(const f16x4*)(PROJ + m_ * IN_PAD + C_K + ch_); pvc[ci] = *(const f16x4*)(PROJ + m_ * IN_PAD + C_V + ch_); \
            prp[ci] = (f16x4){0, 0, 0, 0}; pkp[ci] = (f16x4){0, 0, 0, 0}; pvp[ci] = (f16x4){0, 0, 0, 0}; \
            if ((c_ * 64 + t2_) != 0) { prp[ci] = *(const f16x4*)(PROJ + (m_ - 1) * IN_PAD + C_R + ch_); pkp[ci] = *(const f16x4*)(PROJ + (m_ - 1) * IN_PAD + C_K + ch_); pvp[ci] = *(const f16x4*)(PROJ + (m_ - 1) * IN_PAD + C_V + ch_); } } } while (0)
    { const int u0 = X_UNIT(0); if (u0 < NUNIT) X_PREFETCH(u0, true); }
    int chunk_id = -1;
#pragma unroll 1
    for (int itx = 0; itx < nit; ++itx) {
        const int u = X_UNIT(itx); if (u >= NUNIT) break;
        const int un = (itx + 1 < nit) ? X_UNIT(itx + 1) : NUNIT;
        int lane_o = lane; asm volatile("" : "+v"(lane_o));
        const int r16 = lane_o & 15, g = lane_o >> 4, qq = r16 >> 2, pp = lane_o & 3;
        const int h = u & 7, c = (u >> 3) & 63, b = u >> 9;
        const size_t m0 = (size_t)(b << 12) + c * 64;
        const bool newchunk = (u >> 3) != chunk_id; chunk_id = u >> 3;
        lds_barrier();
        if (h != h_tab) { h_tab = h;
            if (tid < 64) { const int ch = h * 64 + tid; LAS float* ct = (LAS float*)(lds + XCONST_OFF) + tid;
                ct[0] = mu[ch]; ct[64] = mu[512 + ch]; ct[128] = mu[1024 + ch]; ct[192] = a.in[18][ch]; ct[256] = a.in[20][ch]; ct[320] = a.in[23][ch]; ct[384] = a.in[24][ch]; ct[448] = a.in[25][ch]; } }
        if (newchunk) {
            const f32x4 mu0 = *(const f32x4*)(mu + 1536 + 4 * lane_o); const f32x4 mu1 = *(const f32x4*)(mu + 1536 + 256 + 4 * (lane_o & 7));
            const float kf = lane_o < 16 ? 2.f : 1.f; const bool is_t = lane_o < 16, is_id = (lane_o >= 16 && lane_o < 32);
            LAS unsigned char* d0 = is_t ? lds + XD_OFF + 8 * lane_o : is_id ? lds + XA_OFF + 8 * (lane_o - 16) : lds + XG_OFF + 8 * (lane_o - 32);
            const int p0 = (lane_o < 32) ? XP : XG_P;
#pragma unroll
            for (int i = 0; i < 8; ++i) { const int t = 8 * wave + i; float o[4];
#pragma unroll
                for (int e = 0; e < 4; ++e) { const float cu = (float)rv0[i + 1][e], pv = (float)rv0[i][e]; const float x = cu + mu0[e] * (pv - cu);
                    const float sg = __builtin_amdgcn_rcpf(1.f + __expf(-kf * x)); o[e] = is_t ? 2.f * sg - 1.f : is_id ? x : sg; }
                u32x2 w; w.x = pkh(o[0], o[1]); w.y = pkh(o[2], o[3]); *(LAS u32x2*)(d0 + t * p0) = w; }
            {
                float o1[4];
#pragma unroll
                for (int e = 0; e < 4; ++e) { const float cu1 = (float)rv1c[e], pv1 = (float)rv1p[e]; const float x1 = cu1 + mu1[e] * (pv1 - cu1); o1[e] = __builtin_amdgcn_rcpf(1.f + __expf(-x1)); }
                u32x2 w1; w1.x = pkh(o1[0], o1[1]); w1.y = pkh(o1[2], o1[3]); *(LAS u32x2*)(lds + XG_OFF + (8 * wave + (lane_o >> 3)) * XG_P + (128 + 4 * (lane_o & 7)) * 2) = w1; }
        }
        lds_barrier();
        const int tb = wave & 3, cth = wave >> 2;
        const int t = 16 * tb + r16; const size_t m = m0 + t;
        f32x4 dA[2], aA[2], gA[2];
#pragma unroll
        for (int ci = 0; ci < 2; ++ci) {
            dA[ci] = z4; aA[ci] = z4; gA[ci] = z4;
#pragma unroll
            for (int ks = 0; ks < 2; ++ks) {
                dA[ci] = MFMA_H(wfd[ci][ks], rd_row(lds + XD_OFF, XP, t, 32 * ks + 8 * g), dA[ci]);
                aA[ci] = MFMA_H(wfa[ci][ks], rd_row(lds + XA_OFF, XP, t, 32 * ks + 8 * g), aA[ci]); }
#pragma unroll
            for (int ks = 0; ks < 5; ++ks) gA[ci] = MFMA_H(wfg[ci][ks], rd_row(lds + XG_OFF, XG_P, t, 32 * ks + 8 * g), gA[ci]);
        }
        float lwv[2][4], asg[2][4], rs[2][4], kp[2][4], vs[2][4], kkv[2][4], cl[2][4];
        float pn = 0.f, prk = 0.f;
#pragma unroll
        for (int ci = 0; ci < 2; ++ci) {
            const int chl = 16 * (2 * cth + ci) + 4 * g, ch = h * 64 + chl;
            const f16x4 rc = prc[ci], kc = pkc[ci], vc = pvc[ci], rp = prp[ci], kq = pkp[ci], vp = pvp[ci];
            const LAS float* ct = (const LAS float*)(lds + XCONST_OFF) + chl;
            const f32x4 mur = *(const LAS f32x4*)(ct), muk = *(const LAS f32x4*)(ct + 64), muv = *(const LAS f32x4*)(ct + 128);
            const f32x4 w0 = *(const LAS f32x4*)(ct + 192), a0 = *(const LAS f32x4*)(ct + 256), kkc = *(const LAS f32x4*)(ct + 320), kac = *(const LAS f32x4*)(ct + 384), rkc = *(const LAS f32x4*)(ct + 448);
            float gl[4];
#pragma unroll
            for (int e = 0; e < 4; ++e) {
                const float z = -(w0[e] + dA[ci][e]); const float sp = fmaxf(z, 0.f) + __logf(1.f + __expf(-fabsf(z)));
                lwv[ci][e] = -__expf(-sp - 0.5f);
                asg[ci][e] = sigmoidf_(a0[e] + aA[ci][e]); gl[e] = gA[ci][e];
                rs[ci][e] = (float)rc[e] + mur[e] * ((float)rp[e] - (float)rc[e]);
                const float ks_ = (float)kc[e] + muk[e] * ((float)kq[e] - (float)kc[e]);
                vs[ci][e] = (float)vc[e] + muv[e] * ((float)vp[e] - (float)vc[e]);
                kkv[ci][e] = ks_ * kkc[e]; pn += kkv[ci][e] * kkv[ci][e];
                kp[ci][e] = ks_ * (1.f + (asg[ci][e] - 1.f) * kac[e]);
                prk += rs[ci][e] * kp[ci][e] * rkc[e];
                cl[ci][e] = row16_incl_scan(lwv[ci][e]);
                if (r16 == 15) ((LAS float*)(lds + CUMB_OFF))[tb * 64 + chl + e] = cl[ci][e];
            }
            u32x2 gw; gw.x = pkh(gl[0], gl[1]); gw.y = pkh(gl[2], gl[3]); *(u32x2*)(RWG + m * RW + ch) = gw;
        }
        pn += __shfl_xor(pn, 16); pn += __shfl_xor(pn, 32); prk += __shfl_xor(prk, 16); prk += __shfl_xor(prk, 32);
        if (g == 0) { ((LAS float*)(lds + NRM_OFF))[t * 2 + cth] = pn; BON[((size_t)u * 64 + t) * 2 + cth] = prk; }
        lds_barrier();
        {
            const float nrm = sqrtf(((LAS float*)(lds + NRM_OFF))[t * 2] + ((LAS float*)(lds + NRM_OFF))[t * 2 + 1]); const float inrm = __builtin_amdgcn_rcpf(fmaxf(nrm, 1e-12f));
#pragma unroll
            for (int ci = 0; ci < 2; ++ci) {
                const int chl = 16 * (2 * cth + ci) + 4 * g;
                float Ab[4], Rb[4], Bb[4], Kb[4], Bp[4], Kp[4];
                const LAS float* cbp = (const LAS float*)(lds + CUMB_OFF) + chl;
                const f32x4 cb0 = *(const LAS f32x4*)(cbp), cb1 = *(const LAS f32x4*)(cbp + 64), cb2 = *(const LAS f32x4*)(cbp + 128), cb3 = *(const LAS f32x4*)(cbp + 192);
#pragma unroll
                for (int e = 0; e < 4; ++e) {
                    const float b0 = cb0[e], b1 = cb1[e], b2 = cb2[e], b3 = cb3[e];
                    const float pre = (tb > 0 ? b0 : 0.f) + (tb > 1 ? b1 : 0.f) + (tb > 2 ? b2 : 0.f);
                    const float cum = cl[ci][e] + pre, cumC = (b0 + b1) + (b2 + b3);
                    const float kkn = kkv[ci][e] * inrm, av = -kkn, bv = kkn * asg[ci][e];
                    const float eg = __expf(cum), egi = __expf(-cum), egc = __expf(cumC - cum);
                    Ab[e] = av * __expf(cum - lwv[ci][e]); Rb[e] = rs[ci][e] * eg; Bb[e] = bv * egi; Kb[e] = kp[ci][e] * egi; Bp[e] = bv * egc; Kp[e] = kp[ci][e] * egc;
                }
                const int ro = t * XP + chl * 2;
                u32x2 w;
                w.x = pkb(Ab[0], Ab[1]); w.y = pkb(Ab[2], Ab[3]); *(LAS u32x2*)(lds + AB_OFF + ro) = w;
                w.x = pkb(Rb[0], Rb[1]); w.y = pkb(Rb[2], Rb[3]); *(LAS u32x2*)(lds + RB_OFF + ro) = w;
                w.x = pkb(Bb[0], Bb[1]); w.y = pkb(Bb[2], Bb[3]); *(LAS u32x2*)(lds + BB_OFF + ro) = w;
                w.x = pkb(Kb[0], Kb[1]); w.y = pkb(Kb[2], Kb[3]); *(LAS u32x2*)(lds + KB_OFF + ro) = w;
                w.x = pkh(Ab[0], Ab[1]); w.y = pkh(Ab[2], Ab[3]); *(LAS u32x2*)(lds + AH_OFF + ro) = w;
                w.x = pkh(Rb[0], Rb[1]); w.y = pkh(Rb[2], Rb[3]); *(LAS u32x2*)(lds + RH_OFF + ro) = w;
                w.x = pkh(vs[ci][0], vs[ci][1]); w.y = pkh(vs[ci][2], vs[ci][3]); *(LAS u32x2*)(lds + VH_OFF + ro) = w;
                w.x = pkh(Bp[0], Bp[1]); w.y = pkh(Bp[2], Bp[3]); *(LAS u32x2*)(lds + BP_OFF + ro) = w;
                w.x = pkh(Kp[0], Kp[1]); w.y = pkh(Kp[2], Kp[3]); *(LAS u32x2*)(lds + KP_OFF + ro) = w;
            }
        }
        lds_barrier();
#pragma unroll 1
        for (int k = 0; k < 5; ++k) {
            const int idx = wave + 8 * k, prod = idx / 10, rem = idx - prod * 10;
            const int tb1 = rem >= 6 ? 3 : rem >= 3 ? 2 : rem >= 1 ? 1 : 0, ub = rem - (tb1 * (tb1 + 1)) / 2;
            LAS unsigned char* X = lds + ((prod < 2) ? AB_OFF : RB_OFF); LAS unsigned char* Y = lds + ((prod & 1) ? KB_OFF : BB_OFF);
            f32x4 acc = z4;
#pragma unroll
            for (int ks = 0; ks < 2; ++ks) acc = MFMA_B(rd_rowb(Y, XP, 16 * ub + r16, 32 * ks + 8 * g), rd_rowb(X, XP, 16 * tb1 + r16, 32 * ks + 8 * g), acc);
            const int tt = 16 * tb1 + r16, tau0 = 16 * ub + 4 * g; const int lim = (prod < 2) ? tt : tt + 1;
#pragma unroll
            for (int e = 0; e < 4; ++e) if (tau0 + e >= lim) acc[e] = 0.f;
            wr4h(lds + LAB_OFF + prod * 9216 + tt * XP + tau0 * 2, acc);
        }
#pragma unroll 1
        for (int k = 0; k < 3; ++k) {
            const int idx = wave + 8 * k, prod = idx / 6, rem = idx - prod * 6;
            const int tb1 = rem >= 5 ? 2 : rem >= 3 ? 1 : 0, ub = (rem >= 5) ? 3 : (rem >= 3) ? rem - 1 : rem + 1;
            wr4h(lds + LAB_OFF + prod * 9216 + (16 * tb1 + r16) * XP + (16 * ub + 4 * g) * 2, z4);
        }
        lds_barrier();
        if (wave == 0) {
            LAS unsigned char* L = lds + LAB_OFF; LAS unsigned char* TT = lds + TT_OFF;
            f32x4 TB[4][4]; f16x4 TAh[4];
            float idn[4];
#pragma unroll
            for (int e = 0; e < 4; ++e) idn[e] = (r16 == 4 * g + e) ? 1.f : 0.f;
#pragma unroll
            for (int i = 0; i < 4; ++i) {
                f16x4 XA = *(const LAS f16x4*)(L + (16 * i + r16) * XP + (16 * i + 4 * g) * 2);
                f16x4 XB = tr_read16(L + (16 * i + 4 * g + qq) * XP + (16 * i + 4 * pp) * 2);
                f32x4 TAf, TBf;
#pragma unroll
                for (int e = 0; e < 4; ++e) { TAf[e] = idn[e] + (float)XA[e]; TBf[e] = idn[e] + (float)XB[e]; }
#pragma unroll
                for (int lv = 0; lv < 3; ++lv) {
                    const f32x4 X2B = MFMA_H16(XA, XB, z4), X2A = MFMA_H16(XB, XA, z4);
                    XA = cvt4h(X2A); XB = cvt4h(X2B);
                    const f16x4 ta = cvt4h(TAf);
                    TBf = MFMA_H16(ta, XB, TBf); TAf = MFMA_H16(XB, ta, TAf);
                }
                TB[i][i] = TBf; TAh[i] = cvt4h(TAf);
            }
#pragma unroll
            for (int d = 1; d < 4; ++d)
#pragma unroll
                for (int j = 0; j + d < 4; ++j) { const int i = j + d;
                    f32x4 M = z4;
#pragma unroll
                    for (int kq2 = j; kq2 < i; ++kq2) M = MFMA_H16(*(const LAS f16x4*)(L + (16 * i + r16) * XP + (16 * kq2 + 4 * g) * 2), cvt4h(TB[kq2][j]), M);
                    TB[i][j] = MFMA_H16(TAh[i], cvt4h(M), z4);
                }
#pragma unroll
            for (int i = 0; i < 4; ++i)
#pragma unroll
                for (int j = 0; j < 4; ++j) wr4h(TT + (16 * j + r16) * XP + (16 * i + 4 * g) * 2, (j <= i) ? TB[i][j] : z4);
        } else {
#pragma unroll 1
            for (int idx = wave - 1; idx < 16; idx += 7) { const int tb1 = idx >> 2, ib = idx & 3;
                f32x4 acc = z4;
#pragma unroll
                for (int ks = 0; ks < 2; ++ks) acc = MFMA_H(rd_row(lds + LAK_OFF, XP, 16 * tb1 + r16, 32 * ks + 8 * g), rd_tr(lds + VH_OFF, 32 * ks, 16 * ib, g, qq, pp), acc);
                wr4h(lds + M1T_OFF + (16 * ib + r16) * XP + (16 * tb1 + 4 * g) * 2, acc);
            }
        }
        lds_barrier();
#pragma unroll
        for (int k = 0; k < 4; ++k) {
            const int which = k >> 1, tb1 = 2 * (k & 1) + (wave >> 2), nb = wave & 3;
            f32x4 acc = z4;
#pragma unroll
            for (int ks = 0; ks < 2; ++ks) {
                const f16x8 af = rd_tr(lds + TT_OFF, 32 * ks, 16 * tb1, g, qq, pp);
                const f16x8 bf = which ? rd_row(lds + M1T_OFF, XP, 16 * nb + r16, 32 * ks + 8 * g) : rd_tr(lds + AH_OFF, 32 * ks, 16 * nb, g, qq, pp);
                acc = MFMA_H(af, bf, acc);
            }
            wr4h(lds + (which ? U1T_OFF : A2T_OFF) + (16 * nb + r16) * XP + (16 * tb1 + 4 * g) * 2, acc);
        }
        lds_barrier();
        if (un < NUNIT) X_PREFETCH(un, (un >> 3) != chunk_id);
#pragma unroll
        for (int k = 0; k < 8; ++k) {
            const int kind = k >> 1, a4 = 2 * (k & 1) + (wave >> 2), b4 = wave & 3;
            f32x4 acc = z4;
            if (kind == 0) {
#pragma unroll
                for (int ks = 0; ks < 2; ++ks) acc = MFMA_H(rd_row(lds + A2T_OFF, XP, 16 * a4 + r16, 32 * ks + 8 * g), rd_tr(lds + BP_OFF, 32 * ks, 16 * b4, g, qq, pp), acc);
                if (a4 == b4) { const LAS float* cb = (const LAS float*)(lds + CUMB_OFF) + 16 * b4 + r16; const float gC = __expf((cb[0] + cb[64]) + (cb[128] + cb[192]));
#pragma unroll
                    for (int e = 0; e < 4; ++e) if (4 * g + e == r16) acc[e] += gC; }
                u32x2 w; w.x = pkh(acc[0], acc[1]); w.y = pkh(acc[2], acc[3]);
                *(u32x2*)(RWP + (size_t)u * 4096 + ((b4 * 2 + (a4 >> 1)) * 64 + lane_o) * 8 + (a4 & 1) * 4) = w;
            } else if (kind == 1) {
#pragma unroll
                for (int ks = 0; ks < 2; ++ks) { acc = MFMA_H(rd_tr(lds + BP_OFF, 32 * ks, 16 * a4, g, qq, pp), rd_row(lds + U1T_OFF, XP, 16 * b4 + r16, 32 * ks + 8 * g), acc);
                    acc = MFMA_H(rd_tr(lds + KP_OFF, 32 * ks, 16 * a4, g, qq, pp), rd_tr(lds + VH_OFF, 32 * ks, 16 * b4, g, qq, pp), acc); }
                u32x2 w; w.x = pkh(acc[0], acc[1]); w.y = pkh(acc[2], acc[3]);
                *(u32x2*)(RWQ + (size_t)u * 4096 + ((b4 * 4 + a4) * 64 + lane_o) * 4) = w;
            } else if (kind == 2) {
                { const f16x4 rh4 = *(const LAS f16x4*)(lds + RH_OFF + (16 * b4 + r16) * XP + (16 * a4 + 4 * g) * 2); acc = cvt4f(rh4); }
#pragma unroll
                for (int ks = 0; ks < 2; ++ks) acc = MFMA_H(rd_row(lds + A2T_OFF, XP, 16 * a4 + r16, 32 * ks + 8 * g), rd_row(lds + LRB_OFF, XP, 16 * b4 + r16, 32 * ks + 8 * g), acc);
                u32x2 w; w.x = pkh(acc[0], acc[1]); w.y = pkh(acc[2], acc[3]);
                *(u32x2*)(RWR2 + (size_t)u * 4096 + (16 * b4 + r16) * 64 + 16 * a4 + 4 * g) = w;
            } else {
#pragma unroll
                for (int ks = 0; ks < 2; ++ks) { acc = MFMA_H(rd_row(lds + U1T_OFF, XP, 16 * a4 + r16, 32 * ks + 8 * g), rd_row(lds + LRB_OFF, XP, 16 * b4 + r16, 32 * ks + 8 * g), acc);
                    acc = MFMA_H(rd_tr(lds + VH_OFF, 32 * ks, 16 * a4, g, qq, pp), rd_row(lds + LRK_OFF, XP, 16 * b4 + r16, 32 * ks + 8 * g), acc); }
                u32x2 w; w.x = pkh(acc[0], acc[1]); w.y = pkh(acc[2], acc[3]);
                *(u32x2*)(RWY1 + (size_t)u * 4096 + ((a4 * 4 + b4) * 64 + lane_o) * 4) = w;
            }
        }
    }
}

#undef X_UNIT
#undef X_PREFETCH
struct ChBuf { f16x8 p[4][2]; u32x2 q[4]; };
__device__ __forceinline__ void p7y_chain(const Args& a, int bx0, int G, int wave, int lane) {
    unsigned char* ws = a.ws;
    const f16* RWP = (const f16*)(ws + WS_RWP); const f16* RWQ = (const f16*)(ws + WS_RWQ); f16* RWS0 = (f16*)(ws + WS_RWS0);
    if (wave != 0) return;
#pragma unroll 1
    for (int bx = bx0; bx < 256; bx += G) {
    const int r16 = lane & 15, g = lane >> 4;
    const int b = bx & 7, rest = bx >> 3, h = rest >> 2, it = rest & 3;
    f32x4 S[4];
#pragma unroll
    for (int mt = 0; mt < 4; ++mt) S[mt] = (f32x4){0.f, 0.f, 0.f, 0.f};
    ChBuf B0, B1, B2, B3;
#define CH_LOAD(BUF, c_) do { const size_t uu = ((size_t)(b * 64 + (c_)) * 8 + h); \
        _Pragma("unroll") for (int mo = 0; mo < 4; ++mo) { BUF.q[mo] = *(const u32x2*)(RWQ + uu * 4096 + ((it * 4 + mo) * 64 + lane) * 4); \
            _Pragma("unroll") for (int ks = 0; ks < 2; ++ks) BUF.p[mo][ks] = *(const f16x8*)(RWP + uu * 4096 + ((mo * 2 + ks) * 64 + lane) * 8); } } while (0)
#define CH_STEP(BUF, c_) do { const size_t uu = ((size_t)(b * 64 + (c_)) * 8 + h); f16x8 bfr[2]; \
        _Pragma("unroll") for (int mt = 0; mt < 4; ++mt) { u32x2 w; w.x = pkh(S[mt][0], S[mt][1]); w.y = pkh(S[mt][2], S[mt][3]); \
            *(u32x2*)(RWS0 + uu * 4096 + (16 * it + r16) * 64 + 16 * mt + 4 * g) = w; const f16x4 hv = __builtin_bit_cast(f16x4, w); \
            bfr[mt >> 1][(mt & 1) * 4 + 0] = hv[0]; bfr[mt >> 1][(mt & 1) * 4 + 1] = hv[1]; bfr[mt >> 1][(mt & 1) * 4 + 2] = hv[2]; bfr[mt >> 1][(mt & 1) * 4 + 3] = hv[3]; } \
        _Pragma("unroll") for (int mo = 0; mo < 4; ++mo) { f32x4 n_ = cvt4f(__builtin_bit_cast(f16x4, BUF.q[mo])); \
            _Pragma("unroll") for (int ks = 0; ks < 2; ++ks) n_ = MFMA_H(BUF.p[mo][ks], bfr[ks], n_); S[mo] = n_; } \
        if ((c_) + 4 < 64) CH_LOAD(BUF, (c_) + 4); } while (0)
    CH_LOAD(B0, 0); CH_LOAD(B1, 1); CH_LOAD(B2, 2); CH_LOAD(B3, 3);
#pragma unroll 1
    for (int c = 0; c < 64; c += 4) { CH_STEP(B0, c); CH_STEP(B1, c + 1); CH_STEP(B2, c + 2); CH_STEP(B3, c + 3); }
    }
#undef CH_LOAD
#undef CH_STEP
}

__device__ __forceinline__ void p8z_out(const Args& a, int vcu, int G, int wave, int lane) {
    unsigned char* ws = a.ws;
    const f16* PROJ = (const f16*)(ws + WS_PROJ); const f16* RWG = (const f16*)(ws + WS_RWG);
    const f16* RWR2 = (const f16*)(ws + WS_RWR2); const f16* RWY1 = (const f16*)(ws + WS_RWY1); const f16* RWS0 = (const f16*)(ws + WS_RWS0);
    const float* BON = (const float*)(ws + WS_BON); f16* OATT = (f16*)(ws + WS_OATT);
    const int gw = vcu * NWAVES + wave, NGW = G * NWAVES;
    const bool bal = (G == 256); const int bxx = blockIdx.x;
    const int nit = bal ? 2 : (NUNIT + NGW - 1) / NGW;
#pragma unroll 1
    for (int itx = 0; itx < nit; ++itx) {
        int u;
        if (bal) { const int idx = (bxx >> 3) * 8 + wave + 256 * itx; u = (((bxx & 7) * 64 + (idx >> 3)) * 8 + (idx & 7)); } else { u = gw + itx * NGW; if (u >= NUNIT) break; }
        int lane_o = lane; asm volatile("" : "+v"(lane_o));
        const int r16 = lane_o & 15, g = lane_o >> 4;
        const int h = u & 7, c = (u >> 3) & 63, b = u >> 9;
        const size_t m0 = (size_t)(b << 12) + c * 64;
        f32x4 acc[4][4];
#pragma unroll
        for (int mt = 0; mt < 4; ++mt)
#pragma unroll
            for (int nt = 0; nt < 4; ++nt) acc[mt][nt] = cvt4f(*(const f16x4*)(RWY1 + (size_t)u * 4096 + ((mt * 4 + nt) * 64 + lane_o) * 4));
#pragma unroll
        for (int ks = 0; ks < 2; ++ks) {
            f16x8 sf[4], rf[4];
#pragma unroll
            for (int x = 0; x < 4; ++x) { sf[x] = *(const f16x8*)(RWS0 + (size_t)u * 4096 + (16 * x + r16) * 64 + 32 * ks + 8 * g); rf[x] = *(const f16x8*)(RWR2 + (size_t)u * 4096 + (16 * x + r16) * 64 + 32 * ks + 8 * g); }
#pragma unroll
            for (int mt = 0; mt < 4; ++mt)
#pragma unroll
                for (int nt = 0; nt < 4; ++nt) acc[mt][nt] = MFMA_H(sf[mt], rf[nt], acc[mt][nt]);
        }
#pragma unroll
        for (int nt = 0; nt < 4; ++nt) {
            const int t = 16 * nt + r16; const size_t m = m0 + t;
            float s = 0.f;
#pragma unroll
            for (int mt = 0; mt < 4; ++mt) s += (acc[mt][nt][0] + acc[mt][nt][1]) + (acc[mt][nt][2] + acc[mt][nt][3]);
            s += __shfl_xor(s, 16); s += __shfl_xor(s, 32);
            const float mean = s * (1.f / 64.f); float q = 0.f;
#pragma unroll
            for (int mt = 0; mt < 4; ++mt)
#pragma unroll
                for (int e = 0; e < 4; ++e) { const float d = acc[mt][nt][e] - mean; q += d * d; }
            q += __shfl_xor(q, 16); q += __shfl_xor(q, 32);
            const float rstd = rsqrtf(q * (1.f / 64.f) + GN_EPS);
            const f32x2 bo = *(const f32x2*)(BON + ((size_t)u * 64 + t) * 2); const float bonus = bo[0] + bo[1];
#pragma unroll
            for (int mt = 0; mt < 4; ++mt) {
                const int ch = h * 64 + 16 * mt + 4 * g;
                const f16x4 vc = *(const f16x4*)(PROJ + m * IN_PAD + C_V + ch);
                f16x4 vp = {0, 0, 0, 0}; if ((c * 64 + t) != 0) vp = *(const f16x4*)(PROJ + (m - 1) * IN_PAD + C_V + ch);
                const f32x4 muv = *(const f32x4*)(a.in[17] + 1024 + ch), gn = *(const f32x4*)(a.in[26] + ch), bs = *(const f32x4*)(a.in[27] + ch);
                const f16x4 gg = *(const f16x4*)(RWG + m * RW + ch);
                float o[4];
#pragma unroll
                for (int e = 0; e < 4; ++e) { const float vsv = (float)vc[e] + muv[e] * ((float)vp[e] - (float)vc[e]);
                    o[e] = ((acc[mt][nt][e] - mean) * rstd * gn[e] + bs[e] + bonus * vsv) * (float)gg[e]; }
                u32x2 w; w.x = pkh(o[0], o[1]); w.y = pkh(o[2], o[3]);
                *(u32x2*)(OATT + m * KOUT + 1024 + ch) = w;
            }
        }
    }
}

__device__ __forceinline__ f16* x1_row(unsigned char* ws, int m) { return (f16*)(ws + ((m < 16384) ? WS_RWG : (WS_RWS0 - (size_t)16384 * 2048)) + (size_t)m * 2048); }
__device__ __forceinline__ void p10_mid(const Args& a, int vcu, int G, int wave, int lane) {
    unsigned char* ws = a.ws;
    const f16* MIX = (const f16*)(ws + WS_MIX); const float* mod = (const float*)(ws + WS_MOD); f16* HF = (f16*)(ws + WS_H);
    const int gw = vcu * NWAVES + wave, NGW = G * NWAVES;
    float g6[16], g7[16];
#pragma unroll
    for (int j = 0; j < 2; ++j) { const int c = 8 * lane + 512 * j;
        const f32x4 p0 = *(const f32x4*)(a.in[6] + c), p1 = *(const f32x4*)(a.in[6] + c + 4), q0 = *(const f32x4*)(a.in[7] + c), q1 = *(const f32x4*)(a.in[7] + c + 4);
#pragma unroll
        for (int e = 0; e < 4; ++e) { g6[8 * j + e] = p0[e]; g6[8 * j + 4 + e] = p1[e]; g7[8 * j + e] = q0[e]; g7[8 * j + 4 + e] = q1[e]; } }
    f16x8 nmx[2]; f32x4 nx[4];
    if (gw < MTOK) {
#pragma unroll
        for (int j = 0; j < 2; ++j) { const int c = 8 * lane + 512 * j; nmx[j] = *(const f16x8*)(MIX + (size_t)gw * D + c); nx[2 * j] = *(const f32x4*)(a.in[0] + (size_t)gw * D + c); nx[2 * j + 1] = *(const f32x4*)(a.in[0] + (size_t)gw * D + c + 4); } }
    for (int m = gw; m < MTOK; m += NGW) {
        const int b = m >> 12; const float* md = mod + b * 6144;
        float mx[16], xv[16]; float s = 0.f;
#pragma unroll
        for (int j = 0; j < 2; ++j) { const f16x8 v = nmx[j];
#pragma unroll
            for (int e = 0; e < 8; ++e) { mx[8 * j + e] = (float)v[e]; s += mx[8 * j + e] * mx[8 * j + e]; }
#pragma unroll
            for (int e = 0; e < 4; ++e) { xv[8 * j + e] = nx[2 * j][e]; xv[8 * j + 4 + e] = nx[2 * j + 1][e]; } }
        { const int mn = (m + NGW < MTOK) ? m + NGW : m;
#pragma unroll
          for (int j = 0; j < 2; ++j) { const int c = 8 * lane + 512 * j; nmx[j] = *(const f16x8*)(MIX + (size_t)mn * D + c); nx[2 * j] = *(const f32x4*)(a.in[0] + (size_t)mn * D + c); nx[2 * j + 1] = *(const f32x4*)(a.in[0] + (size_t)mn * D + c + 4); } }
        const float r = rsqrtf(wave_sum(s) * (1.f / D) + NORM_EPS);
        float s1 = 0.f;
        f16* x1r = x1_row(ws, m);
#pragma unroll
        for (int j = 0; j < 2; ++j) { const int c = 8 * lane + 512 * j;
            const f32x4 gm0 = *(const f32x4*)(md + 2048 + c), gm1 = *(const f32x4*)(md + 2048 + c + 4);
#pragma unroll
            for (int e = 0; e < 8; ++e) { const float gm = e < 4 ? gm0[e & 3] : gm1[e & 3]; const float x1 = xv[8 * j + e] + gm * (mx[8 * j + e] * r * g6[8 * j + e]); xv[8 * j + e] = x1; s1 += x1 * x1; }
            u32x4 w; w.x = pkh(xv[8 * j], xv[8 * j + 1]); w.y = pkh(xv[8 * j + 2], xv[8 * j + 3]); w.z = pkh(xv[8 * j + 4], xv[8 * j + 5]); w.w = pkh(xv[8 * j + 6], xv[8 * j + 7]);
            *(u32x4*)(x1r + c) = w; }
        const float r1 = rsqrtf(wave_sum(s1) * (1.f / D) + NORM_EPS);
#pragma unroll
        for (int j = 0; j < 2; ++j) { const int c = 8 * lane + 512 * j; float y[8];
            const f32x4 sc0 = *(const f32x4*)(md + 4096 + c), sc1 = *(const f32x4*)(md + 4096 + c + 4), sh0 = *(const f32x4*)(md + 3072 + c), sh1 = *(const f32x4*)(md + 3072 + c + 4);
#pragma unroll
            for (int e = 0; e < 8; ++e) { const float sc = e < 4 ? sc0[e & 3] : sc1[e & 3], sh = e < 4 ? sh0[e & 3] : sh1[e & 3]; y[e] = xv[8 * j + e] * r1 * g7[8 * j + e] * (1.f + sc) + sh; }
            u32x4 w; w.x = pkh(y[0], y[1]); w.y = pkh(y[2], y[3]); w.z = pkh(y[4], y[5]); w.w = pkh(y[6], y[7]);
            *(u32x4*)(HF + (size_t)m * D + c) = w; }
    }
}
__device__ __forceinline__ void p13_final(const Args& a, int vcu, int G, int wave, int lane) {
    unsigned char* ws = a.ws;
    const f16* F = (const f16*)(ws + WS_F); const float* mod = (const float*)(ws + WS_MOD);
    const int gw = vcu * NWAVES + wave, NGW = G * NWAVES;
    float g8[16];
#pragma unroll
    for (int j = 0; j < 2; ++j) { const int c = 8 * lane + 512 * j; const f32x4 p0 = *(const f32x4*)(a.in[8] + c), p1 = *(const f32x4*)(a.in[8] + c + 4);
#pragma unroll
        for (int e = 0; e < 4; ++e) { g8[8 * j + e] = p0[e]; g8[8 * j + 4 + e] = p1[e]; } }
    f16x8 nf[2], nxh[2];
    if (gw < MTOK) { const f16* x1n = x1_row(ws, gw);
#pragma unroll
        for (int j = 0; j < 2; ++j) { const int c = 8 * lane + 512 * j; nf[j] = *(const f16x8*)(F + (size_t)gw * D + c); nxh[j] = *(const f16x8*)(x1n + c); } }
    for (int m = gw; m < MTOK; m += NGW) {
        const int b = m >> 12; const float* md = mod + b * 6144;
        float fv[16]; float s = 0.f;
        f16x8 xh[2];
#pragma unroll
        for (int j = 0; j < 2; ++j) { const f16x8 v = nf[j]; xh[j] = nxh[j];
#pragma unroll
            for (int e = 0; e < 8; ++e) { fv[8 * j + e] = (float)v[e]; s += fv[8 * j + e] * fv[8 * j + e]; } }
        { const int mn = (m + NGW < MTOK) ? m + NGW : m; const f16* x1n = x1_row(ws, mn);
#pragma unroll
          for (int j = 0; j < 2; ++j) { const int c = 8 * lane + 512 * j; nf[j] = *(const f16x8*)(F + (size_t)mn * D + c); nxh[j] = *(const f16x8*)(x1n + c); } }
        const float r = rsqrtf(wave_sum(s) * (1.f / D) + NORM_EPS);
#pragma unroll
        for (int j = 0; j < 2; ++j) { const int c = 8 * lane + 512 * j;
            const f32x4 gf0 = *(const f32x4*)(md + 5120 + c), gf1 = *(const f32x4*)(md + 5120 + c + 4);
            f32x4 o0, o1;
#pragma unroll
            for (int e = 0; e < 4; ++e) { o0[e] = (float)xh[j][e] + gf0[e] * (fv[8 * j + e] * r * g8[8 * j + e]); o1[e] = (float)xh[j][4 + e] + gf1[e] * (fv[8 * j + 4 + e] * r * g8[8 * j + 4 + e]); }
            *(f32x4*)(a.out + (size_t)m * D + c) = o0; *(f32x4*)(a.out + (size_t)m * D + c + 4) = o1; }
    }
}

constexpr int NPHASE = 14;
__global__ void __launch_bounds__(NWAVES * 64, 2) fwd(Args args) {
    extern __shared__ __attribute__((aligned(16))) unsigned char lds_raw[];
    LAS unsigned char* lds = (LAS unsigned char*)lds_raw;
    const int tid = threadIdx.x, lane = tid & 63, wave = __builtin_amdgcn_readfirstlane(tid >> 6);
    const int G = gridDim.x; const int bx = blockIdx.x; const int vcu = (G % 8 == 0) ? (bx % 8) * (G / 8) + bx / 8 : bx;
    volatile LAS unsigned* MISC = (volatile LAS unsigned*)(lds + MISC_OFF);
    if (tid < 16) MISC[tid] = 0u;
    __syncthreads();
    const int lo = args.ph_lo, hi = args.ph_hi;
    unsigned* barw = (unsigned*)(args.ws + WS_CTL) + CW_BAR;
    XcdBarrier bar; bar.bar = barw; bar.x = 0; bar.st = nullptr;
    if (hi - lo > 1) bar = xcd_barrier_post(barw, MISC);
#ifndef PHMASK
#define PHMASK 0x3FFF
#endif
#ifndef REPMASK
#define REPMASK 0
#endif
#define IN(k) (((PHMASK >> (k)) & 1) && lo <= (k) && (k) < hi)
#define REP(k) for (int rep_ = 0; rep_ < (((REPMASK >> (k)) & 1) ? 2 : 1); ++rep_)
#ifndef BARREP
#define BARREP 1
#endif
#define SEAM(k) do { if (IN(k) && IN((k) + 1)) for (int br_ = 0; br_ < BARREP; ++br_) xcd_barrier(bar); } while (0)
    unsigned char* ws = args.ws;
    if (IN(0)) REP(0) { if (rep_) __syncthreads(); p0_prologue(args, lds, vcu, G, wave, lane); } SEAM(0);
    if (IN(1)) REP(1) { if (rep_) __syncthreads(); p1_modnorm(args, vcu, G, wave, lane); } SEAM(1);
    if (IN(2)) REP(2) { if (rep_) __syncthreads(); pg8::Gemm g{(const f16*)(ws + WS_H), (const f16*)(ws + WS_WIN), MTOK, IN_PAD, D}; pg8::StaticOrder S; S.init(MTOK, IN_PAD, G, bx);
        pg8::EpiF16 E{(f16*)(ws + WS_PROJ), IN_PAD}; pg8::gemm_phase<pg8::EpiF16, pg8::StaticOrder, true, true>(lds, g, S, E); } SEAM(2);
#ifdef OLD_BASELINE
    if (IN(5)) REP(5) { if (rep_) __syncthreads(); p5_indexer(args, lds, vcu, G, wave, lane); } SEAM(5);
    if (IN(6)) REP(6) { if (rep_) __syncthreads(); p6_attention(args, lds, vcu, G, wave, lane); p3_rwkv_prep(args, lds, vcu, G, tid); } SEAM(6);
    if (IN(7)) REP(7) { if (rep_) __syncthreads(); p7_scan(args, lds, vcu, G, wave, lane); } SEAM(7);
    if (IN(8)) REP(8) { if (rep_) __syncthreads(); p8_rwkv_post(args, vcu, G, wave, lane); } SEAM(8);
#else
#define SEAMX() do { if (hi - lo > 1) for (int br_ = 0; br_ < BARREP; ++br_) xcd_barrier(bar); } while (0)
    if (IN(3)) REP(3) { if (rep_) __syncthreads(); p3_rows(args, vcu, G, wave, lane); }
    if (IN(6)) REP(6) { __syncthreads(); p7x_chunks(args, lds, vcu, G, tid, wave, lane); } SEAMX();
    if (IN(4)) REP(4) { if (rep_) __syncthreads(); pg8::Gemm g{(const f16*)(ws + WS_CQ), (const f16*)(ws + WS_WCQ), MTOK, NQI, QL}; pg8::StaticOrder S; S.init(MTOK, NQI, G, bx);
        pg8::EpiF16 E{(f16*)args.out, NQI}; pg8::gemm_phase<pg8::EpiF16, pg8::StaticOrder, true, true>(lds, g, S, E); }
    if (IN(7)) REP(7) { __syncthreads(); p7y_chain(args, bx, G, wave, lane); } SEAMX();
    if (IN(5)) REP(5) { if (rep_) __syncthreads(); p5_dsa(args, lds, G, bx, tid, wave, lane); }
    if (IN(8)) REP(8) { __syncthreads(); p8z_out(args, vcu, G, wave, lane); } SEAMX();
#endif
    if (IN(9)) REP(9) { if (rep_) __syncthreads(); pg8::Gemm g{(const f16*)(ws + WS_OATT), (const f16*)(ws + WS_WOUT), MTOK, D, KOUT}; pg8::StaticOrder S; S.init(MTOK, D, G, bx);
        pg8::EpiF16 E{(f16*)(ws + WS_MIX), D}; pg8::gemm_phase<pg8::EpiF16, pg8::StaticOrder, true, true>(lds, g, S, E); } SEAM(9);
    if (IN(10)) REP(10) { if (rep_) __syncthreads(); p10_mid(args, vcu, G, wave, lane); } SEAM(10);
    if (IN(11)) REP(11) { if (rep_) __syncthreads(); pg8::Gemm g{(const f16*)(ws + WS_H), (const f16*)(ws + WS_WGU), MTOK, 2 * DFF, D}; pg8::StaticOrder S; S.init(MTOK, 2 * DFF, G, bx);
        pg8::EpiSwiGLU E{(f16*)(ws + WS_ACT), DFF}; pg8::gemm_phase<pg8::EpiSwiGLU, pg8::StaticOrder, true, true>(lds, g, S, E); } SEAM(11);
    if (IN(12)) REP(12) { if (rep_) __syncthreads(); pg8::Gemm g{(const f16*)(ws + WS_ACT), (const f16*)(ws + WS_WDN), MTOK, D, DFF}; pg8::StaticOrder S; S.init(MTOK, D, G, bx);
        pg8::EpiF16 E{(f16*)(ws + WS_F), D}; pg8::gemm_phase<pg8::EpiF16, pg8::StaticOrder, true, true>(lds, g, S, E); } SEAM(12);
    if (IN(13)) REP(13) { if (rep_) __syncthreads(); p13_final(args, vcu, G, wave, lane); }
#undef IN
#undef SEAM
}

#ifndef N_LAUNCH_MODE
#define N_LAUNCH_MODE 1
#endif
extern "C" void kernel_launch(void* const* d_in, const int* in_sizes, int n_in, void* d_out, int out_size, void* d_ws, size_t ws_size, hipStream_t stream) {
    static int grid = 0;
    if (grid == 0) {
        int dev = 0, cus = 0, per_cu = 0;
        if (n_in != 32 || ws_size < WS_END) { fprintf(stderr, "kernel_launch: unexpected n_in %d or ws_size %zu (< %zu)\n", n_in, ws_size, (size_t)WS_END); }
        if (hipGetDevice(&dev) != hipSuccess || hipDeviceGetAttribute(&cus, hipDeviceAttributeMultiprocessorCount, dev) != hipSuccess) { grid = -1; return; }
        if (hipFuncSetAttribute((const void*)fwd, hipFuncAttributeMaxDynamicSharedMemorySize, LDS_BYTES) != hipSuccess) { fprintf(stderr, "kernel_launch: hipFuncSetAttribute failed\n"); grid = -1; return; }
        if (hipOccupancyMaxActiveBlocksPerMultiprocessor(&per_cu, (const void*)fwd, NWAVES * 64, LDS_BYTES) != hipSuccess || per_cu < 1) fprintf(stderr, "kernel_launch: occupancy query says %d\n", per_cu);
        (void)hipGetLastError();
        grid = cus;
    }
    if (grid < 0) return;
    (void)hipMemsetAsync((char*)d_ws + WS_CTL, 0, CTL_ZERO_BYTES, stream);
    Args a{};
    for (int i = 0; i < 32; ++i) a.in[i] = (const float*)d_in[i];
    a.out = (float*)d_out; a.ws = (unsigned char*)d_ws;
    if (N_LAUNCH_MODE == 1) { a.ph_lo = 0; a.ph_hi = NPHASE; hipLaunchKernelGGL(fwd, dim3(grid), dim3(NWAVES * 64), LDS_BYTES, stream, a); }
    else for (int p = 0; p < NPHASE; ++p) { a.ph_lo = p; a.ph_hi = p + 1; hipLaunchKernelGGL(fwd, dim3(grid), dim3(NWAVES * 64), LDS_BYTES, stream, a); }
}
```

```cpp
#include <hip/hip_runtime.h>
#include <cstdio>
#include <cstdint>

#define LAS __attribute__((address_space(3)))
#define GAS __attribute__((address_space(1)))
typedef _Float16 f16;
typedef _Float16 f16x8 __attribute__((ext_vector_type(8)));
typedef _Float16 f16x4 __attribute__((ext_vector_type(4)));
typedef _Float16 f16x2 __attribute__((ext_vector_type(2)));
typedef float f32x4 __attribute__((ext_vector_type(4)));
typedef float f32x2 __attribute__((ext_vector_type(2)));
typedef unsigned u32x4 __attribute__((ext_vector_type(4)));
typedef unsigned u32x2 __attribute__((ext_vector_type(2)));

__device__ __forceinline__ unsigned pkh(float a, float b) { f16x2 v = {(f16)a, (f16)b}; return __builtin_bit_cast(unsigned, v); }
__device__ __forceinline__ float h2f(f16 h) { return (float)h; }

namespace pg8 {
constexpr int BM = 256, BK = 64, HALF = 128, HTB = HALF * BK * 2, STAGE_BYTES = 8 * HTB, NXCD = 8, WGM = 8;
__host__ __device__ __forceinline__ int lds_byte(int r, int c) { const int st = (r >> 4) * 2 + (c >> 5), rr = r & 15, cc = c & 31, ob = rr * 64 + cc * 2; return st * 1024 + (ob ^ (((ob >> 9) & 1) << 5)); }
__host__ __device__ __forceinline__ void stage_rc(int b, int& R, int& C) { const int st = b / 1024, sb = b % 1024, swz = sb ^ (((sb >> 9) & 1) << 5); R = (st >> 1) * 16 + swz / 64; C = (st & 1) * 32 + (swz % 64) / 2; }
__host__ __device__ __forceinline__ int perm32(int rho) { const int n = rho >> 4, i = rho & 15; return 8 * (i >> 2) + 4 * n + (i & 3); }

struct Unit { int pm, pn; };
struct Gemm { const f16* A; const f16* Bt; int M, N, K; };

struct StaticOrder {
    int nM, nN, nwg, G, c;
    __host__ __device__ void init(int M, int N, int G_, int c_) { nM = M / BM; nN = N / BM; nwg = nM * nN; G = G_; c = c_; }
    __host__ __device__ bool next(int i, Unit& u) const {
        const long L = (long)i * G + c; if (L >= nwg) return false;
        int wgid = (int)L; { const int q = nwg / NXCD, r = nwg % NXCD, xcd = wgid % NXCD, off = wgid / NXCD; wgid = (xcd < r ? xcd * (q + 1) : r * (q + 1) + (xcd - r) * q) + off; }
        const int nig = WGM * nN, gid = wgid / nig, fm = gid * WGM, gsz = (nM - fm) < WGM ? (nM - fm) : WGM;
        u.pm = fm + ((wgid % nig) % gsz); u.pn = (wgid % nig) / gsz; return true;
    }
    __device__ __forceinline__ void a_ready(const Unit&) const {}
    __device__ __forceinline__ void done(const Unit&) const {}
};

struct EpiF16 {
    static constexpr bool PERM = true, AFTER_DRAIN = false;
    f16* O; int ldc;
    __device__ __forceinline__ void operator()(const f32x4 (&acc)[2][2][4][2], const Unit& u, int wr, int wc, int fr, int fq) const {
        const int row0 = u.pm * BM + wr * 64 + fr; const int col0 = u.pn * BM + wc * 32 + 8 * fq;
#pragma unroll
        for (int ai = 0; ai < 2; ++ai)
#pragma unroll
            for (int m = 0; m < 4; ++m) { f16* rowp = O + (size_t)(row0 + ai * HALF + m * 16) * ldc + col0;
#pragma unroll
                for (int bj = 0; bj < 2; ++bj) { const f32x4 v0 = acc[ai][bj][m][0], v1 = acc[ai][bj][m][1];
                    u32x4 w; w.x = pkh(v0[0], v0[1]); w.y = pkh(v0[2], v0[3]); w.z = pkh(v1[0], v1[1]); w.w = pkh(v1[2], v1[3]);
                    *(u32x4*)(rowp + bj * HALF) = w; } }
    }
};
struct EpiSwiGLU {
    static constexpr bool PERM = true, AFTER_DRAIN = false;
    f16* O; int ldc;
    __device__ __forceinline__ void operator()(const f32x4 (&acc)[2][2][4][2], const Unit& u, int wr, int wc, int fr, int fq) const {
        const int row0 = u.pm * BM + wr * 64 + fr; const int col0 = u.pn * HALF + wc * 32 + 8 * fq;
#pragma unroll
        for (int ai = 0; ai < 2; ++ai)
#pragma unroll
            for (int m = 0; m < 4; ++m) { f16* rowp = O + (size_t)(row0 + ai * HALF + m * 16) * ldc + col0;
                float o[8];
#pragma unroll
                for (int n = 0; n < 2; ++n)
#pragma unroll
                    for (int j = 0; j < 4; ++j) { const float g = acc[ai][0][m][n][j], up = acc[ai][1][m][n][j]; o[n * 4 + j] = g * __builtin_amdgcn_rcpf(1.0f + __expf(-g)) * up; }
                u32x4 w; w.x = pkh(o[0], o[1]); w.y = pkh(o[2], o[3]); w.z = pkh(o[4], o[5]); w.w = pkh(o[6], o[7]);
                *(u32x4*)rowp = w; }
    }
};

template <class Epi, class Sched, bool ALIGN_EPI = false, bool SP2 = false>
__device__ __forceinline__ void gemm_phase(LAS unsigned char* lds, const Gemm g, const Sched& S, const Epi& E) {
    const int tid = threadIdx.x, wid = __builtin_amdgcn_readfirstlane(tid >> 6), lane = tid & 63, wr = wid >> 2, wc = wid & 3, fr = lane & 15, fq = lane >> 4;
    const int K = g.K, nt = K / BK;
    unsigned voffA[2], voffB[2];
#pragma unroll
    for (int i = 0; i < 2; ++i) { int R, C; stage_rc(tid * 16 + i * 8192, R, C); const int Rb = Epi::PERM ? ((R & ~31) + perm32(R & 31)) : R;
        voffA[i] = (unsigned)(R * K + C) * 2u; voffB[i] = (unsigned)(Rb * K + C) * 2u; }
    const size_t kstep = (size_t)(BK * 2);
    const size_t hstep = (size_t)HALF * K * 2;
    const size_t tstep = 2 * hstep;
    const unsigned ldsw = (unsigned)wid * 1024u;
    const int aoff = lds_byte(wr * 64 + fr, fq * 8), boff = lds_byte(wc * 32 + fr, fq * 8);
#define PG8_SA(b, h) (((b) * 2 + (h)) * HTB)
#define PG8_SB(b, h) ((4 + (b) * 2 + (h)) * HTB)
#define PG8_STAGE(bufoff, gbase, voff) do { _Pragma("unroll") for (int _i = 0; _i < 2; ++_i) \
        __builtin_amdgcn_global_load_lds((const unsigned*)((const char*)(gbase) + (voff)[_i]), (LAS unsigned*)(lds + (bufoff) + ldsw + _i * 8192), 16, 0, 0); } while (0)
#define PG8_LDA(dst, b, h) do { _Pragma("unroll") for (int m = 0; m < 4; ++m) _Pragma("unroll") for (int k = 0; k < 2; ++k) dst[m][k] = *(const LAS f16x8*)(lds + PG8_SA(b, h) + aoff + m * 2048 + k * 1024); } while (0)
#define PG8_LDB(dst, b, h) do { _Pragma("unroll") for (int n = 0; n < 2; ++n) _Pragma("unroll") for (int k = 0; k < 2; ++k) dst[n][k] = *(const LAS f16x8*)(lds + PG8_SB(b, h) + boff + n * 2048 + k * 1024); } while (0)
#define PG8_MMA(ai, bj, At, Bt) do { __builtin_amdgcn_s_setprio(1); _Pragma("unroll") for (int m = 0; m < 4; ++m) _Pragma("unroll") for (int n = 0; n < 2; ++n) _Pragma("unroll") for (int k = 0; k < 2; ++k) \
        acc[ai][bj][m][n] = __builtin_amdgcn_mfma_f32_16x16x32_f16(Bt[n][k], At[m][k], acc[ai][bj][m][n], 0, 0, 0); __builtin_amdgcn_s_setprio(0); } while (0)
#define PG8_WAIT_V(n) asm volatile("s_waitcnt vmcnt(" #n ")" ::: "memory")
#define PG8_WAIT_L(n) asm volatile("s_waitcnt lgkmcnt(" #n ")" ::: "memory")
#define PG8_BAR __builtin_amdgcn_s_barrier()
#define PG8_SCHED __builtin_amdgcn_sched_barrier(0)
    Unit cur, nxt; int ui = 0;
    if (!S.next(0, cur)) return;
    f32x4 acc[2][2][4][2];
#pragma unroll
    for (int a = 0; a < 2; ++a)
#pragma unroll
        for (int b = 0; b < 2; ++b)
#pragma unroll
            for (int m = 0; m < 4; ++m)
#pragma unroll
                for (int n = 0; n < 2; ++n) acc[a][b][m][n] = (f32x4){0.f, 0.f, 0.f, 0.f};
    f16x8 At[4][2], B0[2][2], B1[2][2];
    const char* cA = (const char*)g.A + (size_t)cur.pm * tstep; const char* cB = (const char*)g.Bt + (size_t)cur.pn * tstep;
    S.a_ready(cur);
    if constexpr (SP2) {
        PG8_STAGE(PG8_SB(0, 0), cB, voffB); PG8_STAGE(PG8_SB(0, 1), cB + hstep, voffB); PG8_STAGE(PG8_SA(0, 0), cA, voffA); PG8_STAGE(PG8_SA(0, 1), cA + hstep, voffA);
        if (wr == 1) PG8_BAR;
        PG8_WAIT_V(2); PG8_BAR;
        PG8_STAGE(PG8_SB(1, 0), cB + kstep, voffB); PG8_STAGE(PG8_SA(1, 0), cA + kstep, voffA); PG8_STAGE(PG8_SB(1, 1), cB + hstep + kstep, voffB);
        PG8_WAIT_V(6); PG8_BAR;
    } else {
        PG8_STAGE(PG8_SB(0, 0), cB, voffB); PG8_STAGE(PG8_SA(0, 0), cA, voffA); PG8_STAGE(PG8_SB(0, 1), cB + hstep, voffB); PG8_STAGE(PG8_SA(0, 1), cA + hstep, voffA);
        if (wr == 1) PG8_BAR;
        PG8_WAIT_V(4); PG8_BAR;
        PG8_STAGE(PG8_SB(1, 0), cB + kstep, voffB); PG8_STAGE(PG8_SA(1, 0), cA + kstep, voffA); PG8_STAGE(PG8_SB(1, 1), cB + hstep + kstep, voffB);
        PG8_WAIT_V(6); PG8_BAR;
    }
    for (;;) {
        const bool has_next = S.next(ui + 1, nxt);
        const char* nA = has_next ? (const char*)g.A + (size_t)nxt.pm * tstep : cA; const char* nB = has_next ? (const char*)g.Bt + (size_t)nxt.pn * tstep : cB;
        for (int t = 0; t < nt; t += 2) {
            const bool last = (t == nt - 2);
            const char* a1 = cA + (size_t)(t + 1) * kstep;
            const char* a2 = last ? nA : cA + (size_t)(t + 2) * kstep; const char* b2 = last ? nB : cB + (size_t)(t + 2) * kstep;
            const char* a3 = a2 + kstep; const char* b3 = b2 + kstep;
            if (last && has_next) S.a_ready(nxt);
            if constexpr (SP2) {
            PG8_LDB(B0, 0, 0); PG8_LDB(B1, 0, 1); PG8_SCHED; PG8_LDA(At, 0, 0); PG8_STAGE(PG8_SA(1, 1), a1 + hstep, voffA);
            PG8_WAIT_V(8); PG8_WAIT_L(0); PG8_BAR; PG8_MMA(0, 0, At, B0); PG8_MMA(0, 1, At, B1); PG8_BAR; PG8_SCHED;
            PG8_LDA(At, 0, 1); PG8_STAGE(PG8_SB(0, 0), b2, voffB); PG8_STAGE(PG8_SB(0, 1), b2 + hstep, voffB); PG8_STAGE(PG8_SA(0, 0), a2, voffA);
            PG8_WAIT_V(8); PG8_WAIT_L(0); PG8_BAR; PG8_MMA(1, 0, At, B0); PG8_MMA(1, 1, At, B1); PG8_BAR; PG8_SCHED;
            PG8_LDB(B0, 1, 0); PG8_LDB(B1, 1, 1); PG8_SCHED; PG8_LDA(At, 1, 0); PG8_STAGE(PG8_SA(0, 1), a2 + hstep, voffA);
            PG8_WAIT_V(8); PG8_WAIT_L(0); PG8_BAR; PG8_MMA(0, 0, At, B0); PG8_MMA(0, 1, At, B1); PG8_BAR; PG8_SCHED;
            PG8_LDA(At, 1, 1); PG8_STAGE(PG8_SB(1, 0), b3, voffB); PG8_STAGE(PG8_SB(1, 1), b3 + hstep, voffB); PG8_STAGE(PG8_SA(1, 0), a3, voffA);
            PG8_WAIT_V(8); PG8_WAIT_L(0); PG8_BAR; PG8_MMA(1, 0, At, B0); PG8_MMA(1, 1, At, B1); PG8_BAR; PG8_SCHED;
            } else {
            PG8_LDB(B0, 0, 0); PG8_SCHED; PG8_LDA(At, 0, 0); PG8_STAGE(PG8_SA(1, 1), a1 + hstep, voffA);
            PG8_WAIT_L(8); PG8_BAR; PG8_WAIT_L(0); PG8_MMA(0, 0, At, B0); PG8_BAR; PG8_SCHED;
            PG8_LDB(B1, 0, 1); PG8_STAGE(PG8_SB(0, 0), b2, voffB);
            PG8_BAR; PG8_WAIT_L(0); PG8_MMA(0, 1, At, B1); PG8_BAR;
            PG8_LDA(At, 0, 1); PG8_STAGE(PG8_SA(0, 0), a2, voffA);
            PG8_BAR; PG8_WAIT_L(0); PG8_MMA(1, 0, At, B0); PG8_BAR; PG8_SCHED;
            PG8_STAGE(PG8_SB(0, 1), b2 + hstep, voffB);
            PG8_WAIT_V(6); PG8_BAR; PG8_MMA(1, 1, At, B1); PG8_BAR;
            PG8_LDB(B0, 1, 0); PG8_SCHED; PG8_LDA(At, 1, 0); PG8_STAGE(PG8_SA(0, 1), a2 + hstep, voffA);
            PG8_WAIT_L(8); PG8_BAR; PG8_WAIT_L(0); PG8_MMA(0, 0, At, B0); PG8_BAR; PG8_SCHED;
            PG8_LDB(B1, 1, 1); PG8_STAGE(PG8_SB(1, 0), b3, voffB);
            PG8_BAR; PG8_WAIT_L(0); PG8_MMA(0, 1, At, B1); PG8_BAR;
            PG8_LDA(At, 1, 1); PG8_STAGE(PG8_SA(1, 0), a3, voffA);
            PG8_BAR; PG8_WAIT_L(0); PG8_MMA(1, 0, At, B0); PG8_BAR; PG8_SCHED;
            PG8_STAGE(PG8_SB(1, 1), b3 + hstep, voffB);
            PG8_WAIT_V(6); PG8_BAR; PG8_MMA(1, 1, At, B1); PG8_BAR;
            }
        }
        if constexpr (ALIGN_EPI) { if (wr == 0) PG8_BAR; }
        if constexpr (!Epi::AFTER_DRAIN) { E(acc, cur, wr, wc, fr, fq); S.done(cur); }
        if (!has_next) break;
#pragma unroll
        for (int a = 0; a < 2; ++a)
#pragma unroll
            for (int b = 0; b < 2; ++b)
#pragma unroll
                for (int m = 0; m < 4; ++m)
#pragma unroll
                    for (int n = 0; n < 2; ++n) acc[a][b][m][n] = (f32x4){0.f, 0.f, 0.f, 0.f};
        cur = nxt; cA = nA; cB = nB; ++ui;
        if constexpr (ALIGN_EPI) { if (wr == 1) PG8_BAR; }
    }
    PG8_WAIT_V(0);
    if constexpr (!ALIGN_EPI) { if (wr == 0) PG8_BAR; }
    PG8_BAR;
#undef PG8_SA
#undef PG8_SB
#undef PG8_STAGE
#undef PG8_LDA
#undef PG8_LDB
#undef PG8_MMA
#undef PG8_WAIT_V
#undef PG8_WAIT_L
#undef PG8_BAR
#undef PG8_SCHED
}
}

#define XB_TMO      128
#define XB_XCNT(j)  (256  + 64 * (j))
#define XB_XSUB(j)  (1280 + 64 * (j))
#define XB_XGEN(j)  (2304 + 64 * (j))
#define XB_TOP      3328
#define XB_TOPGEN   3392
#define XCD_BAR_WORDS 3456
#define XB_SPIN_CAP (1u << 18)
__device__ __forceinline__ unsigned xb_ld(unsigned* p)              { return __hip_atomic_load(p, __ATOMIC_RELAXED, __HIP_MEMORY_SCOPE_AGENT); }
__device__ __forceinline__ unsigned xb_add(unsigned* p, unsigned v) { return __hip_atomic_fetch_add(p, v, __ATOMIC_RELAXED, __HIP_MEMORY_SCOPE_AGENT); }
__device__ __forceinline__ unsigned xb_xcc_id() { return (unsigned)__builtin_amdgcn_s_getreg((3 << 11) | 20) & 0xFu; }
#define XB_SPIN(cond, bar) do { unsigned _sp = 0; while (cond) { __builtin_amdgcn_s_sleep(1); \
    if ((++_sp & 255u) == 0u) { if (xb_ld(&(bar)[XB_TMO])) break; if (_sp > XB_SPIN_CAP) { atomicAdd(&(bar)[XB_TMO], 1u); break; } } } } while (0)
struct XcdBarrier { unsigned* bar; unsigned x; volatile LAS unsigned* st; };
__device__ __forceinline__ XcdBarrier xcd_barrier_post(unsigned* bar, volatile LAS unsigned* st) {
    XcdBarrier b; b.bar = bar; b.x = xb_xcc_id(); b.st = st;
    if (threadIdx.x == 0) (void)xb_add(&bar[XB_XCNT(b.x)], 1u);
    return b;
}
__device__ __forceinline__ void xcd_barrier_complete(unsigned* bar, unsigned x, unsigned& nloc, unsigned& nx) {
    const unsigned G = gridDim.x * gridDim.y * gridDim.z;
    unsigned sum, cnt, mine, sp = 0u;
    for (;;) {
        sum = 0u; cnt = 0u; mine = 0u;
#pragma unroll
        for (unsigned j = 0; j < 16; ++j) { const unsigned c = xb_ld(&bar[XB_XCNT(j)]); sum += c; cnt += (c > 0u) ? 1u : 0u; mine = (j == x) ? c : mine; }
        if (sum == G) break;
        __builtin_amdgcn_s_sleep(1);
        if ((++sp & 255u) == 0u) { if (xb_ld(&bar[XB_TMO])) break; if (sp > XB_SPIN_CAP) { atomicAdd(&bar[XB_TMO], 1u); break; } }
    }
    nloc = mine > 0u ? mine : 1u; nx = cnt > 0u ? cnt : 1u;
}
__device__ __forceinline__ void xcd_barrier(const XcdBarrier& b) {
    asm volatile("s_waitcnt vmcnt(0)" ::: "memory");
    __syncthreads();
    if (threadIdx.x == 0) {
        unsigned* bar = b.bar;
        __builtin_amdgcn_s_waitcnt(0);
        unsigned nloc = b.st[0], nx = b.st[1];
        if (nloc == 0u) { xcd_barrier_complete(bar, b.x, nloc, nx); b.st[0] = nloc; b.st[1] = nx; }
        const unsigned old = xb_add(&bar[XB_XSUB(b.x)], 1u);
        const unsigned gen = old / nloc;
        if (old + 1u == (gen + 1u) * nloc) {
            __builtin_amdgcn_fence(__ATOMIC_RELEASE, "agent");
            asm volatile("s_waitcnt vmcnt(0)" ::: "memory");
            const unsigned og = xb_add(&bar[XB_TOP], 1u);
            const unsigned tg = og / nx;
            if (og + 1u == (tg + 1u) * nx) xb_add(&bar[XB_TOPGEN], 1u);
            else XB_SPIN(xb_ld(&bar[XB_TOPGEN]) == tg, bar);
            __builtin_amdgcn_fence(__ATOMIC_ACQUIRE, "agent");
            xb_add(&bar[XB_XGEN(b.x)], 1u);
            asm volatile("s_waitcnt vmcnt(0)" ::: "memory");
        } else {
            XB_SPIN(xb_ld(&bar[XB_XGEN(b.x)]) == gen, bar);
            __builtin_amdgcn_fence(__ATOMIC_ACQUIRE, "agent");
            asm volatile("s_waitcnt vmcnt(0)" ::: "memory");
        }
    }
    __syncthreads();
}

constexpr int BATCH = 8, SEQ = 4096, D = 1024, MTOK = BATCH * SEQ;
constexpr int QL = 256, KVL = 128, IDXD = 64, IDXH = 8, HATT = 8, TOPK = 256;
constexpr int RW = 512, HRW = 8, NRW = 64;
constexpr int IN_COLS = 2280, IN_PAD = 2304;
constexpr int C_CQ = 0, C_CKV = 256, C_IK = 384, C_IW = 448, C_R = 456, C_K = 968, C_V = 1480, C_WD = 1992, C_AD = 2056, C_GD = 2120;
constexpr int DFF = 2816;
constexpr int NQI = 1536;
constexpr int KOUT = 1536;
constexpr float NORM_EPS = 1e-6f, GN_EPS = 64e-5f;

constexpr size_t MiB = 1u << 20;
constexpr size_t WS_CTL = 0, CTL_ZERO_BYTES = 64 * 1024;
constexpr size_t WS_MOD = 1 * MiB;
constexpr size_t WS_WIN = 2 * MiB;
constexpr size_t WS_WCQ = 7 * MiB;
constexpr size_t WS_WOUT = 8 * MiB;
constexpr size_t WS_WGU = 11 * MiB;
constexpr size_t WS_WDN = 22 * MiB;
constexpr size_t WS_H = 32 * MiB;
constexpr size_t WS_RWW = 32 * MiB, WS_RWA = 64 * MiB;
constexpr size_t WS_PROJ = 96 * MiB;
constexpr size_t WS_CQ = 240 * MiB;
constexpr size_t WS_SEL = 240 * MiB;
constexpr size_t WS_OATT = 256 * MiB;
constexpr size_t WS_CKV = 352 * MiB;
constexpr size_t WS_IK16 = 360 * MiB;
constexpr size_t WS_IK32 = 364 * MiB;
constexpr size_t WS_IW = 372 * MiB;
constexpr size_t WS_RWG = 376 * MiB;
constexpr size_t WS_YRAW = 408 * MiB;
constexpr size_t WS_MIX = 408 * MiB;
constexpr size_t WS_ACT = 96 * MiB;
constexpr size_t WS_F = 288 * MiB;
constexpr size_t WS_CKV8 = 368 * MiB;
constexpr size_t WS_END = 504 * MiB;

constexpr int CW_BAR = 1024;
constexpr int NWAVES = 8;
constexpr int RING_BYTES = 131072, AUX_OFF = RING_BYTES  , MISC_OFF = 163584, LDS_BYTES = 163648;

struct Args { const float* in[32]; float* out; unsigned char* ws; int ph_lo, ph_hi; };

__device__ __forceinline__ float wave_sum(float v) {
#pragma unroll
    for (int o = 1; o < 64; o <<= 1) v += __shfl_xor(v, o);
    return v;
}
__device__ __forceinline__ void lds_barrier() { asm volatile("s_waitcnt lgkmcnt(0)\n\ts_barrier" ::: "memory"); }
__device__ __forceinline__ float sigmoidf_(float x) { return __builtin_amdgcn_rcpf(1.0f + __expf(-x)); }

__device__ __forceinline__ void p0_transpose_item(const float* W, int K, int N, int Npad, f16* WT, int ldk, int koff, int row_off, int mode, LAS float* scr, int item, int lane) {
    const int nblk = Npad / 32, kb = item / nblk, nb = item % nblk, k0 = 64 * kb, n0 = 32 * nb;
    const int rr = lane >> 3, c4 = 4 * (lane & 7);
    f32x4 v[8];
#pragma unroll
    for (int i = 0; i < 8; ++i) { const int kk = 8 * i + rr; v[i] = (n0 + c4 < N && k0 + kk < K) ? *(const f32x4*)(W + (size_t)(k0 + kk) * N + n0 + c4) : (f32x4){0.f, 0.f, 0.f, 0.f}; }
#pragma unroll
    for (int i = 0; i < 8; ++i) { const int kk = 8 * i + rr; LAS float* d = scr + kk * 33 + c4; d[0] = v[i][0]; d[1] = v[i][1]; d[2] = v[i][2]; d[3] = v[i][3]; }
    asm volatile("s_waitcnt lgkmcnt(0)" ::: "memory");
    const int c = lane & 7;
#pragma unroll
    for (int j = 0; j < 4; ++j) { const int nl = (lane >> 3) + 8 * j; const LAS float* s = scr + (8 * c) * 33 + nl;
        u32x4 o; o.x = pkh(s[0 * 33], s[1 * 33]); o.y = pkh(s[2 * 33], s[3 * 33]); o.z = pkh(s[4 * 33], s[5 * 33]); o.w = pkh(s[6 * 33], s[7 * 33]);
        const int n = n0 + nl; int row;
        if (mode == 0) row = row_off + n; else row = (n >> 7) * 256 + (mode == 2 ? 128 : 0) + (n & 127);
        *(u32x4*)(WT + (size_t)row * ldk + koff + k0 + 8 * c) = o; }
    asm volatile("s_waitcnt lgkmcnt(0)" ::: "memory");
}

__device__ __forceinline__ void p0_prologue(const Args& a, LAS unsigned char* lds, int vcu, int G, int wave, int lane) {
    unsigned char* ws = a.ws;
    LAS float* scr = (LAS float*)(lds + wave * 16384);
    const int gw = vcu * NWAVES + wave, NGW = G * NWAVES;
    f16* Win = (f16*)(ws + WS_WIN); f16* Wcq = (f16*)(ws + WS_WCQ); f16* Wout = (f16*)(ws + WS_WOUT); f16* Wgu = (f16*)(ws + WS_WGU); f16* Wdn = (f16*)(ws + WS_WDN);
    constexpr int I_IN = (D / 64) * (IN_PAD / 32), I_IDX = (QL / 64) * (512 / 32), I_OR = (512 / 64) * (D / 32), I_G = (D / 64) * (DFF / 32), I_D = (DFF / 64) * (D / 32);
    constexpr int I_FQ = 4 * 64, I_FO = 16 * 64, I_MOD = 8 * 96, I_LD = 16, I_LG = 48;
    constexpr int NITEMS = I_IN + I_IDX + I_OR + 2 * I_G + I_D + I_FQ + I_FO + 2 * I_LD + I_LG;
    const bool split = (G == 256);
    const int gw2 = split ? (vcu - 96) * NWAVES + wave : gw, NGW2 = split ? (G - 96) * NWAVES : NGW;
    for (int it = gw2; it < NITEMS && gw2 >= 0; it += NGW2) {
        int r = it;
        if (r < I_IN) { p0_transpose_item(a.in[9], D, IN_COLS, IN_PAD, Win, D, 0, 0, 0, scr, r, lane); continue; } r -= I_IN;
        if (r < I_IDX) { p0_transpose_item(a.in[12], QL, 512, 512, Wcq, QL, 0, 1024, 0, scr, r, lane); continue; } r -= I_IDX;
        if (r < I_OR) { p0_transpose_item(a.in[28] + (size_t)512 * D, 512, D, D, Wout, KOUT, 1024, 0, 0, scr, r, lane); continue; } r -= I_OR;
        if (r < I_G) { p0_transpose_item(a.in[29], D, DFF, DFF, Wgu, D, 0, 0, 1, scr, r, lane); continue; } r -= I_G;
        if (r < I_G) { p0_transpose_item(a.in[30], D, DFF, DFF, Wgu, D, 0, 0, 2, scr, r, lane); continue; } r -= I_G;
        if (r < I_D) { p0_transpose_item(a.in[31], DFF, D, D, Wdn, DFF, 0, 0, 0, scr, r, lane); continue; } r -= I_D;
        if (r < I_FQ) {
            const int rb = r & 3, nb = r >> 2, rr = rb * 64 + lane, n0 = nb * 16, h = n0 >> 7;
            const float* uq = a.in[11] + (size_t)rr * 512 + h * 64; const float* uk = a.in[15] + (size_t)n0 * 64;
            float q[64];
#pragma unroll
            for (int d4 = 0; d4 < 16; ++d4) { const f32x4 v = *(const f32x4*)(uq + 4 * d4); q[4 * d4] = v[0]; q[4 * d4 + 1] = v[1]; q[4 * d4 + 2] = v[2]; q[4 * d4 + 3] = v[3]; }
#pragma unroll 4
            for (int i = 0; i < 16; ++i) { float s = 0.f;
#pragma unroll
                for (int d = 0; d < 64; ++d) s += q[d] * uk[i * 64 + d];
                Wcq[(size_t)(n0 + i) * QL + rr] = (f16)(0.125f * s); }
            continue; } r -= I_FQ;
        if (r < I_FO) {
            const int kb = r & 15, nb = r >> 4, k = kb * 64 + lane, h = kb >> 1, n0 = nb * 16;
            const float* uvp = a.in[16] + (size_t)k * 64; const float* wo = a.in[28] + (size_t)(h * 64) * D + n0;
            float uv[64];
#pragma unroll
            for (int d4 = 0; d4 < 16; ++d4) { const f32x4 v = *(const f32x4*)(uvp + 4 * d4); uv[4 * d4] = v[0]; uv[4 * d4 + 1] = v[1]; uv[4 * d4 + 2] = v[2]; uv[4 * d4 + 3] = v[3]; }
            float acc[16];
#pragma unroll
            for (int i = 0; i < 16; ++i) acc[i] = 0.f;
#pragma unroll
            for (int d = 0; d < 64; ++d) {
#pragma unroll
                for (int i = 0; i < 16; ++i) acc[i] += uv[d] * wo[(size_t)d * D + i]; }
#pragma unroll
            for (int i = 0; i < 16; ++i) Wout[(size_t)(n0 + i) * KOUT + k] = (f16)acc[i];
            continue; } r -= I_FO;
        if (r < I_LD) { p0_transpose_item(a.in[19], 64, 512, 512, (f16*)(ws + (28u << 20)), 64, 0, 0, 0, scr, r, lane); continue; } r -= I_LD;
        if (r < I_LD) { p0_transpose_item(a.in[21], 64, 512, 512, (f16*)(ws + (28u << 20) + 65536), 64, 0, 0, 0, scr, r, lane); continue; } r -= I_LD;
        { p0_transpose_item(a.in[22], 160, 512, 512, (f16*)(ws + (28u << 20) + 131072), 192, 0, 0, 0, scr, r, lane); }
    }
    if (vcu < 96) {
        __syncthreads();
        const int tid = wave * 64 + lane;
        for (int e = tid; e < 8 * D; e += 512) { const float cc = a.in[1][e]; *(LAS float*)(lds + (e >> 10) * 16384 + 10496 + (e & 1023) * 4) = cc * sigmoidf_(cc); }
        for (int cb = vcu; cb < 96; cb += G) {
            __syncthreads();
            const int j = cb * 64 + lane; const float* aw = a.in[3] + j;
            float acc[8];
#pragma unroll
            for (int b = 0; b < 8; ++b) acc[b] = 0.f;
            const int kbeg = wave * 128;
#pragma unroll 1
            for (int k0 = 0; k0 < 128; k0 += 16) {
                float wv[16];
#pragma unroll
                for (int i = 0; i < 16; ++i) wv[i] = aw[(size_t)(kbeg + k0 + i) * 6144];
#pragma unroll
                for (int b = 0; b < 8; ++b) {
#pragma unroll
                    for (int i4 = 0; i4 < 4; ++i4) { const f32x4 sv = *(const LAS f32x4*)(lds + b * 16384 + 10496 + (kbeg + k0 + 4 * i4) * 4);
                        acc[b] += sv[0] * wv[4 * i4] + sv[1] * wv[4 * i4 + 1] + sv[2] * wv[4 * i4 + 2] + sv[3] * wv[4 * i4 + 3]; } }
            }
#pragma unroll
            for (int b = 0; b < 8; ++b) *(LAS float*)(lds + wave * 16384 + 8448 + (b * 64 + lane) * 4) = acc[b];
            __syncthreads();
            float sum = 0.f;
#pragma unroll
            for (int w = 0; w < 8; ++w) sum += *(const LAS float*)(lds + w * 16384 + 8448 + (wave * 64 + lane) * 4);
            ((float*)(ws + WS_MOD))[wave * 6144 + j] = sum + a.in[4][j];
        }
    }
}

__device__ __forceinline__ void p1_modnorm(const Args& a, int vcu, int G, int wave, int lane) {
    const int gw = vcu * NWAVES + wave, NGW = G * NWAVES;
    const float* mod = (const float*)(a.ws + WS_MOD); f16* H = (f16*)(a.ws + WS_H);
    f32x4 gq[4];
#pragma unroll
    for (int j = 0; j < 4; ++j) gq[j] = *(const f32x4*)(a.in[5] + 4 * lane + 256 * j);
    f32x4 nv[4];
    if (gw < MTOK) {
#pragma unroll
        for (int j = 0; j < 4; ++j) nv[j] = __builtin_nontemporal_load((const f32x4*)(a.in[0] + (size_t)gw * D) + lane + 64 * j); }
    for (int m = gw; m < MTOK; m += NGW) {
        const int b = m >> 12;
        f32x4 v[4]; float s = 0.f;
#pragma unroll
        for (int j = 0; j < 4; ++j) { v[j] = nv[j]; s += (v[j][0] * v[j][0] + v[j][1] * v[j][1]) + (v[j][2] * v[j][2] + v[j][3] * v[j][3]); }
        const int mn = (m + NGW < MTOK) ? m + NGW : m;
#pragma unroll
        for (int j = 0; j < 4; ++j) nv[j] = __builtin_nontemporal_load((const f32x4*)(a.in[0] + (size_t)mn * D) + lane + 64 * j);
        const float r = rsqrtf(wave_sum(s) * (1.f / D) + NORM_EPS);
        u32x2* o = (u32x2*)(H + (size_t)m * D) + lane;
#pragma unroll
        for (int j = 0; j < 4; ++j) { const int c = 4 * lane + 256 * j;
            const f32x4 sh = *(const f32x4*)(mod + b * 6144 + c), sc = *(const f32x4*)(mod + b * 6144 + 1024 + c);
            f32x4 y;
#pragma unroll
            for (int e = 0; e < 4; ++e) y[e] = v[j][e] * r * gq[j][e] * (1.f + sc[e]) + sh[e];
            u32x2 w; w.x = pkh(y[0], y[1]); w.y = pkh(y[2], y[3]); o[64 * j] = w; }
    }
}

__device__ __forceinline__ void p3_rows(const Args& a, int vcu, int G, int wave, int lane) {
    const int gw = vcu * NWAVES + wave, NGW = G * NWAVES;
    unsigned char* ws = a.ws;
    const f16* PROJ = (const f16*)(ws + WS_PROJ);
    f16* CQ = (f16*)(ws + WS_CQ); f16* CKV = (f16*)(ws + WS_CKV); f16* IK16 = (f16*)(ws + WS_IK16); float* IW = (float*)(ws + WS_IW);
    for (int m = gw; m < MTOK; m += NGW) {
        const f16* pr = PROJ + (size_t)m * IN_PAD;
        const f16x4 q = *(const f16x4*)(pr + C_CQ + 4 * lane);
        const f16x2 kv = *(const f16x2*)(pr + C_CKV + 2 * lane);
        const float ik = (float)pr[C_IK + lane];
        float q0 = (float)q[0], q1 = (float)q[1], q2 = (float)q[2], q3 = (float)q[3], k0 = (float)kv[0], k1 = (float)kv[1];
        const float rq = rsqrtf(wave_sum(q0 * q0 + q1 * q1 + q2 * q2 + q3 * q3) * (1.f / QL) + NORM_EPS);
        const float rk = rsqrtf(wave_sum(k0 * k0 + k1 * k1) * (1.f / KVL) + NORM_EPS);
        const float ri = rsqrtf(wave_sum(ik * ik) * (1.f / IDXD) + NORM_EPS);
        const f32x4 gq = *(const f32x4*)(a.in[10] + 4 * lane); const f32x2 gk = *(const f32x2*)(a.in[13] + 2 * lane); const float gi = a.in[14][lane];
        u32x2 w; w.x = pkh(q0 * rq * gq[0], q1 * rq * gq[1]); w.y = pkh(q2 * rq * gq[2], q3 * rq * gq[3]);
        *(u32x2*)(CQ + (size_t)m * QL + 4 * lane) = w;
        ((unsigned short*)(ws + WS_CKV8))[(size_t)m * 64 + lane] = (unsigned short)__builtin_amdgcn_cvt_pk_fp8_f32(k0 * rk * gk[0], k1 * rk * gk[1], 0, false);
        const float ikn = ik * ri * gi;
        IK16[(size_t)m * IDXD + lane] = (f16)ikn;
        if (lane < 8) IW[(size_t)m * 8 + lane] = (float)pr[C_IW + lane] * 0.04419417382415922f;
    }
}
__device__ __forceinline__ void p3_rwkv_prep(const Args& a, LAS unsigned char* lds, int vcu, int G, int tid) {
    unsigned char* ws = a.ws;
    const f16* PROJ = (const f16*)(ws + WS_PROJ);
    f16* RWW = (f16*)(ws + WS_RWW); f16* RWA = (f16*)(ws + WS_RWA); f16* RWG = (f16*)(ws + WS_RWG);
    LAS float* xs = (LAS float*)lds;
    const float* mu = a.in[17];
    const int ch = tid;
    const float w0 = a.in[18][ch], a0 = a.in[20][ch];
    for (int u = vcu; u < MTOK / 16; u += G) {
        const int m0 = u * 16;
        __syncthreads();
        for (int e = tid; e < 16 * 288; e += 512) {
            const int t = e / 288, col = e % 288, m = m0 + t;
            const float cur = (float)PROJ[(size_t)m * IN_PAD + C_WD + col];
            const float prev = ((m & (SEQ - 1)) != 0) ? (float)PROJ[(size_t)(m - 1) * IN_PAD + C_WD + col] : 0.f;
            float v = cur + mu[1536 + col] * (prev - cur);
            if (col < 64) v = tanhf(v); else if (col >= 128) v = sigmoidf_(v);
            xs[t * 288 + col] = v;
        }
        __syncthreads();
        float dl[16], al[16], gl[16];
#pragma unroll
        for (int t = 0; t < 16; ++t) { dl[t] = 0.f; al[t] = 0.f; gl[t] = 0.f; }
        for (int kk = 0; kk < 64; ++kk) {
            const float wd = a.in[19][kk * 512 + ch], wa = a.in[21][kk * 512 + ch];
#pragma unroll
            for (int t = 0; t < 16; ++t) { dl[t] += xs[t * 288 + kk] * wd; al[t] += xs[t * 288 + 64 + kk] * wa; }
        }
        for (int kk = 0; kk < 160; ++kk) {
            const float wg = a.in[22][kk * 512 + ch];
#pragma unroll
            for (int t = 0; t < 16; ++t) gl[t] += xs[t * 288 + 128 + kk] * wg;
        }
#pragma unroll
        for (int t = 0; t < 16; ++t) {
            const float z = -(w0 + dl[t]);
            const float sp = z > 20.f ? z : log1pf(__expf(z));
            const float wlog = -sp - 0.5f;
            const float lw = -__expf(wlog);
            const float av = sigmoidf_(a0 + al[t]);
            const size_t o = (size_t)(m0 + t) * RW + ch;
            RWW[o] = (f16)lw; RWA[o] = (f16)av; RWG[o] = (f16)gl[t];
        }
    }
}

__device__ __forceinline__ unsigned f2key(float f) { const unsigned u = __builtin_bit_cast(unsigned, f); return (u & 0x80000000u) ? ~u : (u | 0x80000000u); }
__device__ __forceinline__ void p5_indexer(const Args& a, LAS unsigned char* lds, int vcu, int G, int wave, int lane) {
    unsigned char* ws = a.ws;
    const f16* QI = (const f16*)a.out;
    const float* IK32 = (const float*)(ws + WS_IK32); const float* IW = (const float*)(ws + WS_IW);
    unsigned short* SEL = (unsigned short*)(ws + WS_SEL);
    LAS float* sc = (LAS float*)(lds + wave * 16384);
    LAS float* iq = (LAS float*)(lds + AUX_OFF + wave * 2048);
    const int gw = vcu * NWAVES + wave, NGW = G * NWAVES;
    for (int q = gw; q < MTOK; q += NGW) {
        const int b = q >> 12, t = q & (SEQ - 1);
        unsigned short* sel = SEL + (size_t)q * TOPK;
        if (t < TOPK) {
#pragma unroll
            for (int j = 0; j < 4; ++j) { const int s = lane + 64 * j; sel[s] = (s <= t) ? (unsigned short)s : (unsigned short)0xFFFF; }
            continue;
        }
        { const f16x8 v = *(const f16x8*)(QI + (size_t)q * NQI + 1024 + 8 * lane);
#pragma unroll
          for (int e = 0; e < 8; ++e) iq[8 * lane + e] = (float)v[e]; }
        float wq[8];
#pragma unroll
        for (int h = 0; h < 8; ++h) wq[h] = IW[(size_t)q * 8 + h];
        asm volatile("s_waitcnt lgkmcnt(0)" ::: "memory");
        const int nj = (t >> 6) + 1;
        for (int j = 0; j < nj; ++j) {
            const int s = j * 64 + lane;
            const float* kr = IK32 + ((size_t)(b << 12) + (s <= t ? s : t)) * IDXD;
            float kx[64];
#pragma unroll
            for (int d4 = 0; d4 < 16; ++d4) { const f32x4 v = *(const f32x4*)(kr + 4 * d4); kx[4 * d4] = v[0]; kx[4 * d4 + 1] = v[1]; kx[4 * d4 + 2] = v[2]; kx[4 * d4 + 3] = v[3]; }
            float score = 0.f;
#pragma unroll
            for (int h = 0; h < 8; ++h) { float d0 = 0.f;
#pragma unroll
                for (int d4 = 0; d4 < 16; ++d4) { const f32x4 qv = *(const LAS f32x4*)(iq + h * 64 + 4 * d4); d0 += qv[0] * kx[4 * d4]; d0 += qv[1] * kx[4 * d4 + 1]; d0 += qv[2] * kx[4 * d4 + 2]; d0 += qv[3] * kx[4 * d4 + 3]; }
                score += wq[h] * fmaxf(d0, 0.f); }
            sc[s] = (s <= t) ? score : -INFINITY;
        }
        asm volatile("s_waitcnt lgkmcnt(0)" ::: "memory");
        const int nvalid = nj * 64;
        unsigned key[64];
#pragma unroll
        for (int j = 0; j < 64; ++j) { const int s = lane * 64 + j; key[j] = (s < nvalid) ? f2key(sc[s]) : 0u; }
        unsigned prefix = 0u;
        for (int bit = 31; bit >= 0; --bit) {
            const unsigned cand = prefix | (1u << bit);
            int c = 0;
#pragma unroll
            for (int j = 0; j < 64; ++j) c += (key[j] >= cand) ? 1 : 0;
#pragma unroll
            for (int o = 1; o < 64; o <<= 1) c += __shfl_xor(c, o);
            if (c >= TOPK) prefix = cand;
        }
        int cgt = 0, ceq = 0;
#pragma unroll
        for (int j = 0; j < 64; ++j) { cgt += (key[j] > prefix) ? 1 : 0; ceq += (key[j] == prefix) ? 1 : 0; }
        int sgt = cgt, seq = ceq;
#pragma unroll
        for (int o = 1; o < 64; o <<= 1) { const int x = __shfl_up(sgt, o), y = __shfl_up(seq, o); if (lane >= o) { sgt += x; seq += y; } }
        const int tot_gt = __shfl(sgt, 63);
        int pos_gt = sgt - cgt, rank_eq = seq - ceq;
        const int need = TOPK - tot_gt;
#pragma unroll
        for (int j = 0; j < 64; ++j) {
            const int s = lane * 64 + j;
            if (key[j] > prefix) { sel[pos_gt] = (unsigned short)s; ++pos_gt; }
            else if (key[j] == prefix) { if (rank_eq < need) sel[tot_gt + rank_eq] = (unsigned short)s; ++rank_eq; }
        }
    }
}

__device__ __forceinline__ int t5_bucket(int rel) {
    if (rel < 16) return rel;
    const int l = 16 + (int)(logf((float)rel * (1.f / 16.f)) / 2.0794415416798357f * 16.f);
    return l < 31 ? l : 31;
}
__device__ __forceinline__ void p6_attention(const Args& a, LAS unsigned char* lds, int vcu, int G, int wave, int lane) {
    unsigned char* ws = a.ws;
    const f16* QI = (const f16*)a.out; const f16* CKV = (const f16*)(ws + WS_CKV);
    const unsigned short* SEL = (const unsigned short*)(ws + WS_SEL);
    f16* OATT = (f16*)(ws + WS_OATT);
    const float* rel_bias = a.in[2];
    LAS float* qa = (LAS float*)(lds + wave * 16384);
    LAS float* pp = (LAS float*)(lds + wave * 16384 + 4096);
    LAS int* sidx = (LAS int*)(lds + wave * 16384 + 12288);
    const int gw = vcu * NWAVES + wave, NGW = G * NWAVES;
    for (int q = gw; q < MTOK; q += NGW) {
        const int b = q >> 12, t = q & (SEQ - 1);
#pragma unroll
        for (int i = 0; i < 2; ++i) { const f16x8 v = *(const f16x8*)(QI + (size_t)q * NQI + 512 * i + 8 * lane);
#pragma unroll
            for (int e = 0; e < 8; ++e) qa[512 * i + 8 * lane + e] = (float)v[e]; }
        asm volatile("s_waitcnt lgkmcnt(0)" ::: "memory");
        float lg[4][8];
        int srow[4]; bool okv[4];
#pragma unroll
        for (int i = 0; i < 4; ++i) {
            const int sraw = SEL[(size_t)q * TOPK + lane + 64 * i];
            okv[i] = sraw != 0xFFFF && sraw <= t;
            srow[i] = okv[i] ? sraw : 0;
            sidx[lane + 64 * i] = okv[i] ? sraw : -1;
#pragma unroll
            for (int h = 0; h < 8; ++h) lg[i][h] = 0.f;
        }
#pragma unroll 1
        for (int c8 = 0; c8 < 16; ++c8) {
            f16x8 kv[4];
#pragma unroll
            for (int i = 0; i < 4; ++i) kv[i] = *(const f16x8*)(CKV + ((size_t)(b << 12) + srow[i]) * KVL + 8 * c8);
#pragma unroll
            for (int h = 0; h < 8; ++h) {
                const f32x4 q0 = *(const LAS f32x4*)(qa + h * 128 + 8 * c8), q1 = *(const LAS f32x4*)(qa + h * 128 + 8 * c8 + 4);
#pragma unroll
                for (int i = 0; i < 4; ++i)
                    lg[i][h] += q0[0] * (float)kv[i][0] + q0[1] * (float)kv[i][1] + q0[2] * (float)kv[i][2] + q0[3] * (float)kv[i][3] + q1[0] * (float)kv[i][4] + q1[1] * (float)kv[i][5] + q1[2] * (float)kv[i][6] + q1[3] * (float)kv[i][7];
            }
        }
#pragma unroll
        for (int i = 0; i < 4; ++i) {
            const int bk = t5_bucket(t - srow[i]);
#pragma unroll
            for (int h = 0; h < 8; ++h) lg[i][h] = okv[i] ? lg[i][h] + rel_bias[bk * 8 + h] : -INFINITY;
        }
#pragma unroll
        for (int h = 0; h < 8; ++h) {
            float mx = fmaxf(fmaxf(lg[0][h], lg[1][h]), fmaxf(lg[2][h], lg[3][h]));
#pragma unroll
            for (int o = 1; o < 64; o <<= 1) mx = fmaxf(mx, __shfl_xor(mx, o));
            float e[4], s = 0.f;
#pragma unroll
            for (int i = 0; i < 4; ++i) { e[i] = __expf(lg[i][h] - mx); s += e[i]; }
            s = wave_sum(s);
            const float inv = 1.f / s;
#pragma unroll
            for (int i = 0; i < 4; ++i) pp[h * 256 + lane + 64 * i] = e[i] * inv;
        }
        asm volatile("s_waitcnt lgkmcnt(0)" ::: "memory");
        float o0[8], o1[8];
#pragma unroll
        for (int h = 0; h < 8; ++h) { o0[h] = 0.f; o1[h] = 0.f; }
        for (int kk = 0; kk < TOPK; ++kk) {
            const int s = sidx[kk];
            if (s < 0) continue;
            const f16x2 kv = *(const f16x2*)(CKV + ((size_t)(b << 12) + s) * KVL + 2 * lane);
            const float v0 = (float)kv[0], v1 = (float)kv[1];
#pragma unroll
            for (int h = 0; h < 8; ++h) { const float p = pp[h * 256 + kk]; o0[h] += p * v0; o1[h] += p * v1; }
        }
#pragma unroll
        for (int h = 0; h < 8; ++h) *(unsigned*)(OATT + (size_t)q * KOUT + h * 128 + 2 * lane) = pkh(o0[h], o1[h]);
        asm volatile("s_waitcnt lgkmcnt(0)" ::: "memory");
    }
}

constexpr int SC_PITCH = 8224, DSA_SEL_OFF = 16 * SC_PITCH, DSA_BL_OFF = DSA_SEL_OFF + 8192, DSA_HIST_OFF = 143936;
static_assert(DSA_BL_OFF + 129 * 8 * 4 <= DSA_HIST_OFF && DSA_HIST_OFF + 8 * 2304 <= MISC_OFF, "DSA LDS map");
typedef short v4i16_t __attribute__((ext_vector_type(4)));
__device__ __forceinline__ unsigned kv_off(unsigned row, unsigned ch) { return 256u * row + 16u * (ch ^ (((row & 3u) << 2) | ((row >> 2) & 3u))); }
__device__ __forceinline__ f16x4 tr_read16(LAS unsigned char* p) { return __builtin_bit_cast(f16x4, __builtin_amdgcn_ds_read_tr16_b64_v4i16((LAS v4i16_t*)p)); }
template <int CTRL, int RMASK> __device__ __forceinline__ int dpp_i(int x) { return __builtin_amdgcn_update_dpp(0, x, CTRL, RMASK, 0xF, false); }
template <int CTRL> __device__ __forceinline__ int dpp_iz(int x) { return __builtin_amdgcn_update_dpp(0, x, CTRL, 0xF, 0xF, true); }
__device__ __forceinline__ int wave_incl_scan_i(int x) { x += dpp_iz<0x111>(x); x += dpp_iz<0x112>(x); x += dpp_iz<0x114>(x); x += dpp_iz<0x118>(x);
    x += dpp_i<0x142, 0xA>(x); x += dpp_i<0x143, 0xC>(x); return x; }
__device__ __forceinline__ void p5_dsa(const Args& a, LAS unsigned char* lds, int G, int bx, int tid, int wave, int lane) {
    unsigned char* ws = a.ws;
    const f16* QI = (const f16*)a.out; const f16* IK16 = (const f16*)(ws + WS_IK16); const float* IW = (const float*)(ws + WS_IW);
    const f16* CKV = (const f16*)(ws + WS_CKV); f16* OATT = (f16*)(ws + WS_OATT);
    LAS unsigned short* SELL = (LAS unsigned short*)(lds + DSA_SEL_OFF);
    LAS float* BL = (LAS float*)(lds + DSA_BL_OFF);
    for (int e = tid; e < 129 * 8; e += 512) { const int rel = e >> 3, h = e & 7; BL[e] = a.in[2][t5_bucket(rel) * 8 + h] * 1.4426950408889634f; }
    const int nunits = BATCH * (SEQ / 16);
    const bool balanced = (G == 256);
    const int niter = balanced ? 8 : (nunits + G - 1) / G;
#pragma unroll 1
    for (int it = 0; it < niter; ++it) {
        int b, tile;
        if (balanced) { b = bx & 7; const int r = bx >> 3, base = 64 * (it >> 1); tile = (it & 1) ? base + 63 - r : base + r; }
        else { const int u = it * G + bx; if (u >= nunits) break; b = u >> 8; tile = u & 255; }
        int lane_o = lane; asm volatile("" : "+v"(lane_o));
        const int r16 = lane_o & 15, g = lane_o >> 4;
        const int t0 = tile * 16;
        const size_t qb = (size_t)(b << 12);
        const int jn = ((t0 + 15) >> 7) + 1;
        lds_barrier();
#ifndef DSAREP
#define DSAREP 0
#endif
#ifndef DSA_NO_A
        for (int ra_ = 0; ra_ < ((DSAREP & 1) ? 2 : 1); ++ra_)
        if (t0 + 15 >= TOPK) {
            f16x8 afr[8][2]; f32x4 wv[4][2];
#pragma unroll
            for (int mt = 0; mt < 8; ++mt) { const int tg = mt >> 1, hf = mt & 1, t = t0 + 4 * tg + (r16 >> 2), h = 4 * hf + (r16 & 3);
#pragma unroll
                for (int ks = 0; ks < 2; ++ks) afr[mt][ks] = *(const f16x8*)(QI + (qb + t) * NQI + 1024 + h * 64 + 32 * ks + 8 * g); }
#pragma unroll
            for (int tg = 0; tg < 4; ++tg)
#pragma unroll
                for (int hf = 0; hf < 2; ++hf) wv[tg][hf] = *(const f32x4*)(IW + (qb + t0 + 4 * tg + g) * 8 + 4 * hf) * 65536.0f;
            const f32x2 cscale = {1.52587890625e-05f, 1.52587890625e-05f};
            f16x8 bn0[2], bn1[2], bn2[2];
            const f16* ikp = IK16 + (qb + 16 * wave + r16) * IDXD + 8 * g;
#define A_LOAD(BN, j_) do { const f16* p_ = ikp + (size_t)(128 * (j_)) * IDXD; asm volatile("global_load_dwordx4 %0, %2, off\n\tglobal_load_dwordx4 %1, %2, off offset:64" : "=&v"(BN[0]), "=&v"(BN[1]) : "v"(p_) : "memory"); } while (0)
#define A_WAIT(BN) asm volatile("s_waitcnt vmcnt(4)" : "+v"(BN[0]), "+v"(BN[1]) :: "memory")
#define A_STEP(BN, j_) do { const int j = (j_); const int s = 128 * j + 16 * wave + r16; A_WAIT(BN); f16x8 bfr[2]; bfr[0] = BN[0]; bfr[1] = BN[1]; \
                f32x4 acc[8]; \
_Pragma("unroll") \
                for (int mt = 0; mt < 8; ++mt) { acc[mt] = __builtin_amdgcn_mfma_f32_16x16x32_f16(afr[mt][0], bfr[0], (f32x4){0.f, 0.f, 0.f, 0.f}, 0, 0, 0); \
                    acc[mt] = __builtin_amdgcn_mfma_f32_16x16x32_f16(afr[mt][1], bfr[1], acc[mt], 0, 0, 0); } \
                asm volatile("s_nop 15\n\ts_nop 7" :: "v"(acc[0]), "v"(acc[1]), "v"(acc[2]), "v"(acc[3]), "v"(acc[4]), "v"(acc[5]), "v"(acc[6]), "v"(acc[7])); \
                float scv[4]; \
_Pragma("unroll") \
                for (int tg = 0; tg < 4; ++tg) { f32x2 s2 = {0.f, 0.f}; \
_Pragma("unroll") \
                    for (int hf = 0; hf < 2; ++hf) \
_Pragma("unroll") \
                        for (int p = 0; p < 2; ++p) { const f32x2 av = {acc[2 * tg + hf][2 * p], acc[2 * tg + hf][2 * p + 1]}; f32x2 r; \
                            asm volatile("v_pk_mul_f32 %0, %1, %2 clamp" : "=v"(r) : "v"(av), "v"(cscale)); \
                            const f32x2 wp = {wv[tg][hf][2 * p], wv[tg][hf][2 * p + 1]}; s2 = r * wp + s2; } \
                    scv[tg] = s2[0] + s2[1]; } \
                if (j == jn - 1) { \
_Pragma("unroll") \
                    for (int tg = 0; tg < 4; ++tg) if (s > t0 + 4 * tg + g) scv[tg] = -INFINITY; } \
_Pragma("unroll") \
                for (int pr = 0; pr < 2; ++pr) { \
                    const unsigned x = pkh(scv[2 * pr], scv[2 * pr + 1]); \
                    const unsigned k2 = x ^ ((((x >> 15) & 0x00010001u) * 0x7FFFu) | 0x80008000u); \
                    *(LAS unsigned short*)(lds + (4 * (2 * pr) + g) * SC_PITCH + s * 2) = (unsigned short)(k2 & 0xFFFFu); \
                    *(LAS unsigned short*)(lds + (4 * (2 * pr + 1) + g) * SC_PITCH + s * 2) = (unsigned short)(k2 >> 16); } \
                A_LOAD(BN, (j + 3 < jn) ? j + 3 : jn - 1); } while (0)
            A_LOAD(bn0, 0); A_LOAD(bn1, (jn > 1) ? 1 : 0); A_LOAD(bn2, (jn > 2) ? 2 : jn - 1);
#pragma unroll 1
            for (int j3 = 0; j3 < jn; j3 += 3) { A_STEP(bn0, j3); if (j3 + 1 < jn) A_STEP(bn1, j3 + 1); if (j3 + 2 < jn) A_STEP(bn2, j3 + 2); }
            asm volatile("s_waitcnt vmcnt(0)" : "+v"(bn0[0]), "+v"(bn0[1]), "+v"(bn1[0]), "+v"(bn1[1]), "+v"(bn2[0]), "+v"(bn2[1]) :: "memory");
#undef A_LOAD
#undef A_WAIT
#undef A_STEP
        }
#endif
        __builtin_amdgcn_sched_barrier(0); lds_barrier(); __builtin_amdgcn_sched_barrier(0);
#ifndef DSA_NO_C
        {
            const int rlA = 2 * wave, rlB = 2 * wave + 1, tA = t0 + rlA, tB = t0 + rlB;
            LAS unsigned short* selA = SELL + rlA * 256; LAS unsigned short* selB = SELL + rlB * 256;
            if (tA < TOPK) {
#pragma unroll
                for (int k = 0; k < 4; ++k) { const int jx = lane_o + 64 * k; selA[jx] = (jx <= tA) ? (unsigned short)jx : (unsigned short)0xFFFF; selB[jx] = (jx <= tB) ? (unsigned short)jx : (unsigned short)0xFFFF; }
            } else {
                const LAS unsigned* srA = (const LAS unsigned*)(lds + rlA * SC_PITCH) + lane_o; const LAS unsigned* srB = (const LAS unsigned*)(lds + rlB * SC_PITCH) + lane_o;
                LAS unsigned* hA = (LAS unsigned*)(lds + DSA_HIST_OFF + wave * 2304); LAS unsigned* hB = hA + 256; LAS unsigned* hD = hA + 512;
                unsigned pfA = 0u, pfB = 0u; int knA = TOPK, knB = TOPK;
#pragma unroll 1
                for (int pass = 0; pass < 2; ++pass) {
                    *(LAS u32x4*)(hA + 4 * lane_o) = (u32x4){0u, 0u, 0u, 0u}; *(LAS u32x4*)(hB + 4 * lane_o) = (u32x4){0u, 0u, 0u, 0u};
                    asm volatile("s_waitcnt lgkmcnt(0)" ::: "memory");
                    if (pass == 0) {
#pragma unroll 4
                        for (int jj = 0; jj < jn; ++jj) { const unsigned ka = srA[jj * 64], kb_ = srB[jj * 64];
                            __hip_atomic_fetch_add(hA + (ka >> 24), 1u, __ATOMIC_RELAXED, __HIP_MEMORY_SCOPE_WORKGROUP); __hip_atomic_fetch_add(hB + (kb_ >> 24), 1u, __ATOMIC_RELAXED, __HIP_MEMORY_SCOPE_WORKGROUP);
                            __hip_atomic_fetch_add(hA + ((ka >> 8) & 0xFFu), 1u, __ATOMIC_RELAXED, __HIP_MEMORY_SCOPE_WORKGROUP); __hip_atomic_fetch_add(hB + ((kb_ >> 8) & 0xFFu), 1u, __ATOMIC_RELAXED, __HIP_MEMORY_SCOPE_WORKGROUP); }
                    } else {
                        LAS unsigned* dmp = hD + lane_o;
#pragma unroll 4
                        for (int jj = 0; jj < jn; ++jj) { const unsigned ka = srA[jj * 64], kb_ = srB[jj * 64];
                            __hip_atomic_fetch_add(((ka >> 24) == pfA) ? hA + ((ka >> 16) & 0xFFu) : dmp, 1u, __ATOMIC_RELAXED, __HIP_MEMORY_SCOPE_WORKGROUP);
                            __hip_atomic_fetch_add(((kb_ >> 24) == pfB) ? hB + ((kb_ >> 16) & 0xFFu) : dmp, 1u, __ATOMIC_RELAXED, __HIP_MEMORY_SCOPE_WORKGROUP);
                            __hip_atomic_fetch_add((((ka >> 8) & 0xFFu) == pfA) ? hA + (ka & 0xFFu) : dmp, 1u, __ATOMIC_RELAXED, __HIP_MEMORY_SCOPE_WORKGROUP);
                            __hip_atomic_fetch_add((((kb_ >> 8) & 0xFFu) == pfB) ? hB + (kb_ & 0xFFu) : dmp, 1u, __ATOMIC_RELAXED, __HIP_MEMORY_SCOPE_WORKGROUP); }
                    }
                    asm volatile("s_waitcnt lgkmcnt(0)" ::: "memory");
#define DSA_FIND(H, PF, KN) do { const u32x4 hv = *(const LAS u32x4*)(H + 4 * lane_o); const int sl = (int)(hv.x + hv.y + hv.z + hv.w); \
                        const int pre = wave_incl_scan_i(sl); const int tot = __builtin_amdgcn_readlane(pre, 63); const int S = tot - pre + sl; const int excl = S - sl; \
                        const unsigned long long bm = __ballot(excl < KN && S >= KN); const int L = bm ? (int)__builtin_ctzll(bm) : 0; \
                        const int ex = __builtin_amdgcn_readlane(excl, L); const int h1 = __builtin_amdgcn_readlane((int)hv.y, L), h2 = __builtin_amdgcn_readlane((int)hv.z, L), h3 = __builtin_amdgcn_readlane((int)hv.w, L); \
                        int cabove = ex, bin; \
                        if (cabove + h3 >= KN) bin = 3; else { cabove += h3; if (cabove + h2 >= KN) bin = 2; else { cabove += h2; if (cabove + h1 >= KN) bin = 1; else { cabove += h1; bin = 0; } } } \
                        PF = (PF << 8) | (unsigned)(4 * L + bin); KN -= cabove; } while (0)
                    DSA_FIND(hA, pfA, knA); DSA_FIND(hB, pfB, knB);
#undef DSA_FIND
                }
                const unsigned loA = pfA << 16, hiA = (pfA + 1u) << 16, loB = pfB << 16, hiB = (pfB + 1u) << 16;
                const int tgA = TOPK - knA, tgB = TOPK - knB;
                LAS unsigned short* dumpp = (LAS unsigned short*)hD + lane_o;
                int baseA = 0, tbA = 0, baseB = 0, tbB = 0;
#define DSA_EMIT(K, SEL, LO, HI, BASE, TB, TG, KN) do { const unsigned kq_ = (K) << 16; const bool g0 = kq_ >= HI, g1 = (K) >= HI; \
                    const unsigned long long m0 = __ballot(g0), m1 = __ballot(g1); \
                    const int p0 = BASE + (int)__builtin_amdgcn_mbcnt_hi((unsigned)(m0 >> 32), __builtin_amdgcn_mbcnt_lo((unsigned)m0, 0u)); BASE += __popcll(m0); \
                    const int p1 = BASE + (int)__builtin_amdgcn_mbcnt_hi((unsigned)(m1 >> 32), __builtin_amdgcn_mbcnt_lo((unsigned)m1, 0u)); BASE += __popcll(m1); \
                    *(g0 ? SEL + p0 : dumpp) = (unsigned short)s0; *(g1 ? SEL + p1 : dumpp) = (unsigned short)(s0 + 1); \
                    const bool e0 = (kq_ >= LO) && !g0, e1 = ((K) >= LO) && !g1; const unsigned long long t0m = __ballot(e0), t1m = __ballot(e1); \
                    if (t0m | t1m) { const int r0 = TB + (int)__builtin_amdgcn_mbcnt_hi((unsigned)(t0m >> 32), __builtin_amdgcn_mbcnt_lo((unsigned)t0m, 0u)); TB += __popcll(t0m); \
                        const int r1 = TB + (int)__builtin_amdgcn_mbcnt_hi((unsigned)(t1m >> 32), __builtin_amdgcn_mbcnt_lo((unsigned)t1m, 0u)); TB += __popcll(t1m); \
                        if (e0 && r0 < KN) SEL[TG + r0] = (unsigned short)s0; if (e1 && r1 < KN) SEL[TG + r1] = (unsigned short)(s0 + 1); } } while (0)
#pragma unroll 2
                for (int jj = 0; jj < jn; ++jj) { const unsigned ka = srA[jj * 64], kb2 = srB[jj * 64]; const int s0 = 2 * (jj * 64 + lane_o);
                    DSA_EMIT(ka, selA, loA, hiA, baseA, tbA, tgA, knA); DSA_EMIT(kb2, selB, loB, hiB, baseB, tbB, tgB, knB); }
#undef DSA_EMIT
            }
        }
#endif
        __builtin_amdgcn_sched_barrier(0); lds_barrier(); __builtin_amdgcn_sched_barrier(0);
#ifndef DSA_NO_D
        LAS unsigned char* kvb = lds + wave * 16384;
        const unsigned char* CKV8 = ws + WS_CKV8;
#pragma unroll 1
        for (int rr = 0; rr < ((DSAREP & 4) ? 4 : 2); ++rr) {
            const int rl = 2 * wave + (rr & 1), t = t0 + rl; const size_t q = qb + t;
            const LAS unsigned short* sel = SELL + rl * 256;
            long qf8[4];
#pragma unroll
            for (int ks = 0; ks < 4; ++ks) { const f16x8 v = *(const f16x8*)(QI + q * NQI + (r16 & 7) * 128 + 32 * ks + 8 * g); const float zs = (r16 >= 8) ? 0.f : 64.f;
                int lo32 = __builtin_amdgcn_cvt_pk_fp8_f32((float)v[0] * zs, (float)v[1] * zs, 0, false); lo32 = __builtin_amdgcn_cvt_pk_fp8_f32((float)v[2] * zs, (float)v[3] * zs, lo32, true);
                int hi32 = __builtin_amdgcn_cvt_pk_fp8_f32((float)v[4] * zs, (float)v[5] * zs, 0, false); hi32 = __builtin_amdgcn_cvt_pk_fp8_f32((float)v[6] * zs, (float)v[7] * zs, hi32, true);
                qf8[ks] = (long)(((unsigned long long)(unsigned)hi32 << 32) | (unsigned)lo32); }
            const LAS float* BLh = BL + (r16 & 7);
            float m_run = -1e30f, l_run = 0.f;
            f32x4 oE[4], oO[4];
#pragma unroll
            for (int cb = 0; cb < 4; ++cb) { oE[cb] = (f32x4){0.f, 0.f, 0.f, 0.f}; oO[cb] = (f32x4){0.f, 0.f, 0.f, 0.f}; }
            const int nch = (t < TOPK) ? (t >> 6) + 1 : 4;
#define DSA_DMA(ch_) do { unsigned so_[8]; _Pragma("unroll") for (int i = 0; i < 8; ++i) { const int R = 8 * i + (lane_o >> 3); \
                const unsigned ix = sel[64 * (ch_) + R]; const unsigned srow = (ix == 0xFFFFu) ? 0u : ix; so_[i] = srow * 128u + 16u * (((unsigned)lane_o & 7u) ^ ((unsigned)R & 7u)); } \
            _Pragma("unroll") for (int i = 0; i < 8; ++i) __builtin_amdgcn_global_load_lds((const unsigned*)(ckvb + so_[i]), (LAS unsigned*)(kvb + i * 1024), 16, 0, 0); } while (0)
            const unsigned char* ckvb = CKV8 + qb * 128;
            asm volatile("s_waitcnt vmcnt(0)" ::: "memory");
            DSA_DMA(0);
            const int qq = (lane_o & 15) >> 2, pp = lane_o & 3;
            unsigned offA[4][4], offT[4][2][2];
#pragma unroll
            for (int mt = 0; mt < 4; ++mt) { const int row = 16 * mt + r16;
#pragma unroll
                for (int ks = 0; ks < 4; ++ks) offA[mt][ks] = row * 128 + 16 * ((2 * ks + (g >> 1)) ^ (row & 7)) + 8 * (g & 1); }
#pragma unroll
            for (int cb = 0; cb < 4; ++cb)
#pragma unroll
                for (int k2 = 0; k2 < 2; ++k2) { const int r1 = 32 * k2 + 4 * g + qq, r2 = r1 + 16;
                    offT[cb][k2][0] = r1 * 128 + 16 * ((2 * cb + (pp >> 1)) ^ (r1 & 7)) + 8 * (pp & 1); offT[cb][k2][1] = r2 * 128 + 16 * ((2 * cb + (pp >> 1)) ^ (r2 & 7)) + 8 * (pp & 1); }
#define DSA_CHUNK(CHK) do { \
                asm volatile("s_waitcnt vmcnt(0)" ::: "memory"); \
                long af[4][4]; u32x2 td[4][2][2]; \
                _Pragma("unroll") for (int mt = 0; mt < 4; ++mt) \
                    _Pragma("unroll") for (int ks = 0; ks < 4; ++ks) af[mt][ks] = *(const LAS long*)(kvb + offA[mt][ks]); \
                _Pragma("unroll") for (int cb = 0; cb < 4; ++cb) \
                    _Pragma("unroll") for (int k2 = 0; k2 < 2; ++k2) { td[cb][k2][0] = __builtin_bit_cast(u32x2, tr_read16(kvb + offT[cb][k2][0])); td[cb][k2][1] = __builtin_bit_cast(u32x2, tr_read16(kvb + offT[cb][k2][1])); } \
                float bvv[4][4]; bool inv4[4][4]; \
                _Pragma("unroll") for (int mt = 0; mt < 4; ++mt) { const u32x2 pk2 = *(const LAS u32x2*)(sel + 64 * ch + 16 * mt + 4 * g); \
                    _Pragma("unroll") for (int e = 0; e < 4; ++e) { const unsigned ix = ((e & 2) ? pk2.y : pk2.x) >> ((e & 1) * 16) & 0xFFFFu; \
                        const int rel = t - (int)ix; const int rc = (CHK) ? min(max(rel, 0), 128) : min(rel, 128); \
                        inv4[mt][e] = (CHK) && (ix == 0xFFFFu); bvv[mt][e] = BLh[rc * 8]; } } \
                asm volatile("s_waitcnt lgkmcnt(0)" : "+v"(bvv[0][0]), "+v"(bvv[0][1]), "+v"(bvv[0][2]), "+v"(bvv[0][3]), "+v"(bvv[1][0]), "+v"(bvv[1][1]), "+v"(bvv[1][2]), "+v"(bvv[1][3]), \
                             "+v"(bvv[2][0]), "+v"(bvv[2][1]), "+v"(bvv[2][2]), "+v"(bvv[2][3]), "+v"(bvv[3][0]), "+v"(bvv[3][1]), "+v"(bvv[3][2]), "+v"(bvv[3][3]) :: "memory"); \
                if (ch + 1 < nch) DSA_DMA(ch + 1); \
                f32x4 lg[4]; \
                _Pragma("unroll") for (int mt = 0; mt < 4; ++mt) { lg[mt] = (f32x4){0.f, 0.f, 0.f, 0.f}; \
                    _Pragma("unroll") for (int ks = 0; ks < 4; ++ks) lg[mt] = __builtin_amdgcn_mfma_f32_16x16x32_fp8_fp8(af[mt][ks], qf8[ks], lg[mt], 0, 0, 0); } \
                float cmax = -INFINITY; \
                _Pragma("unroll") for (int mt = 0; mt < 4; ++mt) \
                    _Pragma("unroll") for (int e = 0; e < 4; ++e) { const float v = inv4[mt][e] ? -INFINITY : lg[mt][e] * 0.02254211001388847f + bvv[mt][e]; lg[mt][e] = v; cmax = fmaxf(cmax, v); } \
                cmax = fmaxf(cmax, __shfl_xor(cmax, 16)); cmax = fmaxf(cmax, __shfl_xor(cmax, 32)); \
                const float m_new = fmaxf(m_run, cmax); const float alpha = __builtin_amdgcn_exp2f(m_run - m_new); m_run = m_new; \
                float ps = 0.f; long pf8[2]; \
                _Pragma("unroll") for (int k2 = 0; k2 < 2; ++k2) { float pv[8]; \
                    _Pragma("unroll") for (int mt = 0; mt < 2; ++mt) \
                        _Pragma("unroll") for (int e = 0; e < 4; ++e) { const float p = __builtin_amdgcn_exp2f(lg[2 * k2 + mt][e] - m_new); ps += p; pv[mt * 4 + e] = p; } \
                    int plo = __builtin_amdgcn_cvt_pk_fp8_f32(pv[0], pv[1], 0, false); plo = __builtin_amdgcn_cvt_pk_fp8_f32(pv[2], pv[3], plo, true); \
                    int phi = __builtin_amdgcn_cvt_pk_fp8_f32(pv[4], pv[5], 0, false); phi = __builtin_amdgcn_cvt_pk_fp8_f32(pv[6], pv[7], phi, true); \
                    pf8[k2] = (long)(((unsigned long long)(unsigned)phi << 32) | (unsigned)plo); } \
                l_run = l_run * alpha + ps; \
                if (__ballot(alpha != 1.f) != 0ull) { _Pragma("unroll") for (int cb = 0; cb < 4; ++cb) { oE[cb] *= alpha; oO[cb] *= alpha; } } \
                _Pragma("unroll") for (int cb = 0; cb < 4; ++cb) \
                    _Pragma("unroll") for (int k2 = 0; k2 < 2; ++k2) { \
                        const u32x2 d1 = td[cb][k2][0], d2 = td[cb][k2][1]; \
                        const unsigned xe0 = __builtin_amdgcn_perm(d1.y, d1.x, 0x06040200u), xo0 = __builtin_amdgcn_perm(d1.y, d1.x, 0x07050301u); \
                        const unsigned xe1 = __builtin_amdgcn_perm(d2.y, d2.x, 0x06040200u), xo1 = __builtin_amdgcn_perm(d2.y, d2.x, 0x07050301u); \
                        oE[cb] = __builtin_amdgcn_mfma_f32_16x16x32_fp8_fp8((long)(((unsigned long long)xe1 << 32) | xe0), pf8[k2], oE[cb], 0, 0, 0); \
                        oO[cb] = __builtin_amdgcn_mfma_f32_16x16x32_fp8_fp8((long)(((unsigned long long)xo1 << 32) | xo0), pf8[k2], oO[cb], 0, 0, 0); } } while (0)
            if (t < TOPK) {
#pragma unroll 1
                for (int ch = 0; ch < nch; ++ch) DSA_CHUNK(1);
            } else {
#pragma unroll 1
                for (int ch = 0; ch < nch; ++ch) DSA_CHUNK(0);
            }
#undef DSA_CHUNK
#undef DSA_DMA
            l_run += __shfl_xor(l_run, 16); l_run += __shfl_xor(l_run, 32);
            const float inv = 1.f / l_run;
            if (r16 < 8) {
#pragma unroll
                for (int cb = 0; cb < 4; ++cb) { u32x4 w; w.x = pkh(oE[cb][0] * inv, oO[cb][0] * inv); w.y = pkh(oE[cb][1] * inv, oO[cb][1] * inv); w.z = pkh(oE[cb][2] * inv, oO[cb][2] * inv); w.w = pkh(oE[cb][3] * inv, oO[cb][3] * inv);
                    *(u32x4*)(OATT + q * KOUT + r16 * 128 + 32 * cb + 8 * g) = w; }
            }
        }
#endif
    }
}

template <int CTRL> __device__ __forceinline__ float dpp_f(float x) { return __builtin_bit_cast(float, __builtin_amdgcn_update_dpp(0, __builtin_bit_cast(int, x), CTRL, 0xF, 0xF, false)); }
__device__ __forceinline__ float row16_sum(float x) { x += dpp_f<0x128>(x); x += dpp_f<0x124>(x); x += dpp_f<0x122>(x); x += dpp_f<0x121>(x); return x; }
constexpr int SCAN_TB = 32;
__device__ __forceinline__ void p7_scan(const Args& a, LAS unsigned char* lds, int vcu, int G, int wave, int lane) {
    unsigned char* ws = a.ws;
    const f16* PROJ = (const f16*)(ws + WS_PROJ); const f16* RWW = (const f16*)(ws + WS_RWW); const f16* RWA = (const f16*)(ws + WS_RWA);
    float* YRAW = (float*)(ws + WS_YRAW);
    for (int u = vcu; u < BATCH * HRW * 2; u += G) {
        const int half = u & 1, h = (u >> 1) & 7, b = u >> 4;
        const int ch = h * 64 + lane;
        const float mu_r = a.in[17][ch], mu_k = a.in[17][512 + ch], mu_v = a.in[17][1024 + ch], kkc = a.in[23][ch], kac = a.in[24][ch];
        const int rr = lane >> 4, qd = lane & 15, irow = half * 32 + wave * 4 + rr;
        float S0 = 0.f, S1 = 0.f, S2 = 0.f, S3 = 0.f;
#define SCAN_LOAD(blk_) do { _Pragma("unroll") for (int tt = 0; tt < 4; ++tt) { const int t = (blk_) * SCAN_TB + wave * 4 + tt; const size_t m = (size_t)(b << 12) + t; \
            const f16* pr = PROJ + m * IN_PAD + h * 64 + lane; \
            st_r[tt] = (float)pr[C_R]; st_k[tt] = (float)pr[C_K]; st_v[tt] = (float)pr[C_V]; \
            if (t > 0) { st_rp[tt] = (float)pr[C_R - IN_PAD]; st_kp[tt] = (float)pr[C_K - IN_PAD]; st_vp[tt] = (float)pr[C_V - IN_PAD]; } else { st_rp[tt] = 0.f; st_kp[tt] = 0.f; st_vp[tt] = 0.f; } \
            st_lw[tt] = (float)RWW[m * RW + ch]; st_av[tt] = (float)RWA[m * RW + ch]; } } while (0)
#define SCAN_WRITE(buf_) do { LAS float* base_ = (LAS float*)(lds + (buf_) * 49152); _Pragma("unroll") for (int tt = 0; tt < 4; ++tt) { const int tl = wave * 4 + tt; \
            const float rs = st_r[tt] + mu_r * (st_rp[tt] - st_r[tt]), ks = st_k[tt] + mu_k * (st_kp[tt] - st_k[tt]), vs = st_v[tt] + mu_v * (st_vp[tt] - st_v[tt]); \
            const float kkv = ks * kkc; const float nrm = sqrtf(wave_sum(kkv * kkv)); const float kkn = kkv / fmaxf(nrm, 1e-12f); \
            const float av = st_av[tt]; const float km = ks * (1.f + (av - 1.f) * kac); \
            base_[0 * 2048 + tl * 64 + lane] = rs; base_[1 * 2048 + tl * 64 + lane] = __expf(st_lw[tt]); base_[2 * 2048 + tl * 64 + lane] = km; \
            base_[3 * 2048 + tl * 64 + lane] = vs; base_[4 * 2048 + tl * 64 + lane] = -kkn; base_[5 * 2048 + tl * 64 + lane] = kkn * av; } } while (0)
        float st_r[4], st_k[4], st_v[4], st_rp[4], st_kp[4], st_vp[4], st_lw[4], st_av[4];
        __syncthreads();
        SCAN_LOAD(0); SCAN_WRITE(0);
        constexpr int NBLK = SEQ / SCAN_TB;
        for (int blk = 0; blk < NBLK; ++blk) {
            __syncthreads();
            if (blk + 1 < NBLK) SCAN_LOAD(blk + 1);
            const LAS float* base = (const LAS float*)(lds + (blk & 1) * 49152);
            for (int tl = 0; tl < SCAN_TB; ++tl) {
                const f32x4 r4 = *(const LAS f32x4*)(base + 0 * 2048 + tl * 64 + 4 * qd), w4 = *(const LAS f32x4*)(base + 1 * 2048 + tl * 64 + 4 * qd), k4 = *(const LAS f32x4*)(base + 2 * 2048 + tl * 64 + 4 * qd);
                const f32x4 a4 = *(const LAS f32x4*)(base + 4 * 2048 + tl * 64 + 4 * qd), b4 = *(const LAS f32x4*)(base + 5 * 2048 + tl * 64 + 4 * qd);
                const float vi = base[3 * 2048 + tl * 64 + irow];
                float sa = S0 * a4[0] + S1 * a4[1] + S2 * a4[2] + S3 * a4[3];
                sa = row16_sum(sa);
                S0 = S0 * w4[0] + sa * b4[0] + vi * k4[0]; S1 = S1 * w4[1] + sa * b4[1] + vi * k4[1]; S2 = S2 * w4[2] + sa * b4[2] + vi * k4[2]; S3 = S3 * w4[3] + sa * b4[3] + vi * k4[3];
                float y = S0 * r4[0] + S1 * r4[1] + S2 * r4[2] + S3 * r4[3];
                y = row16_sum(y);
                if (qd == 0) YRAW[((size_t)(b << 12) + blk * SCAN_TB + tl) * RW + h * 64 + irow] = y;
            }
            if (blk + 1 < NBLK) SCAN_WRITE((blk + 1) & 1);
        }
        __syncthreads();
    }
}

__device__ __forceinline__ void p8_rwkv_post(const Args& a, int vcu, int G, int wave, int lane) {
    unsigned char* ws = a.ws;
    const f16* PROJ = (const f16*)(ws + WS_PROJ); const f16* RWA = (const f16*)(ws + WS_RWA); const f16* RWG = (const f16*)(ws + WS_RWG);
    const float* YRAW = (const float*)(ws + WS_YRAW); f16* OATT = (f16*)(ws + WS_OATT);
    const int gw = vcu * NWAVES + wave, NGW = G * NWAVES;
    for (int it = gw; it < MTOK * HRW; it += NGW) {
        const int m = it >> 3, h = it & 7, ch = h * 64 + lane, t = m & (SEQ - 1);
        const f16* pr = PROJ + (size_t)m * IN_PAD + ch;
        float r = (float)pr[C_R], k = (float)pr[C_K], v = (float)pr[C_V], rp = 0.f, kp = 0.f, vp = 0.f;
        if (t > 0) { rp = (float)pr[C_R - IN_PAD]; kp = (float)pr[C_K - IN_PAD]; vp = (float)pr[C_V - IN_PAD]; }
        const float rs = r + a.in[17][ch] * (rp - r), ks = k + a.in[17][512 + ch] * (kp - k), vs = v + a.in[17][1024 + ch] * (vp - v);
        const float av = (float)RWA[(size_t)m * RW + ch];
        const float km = ks * (1.f + (av - 1.f) * a.in[24][ch]);
        const float y = YRAW[(size_t)m * RW + ch];
        const float mean = wave_sum(y) * (1.f / 64.f); const float dy = y - mean;
        const float var = wave_sum(dy * dy) * (1.f / 64.f);
        const float yn = dy * rsqrtf(var + GN_EPS) * a.in[26][ch] + a.in[27][ch];
        const float bonus = wave_sum(rs * km * a.in[25][ch]) * vs;
        OATT[(size_t)m * KOUT + 1024 + ch] = (f16)((yn + bonus) * (float)RWG[(size_t)m * RW + ch]);
    }
}

typedef short bf16x8 __attribute__((ext_vector_type(8)));
typedef _Float16 f16x4v __attribute__((ext_vector_type(4)));
__device__ __forceinline__ unsigned f2bf(float f) { unsigned u = __builtin_bit_cast(unsigned, f); return (u + 0x7fffu + ((u >> 16) & 1u)) >> 16; }
__device__ __forceinline__ unsigned pkb(float lo, float hi) { unsigned r; asm("v_cvt_pk_bf16_f32 %0, %1, %2" : "=v"(r) : "v"(lo), "v"(hi)); return r; }
constexpr int XP = 144;
constexpr int XD_OFF = 0, XA_OFF = 9216, XG_OFF = 18432, XG_P = 336;
constexpr int LAB_OFF = 126720, LAK_OFF = LAB_OFF + 9216, LRB_OFF = LAK_OFF + 9216, LRK_OFF = LRB_OFF + 9216;
static_assert(LRK_OFF + 9216 <= MISC_OFF, "X-phase LDS map");
constexpr int AB_OFF = 39936, RB_OFF = AB_OFF + 9216, BB_OFF = RB_OFF + 9216, KB_OFF = BB_OFF + 9216;
constexpr int TT_OFF = 39936, M1T_OFF = TT_OFF + 9216, A2T_OFF = M1T_OFF + 9216, U1T_OFF = A2T_OFF + 9216;
constexpr int AH_OFF = 76800, VH_OFF = AH_OFF + 9216, BP_OFF = VH_OFF + 9216, KP_OFF = BP_OFF + 9216, RH_OFF = KP_OFF + 9216;
constexpr int NRM_OFF = 122880, CUMB_OFF = NRM_OFF + 512, XCONST_OFF = CUMB_OFF + 1024;
constexpr size_t WS_WDT = 28 * MiB, WS_WAT = WS_WDT + 65536, WS_WGT = WS_WAT + 65536;
constexpr size_t WS_RWP = 32 * MiB, WS_RWQ = 64 * MiB, WS_RWR2 = 408 * MiB, WS_RWY1 = 440 * MiB, WS_RWS0 = 472 * MiB, WS_BON = 364 * MiB;
constexpr int NUNIT = BATCH * 64 * HRW;

__device__ __forceinline__ f16x8 rd_row(LAS unsigned char* base, int pitch, int row, int col) { return *(const LAS f16x8*)(base + row * pitch + col * 2); }
__device__ __forceinline__ bf16x8 rd_rowb(LAS unsigned char* base, int pitch, int row, int col) { return *(const LAS bf16x8*)(base + row * pitch + col * 2); }
__device__ __forceinline__ f16x8 rd_tr(LAS unsigned char* base, int k0, int c0, int g, int qq, int pp) {
    const f16x4 v0 = tr_read16(base + (k0 + 8 * g + qq) * XP + (c0 + 4 * pp) * 2), v1 = tr_read16(base + (k0 + 8 * g + 4 + qq) * XP + (c0 + 4 * pp) * 2);
    return (f16x8){v0[0], v0[1], v0[2], v0[3], v1[0], v1[1], v1[2], v1[3]};
}
__device__ __forceinline__ void wr4h(LAS unsigned char* p, const f32x4& v) { u32x2 w; w.x = pkh(v[0], v[1]); w.y = pkh(v[2], v[3]); *(LAS u32x2*)p = w; }
__device__ __forceinline__ float dpp_shr_f(float x, int) { return x; }
template <int CTRL> __device__ __forceinline__ float dpp_z(float x) { return __builtin_bit_cast(float, __builtin_amdgcn_update_dpp(0, __builtin_bit_cast(int, x), CTRL, 0xF, 0xF, true)); }
__device__ __forceinline__ float row16_incl_scan(float x) { x += dpp_z<0x111>(x); x += dpp_z<0x112>(x); x += dpp_z<0x114>(x); x += dpp_z<0x118>(x); return x; }
#define MFMA_H(a, b, c) __builtin_amdgcn_mfma_f32_16x16x32_f16((a), (b), (c), 0, 0, 0)
#define MFMA_B(a, b, c) __builtin_amdgcn_mfma_f32_16x16x32_bf16((a), (b), (c), 0, 0, 0)
#define MFMA_H16(a, b, c) __builtin_amdgcn_mfma_f32_16x16x16f16((a), (b), (c), 0, 0, 0)
__device__ __forceinline__ f16x4 cvt4h(const f32x4& v) { return (f16x4){(f16)v[0], (f16)v[1], (f16)v[2], (f16)v[3]}; }
__device__ __forceinline__ f32x4 cvt4f(const f16x4& v) { return (f32x4){(float)v[0], (float)v[1], (float)v[2], (float)v[3]}; }

__device__ __forceinline__ void p7x_chunks(const Args& a, LAS unsigned char* lds, int vcu, int G, int tid, int wave, int lane) {
    unsigned char* ws = a.ws;
    const f16* PROJ = (const f16*)(ws + WS_PROJ);
    const f16* WDT = (const f16*)(ws + WS_WDT); const f16* WAT = (const f16*)(ws + WS_WAT); const f16* WGT = (const f16*)(ws + WS_WGT);
    f16* RWG = (f16*)(ws + WS_RWG); f16* RWP = (f16*)(ws + WS_RWP); f16* RWQ = (f16*)(ws + WS_RWQ); f16* RWR2 = (f16*)(ws + WS_RWR2); f16* RWY1 = (f16*)(ws + WS_RWY1);
    float* BON = (float*)(ws + WS_BON);
    const float* mu = a.in[17];
    const f32x4 z4 = {0.f, 0.f, 0.f, 0.f};
    const bool bal = (G == 256); const int bxx = blockIdx.x;
    const int nit = bal ? 16 : (NUNIT + G - 1) / G;
#define X_UNIT(itx_) (bal ? ((((bxx & 7) * 64 + ((bxx >> 3) + 32 * ((itx_) >> 3))) * 8 + ((itx_) & 7))) : (vcu + (itx_) * G))
    f16x4 rv0[9], rv1c, rv1p, prc[2], pkc[2], pvc[2], prp[2], pkp[2], pvp[2];
    f16x8 wfd[2][2], wfa[2][2], wfg[2][5];
    int h_tab = -1;
#define X_PREFETCH(u_, rows_) do { int lp = lane; asm volatile("" : "+v"(lp)); const int h_ = (u_) & 7, c_ = ((u_) >> 3) & 63, b_ = (u_) >> 9; const size_t m0_ = (size_t)(b_ << 12) + c_ * 64; \
        if (rows_) { _Pragma("unroll") for (int i = 0; i < 9; ++i) { const int t_ = 8 * wave + i - 1; const bool ok_ = (t_ >= 0 || c_ > 0); const f16* rowp = PROJ + (m0_ + t_) * IN_PAD + C_WD; \
            rv0[i] = (f16x4){0, 0, 0, 0}; if (ok_) rv0[i] = *(const f16x4*)(rowp + 4 * lp); } \
        { const int t1_ = 8 * wave + (lp >> 3); const f16* rp1 = PROJ + (m0_ + t1_) * IN_PAD + C_WD + 256 + 4 * (lp & 7); rv1c = *(const f16x4*)rp1; rv1p = (f16x4){0, 0, 0, 0}; if (t1_ > 0 || c_ > 0) rv1p = *(const f16x4*)(rp1 - IN_PAD); } } \
        _Pragma("unroll") for (int ci = 0; ci < 2; ++ci) { const int chr_ = h_ * 64 + 16 * (2 * (wave >> 2) + ci) + (lp & 15); \
            _Pragma("unroll") for (int ks = 0; ks < 2; ++ks) { wfd[ci][ks] = *(const f16x8*)(WDT + (size_t)chr_ * 64 + 32 * ks + 8 * (lp >> 4)); wfa[ci][ks] = *(const f16x8*)(WAT + (size_t)chr_ * 64 + 32 * ks + 8 * (lp >> 4)); } \
            _Pragma("unroll") for (int ks = 0; ks < 5; ++ks) wfg[ci][ks] = *(const f16x8*)(WGT + (size_t)chr_ * 192 + 32 * ks + 8 * (lp >> 4)); } \
        const int t2_ = 16 * (wave & 3) + (lp & 15); const size_t m_ = m0_ + t2_; \
        _Pragma("unroll") for (int ci = 0; ci < 2; ++ci) { const int ch_ = h_ * 64 + 16 * (2 * (wave >> 2) + ci) + 4 * (lp >> 4); \
            prc[ci] = *(const f16x4*)(PROJ + m_ * IN_PAD + C_R + ch_); pkc[ci] = *(const f16x4*)(PROJ + m_ * IN_PAD + C_K + ch_); pvc[ci] = *(const f16x4*)(PROJ + m_ * IN_PAD + C_V + ch_); \
            prp[ci] = (f16x4){0, 0, 0, 0}; pkp[ci] = (f16x4){0, 0, 0, 0}; pvp[ci] = (f16x4){0, 0, 0, 0}; \
            if ((c_ * 64 + t2_) != 0) { prp[ci] = *(const f16x4*)(PROJ + (m_ - 1) * IN_PAD + C_R + ch_); pkp[ci] = *(const f16x4*)(PROJ + (m_ - 1) * IN_PAD + C_K + ch_); pvp[ci] = *(const f16x4*)(PROJ + (m_ - 1) * IN_PAD + C_V + ch_); } } } while (0)
    { const int u0 = X_UNIT(0); if (u0 < NUNIT) X_PREFETCH(u0, true); }
    int chunk_id = -1;
#pragma unroll 1
    for (int itx = 0; itx < nit; ++itx) {
        const int u = X_UNIT(itx); if (u >= NUNIT) break;
        const int un = (itx + 1 < nit) ? X_UNIT(itx + 1) : NUNIT;
        int lane_o = lane; asm volatile("" : "+v"(lane_o));
        const int r16 = lane_o & 15, g = lane_o >> 4, qq = r16 >> 2, pp = lane_o & 3;
        const int h = u & 7, c = (u >> 3) & 63, b = u >> 9;
        const size_t m0 = (size_t)(b << 12) + c * 64;
        const bool newchunk = (u >> 3) != chunk_id; chunk_id = u >> 3;
        lds_barrier();
        if (h != h_tab) { h_tab = h;
            if (tid < 64) { const int ch = h * 64 + tid; LAS float* ct = (LAS float*)(lds + XCONST_OFF) + tid;
                ct[0] = mu[ch]; ct[64] = mu[512 + ch]; ct[128] = mu[1024 + ch]; ct[192] = a.in[18][ch]; ct[256] = a.in[20][ch]; ct[320] = a.in[23][ch]; ct[384] = a.in[24][ch]; ct[448] = a.in[25][ch]; } }
        if (newchunk) {
            const f32x4 mu0 = *(const f32x4*)(mu + 1536 + 4 * lane_o); const f32x4 mu1 = *(const f32x4*)(mu + 1536 + 256 + 4 * (lane_o & 7));
            const float kf = lane_o < 16 ? 2.f : 1.f; const bool is_t = lane_o < 16, is_id = (lane_o >= 16 && lane_o < 32);
            LAS unsigned char* d0 = is_t ? lds + XD_OFF + 8 * lane_o : is_id ? lds + XA_OFF + 8 * (lane_o - 16) : lds + XG_OFF + 8 * (lane_o - 32);
            const int p0 = (lane_o < 32) ? XP : XG_P;
#pragma unroll
            for (int i = 0; i < 8; ++i) { const int t = 8 * wave + i; float o[4];
#pragma unroll
                for (int e = 0; e < 4; ++e) { const float cu = (float)rv0[i + 1][e], pv = (float)rv0[i][e]; const float x = cu + mu0[e] * (pv - cu);
                    const float sg = __builtin_amdgcn_rcpf(1.f + __expf(-kf * x)); o[e] = is_t ? 2.f * sg - 1.f : is_id ? x : sg; }
                u32x2 w; w.x = pkh(o[0], o[1]); w.y = pkh(o[2], o[3]); *(LAS u32x2*)(d0 + t * p0) = w; }
            {
                float o1[4];
#pragma unroll
                for (int e = 0; e < 4; ++e) { const float cu1 = (float)rv1c[e], pv1 = (float)rv1p[e]; const float x1 = cu1 + mu1[e] * (pv1 - cu1); o1[e] = __builtin_amdgcn_rcpf(1.f + __expf(-x1)); }
                u32x2 w1; w1.x = pkh(o1[0], o1[1]); w1.y = pkh(o1[2], o1[3]); *(LAS u32x2*)(lds + XG_OFF + (8 * wave + (lane_o >> 3)) * XG_P + (128 + 4 * (lane_o & 7)) * 2) = w1; }
        }
        lds_barrier();
        const int tb = wave & 3, cth = wave >> 2;
        const int t = 16 * tb + r16; const size_t m = m0 + t;
        f32x4 dA[2], aA[2], gA[2];
#pragma unroll
        for (int ci = 0; ci < 2; ++ci) {
            dA[ci] = z4; aA[ci] = z4; gA[ci] = z4;
#pragma unroll
            for (int ks = 0; ks < 2; ++ks) {
                dA[ci] = MFMA_H(wfd[ci][ks], rd_row(lds + XD_OFF, XP, t, 32 * ks + 8 * g), dA[ci]);
                aA[ci] = MFMA_H(wfa[ci][ks], rd_row(lds + XA_OFF, XP, t, 32 * ks + 8 * g), aA[ci]); }
#pragma unroll
            for (int ks = 0; ks < 5; ++ks) gA[ci] = MFMA_H(wfg[ci][ks], rd_row(lds + XG_OFF, XG_P, t, 32 * ks + 8 * g), gA[ci]);
        }
        float lwv[2][4], asg[2][4], rs[2][4], kp[2][4], vs[2][4], kkv[2][4], cl[2][4];
        float pn = 0.f, prk = 0.f;
#pragma unroll
        for (int ci = 0; ci < 2; ++ci) {
            const int chl = 16 * (2 * cth + ci) + 4 * g, ch = h * 64 + chl;
            const f16x4 rc = prc[ci], kc = pkc[ci], vc = pvc[ci], rp = prp[ci], kq = pkp[ci], vp = pvp[ci];
            const LAS float* ct = (const LAS float*)(lds + XCONST_OFF) + chl;
            const f32x4 mur = *(const LAS f32x4*)(ct), muk = *(const LAS f32x4*)(ct + 64), muv = *(const LAS f32x4*)(ct + 128);
            const f32x4 w0 = *(const LAS f32x4*)(ct + 192), a0 = *(const LAS f32x4*)(ct + 256), kkc = *(const LAS f32x4*)(ct + 320), kac = *(const LAS f32x4*)(ct + 384), rkc = *(const LAS f32x4*)(ct + 448);
            float gl[4];
#pragma unroll
            for (int e = 0; e < 4; ++e) {
                const float z = -(w0[e] + dA[ci][e]); const float sp = fmaxf(z, 0.f) + __logf(1.f + __expf(-fabsf(z)));
                lwv[ci][e] = -__expf(-sp - 0.5f);
                asg[ci][e] = sigmoidf_(a0[e] + aA[ci][e]); gl[e] = gA[ci][e];
                rs[ci][e] = (float)rc[e] + mur[e] * ((float)rp[e] - (float)rc[e]);
                const float ks_ = (float)kc[e] + muk[e] * ((float)kq[e] - (float)kc[e]);
                vs[ci][e] = (float)vc[e] + muv[e] * ((float)vp[e] - (float)vc[e]);
                kkv[ci][e] = ks_ * kkc[e]; pn += kkv[ci][e] * kkv[ci][e];
                kp[ci][e] = ks_ * (1.f + (asg[ci][e] - 1.f) * kac[e]);
                prk += rs[ci][e] * kp[ci][e] * rkc[e];
                cl[ci][e] = row16_incl_scan(lwv[ci][e]);
                if (r16 == 15) ((LAS float*)(lds + CUMB_OFF))[tb * 64 + chl + e] = cl[ci][e];
            }
            u32x2 gw; gw.x = pkh(gl[0], gl[1]); gw.y = pkh(gl[2], gl[3]); *(u32x2*)(RWG + m * RW + ch) = gw;
        }
        pn += __shfl_xor(pn, 16); pn += __shfl_xor(pn, 32); prk += __shfl_xor(prk, 16); prk += __shfl_xor(prk, 32);
        if (g == 0) { ((LAS float*)(lds + NRM_OFF))[t * 2 + cth] = pn; BON[((size_t)u * 64 + t) * 2 + cth] = prk; }
        lds_barrier();
        {
            const float nrm = sqrtf(((LAS float*)(lds + NRM_OFF))[t * 2] + ((LAS float*)(lds + NRM_OFF))[t * 2 + 1]); const float inrm = __builtin_amdgcn_rcpf(fmaxf(nrm, 1e-12f));
#pragma unroll
            for (int ci = 0; ci < 2; ++ci) {
                const int chl = 16 * (2 * cth + ci) + 4 * g;
                float Ab[4], Rb[4], Bb[4], Kb[4], Bp[4], Kp[4];
                const LAS float* cbp = (const LAS float*)(lds + CUMB_OFF) + chl;
                const f32x4 cb0 = *(const LAS f32x4*)(cbp), cb1 = *(const LAS f32x4*)(cbp + 64), cb2 = *(const LAS f32x4*)(cbp + 128), cb3 = *(const LAS f32x4*)(cbp + 192);
#pragma unroll
                for (int e = 0; e < 4; ++e) {
                    const float b0 = cb0[e], b1 = cb1[e], b2 = cb2[e], b3 = cb3[e];
                    const float pre = (tb > 0 ? b0 : 0.f) + (tb > 1 ? b1 : 0.f) + (tb > 2 ? b2 : 0.f);
                    const float cum = cl[ci][e] + pre, cumC = (b0 + b1) + (b2 + b3);
                    const float kkn = kkv[ci][e] * inrm, av = -kkn, bv = kkn * asg[ci][e];
                    const float eg = __expf(cum), egi = __expf(-cum), egc = __expf(cumC - cum);
                    Ab[e] = av * __expf(cum - lwv[ci][e]); Rb[e] = rs[ci][e] * eg; Bb[e] = bv * egi; Kb[e] = kp[ci][e] * egi; Bp[e] = bv * egc; Kp[e] = kp[ci][e] * egc;
                }
                const int ro = t * XP + chl * 2;
                u32x2 w;
                w.x = pkb(Ab[0], Ab[1]); w.y = pkb(Ab[2], Ab[3]); *(LAS u32x2*)(lds + AB_OFF + ro) = w;
                w.x = pkb(Rb[0], Rb[1]); w.y = pkb(Rb[2], Rb[3]); *(LAS u32x2*)(lds + RB_OFF + ro) = w;
                w.x = pkb(Bb[0], Bb[1]); w.y = pkb(Bb[2], Bb[3]); *(LAS u32x2*)(lds + BB_OFF + ro) = w;
                w.x = pkb(Kb[0], Kb[1]); w.y = pkb(Kb[2], Kb[3]); *(LAS u32x2*)(lds + KB_OFF + ro) = w;
                w.x = pkh(Ab[0], Ab[1]); w.y = pkh(Ab[2], Ab[3]); *(LAS u32x2*)(lds + AH_OFF + ro) = w;
                w.x = pkh(Rb[0], Rb[1]); w.y = pkh(Rb[2], Rb[3]); *(LAS u32x2*)(lds + RH_OFF + ro) = w;
                w.x = pkh(vs[ci][0], vs[ci][1]); w.y = pkh(vs[ci][2], vs[ci][3]); *(LAS u32x2*)(lds + VH_OFF + ro) = w;
                w.x = pkh(Bp[0], Bp[1]); w.y = pkh(Bp[2], Bp[3]); *(LAS u32x2*)(lds + BP_OFF + ro) = w;
                w.x = pkh(Kp[0], Kp[1]); w.y = pkh(Kp[2], Kp[3]); *(LAS u32x2*)(lds + KP_OFF + ro) = w;
            }
        }
        lds_barrier();
#pragma unroll 1
        for (int k = 0; k < 5; ++k) {
            const int idx = wave + 8 * k, prod = idx / 10, rem = idx - prod * 10;
            const int tb1 = rem >= 6 ? 3 : rem >= 3 ? 2 : rem >= 1 ? 1 : 0, ub = rem - (tb1 * (tb1 + 1)) / 2;
            LAS unsigned char* X = lds + ((prod < 2) ? AB_OFF : RB_OFF); LAS unsigned char* Y = lds + ((prod & 1) ? KB_OFF : BB_OFF);
            f32x4 acc = z4;
#pragma unroll
            for (int ks = 0; ks < 2; ++ks) acc = MFMA_B(rd_rowb(Y, XP, 16 * ub + r16, 32 * ks + 8 * g), rd_rowb(X, XP, 16 * tb1 + r16, 32 * ks + 8 * g), acc);
            const int tt = 16 * tb1 + r16, tau0 = 16 * ub + 4 * g; const int lim = (prod < 2) ? tt : tt + 1;
#pragma unroll
            for (int e = 0; e < 4; ++e) if (tau0 + e >= lim) acc[e] = 0.f;
            wr4h(lds + LAB_OFF + prod * 9216 + tt * XP + tau0 * 2, acc);
        }
#pragma unroll 1
        for (int k = 0; k < 3; ++k) {
            const int idx = wave + 8 * k, prod = idx / 6, rem = idx - prod * 6;
            const int tb1 = rem >= 5 ? 2 : rem >= 3 ? 1 : 0, ub = (rem >= 5) ? 3 : (rem >= 3) ? rem - 1 : rem + 1;
            wr4h(lds + LAB_OFF + prod * 9216 + (16 * tb1 + r16) * XP + (16 * ub + 4 * g) * 2, z4);
        }
        lds_barrier();
        if (wave == 0) {
            LAS unsigned char* L = lds + LAB_OFF; LAS unsigned char* TT = lds + TT_OFF;
            f32x4 TB[4][4]; f16x4 TAh[4];
            float idn[4];
#pragma unroll
            for (int e = 0; e < 4; ++e) idn[e] = (r16 == 4 * g + e) ? 1.f : 0.f;
#pragma unroll
            for (int i = 0; i < 4; ++i) {
                f16x4 XA = *(const LAS f16x4*)(L + (16 * i + r16) * XP + (16 * i + 4 * g) * 2);
                f16x4 XB = tr_read16(L + (16 * i + 4 * g + qq) * XP + (16 * i + 4 * pp) * 2);
                f32x4 TAf, TBf;
#pragma unroll
                for (int e = 0; e < 4; ++e) { TAf[e] = idn[e] + (float)XA[e]; TBf[e] = idn[e] + (float)XB[e]; }
#pragma unroll
                for (int lv = 0; lv < 3; ++lv) {
                    const f32x4 X2B = MFMA_H16(XA, XB, z4), X2A = MFMA_H16(XB, XA, z4);
                    XA = cvt4h(X2A); XB = cvt4h(X2B);
                    const f16x4 ta = cvt4h(TAf);
                    TBf = MFMA_H16(ta, XB, TBf); TAf = MFMA_H16(XB, ta, TAf);
                }
                TB[i][i] = TBf; TAh[i] = cvt4h(TAf);
            }
#pragma unroll
            for (int d = 1; d < 4; ++d)
#pragma unroll
                for (int j = 0; j + d < 4; ++j) { const int i = j + d;
                    f32x4 M = z4;
#pragma unroll
                    for (int kq2 = j; kq2 < i; ++kq2) M = MFMA_H16(*(const LAS f16x4*)(L + (16 * i + r16) * XP + (16 * kq2 + 4 * g) * 2), cvt4h(TB[kq2][j]), M);
                    TB[i][j] = MFMA_H16(TAh[i], cvt4h(M), z4);
                }
#pragma unroll
            for (int i = 0; i < 4; ++i)
#pragma unroll
                for (int j = 0; j < 4; ++j) wr4h(TT + (16 * j + r16) * XP + (16 * i + 4 * g) * 2, (j <= i) ? TB[i][j] : z4);
        } else {
#pragma unroll 1
            for (int idx = wave - 1; idx < 16; idx += 7) { const int tb1 = idx >> 2, ib = idx & 3;
                f32x4 acc = z4;
#pragma unroll
                for (int ks = 0; ks < 2; ++ks) acc = MFMA_H(rd_row(lds + LAK_OFF, XP, 16 * tb1 + r16, 32 * ks + 8 * g), rd_tr(lds + VH_OFF, 32 * ks, 16 * ib, g, qq, pp), acc);
                wr4h(lds + M1T_OFF + (16 * ib + r16) * XP + (16 * tb1 + 4 * g) * 2, acc);
            }
        }
        lds_barrier();
#pragma unroll
        for (int k = 0; k < 4; ++k) {
            const int which = k >> 1, tb1 = 2 * (k & 1) + (wave >> 2), nb = wave & 3;
            f32x4 acc = z4;
#pragma unroll
            for (int ks = 0; ks < 2; ++ks) {
                const f16x8 af = rd_tr(lds + TT_OFF, 32 * ks, 16 * tb1, g, qq, pp);
                const f16x8 bf = which ? rd_row(lds + M1T_OFF, XP, 16 * nb + r16, 32 * ks + 8 * g) : rd_tr(lds + AH_OFF, 32 * ks, 16 * nb, g, qq, pp);
                acc = MFMA_H(af, bf, acc);
            }
            wr4h(lds + (which ? U1T_OFF : A2T_OFF) + (16 * nb + r16) * XP + (16 * tb1 + 4 * g) * 2, acc);
        }
        lds_barrier();
        if (un < NUNIT) X_PREFETCH(un, (un >> 3) != chunk_id);
#pragma unroll
        for (int k = 0; k < 8; ++k) {
            const int kind = k >> 1, a4 = 2 * (k & 1) + (wave >> 2), b4 = wave & 3;
            f32x4 acc = z4;
            if (kind == 0) {
#pragma unroll
                for (int ks = 0; ks < 2; ++ks) acc = MFMA_H(rd_row(lds + A2T_OFF, XP, 16 * a4 + r16, 32 * ks + 8 * g), rd_tr(lds + BP_OFF, 32 * ks, 16 * b4, g, qq, pp), acc);
                if (a4 == b4) { const LAS float* cb = (const LAS float*)(lds + CUMB_OFF) + 16 * b4 + r16; const float gC = __expf((cb[0] + cb[64]) + (cb[128] + cb[192]));
#pragma unroll
                    for (int e = 0; e < 4; ++e) if (4 * g + e == r16) acc[e] += gC; }
                u32x2 w; w.x = pkh(acc[0], acc[1]); w.y = pkh(acc[2], acc[3]);
                *(u32x2*)(RWP + (size_t)u * 4096 + ((b4 * 2 + (a4 >> 1)) * 64 + lane_o) * 8 + (a4 & 1) * 4) = w;
            } else if (kind == 1) {
#pragma unroll
                for (int ks = 0; ks < 2; ++ks) { acc = MFMA_H(rd_tr(lds + BP_OFF, 32 * ks, 16 * a4, g, qq, pp), rd_row(lds + U1T_OFF, XP, 16 * b4 + r16, 32 * ks + 8 * g), acc);
                    acc = MFMA_H(rd_tr(lds + KP_OFF, 32 * ks, 16 * a4, g, qq, pp), rd_tr(lds + VH_OFF, 32 * ks, 16 * b4, g, qq, pp), acc); }
                u32x2 w; w.x = pkh(acc[0], acc[1]); w.y = pkh(acc[2], acc[3]);
                *(u32x2*)(RWQ + (size_t)u * 4096 + ((b4 * 4 + a4) * 64 + lane_o) * 4) = w;
            } else if (kind == 2) {
                { const f16x4 rh4 = *(const LAS f16x4*)(lds + RH_OFF + (16 * b4 + r16) * XP + (16 * a4 + 4 * g) * 2); acc = cvt4f(rh4); }
#pragma unroll
                for (int ks = 0; ks < 2; ++ks) acc = MFMA_H(rd_row(lds + A2T_OFF, XP, 16 * a4 + r16, 32 * ks + 8 * g), rd_row(lds + LRB_OFF, XP, 16 * b4 + r16, 32 * ks + 8 * g), acc);
                u32x2 w; w.x = pkh(acc[0], acc[1]); w.y = pkh(acc[2], acc[3]);
                *(u32x2*)(RWR2 + (size_t)u * 4096 + (16 * b4 + r16) * 64 + 16 * a4 + 4 * g) = w;
            } else {
#pragma unroll
                for (int ks = 0; ks < 2; ++ks) { acc = MFMA_H(rd_row(lds + U1T_OFF, XP, 16 * a4 + r16, 32 * ks + 8 * g), rd_row(lds + LRB_OFF, XP, 16 * b4 + r16, 32 * ks + 8 * g), acc);
                    acc = MFMA_H(rd_tr(lds + VH_OFF, 32 * ks, 16 * a4, g, qq, pp), rd_row(lds + LRK_OFF, XP, 16 * b4 + r16, 32 * ks + 8 * g), acc); }
                u32x2 w; w.x = pkh(acc[0], acc[1]); w.y = pkh(acc[2], acc[3]);
                *(u32x2*)(RWY1 + (size_t)u * 4096 + ((a4 * 4 + b4) * 64 + lane_o) * 4) = w;
            }
        }
    }
}

#undef X_UNIT
#undef X_PREFETCH
struct ChBuf { f16x8 p[4][2]; u32x2 q[4]; };
__device__ __forceinline__ void p7y_chain(const Args& a, int bx0, int G, int wave, int lane) {
    unsigned char* ws = a.ws;
    const f16* RWP = (const f16*)(ws + WS_RWP); const f16* RWQ = (const f16*)(ws + WS_RWQ); f16* RWS0 = (f16*)(ws + WS_RWS0);
    if (wave != 0) return;
#pragma unroll 1
    for (int bx = bx0; bx < 256; bx += G) {
    const int r16 = lane & 15, g = lane >> 4;
    const int b = bx & 7, rest = bx >> 3, h = rest >> 2, it = rest & 3;
    f32x4 S[4];
#pragma unroll
    for (int mt = 0; mt < 4; ++mt) S[mt] = (f32x4){0.f, 0.f, 0.f, 0.f};
    ChBuf B0, B1, B2, B3;
#define CH_LOAD(BUF, c_) do { const size_t uu = ((size_t)(b * 64 + (c_)) * 8 + h); \
        _Pragma("unroll") for (int mo = 0; mo < 4; ++mo) { BUF.q[mo] = *(const u32x2*)(RWQ + uu * 4096 + ((it * 4 + mo) * 64 + lane) * 4); \
            _Pragma("unroll") for (int ks = 0; ks < 2; ++ks) BUF.p[mo][ks] = *(const f16x8*)(RWP + uu * 4096 + ((mo * 2 + ks) * 64 + lane) * 8); } } while (0)
#define CH_STEP(BUF, c_) do { const size_t uu = ((size_t)(b * 64 + (c_)) * 8 + h); f16x8 bfr[2]; \
        _Pragma("unroll") for (int mt = 0; mt < 4; ++mt) { u32x2 w; w.x = pkh(S[mt][0], S[mt][1]); w.y = pkh(S[mt][2], S[mt][3]); \
            *(u32x2*)(RWS0 + uu * 4096 + (16 * it + r16) * 64 + 16 * mt + 4 * g) = w; const f16x4 hv = __builtin_bit_cast(f16x4, w); \
            bfr[mt >> 1][(mt & 1) * 4 + 0] = hv[0]; bfr[mt >> 1][(mt & 1) * 4 + 1] = hv[1]; bfr[mt >> 1][(mt & 1) * 4 + 2] = hv[2]; bfr[mt >> 1][(mt & 1) * 4 + 3] = hv[3]; } \
        _Pragma("unroll") for (int mo = 0; mo < 4; ++mo) { f32x4 n_ = cvt4f(__builtin_bit_cast(f16x4, BUF.q[mo])); \
            _Pragma("unroll") for (int ks = 0; ks < 2; ++ks) n_ = MFMA_H(BUF.p[mo][ks], bfr[ks], n_); S[mo] = n_; } \
        if ((c_) + 4 < 64) CH_LOAD(BUF, (c_) + 4); } while (0)
    CH_LOAD(B0, 0); CH_LOAD(B1, 1); CH_LOAD(B2, 2); CH_LOAD(B3, 3);
#pragma unroll 1
    for (int c = 0; c < 64; c += 4) { CH_STEP(B0, c); CH_STEP(B1, c + 1); CH_STEP(B2, c + 2); CH_STEP(B3, c + 3); }
    }
#undef CH_LOAD
#undef CH_STEP
}

__device__ __forceinline__ void p8z_out(const Args& a, int vcu, int G, int wave, int lane) {
    unsigned char* ws = a.ws;
    const f16* PROJ = (const f16*)(ws + WS_PROJ); const f16* RWG = (const f16*)(ws + WS_RWG);
    const f16* RWR2 = (const f16*)(ws + WS_RWR2); const f16* RWY1 = (const f16*)(ws + WS_RWY1); const f16* RWS0 = (const f16*)(ws + WS_RWS0);
    const float* BON = (const float*)(ws + WS_BON); f16* OATT = (f16*)(ws + WS_OATT);
    const int gw = vcu * NWAVES + wave, NGW = G * NWAVES;
    const bool bal = (G == 256); const int bxx = blockIdx.x;
    const int nit = bal ? 2 : (NUNIT + NGW - 1) / NGW;
#pragma unroll 1
    for (int itx = 0; itx < nit; ++itx) {
        int u;
        if (bal) { const int idx = (bxx >> 3) * 8 + wave + 256 * itx; u = (((bxx & 7) * 64 + (idx >> 3)) * 8 + (idx & 7)); } else { u = gw + itx * NGW; if (u >= NUNIT) break; }
        int lane_o = lane; asm volatile("" : "+v"(lane_o));
        const int r16 = lane_o & 15, g = lane_o >> 4;
        const int h = u & 7, c = (u >> 3) & 63, b = u >> 9;
        const size_t m0 = (size_t)(b << 12) + c * 64;
        f32x4 acc[4][4];
#pragma unroll
        for (int mt = 0; mt < 4; ++mt)
#pragma unroll
            for (int nt = 0; nt < 4; ++nt) acc[mt][nt] = cvt4f(*(const f16x4*)(RWY1 + (size_t)u * 4096 + ((mt * 4 + nt) * 64 + lane_o) * 4));
#pragma unroll
        for (int ks = 0; ks < 2; ++ks) {
            f16x8 sf[4], rf[4];
#pragma unroll
            for (int x = 0; x < 4; ++x) { sf[x] = *(const f16x8*)(RWS0 + (size_t)u * 4096 + (16 * x + r16) * 64 + 32 * ks + 8 * g); rf[x] = *(const f16x8*)(RWR2 + (size_t)u * 4096 + (16 * x + r16) * 64 + 32 * ks + 8 * g); }
#pragma unroll
            for (int mt = 0; mt < 4; ++mt)
#pragma unroll
                for (int nt = 0; nt < 4; ++nt) acc[mt][nt] = MFMA_H(sf[mt], rf[nt], acc[mt][nt]);
        }
#pragma unroll
        for (int nt = 0; nt < 4; ++nt) {
            const int t = 16 * nt + r16; const size_t m = m0 + t;
            float s = 0.f;
#pragma unroll
            for (int mt = 0; mt < 4; ++mt) s += (acc[mt][nt][0] + acc[mt][nt][1]) + (acc[mt][nt][2] + acc[mt][nt][3]);
            s += __shfl_xor(s, 16); s += __shfl_xor(s, 32);
            const float mean = s * (1.f / 64.f); float q = 0.f;
#pragma unroll
            for (int mt = 0; mt < 4; ++mt)
#pragma unroll
                for (int e = 0; e < 4; ++e) { const float d = acc[mt][nt][e] - mean; q += d * d; }
            q += __shfl_xor(q, 16); q += __shfl_xor(q, 32);
            const float rstd = rsqrtf(q * (1.f / 64.f) + GN_EPS);
            const f32x2 bo = *(const f32x2*)(BON + ((size_t)u * 64 + t) * 2); const float bonus = bo[0] + bo[1];
#pragma unroll
            for (int mt = 0; mt < 4; ++mt) {
                const int ch = h * 64 + 16 * mt + 4 * g;
                const f16x4 vc = *(const f16x4*)(PROJ + m * IN_PAD + C_V + ch);
                f16x4 vp = {0, 0, 0, 0}; if ((c * 64 + t) != 0) vp = *(const f16x4*)(PROJ + (m - 1) * IN_PAD + C_V + ch);
                const f32x4 muv = *(const f32x4*)(a.in[17] + 1024 + ch), gn = *(const f32x4*)(a.in[26] + ch), bs = *(const f32x4*)(a.in[27] + ch);
                const f16x4 gg = *(const f16x4*)(RWG + m * RW + ch);
                float o[4];
#pragma unroll
                for (int e = 0; e < 4; ++e) { const float vsv = (float)vc[e] + muv[e] * ((float)vp[e] - (float)vc[e]);
                    o[e] = ((acc[mt][nt][e] - mean) * rstd * gn[e] + bs[e] + bonus * vsv) * (float)gg[e]; }
                u32x2 w; w.x = pkh(o[0], o[1]); w.y = pkh(o[2], o[3]);
                *(u32x2*)(OATT + m * KOUT + 1024 + ch) = w;
            }
        }
    }
}

__device__ __forceinline__ f16* x1_row(unsigned char* ws, int m) { return (f16*)(ws + ((m < 16384) ? WS_RWG : (WS_RWS0 - (size_t)16384 * 2048)) + (size_t)m * 2048); }
__device__ __forceinline__ void p10_mid(const Args& a, int vcu, int G, int wave, int lane) {
    unsigned char* ws = a.ws;
    const f16* MIX = (const f16*)(ws + WS_MIX); const float* mod = (const float*)(ws + WS_MOD); f16* HF = (f16*)(ws + WS_H);
    const int gw = vcu * NWAVES + wave, NGW = G * NWAVES;
    float g6[16], g7[16];
#pragma unroll
    for (int j = 0; j < 2; ++j) { const int c = 8 * lane + 512 * j;
        const f32x4 p0 = *(const f32x4*)(a.in[6] + c), p1 = *(const f32x4*)(a.in[6] + c + 4), q0 = *(const f32x4*)(a.in[7] + c), q1 = *(const f32x4*)(a.in[7] + c + 4);
#pragma unroll
        for (int e = 0; e < 4; ++e) { g6[8 * j + e] = p0[e]; g6[8 * j + 4 + e] = p1[e]; g7[8 * j + e] = q0[e]; g7[8 * j + 4 + e] = q1[e]; } }
    f16x8 nmx[2]; f32x4 nx[4];
    if (gw < MTOK) {
#pragma unroll
        for (int j = 0; j < 2; ++j) { const int c = 8 * lane + 512 * j; nmx[j] = *(const f16x8*)(MIX + (size_t)gw * D + c); nx[2 * j] = *(const f32x4*)(a.in[0] + (size_t)gw * D + c); nx[2 * j + 1] = *(const f32x4*)(a.in[0] + (size_t)gw * D + c + 4); } }
    for (int m = gw; m < MTOK; m += NGW) {
        const int b = m >> 12; const float* md = mod + b * 6144;
        float mx[16], xv[16]; float s = 0.f;
#pragma unroll
        for (int j = 0; j < 2; ++j) { const f16x8 v = nmx[j];
#pragma unroll
            for (int e = 0; e < 8; ++e) { mx[8 * j + e] = (float)v[e]; s += mx[8 * j + e] * mx[8 * j + e]; }
#pragma unroll
            for (int e = 0; e < 4; ++e) { xv[8 * j + e] = nx[2 * j][e]; xv[8 * j + 4 + e] = nx[2 * j + 1][e]; } }
        { const int mn = (m + NGW < MTOK) ? m + NGW : m;
#pragma unroll
          for (int j = 0; j < 2; ++j) { const int c = 8 * lane + 512 * j; nmx[j] = *(const f16x8*)(MIX + (size_t)mn * D + c); nx[2 * j] = *(const f32x4*)(a.in[0] + (size_t)mn * D + c); nx[2 * j + 1] = *(const f32x4*)(a.in[0] + (size_t)mn * D + c + 4); } }
        const float r = rsqrtf(wave_sum(s) * (1.f / D) + NORM_EPS);
        float s1 = 0.f;
        f16* x1r = x1_row(ws, m);
#pragma unroll
        for (int j = 0; j < 2; ++j) { const int c = 8 * lane + 512 * j;
            const f32x4 gm0 = *(const f32x4*)(md + 2048 + c), gm1 = *(const f32x4*)(md + 2048 + c + 4);
#pragma unroll
            for (int e = 0; e < 8; ++e) { const float gm = e < 4 ? gm0[e & 3] : gm1[e & 3]; const float x1 = xv[8 * j + e] + gm * (mx[8 * j + e] * r * g6[8 * j + e]); xv[8 * j + e] = x1; s1 += x1 * x1; }
            u32x4 w; w.x = pkh(xv[8 * j], xv[8 * j + 1]); w.y = pkh(xv[8 * j + 2], xv[8 * j + 3]); w.z = pkh(xv[8 * j + 4], xv[8 * j + 5]); w.w = pkh(xv[8 * j + 6], xv[8 * j + 7]);
            *(u32x4*)(x1r + c) = w; }
        const float r1 = rsqrtf(wave_sum(s1) * (1.f / D) + NORM_EPS);
#pragma unroll
        for (int j = 0; j < 2; ++j) { const int c = 8 * lane + 512 * j; float y[8];
            const f32x4 sc0 = *(const f32x4*)(md + 4096 + c), sc1 = *(const f32x4*)(md + 4096 + c + 4), sh0 = *(const f32x4*)(md + 3072 + c), sh1 = *(const f32x4*)(md + 3072 + c + 4);
#pragma unroll
            for (int e = 0; e < 8; ++e) { const float sc = e < 4 ? sc0[e & 3] : sc1[e & 3], sh = e < 4 ? sh0[e & 3] : sh1[e & 3]; y[e] = xv[8 * j + e] * r1 * g7[8 * j + e] * (1.f + sc) + sh; }
            u32x4 w; w.x = pkh(y[0], y[1]); w.y = pkh(y[2], y[3]); w.z = pkh(y[4], y[5]); w.w = pkh(y[6], y[7]);
            *(u32x4*)(HF + (size_t)m * D + c) = w; }
    }
}
__device__ __forceinline__ void p13_final(const Args& a, int vcu, int G, int wave, int lane) {
    unsigned char* ws = a.ws;
    const f16* F = (const f16*)(ws + WS_F); const float* mod = (const float*)(ws + WS_MOD);
    const int gw = vcu * NWAVES + wave, NGW = G * NWAVES;
    float g8[16];
#pragma unroll
    for (int j = 0; j < 2; ++j) { const int c = 8 * lane + 512 * j; const f32x4 p0 = *(const f32x4*)(a.in[8] + c), p1 = *(const f32x4*)(a.in[8] + c + 4);
#pragma unroll
        for (int e = 0; e < 4; ++e) { g8[8 * j + e] = p0[e]; g8[8 * j + 4 + e] = p1[e]; } }
    f16x8 nf[2], nxh[2];
    if (gw < MTOK) { const f16* x1n = x1_row(ws, gw);
#pragma unroll
        for (int j = 0; j < 2; ++j) { const int c = 8 * lane + 512 * j; nf[j] = *(const f16x8*)(F + (size_t)gw * D + c); nxh[j] = *(const f16x8*)(x1n + c); } }
    for (int m = gw; m < MTOK; m += NGW) {
        const int b = m >> 12; const float* md = mod + b * 6144;
        float fv[16]; float s = 0.f;
        f16x8 xh[2];
#pragma unroll
        for (int j = 0; j < 2; ++j) { const f16x8 v = nf[j]; xh[j] = nxh[j];
#pragma unroll
            for (int e = 0; e < 8; ++e) { fv[8 * j + e] = (float)v[e]; s += fv[8 * j + e] * fv[8 * j + e]; } }
        { const int mn = (m + NGW < MTOK) ? m + NGW : m; const f16* x1n = x1_row(ws, mn);
#pragma unroll
          for (int j = 0; j < 2; ++j) { const int c = 8 * lane + 512 * j; nf[j] = *(const f16x8*)(F + (size_t)mn * D + c); nxh[j] = *(const f16x8*)(x1n + c); } }
        const float r = rsqrtf(wave_sum(s) * (1.f / D) + NORM_EPS);
#pragma unroll
        for (int j = 0; j < 2; ++j) { const int c = 8 * lane + 512 * j;
            const f32x4 gf0 = *(const f32x4*)(md + 5120 + c), gf1 = *(const f32x4*)(md + 5120 + c + 4);
            f32x4 o0, o1;
#pragma unroll
            for (int e = 0; e < 4; ++e) { o0[e] = (float)xh[j][e] + gf0[e] * (fv[8 * j + e] * r * g8[8 * j + e]); o1[e] = (float)xh[j][4 + e] + gf1[e] * (fv[8 * j + 4 + e] * r * g8[8 * j + 4 + e]); }
            __builtin_nontemporal_store(o0, (f32x4*)(a.out + (size_t)m * D + c)); __builtin_nontemporal_store(o1, (f32x4*)(a.out + (size_t)m * D + c + 4)); }
    }
}

constexpr int NPHASE = 14;
__global__ void __launch_bounds__(NWAVES * 64, 2) fwd(Args args) {
    extern __shared__ __attribute__((aligned(16))) unsigned char lds_raw[];
    LAS unsigned char* lds = (LAS unsigned char*)lds_raw;
    const int tid = threadIdx.x, lane = tid & 63, wave = __builtin_amdgcn_readfirstlane(tid >> 6);
    const int G = gridDim.x; const int bx = blockIdx.x; const int vcu = (G % 8 == 0) ? (bx % 8) * (G / 8) + bx / 8 : bx;
    volatile LAS unsigned* MISC = (volatile LAS unsigned*)(lds + MISC_OFF);
    if (tid < 16) MISC[tid] = 0u;
    __syncthreads();
    const int lo = args.ph_lo, hi = args.ph_hi;
    unsigned* barw = (unsigned*)(args.ws + WS_CTL) + CW_BAR;
    XcdBarrier bar; bar.bar = barw; bar.x = 0; bar.st = nullptr;
    if (hi - lo > 1) bar = xcd_barrier_post(barw, MISC);
#ifndef PHMASK
#define PHMASK 0x3FFF
#endif
#ifndef REPMASK
#define REPMASK 0
#endif
#define IN(k) (((PHMASK >> (k)) & 1) && lo <= (k) && (k) < hi)
#define REP(k) for (int rep_ = 0; rep_ < (((REPMASK >> (k)) & 1) ? 2 : 1); ++rep_)
#ifndef BARREP
#define BARREP 1
#endif
#define SEAM(k) do { if (IN(k) && IN((k) + 1)) for (int br_ = 0; br_ < BARREP; ++br_) xcd_barrier(bar); } while (0)
    unsigned char* ws = args.ws;
    if (IN(0)) REP(0) { if (rep_) __syncthreads(); p0_prologue(args, lds, vcu, G, wave, lane); } SEAM(0);
    if (IN(1)) REP(1) { if (rep_) __syncthreads(); p1_modnorm(args, vcu, G, wave, lane); } SEAM(1);
    if (IN(2)) REP(2) { if (rep_) __syncthreads(); pg8::Gemm g{(const f16*)(ws + WS_H), (const f16*)(ws + WS_WIN), MTOK, IN_PAD, D}; pg8::StaticOrder S; S.init(MTOK, IN_PAD, G, bx);
        pg8::EpiF16 E{(f16*)(ws + WS_PROJ), IN_PAD}; pg8::gemm_phase<pg8::EpiF16, pg8::StaticOrder, true, true>(lds, g, S, E); } SEAM(2);
#ifdef OLD_BASELINE
    if (IN(5)) REP(5) { if (rep_) __syncthreads(); p5_indexer(args, lds, vcu, G, wave, lane); } SEAM(5);
    if (IN(6)) REP(6) { if (rep_) __syncthreads(); p6_attention(args, lds, vcu, G, wave, lane); p3_rwkv_prep(args, lds, vcu, G, tid); } SEAM(6);
    if (IN(7)) REP(7) { if (rep_) __syncthreads(); p7_scan(args, lds, vcu, G, wave, lane); } SEAM(7);
    if (IN(8)) REP(8) { if (rep_) __syncthreads(); p8_rwkv_post(args, vcu, G, wave, lane); } SEAM(8);
#else
#define SEAMX() do { if (hi - lo > 1) for (int br_ = 0; br_ < BARREP; ++br_) xcd_barrier(bar); } while (0)
    if (IN(3)) REP(3) { if (rep_) __syncthreads(); p3_rows(args, vcu, G, wave, lane); }
    if (IN(6)) REP(6) { __syncthreads(); p7x_chunks(args, lds, vcu, G, tid, wave, lane); } SEAMX();
    if (IN(4)) REP(4) { if (rep_) __syncthreads(); pg8::Gemm g{(const f16*)(ws + WS_CQ), (const f16*)(ws + WS_WCQ), MTOK, NQI, QL}; pg8::StaticOrder S; S.init(MTOK, NQI, G, bx);
        pg8::EpiF16 E{(f16*)args.out, NQI}; pg8::gemm_phase<pg8::EpiF16, pg8::StaticOrder, true, true>(lds, g, S, E); }
    if (IN(7)) REP(7) { __syncthreads(); p7y_chain(args, bx, G, wave, lane); } SEAMX();
    if (IN(5)) REP(5) { if (rep_) __syncthreads(); p5_dsa(args, lds, G, bx, tid, wave, lane); }
    if (IN(8)) REP(8) { __syncthreads(); p8z_out(args, vcu, G, wave, lane); } SEAMX();
#endif
    if (IN(9)) REP(9) { if (rep_) __syncthreads(); pg8::Gemm g{(const f16*)(ws + WS_OATT), (const f16*)(ws + WS_WOUT), MTOK, D, KOUT}; pg8::StaticOrder S; S.init(MTOK, D, G, bx);
        pg8::EpiF16 E{(f16*)(ws + WS_MIX), D}; pg8::gemm_phase<pg8::EpiF16, pg8::StaticOrder, true, true>(lds, g, S, E); } SEAM(9);
    if (IN(10)) REP(10) { if (rep_) __syncthreads(); p10_mid(args, vcu, G, wave, lane); } SEAM(10);
    if (IN(11)) REP(11) { if (rep_) __syncthreads(); pg8::Gemm g{(const f16*)(ws + WS_H), (const f16*)(ws + WS_WGU), MTOK, 2 * DFF, D}; pg8::StaticOrder S; S.init(MTOK, 2 * DFF, G, bx);
        pg8::EpiSwiGLU E{(f16*)(ws + WS_ACT), DFF}; pg8::gemm_phase<pg8::EpiSwiGLU, pg8::StaticOrder, true, true>(lds, g, S, E); } SEAM(11);
    if (IN(12)) REP(12) { if (rep_) __syncthreads(); pg8::Gemm g{(const f16*)(ws + WS_ACT), (const f16*)(ws + WS_WDN), MTOK, D, DFF}; pg8::StaticOrder S; S.init(MTOK, D, G, bx);
        pg8::EpiF16 E{(f16*)(ws + WS_F), D}; pg8::gemm_phase<pg8::EpiF16, pg8::StaticOrder, true, true>(lds, g, S, E); } SEAM(12);
    if (IN(13)) REP(13) { if (rep_) __syncthreads(); p13_final(args, vcu, G, wave, lane); }
#undef IN
#undef SEAM
}

#ifndef N_LAUNCH_MODE
#define N_LAUNCH_MODE 1
#endif
extern "C" void kernel_launch(void* const* d_in, const int* in_sizes, int n_in, void* d_out, int out_size, void* d_ws, size_t ws_size, hipStream_t stream) {
    static int grid = 0;
    if (grid == 0) {
        int dev = 0, cus = 0, per_cu = 0;
        if (n_in != 32 || ws_size < WS_END) { fprintf(stderr, "kernel_launch: unexpected n_in %d or ws_size %zu (< %zu)\n", n_in, ws_size, (size_t)WS_END); }
        if (hipGetDevice(&dev) != hipSuccess || hipDeviceGetAttribute(&cus, hipDeviceAttributeMultiprocessorCount, dev) != hipSuccess) { grid = -1; return; }
        if (hipFuncSetAttribute((const void*)fwd, hipFuncAttributeMaxDynamicSharedMemorySize, LDS_BYTES) != hipSuccess) { fprintf(stderr, "kernel_launch: hipFuncSetAttribute failed\n"); grid = -1; return; }
        if (hipOccupancyMaxActiveBlocksPerMultiprocessor(&per_cu, (const void*)fwd, NWAVES * 64, LDS_BYTES) != hipSuccess || per_cu < 1) fprintf(stderr, "kernel_launch: occupancy query says %d\n", per_cu);
        (void)hipGetLastError();
        grid = cus;
    }
    if (grid < 0) return;
    (void)hipMemsetAsync((char*)d_ws + WS_CTL, 0, CTL_ZERO_BYTES, stream);
    Args a{};
    for (int i = 0; i < 32; ++i) a.in[i] = (const float*)d_in[i];
    a.out = (float*)d_out; a.ws = (unsigned char*)d_ws;
    if (N_LAUNCH_MODE == 1) { a.ph_lo = 0; a.ph_hi = NPHASE; hipLaunchKernelGGL(fwd, dim3(grid), dim3(NWAVES * 64), LDS_BYTES, stream, a); }
    else for (int p = 0; p < NPHASE; ++p) { a.ph_lo = p; a.ph_hi = p + 1; hipLaunchKernelGGL(fwd, dim3(grid), dim3(NWAVES * 64), LDS_BYTES, stream, a); }
}
```

```cpp
#include <hip/hip_runtime.h>
#include <cstdio>
#include <cstdint>

#define LAS __attribute__((address_space(3)))
#define GAS __attribute__((address_space(1)))
typedef _Float16 f16;
typedef _Float16 f16x8 __attribute__((ext_vector_type(8)));
typedef _Float16 f16x4 __attribute__((ext_vector_type(4)));
typedef _Float16 f16x2 __attribute__((ext_vector_type(2)));
typedef float f32x4 __attribute__((ext_vector_type(4)));
typedef float f32x2 __attribute__((ext_vector_type(2)));
typedef unsigned u32x4 __attribute__((ext_vector_type(4)));
typedef unsigned u32x2 __attribute__((ext_vector_type(2)));

__device__ __forceinline__ unsigned pkh(float a, float b) { f16x2 v = {(f16)a, (f16)b}; return __builtin_bit_cast(unsigned, v); }
__device__ __forceinline__ float h2f(f16 h) { return (float)h; }

namespace pg8 {
constexpr int BM = 256, BK = 64, HALF = 128, HTB = HALF * BK * 2, STAGE_BYTES = 8 * HTB, NXCD = 8, WGM = 8;
__host__ __device__ __forceinline__ int lds_byte(int r, int c) { const int st = (r >> 4) * 2 + (c >> 5), rr = r & 15, cc = c & 31, ob = rr * 64 + cc * 2; return st * 1024 + (ob ^ (((ob >> 9) & 1) << 5)); }
__host__ __device__ __forceinline__ void stage_rc(int b, int& R, int& C) { const int st = b / 1024, sb = b % 1024, swz = sb ^ (((sb >> 9) & 1) << 5); R = (st >> 1) * 16 + swz / 64; C = (st & 1) * 32 + (swz % 64) / 2; }
__host__ __device__ __forceinline__ int perm32(int rho) { const int n = rho >> 4, i = rho & 15; return 8 * (i >> 2) + 4 * n + (i & 3); }

struct Unit { int pm, pn; };
struct Gemm { const f16* A; const f16* Bt; int M, N, K; };

struct StaticOrder {
    int nM, nN, nwg, G, c;
    __host__ __device__ void init(int M, int N, int G_, int c_) { nM = M / BM; nN = N / BM; nwg = nM * nN; G = G_; c = c_; }
    __host__ __device__ bool next(int i, Unit& u) const {
        const long L = (long)i * G + c; if (L >= nwg) return false;
        int wgid = (int)L; { const int q = nwg / NXCD, r = nwg % NXCD, xcd = wgid % NXCD, off = wgid / NXCD; wgid = (xcd < r ? xcd * (q + 1) : r * (q + 1) + (xcd - r) * q) + off; }
        const int nig = WGM * nN, gid = wgid / nig, fm = gid * WGM, gsz = (nM - fm) < WGM ? (nM - fm) : WGM;
        u.pm = fm + ((wgid % nig) % gsz); u.pn = (wgid % nig) / gsz; return true;
    }
    __device__ __forceinline__ void a_ready(const Unit&) const {}
    __device__ __forceinline__ void done(const Unit&) const {}
};

struct EpiF16 {
    static constexpr bool PERM = true, AFTER_DRAIN = false;
    f16* O; int ldc;
    __device__ __forceinline__ void operator()(const f32x4 (&acc)[2][2][4][2], const Unit& u, int wr, int wc, int fr, int fq) const {
        const int row0 = u.pm * BM + wr * 64 + fr; const int col0 = u.pn * BM + wc * 32 + 8 * fq;
#pragma unroll
        for (int ai = 0; ai < 2; ++ai)
#pragma unroll
            for (int m = 0; m < 4; ++m) { f16* rowp = O + (size_t)(row0 + ai * HALF + m * 16) * ldc + col0;
#pragma unroll
                for (int bj = 0; bj < 2; ++bj) { const f32x4 v0 = acc[ai][bj][m][0], v1 = acc[ai][bj][m][1];
                    u32x4 w; w.x = pkh(v0[0], v0[1]); w.y = pkh(v0[2], v0[3]); w.z = pkh(v1[0], v1[1]); w.w = pkh(v1[2], v1[3]);
                    *(u32x4*)(rowp + bj * HALF) = w; } }
    }
};
struct EpiSwiGLU {
    static constexpr bool PERM = true, AFTER_DRAIN = false;
    f16* O; int ldc;
    __device__ __forceinline__ void operator()(const f32x4 (&acc)[2][2][4][2], const Unit& u, int wr, int wc, int fr, int fq) const {
        const int row0 = u.pm * BM + wr * 64 + fr; const int col0 = u.pn * HALF + wc * 32 + 8 * fq;
#pragma unroll
        for (int ai = 0; ai < 2; ++ai)
#pragma unroll
            for (int m = 0; m < 4; ++m) { f16* rowp = O + (size_t)(row0 + ai * HALF + m * 16) * ldc + col0;
                float o[8];
#pragma unroll
                for (int n = 0; n < 2; ++n)
#pragma unroll
                    for (int j = 0; j < 4; ++j) { const float g = acc[ai][0][m][n][j], up = acc[ai][1][m][n][j]; o[n * 4 + j] = g * __builtin_amdgcn_rcpf(1.0f + __expf(-g)) * up; }
                u32x4 w; w.x = pkh(o[0], o[1]); w.y = pkh(o[2], o[3]); w.z = pkh(o[4], o[5]); w.w = pkh(o[6], o[7]);
                *(u32x4*)rowp = w; }
    }
};

template <class Epi, class Sched, bool ALIGN_EPI = false, bool SP2 = false>
__device__ __forceinline__ void gemm_phase(LAS unsigned char* lds, const Gemm g, const Sched& S, const Epi& E) {
    const int tid = threadIdx.x, wid = __builtin_amdgcn_readfirstlane(tid >> 6), lane = tid & 63, wr = wid >> 2, wc = wid & 3, fr = lane & 15, fq = lane >> 4;
    const int K = g.K, nt = K / BK;
    unsigned voffA[2], voffB[2];
#pragma unroll
    for (int i = 0; i < 2; ++i) { int R, C; stage_rc(tid * 16 + i * 8192, R, C); const int Rb = Epi::PERM ? ((R & ~31) + perm32(R & 31)) : R;
        voffA[i] = (unsigned)(R * K + C) * 2u; voffB[i] = (unsigned)(Rb * K + C) * 2u; }
    const size_t kstep = (size_t)(BK * 2);
    const size_t hstep = (size_t)HALF * K * 2;
    const size_t tstep = 2 * hstep;
    const unsigned ldsw = (unsigned)wid * 1024u;
    const int aoff = lds_byte(wr * 64 + fr, fq * 8), boff = lds_byte(wc * 32 + fr, fq * 8);
#define PG8_SA(b, h) (((b) * 2 + (h)) * HTB)
#define PG8_SB(b, h) ((4 + (b) * 2 + (h)) * HTB)
#define PG8_STAGE(bufoff, gbase, voff) do { _Pragma("unroll") for (int _i = 0; _i < 2; ++_i) \
        __builtin_amdgcn_global_load_lds((const unsigned*)((const char*)(gbase) + (voff)[_i]), (LAS unsigned*)(lds + (bufoff) + ldsw + _i * 8192), 16, 0, 0); } while (0)
#define PG8_LDA(dst, b, h) do { _Pragma("unroll") for (int m = 0; m < 4; ++m) _Pragma("unroll") for (int k = 0; k < 2; ++k) dst[m][k] = *(const LAS f16x8*)(lds + PG8_SA(b, h) + aoff + m * 2048 + k * 1024); } while (0)
#define PG8_LDB(dst, b, h) do { _Pragma("unroll") for (int n = 0; n < 2; ++n) _Pragma("unroll") for (int k = 0; k < 2; ++k) dst[n][k] = *(const LAS f16x8*)(lds + PG8_SB(b, h) + boff + n * 2048 + k * 1024); } while (0)
#define PG8_MMA(ai, bj, At, Bt) do { __builtin_amdgcn_s_setprio(1); _Pragma("unroll") for (int m = 0; m < 4; ++m) _Pragma("unroll") for (int n = 0; n < 2; ++n) _Pragma("unroll") for (int k = 0; k < 2; ++k) \
        acc[ai][bj][m][n] = __builtin_amdgcn_mfma_f32_16x16x32_f16(Bt[n][k], At[m][k], acc[ai][bj][m][n], 0, 0, 0); __builtin_amdgcn_s_setprio(0); } while (0)
#define PG8_WAIT_V(n) asm volatile("s_waitcnt vmcnt(" #n ")" ::: "memory")
#define PG8_WAIT_L(n) asm volatile("s_waitcnt lgkmcnt(" #n ")" ::: "memory")
#define PG8_BAR __builtin_amdgcn_s_barrier()
#define PG8_SCHED __builtin_amdgcn_sched_barrier(0)
    Unit cur, nxt; int ui = 0;
    if (!S.next(0, cur)) return;
    f32x4 acc[2][2][4][2];
#pragma unroll
    for (int a = 0; a < 2; ++a)
#pragma unroll
        for (int b = 0; b < 2; ++b)
#pragma unroll
            for (int m = 0; m < 4; ++m)
#pragma unroll
                for (int n = 0; n < 2; ++n) acc[a][b][m][n] = (f32x4){0.f, 0.f, 0.f, 0.f};
    f16x8 At[4][2], B0[2][2], B1[2][2];
    const char* cA = (const char*)g.A + (size_t)cur.pm * tstep; const char* cB = (const char*)g.Bt + (size_t)cur.pn * tstep;
    S.a_ready(cur);
    if constexpr (SP2) {
        PG8_STAGE(PG8_SB(0, 0), cB, voffB); PG8_STAGE(PG8_SB(0, 1), cB + hstep, voffB); PG8_STAGE(PG8_SA(0, 0), cA, voffA); PG8_STAGE(PG8_SA(0, 1), cA + hstep, voffA);
        if (wr == 1) PG8_BAR;
        PG8_WAIT_V(2); PG8_BAR;
        PG8_STAGE(PG8_SB(1, 0), cB + kstep, voffB); PG8_STAGE(PG8_SA(1, 0), cA + kstep, voffA); PG8_STAGE(PG8_SB(1, 1), cB + hstep + kstep, voffB);
        PG8_WAIT_V(6); PG8_BAR;
    } else {
        PG8_STAGE(PG8_SB(0, 0), cB, voffB); PG8_STAGE(PG8_SA(0, 0), cA, voffA); PG8_STAGE(PG8_SB(0, 1), cB + hstep, voffB); PG8_STAGE(PG8_SA(0, 1), cA + hstep, voffA);
        if (wr == 1) PG8_BAR;
        PG8_WAIT_V(4); PG8_BAR;
        PG8_STAGE(PG8_SB(1, 0), cB + kstep, voffB); PG8_STAGE(PG8_SA(1, 0), cA + kstep, voffA); PG8_STAGE(PG8_SB(1, 1), cB + hstep + kstep, voffB);
        PG8_WAIT_V(6); PG8_BAR;
    }
    for (;;) {
        const bool has_next = S.next(ui + 1, nxt);
        const char* nA = has_next ? (const char*)g.A + (size_t)nxt.pm * tstep : cA; const char* nB = has_next ? (const char*)g.Bt + (size_t)nxt.pn * tstep : cB;
        for (int t = 0; t < nt; t += 2) {
            const bool last = (t == nt - 2);
            const char* a1 = cA + (size_t)(t + 1) * kstep;
            const char* a2 = last ? nA : cA + (size_t)(t + 2) * kstep; const char* b2 = last ? nB : cB + (size_t)(t + 2) * kstep;
            const char* a3 = a2 + kstep; const char* b3 = b2 + kstep;
            if (last && has_next) S.a_ready(nxt);
            if constexpr (SP2) {
            PG8_LDB(B0, 0, 0); PG8_LDB(B1, 0, 1); PG8_SCHED; PG8_LDA(At, 0, 0); PG8_STAGE(PG8_SA(1, 1), a1 + hstep, voffA);
            PG8_WAIT_V(8); PG8_WAIT_L(0); PG8_BAR; PG8_MMA(0, 0, At, B0); PG8_MMA(0, 1, At, B1); PG8_BAR; PG8_SCHED;
            PG8_LDA(At, 0, 1); PG8_STAGE(PG8_SB(0, 0), b2, voffB); PG8_STAGE(PG8_SB(0, 1), b2 + hstep, voffB); PG8_STAGE(PG8_SA(0, 0), a2, voffA);
            PG8_WAIT_V(8); PG8_WAIT_L(0); PG8_BAR; PG8_MMA(1, 0, At, B0); PG8_MMA(1, 1, At, B1); PG8_BAR; PG8_SCHED;
            PG8_LDB(B0, 1, 0); PG8_LDB(B1, 1, 1); PG8_SCHED; PG8_LDA(At, 1, 0); PG8_STAGE(PG8_SA(0, 1), a2 + hstep, voffA);
            PG8_WAIT_V(8); PG8_WAIT_L(0); PG8_BAR; PG8_MMA(0, 0, At, B0); PG8_MMA(0, 1, At, B1); PG8_BAR; PG8_SCHED;
            PG8_LDA(At, 1, 1); PG8_STAGE(PG8_SB(1, 0), b3, voffB); PG8_STAGE(PG8_SB(1, 1), b3 + hstep, voffB); PG8_STAGE(PG8_SA(1, 0), a3, voffA);
            PG8_WAIT_V(8); PG8_WAIT_L(0); PG8_BAR; PG8_MMA(1, 0, At, B0); PG8_MMA(1, 1, At, B1); PG8_BAR; PG8_SCHED;
            } else {
            PG8_LDB(B0, 0, 0); PG8_SCHED; PG8_LDA(At, 0, 0); PG8_STAGE(PG8_SA(1, 1), a1 + hstep, voffA);
            PG8_WAIT_L(8); PG8_BAR; PG8_WAIT_L(0); PG8_MMA(0, 0, At, B0); PG8_BAR; PG8_SCHED;
            PG8_LDB(B1, 0, 1); PG8_STAGE(PG8_SB(0, 0), b2, voffB);
            PG8_BAR; PG8_WAIT_L(0); PG8_MMA(0, 1, At, B1); PG8_BAR;
            PG8_LDA(At, 0, 1); PG8_STAGE(PG8_SA(0, 0), a2, voffA);
            PG8_BAR; PG8_WAIT_L(0); PG8_MMA(1, 0, At, B0); PG8_BAR; PG8_SCHED;
            PG8_STAGE(PG8_SB(0, 1), b2 + hstep, voffB);
            PG8_WAIT_V(6); PG8_BAR; PG8_MMA(1, 1, At, B1); PG8_BAR;
            PG8_LDB(B0, 1, 0); PG8_SCHED; PG8_LDA(At, 1, 0); PG8_STAGE(PG8_SA(0, 1), a2 + hstep, voffA);
            PG8_WAIT_L(8); PG8_BAR; PG8_WAIT_L(0); PG8_MMA(0, 0, At, B0); PG8_BAR; PG8_SCHED;
            PG8_LDB(B1, 1, 1); PG8_STAGE(PG8_SB(1, 0), b3, voffB);
            PG8_BAR; PG8_WAIT_L(0); PG8_MMA(0, 1, At, B1); PG8_BAR;
            PG8_LDA(At, 1, 1); PG8_STAGE(PG8_SA(1, 0), a3, voffA);
            PG8_BAR; PG8_WAIT_L(0); PG8_MMA(1, 0, At, B0); PG8_BAR; PG8_SCHED;
            PG8_STAGE(PG8_SB(1, 1), b3 + hstep, voffB);
            PG8_WAIT_V(6); PG8_BAR; PG8_MMA(1, 1, At, B1); PG8_BAR;
            }
        }
        if constexpr (ALIGN_EPI) { if (wr == 0) PG8_BAR; }
        if constexpr (!Epi::AFTER_DRAIN) { E(acc, cur, wr, wc, fr, fq); S.done(cur); }
        if (!has_next) break;
#pragma unroll
        for (int a = 0; a < 2; ++a)
#pragma unroll
            for (int b = 0; b < 2; ++b)
#pragma unroll
                for (int m = 0; m < 4; ++m)
#pragma unroll
                    for (int n = 0; n < 2; ++n) acc[a][b][m][n] = (f32x4){0.f, 0.f, 0.f, 0.f};
        cur = nxt; cA = nA; cB = nB; ++ui;
        if constexpr (ALIGN_EPI) { if (wr == 1) PG8_BAR; }
    }
    PG8_WAIT_V(0);
    if constexpr (!ALIGN_EPI) { if (wr == 0) PG8_BAR; }
    PG8_BAR;
#undef PG8_SA
#undef PG8_SB
#undef PG8_STAGE
#undef PG8_LDA
#undef PG8_LDB
#undef PG8_MMA
#undef PG8_WAIT_V
#undef PG8_WAIT_L
#undef PG8_BAR
#undef PG8_SCHED
}
}

#define XB_TMO      128
#define XB_XCNT(j)  (256  + 64 * (j))
#define XB_XSUB(j)  (1280 + 64 * (j))
#define XB_XGEN(j)  (2304 + 64 * (j))
#define XB_TOP      3328
#define XB_TOPGEN   3392
#define XCD_BAR_WORDS 3456
#define XB_SPIN_CAP (1u << 18)
__device__ __forceinline__ unsigned xb_ld(unsigned* p)              { return __hip_atomic_load(p, __ATOMIC_RELAXED, __HIP_MEMORY_SCOPE_AGENT); }
__device__ __forceinline__ unsigned xb_add(unsigned* p, unsigned v) { return __hip_atomic_fetch_add(p, v, __ATOMIC_RELAXED, __HIP_MEMORY_SCOPE_AGENT); }
__device__ __forceinline__ unsigned xb_xcc_id() { return (unsigned)__builtin_amdgcn_s_getreg((3 << 11) | 20) & 0xFu; }
#define XB_SPIN(cond, bar) do { unsigned _sp = 0; while (cond) { __builtin_amdgcn_s_sleep(1); \
    if ((++_sp & 255u) == 0u) { if (xb_ld(&(bar)[XB_TMO])) break; if (_sp > XB_SPIN_CAP) { atomicAdd(&(bar)[XB_TMO], 1u); break; } } } } while (0)
struct XcdBarrier { unsigned* bar; unsigned x; volatile LAS unsigned* st; };
__device__ __forceinline__ XcdBarrier xcd_barrier_post(unsigned* bar, volatile LAS unsigned* st) {
    XcdBarrier b; b.bar = bar; b.x = xb_xcc_id(); b.st = st;
    if (threadIdx.x == 0) (void)xb_add(&bar[XB_XCNT(b.x)], 1u);
    return b;
}
__device__ __forceinline__ void xcd_barrier_complete(unsigned* bar, unsigned x, unsigned& nloc, unsigned& nx) {
    const unsigned G = gridDim.x * gridDim.y * gridDim.z;
    unsigned sum, cnt, mine, sp = 0u;
    for (;;) {
        sum = 0u; cnt = 0u; mine = 0u;
#pragma unroll
        for (unsigned j = 0; j < 16; ++j) { const unsigned c = xb_ld(&bar[XB_XCNT(j)]); sum += c; cnt += (c > 0u) ? 1u : 0u; mine = (j == x) ? c : mine; }
        if (sum == G) break;
        __builtin_amdgcn_s_sleep(1);
        if ((++sp & 255u) == 0u) { if (xb_ld(&bar[XB_TMO])) break; if (sp > XB_SPIN_CAP) { atomicAdd(&bar[XB_TMO], 1u); break; } }
    }
    nloc = mine > 0u ? mine : 1u; nx = cnt > 0u ? cnt : 1u;
}
__device__ __forceinline__ void xcd_barrier(const XcdBarrier& b) {
    asm volatile("s_waitcnt vmcnt(0)" ::: "memory");
    __syncthreads();
    if (threadIdx.x == 0) {
        unsigned* bar = b.bar;
        __builtin_amdgcn_s_waitcnt(0);
        unsigned nloc = b.st[0], nx = b.st[1];
        if (nloc == 0u) { xcd_barrier_complete(bar, b.x, nloc, nx); b.st[0] = nloc; b.st[1] = nx; }
        const unsigned old = xb_add(&bar[XB_XSUB(b.x)], 1u);
        const unsigned gen = old / nloc;
        if (old + 1u == (gen + 1u) * nloc) {
            __builtin_amdgcn_fence(__ATOMIC_RELEASE, "agent");
            asm volatile("s_waitcnt vmcnt(0)" ::: "memory");
            const unsigned og = xb_add(&bar[XB_TOP], 1u);
            const unsigned tg = og / nx;
            if (og + 1u == (tg + 1u) * nx) xb_add(&bar[XB_TOPGEN], 1u);
            else XB_SPIN(xb_ld(&bar[XB_TOPGEN]) == tg, bar);
            __builtin_amdgcn_fence(__ATOMIC_ACQUIRE, "agent");
            xb_add(&bar[XB_XGEN(b.x)], 1u);
            asm volatile("s_waitcnt vmcnt(0)" ::: "memory");
        } else {
            XB_SPIN(xb_ld(&bar[XB_XGEN(b.x)]) == gen, bar);
            __builtin_amdgcn_fence(__ATOMIC_ACQUIRE, "agent");
            asm volatile("s_waitcnt vmcnt(0)" ::: "memory");
        }
    }
    __syncthreads();
}

constexpr int BATCH = 8, SEQ = 4096, D = 1024, MTOK = BATCH * SEQ;
constexpr int QL = 256, KVL = 128, IDXD = 64, IDXH = 8, HATT = 8, TOPK = 256;
constexpr int RW = 512, HRW = 8, NRW = 64;
constexpr int IN_COLS = 2280, IN_PAD = 2304;
constexpr int C_CQ = 0, C_CKV = 256, C_IK = 384, C_IW = 448, C_R = 456, C_K = 968, C_V = 1480, C_WD = 1992, C_AD = 2056, C_GD = 2120;
constexpr int DFF = 2816;
constexpr int NQI = 1536;
constexpr int KOUT = 1536;
constexpr float NORM_EPS = 1e-6f, GN_EPS = 64e-5f;

constexpr size_t MiB = 1u << 20;
constexpr size_t WS_CTL = 0, CTL_ZERO_BYTES = 64 * 1024;
constexpr size_t WS_MOD = 1 * MiB;
constexpr size_t WS_WIN = 2 * MiB;
constexpr size_t WS_WCQ = 7 * MiB;
constexpr size_t WS_WOUT = 8 * MiB;
constexpr size_t WS_WGU = 11 * MiB;
constexpr size_t WS_WDN = 22 * MiB;
constexpr size_t WS_H = 32 * MiB;
constexpr size_t WS_RWW = 32 * MiB, WS_RWA = 64 * MiB;
constexpr size_t WS_PROJ = 96 * MiB;
constexpr size_t WS_CQ = 240 * MiB;
constexpr size_t WS_SEL = 240 * MiB;
constexpr size_t WS_OATT = 256 * MiB;
constexpr size_t WS_CKV = 352 * MiB;
constexpr size_t WS_IK16 = 360 * MiB;
constexpr size_t WS_IK32 = 364 * MiB;
constexpr size_t WS_IW = 372 * MiB;
constexpr size_t WS_RWG = 376 * MiB;
constexpr size_t WS_YRAW = 408 * MiB;
constexpr size_t WS_MIX = 408 * MiB;
constexpr size_t WS_ACT = 96 * MiB;
constexpr size_t WS_F = 288 * MiB;
constexpr size_t WS_CKV8 = 368 * MiB;
constexpr size_t WS_END = 504 * MiB;

constexpr int CW_BAR = 1024;
constexpr int NWAVES = 8;
constexpr int RING_BYTES = 131072, AUX_OFF = RING_BYTES  , MISC_OFF = 163584, LDS_BYTES = 163648;

struct Args { const float* in[32]; float* out; unsigned char* ws; int ph_lo, ph_hi; };

__device__ __forceinline__ float wave_sum(float v) {
#pragma unroll
    for (int o = 1; o < 64; o <<= 1) v += __shfl_xor(v, o);
    return v;
}
__device__ __forceinline__ void lds_barrier() { asm volatile("s_waitcnt lgkmcnt(0)\n\ts_barrier" ::: "memory"); }
__device__ __forceinline__ float sigmoidf_(float x) { return __builtin_amdgcn_rcpf(1.0f + __expf(-x)); }

__device__ __forceinline__ void p0_transpose_item(const float* W, int K, int N, int Npad, f16* WT, int ldk, int koff, int row_off, int mode, LAS float* scr, int item, int lane) {
    const int nblk = Npad / 32, kb = item / nblk, nb = item % nblk, k0 = 64 * kb, n0 = 32 * nb;
    const int rr = lane >> 3, c4 = 4 * (lane & 7);
    f32x4 v[8];
#pragma unroll
    for (int i = 0; i < 8; ++i) { const int kk = 8 * i + rr; v[i] = (n0 + c4 < N && k0 + kk < K) ? *(const f32x4*)(W + (size_t)(k0 + kk) * N + n0 + c4) : (f32x4){0.f, 0.f, 0.f, 0.f}; }
#pragma unroll
    for (int i = 0; i < 8; ++i) { const int kk = 8 * i + rr; LAS float* d = scr + kk * 33 + c4; d[0] = v[i][0]; d[1] = v[i][1]; d[2] = v[i][2]; d[3] = v[i][3]; }
    asm volatile("s_waitcnt lgkmcnt(0)" ::: "memory");
    const int c = lane & 7;
#pragma unroll
    for (int j = 0; j < 4; ++j) { const int nl = (lane >> 3) + 8 * j; const LAS float* s = scr + (8 * c) * 33 + nl;
        u32x4 o; o.x = pkh(s[0 * 33], s[1 * 33]); o.y = pkh(s[2 * 33], s[3 * 33]); o.z = pkh(s[4 * 33], s[5 * 33]); o.w = pkh(s[6 * 33], s[7 * 33]);
        const int n = n0 + nl; int row;
        if (mode == 0) row = row_off + n; else row = (n >> 7) * 256 + (mode == 2 ? 128 : 0) + (n & 127);
        *(u32x4*)(WT + (size_t)row * ldk + koff + k0 + 8 * c) = o; }
    asm volatile("s_waitcnt lgkmcnt(0)" ::: "memory");
}

__device__ __forceinline__ void p0_prologue(const Args& a, LAS unsigned char* lds, int vcu, int G, int wave, int lane) {
    unsigned char* ws = a.ws;
    LAS float* scr = (LAS float*)(lds + wave * 16384);
    const int gw = vcu * NWAVES + wave, NGW = G * NWAVES;
    f16* Win = (f16*)(ws + WS_WIN); f16* Wcq = (f16*)(ws + WS_WCQ); f16* Wout = (f16*)(ws + WS_WOUT); f16* Wgu = (f16*)(ws + WS_WGU); f16* Wdn = (f16*)(ws + WS_WDN);
    constexpr int I_IN = (D / 64) * (IN_PAD / 32), I_IDX = (QL / 64) * (512 / 32), I_OR = (512 / 64) * (D / 32), I_G = (D / 64) * (DFF / 32), I_D = (DFF / 64) * (D / 32);
    constexpr int I_FQ = 4 * 64, I_FO = 16 * 64, I_MOD = 8 * 96, I_LD = 16, I_LG = 48;
    constexpr int NITEMS = I_IN + I_IDX + I_OR + 2 * I_G + I_D + I_FQ + I_FO + 2 * I_LD + I_LG;
    const bool split = (G == 256);
    const int gw2 = split ? (vcu - 96) * NWAVES + wave : gw, NGW2 = split ? (G - 96) * NWAVES : NGW;
    for (int it = gw2; it < NITEMS && gw2 >= 0; it += NGW2) {
        int r = it;
        if (r < I_IN) { p0_transpose_item(a.in[9], D, IN_COLS, IN_PAD, Win, D, 0, 0, 0, scr, r, lane); continue; } r -= I_IN;
        if (r < I_IDX) { p0_transpose_item(a.in[12], QL, 512, 512, Wcq, QL, 0, 1024, 0, scr, r, lane); continue; } r -= I_IDX;
        if (r < I_OR) { p0_transpose_item(a.in[28] + (size_t)512 * D, 512, D, D, Wout, KOUT, 1024, 0, 0, scr, r, lane); continue; } r -= I_OR;
        if (r < I_G) { p0_transpose_item(a.in[29], D, DFF, DFF, Wgu, D, 0, 0, 1, scr, r, lane); continue; } r -= I_G;
        if (r < I_G) { p0_transpose_item(a.in[30], D, DFF, DFF, Wgu, D, 0, 0, 2, scr, r, lane); continue; } r -= I_G;
        if (r < I_D) { p0_transpose_item(a.in[31], DFF, D, D, Wdn, DFF, 0, 0, 0, scr, r, lane); continue; } r -= I_D;
        if (r < I_FQ) {
            const int rb = r & 3, nb = r >> 2, rr = rb * 64 + lane, n0 = nb * 16, h = n0 >> 7;
            const float* uq = a.in[11] + (size_t)rr * 512 + h * 64; const float* uk = a.in[15] + (size_t)n0 * 64;
            float q[64];
#pragma unroll
            for (int d4 = 0; d4 < 16; ++d4) { const f32x4 v = *(const f32x4*)(uq + 4 * d4); q[4 * d4] = v[0]; q[4 * d4 + 1] = v[1]; q[4 * d4 + 2] = v[2]; q[4 * d4 + 3] = v[3]; }
#pragma unroll 4
            for (int i = 0; i < 16; ++i) { float s = 0.f;
#pragma unroll
                for (int d = 0; d < 64; ++d) s += q[d] * uk[i * 64 + d];
                Wcq[(size_t)(n0 + i) * QL + rr] = (f16)(0.125f * s); }
            continue; } r -= I_FQ;
        if (r < I_FO) {
            const int kb = r & 15, nb = r >> 4, k = kb * 64 + lane, h = kb >> 1, n0 = nb * 16;
            const float* uvp = a.in[16] + (size_t)k * 64; const float* wo = a.in[28] + (size_t)(h * 64) * D + n0;
            float uv[64];
#pragma unroll
            for (int d4 = 0; d4 < 16; ++d4) { const f32x4 v = *(const f32x4*)(uvp + 4 * d4); uv[4 * d4] = v[0]; uv[4 * d4 + 1] = v[1]; uv[4 * d4 + 2] = v[2]; uv[4 * d4 + 3] = v[3]; }
            float acc[16];
#pragma unroll
            for (int i = 0; i < 16; ++i) acc[i] = 0.f;
#pragma unroll
            for (int d = 0; d < 64; ++d) {
#pragma unroll
                for (int i = 0; i < 16; ++i) acc[i] += uv[d] * wo[(size_t)d * D + i]; }
#pragma unroll
            for (int i = 0; i < 16; ++i) Wout[(size_t)(n0 + i) * KOUT + k] = (f16)acc[i];
            continue; } r -= I_FO;
        if (r < I_LD) { p0_transpose_item(a.in[19], 64, 512, 512, (f16*)(ws + (28u << 20)), 64, 0, 0, 0, scr, r, lane); continue; } r -= I_LD;
        if (r < I_LD) { p0_transpose_item(a.in[21], 64, 512, 512, (f16*)(ws + (28u << 20) + 65536), 64, 0, 0, 0, scr, r, lane); continue; } r -= I_LD;
        { p0_transpose_item(a.in[22], 160, 512, 512, (f16*)(ws + (28u << 20) + 131072), 192, 0, 0, 0, scr, r, lane); }
    }
    if (vcu < 96) {
        __syncthreads();
        const int tid = wave * 64 + lane;
        for (int e = tid; e < 8 * D; e += 512) { const float cc = a.in[1][e]; *(LAS float*)(lds + (e >> 10) * 16384 + 10496 + (e & 1023) * 4) = cc * sigmoidf_(cc); }
        for (int cb = vcu; cb < 96; cb += G) {
            __syncthreads();
            const int j = cb * 64 + lane; const float* aw = a.in[3] + j;
            float acc[8];
#pragma unroll
            for (int b = 0; b < 8; ++b) acc[b] = 0.f;
            const int kbeg = wave * 128;
#pragma unroll 1
            for (int k0 = 0; k0 < 128; k0 += 16) {
                float wv[16];
#pragma unroll
                for (int i = 0; i < 16; ++i) wv[i] = aw[(size_t)(kbeg + k0 + i) * 6144];
#pragma unroll
                for (int b = 0; b < 8; ++b) {
#pragma unroll
                    for (int i4 = 0; i4 < 4; ++i4) { const f32x4 sv = *(const LAS f32x4*)(lds + b * 16384 + 10496 + (kbeg + k0 + 4 * i4) * 4);
                        acc[b] += sv[0] * wv[4 * i4] + sv[1] * wv[4 * i4 + 1] + sv[2] * wv[4 * i4 + 2] + sv[3] * wv[4 * i4 + 3]; } }
            }
#pragma unroll
            for (int b = 0; b < 8; ++b) *(LAS float*)(lds + wave * 16384 + 8448 + (b * 64 + lane) * 4) = acc[b];
            __syncthreads();
            float sum = 0.f;
#pragma unroll
            for (int w = 0; w < 8; ++w) sum += *(const LAS float*)(lds + w * 16384 + 8448 + (wave * 64 + lane) * 4);
            ((float*)(ws + WS_MOD))[wave * 6144 + j] = sum + a.in[4][j];
        }
    }
}

__device__ __forceinline__ void p1_modnorm(const Args& a, int vcu, int G, int wave, int lane) {
    const int gw = vcu * NWAVES + wave, NGW = G * NWAVES;
    const float* mod = (const float*)(a.ws + WS_MOD); f16* H = (f16*)(a.ws + WS_H);
    f32x4 gq[4];
#pragma unroll
    for (int j = 0; j < 4; ++j) gq[j] = *(const f32x4*)(a.in[5] + 4 * lane + 256 * j);
    f32x4 nv[4];
    if (gw < MTOK) {
#pragma unroll
        for (int j = 0; j < 4; ++j) nv[j] = __builtin_nontemporal_load((const f32x4*)(a.in[0] + (size_t)gw * D) + lane + 64 * j); }
    for (int m = gw; m < MTOK; m += NGW) {
        const int b = m >> 12;
        f32x4 v[4]; float s = 0.f;
#pragma unroll
        for (int j = 0; j < 4; ++j) { v[j] = nv[j]; s += (v[j][0] * v[j][0] + v[j][1] * v[j][1]) + (v[j][2] * v[j][2] + v[j][3] * v[j][3]); }
        const int mn = (m + NGW < MTOK) ? m + NGW : m;
#pragma unroll
        for (int j = 0; j < 4; ++j) nv[j] = __builtin_nontemporal_load((const f32x4*)(a.in[0] + (size_t)mn * D) + lane + 64 * j);
        const float r = rsqrtf(wave_sum(s) * (1.f / D) + NORM_EPS);
        u32x2* o = (u32x2*)(H + (size_t)m * D) + lane;
#pragma unroll
        for (int j = 0; j < 4; ++j) { const int c = 4 * lane + 256 * j;
            const f32x4 sh = *(const f32x4*)(mod + b * 6144 + c), sc = *(const f32x4*)(mod + b * 6144 + 1024 + c);
            f32x4 y;
#pragma unroll
            for (int e = 0; e < 4; ++e) y[e] = v[j][e] * r * gq[j][e] * (1.f + sc[e]) + sh[e];
            u32x2 w; w.x = pkh(y[0], y[1]); w.y = pkh(y[2], y[3]); o[64 * j] = w; }
    }
}

__device__ __forceinline__ void p3_rows(const Args& a, int vcu, int G, int wave, int lane) {
    const int gw = vcu * NWAVES + wave, NGW = G * NWAVES;
    unsigned char* ws = a.ws;
    const f16* PROJ = (const f16*)(ws + WS_PROJ);
    f16* CQ = (f16*)(ws + WS_CQ); f16* CKV = (f16*)(ws + WS_CKV); f16* IK16 = (f16*)(ws + WS_IK16); float* IW = (float*)(ws + WS_IW);
    const f32x4 gq = *(const f32x4*)(a.in[10] + 4 * lane); const f32x2 gk = *(const f32x2*)(a.in[13] + 2 * lane); const float gi = a.in[14][lane];
    f16x4 nq = {0, 0, 0, 0}; f16x2 nkv = {0, 0}; f16 nik = 0, niw = 0;
    if (gw < MTOK) { const f16* pr = PROJ + (size_t)gw * IN_PAD; nq = *(const f16x4*)(pr + C_CQ + 4 * lane); nkv = *(const f16x2*)(pr + C_CKV + 2 * lane); nik = pr[C_IK + lane]; niw = pr[C_IW + (lane & 7)]; }
    for (int m = gw; m < MTOK; m += NGW) {
        const f16x4 q = nq; const f16x2 kv = nkv; const float ik = (float)nik; const float iwv = (float)niw;
        { const int mn = (m + NGW < MTOK) ? m + NGW : m; const f16* pr = PROJ + (size_t)mn * IN_PAD; nq = *(const f16x4*)(pr + C_CQ + 4 * lane); nkv = *(const f16x2*)(pr + C_CKV + 2 * lane); nik = pr[C_IK + lane]; niw = pr[C_IW + (lane & 7)]; }
        float q0 = (float)q[0], q1 = (float)q[1], q2 = (float)q[2], q3 = (float)q[3], k0 = (float)kv[0], k1 = (float)kv[1];
        const float rq = rsqrtf(wave_sum(q0 * q0 + q1 * q1 + q2 * q2 + q3 * q3) * (1.f / QL) + NORM_EPS);
        const float rk = rsqrtf(wave_sum(k0 * k0 + k1 * k1) * (1.f / KVL) + NORM_EPS);
        const float ri = rsqrtf(wave_sum(ik * ik) * (1.f / IDXD) + NORM_EPS);
        u32x2 w; w.x = pkh(q0 * rq * gq[0], q1 * rq * gq[1]); w.y = pkh(q2 * rq * gq[2], q3 * rq * gq[3]);
        *(u32x2*)(CQ + (size_t)m * QL + 4 * lane) = w;
        ((unsigned short*)(ws + WS_CKV8))[(size_t)m * 64 + lane] = (unsigned short)__builtin_amdgcn_cvt_pk_fp8_f32(k0 * rk * gk[0], k1 * rk * gk[1], 0, false);
        const float ikn = ik * ri * gi;
        IK16[(size_t)m * IDXD + lane] = (f16)ikn;
        if (lane < 8) IW[(size_t)m * 8 + lane] = iwv * 0.04419417382415922f;
    }
}
__device__ __forceinline__ void p3_rwkv_prep(const Args& a, LAS unsigned char* lds, int vcu, int G, int tid) {
    unsigned char* ws = a.ws;
    const f16* PROJ = (const f16*)(ws + WS_PROJ);
    f16* RWW = (f16*)(ws + WS_RWW); f16* RWA = (f16*)(ws + WS_RWA); f16* RWG = (f16*)(ws + WS_RWG);
    LAS float* xs = (LAS float*)lds;
    const float* mu = a.in[17];
    const int ch = tid;
    const float w0 = a.in[18][ch], a0 = a.in[20][ch];
    for (int u = vcu; u < MTOK / 16; u += G) {
        const int m0 = u * 16;
        __syncthreads();
        for (int e = tid; e < 16 * 288; e += 512) {
            const int t = e / 288, col = e % 288, m = m0 + t;
            const float cur = (float)PROJ[(size_t)m * IN_PAD + C_WD + col];
            const float prev = ((m & (SEQ - 1)) != 0) ? (float)PROJ[(size_t)(m - 1) * IN_PAD + C_WD + col] : 0.f;
            float v = cur + mu[1536 + col] * (prev - cur);
            if (col < 64) v = tanhf(v); else if (col >= 128) v = sigmoidf_(v);
            xs[t * 288 + col] = v;
        }
        __syncthreads();
        float dl[16], al[16], gl[16];
#pragma unroll
        for (int t = 0; t < 16; ++t) { dl[t] = 0.f; al[t] = 0.f; gl[t] = 0.f; }
        for (int kk = 0; kk < 64; ++kk) {
            const float wd = a.in[19][kk * 512 + ch], wa = a.in[21][kk * 512 + ch];
#pragma unroll
            for (int t = 0; t < 16; ++t) { dl[t] += xs[t * 288 + kk] * wd; al[t] += xs[t * 288 + 64 + kk] * wa; }
        }
        for (int kk = 0; kk < 160; ++kk) {
            const float wg = a.in[22][kk * 512 + ch];
#pragma unroll
            for (int t = 0; t < 16; ++t) gl[t] += xs[t * 288 + 128 + kk] * wg;
        }
#pragma unroll
        for (int t = 0; t < 16; ++t) {
            const float z = -(w0 + dl[t]);
            const float sp = z > 20.f ? z : log1pf(__expf(z));
            const float wlog = -sp - 0.5f;
            const float lw = -__expf(wlog);
            const float av = sigmoidf_(a0 + al[t]);
            const size_t o = (size_t)(m0 + t) * RW + ch;
            RWW[o] = (f16)lw; RWA[o] = (f16)av; RWG[o] = (f16)gl[t];
        }
    }
}

__device__ __forceinline__ unsigned f2key(float f) { const unsigned u = __builtin_bit_cast(unsigned, f); return (u & 0x80000000u) ? ~u : (u | 0x80000000u); }
__device__ __forceinline__ void p5_indexer(const Args& a, LAS unsigned char* lds, int vcu, int G, int wave, int lane) {
    unsigned char* ws = a.ws;
    const f16* QI = (const f16*)a.out;
    const float* IK32 = (const float*)(ws + WS_IK32); const float* IW = (const float*)(ws + WS_IW);
    unsigned short* SEL = (unsigned short*)(ws + WS_SEL);
    LAS float* sc = (LAS float*)(lds + wave * 16384);
    LAS float* iq = (LAS float*)(lds + AUX_OFF + wave * 2048);
    const int gw = vcu * NWAVES + wave, NGW = G * NWAVES;
    for (int q = gw; q < MTOK; q += NGW) {
        const int b = q >> 12, t = q & (SEQ - 1);
        unsigned short* sel = SEL + (size_t)q * TOPK;
        if (t < TOPK) {
#pragma unroll
            for (int j = 0; j < 4; ++j) { const int s = lane + 64 * j; sel[s] = (s <= t) ? (unsigned short)s : (unsigned short)0xFFFF; }
            continue;
        }
        { const f16x8 v = *(const f16x8*)(QI + (size_t)q * NQI + 1024 + 8 * lane);
#pragma unroll
          for (int e = 0; e < 8; ++e) iq[8 * lane + e] = (float)v[e]; }
        float wq[8];
#pragma unroll
        for (int h = 0; h < 8; ++h) wq[h] = IW[(size_t)q * 8 + h];
        asm volatile("s_waitcnt lgkmcnt(0)" ::: "memory");
        const int nj = (t >> 6) + 1;
        for (int j = 0; j < nj; ++j) {
            const int s = j * 64 + lane;
            const float* kr = IK32 + ((size_t)(b << 12) + (s <= t ? s : t)) * IDXD;
            float kx[64];
#pragma unroll
            for (int d4 = 0; d4 < 16; ++d4) { const f32x4 v = *(const f32x4*)(kr + 4 * d4); kx[4 * d4] = v[0]; kx[4 * d4 + 1] = v[1]; kx[4 * d4 + 2] = v[2]; kx[4 * d4 + 3] = v[3]; }
            float score = 0.f;
#pragma unroll
            for (int h = 0; h < 8; ++h) { float d0 = 0.f;
#pragma unroll
                for (int d4 = 0; d4 < 16; ++d4) { const f32x4 qv = *(const LAS f32x4*)(iq + h * 64 + 4 * d4); d0 += qv[0] * kx[4 * d4]; d0 += qv[1] * kx[4 * d4 + 1]; d0 += qv[2] * kx[4 * d4 + 2]; d0 += qv[3] * kx[4 * d4 + 3]; }
                score += wq[h] * fmaxf(d0, 0.f); }
            sc[s] = (s <= t) ? score : -INFINITY;
        }
        asm volatile("s_waitcnt lgkmcnt(0)" ::: "memory");
        const int nvalid = nj * 64;
        unsigned key[64];
#pragma unroll
        for (int j = 0; j < 64; ++j) { const int s = lane * 64 + j; key[j] = (s < nvalid) ? f2key(sc[s]) : 0u; }
        unsigned prefix = 0u;
        for (int bit = 31; bit >= 0; --bit) {
            const unsigned cand = prefix | (1u << bit);
            int c = 0;
#pragma unroll
            for (int j = 0; j < 64; ++j) c += (key[j] >= cand) ? 1 : 0;
#pragma unroll
            for (int o = 1; o < 64; o <<= 1) c += __shfl_xor(c, o);
            if (c >= TOPK) prefix = cand;
        }
        int cgt = 0, ceq = 0;
#pragma unroll
        for (int j = 0; j < 64; ++j) { cgt += (key[j] > prefix) ? 1 : 0; ceq += (key[j] == prefix) ? 1 : 0; }
        int sgt = cgt, seq = ceq;
#pragma unroll
        for (int o = 1; o < 64; o <<= 1) { const int x = __shfl_up(sgt, o), y = __shfl_up(seq, o); if (lane >= o) { sgt += x; seq += y; } }
        const int tot_gt = __shfl(sgt, 63);
        int pos_gt = sgt - cgt, rank_eq = seq - ceq;
        const int need = TOPK - tot_gt;
#pragma unroll
        for (int j = 0; j < 64; ++j) {
            const int s = lane * 64 + j;
            if (key[j] > prefix) { sel[pos_gt] = (unsigned short)s; ++pos_gt; }
            else if (key[j] == prefix) { if (rank_eq < need) sel[tot_gt + rank_eq] = (unsigned short)s; ++rank_eq; }
        }
    }
}

__device__ __forceinline__ int t5_bucket(int rel) {
    if (rel < 16) return rel;
    const int l = 16 + (int)(logf((float)rel * (1.f / 16.f)) / 2.0794415416798357f * 16.f);
    return l < 31 ? l : 31;
}
__device__ __forceinline__ void p6_attention(const Args& a, LAS unsigned char* lds, int vcu, int G, int wave, int lane) {
    unsigned char* ws = a.ws;
    const f16* QI = (const f16*)a.out; const f16* CKV = (const f16*)(ws + WS_CKV);
    const unsigned short* SEL = (const unsigned short*)(ws + WS_SEL);
    f16* OATT = (f16*)(ws + WS_OATT);
    const float* rel_bias = a.in[2];
    LAS float* qa = (LAS float*)(lds + wave * 16384);
    LAS float* pp = (LAS float*)(lds + wave * 16384 + 4096);
    LAS int* sidx = (LAS int*)(lds + wave * 16384 + 12288);
    const int gw = vcu * NWAVES + wave, NGW = G * NWAVES;
    for (int q = gw; q < MTOK; q += NGW) {
        const int b = q >> 12, t = q & (SEQ - 1);
#pragma unroll
        for (int i = 0; i < 2; ++i) { const f16x8 v = *(const f16x8*)(QI + (size_t)q * NQI + 512 * i + 8 * lane);
#pragma unroll
            for (int e = 0; e < 8; ++e) qa[512 * i + 8 * lane + e] = (float)v[e]; }
        asm volatile("s_waitcnt lgkmcnt(0)" ::: "memory");
        float lg[4][8];
        int srow[4]; bool okv[4];
#pragma unroll
        for (int i = 0; i < 4; ++i) {
            const int sraw = SEL[(size_t)q * TOPK + lane + 64 * i];
            okv[i] = sraw != 0xFFFF && sraw <= t;
            srow[i] = okv[i] ? sraw : 0;
            sidx[lane + 64 * i] = okv[i] ? sraw : -1;
#pragma unroll
            for (int h = 0; h < 8; ++h) lg[i][h] = 0.f;
        }
#pragma unroll 1
        for (int c8 = 0; c8 < 16; ++c8) {
            f16x8 kv[4];
#pragma unroll
            for (int i = 0; i < 4; ++i) kv[i] = *(const f16x8*)(CKV + ((size_t)(b << 12) + srow[i]) * KVL + 8 * c8);
#pragma unroll
            for (int h = 0; h < 8; ++h) {
                const f32x4 q0 = *(const LAS f32x4*)(qa + h * 128 + 8 * c8), q1 = *(const LAS f32x4*)(qa + h * 128 + 8 * c8 + 4);
#pragma unroll
                for (int i = 0; i < 4; ++i)
                    lg[i][h] += q0[0] * (float)kv[i][0] + q0[1] * (float)kv[i][1] + q0[2] * (float)kv[i][2] + q0[3] * (float)kv[i][3] + q1[0] * (float)kv[i][4] + q1[1] * (float)kv[i][5] + q1[2] * (float)kv[i][6] + q1[3] * (float)kv[i][7];
            }
        }
#pragma unroll
        for (int i = 0; i < 4; ++i) {
            const int bk = t5_bucket(t - srow[i]);
#pragma unroll
            for (int h = 0; h < 8; ++h) lg[i][h] = okv[i] ? lg[i][h] + rel_bias[bk * 8 + h] : -INFINITY;
        }
#pragma unroll
        for (int h = 0; h < 8; ++h) {
            float mx = fmaxf(fmaxf(lg[0][h], lg[1][h]), fmaxf(lg[2][h], lg[3][h]));
#pragma unroll
            for (int o = 1; o < 64; o <<= 1) mx = fmaxf(mx, __shfl_xor(mx, o));
            float e[4], s = 0.f;
#pragma unroll
            for (int i = 0; i < 4; ++i) { e[i] = __expf(lg[i][h] - mx); s += e[i]; }
            s = wave_sum(s);
            const float inv = 1.f / s;
#pragma unroll
            for (int i = 0; i < 4; ++i) pp[h * 256 + lane + 64 * i] = e[i] * inv;
        }
        asm volatile("s_waitcnt lgkmcnt(0)" ::: "memory");
        float o0[8], o1[8];
#pragma unroll
        for (int h = 0; h < 8; ++h) { o0[h] = 0.f; o1[h] = 0.f; }
        for (int kk = 0; kk < TOPK; ++kk) {
            const int s = sidx[kk];
            if (s < 0) continue;
            const f16x2 kv = *(const f16x2*)(CKV + ((size_t)(b << 12) + s) * KVL + 2 * lane);
            const float v0 = (float)kv[0], v1 = (float)kv[1];
#pragma unroll
            for (int h = 0; h < 8; ++h) { const float p = pp[h * 256 + kk]; o0[h] += p * v0; o1[h] += p * v1; }
        }
#pragma unroll
        for (int h = 0; h < 8; ++h) *(unsigned*)(OATT + (size_t)q * KOUT + h * 128 + 2 * lane) = pkh(o0[h], o1[h]);
        asm volatile("s_waitcnt lgkmcnt(0)" ::: "memory");
    }
}

constexpr int SC_PITCH = 8224, DSA_SEL_OFF = 16 * SC_PITCH, DSA_BL_OFF = DSA_SEL_OFF + 8192, DSA_HIST_OFF = 143936;
static_assert(DSA_BL_OFF + 129 * 8 * 4 <= DSA_HIST_OFF && DSA_HIST_OFF + 8 * 2304 <= MISC_OFF, "DSA LDS map");
typedef short v4i16_t __attribute__((ext_vector_type(4)));
__device__ __forceinline__ unsigned kv_off(unsigned row, unsigned ch) { return 256u * row + 16u * (ch ^ (((row & 3u) << 2) | ((row >> 2) & 3u))); }
__device__ __forceinline__ f16x4 tr_read16(LAS unsigned char* p) { return __builtin_bit_cast(f16x4, __builtin_amdgcn_ds_read_tr16_b64_v4i16((LAS v4i16_t*)p)); }
template <int CTRL, int RMASK> __device__ __forceinline__ int dpp_i(int x) { return __builtin_amdgcn_update_dpp(0, x, CTRL, RMASK, 0xF, false); }
template <int CTRL> __device__ __forceinline__ int dpp_iz(int x) { return __builtin_amdgcn_update_dpp(0, x, CTRL, 0xF, 0xF, true); }
__device__ __forceinline__ int wave_incl_scan_i(int x) { x += dpp_iz<0x111>(x); x += dpp_iz<0x112>(x); x += dpp_iz<0x114>(x); x += dpp_iz<0x118>(x);
    x += dpp_i<0x142, 0xA>(x); x += dpp_i<0x143, 0xC>(x); return x; }
__device__ __forceinline__ void p5_dsa(const Args& a, LAS unsigned char* lds, int G, int bx, int tid, int wave, int lane) {
    unsigned char* ws = a.ws;
    const f16* QI = (const f16*)a.out; const f16* IK16 = (const f16*)(ws + WS_IK16); const float* IW = (const float*)(ws + WS_IW);
    const f16* CKV = (const f16*)(ws + WS_CKV); f16* OATT = (f16*)(ws + WS_OATT);
    LAS unsigned short* SELL = (LAS unsigned short*)(lds + DSA_SEL_OFF);
    LAS float* BL = (LAS float*)(lds + DSA_BL_OFF);
    for (int e = tid; e < 129 * 8; e += 512) { const int rel = e >> 3, h = e & 7; BL[e] = a.in[2][t5_bucket(rel) * 8 + h] * 1.4426950408889634f; }
    const int nunits = BATCH * (SEQ / 16);
    const bool balanced = (G == 256);
    const int niter = balanced ? 8 : (nunits + G - 1) / G;
#pragma unroll 1
    for (int it = 0; it < niter; ++it) {
        int b, tile;
        if (balanced) { b = bx & 7; const int r = bx >> 3, base = 64 * (it >> 1); tile = (it & 1) ? base + 63 - r : base + r; }
        else { const int u = it * G + bx; if (u >= nunits) break; b = u >> 8; tile = u & 255; }
        int lane_o = lane; asm volatile("" : "+v"(lane_o));
        const int r16 = lane_o & 15, g = lane_o >> 4;
        const int t0 = tile * 16;
        const size_t qb = (size_t)(b << 12);
        const int jn = ((t0 + 15) >> 7) + 1;
        lds_barrier();
#ifndef DSAREP
#define DSAREP 0
#endif
#ifndef DSA_NO_A
        for (int ra_ = 0; ra_ < ((DSAREP & 1) ? 2 : 1); ++ra_)
        if (t0 + 15 >= TOPK) {
            f16x8 afr[8][2]; f32x4 wv[4][2];
#pragma unroll
            for (int mt = 0; mt < 8; ++mt) { const int tg = mt >> 1, hf = mt & 1, t = t0 + 4 * tg + (r16 >> 2), h = 4 * hf + (r16 & 3);
#pragma unroll
                for (int ks = 0; ks < 2; ++ks) afr[mt][ks] = *(const f16x8*)(QI + (qb + t) * NQI + 1024 + h * 64 + 32 * ks + 8 * g); }
#pragma unroll
            for (int tg = 0; tg < 4; ++tg)
#pragma unroll
                for (int hf = 0; hf < 2; ++hf) wv[tg][hf] = *(const f32x4*)(IW + (qb + t0 + 4 * tg + g) * 8 + 4 * hf) * 65536.0f;
            const f32x2 cscale = {1.52587890625e-05f, 1.52587890625e-05f};
            f16x8 bn0[2], bn1[2], bn2[2];
            const f16* ikp = IK16 + (qb + 16 * wave + r16) * IDXD + 8 * g;
#define A_LOAD(BN, j_) do { const f16* p_ = ikp + (size_t)(128 * (j_)) * IDXD; asm volatile("global_load_dwordx4 %0, %2, off\n\tglobal_load_dwordx4 %1, %2, off offset:64" : "=&v"(BN[0]), "=&v"(BN[1]) : "v"(p_) : "memory"); } while (0)
#define A_WAIT(BN) asm volatile("s_waitcnt vmcnt(4)" : "+v"(BN[0]), "+v"(BN[1]) :: "memory")
#define A_STEP(BN, j_) do { const int j = (j_); const int s = 128 * j + 16 * wave + r16; A_WAIT(BN); f16x8 bfr[2]; bfr[0] = BN[0]; bfr[1] = BN[1]; \
                f32x4 acc[8]; \
_Pragma("unroll") \
                for (int mt = 0; mt < 8; ++mt) { acc[mt] = __builtin_amdgcn_mfma_f32_16x16x32_f16(afr[mt][0], bfr[0], (f32x4){0.f, 0.f, 0.f, 0.f}, 0, 0, 0); \
                    acc[mt] = __builtin_amdgcn_mfma_f32_16x16x32_f16(afr[mt][1], bfr[1], acc[mt], 0, 0, 0); } \
                asm volatile("s_nop 15\n\ts_nop 7" :: "v"(acc[0]), "v"(acc[1]), "v"(acc[2]), "v"(acc[3]), "v"(acc[4]), "v"(acc[5]), "v"(acc[6]), "v"(acc[7])); \
                float scv[4]; \
_Pragma("unroll") \
                for (int tg = 0; tg < 4; ++tg) { f32x2 s2 = {0.f, 0.f}; \
_Pragma("unroll") \
                    for (int hf = 0; hf < 2; ++hf) \
_Pragma("unroll") \
                        for (int p = 0; p < 2; ++p) { const f32x2 av = {acc[2 * tg + hf][2 * p], acc[2 * tg + hf][2 * p + 1]}; f32x2 r; \
                            asm volatile("v_pk_mul_f32 %0, %1, %2 clamp" : "=v"(r) : "v"(av), "v"(cscale)); \
                            const f32x2 wp = {wv[tg][hf][2 * p], wv[tg][hf][2 * p + 1]}; s2 = r * wp + s2; } \
                    scv[tg] = s2[0] + s2[1]; } \
                if (j == jn - 1) { \
_Pragma("unroll") \
                    for (int tg = 0; tg < 4; ++tg) if (s > t0 + 4 * tg + g) scv[tg] = -INFINITY; } \
_Pragma("unroll") \
                for (int pr = 0; pr < 2; ++pr) { \
                    const unsigned x = pkh(scv[2 * pr], scv[2 * pr + 1]); \
                    const unsigned k2 = x ^ ((((x >> 15) & 0x00010001u) * 0x7FFFu) | 0x80008000u); \
                    *(LAS unsigned short*)(lds + (4 * (2 * pr) + g) * SC_PITCH + s * 2) = (unsigned short)(k2 & 0xFFFFu); \
                    *(LAS unsigned short*)(lds + (4 * (2 * pr + 1) + g) * SC_PITCH + s * 2) = (unsigned short)(k2 >> 16); } \
                A_LOAD(BN, (j + 3 < jn) ? j + 3 : jn - 1); } while (0)
            A_LOAD(bn0, 0); A_LOAD(bn1, (jn > 1) ? 1 : 0); A_LOAD(bn2, (jn > 2) ? 2 : jn - 1);
#pragma unroll 1
            for (int j3 = 0; j3 < jn; j3 += 3) { A_STEP(bn0, j3); if (j3 + 1 < jn) A_STEP(bn1, j3 + 1); if (j3 + 2 < jn) A_STEP(bn2, j3 + 2); }
            asm volatile("s_waitcnt vmcnt(0)" : "+v"(bn0[0]), "+v"(bn0[1]), "+v"(bn1[0]), "+v"(bn1[1]), "+v"(bn2[0]), "+v"(bn2[1]) :: "memory");
#undef A_LOAD
#undef A_WAIT
#undef A_STEP
        }
#endif
        __builtin_amdgcn_sched_barrier(0); lds_barrier(); __builtin_amdgcn_sched_barrier(0);
#ifndef DSA_NO_C
        {
            const int rlA = 2 * wave, rlB = 2 * wave + 1, tA = t0 + rlA, tB = t0 + rlB;
            LAS unsigned short* selA = SELL + rlA * 256; LAS unsigned short* selB = SELL + rlB * 256;
            if (tA < TOPK) {
#pragma unroll
                for (int k = 0; k < 4; ++k) { const int jx = lane_o + 64 * k; selA[jx] = (jx <= tA) ? (unsigned short)jx : (unsigned short)0xFFFF; selB[jx] = (jx <= tB) ? (unsigned short)jx : (unsigned short)0xFFFF; }
            } else {
                const LAS unsigned* srA = (const LAS unsigned*)(lds + rlA * SC_PITCH) + lane_o; const LAS unsigned* srB = (const LAS unsigned*)(lds + rlB * SC_PITCH) + lane_o;
                LAS unsigned* hA = (LAS unsigned*)(lds + DSA_HIST_OFF + wave * 2304); LAS unsigned* hB = hA + 256; LAS unsigned* hD = hA + 512;
                unsigned pfA = 0u, pfB = 0u; int knA = TOPK, knB = TOPK;
#pragma unroll 1
                for (int pass = 0; pass < 2; ++pass) {
                    *(LAS u32x4*)(hA + 4 * lane_o) = (u32x4){0u, 0u, 0u, 0u}; *(LAS u32x4*)(hB + 4 * lane_o) = (u32x4){0u, 0u, 0u, 0u};
                    asm volatile("s_waitcnt lgkmcnt(0)" ::: "memory");
                    if (pass == 0) {
#pragma unroll 4
                        for (int jj = 0; jj < jn; ++jj) { const unsigned ka = srA[jj * 64], kb_ = srB[jj * 64];
                            __hip_atomic_fetch_add(hA + (ka >> 24), 1u, __ATOMIC_RELAXED, __HIP_MEMORY_SCOPE_WORKGROUP); __hip_atomic_fetch_add(hB + (kb_ >> 24), 1u, __ATOMIC_RELAXED, __HIP_MEMORY_SCOPE_WORKGROUP);
                            __hip_atomic_fetch_add(hA + ((ka >> 8) & 0xFFu), 1u, __ATOMIC_RELAXED, __HIP_MEMORY_SCOPE_WORKGROUP); __hip_atomic_fetch_add(hB + ((kb_ >> 8) & 0xFFu), 1u, __ATOMIC_RELAXED, __HIP_MEMORY_SCOPE_WORKGROUP); }
                    } else {
                        LAS unsigned* dmp = hD + lane_o;
#pragma unroll 4
                        for (int jj = 0; jj < jn; ++jj) { const unsigned ka = srA[jj * 64], kb_ = srB[jj * 64];
                            __hip_atomic_fetch_add(((ka >> 24) == pfA) ? hA + ((ka >> 16) & 0xFFu) : dmp, 1u, __ATOMIC_RELAXED, __HIP_MEMORY_SCOPE_WORKGROUP);
                            __hip_atomic_fetch_add(((kb_ >> 24) == pfB) ? hB + ((kb_ >> 16) & 0xFFu) : dmp, 1u, __ATOMIC_RELAXED, __HIP_MEMORY_SCOPE_WORKGROUP);
                            __hip_atomic_fetch_add((((ka >> 8) & 0xFFu) == pfA) ? hA + (ka & 0xFFu) : dmp, 1u, __ATOMIC_RELAXED, __HIP_MEMORY_SCOPE_WORKGROUP);
                            __hip_atomic_fetch_add((((kb_ >> 8) & 0xFFu) == pfB) ? hB + (kb_ & 0xFFu) : dmp, 1u, __ATOMIC_RELAXED, __HIP_MEMORY_SCOPE_WORKGROUP); }
                    }
                    asm volatile("s_waitcnt lgkmcnt(0)" ::: "memory");
#define DSA_FIND(H, PF, KN) do { const u32x4 hv = *(const LAS u32x4*)(H + 4 * lane_o); const int sl = (int)(hv.x + hv.y + hv.z + hv.w); \
                        const int pre = wave_incl_scan_i(sl); const int tot = __builtin_amdgcn_readlane(pre, 63); const int S = tot - pre + sl; const int excl = S - sl; \
                        const unsigned long long bm = __ballot(excl < KN && S >= KN); const int L = bm ? (int)__builtin_ctzll(bm) : 0; \
                        const int ex = __builtin_amdgcn_readlane(excl, L); const int h1 = __builtin_amdgcn_readlane((int)hv.y, L), h2 = __builtin_amdgcn_readlane((int)hv.z, L), h3 = __builtin_amdgcn_readlane((int)hv.w, L); \
                        int cabove = ex, bin; \
                        if (cabove + h3 >= KN) bin = 3; else { cabove += h3; if (cabove + h2 >= KN) bin = 2; else { cabove += h2; if (cabove + h1 >= KN) bin = 1; else { cabove += h1; bin = 0; } } } \
                        PF = (PF << 8) | (unsigned)(4 * L + bin); KN -= cabove; } while (0)
                    DSA_FIND(hA, pfA, knA); DSA_FIND(hB, pfB, knB);
#undef DSA_FIND
                }
                const unsigned loA = pfA << 16, hiA = (pfA + 1u) << 16, loB = pfB << 16, hiB = (pfB + 1u) << 16;
                const int tgA = TOPK - knA, tgB = TOPK - knB;
                LAS unsigned short* dumpp = (LAS unsigned short*)hD + lane_o;
                int baseA = 0, tbA = 0, baseB = 0, tbB = 0;
#define DSA_EMIT(K, SEL, LO, HI, BASE, TB, TG, KN) do { const unsigned kq_ = (K) << 16; const bool g0 = kq_ >= HI, g1 = (K) >= HI; \
                    const unsigned long long m0 = __ballot(g0), m1 = __ballot(g1); \
                    const int p0 = BASE + (int)__builtin_amdgcn_mbcnt_hi((unsigned)(m0 >> 32), __builtin_amdgcn_mbcnt_lo((unsigned)m0, 0u)); BASE += __popcll(m0); \
                    const int p1 = BASE + (int)__builtin_amdgcn_mbcnt_hi((unsigned)(m1 >> 32), __builtin_amdgcn_mbcnt_lo((unsigned)m1, 0u)); BASE += __popcll(m1); \
                    *(g0 ? SEL + p0 : dumpp) = (unsigned short)s0; *(g1 ? SEL + p1 : dumpp) = (unsigned short)(s0 + 1); \
                    const bool e0 = (kq_ >= LO) && !g0, e1 = ((K) >= LO) && !g1; const unsigned long long t0m = __ballot(e0), t1m = __ballot(e1); \
                    if (t0m | t1m) { const int r0 = TB + (int)__builtin_amdgcn_mbcnt_hi((unsigned)(t0m >> 32), __builtin_amdgcn_mbcnt_lo((unsigned)t0m, 0u)); TB += __popcll(t0m); \
                        const int r1 = TB + (int)__builtin_amdgcn_mbcnt_hi((unsigned)(t1m >> 32), __builtin_amdgcn_mbcnt_lo((unsigned)t1m, 0u)); TB += __popcll(t1m); \
                        if (e0 && r0 < KN) SEL[TG + r0] = (unsigned short)s0; if (e1 && r1 < KN) SEL[TG + r1] = (unsigned short)(s0 + 1); } } while (0)
#pragma unroll 2
                for (int jj = 0; jj < jn; ++jj) { const unsigned ka = srA[jj * 64], kb2 = srB[jj * 64]; const int s0 = 2 * (jj * 64 + lane_o);
                    DSA_EMIT(ka, selA, loA, hiA, baseA, tbA, tgA, knA); DSA_EMIT(kb2, selB, loB, hiB, baseB, tbB, tgB, knB); }
#undef DSA_EMIT
            }
        }
#endif
        __builtin_amdgcn_sched_barrier(0); lds_barrier(); __builtin_amdgcn_sched_barrier(0);
#ifndef DSA_NO_D
        LAS unsigned char* kvb = lds + wave * 16384;
        const unsigned char* CKV8 = ws + WS_CKV8;
#pragma unroll 1
        for (int rr = 0; rr < ((DSAREP & 4) ? 4 : 2); ++rr) {
            const int rl = 2 * wave + (rr & 1), t = t0 + rl; const size_t q = qb + t;
            const LAS unsigned short* sel = SELL + rl * 256;
            long qf8[4];
#pragma unroll
            for (int ks = 0; ks < 4; ++ks) { const f16x8 v = *(const f16x8*)(QI + q * NQI + (r16 & 7) * 128 + 32 * ks + 8 * g); const float zs = (r16 >= 8) ? 0.f : 64.f;
                int lo32 = __builtin_amdgcn_cvt_pk_fp8_f32((float)v[0] * zs, (float)v[1] * zs, 0, false); lo32 = __builtin_amdgcn_cvt_pk_fp8_f32((float)v[2] * zs, (float)v[3] * zs, lo32, true);
                int hi32 = __builtin_amdgcn_cvt_pk_fp8_f32((float)v[4] * zs, (float)v[5] * zs, 0, false); hi32 = __builtin_amdgcn_cvt_pk_fp8_f32((float)v[6] * zs, (float)v[7] * zs, hi32, true);
                qf8[ks] = (long)(((unsigned long long)(unsigned)hi32 << 32) | (unsigned)lo32); }
            const LAS float* BLh = BL + (r16 & 7);
            float m_run = -1e30f, l_run = 0.f;
            f32x4 oE[4], oO[4];
#pragma unroll
            for (int cb = 0; cb < 4; ++cb) { oE[cb] = (f32x4){0.f, 0.f, 0.f, 0.f}; oO[cb] = (f32x4){0.f, 0.f, 0.f, 0.f}; }
            const int nch = (t < TOPK) ? (t >> 6) + 1 : 4;
#define DSA_DMA(ch_) do { unsigned so_[8]; _Pragma("unroll") for (int i = 0; i < 8; ++i) { const int R = 8 * i + (lane_o >> 3); \
                const unsigned ix = sel[64 * (ch_) + R]; const unsigned srow = (ix == 0xFFFFu) ? 0u : ix; so_[i] = srow * 128u + 16u * (((unsigned)lane_o & 7u) ^ ((unsigned)R & 7u)); } \
            _Pragma("unroll") for (int i = 0; i < 8; ++i) __builtin_amdgcn_global_load_lds((const unsigned*)(ckvb + so_[i]), (LAS unsigned*)(kvb + i * 1024), 16, 0, 0); } while (0)
            const unsigned char* ckvb = CKV8 + qb * 128;
            asm volatile("s_waitcnt vmcnt(0)" ::: "memory");
            DSA_DMA(0);
            const int qq = (lane_o & 15) >> 2, pp = lane_o & 3;
            unsigned offA[4][4], offT[4][2][2];
#pragma unroll
            for (int mt = 0; mt < 4; ++mt) { const int row = 16 * mt + r16;
#pragma unroll
                for (int ks = 0; ks < 4; ++ks) offA[mt][ks] = row * 128 + 16 * ((2 * ks + (g >> 1)) ^ (row & 7)) + 8 * (g & 1); }
#pragma unroll
            for (int cb = 0; cb < 4; ++cb)
#pragma unroll
                for (int k2 = 0; k2 < 2; ++k2) { const int r1 = 32 * k2 + 4 * g + qq, r2 = r1 + 16;
                    offT[cb][k2][0] = r1 * 128 + 16 * ((2 * cb + (pp >> 1)) ^ (r1 & 7)) + 8 * (pp & 1); offT[cb][k2][1] = r2 * 128 + 16 * ((2 * cb + (pp >> 1)) ^ (r2 & 7)) + 8 * (pp & 1); }
#define DSA_CHUNK(CHK) do { \
                asm volatile("s_waitcnt vmcnt(0)" ::: "memory"); \
                long af[4][4]; u32x2 td[4][2][2]; \
                _Pragma("unroll") for (int mt = 0; mt < 4; ++mt) \
                    _Pragma("unroll") for (int ks = 0; ks < 4; ++ks) af[mt][ks] = *(const LAS long*)(kvb + offA[mt][ks]); \
                _Pragma("unroll") for (int cb = 0; cb < 4; ++cb) \
                    _Pragma("unroll") for (int k2 = 0; k2 < 2; ++k2) { td[cb][k2][0] = __builtin_bit_cast(u32x2, tr_read16(kvb + offT[cb][k2][0])); td[cb][k2][1] = __builtin_bit_cast(u32x2, tr_read16(kvb + offT[cb][k2][1])); } \
                float bvv[4][4]; bool inv4[4][4]; \
                _Pragma("unroll") for (int mt = 0; mt < 4; ++mt) { const u32x2 pk2 = *(const LAS u32x2*)(sel + 64 * ch + 16 * mt + 4 * g); \
                    _Pragma("unroll") for (int e = 0; e < 4; ++e) { const unsigned ix = ((e & 2) ? pk2.y : pk2.x) >> ((e & 1) * 16) & 0xFFFFu; \
                        const int rel = t - (int)ix; const int rc = (CHK) ? min(max(rel, 0), 128) : min(rel, 128); \
                        inv4[mt][e] = (CHK) && (ix == 0xFFFFu); bvv[mt][e] = BLh[rc * 8]; } } \
                asm volatile("s_waitcnt lgkmcnt(0)" : "+v"(bvv[0][0]), "+v"(bvv[0][1]), "+v"(bvv[0][2]), "+v"(bvv[0][3]), "+v"(bvv[1][0]), "+v"(bvv[1][1]), "+v"(bvv[1][2]), "+v"(bvv[1][3]), \
                             "+v"(bvv[2][0]), "+v"(bvv[2][1]), "+v"(bvv[2][2]), "+v"(bvv[2][3]), "+v"(bvv[3][0]), "+v"(bvv[3][1]), "+v"(bvv[3][2]), "+v"(bvv[3][3]) :: "memory"); \
                if (ch + 1 < nch) DSA_DMA(ch + 1); \
                f32x4 lg[4]; \
                _Pragma("unroll") for (int mt = 0; mt < 4; ++mt) { lg[mt] = (f32x4){0.f, 0.f, 0.f, 0.f}; \
                    _Pragma("unroll") for (int ks = 0; ks < 4; ++ks) lg[mt] = __builtin_amdgcn_mfma_f32_16x16x32_fp8_fp8(af[mt][ks], qf8[ks], lg[mt], 0, 0, 0); } \
                float cmax = -INFINITY; \
                _Pragma("unroll") for (int mt = 0; mt < 4; ++mt) \
                    _Pragma("unroll") for (int e = 0; e < 4; ++e) { const float v = inv4[mt][e] ? -INFINITY : lg[mt][e] * 0.02254211001388847f + bvv[mt][e]; lg[mt][e] = v; cmax = fmaxf(cmax, v); } \
                float m_new = m_run, alpha = 1.f; \
                if (__ballot(cmax > m_run + 6.f) != 0ull) {        \
                    cmax = fmaxf(cmax, __shfl_xor(cmax, 16)); cmax = fmaxf(cmax, __shfl_xor(cmax, 32)); \
                    m_new = fmaxf(m_run, cmax); alpha = __builtin_amdgcn_exp2f(m_run - m_new); m_run = m_new; } \
                float ps = 0.f; long pf8[2]; \
                _Pragma("unroll") for (int k2 = 0; k2 < 2; ++k2) { float pv[8]; \
                    _Pragma("unroll") for (int mt = 0; mt < 2; ++mt) \
                        _Pragma("unroll") for (int e = 0; e < 4; ++e) { const float p = __builtin_amdgcn_exp2f(lg[2 * k2 + mt][e] - m_new); ps += p; pv[mt * 4 + e] = p; } \
                    int plo = __builtin_amdgcn_cvt_pk_fp8_f32(pv[0], pv[1], 0, false); plo = __builtin_amdgcn_cvt_pk_fp8_f32(pv[2], pv[3], plo, true); \
                    int phi = __builtin_amdgcn_cvt_pk_fp8_f32(pv[4], pv[5], 0, false); phi = __builtin_amdgcn_cvt_pk_fp8_f32(pv[6], pv[7], phi, true); \
                    pf8[k2] = (long)(((unsigned long long)(unsigned)phi << 32) | (unsigned)plo); } \
                l_run = l_run * alpha + ps; \
                if (__ballot(alpha != 1.f) != 0ull) { _Pragma("unroll") for (int cb = 0; cb < 4; ++cb) { oE[cb] *= alpha; oO[cb] *= alpha; } } \
                _Pragma("unroll") for (int cb = 0; cb < 4; ++cb) \
                    _Pragma("unroll") for (int k2 = 0; k2 < 2; ++k2) { \
                        const u32x2 d1 = td[cb][k2][0], d2 = td[cb][k2][1]; \
                        const unsigned xe0 = __builtin_amdgcn_perm(d1.y, d1.x, 0x06040200u), xo0 = __builtin_amdgcn_perm(d1.y, d1.x, 0x07050301u); \
                        const unsigned xe1 = __builtin_amdgcn_perm(d2.y, d2.x, 0x06040200u), xo1 = __builtin_amdgcn_perm(d2.y, d2.x, 0x07050301u); \
                        oE[cb] = __builtin_amdgcn_mfma_f32_16x16x32_fp8_fp8((long)(((unsigned long long)xe1 << 32) | xe0), pf8[k2], oE[cb], 0, 0, 0); \
                        oO[cb] = __builtin_amdgcn_mfma_f32_16x16x32_fp8_fp8((long)(((unsigned long long)xo1 << 32) | xo0), pf8[k2], oO[cb], 0, 0, 0); } } while (0)
            if (t < TOPK) {
#pragma unroll 1
                for (int ch = 0; ch < nch; ++ch) DSA_CHUNK(1);
            } else {
#pragma unroll 1
                for (int ch = 0; ch < nch; ++ch) DSA_CHUNK(0);
            }
#undef DSA_CHUNK
#undef DSA_DMA
            l_run += __shfl_xor(l_run, 16); l_run += __shfl_xor(l_run, 32);
            const float inv = 1.f / l_run;
            if (r16 < 8) {
#pragma unroll
                for (int cb = 0; cb < 4; ++cb) { u32x4 w; w.x = pkh(oE[cb][0] * inv, oO[cb][0] * inv); w.y = pkh(oE[cb][1] * inv, oO[cb][1] * inv); w.z = pkh(oE[cb][2] * inv, oO[cb][2] * inv); w.w = pkh(oE[cb][3] * inv, oO[cb][3] * inv);
                    *(u32x4*)(OATT + q * KOUT + r16 * 128 + 32 * cb + 8 * g) = w; }
            }
        }
#endif
    }
}

template <int CTRL> __device__ __forceinline__ float dpp_f(float x) { return __builtin_bit_cast(float, __builtin_amdgcn_update_dpp(0, __builtin_bit_cast(int, x), CTRL, 0xF, 0xF, false)); }
__device__ __forceinline__ float row16_sum(float x) { x += dpp_f<0x128>(x); x += dpp_f<0x124>(x); x += dpp_f<0x122>(x); x += dpp_f<0x121>(x); return x; }
constexpr int SCAN_TB = 32;
__device__ __forceinline__ void p7_scan(const Args& a, LAS unsigned char* lds, int vcu, int G, int wave, int lane) {
    unsigned char* ws = a.ws;
    const f16* PROJ = (const f16*)(ws + WS_PROJ); const f16* RWW = (const f16*)(ws + WS_RWW); const f16* RWA = (const f16*)(ws + WS_RWA);
    float* YRAW = (float*)(ws + WS_YRAW);
    for (int u = vcu; u < BATCH * HRW * 2; u += G) {
        const int half = u & 1, h = (u >> 1) & 7, b = u >> 4;
        const int ch = h * 64 + lane;
        const float mu_r = a.in[17][ch], mu_k = a.in[17][512 + ch], mu_v = a.in[17][1024 + ch], kkc = a.in[23][ch], kac = a.in[24][ch];
        const int rr = lane >> 4, qd = lane & 15, irow = half * 32 + wave * 4 + rr;
        float S0 = 0.f, S1 = 0.f, S2 = 0.f, S3 = 0.f;
#define SCAN_LOAD(blk_) do { _Pragma("unroll") for (int tt = 0; tt < 4; ++tt) { const int t = (blk_) * SCAN_TB + wave * 4 + tt; const size_t m = (size_t)(b << 12) + t; \
            const f16* pr = PROJ + m * IN_PAD + h * 64 + lane; \
            st_r[tt] = (float)pr[C_R]; st_k[tt] = (float)pr[C_K]; st_v[tt] = (float)pr[C_V]; \
            if (t > 0) { st_rp[tt] = (float)pr[C_R - IN_PAD]; st_kp[tt] = (float)pr[C_K - IN_PAD]; st_vp[tt] = (float)pr[C_V - IN_PAD]; } else { st_rp[tt] = 0.f; st_kp[tt] = 0.f; st_vp[tt] = 0.f; } \
            st_lw[tt] = (float)RWW[m * RW + ch]; st_av[tt] = (float)RWA[m * RW + ch]; } } while (0)
#define SCAN_WRITE(buf_) do { LAS float* base_ = (LAS float*)(lds + (buf_) * 49152); _Pragma("unroll") for (int tt = 0; tt < 4; ++tt) { const int tl = wave * 4 + tt; \
            const float rs = st_r[tt] + mu_r * (st_rp[tt] - st_r[tt]), ks = st_k[tt] + mu_k * (st_kp[tt] - st_k[tt]), vs = st_v[tt] + mu_v * (st_vp[tt] - st_v[tt]); \
            const float kkv = ks * kkc; const float nrm = sqrtf(wave_sum(kkv * kkv)); const float kkn = kkv / fmaxf(nrm, 1e-12f); \
            const float av = st_av[tt]; const float km = ks * (1.f + (av - 1.f) * kac); \
            base_[0 * 2048 + tl * 64 + lane] = rs; base_[1 * 2048 + tl * 64 + lane] = __expf(st_lw[tt]); base_[2 * 2048 + tl * 64 + lane] = km; \
            base_[3 * 2048 + tl * 64 + lane] = vs; base_[4 * 2048 + tl * 64 + lane] = -kkn; base_[5 * 2048 + tl * 64 + lane] = kkn * av; } } while (0)
        float st_r[4], st_k[4], st_v[4], st_rp[4], st_kp[4], st_vp[4], st_lw[4], st_av[4];
        __syncthreads();
        SCAN_LOAD(0); SCAN_WRITE(0);
        constexpr int NBLK = SEQ / SCAN_TB;
        for (int blk = 0; blk < NBLK; ++blk) {
            __syncthreads();
            if (blk + 1 < NBLK) SCAN_LOAD(blk + 1);
            const LAS float* base = (const LAS float*)(lds + (blk & 1) * 49152);
            for (int tl = 0; tl < SCAN_TB; ++tl) {
                const f32x4 r4 = *(const LAS f32x4*)(base + 0 * 2048 + tl * 64 + 4 * qd), w4 = *(const LAS f32x4*)(base + 1 * 2048 + tl * 64 + 4 * qd), k4 = *(const LAS f32x4*)(base + 2 * 2048 + tl * 64 + 4 * qd);
                const f32x4 a4 = *(const LAS f32x4*)(base + 4 * 2048 + tl * 64 + 4 * qd), b4 = *(const LAS f32x4*)(base + 5 * 2048 + tl * 64 + 4 * qd);
                const float vi = base[3 * 2048 + tl * 64 + irow];
                float sa = S0 * a4[0] + S1 * a4[1] + S2 * a4[2] + S3 * a4[3];
                sa = row16_sum(sa);
                S0 = S0 * w4[0] + sa * b4[0] + vi * k4[0]; S1 = S1 * w4[1] + sa * b4[1] + vi * k4[1]; S2 = S2 * w4[2] + sa * b4[2] + vi * k4[2]; S3 = S3 * w4[3] + sa * b4[3] + vi * k4[3];
                float y = S0 * r4[0] + S1 * r4[1] + S2 * r4[2] + S3 * r4[3];
                y = row16_sum(y);
                if (qd == 0) YRAW[((size_t)(b << 12) + blk * SCAN_TB + tl) * RW + h * 64 + irow] = y;
            }
            if (blk + 1 < NBLK) SCAN_WRITE((blk + 1) & 1);
        }
        __syncthreads();
    }
}

__device__ __forceinline__ void p8_rwkv_post(const Args& a, int vcu, int G, int wave, int lane) {
    unsigned char* ws = a.ws;
    const f16* PROJ = (const f16*)(ws + WS_PROJ); const f16* RWA = (const f16*)(ws + WS_RWA); const f16* RWG = (const f16*)(ws + WS_RWG);
    const float* YRAW = (const float*)(ws + WS_YRAW); f16* OATT = (f16*)(ws + WS_OATT);
    const int gw = vcu * NWAVES + wave, NGW = G * NWAVES;
    for (int it = gw; it < MTOK * HRW; it += NGW) {
        const int m = it >> 3, h = it & 7, ch = h * 64 + lane, t = m & (SEQ - 1);
        const f16* pr = PROJ + (size_t)m * IN_PAD + ch;
        float r = (float)pr[C_R], k = (float)pr[C_K], v = (float)pr[C_V], rp = 0.f, kp = 0.f, vp = 0.f;
        if (t > 0) { rp = (float)pr[C_R - IN_PAD]; kp = (float)pr[C_K - IN_PAD]; vp = (float)pr[C_V - IN_PAD]; }
        const float rs = r + a.in[17][ch] * (rp - r), ks = k + a.in[17][512 + ch] * (kp - k), vs = v + a.in[17][1024 + ch] * (vp - v);
        const float av = (float)RWA[(size_t)m * RW + ch];
        const float km = ks * (1.f + (av - 1.f) * a.in[24][ch]);
        const float y = YRAW[(size_t)m * RW + ch];
        const float mean = wave_sum(y) * (1.f / 64.f); const float dy = y - mean;
        const float var = wave_sum(dy * dy) * (1.f / 64.f);
        const float yn = dy * rsqrtf(var + GN_EPS) * a.in[26][ch] + a.in[27][ch];
        const float bonus = wave_sum(rs * km * a.in[25][ch]) * vs;
        OATT[(size_t)m * KOUT + 1024 + ch] = (f16)((yn + bonus) * (float)RWG[(size_t)m * RW + ch]);
    }
}

typedef short bf16x8 __attribute__((ext_vector_type(8)));
typedef _Float16 f16x4v __attribute__((ext_vector_type(4)));
__device__ __forceinline__ unsigned f2bf(float f) { unsigned u = __builtin_bit_cast(unsigned, f); return (u + 0x7fffu + ((u >> 16) & 1u)) >> 16; }
__device__ __forceinline__ unsigned pkb(float lo, float hi) { unsigned r; asm("v_cvt_pk_bf16_f32 %0, %1, %2" : "=v"(r) : "v"(lo), "v"(hi)); return r; }
constexpr int XP = 144;
constexpr int XD_OFF = 0, XA_OFF = 9216, XG_OFF = 18432, XG_P = 336;
constexpr int LAB_OFF = 126720, LAK_OFF = LAB_OFF + 9216, LRB_OFF = LAK_OFF + 9216, LRK_OFF = LRB_OFF + 9216;
static_assert(LRK_OFF + 9216 <= MISC_OFF, "X-phase LDS map");
constexpr int AB_OFF = 39936, RB_OFF = AB_OFF + 9216, BB_OFF = RB_OFF + 9216, KB_OFF = BB_OFF + 9216;
constexpr int TT_OFF = 39936, M1T_OFF = TT_OFF + 9216, A2T_OFF = M1T_OFF + 9216, U1T_OFF = A2T_OFF + 9216;
constexpr int AH_OFF = 76800, VH_OFF = AH_OFF + 9216, BP_OFF = VH_OFF + 9216, KP_OFF = BP_OFF + 9216, RH_OFF = KP_OFF + 9216;
constexpr int NRM_OFF = 122880, CUMB_OFF = NRM_OFF + 512, XCONST_OFF = CUMB_OFF + 1024;
constexpr size_t WS_WDT = 28 * MiB, WS_WAT = WS_WDT + 65536, WS_WGT = WS_WAT + 65536;
constexpr size_t WS_RWP = 32 * MiB, WS_RWQ = 64 * MiB, WS_RWR2 = 408 * MiB, WS_RWY1 = 440 * MiB, WS_RWS0 = 472 * MiB, WS_BON = 364 * MiB;
constexpr int NUNIT = BATCH * 64 * HRW;

__device__ __forceinline__ f16x8 rd_row(LAS unsigned char* base, int pitch, int row, int col) { return *(const LAS f16x8*)(base + row * pitch + col * 2); }
__device__ __forceinline__ bf16x8 rd_rowb(LAS unsigned char* base, int pitch, int row, int col) { return *(const LAS bf16x8*)(base + row * pitch + col * 2); }
__device__ __forceinline__ f16x8 rd_tr(LAS unsigned char* base, int k0, int c0, int g, int qq, int pp) {
    const f16x4 v0 = tr_read16(base + (k0 + 8 * g + qq) * XP + (c0 + 4 * pp) * 2), v1 = tr_read16(base + (k0 + 8 * g + 4 + qq) * XP + (c0 + 4 * pp) * 2);
    return (f16x8){v0[0], v0[1], v0[2], v0[3], v1[0], v1[1], v1[2], v1[3]};
}
__device__ __forceinline__ void wr4h(LAS unsigned char* p, const f32x4& v) { u32x2 w; w.x = pkh(v[0], v[1]); w.y = pkh(v[2], v[3]); *(LAS u32x2*)p = w; }
__device__ __forceinline__ float dpp_shr_f(float x, int) { return x; }
template <int CTRL> __device__ __forceinline__ float dpp_z(float x) { return __builtin_bit_cast(float, __builtin_amdgcn_update_dpp(0, __builtin_bit_cast(int, x), CTRL, 0xF, 0xF, true)); }
__device__ __forceinline__ float row16_incl_scan(float x) { x += dpp_z<0x111>(x); x += dpp_z<0x112>(x); x += dpp_z<0x114>(x); x += dpp_z<0x118>(x); return x; }
#define MFMA_H(a, b, c) __builtin_amdgcn_mfma_f32_16x16x32_f16((a), (b), (c), 0, 0, 0)
#define MFMA_B(a, b, c) __builtin_amdgcn_mfma_f32_16x16x32_bf16((a), (b), (c), 0, 0, 0)
#define MFMA_H16(a, b, c) __builtin_amdgcn_mfma_f32_16x16x16f16((a), (b), (c), 0, 0, 0)
__device__ __forceinline__ f16x4 cvt4h(const f32x4& v) { return (f16x4){(f16)v[0], (f16)v[1], (f16)v[2], (f16)v[3]}; }
__device__ __forceinline__ f32x4 cvt4f(const f16x4& v) { return (f32x4){(float)v[0], (float)v[1], (float)v[2], (float)v[3]}; }

__device__ __forceinline__ void p7x_chunks(const Args& a, LAS unsigned char* lds, int vcu, int G, int tid, int wave, int lane) {
    unsigned char* ws = a.ws;
    const f16* PROJ = (const f16*)(ws + WS_PROJ);
    const f16* WDT = (const f16*)(ws + WS_WDT); const f16* WAT = (const f16*)(ws + WS_WAT); const f16* WGT = (const f16*)(ws + WS_WGT);
    f16* RWG = (f16*)(ws + WS_RWG); f16* RWP = (f16*)(ws + WS_RWP); f16* RWQ = (f16*)(ws + WS_RWQ); f16* RWR2 = (f16*)(ws + WS_RWR2); f16* RWY1 = (f16*)(ws + WS_RWY1);
    float* BON = (float*)(ws + WS_BON);
    const float* mu = a.in[17];
    const f32x4 z4 = {0.f, 0.f, 0.f, 0.f};
    const bool bal = (G == 256); const int bxx = blockIdx.x;
    const int nit = bal ? 16 : (NUNIT + G - 1) / G;
#define X_UNIT(itx_) (bal ? ((((bxx & 7) * 64 + ((bxx >> 3) + 32 * ((itx_) >> 3))) * 8 + ((itx_) & 7))) : (vcu + (itx_) * G))
    f16x4 rv0[9], rv1c, rv1p, prc[2], pkc[2], pvc[2], prp[2], pkp[2], pvp[2];
    f16x8 wfd[2][2], wfa[2][2], wfg[2][5];
    int h_tab = -1;
#define X_PREFETCH(u_, rows_) do { int lp = lane; asm volatile("" : "+v"(lp)); const int h_ = (u_) & 7, c_ = ((u_) >> 3) & 63, b_ = (u_) >> 9; const size_t m0_ = (size_t)(b_ << 12) + c_ * 64; \
        if (rows_) { _Pragma("unroll") for (int i = 0; i < 9; ++i) { const int t_ = 8 * wave + i - 1; const bool ok_ = (t_ >= 0 || c_ > 0); const f16* rowp = PROJ + (m0_ + t_) * IN_PAD + C_WD; \
            rv0[i] = (f16x4){0, 0, 0, 0}; if (ok_) rv0[i] = *(const f16x4*)(rowp + 4 * lp); } \
        { const int t1_ = 8 * wave + (lp >> 3); const f16* rp1 = PROJ + (m0_ + t1_) * IN_PAD + C_WD + 256 + 4 * (lp & 7); rv1c = *(const f16x4*)rp1; rv1p = (f16x4){0, 0, 0, 0}; if (t1_ > 0 || c_ > 0) rv1p = *(const f16x4*)(rp1 - IN_PAD); } } \
        _Pragma("unroll") for (int ci = 0; ci < 2; ++ci) { const int chr_ = h_ * 64 + 16 * (2 * (wave >> 2) + ci) + (lp & 15); \
            _Pragma("unroll") for (int ks = 0; ks < 2; ++ks) { wfd[ci][ks] = *(const f16x8*)(WDT + (size_t)chr_ * 64 + 32 * ks + 8 * (lp >> 4)); wfa[ci][ks] = *(const f16x8*)(WAT + (size_t)chr_ * 64 + 32 * ks + 8 * (lp >> 4)); } \
            _Pragma("unroll") for (int ks = 0; ks < 5; ++ks) wfg[ci][ks] = *(const f16x8*)(WGT + (size_t)chr_ * 192 + 32 * ks + 8 * (lp >> 4)); } \
        const int t2_ = 16 * (wave & 3) + (lp & 15); const size_t m_ = m0_ + t2_; \
        _Pragma("unroll") for (int ci = 0; ci < 2; ++ci) { const int ch_ = h_ * 64 + 16 * (2 * (wave >> 2) + ci) + 4 * (lp >> 4); \
            prc[ci] = *(const f16x4*)(PROJ + m_ * IN_PAD + C_R + ch_); pkc[ci] = *(const f16x4*)(PROJ + m_ * IN_PAD + C_K + ch_); pvc[ci] = *(const f16x4*)(PROJ + m_ * IN_PAD + C_V + ch_); \
            prp[ci] = (f16x4){0, 0, 0, 0}; pkp[ci] = (f16x4){0, 0, 0, 0}; pvp[ci] = (f16x4){0, 0, 0, 0}; \
            if ((c_ * 64 + t2_) != 0) { prp[ci] = *(const f16x4*)(PROJ + (m_ - 1) * IN_PAD + C_R + ch_); pkp[ci] = *(const f16x4*)(PROJ + (m_ - 1) * IN_PAD + C_K + ch_); pvp[ci] = *(const f16x4*)(PROJ + (m_ - 1) * IN_PAD + C_V + ch_); } } } while (0)
    { const int u0 = X_UNIT(0); if (u0 < NUNIT) X_PREFETCH(u0, true); }
    int chunk_id = -1;
#pragma unroll 1
    for (int itx = 0; itx < nit; ++itx) {
        const int u = X_UNIT(itx); if (u >= NUNIT) break;
        const int un = (itx + 1 < nit) ? X_UNIT(itx + 1) : NUNIT;
        int lane_o = lane; asm volatile("" : "+v"(lane_o));
        const int r16 = lane_o & 15, g = lane_o >> 4, qq = r16 >> 2, pp = lane_o & 3;
        const int h = u & 7, c = (u >> 3) & 63, b = u >> 9;
        const size_t m0 = (size_t)(b << 12) + c * 64;
        const bool newchunk = (u >> 3) != chunk_id; chunk_id = u >> 3;
        lds_barrier();
        if (h != h_tab) { h_tab = h;
            if (tid < 64) { const int ch = h * 64 + tid; LAS float* ct = (LAS float*)(lds + XCONST_OFF) + tid;
                ct[0] = mu[ch]; ct[64] = mu[512 + ch]; ct[128] = mu[1024 + ch]; ct[192] = a.in[18][ch]; ct[256] = a.in[20][ch]; ct[320] = a.in[23][ch]; ct[384] = a.in[24][ch]; ct[448] = a.in[25][ch]; } }
        if (newchunk) {
            const f32x4 mu0 = *(const f32x4*)(mu + 1536 + 4 * lane_o); const f32x4 mu1 = *(const f32x4*)(mu + 1536 + 256 + 4 * (lane_o & 7));
            const float kf = lane_o < 16 ? 2.f : 1.f; const bool is_t = lane_o < 16, is_id = (lane_o >= 16 && lane_o < 32);
            LAS unsigned char* d0 = is_t ? lds + XD_OFF + 8 * lane_o : is_id ? lds + XA_OFF + 8 * (lane_o - 16) : lds + XG_OFF + 8 * (lane_o - 32);
            const int p0 = (lane_o < 32) ? XP : XG_P;
#pragma unroll
            for (int i = 0; i < 8; ++i) { const int t = 8 * wave + i; float o[4];
#pragma unroll
                for (int e = 0; e < 4; ++e) { const float cu = (float)rv0[i + 1][e], pv = (float)rv0[i][e]; const float x = cu + mu0[e] * (pv - cu);
                    const float sg = __builtin_amdgcn_rcpf(1.f + __expf(-kf * x)); o[e] = is_t ? 2.f * sg - 1.f : is_id ? x : sg; }
                u32x2 w; w.x = pkh(o[0], o[1]); w.y = pkh(o[2], o[3]); *(LAS u32x2*)(d0 + t * p0) = w; }
            {
                float o1[4];
#pragma unroll
                for (int e = 0; e < 4; ++e) { const float cu1 = (float)rv1c[e], pv1 = (float)rv1p[e]; const float x1 = cu1 + mu1[e] * (pv1 - cu1); o1[e] = __builtin_amdgcn_rcpf(1.f + __expf(-x1)); }
                u32x2 w1; w1.x = pkh(o1[0], o1[1]); w1.y = pkh(o1[2], o1[3]); *(LAS u32x2*)(lds + XG_OFF + (8 * wave + (lane_o >> 3)) * XG_P + (128 + 4 * (lane_o & 7)) * 2) = w1; }
        }
        lds_barrier();
        const int tb = wave & 3, cth = wave >> 2;
        const int t = 16 * tb + r16; const size_t m = m0 + t;
        f32x4 dA[2], aA[2], gA[2];
#pragma unroll
        for (int ci = 0; ci < 2; ++ci) {
            dA[ci] = z4; aA[ci] = z4; gA[ci] = z4;
#pragma unroll
            for (int ks = 0; ks < 2; ++ks) {
                dA[ci] = MFMA_H(wfd[ci][ks], rd_row(lds + XD_OFF, XP, t, 32 * ks + 8 * g), dA[ci]);
                aA[ci] = MFMA_H(wfa[ci][ks], rd_row(lds + XA_OFF, XP, t, 32 * ks + 8 * g), aA[ci]); }
#pragma unroll
            for (int ks = 0; ks < 5; ++ks) gA[ci] = MFMA_H(wfg[ci][ks], rd_row(lds + XG_OFF, XG_P, t, 32 * ks + 8 * g), gA[ci]);
        }
        float lwv[2][4], asg[2][4], rs[2][4], kp[2][4], vs[2][4], kkv[2][4], cl[2][4];
        float pn = 0.f, prk = 0.f;
#pragma unroll
        for (int ci = 0; ci < 2; ++ci) {
            const int chl = 16 * (2 * cth + ci) + 4 * g, ch = h * 64 + chl;
            const f16x4 rc = prc[ci], kc = pkc[ci], vc = pvc[ci], rp = prp[ci], kq = pkp[ci], vp = pvp[ci];
            const LAS float* ct = (const LAS float*)(lds + XCONST_OFF) + chl;
            const f32x4 mur = *(const LAS f32x4*)(ct), muk = *(const LAS f32x4*)(ct + 64), muv = *(const LAS f32x4*)(ct + 128);
            const f32x4 w0 = *(const LAS f32x4*)(ct + 192), a0 = *(const LAS f32x4*)(ct + 256), kkc = *(const LAS f32x4*)(ct + 320), kac = *(const LAS f32x4*)(ct + 384), rkc = *(const LAS f32x4*)(ct + 448);
            float gl[4];
#pragma unroll
            for (int e = 0; e < 4; ++e) {
                const float z = -(w0[e] + dA[ci][e]); const float sp = fmaxf(z, 0.f) + __logf(1.f + __expf(-fabsf(z)));
                lwv[ci][e] = -__expf(-sp - 0.5f);
                asg[ci][e] = sigmoidf_(a0[e] + aA[ci][e]); gl[e] = gA[ci][e];
                rs[ci][e] = (float)rc[e] + mur[e] * ((float)rp[e] - (float)rc[e]);
                const float ks_ = (float)kc[e] + muk[e] * ((float)kq[e] - (float)kc[e]);
                vs[ci][e] = (float)vc[e] + muv[e] * ((float)vp[e] - (float)vc[e]);
                kkv[ci][e] = ks_ * kkc[e]; pn += kkv[ci][e] * kkv[ci][e];
                kp[ci][e] = ks_ * (1.f + (asg[ci][e] - 1.f) * kac[e]);
                prk += rs[ci][e] * kp[ci][e] * rkc[e];
                cl[ci][e] = row16_incl_scan(lwv[ci][e]);
                if (r16 == 15) ((LAS float*)(lds + CUMB_OFF))[tb * 64 + chl + e] = cl[ci][e];
            }
            u32x2 gw; gw.x = pkh(gl[0], gl[1]); gw.y = pkh(gl[2], gl[3]); *(u32x2*)(RWG + m * RW + ch) = gw;
        }
        pn += __shfl_xor(pn, 16); pn += __shfl_xor(pn, 32); prk += __shfl_xor(prk, 16); prk += __shfl_xor(prk, 32);
        if (g == 0) { ((LAS float*)(lds + NRM_OFF))[t * 2 + cth] = pn; BON[((size_t)u * 64 + t) * 2 + cth] = prk; }
        lds_barrier();
        {
            const float nrm = sqrtf(((LAS float*)(lds + NRM_OFF))[t * 2] + ((LAS float*)(lds + NRM_OFF))[t * 2 + 1]); const float inrm = __builtin_amdgcn_rcpf(fmaxf(nrm, 1e-12f));
#pragma unroll
            for (int ci = 0; ci < 2; ++ci) {
                const int chl = 16 * (2 * cth + ci) + 4 * g;
                float Ab[4], Rb[4], Bb[4], Kb[4], Bp[4], Kp[4];
                const LAS float* cbp = (const LAS float*)(lds + CUMB_OFF) + chl;
                const f32x4 cb0 = *(const LAS f32x4*)(cbp), cb1 = *(const LAS f32x4*)(cbp + 64), cb2 = *(const LAS f32x4*)(cbp + 128), cb3 = *(const LAS f32x4*)(cbp + 192);
#pragma unroll
                for (int e = 0; e < 4; ++e) {
                    const float b0 = cb0[e], b1 = cb1[e], b2 = cb2[e], b3 = cb3[e];
                    const float pre = (tb > 0 ? b0 : 0.f) + (tb > 1 ? b1 : 0.f) + (tb > 2 ? b2 : 0.f);
                    const float cum = cl[ci][e] + pre, cumC = (b0 + b1) + (b2 + b3);
                    const float kkn = kkv[ci][e] * inrm, av = -kkn, bv = kkn * asg[ci][e];
                    const float eg = __expf(cum), egi = __expf(-cum), egc = __expf(cumC - cum);
                    Ab[e] = av * __expf(cum - lwv[ci][e]); Rb[e] = rs[ci][e] * eg; Bb[e] = bv * egi; Kb[e] = kp[ci][e] * egi; Bp[e] = bv * egc; Kp[e] = kp[ci][e] * egc;
                }
                const int ro = t * XP + chl * 2;
                u32x2 w;
                w.x = pkb(Ab[0], Ab[1]); w.y = pkb(Ab[2], Ab[3]); *(LAS u32x2*)(lds + AB_OFF + ro) = w;
                w.x = pkb(Rb[0], Rb[1]); w.y = pkb(Rb[2], Rb[3]); *(LAS u32x2*)(lds + RB_OFF + ro) = w;
                w.x = pkb(Bb[0], Bb[1]); w.y = pkb(Bb[2], Bb[3]); *(LAS u32x2*)(lds + BB_OFF + ro) = w;
                w.x = pkb(Kb[0], Kb[1]); w.y = pkb(Kb[2], Kb[3]); *(LAS u32x2*)(lds + KB_OFF + ro) = w;
                w.x = pkh(Ab[0], Ab[1]); w.y = pkh(Ab[2], Ab[3]); *(LAS u32x2*)(lds + AH_OFF + ro) = w;
                w.x = pkh(Rb[0], Rb[1]); w.y = pkh(Rb[2], Rb[3]); *(LAS u32x2*)(lds + RH_OFF + ro) = w;
                w.x = pkh(vs[ci][0], vs[ci][1]); w.y = pkh(vs[ci][2], vs[ci][3]); *(LAS u32x2*)(lds + VH_OFF + ro) = w;
                w.x = pkh(Bp[0], Bp[1]); w.y = pkh(Bp[2], Bp[3]); *(LAS u32x2*)(lds + BP_OFF + ro) = w;
                w.x = pkh(Kp[0], Kp[1]); w.y = pkh(Kp[2], Kp[3]); *(LAS u32x2*)(lds + KP_OFF + ro) = w;
            }
        }
        lds_barrier();
#pragma unroll 1
        for (int k = 0; k < 5; ++k) {
            const int idx = wave + 8 * k, prod = idx / 10, rem = idx - prod * 10;
            const int tb1 = rem >= 6 ? 3 : rem >= 3 ? 2 : rem >= 1 ? 1 : 0, ub = rem - (tb1 * (tb1 + 1)) / 2;
            LAS unsigned char* X = lds + ((prod < 2) ? AB_OFF : RB_OFF); LAS unsigned char* Y = lds + ((prod & 1) ? KB_OFF : BB_OFF);
            f32x4 acc = z4;
#pragma unroll
            for (int ks = 0; ks < 2; ++ks) acc = MFMA_B(rd_rowb(Y, XP, 16 * ub + r16, 32 * ks + 8 * g), rd_rowb(X, XP, 16 * tb1 + r16, 32 * ks + 8 * g), acc);
            const int tt = 16 * tb1 + r16, tau0 = 16 * ub + 4 * g; const int lim = (prod < 2) ? tt : tt + 1;
#pragma unroll
            for (int e = 0; e < 4; ++e) if (tau0 + e >= lim) acc[e] = 0.f;
            wr4h(lds + LAB_OFF + prod * 9216 + tt * XP + tau0 * 2, acc);
        }
#pragma unroll 1
        for (int k = 0; k < 3; ++k) {
            const int idx = wave + 8 * k, prod = idx / 6, rem = idx - prod * 6;
            const int tb1 = rem >= 5 ? 2 : rem >= 3 ? 1 : 0, ub = (rem >= 5) ? 3 : (rem >= 3) ? rem - 1 : rem + 1;
            wr4h(lds + LAB_OFF + prod * 9216 + (16 * tb1 + r16) * XP + (16 * ub + 4 * g) * 2, z4);
        }
        lds_barrier();
        if (wave == 0) {
            LAS unsigned char* L = lds + LAB_OFF; LAS unsigned char* TT = lds + TT_OFF;
            f32x4 TB[4][4]; f16x4 TAh[4];
            float idn[4];
#pragma unroll
            for (int e = 0; e < 4; ++e) idn[e] = (r16 == 4 * g + e) ? 1.f : 0.f;
#pragma unroll
            for (int i = 0; i < 4; ++i) {
                f16x4 XA = *(const LAS f16x4*)(L + (16 * i + r16) * XP + (16 * i + 4 * g) * 2);
                f16x4 XB = tr_read16(L + (16 * i + 4 * g + qq) * XP + (16 * i + 4 * pp) * 2);
                f32x4 TAf, TBf;
#pragma unroll
                for (int e = 0; e < 4; ++e) { TAf[e] = idn[e] + (float)XA[e]; TBf[e] = idn[e] + (float)XB[e]; }
#pragma unroll
                for (int lv = 0; lv < 3; ++lv) {
                    const f32x4 X2B = MFMA_H16(XA, XB, z4), X2A = MFMA_H16(XB, XA, z4);
                    XA = cvt4h(X2A); XB = cvt4h(X2B);
                    const f16x4 ta = cvt4h(TAf);
                    TBf = MFMA_H16(ta, XB, TBf); TAf = MFMA_H16(XB, ta, TAf);
                }
                TB[i][i] = TBf; TAh[i] = cvt4h(TAf);
            }
#pragma unroll
            for (int d = 1; d < 4; ++d)
#pragma unroll
                for (int j = 0; j + d < 4; ++j) { const int i = j + d;
                    f32x4 M = z4;
#pragma unroll
                    for (int kq2 = j; kq2 < i; ++kq2) M = MFMA_H16(*(const LAS f16x4*)(L + (16 * i + r16) * XP + (16 * kq2 + 4 * g) * 2), cvt4h(TB[kq2][j]), M);
                    TB[i][j] = MFMA_H16(TAh[i], cvt4h(M), z4);
                }
#pragma unroll
            for (int i = 0; i < 4; ++i)
#pragma unroll
                for (int j = 0; j < 4; ++j) wr4h(TT + (16 * j + r16) * XP + (16 * i + 4 * g) * 2, (j <= i) ? TB[i][j] : z4);
        } else {
#pragma unroll 1
            for (int idx = wave - 1; idx < 16; idx += 7) { const int tb1 = idx >> 2, ib = idx & 3;
                f32x4 acc = z4;
#pragma unroll
                for (int ks = 0; ks < 2; ++ks) acc = MFMA_H(rd_row(lds + LAK_OFF, XP, 16 * tb1 + r16, 32 * ks + 8 * g), rd_tr(lds + VH_OFF, 32 * ks, 16 * ib, g, qq, pp), acc);
                wr4h(lds + M1T_OFF + (16 * ib + r16) * XP + (16 * tb1 + 4 * g) * 2, acc);
            }
        }
        lds_barrier();
#pragma unroll
        for (int k = 0; k < 4; ++k) {
            const int which = k >> 1, tb1 = 2 * (k & 1) + (wave >> 2), nb = wave & 3;
            f32x4 acc = z4;
#pragma unroll
            for (int ks = 0; ks < 2; ++ks) {
                const f16x8 af = rd_tr(lds + TT_OFF, 32 * ks, 16 * tb1, g, qq, pp);
                const f16x8 bf = which ? rd_row(lds + M1T_OFF, XP, 16 * nb + r16, 32 * ks + 8 * g) : rd_tr(lds + AH_OFF, 32 * ks, 16 * nb, g, qq, pp);
                acc = MFMA_H(af, bf, acc);
            }
            wr4h(lds + (which ? U1T_OFF : A2T_OFF) + (16 * nb + r16) * XP + (16 * tb1 + 4 * g) * 2, acc);
        }
        lds_barrier();
        if (un < NUNIT) X_PREFETCH(un, (un >> 3) != chunk_id);
#pragma unroll
        for (int k = 0; k < 8; ++k) {
            const int kind = k >> 1, a4 = 2 * (k & 1) + (wave >> 2), b4 = wave & 3;
            f32x4 acc = z4;
            if (kind == 0) {
#pragma unroll
                for (int ks = 0; ks < 2; ++ks) acc = MFMA_H(rd_row(lds + A2T_OFF, XP, 16 * a4 + r16, 32 * ks + 8 * g), rd_tr(lds + BP_OFF, 32 * ks, 16 * b4, g, qq, pp), acc);
                if (a4 == b4) { const LAS float* cb = (const LAS float*)(lds + CUMB_OFF) + 16 * b4 + r16; const float gC = __expf((cb[0] + cb[64]) + (cb[128] + cb[192]));
#pragma unroll
                    for (int e = 0; e < 4; ++e) if (4 * g + e == r16) acc[e] += gC; }
                u32x2 w; w.x = pkh(acc[0], acc[1]); w.y = pkh(acc[2], acc[3]);
                *(u32x2*)(RWP + (size_t)u * 4096 + ((b4 * 2 + (a4 >> 1)) * 64 + lane_o) * 8 + (a4 & 1) * 4) = w;
            } else if (kind == 1) {
#pragma unroll
                for (int ks = 0; ks < 2; ++ks) { acc = MFMA_H(rd_tr(lds + BP_OFF, 32 * ks, 16 * a4, g, qq, pp), rd_row(lds + U1T_OFF, XP, 16 * b4 + r16, 32 * ks + 8 * g), acc);
                    acc = MFMA_H(rd_tr(lds + KP_OFF, 32 * ks, 16 * a4, g, qq, pp), rd_tr(lds + VH_OFF, 32 * ks, 16 * b4, g, qq, pp), acc); }
                u32x2 w; w.x = pkh(acc[0], acc[1]); w.y = pkh(acc[2], acc[3]);
                *(u32x2*)(RWQ + (size_t)u * 4096 + ((b4 * 4 + a4) * 64 + lane_o) * 4) = w;
            } else if (kind == 2) {
                { const f16x4 rh4 = *(const LAS f16x4*)(lds + RH_OFF + (16 * b4 + r16) * XP + (16 * a4 + 4 * g) * 2); acc = cvt4f(rh4); }
#pragma unroll
                for (int ks = 0; ks < 2; ++ks) acc = MFMA_H(rd_row(lds + A2T_OFF, XP, 16 * a4 + r16, 32 * ks + 8 * g), rd_row(lds + LRB_OFF, XP, 16 * b4 + r16, 32 * ks + 8 * g), acc);
                u32x2 w; w.x = pkh(acc[0], acc[1]); w.y = pkh(acc[2], acc[3]);
                *(u32x2*)(RWR2 + (size_t)u * 4096 + (16 * b4 + r16) * 64 + 16 * a4 + 4 * g) = w;
            } else {
#pragma unroll
                for (int ks = 0; ks < 2; ++ks) { acc = MFMA_H(rd_row(lds + U1T_OFF, XP, 16 * a4 + r16, 32 * ks + 8 * g), rd_row(lds + LRB_OFF, XP, 16 * b4 + r16, 32 * ks + 8 * g), acc);
                    acc = MFMA_H(rd_tr(lds + VH_OFF, 32 * ks, 16 * a4, g, qq, pp), rd_row(lds + LRK_OFF, XP, 16 * b4 + r16, 32 * ks + 8 * g), acc); }
                u32x2 w; w.x = pkh(acc[0], acc[1]); w.y = pkh(acc[2], acc[3]);
                *(u32x2*)(RWY1 + (size_t)u * 4096 + ((a4 * 4 + b4) * 64 + lane_o) * 4) = w;
            }
        }
    }
}

#undef X_UNIT
#undef X_PREFETCH
struct ChBuf { f16x8 p[4][2]; u32x2 q[4]; };
__device__ __forceinline__ void p7y_chain(const Args& a, int bx0, int G, int wave, int lane) {
    unsigned char* ws = a.ws;
    const f16* RWP = (const f16*)(ws + WS_RWP); const f16* RWQ = (const f16*)(ws + WS_RWQ); f16* RWS0 = (f16*)(ws + WS_RWS0);
    if (wave != 0) return;
#pragma unroll 1
    for (int bx = bx0; bx < 256; bx += G) {
    const int r16 = lane & 15, g = lane >> 4;
    const int b = bx & 7, rest = bx >> 3, h = rest >> 2, it = rest & 3;
    f32x4 S[4];
#pragma unroll
    for (int mt = 0; mt < 4; ++mt) S[mt] = (f32x4){0.f, 0.f, 0.f, 0.f};
    ChBuf B0, B1, B2, B3;
#define CH_LOAD(BUF, c_) do { const size_t uu = ((size_t)(b * 64 + (c_)) * 8 + h); \
        _Pragma("unroll") for (int mo = 0; mo < 4; ++mo) { BUF.q[mo] = *(const u32x2*)(RWQ + uu * 4096 + ((it * 4 + mo) * 64 + lane) * 4); \
            _Pragma("unroll") for (int ks = 0; ks < 2; ++ks) BUF.p[mo][ks] = *(const f16x8*)(RWP + uu * 4096 + ((mo * 2 + ks) * 64 + lane) * 8); } } while (0)
#define CH_STEP(BUF, c_) do { const size_t uu = ((size_t)(b * 64 + (c_)) * 8 + h); f16x8 bfr[2]; \
        _Pragma("unroll") for (int mt = 0; mt < 4; ++mt) { u32x2 w; w.x = pkh(S[mt][0], S[mt][1]); w.y = pkh(S[mt][2], S[mt][3]); \
            *(u32x2*)(RWS0 + uu * 4096 + (16 * it + r16) * 64 + 16 * mt + 4 * g) = w; const f16x4 hv = __builtin_bit_cast(f16x4, w); \
            bfr[mt >> 1][(mt & 1) * 4 + 0] = hv[0]; bfr[mt >> 1][(mt & 1) * 4 + 1] = hv[1]; bfr[mt >> 1][(mt & 1) * 4 + 2] = hv[2]; bfr[mt >> 1][(mt & 1) * 4 + 3] = hv[3]; } \
        _Pragma("unroll") for (int mo = 0; mo < 4; ++mo) { f32x4 n_ = cvt4f(__builtin_bit_cast(f16x4, BUF.q[mo])); \
            _Pragma("unroll") for (int ks = 0; ks < 2; ++ks) n_ = MFMA_H(BUF.p[mo][ks], bfr[ks], n_); S[mo] = n_; } \
        if ((c_) + 4 < 64) CH_LOAD(BUF, (c_) + 4); } while (0)
    CH_LOAD(B0, 0); CH_LOAD(B1, 1); CH_LOAD(B2, 2); CH_LOAD(B3, 3);
#pragma unroll 1
    for (int c = 0; c < 64; c += 4) { CH_STEP(B0, c); CH_STEP(B1, c + 1); CH_STEP(B2, c + 2); CH_STEP(B3, c + 3); }
    }
#undef CH_LOAD
#undef CH_STEP
}

__device__ __forceinline__ void p8z_out(const Args& a, int vcu, int G, int wave, int lane) {
    unsigned char* ws = a.ws;
    const f16* PROJ = (const f16*)(ws + WS_PROJ); const f16* RWG = (const f16*)(ws + WS_RWG);
    const f16* RWR2 = (const f16*)(ws + WS_RWR2); const f16* RWY1 = (const f16*)(ws + WS_RWY1); const f16* RWS0 = (const f16*)(ws + WS_RWS0);
    const float* BON = (const float*)(ws + WS_BON); f16* OATT = (f16*)(ws + WS_OATT);
    const int gw = vcu * NWAVES + wave, NGW = G * NWAVES;
    const bool bal = (G == 256); const int bxx = blockIdx.x;
    const int nit = bal ? 2 : (NUNIT + NGW - 1) / NGW;
#pragma unroll 1
    for (int itx = 0; itx < nit; ++itx) {
        int u;
        if (bal) { const int idx = (bxx >> 3) * 8 + wave + 256 * itx; u = (((bxx & 7) * 64 + (idx >> 3)) * 8 + (idx & 7)); } else { u = gw + itx * NGW; if (u >= NUNIT) break; }
        int lane_o = lane; asm volatile("" : "+v"(lane_o));
        const int r16 = lane_o & 15, g = lane_o >> 4;
        const int h = u & 7, c = (u >> 3) & 63, b = u >> 9;
        const size_t m0 = (size_t)(b << 12) + c * 64;
        f32x4 acc[4][4];
#pragma unroll
        for (int mt = 0; mt < 4; ++mt)
#pragma unroll
            for (int nt = 0; nt < 4; ++nt) acc[mt][nt] = cvt4f(*(const f16x4*)(RWY1 + (size_t)u * 4096 + ((mt * 4 + nt) * 64 + lane_o) * 4));
#pragma unroll
        for (int ks = 0; ks < 2; ++ks) {
            f16x8 sf[4], rf[4];
#pragma unroll
            for (int x = 0; x < 4; ++x) { sf[x] = *(const f16x8*)(RWS0 + (size_t)u * 4096 + (16 * x + r16) * 64 + 32 * ks + 8 * g); rf[x] = *(const f16x8*)(RWR2 + (size_t)u * 4096 + (16 * x + r16) * 64 + 32 * ks + 8 * g); }
#pragma unroll
            for (int mt = 0; mt < 4; ++mt)
#pragma unroll
                for (int nt = 0; nt < 4; ++nt) acc[mt][nt] = MFMA_H(sf[mt], rf[nt], acc[mt][nt]);
        }
        f32x4 muv[4], gn[4], bs[4];
#pragma unroll
        for (int mt = 0; mt < 4; ++mt) { const int ch = h * 64 + 16 * mt + 4 * g; muv[mt] = *(const f32x4*)(a.in[17] + 1024 + ch); gn[mt] = *(const f32x4*)(a.in[26] + ch); bs[mt] = *(const f32x4*)(a.in[27] + ch); }
        f16x4 nvc[4], nvp[4], ngg[4]; f32x2 nbo;
#define Z_LOAD(nt_) do { const int t_ = 16 * (nt_) + r16; const size_t m_ = m0 + t_; nbo = *(const f32x2*)(BON + ((size_t)u * 64 + t_) * 2); \
            _Pragma("unroll") for (int mt = 0; mt < 4; ++mt) { const int ch = h * 64 + 16 * mt + 4 * g; nvc[mt] = *(const f16x4*)(PROJ + m_ * IN_PAD + C_V + ch); \
                nvp[mt] = (f16x4){0, 0, 0, 0}; if ((c * 64 + t_) != 0) nvp[mt] = *(const f16x4*)(PROJ + (m_ - 1) * IN_PAD + C_V + ch); ngg[mt] = *(const f16x4*)(RWG + m_ * RW + ch); } } while (0)
        Z_LOAD(0);
#pragma unroll
        for (int nt = 0; nt < 4; ++nt) {
            const int t = 16 * nt + r16; const size_t m = m0 + t;
            f16x4 vc[4], vp[4], gg[4]; const f32x2 bo = nbo;
#pragma unroll
            for (int mt = 0; mt < 4; ++mt) { vc[mt] = nvc[mt]; vp[mt] = nvp[mt]; gg[mt] = ngg[mt]; }
            if (nt < 3) Z_LOAD(nt + 1);
            float s = 0.f;
#pragma unroll
            for (int mt = 0; mt < 4; ++mt) s += (acc[mt][nt][0] + acc[mt][nt][1]) + (acc[mt][nt][2] + acc[mt][nt][3]);
            s += __shfl_xor(s, 16); s += __shfl_xor(s, 32);
            const float mean = s * (1.f / 64.f); float q = 0.f;
#pragma unroll
            for (int mt = 0; mt < 4; ++mt)
#pragma unroll
                for (int e = 0; e < 4; ++e) { const float d = acc[mt][nt][e] - mean; q += d * d; }
            q += __shfl_xor(q, 16); q += __shfl_xor(q, 32);
            const float rstd = rsqrtf(q * (1.f / 64.f) + GN_EPS);
            const float bonus = bo[0] + bo[1];
#pragma unroll
            for (int mt = 0; mt < 4; ++mt) {
                const int ch = h * 64 + 16 * mt + 4 * g;
                float o[4];
#pragma unroll
                for (int e = 0; e < 4; ++e) { const float vsv = (float)vc[mt][e] + muv[mt][e] * ((float)vp[mt][e] - (float)vc[mt][e]);
                    o[e] = ((acc[mt][nt][e] - mean) * rstd * gn[mt][e] + bs[mt][e] + bonus * vsv) * (float)gg[mt][e]; }
                u32x2 w; w.x = pkh(o[0], o[1]); w.y = pkh(o[2], o[3]);
                *(u32x2*)(OATT + m * KOUT + 1024 + ch) = w;
            }
        }
#undef Z_LOAD
    }
}

__device__ __forceinline__ f16* x1_row(unsigned char* ws, int m) { return (f16*)(ws + ((m < 16384) ? WS_RWG : (WS_RWS0 - (size_t)16384 * 2048)) + (size_t)m * 2048); }
__device__ __forceinline__ void p10_mid(const Args& a, int vcu, int G, int wave, int lane) {
    unsigned char* ws = a.ws;
    const f16* MIX = (const f16*)(ws + WS_MIX); const float* mod = (const float*)(ws + WS_MOD); f16* HF = (f16*)(ws + WS_H);
    const int gw = vcu * NWAVES + wave, NGW = G * NWAVES;
    float g6[16], g7[16];
#pragma unroll
    for (int j = 0; j < 2; ++j) { const int c = 8 * lane + 512 * j;
        const f32x4 p0 = *(const f32x4*)(a.in[6] + c), p1 = *(const f32x4*)(a.in[6] + c + 4), q0 = *(const f32x4*)(a.in[7] + c), q1 = *(const f32x4*)(a.in[7] + c + 4);
#pragma unroll
        for (int e = 0; e < 4; ++e) { g6[8 * j + e] = p0[e]; g6[8 * j + 4 + e] = p1[e]; g7[8 * j + e] = q0[e]; g7[8 * j + 4 + e] = q1[e]; } }
    f16x8 nmx[2]; f32x4 nx[4];
    if (gw < MTOK) {
#pragma unroll
        for (int j = 0; j < 2; ++j) { const int c = 8 * lane + 512 * j; nmx[j] = *(const f16x8*)(MIX + (size_t)gw * D + c); nx[2 * j] = *(const f32x4*)(a.in[0] + (size_t)gw * D + c); nx[2 * j + 1] = *(const f32x4*)(a.in[0] + (size_t)gw * D + c + 4); } }
    for (int m = gw; m < MTOK; m += NGW) {
        const int b = m >> 12; const float* md = mod + b * 6144;
        float mx[16], xv[16]; float s = 0.f;
#pragma unroll
        for (int j = 0; j < 2; ++j) { const f16x8 v = nmx[j];
#pragma unroll
            for (int e = 0; e < 8; ++e) { mx[8 * j + e] = (float)v[e]; s += mx[8 * j + e] * mx[8 * j + e]; }
#pragma unroll
            for (int e = 0; e < 4; ++e) { xv[8 * j + e] = nx[2 * j][e]; xv[8 * j + 4 + e] = nx[2 * j + 1][e]; } }
        { const int mn = (m + NGW < MTOK) ? m + NGW : m;
#pragma unroll
          for (int j = 0; j < 2; ++j) { const int c = 8 * lane + 512 * j; nmx[j] = *(const f16x8*)(MIX + (size_t)mn * D + c); nx[2 * j] = *(const f32x4*)(a.in[0] + (size_t)mn * D + c); nx[2 * j + 1] = *(const f32x4*)(a.in[0] + (size_t)mn * D + c + 4); } }
        const float r = rsqrtf(wave_sum(s) * (1.f / D) + NORM_EPS);
        float s1 = 0.f;
        f16* x1r = x1_row(ws, m);
#pragma unroll
        for (int j = 0; j < 2; ++j) { const int c = 8 * lane + 512 * j;
            const f32x4 gm0 = *(const f32x4*)(md + 2048 + c), gm1 = *(const f32x4*)(md + 2048 + c + 4);
#pragma unroll
            for (int e = 0; e < 8; ++e) { const float gm = e < 4 ? gm0[e & 3] : gm1[e & 3]; const float x1 = xv[8 * j + e] + gm * (mx[8 * j + e] * r * g6[8 * j + e]); xv[8 * j + e] = x1; s1 += x1 * x1; }
            u32x4 w; w.x = pkh(xv[8 * j], xv[8 * j + 1]); w.y = pkh(xv[8 * j + 2], xv[8 * j + 3]); w.z = pkh(xv[8 * j + 4], xv[8 * j + 5]); w.w = pkh(xv[8 * j + 6], xv[8 * j + 7]);
            *(u32x4*)(x1r + c) = w; }
        const float r1 = rsqrtf(wave_sum(s1) * (1.f / D) + NORM_EPS);
#pragma unroll
        for (int j = 0; j < 2; ++j) { const int c = 8 * lane + 512 * j; float y[8];
            const f32x4 sc0 = *(const f32x4*)(md + 4096 + c), sc1 = *(const f32x4*)(md + 4096 + c + 4), sh0 = *(const f32x4*)(md + 3072 + c), sh1 = *(const f32x4*)(md + 3072 + c + 4);
#pragma unroll
            for (int e = 0; e < 8; ++e) { const float sc = e < 4 ? sc0[e & 3] : sc1[e & 3], sh = e < 4 ? sh0[e & 3] : sh1[e & 3]; y[e] = xv[8 * j + e] * r1 * g7[8 * j + e] * (1.f + sc) + sh; }
            u32x4 w; w.x = pkh(y[0], y[1]); w.y = pkh(y[2], y[3]); w.z = pkh(y[4], y[5]); w.w = pkh(y[6], y[7]);
            *(u32x4*)(HF + (size_t)m * D + c) = w; }
    }
}
__device__ __forceinline__ void p13_final(const Args& a, int vcu, int G, int wave, int lane) {
    unsigned char* ws = a.ws;
    const f16* F = (const f16*)(ws + WS_F); const float* mod = (const float*)(ws + WS_MOD);
    const int gw = vcu * NWAVES + wave, NGW = G * NWAVES;
    float g8[16];
#pragma unroll
    for (int j = 0; j < 2; ++j) { const int c = 8 * lane + 512 * j; const f32x4 p0 = *(const f32x4*)(a.in[8] + c), p1 = *(const f32x4*)(a.in[8] + c + 4);
#pragma unroll
        for (int e = 0; e < 4; ++e) { g8[8 * j + e] = p0[e]; g8[8 * j + 4 + e] = p1[e]; } }
    f16x8 nf[2], nxh[2];
    if (gw < MTOK) { const f16* x1n = x1_row(ws, gw);
#pragma unroll
        for (int j = 0; j < 2; ++j) { const int c = 8 * lane + 512 * j; nf[j] = *(const f16x8*)(F + (size_t)gw * D + c); nxh[j] = *(const f16x8*)(x1n + c); } }
    for (int m = gw; m < MTOK; m += NGW) {
        const int b = m >> 12; const float* md = mod + b * 6144;
        float fv[16]; float s = 0.f;
        f16x8 xh[2];
#pragma unroll
        for (int j = 0; j < 2; ++j) { const f16x8 v = nf[j]; xh[j] = nxh[j];
#pragma unroll
            for (int e = 0; e < 8; ++e) { fv[8 * j + e] = (float)v[e]; s += fv[8 * j + e] * fv[8 * j + e]; } }
        { const int mn = (m + NGW < MTOK) ? m + NGW : m; const f16* x1n = x1_row(ws, mn);
#pragma unroll
          for (int j = 0; j < 2; ++j) { const int c = 8 * lane + 512 * j; nf[j] = *(const f16x8*)(F + (size_t)mn * D + c); nxh[j] = *(const f16x8*)(x1n + c); } }
        const float r = rsqrtf(wave_sum(s) * (1.f / D) + NORM_EPS);
#pragma unroll
        for (int j = 0; j < 2; ++j) { const int c = 8 * lane + 512 * j;
            const f32x4 gf0 = *(const f32x4*)(md + 5120 + c), gf1 = *(const f32x4*)(md + 5120 + c + 4);
            f32x4 o0, o1;
#pragma unroll
            for (int e = 0; e < 4; ++e) { o0[e] = (float)xh[j][e] + gf0[e] * (fv[8 * j + e] * r * g8[8 * j + e]); o1[e] = (float)xh[j][4 + e] + gf1[e] * (fv[8 * j + 4 + e] * r * g8[8 * j + 4 + e]); }
            __builtin_nontemporal_store(o0, (f32x4*)(a.out + (size_t)m * D + c)); __builtin_nontemporal_store(o1, (f32x4*)(a.out + (size_t)m * D + c + 4)); }
    }
}

constexpr int NPHASE = 14;
__global__ void __launch_bounds__(NWAVES * 64, 2) fwd(Args args) {
    extern __shared__ __attribute__((aligned(16))) unsigned char lds_raw[];
    LAS unsigned char* lds = (LAS unsigned char*)lds_raw;
    const int tid = threadIdx.x, lane = tid & 63, wave = __builtin_amdgcn_readfirstlane(tid >> 6);
    const int G = gridDim.x; const int bx = blockIdx.x; const int vcu = (G % 8 == 0) ? (bx % 8) * (G / 8) + bx / 8 : bx;
    volatile LAS unsigned* MISC = (volatile LAS unsigned*)(lds + MISC_OFF);
    if (tid < 16) MISC[tid] = 0u;
    __syncthreads();
    const int lo = args.ph_lo, hi = args.ph_hi;
    unsigned* barw = (unsigned*)(args.ws + WS_CTL) + CW_BAR;
    XcdBarrier bar; bar.bar = barw; bar.x = 0; bar.st = nullptr;
    if (hi - lo > 1) bar = xcd_barrier_post(barw, MISC);
#ifndef PHMASK
#define PHMASK 0x3FFF
#endif
#ifndef REPMASK
#define REPMASK 0
#endif
#define IN(k) (((PHMASK >> (k)) & 1) && lo <= (k) && (k) < hi)
#define REP(k) for (int rep_ = 0; rep_ < (((REPMASK >> (k)) & 1) ? 2 : 1); ++rep_)
#ifndef BARREP
#define BARREP 1
#endif
#define SEAM(k) do { if (IN(k) && IN((k) + 1)) for (int br_ = 0; br_ < BARREP; ++br_) xcd_barrier(bar); } while (0)
    unsigned char* ws = args.ws;
    if (IN(0)) REP(0) { if (rep_) __syncthreads(); p0_prologue(args, lds, vcu, G, wave, lane); } SEAM(0);
    if (IN(1)) REP(1) { if (rep_) __syncthreads(); p1_modnorm(args, vcu, G, wave, lane); } SEAM(1);
    if (IN(2)) REP(2) { if (rep_) __syncthreads(); pg8::Gemm g{(const f16*)(ws + WS_H), (const f16*)(ws + WS_WIN), MTOK, IN_PAD, D}; pg8::StaticOrder S; S.init(MTOK, IN_PAD, G, bx);
        pg8::EpiF16 E{(f16*)(ws + WS_PROJ), IN_PAD}; pg8::gemm_phase<pg8::EpiF16, pg8::StaticOrder, true, true>(lds, g, S, E); } SEAM(2);
#ifdef OLD_BASELINE
    if (IN(5)) REP(5) { if (rep_) __syncthreads(); p5_indexer(args, lds, vcu, G, wave, lane); } SEAM(5);
    if (IN(6)) REP(6) { if (rep_) __syncthreads(); p6_attention(args, lds, vcu, G, wave, lane); p3_rwkv_prep(args, lds, vcu, G, tid); } SEAM(6);
    if (IN(7)) REP(7) { if (rep_) __syncthreads(); p7_scan(args, lds, vcu, G, wave, lane); } SEAM(7);
    if (IN(8)) REP(8) { if (rep_) __syncthreads(); p8_rwkv_post(args, vcu, G, wave, lane); } SEAM(8);
#else
#define SEAMX() do { if (hi - lo > 1) for (int br_ = 0; br_ < BARREP; ++br_) xcd_barrier(bar); } while (0)
    if (IN(3)) REP(3) { if (rep_) __syncthreads(); p3_rows(args, vcu, G, wave, lane); }
    if (IN(6)) REP(6) { __syncthreads(); p7x_chunks(args, lds, vcu, G, tid, wave, lane); } SEAMX();
    if (IN(4)) REP(4) { if (rep_) __syncthreads(); pg8::Gemm g{(const f16*)(ws + WS_CQ), (const f16*)(ws + WS_WCQ), MTOK, NQI, QL}; pg8::StaticOrder S; S.init(MTOK, NQI, G, bx);
        pg8::EpiF16 E{(f16*)args.out, NQI}; pg8::gemm_phase<pg8::EpiF16, pg8::StaticOrder, true, true>(lds, g, S, E); }
    if (IN(7)) REP(7) { __syncthreads(); p7y_chain(args, bx, G, wave, lane); } SEAMX();
    if (IN(5)) REP(5) { if (rep_) __syncthreads(); p5_dsa(args, lds, G, bx, tid, wave, lane); }
    if (IN(8)) REP(8) { __syncthreads(); p8z_out(args, vcu, G, wave, lane); } SEAMX();
#endif
    if (IN(9)) REP(9) { if (rep_) __syncthreads(); pg8::Gemm g{(const f16*)(ws + WS_OATT), (const f16*)(ws + WS_WOUT), MTOK, D, KOUT}; pg8::StaticOrder S; S.init(MTOK, D, G, bx);
        pg8::EpiF16 E{(f16*)(ws + WS_MIX), D}; pg8::gemm_phase<pg8::EpiF16, pg8::StaticOrder, true, true>(lds, g, S, E); } SEAM(9);
    if (IN(10)) REP(10) { if (rep_) __syncthreads(); p10_mid(args, vcu, G, wave, lane); } SEAM(10);
    if (IN(11)) REP(11) { if (rep_) __syncthreads(); pg8::Gemm g{(const f16*)(ws + WS_H), (const f16*)(ws + WS_WGU), MTOK, 2 * DFF, D}; pg8::StaticOrder S; S.init(MTOK, 2 * DFF, G, bx);
        pg8::EpiSwiGLU E{(f16*)(ws + WS_ACT), DFF}; pg8::gemm_phase<pg8::EpiSwiGLU, pg8::StaticOrder, true, true>(lds, g, S, E); } SEAM(11);
    if (IN(12)) REP(12) { if (rep_) __syncthreads(); pg8::Gemm g{(const f16*)(ws + WS_ACT), (const f16*)(ws + WS_WDN), MTOK, D, DFF}; pg8::StaticOrder S; S.init(MTOK, D, G, bx);
        pg8::EpiF16 E{(f16*)(ws + WS_F), D}; pg8::gemm_phase<pg8::EpiF16, pg8::StaticOrder, true, true>(lds, g, S, E); } SEAM(12);
    if (IN(13)) REP(13) { if (rep_) __syncthreads(); p13_final(args, vcu, G, wave, lane); }
#undef IN
#undef SEAM
}

#ifndef N_LAUNCH_MODE
#define N_LAUNCH_MODE 1
#endif
extern "C" void kernel_launch(void* const* d_in, const int* in_sizes, int n_in, void* d_out, int out_size, void* d_ws, size_t ws_size, hipStream_t stream) {
    static int grid = 0;
    if (grid == 0) {
        int dev = 0, cus = 0, per_cu = 0;
        if (n_in != 32 || ws_size < WS_END) { fprintf(stderr, "kernel_launch: unexpected n_in %d or ws_size %zu (< %zu)\n", n_in, ws_size, (size_t)WS_END); }
        if (hipGetDevice(&dev) != hipSuccess || hipDeviceGetAttribute(&cus, hipDeviceAttributeMultiprocessorCount, dev) != hipSuccess) { grid = -1; return; }
        if (hipFuncSetAttribute((const void*)fwd, hipFuncAttributeMaxDynamicSharedMemorySize, LDS_BYTES) != hipSuccess) { fprintf(stderr, "kernel_launch: hipFuncSetAttribute failed\n"); grid = -1; return; }
        if (hipOccupancyMaxActiveBlocksPerMultiprocessor(&per_cu, (const void*)fwd, NWAVES * 64, LDS_BYTES) != hipSuccess || per_cu < 1) fprintf(stderr, "kernel_launch: occupancy query says %d\n", per_cu);
        (void)hipGetLastError();
        grid = cus;
    }
    if (grid < 0) return;
    (void)hipMemsetAsync((char*)d_ws + WS_CTL, 0, CTL_ZERO_BYTES, stream);
    Args a{};
    for (int i = 0; i < 32; ++i) a.in[i] = (const float*)d_in[i];
    a.out = (float*)d_out; a.ws = (unsigned char*)d_ws;
    if (N_LAUNCH_MODE == 1) { a.ph_lo = 0; a.ph_hi = NPHASE; hipLaunchKernelGGL(fwd, dim3(grid), dim3(NWAVES * 64), LDS_BYTES, stream, a); }
    else for (int p = 0; p < NPHASE; ++p) { a.ph_lo = p; a.ph_hi = p + 1; hipLaunchKernelGGL(fwd, dim3(grid), dim3(NWAVES * 64), LDS_BYTES, stream, a); }
}
```
